# Optimizing an MI355X kernel written in HIP

```python
import math
import numpy as np
import jax
import jax.numpy as jnp
from jax import lax

D_MODEL = 1024
BATCH = 2
SEQ = 8192
DEPTH = 1

NSA_HEADS = 8
NSA_KV_GROUPS = 2
NSA_HPG = NSA_HEADS // NSA_KV_GROUPS
NSA_HEAD_DIM = 64
NSA_WIDTH = NSA_HEADS * NSA_HEAD_DIM
NSA_KV_WIDTH = NSA_KV_GROUPS * NSA_HEAD_DIM
CMP_BLK = 32
CMP_STRIDE = 16
CMP_HID = 256
SEL_BLK = 64
N_SEL = 16
WINDOW = 512
Q_BLK = 128
ROPE_THETA = 10000.0

GDN_HEADS = 4
GDN_HEAD_DIM = 128
GDN_WIDTH = GDN_HEADS * GDN_HEAD_DIM
CONV_K = 4
GDN_CHUNK = 64

MIX_WIDTH = NSA_WIDTH + GDN_WIDTH
IN_SPLITS = (NSA_WIDTH, 6 * NSA_KV_WIDTH, 3 * NSA_HEADS, 3 * GDN_WIDTH, GDN_WIDTH, GDN_HEADS, GDN_HEADS)
IN_COLS = NSA_WIDTH + 6 * NSA_KV_WIDTH + 3 * NSA_HEADS + 4 * GDN_WIDTH + 2 * GDN_HEADS

PEER_HEADS = 8
PEER_TOPK = 16
N_KEYS = 128
N_EXPERTS = N_KEYS * N_KEYS
PEER_DKEY = 256
PEER_TBLK = 128

NEG_INF = -1e30
FORCE = 1e4

kernel_name = 'hybrid_nsa_gdn_peer'


def _rmsnorm(x, g, eps=1e-6):
    xf = x.astype(jnp.float32)
    y = xf * lax.rsqrt(jnp.mean(xf * xf, axis=-1, keepdims=True) + eps)
    return (y * g.astype(jnp.float32)).astype(x.dtype)


def _l2norm(x, eps=1e-6):
    return x * lax.rsqrt(jnp.sum(x * x, axis=-1, keepdims=True) + eps)


def _rope(x, pos):
    d = x.shape[-1]
    half = d // 2
    inv = jnp.exp(-math.log(ROPE_THETA) * 2.0 * jnp.arange(half, dtype=jnp.float32) / d)
    ang = pos.astype(jnp.float32)[:, None] * inv[None, :]
    cos, sin = jnp.cos(ang), jnp.sin(ang)
    xf = x.astype(jnp.float32)
    x1, x2 = xf[..., :half], xf[..., half:]
    return jnp.concatenate([x1 * cos - x2 * sin, x2 * cos + x1 * sin], axis=-1).astype(x.dtype)


def _masked_softmax(s, mask):
    s = jnp.where(mask, s.astype(jnp.float32), NEG_INF)
    p = jax.nn.softmax(s, axis=-1)
    return p * jnp.any(mask, axis=-1, keepdims=True).astype(jnp.float32)


def _cmp_to_sel(p_cmp, n_blk):
    r = SEL_BLK // CMP_STRIDE
    l = CMP_BLK // CMP_STRIDE
    n_cmp = p_cmp.shape[-1]
    pad = [(0, 0)] * (p_cmp.ndim - 1) + [(l - 1, r * n_blk - n_cmp)]
    padded = jnp.pad(p_cmp, pad)
    out = jnp.zeros(p_cmp.shape[:-1] + (n_blk,), jnp.float32)
    for o in range(-(l - 1), r):
        w = float(min(o + l, r) - max(o, 0))
        start = o + l - 1
        out = out + w * padded[..., start:start + r * n_blk:r]
    return out


def _nsa(q_in, kc_in, vc_in, ks_in, vs_in, kw_in, vw_in, gate_in, q_gain, k_gain, cmp_pos, cmp_w1, cmp_w2):
    B, S, _ = q_in.shape
    G, HPG, DH = NSA_KV_GROUPS, NSA_HPG, NSA_HEAD_DIM
    pos = jnp.arange(S)
    q = q_in.reshape(B, S, G, HPG, DH).transpose(0, 2, 3, 1, 4)
    q = _rope(_rmsnorm(q, q_gain), pos)

    def heads(a):
        return a.reshape(B, S, G, DH).transpose(0, 2, 1, 3)

    l = CMP_BLK // CMP_STRIDE
    n_cmp = S // CMP_STRIDE - l + 1

    def compress(a, j):
        a16 = a.reshape(B, G, S // CMP_STRIDE, CMP_STRIDE, DH)
        blocks = jnp.concatenate([a16[:, :, i:i + n_cmp] for i in range(l)], axis=3)
        blocks = (blocks + cmp_pos[j]).reshape(B, G, n_cmp, CMP_BLK * DH)
        return jax.nn.gelu(blocks @ cmp_w1[j]) @ cmp_w2[j]

    cmp_end = jnp.arange(n_cmp) * CMP_STRIDE + CMP_BLK - 1
    kc = _rope(_rmsnorm(compress(heads(kc_in), 0), k_gain[0]), cmp_end)
    vc = compress(heads(vc_in), 1)
    n_blk = S // SEL_BLK
    ks = _rope(_rmsnorm(heads(ks_in), k_gain[1]), pos)
    ks_blk = ks.reshape(B, G, n_blk, SEL_BLK, DH)
    vs_blk = heads(vs_in).reshape(B, G, n_blk, SEL_BLK, DH)
    kw = _rope(_rmsnorm(heads(kw_in), k_gain[2]), pos)
    kw_pad = jnp.pad(kw, ((0, 0), (0, 0), (WINDOW, 0), (0, 0)))
    vw_pad = jnp.pad(heads(vw_in), ((0, 0), (0, 0), (WINDOW, 0), (0, 0)))

    n_sel = min(N_SEL, n_blk)
    scale = DH ** -0.5
    bi = jnp.arange(B)[:, None, None, None]
    gi = jnp.arange(G)[None, :, None, None]
    blk_ids = jnp.arange(n_blk)
    sel_off = jnp.arange(SEL_BLK)
    win_off = jnp.arange(WINDOW + Q_BLK) - WINDOW

    def block(args):
        qb, qq = args
        t0 = qb * Q_BLK
        t = t0 + jnp.arange(Q_BLK)
        s_c = jnp.einsum('bghtd,bgnd->bghtn', qq, kc) * scale
        p_c = _masked_softmax(s_c, cmp_end[None, :] <= t[:, None])
        o_c = jnp.einsum('bghtn,bgnd->bghtd', p_c.astype(vc.dtype), vc)
        imp = _cmp_to_sel(p_c, n_blk).sum(axis=2)
        cur = t // SEL_BLK
        forced = (blk_ids[None, :] == 0) | (blk_ids[None, :] == cur[:, None]) | (blk_ids[None, :] == cur[:, None] - 1)
        causal_blk = blk_ids[None, :] * SEL_BLK <= t[:, None]
        score = jnp.where(causal_blk, jnp.where(forced, FORCE, imp), NEG_INF)
        _, idx = lax.top_k(score, n_sel)
        k_g = ks_blk[bi, gi, idx].reshape(B, G, Q_BLK, n_sel * SEL_BLK, DH)
        v_g = vs_blk[bi, gi, idx].reshape(B, G, Q_BLK, n_sel * SEL_BLK, DH)
        pos_g = (idx[..., None] * SEL_BLK + sel_off).reshape(B, G, Q_BLK, n_sel * SEL_BLK)
        s_s = jnp.einsum('bghtd,bgtkd->bghtk', qq, k_g) * scale
        p_s = _masked_softmax(s_s, (pos_g <= t[:, None])[:, :, None])
        o_s = jnp.einsum('bghtk,bgtkd->bghtd', p_s.astype(v_g.dtype), v_g)
        k_w = lax.dynamic_slice_in_dim(kw_pad, t0, WINDOW + Q_BLK, axis=2)
        v_w = lax.dynamic_slice_in_dim(vw_pad, t0, WINDOW + Q_BLK, axis=2)
        pos_w = t0 + win_off
        rel = t[:, None] - pos_w[None, :]
        mask_w = (pos_w[None, :] >= 0) & (rel >= 0) & (rel < WINDOW)
        s_w = jnp.einsum('bghtd,bgkd->bghtk', qq, k_w) * scale
        p_w = _masked_softmax(s_w, mask_w)
        o_w = jnp.einsum('bghtk,bgkd->bghtd', p_w.astype(v_w.dtype), v_w)
        return o_c, o_s, o_w

    n_qb = S // Q_BLK
    q_blocks = q.reshape(B, G, HPG, n_qb, Q_BLK, DH).transpose(3, 0, 1, 2, 4, 5)
    o_c, o_s, o_w = lax.map(block, (jnp.arange(n_qb), q_blocks))
    o = jnp.stack([o_c, o_s, o_w], axis=-1)
    o = o.transpose(1, 0, 4, 2, 3, 5, 6).reshape(B, S, NSA_HEADS, DH, 3)
    gate = jax.nn.sigmoid(gate_in.astype(jnp.float32)).reshape(B, S, NSA_HEADS, 1, 3)
    return (o.astype(jnp.float32) * gate).sum(-1).reshape(B, S, NSA_WIDTH).astype(q_in.dtype)


def _gated_delta_chunked(q, k, v, g, beta):
    B, H, S, dk = q.shape
    dv = v.shape[-1]
    C = GDN_CHUNK
    N = S // C
    q = q.reshape(B, H, N, C, dk)
    k = k.reshape(B, H, N, C, dk)
    v = v.reshape(B, H, N, C, dv)
    beta = beta.reshape(B, H, N, C)
    g = jnp.cumsum(g.reshape(B, H, N, C), axis=-1)
    incl = jnp.tril(jnp.ones((C, C), bool))
    strict = jnp.tril(jnp.ones((C, C), bool), -1)
    diff = g[..., :, None] - g[..., None, :]
    decay = jnp.where(incl, jnp.exp(jnp.where(incl, diff, 0.0)), 0.0)
    kb = k * beta[..., None]
    a_mat = jnp.where(strict, jnp.einsum('bhnid,bhnjd->bhnij', kb, k) * decay, 0.0)
    m = a_mat + jnp.eye(C, dtype=jnp.float32)
    u = lax.linalg.triangular_solve(m, v * beta[..., None], left_side=True, lower=True)
    w = lax.linalg.triangular_solve(m, kb * jnp.exp(g)[..., None], left_side=True, lower=True)
    intra = jnp.where(incl, jnp.einsum('bhnid,bhnjd->bhnij', q, k) * decay, 0.0)
    q_dec = q * jnp.exp(g)[..., None]
    k_dec = k * jnp.exp(g[..., -1:] - g)[..., None]
    g_last = jnp.exp(g[..., -1])

    def step(state, xs):
        qd, kd, u_c, w_c, a_c, gl = xs
        v_new = u_c - jnp.einsum('bhck,bhkv->bhcv', w_c, state)
        o = jnp.einsum('bhck,bhkv->bhcv', qd, state) + jnp.einsum('bhcj,bhjv->bhcv', a_c, v_new)
        state = state * gl[..., None, None] + jnp.einsum('bhck,bhcv->bhkv', kd, v_new)
        return state, o

    xs = tuple(jnp.moveaxis(a, 2, 0) for a in (q_dec, k_dec, u, w, intra, g_last))
    _, o = lax.scan(step, jnp.zeros((B, H, dk, dv), jnp.float32), xs)
    return jnp.moveaxis(o, 0, 2).reshape(B, H, S, dv)


def _gdn(qkv, z, a, b, conv_w, a_log, dt_bias, out_gain):
    B, S, _ = qkv.shape
    H, DH = GDN_HEADS, GDN_HEAD_DIM
    xp = jnp.pad(qkv, ((0, 0), (CONV_K - 1, 0), (0, 0)))
    conv = xp[:, 0:S] * conv_w[0]
    for j in range(1, CONV_K):
        conv = conv + xp[:, j:j + S] * conv_w[j]
    conv = jax.nn.silu(conv)
    q, k, v = jnp.split(conv, 3, axis=-1)

    def heads(t):
        return t.reshape(B, S, H, DH).transpose(0, 2, 1, 3).astype(jnp.float32)

    q = _l2norm(heads(q)) * (DH ** -0.5)
    k = _l2norm(heads(k))
    v = heads(v)
    beta = jax.nn.sigmoid(b.astype(jnp.float32)).transpose(0, 2, 1)
    g = (-jnp.exp(a_log.astype(jnp.float32)) * jax.nn.softplus(a.astype(jnp.float32) + dt_bias.astype(jnp.float32))).transpose(0, 2, 1)
    o = _gated_delta_chunked(q, k, v, g, beta).transpose(0, 2, 1, 3)
    o = _rmsnorm(o, out_gain) * jax.nn.silu(z.reshape(B, S, H, DH).astype(jnp.float32))
    return o.reshape(B, S, GDN_WIDTH).astype(qkv.dtype)


def _peer(h, w_query, subkeys, u_tab, v_tab):
    B, S, D = h.shape
    T = B * S
    hf = h.reshape(T, D)
    qry = (hf @ w_query).reshape(T, PEER_HEADS, 2, PEER_DKEY // 2).astype(jnp.float32)
    s1 = jnp.einsum('thd,nd->thn', qry[:, :, 0], subkeys[0].astype(jnp.float32))
    s2 = jnp.einsum('thd,nd->thn', qry[:, :, 1], subkeys[1].astype(jnp.float32))
    v1, i1 = lax.top_k(s1, PEER_TOPK)
    v2, i2 = lax.top_k(s2, PEER_TOPK)
    cand = (v1[..., :, None] + v2[..., None, :]).reshape(T, PEER_HEADS, PEER_TOPK * PEER_TOPK)
    cidx = (i1[..., :, None] * N_KEYS + i2[..., None, :]).reshape(T, PEER_HEADS, PEER_TOPK * PEER_TOPK)
    top_s, top_pos = lax.top_k(cand, PEER_TOPK)
    eidx = jnp.take_along_axis(cidx, top_pos, axis=-1)
    gate = jax.nn.softmax(top_s, axis=-1)
    nb = T // PEER_TBLK

    def block(args):
        xb, eb, gb = args
        ue = u_tab[eb]
        act = jax.nn.gelu(jnp.einsum('td,thkd->thk', xb, ue).astype(jnp.float32))
        coef = (gb * act).astype(v_tab.dtype)
        return jnp.einsum('thk,thkd->td', coef, v_tab[eb])

    out = lax.map(block, (hf.reshape(nb, PEER_TBLK, D),
                          eidx.reshape(nb, PEER_TBLK, PEER_HEADS, PEER_TOPK),
                          gate.reshape(nb, PEER_TBLK, PEER_HEADS, PEER_TOPK)))
    return out.reshape(B, S, D).astype(h.dtype)


def setup_inputs(seed: int = 0) -> dict:
    key = jax.random.key(seed)
    ks = jax.random.split(key, 20)
    f32 = jnp.float32
    nrm = lambda k, shape, s: jax.random.normal(k, shape, f32) * s
    dt = jnp.exp(jax.random.uniform(ks[10], (DEPTH, GDN_HEADS), f32, math.log(1e-3), math.log(1e-1)))
    return {
        'x': nrm(ks[0], (BATCH, SEQ, D_MODEL), 1.0),
        'attn_norm': 1.0 + nrm(ks[1], (DEPTH, D_MODEL), 0.02),
        'w_in': nrm(ks[2], (DEPTH, D_MODEL, IN_COLS), D_MODEL ** -0.5),
        'nsa_q_gain': 1.0 + nrm(ks[3], (DEPTH, NSA_HEAD_DIM), 0.02),
        'nsa_k_gain': 1.0 + nrm(ks[4], (DEPTH, 3, NSA_HEAD_DIM), 0.02),
        'cmp_pos': nrm(ks[5], (DEPTH, 2, CMP_BLK, NSA_HEAD_DIM), 0.1),
        'cmp_w1': nrm(ks[6], (DEPTH, 2, CMP_BLK * NSA_HEAD_DIM, CMP_HID), (CMP_BLK * NSA_HEAD_DIM) ** -0.5),
        'cmp_w2': nrm(ks[7], (DEPTH, 2, CMP_HID, NSA_HEAD_DIM), CMP_HID ** -0.5),
        'gdn_conv': nrm(ks[8], (DEPTH, CONV_K, 3 * GDN_WIDTH), CONV_K ** -0.5),
        'gdn_a_log': jnp.log(jax.random.uniform(ks[9], (DEPTH, GDN_HEADS), f32, 1.0, 16.0)),
        'gdn_dt_bias': dt + jnp.log(-jnp.expm1(-dt)),
        'gdn_out_gain': 1.0 + nrm(ks[11], (DEPTH, GDN_HEAD_DIM), 0.02),
        'w_out': nrm(ks[12], (DEPTH, MIX_WIDTH, D_MODEL), MIX_WIDTH ** -0.5),
        'ffn_norm': 1.0 + nrm(ks[13], (DEPTH, D_MODEL), 0.02),
        'peer_w_query': nrm(ks[14], (DEPTH, D_MODEL, PEER_HEADS * PEER_DKEY), D_MODEL ** -0.5),
        'peer_subkeys': nrm(ks[15], (DEPTH, 2, N_KEYS, PEER_DKEY // 2), (PEER_DKEY // 2) ** -0.5),
        'peer_u': nrm(ks[16], (DEPTH, N_EXPERTS, D_MODEL), D_MODEL ** -0.5),
        'peer_v': nrm(ks[17], (DEPTH, N_EXPERTS, D_MODEL), 0.5),
    }


def reference(x, attn_norm, w_in, nsa_q_gain, nsa_k_gain, cmp_pos, cmp_w1, cmp_w2, gdn_conv, gdn_a_log,
              gdn_dt_bias, gdn_out_gain, w_out, ffn_norm, peer_w_query, peer_subkeys, peer_u, peer_v):
    offsets = np.cumsum(np.array(IN_SPLITS))[:-1].tolist()
    for l in range(DEPTH):
        h = _rmsnorm(x, attn_norm[l])
        proj = h @ w_in[l]
        q_a, kv_a, gate_a, qkv_b, z_b, a_b, b_b = jnp.split(proj, offsets, axis=-1)
        kc, vc, ks_, vs_, kw, vw = jnp.split(kv_a, 6, axis=-1)
        o_a = _nsa(q_a, kc, vc, ks_, vs_, kw, vw, gate_a, nsa_q_gain[l], nsa_k_gain[l],
                   cmp_pos[l], cmp_w1[l], cmp_w2[l])
        o_b = _gdn(qkv_b, z_b, a_b, b_b, gdn_conv[l], gdn_a_log[l], gdn_dt_bias[l], gdn_out_gain[l])
        x = x + jnp.concatenate([o_a, o_b], axis=-1) @ w_out[l]
        x = x + _peer(_rmsnorm(x, ffn_norm[l]), peer_w_query[l], peer_subkeys[l], peer_u[l], peer_v[l])
    return x
```

```cpp
#include <hip/hip_runtime.h>
#include <stdint.h>

typedef unsigned short bf16_t;
typedef __attribute__((ext_vector_type(8))) short bf16x8;
typedef __attribute__((ext_vector_type(4))) float f32x4;

#define T_TOK 16384
#define SEQ 8192
#define DM 1024
#define IN_COLS 3360
#define PLD 3456
#define C_Q 0
#define C_KV 512
#define C_GATE 1280
#define C_GQKV 1304
#define C_Z 2840
#define C_A 3352
#define C_B 3356

#define OFF_WINT   0ull
#define OFF_WOUTT  (OFF_WINT  + 3456ull*1024*2)
#define OFF_WQT    (OFF_WOUTT + 1024ull*1024*2)
#define OFF_CW1T   (OFF_WQT   + 2048ull*1024*2)
#define OFF_CBIAS  (OFF_CW1T  + 2ull*256*2048*2)
#define OFF_HBF    (OFF_CBIAS + 4096ull)
#define OFF_PROJ   (OFF_HBF   + 16384ull*1024*2)
#define OFF_KSN    (OFF_PROJ  + (16384ull+32)*PLD*2)
#define OFF_KWN    (OFF_KSN   + 4ull*8192*64*2)
#define OFF_KC     (OFF_KWN   + 4ull*8192*64*2)
#define OFF_VC     (OFF_KC    + 4ull*512*64*2)
#define OFF_HID    (OFF_VC    + 4ull*512*64*2)
#define OFF_GU     (OFF_HID   + 8ull*512*256*2)
#define OFF_GW     (OFF_GU    + 1024ull*64*128*2)
#define OFF_GQD    (OFF_GW    + 1024ull*64*128*2)
#define OFF_GKD    (OFF_GQD   + 1024ull*64*128*2)
#define OFF_GIN    (OFF_GKD   + 1024ull*64*128*2)
#define OFF_GL     (OFF_GIN   + 1024ull*64*64*2)
#define OFF_END    (OFF_GL    + 4096ull)
#define OFF_MIX    OFF_HBF
#define OFF_QRY    OFF_PROJ
#define OFF_H2     (OFF_PROJ + 16384ull*2048*2)
#define OFF_EIDX   OFF_GU
#define OFF_PGATE  (OFF_GU + 16384ull*128*4)

__device__ __forceinline__ bf16_t f2bf(float f) {
    unsigned u = __float_as_uint(f);
    u += 0x7fffu + ((u >> 16) & 1u);
    return (bf16_t)(u >> 16);
}
__device__ __forceinline__ float bf2f(bf16_t h) { return __uint_as_float(((unsigned)h) << 16); }
__device__ __forceinline__ float gelu_tanh(float x) {
    float u = 0.7978845608028654f * (x + 0.044715f * x * x * x);
    return 0.5f * x * (1.f + tanhf(u));
}
__device__ __forceinline__ float sigmoidf_(float x) { return 1.f / (1.f + __expf(-x)); }
__device__ __forceinline__ float wave_sum(float v) {
#pragma unroll
    for (int o = 32; o > 0; o >>= 1) v += __shfl_xor(v, o);
    return v;
}
__device__ __forceinline__ float wave_max(float v) {
#pragma unroll
    for (int o = 32; o > 0; o >>= 1) v = fmaxf(v, __shfl_xor(v, o));
    return v;
}

__device__ __forceinline__ void d_transpose_bf16(const float* __restrict__ W, int K, int N, bf16_t* __restrict__ Wt, int bx, int by, char* smem) {
    float (*tile)[33] = (float (*)[33])smem;
    int n0 = bx * 32, k0 = by * 32;
    int tx = threadIdx.x & 31, ty = threadIdx.x >> 5;
    for (int i = ty; i < 32; i += 8) {
        int n = n0 + tx;
        tile[i][tx] = (n < N) ? W[(size_t)(k0 + i) * N + n] : 0.f;
    }
    __syncthreads();
    for (int i = ty; i < 32; i += 8) {
        Wt[(size_t)(n0 + i) * K + k0 + tx] = f2bf(tile[tx][i]);
    }
}

__device__ __forceinline__ void d_rmsnorm_bf16(const float* __restrict__ x, const float* __restrict__ g, bf16_t* __restrict__ out, int bid) {
    int row = bid * 4 + (threadIdx.x >> 6);
    int lane = threadIdx.x & 63;
    const float4* xr = (const float4*)(x + (size_t)row * DM);
    float4 v[4];
    float ss = 0.f;
#pragma unroll
    for (int i = 0; i < 4; i++) { v[i] = xr[lane + 64 * i]; ss += v[i].x * v[i].x + v[i].y * v[i].y + v[i].z * v[i].z + v[i].w * v[i].w; }
    ss = wave_sum(ss);
    float r = rsqrtf(ss * (1.f / DM) + 1e-6f);
#pragma unroll
    for (int i = 0; i < 4; i++) {
        float4 gg = ((const float4*)g)[lane + 64 * i];
        ushort4 o;
        o.x = f2bf(v[i].x * r * gg.x); o.y = f2bf(v[i].y * r * gg.y); o.z = f2bf(v[i].z * r * gg.z); o.w = f2bf(v[i].w * r * gg.w);
        ((ushort4*)(out + (size_t)row * DM))[lane + 64 * i] = o;
    }
}

__device__ __forceinline__ void d_cmp_bias(const float* __restrict__ pos, const float* __restrict__ w1, float* __restrict__ bias, int bid) {
    int j = bid, c = threadIdx.x;
    float s = 0.f;
    for (int k = 0; k < 2048; k++) s += pos[j * 2048 + k] * w1[((size_t)j * 2048 + k) * 256 + c];
    bias[j * 256 + c] = s;
}

#define EPI_PROJ 0
#define EPI_HID 1
#define EPI_OUT 2
#define EPI_QRY 3
struct GemmP {
    const bf16_t* A; long lda; long akts;
    const bf16_t* Bt; long ldb;
    int K; int mtiles; int ntiles;
    long a_inst; long b_inst;
    void* out; const float* aux; const float* aux2;
};

template <int EPI>
__device__ __forceinline__ void d_gemm(const GemmP& p, int bid, char* smem) {
    bf16_t* As = (bf16_t*)smem;
    bf16_t* Bs = As + 128 * 72;
    const int tid = threadIdx.x, lane = tid & 63, wave = tid >> 6;
    const int wm = wave >> 1, wn = wave & 1;
    const int inst = 0;
    const int mt = bid / p.ntiles, nt = bid % p.ntiles;
    const int m0 = mt * 128, n0 = nt * 128;
    const bf16_t* A = p.A + (size_t)inst * p.a_inst + (size_t)m0 * p.lda;
    const bf16_t* Bt = p.Bt + (size_t)inst * p.b_inst + (size_t)n0 * p.ldb;
    f32x4 acc[4][4];
#pragma unroll
    for (int i = 0; i < 4; i++)
#pragma unroll
        for (int j = 0; j < 4; j++) acc[i][j] = (f32x4){0.f, 0.f, 0.f, 0.f};
    const int nk = p.K >> 6;
    const int lrow = tid >> 3, lc8 = (tid & 7) * 8;
    const bf16_t* Ap = A + (size_t)lrow * p.lda + lc8;
    const bf16_t* Bp = Bt + (size_t)lrow * p.ldb + lc8;
    const size_t a32 = (size_t)32 * p.lda, b32 = (size_t)32 * p.ldb;
    uint4 ra0, ra1, ra2, ra3, rb0, rb1, rb2, rb3;
#define GLOAD(koffA, koffB) \
    ra0 = *(const uint4*)(Ap + (koffA)); ra1 = *(const uint4*)(Ap + a32 + (koffA)); ra2 = *(const uint4*)(Ap + 2 * a32 + (koffA)); ra3 = *(const uint4*)(Ap + 3 * a32 + (koffA)); \
    rb0 = *(const uint4*)(Bp + (koffB)); rb1 = *(const uint4*)(Bp + b32 + (koffB)); rb2 = *(const uint4*)(Bp + 2 * b32 + (koffB)); rb3 = *(const uint4*)(Bp + 3 * b32 + (koffB));
    GLOAD(0, 0)
    bf16_t* Asw = As + lrow * 72 + lc8;
    bf16_t* Bsw = Bs + lrow * 72 + lc8;
    for (int kt = 0; kt < nk; kt++) {
        *(uint4*)(Asw) = ra0; *(uint4*)(Asw + 32 * 72) = ra1; *(uint4*)(Asw + 64 * 72) = ra2; *(uint4*)(Asw + 96 * 72) = ra3;
        *(uint4*)(Bsw) = rb0; *(uint4*)(Bsw + 32 * 72) = rb1; *(uint4*)(Bsw + 64 * 72) = rb2; *(uint4*)(Bsw + 96 * 72) = rb3;
        __syncthreads();
        if (kt + 1 < nk) {
            GLOAD((size_t)(kt + 1) * p.akts, (size_t)(kt + 1) * 64)
        }
#pragma unroll
        for (int ks = 0; ks < 2; ks++) {
            bf16x8 af[4], bfr[4];
#pragma unroll
            for (int i = 0; i < 4; i++) af[i] = *(const bf16x8*)(As + (wm * 64 + i * 16 + (lane & 15)) * 72 + ks * 32 + (lane >> 4) * 8);
#pragma unroll
            for (int j = 0; j < 4; j++) bfr[j] = *(const bf16x8*)(Bs + (wn * 64 + j * 16 + (lane & 15)) * 72 + ks * 32 + (lane >> 4) * 8);
#pragma unroll
            for (int i = 0; i < 4; i++)
#pragma unroll
                for (int j = 0; j < 4; j++) acc[i][j] = __builtin_amdgcn_mfma_f32_16x16x32_bf16(af[i], bfr[j], acc[i][j], 0, 0, 0);
        }
        __syncthreads();
    }
#pragma unroll
    for (int i = 0; i < 4; i++)
#pragma unroll
        for (int j = 0; j < 4; j++)
#pragma unroll
            for (int r = 0; r < 4; r++) {
                int row = m0 + wm * 64 + i * 16 + (lane >> 4) * 4 + r;
                int col = n0 + wn * 64 + j * 16 + (lane & 15);
                float v = acc[i][j][r];
                if (EPI == EPI_PROJ) {
                    ((bf16_t*)p.out)[(size_t)row * PLD + col] = f2bf(v);
                } else if (EPI == EPI_HID) {
                    float bb = p.aux[(inst >> 2) * 256 + col];
                    ((bf16_t*)p.out)[((size_t)inst * 512 + row) * 256 + col] = f2bf(gelu_tanh(v + bb));
                } else if (EPI == EPI_OUT) {
                    ((float*)p.out)[(size_t)row * DM + col] = p.aux[(size_t)row * DM + col] + v;
                } else if (EPI == EPI_QRY) {
                    ((bf16_t*)p.out)[(size_t)row * 2048 + col] = f2bf(v);
                }
            }
}

__device__ __forceinline__ void d_knorm_rope(const bf16_t* __restrict__ proj, const float* __restrict__ kgain, bf16_t* __restrict__ ksn, bf16_t* __restrict__ kwn, int bid) {
    int vec = bid * 8 + (threadIdx.x >> 5);
    int i = threadIdx.x & 31;
    int which = vec >> 15;
    int rem = vec & 32767;
    int b = rem >> 14, g = (rem >> 13) & 1, s = rem & 8191;
    const bf16_t* src = proj + (size_t)(b * SEQ + s) * PLD + C_KV + 128 * (which ? 4 : 2) + 64 * g;
    float x1 = bf2f(src[i]), x2 = bf2f(src[i + 32]);
    float ss = x1 * x1 + x2 * x2;
#pragma unroll
    for (int o = 16; o > 0; o >>= 1) ss += __shfl_xor(ss, o);
    float r = rsqrtf(ss * (1.f / 64.f) + 1e-6f);
    const float* gn = kgain + (which ? 2 : 1) * 64;
    x1 = x1 * r * gn[i]; x2 = x2 * r * gn[i + 32];
    float inv = expf(-9.210340371976184f * (float)(2 * i) / 64.f);
    float ang = (float)s * inv;
    float sn, cs; sincosf(ang, &sn, &cs);
    bf16_t* dst = (which ? kwn : ksn) + ((size_t)(b * 2 + g) * SEQ + s) * 64;
    dst[i] = f2bf(x1 * cs - x2 * sn);
    dst[i + 32] = f2bf(x2 * cs + x1 * sn);
}

__device__ __forceinline__ void d_cmp2(const bf16_t* __restrict__ hid, const float* __restrict__ w2, const float* __restrict__ kgain, bf16_t* __restrict__ kc, bf16_t* __restrict__ vc, int bid) {
    int rowid = bid * 4 + (threadIdx.x >> 6);
    int lane = threadIdx.x & 63;
    int inst = rowid >> 9, n = rowid & 511;
    int j = inst >> 2, bg = inst & 3;
    if (n >= 511) return;
    const bf16_t* hr = hid + (size_t)rowid * 256;
    const float* w = w2 + (size_t)j * 256 * 64;
    float s = 0.f;
    for (int k = 0; k < 256; k++) s += bf2f(hr[k]) * w[k * 64 + lane];
    if (j == 0) {
        float ss = wave_sum(s * s);
        float r = rsqrtf(ss * (1.f / 64.f) + 1e-6f);
        float y = s * r * kgain[lane];
        float other = __shfl_xor(y, 32);
        int i = lane & 31;
        float inv = expf(-9.210340371976184f * (float)(2 * i) / 64.f);
        float ang = (float)(n * 16 + 31) * inv;
        float sn, cs; sincosf(ang, &sn, &cs);
        float o = (lane < 32) ? (y * cs - other * sn) : (y * cs + other * sn);
        kc[((size_t)bg * 512 + n) * 64 + lane] = f2bf(o);
    } else {
        vc[((size_t)bg * 512 + n) * 64 + lane] = f2bf(s);
    }
}

__device__ __forceinline__ float dot64(const float* q, const bf16_t* krow) {
    const uint4* kp = (const uint4*)krow;
    float s = 0.f;
#pragma unroll
    for (int c = 0; c < 8; c++) {
        uint4 u = kp[c];
        unsigned w[4] = {u.x, u.y, u.z, u.w};
#pragma unroll
        for (int e = 0; e < 4; e++) {
            s += q[c * 8 + e * 2] * __uint_as_float(w[e] << 16);
            s += q[c * 8 + e * 2 + 1] * __uint_as_float(w[e] & 0xffff0000u);
        }
    }
    return s;
}

__device__ __forceinline__ void d_nsa_naive(const bf16_t* __restrict__ proj, const float* __restrict__ qgain,
                                                   const bf16_t* __restrict__ ksn, const bf16_t* __restrict__ kwn,
                                                   const bf16_t* __restrict__ kc, const bf16_t* __restrict__ vc,
                                                   bf16_t* __restrict__ mix, int bid, char* smem) {
    float (*qs)[64] = (float (*)[64])smem;
    float (*pbuf)[1024] = (float (*)[1024])(smem + 1024);
    float* sc = (float*)(smem + 1024 + 16384);
    int* sel = (int*)(smem + 1024 + 16384 + 512);
    const int tid = threadIdx.x, lane = tid & 63, w = tid >> 6;
    const int blk = bid;
    const int t = blk & 8191, g = (blk >> 13) & 1, b = blk >> 14;
    const int bg = b * 2 + g;
    const size_t row = (size_t)(b * SEQ + t);
    const int head = g * 4 + w;
    {
        int i = lane & 31;
        const bf16_t* src = proj + row * PLD + C_Q + head * 64;
        float x1 = bf2f(src[i]), x2 = bf2f(src[i + 32]);
        float ss = x1 * x1 + x2 * x2;
#pragma unroll
        for (int o = 16; o > 0; o >>= 1) ss += __shfl_xor(ss, o);
        float r = rsqrtf(ss * (1.f / 64.f) + 1e-6f);
        x1 = x1 * r * qgain[i]; x2 = x2 * r * qgain[i + 32];
        float inv = expf(-9.210340371976184f * (float)(2 * i) / 64.f);
        float ang = (float)t * inv;
        float sn, cs; sincosf(ang, &sn, &cs);
        if (lane < 32) { qs[w][i] = (x1 * cs - x2 * sn) * 0.125f; qs[w][i + 32] = (x2 * cs + x1 * sn) * 0.125f; }
    }
    __syncthreads();
    float q[64];
#pragma unroll
    for (int d = 0; d < 64; d++) q[d] = qs[w][d];
    float o_c = 0.f, o_s = 0.f, o_w = 0.f;
    const int nvis = (t >= 31) ? (((t - 31) >> 4) + 1) : 0;
    {
        float s[8];
        float m = -3e38f;
#pragma unroll
        for (int i = 0; i < 8; i++) {
            int n = lane + 64 * i;
            if (n < nvis) { s[i] = dot64(q, kc + ((size_t)bg * 512 + n) * 64); m = fmaxf(m, s[i]); } else s[i] = -3e38f;
        }
        m = wave_max(m);
        float l = 0.f;
#pragma unroll
        for (int i = 0; i < 8; i++) { int n = lane + 64 * i; s[i] = (n < nvis) ? __expf(s[i] - m) : 0.f; l += s[i]; }
        l = wave_sum(l);
        float il = (nvis > 0) ? 1.f / l : 0.f;
#pragma unroll
        for (int i = 0; i < 8; i++) pbuf[w][lane + 64 * i] = s[i] * il;
        __syncthreads();
        const bf16_t* vp = vc + (size_t)bg * 512 * 64 + lane;
        for (int n = 0; n < nvis; n++) o_c += pbuf[w][n] * bf2f(vp[(size_t)n * 64]);
    }
    if (tid < 128) {
        int j = tid;
        float im = 0.f;
#pragma unroll
        for (int h = 0; h < 4; h++) {
            float a = (j > 0) ? pbuf[h][4 * j - 1] : 0.f;
            im += a + 2.f * (pbuf[h][4 * j] + pbuf[h][4 * j + 1] + pbuf[h][4 * j + 2]) + pbuf[h][4 * j + 3];
        }
        int cur = t >> 6;
        float v;
        if (j > cur) v = -1e30f;
        else if (j == 0 || j == cur || j == cur - 1) v = 1e4f;
        else v = im;
        sc[j] = v;
    }
    __syncthreads();
    if (w == 0) {
        float v0 = sc[lane], v1 = sc[lane + 64];
        for (int it = 0; it < 16; it++) {
            float bv; int bi;
            if (v0 >= v1) { bv = v0; bi = lane; } else { bv = v1; bi = lane + 64; }
#pragma unroll
            for (int o = 32; o > 0; o >>= 1) {
                float ov = __shfl_xor(bv, o); int oi = __shfl_xor(bi, o);
                if (ov > bv || (ov == bv && oi < bi)) { bv = ov; bi = oi; }
            }
            if (lane == 0) sel[it] = (bv > -1e29f) ? bi : -1;
            if (bi == lane) v0 = -3e38f;
            if (bi == lane + 64) v1 = -3e38f;
        }
    }
    __syncthreads();
    {
        float s[16];
        float m = -3e38f;
#pragma unroll
        for (int i = 0; i < 16; i++) {
            int bk = sel[i];
            int pos = bk * 64 + lane;
            if (bk >= 0 && pos <= t) { s[i] = dot64(q, ksn + ((size_t)bg * SEQ + pos) * 64); m = fmaxf(m, s[i]); } else s[i] = -3e38f;
        }
        m = wave_max(m);
        float l = 0.f;
#pragma unroll
        for (int i = 0; i < 16; i++) { s[i] = (s[i] > -1e38f) ? __expf(s[i] - m) : 0.f; l += s[i]; }
        l = wave_sum(l);
        float il = 1.f / l;
#pragma unroll
        for (int i = 0; i < 16; i++) pbuf[w][i * 64 + lane] = s[i] * il;
        __syncthreads();
        for (int i = 0; i < 16; i++) {
            int bk = sel[i];
            if (bk < 0) continue;
            const bf16_t* vp = proj + (size_t)(b * SEQ + bk * 64) * PLD + C_KV + 128 * 3 + 64 * g + lane;
            int kmax = min(64, t - bk * 64 + 1);
            for (int kk = 0; kk < kmax; kk++) o_s += pbuf[w][i * 64 + kk] * bf2f(vp[(size_t)kk * PLD]);
        }
    }
    __syncthreads();
    {
        float s[8];
        float m = -3e38f;
        const int p0 = t - 511;
#pragma unroll
        for (int i = 0; i < 8; i++) {
            int pos = p0 + lane + 64 * i;
            if (pos >= 0) { s[i] = dot64(q, kwn + ((size_t)bg * SEQ + pos) * 64); m = fmaxf(m, s[i]); } else s[i] = -3e38f;
        }
        m = wave_max(m);
        float l = 0.f;
#pragma unroll
        for (int i = 0; i < 8; i++) { s[i] = (s[i] > -1e38f) ? __expf(s[i] - m) : 0.f; l += s[i]; }
        l = wave_sum(l);
        float il = 1.f / l;
#pragma unroll
        for (int i = 0; i < 8; i++) pbuf[w][lane + 64 * i] = s[i] * il;
        __syncthreads();
        int kstart = (p0 < 0) ? -p0 : 0;
        const bf16_t* vp = proj + (size_t)(b * SEQ) * PLD + C_KV + 128 * 5 + 64 * g + lane;
        for (int kk = kstart; kk < 512; kk++) o_w += pbuf[w][kk] * bf2f(vp[(size_t)(p0 + kk) * PLD]);
    }
    const bf16_t* gp = proj + row * PLD + C_GATE + head * 3;
    float g0 = sigmoidf_(bf2f(gp[0])), g1 = sigmoidf_(bf2f(gp[1])), g2 = sigmoidf_(bf2f(gp[2]));
    mix[row * DM + head * 64 + lane] = f2bf(g0 * o_c + g1 * o_s + g2 * o_w);
}

#define GS 132
__device__ __forceinline__ void d_gdn_prep(const bf16_t* __restrict__ proj, const float* __restrict__ conv_w,
                                                  const float* __restrict__ a_log, const float* __restrict__ dt_bias,
                                                  bf16_t* __restrict__ gu, bf16_t* __restrict__ gw, bf16_t* __restrict__ gqd,
                                                  bf16_t* __restrict__ gkd, bf16_t* __restrict__ gin, float* __restrict__ gl, int bid, char* smem) {
    float* sm = (float*)smem;
    float* qs = sm;
    float* ks = qs + 64 * GS;
    float* xs = ks + 64 * GS;
    float* Am = xs + 64 * 256;
    float* gcs = Am + 64 * 64;
    float* bts = gcs + 64;
    const int tid = threadIdx.x;
    const int chunk = bid;
    const int n = chunk & 127, h = (chunk >> 7) & 3, b = chunk >> 9;
    const int t0 = n * 64;
    for (int idx = tid; idx < 3 * 64 * 128; idx += 256) {
        int d = idx & 127, i = (idx >> 7) & 63, m = idx >> 13;
        int ch = m * 512 + h * 128 + d;
        float acc = 0.f;
#pragma unroll
        for (int j = 0; j < 4; j++) {
            int tt = t0 + i - 3 + j;
            if (tt >= 0) acc += bf2f(proj[(size_t)(b * SEQ + tt) * PLD + C_GQKV + ch]) * conv_w[j * 1536 + ch];
        }
        float sv = acc * sigmoidf_(acc);
        if (m == 0) qs[i * GS + d] = sv; else if (m == 1) ks[i * GS + d] = sv; else xs[i * 256 + d] = sv;
    }
    if (tid < 64) {
        size_t r = (size_t)(b * SEQ + t0 + tid) * PLD;
        float a = bf2f(proj[r + C_A + h]), bb = bf2f(proj[r + C_B + h]);
        float xx = a + dt_bias[h];
        float sp = (xx > 20.f) ? xx : log1pf(__expf(xx));
        gcs[tid] = -__expf(a_log[h]) * sp;
        bts[tid] = sigmoidf_(bb);
    }
    __syncthreads();
    {
        int lane = tid & 63, w = tid >> 6;
        for (int i = w * 16; i < w * 16 + 16; i++) {
            float a0 = qs[i * GS + lane], a1 = qs[i * GS + lane + 64];
            float s = wave_sum(a0 * a0 + a1 * a1);
            float r = rsqrtf(s + 1e-6f) * 0.08838834764831845f;
            qs[i * GS + lane] = a0 * r; qs[i * GS + lane + 64] = a1 * r;
            float b0 = ks[i * GS + lane], b1 = ks[i * GS + lane + 64];
            float s2 = wave_sum(b0 * b0 + b1 * b1);
            float r2 = rsqrtf(s2 + 1e-6f);
            ks[i * GS + lane] = b0 * r2; ks[i * GS + lane + 64] = b1 * r2;
        }
        if (tid == 0) {
            float c = 0.f;
            for (int i = 0; i < 64; i++) { c += gcs[i]; gcs[i] = c; }
        }
    }
    __syncthreads();
    {
        int i = tid >> 2, j0 = (tid & 3) * 16;
        float gi = gcs[i], bi = bts[i];
        const size_t cbase = (size_t)chunk * 64 * 64;
        for (int jj = 0; jj < 16; jj++) {
            int j = j0 + jj;
            float kk = 0.f, qk = 0.f;
            if (j <= i) {
                for (int d = 0; d < 128; d += 4) {
                    float4 a = *(const float4*)(ks + i * GS + d);
                    float4 c = *(const float4*)(ks + j * GS + d);
                    float4 e = *(const float4*)(qs + i * GS + d);
                    kk += a.x * c.x + a.y * c.y + a.z * c.z + a.w * c.w;
                    qk += e.x * c.x + e.y * c.y + e.z * c.z + e.w * c.w;
                }
            }
            float dec = (j <= i) ? __expf(gi - gcs[j]) : 0.f;
            Am[i * 64 + j] = (j < i) ? bi * kk * dec : 0.f;
            gin[cbase + i * 64 + j] = f2bf((j <= i) ? qk * dec : 0.f);
        }
    }
    __syncthreads();
    {
        const int c = tid;
        for (int i = 0; i < 64; i++) {
            float rhs;
            if (c < 128) rhs = xs[i * 256 + c] * bts[i];
            else rhs = ks[i * GS + (c - 128)] * bts[i] * __expf(gcs[i]);
            for (int j = 0; j < i; j++) rhs -= Am[i * 64 + j] * xs[j * 256 + c];
            xs[i * 256 + c] = rhs;
        }
        const size_t obase = (size_t)chunk * 64 * 128;
        for (int i = 0; i < 64; i++) {
            if (c < 128) gu[obase + i * 128 + c] = f2bf(xs[i * 256 + c]);
            else gw[obase + i * 128 + (c - 128)] = f2bf(xs[i * 256 + c]);
        }
    }
    {
        const size_t obase = (size_t)chunk * 64 * 128;
        float glast = gcs[63];
        for (int idx = tid; idx < 64 * 128; idx += 256) {
            int i = idx >> 7, d = idx & 127;
            gqd[obase + idx] = f2bf(qs[i * GS + d] * __expf(gcs[i]));
            gkd[obase + idx] = f2bf(ks[i * GS + d] * __expf(glast - gcs[i]));
        }
        if (tid == 0) gl[chunk] = __expf(glast);
    }
}

__device__ __forceinline__ void d_gdn_scan(const bf16_t* __restrict__ gu, const bf16_t* __restrict__ gw, const bf16_t* __restrict__ gqd,
                                                  const bf16_t* __restrict__ gkd, const bf16_t* __restrict__ gin, const float* __restrict__ gl,
                                                  float* __restrict__ og, int bid, char* smem) {
    float* sm = (float*)smem;
    float* ws = sm;
    float* qd = ws + 64 * 129;
    float* kd = qd + 64 * 129;
    float* ins = kd + 64 * 129;
    float* us = ins + 64 * 65;
    float* st = us + 64 * 16;
    float* vn = st + 128 * 16;
    const int tid = threadIdx.x;
    const int bh = bid >> 3, sl = bid & 7;
    const int b = bh >> 2, h = bh & 3;
    for (int i = tid; i < 128 * 16; i += 256) st[i] = 0.f;
    for (int n = 0; n < 128; n++) {
        const int chunk = bh * 128 + n;
        const size_t cb = (size_t)chunk * 64 * 128;
        __syncthreads();
        for (int idx = tid; idx < 64 * 128; idx += 256) {
            int i = idx >> 7, d = idx & 127;
            ws[i * 129 + d] = bf2f(gw[cb + idx]);
            qd[i * 129 + d] = bf2f(gqd[cb + idx]);
            kd[i * 129 + d] = bf2f(gkd[cb + idx]);
        }
        for (int idx = tid; idx < 64 * 64; idx += 256) ins[(idx >> 6) * 65 + (idx & 63)] = bf2f(gin[(size_t)chunk * 4096 + idx]);
        for (int idx = tid; idx < 64 * 16; idx += 256) us[idx] = bf2f(gu[cb + (idx >> 4) * 128 + sl * 16 + (idx & 15)]);
        const float g_last = gl[chunk];
        __syncthreads();
        const int c = tid >> 2, v4 = (tid & 3) * 4;
        float a0 = 0.f, a1 = 0.f, a2 = 0.f, a3 = 0.f, o0 = 0.f, o1 = 0.f, o2 = 0.f, o3 = 0.f;
        for (int k = 0; k < 128; k++) {
            float4 s4 = *(const float4*)(st + k * 16 + v4);
            float wv = ws[c * 129 + k], qv = qd[c * 129 + k];
            a0 += wv * s4.x; a1 += wv * s4.y; a2 += wv * s4.z; a3 += wv * s4.w;
            o0 += qv * s4.x; o1 += qv * s4.y; o2 += qv * s4.z; o3 += qv * s4.w;
        }
        float4 u4 = *(const float4*)(us + c * 16 + v4);
        *(float4*)(vn + c * 16 + v4) = make_float4(u4.x - a0, u4.y - a1, u4.z - a2, u4.w - a3);
        __syncthreads();
        for (int j = 0; j < 64; j++) {
            float4 n4 = *(const float4*)(vn + j * 16 + v4);
            float iv = ins[c * 65 + j];
            o0 += iv * n4.x; o1 += iv * n4.y; o2 += iv * n4.z; o3 += iv * n4.w;
        }
        *(float4*)(og + (size_t)(b * SEQ + n * 64 + c) * 512 + h * 128 + sl * 16 + v4) = make_float4(o0, o1, o2, o3);
        {
            const int k = tid >> 1, v8 = (tid & 1) * 8;
            float4 sA = *(const float4*)(st + k * 16 + v8), sB = *(const float4*)(st + k * 16 + v8 + 4);
            sA.x *= g_last; sA.y *= g_last; sA.z *= g_last; sA.w *= g_last;
            sB.x *= g_last; sB.y *= g_last; sB.z *= g_last; sB.w *= g_last;
            for (int cc = 0; cc < 64; cc++) {
                float kv = kd[cc * 129 + k];
                float4 nA = *(const float4*)(vn + cc * 16 + v8), nB = *(const float4*)(vn + cc * 16 + v8 + 4);
                sA.x += kv * nA.x; sA.y += kv * nA.y; sA.z += kv * nA.z; sA.w += kv * nA.w;
                sB.x += kv * nB.x; sB.y += kv * nB.y; sB.z += kv * nB.z; sB.w += kv * nB.w;
            }
            __syncthreads();
            *(float4*)(st + k * 16 + v8) = sA; *(float4*)(st + k * 16 + v8 + 4) = sB;
        }
    }
}

__device__ __forceinline__ void d_gdn_out(const float* __restrict__ og, const bf16_t* __restrict__ proj, const float* __restrict__ gain, bf16_t* __restrict__ mix, int bid) {
    int id = bid * 4 + (threadIdx.x >> 6);
    int lane = threadIdx.x & 63;
    int t = id >> 2, h = id & 3;
    const float* o = og + (size_t)t * 512 + h * 128;
    float a0 = o[lane], a1 = o[lane + 64];
    float ss = wave_sum(a0 * a0 + a1 * a1);
    float r = rsqrtf(ss * (1.f / 128.f) + 1e-6f);
    const bf16_t* z = proj + (size_t)t * PLD + C_Z + h * 128;
    float z0 = bf2f(z[lane]), z1 = bf2f(z[lane + 64]);
    mix[(size_t)t * DM + 512 + h * 128 + lane] = f2bf(a0 * r * gain[lane] * z0 * sigmoidf_(z0));
    mix[(size_t)t * DM + 512 + h * 128 + lane + 64] = f2bf(a1 * r * gain[lane + 64] * z1 * sigmoidf_(z1));
}

__device__ __forceinline__ void d_peer_route(const bf16_t* __restrict__ qry, const float* __restrict__ subkeys, int* __restrict__ eidx, float* __restrict__ pgate, int bid, char* smem) {
    float (*qsh)[256] = (float (*)[256])smem;
    float (*tv)[2][16] = (float (*)[2][16])(smem + 4096);
    int (*ti)[2][16] = (int (*)[2][16])(smem + 4096 + 512);
    const int lane = threadIdx.x & 63, w = threadIdx.x >> 6;
    const int id = bid * 4 + w;
    const int t = id >> 3, h = id & 7;
    const bf16_t* qp = qry + (size_t)t * 2048 + h * 256;
#pragma unroll
    for (int i = 0; i < 4; i++) qsh[w][lane + 64 * i] = bf2f(qp[lane + 64 * i]);
    __syncthreads();
    for (int half = 0; half < 2; half++) {
        const float* sk0 = subkeys + ((size_t)half * 128 + lane) * 128;
        const float* sk1 = sk0 + 64 * 128;
        float s0 = 0.f, s1 = 0.f;
        for (int d = 0; d < 128; d += 4) {
            float4 a = *(const float4*)(sk0 + d), c = *(const float4*)(sk1 + d);
            float4 qq = *(const float4*)(&qsh[w][half * 128 + d]);
            s0 += a.x * qq.x + a.y * qq.y + a.z * qq.z + a.w * qq.w;
            s1 += c.x * qq.x + c.y * qq.y + c.z * qq.z + c.w * qq.w;
        }
        for (int it = 0; it < 16; it++) {
            float bv; int bi;
            if (s0 >= s1) { bv = s0; bi = lane; } else { bv = s1; bi = lane + 64; }
#pragma unroll
            for (int o = 32; o > 0; o >>= 1) {
                float ov = __shfl_xor(bv, o); int oi = __shfl_xor(bi, o);
                if (ov > bv || (ov == bv && oi < bi)) { bv = ov; bi = oi; }
            }
            if (lane == 0) { tv[w][half][it] = bv; ti[w][half][it] = bi; }
            if (bi == lane) s0 = -3e38f;
            if (bi == lane + 64) s1 = -3e38f;
        }
    }
    __syncthreads();
    float cv[4];
#pragma unroll
    for (int i = 0; i < 4; i++) { int f = lane * 4 + i; cv[i] = tv[w][0][f >> 4] + tv[w][1][f & 15]; }
    float topv = 0.f; int tope = 0;
    float mx = 0.f;
    for (int it = 0; it < 16; it++) {
        float bv = cv[0]; int bi = lane * 4;
#pragma unroll
        for (int i = 1; i < 4; i++) if (cv[i] > bv) { bv = cv[i]; bi = lane * 4 + i; }
#pragma unroll
        for (int o = 32; o > 0; o >>= 1) {
            float ov = __shfl_xor(bv, o); int oi = __shfl_xor(bi, o);
            if (ov > bv || (ov == bv && oi < bi)) { bv = ov; bi = oi; }
        }
        if (it == 0) mx = bv;
        if (lane == it) { topv = bv; tope = ti[w][0][bi >> 4] * 128 + ti[w][1][bi & 15]; }
#pragma unroll
        for (int i = 0; i < 4; i++) if (bi == lane * 4 + i) cv[i] = -3e38f;
    }
    float e = (lane < 16) ? __expf(topv - mx) : 0.f;
    float sum = wave_sum(e);
    if (lane < 16) {
        eidx[(size_t)t * 128 + h * 16 + lane] = tope;
        pgate[(size_t)t * 128 + h * 16 + lane] = e / sum;
    }
}

__device__ __forceinline__ void d_peer_expert(const bf16_t* __restrict__ h2, const int* __restrict__ eidx, const float* __restrict__ pgate,
                                                     const float* __restrict__ utab, const float* __restrict__ vtab, float* __restrict__ out, int bid, char* smem) {
    float (*red)[1024] = (float (*)[1024])smem;
    const int t = bid;
    const int lane = threadIdx.x & 63, w = threadIdx.x >> 6;
    float x[16], acc[16];
#pragma unroll
    for (int i = 0; i < 4; i++) {
        ushort4 u = ((const ushort4*)(h2 + (size_t)t * DM))[lane + 64 * i];
        x[i * 4 + 0] = bf2f(u.x); x[i * 4 + 1] = bf2f(u.y); x[i * 4 + 2] = bf2f(u.z); x[i * 4 + 3] = bf2f(u.w);
    }
#pragma unroll
    for (int i = 0; i < 16; i++) acc[i] = 0.f;
    for (int k = 0; k < 32; k++) {
        int e = eidx[(size_t)t * 128 + w * 32 + k];
        float gt = pgate[(size_t)t * 128 + w * 32 + k];
        const float4* ur = (const float4*)(utab + (size_t)e * DM);
        float d = 0.f;
#pragma unroll
        for (int i = 0; i < 4; i++) {
            float4 u = ur[lane + 64 * i];
            d += u.x * x[i * 4] + u.y * x[i * 4 + 1] + u.z * x[i * 4 + 2] + u.w * x[i * 4 + 3];
        }
        d = wave_sum(d);
        float coef = gt * gelu_tanh(d);
        const float4* vr = (const float4*)(vtab + (size_t)e * DM);
#pragma unroll
        for (int i = 0; i < 4; i++) {
            float4 v = vr[lane + 64 * i];
            acc[i * 4] += coef * v.x; acc[i * 4 + 1] += coef * v.y; acc[i * 4 + 2] += coef * v.z; acc[i * 4 + 3] += coef * v.w;
        }
    }
#pragma unroll
    for (int i = 0; i < 4; i++) *(float4*)(&red[w][(lane + 64 * i) * 4]) = make_float4(acc[i * 4], acc[i * 4 + 1], acc[i * 4 + 2], acc[i * 4 + 3]);
    __syncthreads();
    for (int c = threadIdx.x; c < 1024; c += 256) {
        out[(size_t)t * DM + c] += red[0][c] + red[1][c] + red[2][c] + red[3][c];
    }
}

#define XB_TMO      128
#define XB_XCNT(j)  (256  + 64 * (j))
#define XB_XSUB(j)  (1280 + 64 * (j))
#define XB_XGEN(j)  (2304 + 64 * (j))
#define XB_TOP      3328
#define XB_TOPGEN   3392
#define XB_QUEUE    3456
#define XCD_BAR_WORDS 4096
#define XB_SPIN_CAP (1u << 22)
#define LAS __attribute__((address_space(3)))
__device__ __forceinline__ unsigned xb_ld(unsigned* p)              { return __hip_atomic_load(p, __ATOMIC_RELAXED, __HIP_MEMORY_SCOPE_AGENT); }
__device__ __forceinline__ unsigned xb_add(unsigned* p, unsigned v) { return __hip_atomic_fetch_add(p, v, __ATOMIC_RELAXED, __HIP_MEMORY_SCOPE_AGENT); }
__device__ __forceinline__ unsigned xb_xcc_id() { return (unsigned)__builtin_amdgcn_s_getreg((3 << 11) | 20) & 0xFu; }
#define XB_SPIN(cond, bar) do { unsigned _sp = 0; while (cond) { __builtin_amdgcn_s_sleep(1); \
    if ((++_sp & 255u) == 0u) { if (xb_ld(&(bar)[XB_TMO])) break; if (_sp > XB_SPIN_CAP) { atomicAdd(&(bar)[XB_TMO], 1u); break; } } } } while (0)
struct XcdBarrier { unsigned* bar; unsigned x; volatile LAS unsigned* st; };
__device__ __forceinline__ XcdBarrier xcd_barrier_post(unsigned* bar, volatile LAS unsigned* st) {
    XcdBarrier b; b.bar = bar; b.x = xb_xcc_id(); b.st = st;
    if (threadIdx.x == 0) (void)xb_add(&bar[XB_XCNT(b.x)], 1u);
    return b;
}
__device__ __forceinline__ void xcd_barrier_complete(unsigned* bar, unsigned x, unsigned& nloc, unsigned& nx) {
    const unsigned G = gridDim.x * gridDim.y * gridDim.z;
    unsigned sum, cnt, mine, sp = 0u;
    for (;;) {
        sum = 0u; cnt = 0u; mine = 0u;
#pragma unroll
        for (unsigned j = 0; j < 16; ++j) { const unsigned c = xb_ld(&bar[XB_XCNT(j)]); sum += c; cnt += (c > 0u) ? 1u : 0u; mine = (j == x) ? c : mine; }
        if (sum == G) break;
        __builtin_amdgcn_s_sleep(1);
        if ((++sp & 255u) == 0u) { if (xb_ld(&bar[XB_TMO])) break; if (sp > XB_SPIN_CAP) { atomicAdd(&bar[XB_TMO], 1u); break; } }
    }
    nloc = mine > 0u ? mine : 1u; nx = cnt > 0u ? cnt : 1u;
}
__device__ __forceinline__ void xcd_barrier(const XcdBarrier& b) {
    asm volatile("s_waitcnt vmcnt(0)" ::: "memory");
    __syncthreads();
    if (threadIdx.x == 0) {
        unsigned* bar = b.bar;
        __builtin_amdgcn_s_waitcnt(0);
        unsigned nloc = b.st[0], nx = b.st[1];
        if (nloc == 0u) { xcd_barrier_complete(bar, b.x, nloc, nx); b.st[0] = nloc; b.st[1] = nx; }
        const unsigned old = xb_add(&bar[XB_XSUB(b.x)], 1u);
        const unsigned gen = old / nloc;
        if (old + 1u == (gen + 1u) * nloc) {
            __builtin_amdgcn_fence(__ATOMIC_RELEASE, "agent");
            asm volatile("s_waitcnt vmcnt(0)" ::: "memory");
            const unsigned og = xb_add(&bar[XB_TOP], 1u);
            const unsigned tg = og / nx;
            if (og + 1u == (tg + 1u) * nx) xb_add(&bar[XB_TOPGEN], 1u);
            else XB_SPIN(xb_ld(&bar[XB_TOPGEN]) == tg, bar);
            __builtin_amdgcn_fence(__ATOMIC_ACQUIRE, "agent");
            xb_add(&bar[XB_XGEN(b.x)], 1u);
            asm volatile("s_waitcnt vmcnt(0)" ::: "memory");
        } else {
            XB_SPIN(xb_ld(&bar[XB_XGEN(b.x)]) == gen, bar);
            __builtin_amdgcn_fence(__ATOMIC_ACQUIRE, "agent");
            asm volatile("s_waitcnt vmcnt(0)" ::: "memory");
        }
    }
    __syncthreads();
}

struct MKP {
    const float *x, *attn_norm, *w_in, *q_gain, *k_gain, *cmp_pos, *cmp_w1, *cmp_w2, *gdn_conv, *a_log, *dt_bias, *out_gain, *w_out, *ffn_norm, *w_query, *subkeys, *peer_u, *peer_v;
    float* out; char* ws; unsigned* bar;
};

#define SMEM_BYTES 150016

__global__ __launch_bounds__(256) void hybrid_megakernel(MKP P) {
    extern __shared__ __attribute__((aligned(16))) char smem[];
    __shared__ uint4 xb_words;
    __shared__ int q_item;
    const int G = gridDim.x, bid0 = blockIdx.x;
    if (threadIdx.x == 0) xb_words = make_uint4(0u, 0u, 0u, 0u);
    __syncthreads();
    XcdBarrier B = xcd_barrier_post(P.bar, (volatile LAS unsigned*)&xb_words);
    char* ws = P.ws;
    bf16_t* w_in_t = (bf16_t*)(ws + OFF_WINT);
    bf16_t* w_out_t = (bf16_t*)(ws + OFF_WOUTT);
    bf16_t* w_q_t = (bf16_t*)(ws + OFF_WQT);
    bf16_t* cw1_t = (bf16_t*)(ws + OFF_CW1T);
    float* cbias = (float*)(ws + OFF_CBIAS);
    bf16_t* h_bf = (bf16_t*)(ws + OFF_HBF);
    bf16_t* proj = (bf16_t*)(ws + OFF_PROJ);
    bf16_t* ksn = (bf16_t*)(ws + OFF_KSN);
    bf16_t* kwn = (bf16_t*)(ws + OFF_KWN);
    bf16_t* kc = (bf16_t*)(ws + OFF_KC);
    bf16_t* vc = (bf16_t*)(ws + OFF_VC);
    bf16_t* hid = (bf16_t*)(ws + OFF_HID);
    bf16_t* gu = (bf16_t*)(ws + OFF_GU);
    bf16_t* gw = (bf16_t*)(ws + OFF_GW);
    bf16_t* gqd = (bf16_t*)(ws + OFF_GQD);
    bf16_t* gkd = (bf16_t*)(ws + OFF_GKD);
    bf16_t* gin = (bf16_t*)(ws + OFF_GIN);
    float* gl = (float*)(ws + OFF_GL);
    bf16_t* mix = (bf16_t*)(ws + OFF_MIX);
    bf16_t* qry = (bf16_t*)(ws + OFF_QRY);
    bf16_t* h2 = (bf16_t*)(ws + OFF_H2);
    int* eidx = (int*)(ws + OFF_EIDX);
    float* pgate = (float*)(ws + OFF_PGATE);
    float* og = P.out;

    {
        const int n1 = 108 * 32, n2 = n1 + 32 * 32, n3 = n2 + 64 * 32, n4 = n3 + 2 * 8 * 64;
        for (int it = bid0; it < n4; it += G) {
            if (it < n1) d_transpose_bf16(P.w_in, 1024, IN_COLS, w_in_t, it % 108, it / 108, smem);
            else if (it < n2) { int r = it - n1; d_transpose_bf16(P.w_out, 1024, 1024, w_out_t, r % 32, r / 32, smem); }
            else if (it < n3) { int r = it - n2; d_transpose_bf16(P.w_query, 1024, 2048, w_q_t, r % 64, r / 64, smem); }
            else { int r = it - n3; int j = r >> 9; r &= 511; d_transpose_bf16(P.cmp_w1 + (size_t)j * 2048 * 256, 2048, 256, cw1_t + (size_t)j * 256 * 2048, r % 8, r / 8, smem); }
            __syncthreads();
        }
        for (int it = bid0; it < 2; it += G) d_cmp_bias(P.cmp_pos, P.cmp_w1, cbias, it);
        for (int it = bid0; it < T_TOK / 4; it += G) d_rmsnorm_bf16(P.x, P.attn_norm, h_bf, it);
        for (int i = bid0 * 256 + threadIdx.x; i < 32 * PLD / 2; i += G * 256) ((unsigned*)(proj + (size_t)T_TOK * PLD))[i] = 0u;
    }
    xcd_barrier(B);
    {
        GemmP p{}; p.A = h_bf; p.lda = 1024; p.akts = 64; p.Bt = w_in_t; p.ldb = 1024; p.K = 1024; p.mtiles = 128; p.ntiles = 27; p.out = proj;
        for (int it = bid0; it < 128 * 27; it += G) d_gemm<EPI_PROJ>(p, it, smem);
    }
    xcd_barrier(B);
    {
        for (int it = bid0; it < 64; it += G) {
            int inst = it >> 3, tile = it & 7;
            int j = inst >> 2, b = (inst >> 1) & 1, g = inst & 1;
            GemmP p{}; p.A = proj + (size_t)(b * SEQ) * PLD + C_KV + 128 * j + 64 * g; p.lda = 16 * PLD; p.akts = PLD;
            p.Bt = cw1_t + (size_t)j * 256 * 2048; p.ldb = 2048; p.K = 2048; p.mtiles = 4; p.ntiles = 2;
            p.out = hid + (size_t)inst * 512 * 256; p.aux = cbias + j * 256;
            d_gemm<EPI_HID>(p, tile, smem);
        }
        for (int it = bid0; it < 1024; it += G) { d_gdn_prep(proj, P.gdn_conv, P.a_log, P.dt_bias, gu, gw, gqd, gkd, gin, gl, it, smem); __syncthreads(); }
        for (int it = bid0; it < 8192; it += G) d_knorm_rope(proj, P.k_gain, ksn, kwn, it);
    }
    xcd_barrier(B);
    for (int it = bid0; it < 1024; it += G) d_cmp2(hid, P.cmp_w2, P.k_gain, kc, vc, it);
    xcd_barrier(B);
    {
        if (bid0 < 64) d_gdn_scan(gu, gw, gqd, gkd, gin, gl, og, bid0, smem);
        __syncthreads();
        for (;;) {
            if (threadIdx.x == 0) q_item = (int)xb_add(&P.bar[XB_QUEUE], 1u);
            __syncthreads();
            const int it = q_item;
            if (it >= 2 * 2 * SEQ) break;
            d_nsa_naive(proj, P.q_gain, ksn, kwn, kc, vc, mix, it, smem);
            __syncthreads();
        }
    }
    xcd_barrier(B);
    for (int it = bid0; it < T_TOK; it += G) d_gdn_out(og, proj, P.out_gain, mix, it);
    xcd_barrier(B);
    {
        GemmP p{}; p.A = mix; p.lda = 1024; p.akts = 64; p.Bt = w_out_t; p.ldb = 1024; p.K = 1024; p.mtiles = 128; p.ntiles = 8; p.out = P.out; p.aux = P.x;
        for (int it = bid0; it < 128 * 8; it += G) d_gemm<EPI_OUT>(p, it, smem);
    }
    xcd_barrier(B);
    for (int it = bid0; it < T_TOK / 4; it += G) d_rmsnorm_bf16(P.out, P.ffn_norm, h2, it);
    xcd_barrier(B);
    {
        GemmP p{}; p.A = h2; p.lda = 1024; p.akts = 64; p.Bt = w_q_t; p.ldb = 1024; p.K = 1024; p.mtiles = 128; p.ntiles = 16; p.out = qry;
        for (int it = bid0; it < 128 * 16; it += G) d_gemm<EPI_QRY>(p, it, smem);
    }
    xcd_barrier(B);
    for (int it = bid0; it < T_TOK * 2; it += G) { d_peer_route(qry, P.subkeys, eidx, pgate, it, smem); __syncthreads(); }
    xcd_barrier(B);
    for (int it = bid0; it < T_TOK; it += G) { d_peer_expert(h2, eidx, pgate, P.peer_u, P.peer_v, P.out, it, smem); __syncthreads(); }
}

extern "C" void kernel_launch(void* const* d_in, const int* in_sizes, int n_in, void* d_out, int out_size, void* d_ws, size_t ws_size,
                              hipStream_t stream) {
    const size_t bar_off = (OFF_END + 255) & ~(size_t)255;
    if (ws_size < bar_off + XCD_BAR_WORDS * 4) return;
    static int grid_blocks = 0;
    if (!grid_blocks) {
        int dev = 0, cus = 0, per_cu = 0;
        (void)hipGetDevice(&dev);
        (void)hipDeviceGetAttribute(&cus, hipDeviceAttributeMultiprocessorCount, dev);
        (void)hipFuncSetAttribute((const void*)hybrid_megakernel, hipFuncAttributeMaxDynamicSharedMemorySize, SMEM_BYTES);
        (void)hipOccupancyMaxActiveBlocksPerMultiprocessor(&per_cu, hybrid_megakernel, 256, SMEM_BYTES);
        if (per_cu > 1) per_cu = 1;
        grid_blocks = cus * per_cu;
    }
    if (grid_blocks <= 0) return;
    MKP P{};
    P.x = (const float*)d_in[0]; P.attn_norm = (const float*)d_in[1]; P.w_in = (const float*)d_in[2]; P.q_gain = (const float*)d_in[3];
    P.k_gain = (const float*)d_in[4]; P.cmp_pos = (const float*)d_in[5]; P.cmp_w1 = (const float*)d_in[6]; P.cmp_w2 = (const float*)d_in[7];
    P.gdn_conv = (const float*)d_in[8]; P.a_log = (const float*)d_in[9]; P.dt_bias = (const float*)d_in[10]; P.out_gain = (const float*)d_in[11];
    P.w_out = (const float*)d_in[12]; P.ffn_norm = (const float*)d_in[13]; P.w_query = (const float*)d_in[14]; P.subkeys = (const float*)d_in[15];
    P.peer_u = (const float*)d_in[16]; P.peer_v = (const float*)d_in[17];
    P.out = (float*)d_out; P.ws = (char*)d_ws; P.bar = (unsigned*)((char*)d_ws + bar_off);
    (void)hipMemsetAsync(P.bar, 0, XCD_BAR_WORDS * 4, stream);
    hipLaunchKernelGGL(hybrid_megakernel, dim3(grid_blocks), dim3(256), SMEM_BYTES, stream, P);
}
```

```cpp
#include <hip/hip_runtime.h>
#include <stdint.h>

typedef unsigned short bf16_t;
typedef __attribute__((ext_vector_type(8))) short bf16x8;
typedef __attribute__((ext_vector_type(4))) float f32x4;
#define LAS3 __attribute__((address_space(3)))

#define T_TOK 16384
#define SEQ 8192
#define DM 1024
#define IN_COLS 3360
#define PLD 3456
#define C_Q 0
#define C_KV 512
#define C_GATE 1280
#define C_GQKV 1304
#define C_Z 2840
#define C_A 3352
#define C_B 3356

#define OFF_WINT   0ull
#define OFF_WOUTT  (OFF_WINT  + 3456ull*1024*2)
#define OFF_WQT    (OFF_WOUTT + 1024ull*1024*2)
#define OFF_CW1T   (OFF_WQT   + 2048ull*1024*2)
#define OFF_CBIAS  (OFF_CW1T  + 2ull*256*2048*2)
#define OFF_HBF    (OFF_CBIAS + 4096ull)
#define OFF_PROJ   (OFF_HBF   + 16384ull*1024*2)
#define OFF_KSN    (OFF_PROJ  + (16384ull+32)*PLD*2)
#define OFF_KWN    (OFF_KSN   + 4ull*8192*64*2)
#define OFF_KC     (OFF_KWN   + 4ull*8192*64*2)
#define OFF_VC     (OFF_KC    + 4ull*512*64*2)
#define OFF_HID    (OFF_VC    + 4ull*512*64*2)
#define OFF_GU     (OFF_HID   + 8ull*512*256*2)
#define OFF_GW     (OFF_GU    + 1024ull*64*128*2)
#define OFF_GQD    (OFF_GW    + 1024ull*64*128*2)
#define OFF_GKD    (OFF_GQD   + 1024ull*64*128*2)
#define OFF_GIN    (OFF_GKD   + 1024ull*64*128*2)
#define OFF_GL     (OFF_GIN   + 1024ull*64*64*2)
#define OFF_ROPE   (OFF_GL    + 4096ull)
#define OFF_END    (OFF_ROPE  + 8192ull*32*8)
#define OFF_MIX    OFF_HBF
#define OFF_QRY    OFF_PROJ
#define OFF_H2     (OFF_PROJ + 16384ull*2048*2)
#define OFF_EIDX   OFF_KSN
#define OFF_PGATE  OFF_GIN
#define OFF_UBF    OFF_GU
#define OFF_VBF    OFF_GQD

__device__ __forceinline__ bf16_t f2bf(float f) {
    unsigned u = __float_as_uint(f);
    u += 0x7fffu + ((u >> 16) & 1u);
    return (bf16_t)(u >> 16);
}
__device__ __forceinline__ float bf2f(bf16_t h) { return __uint_as_float(((unsigned)h) << 16); }
__device__ __forceinline__ float gelu_tanh(float x) {
    float u = 0.7978845608028654f * (x + 0.044715f * x * x * x);
    return 0.5f * x * (1.f + tanhf(u));
}
__device__ __forceinline__ float sigmoidf_(float x) { return 1.f / (1.f + __expf(-x)); }
__device__ __forceinline__ float wave_sum(float v) {
#pragma unroll
    for (int o = 32; o > 0; o >>= 1) v += __shfl_xor(v, o);
    return v;
}
__device__ __forceinline__ float wave_max(float v) {
#pragma unroll
    for (int o = 32; o > 0; o >>= 1) v = fmaxf(v, __shfl_xor(v, o));
    return v;
}

__device__ __forceinline__ void d_transpose_bf16(const float* __restrict__ W, int K, int N, bf16_t* __restrict__ Wt, int bx, int by, char* smem) {
    float (*tile)[33] = (float (*)[33])smem;
    int n0 = bx * 32, k0 = by * 32;
    int tx = threadIdx.x & 31, ty = threadIdx.x >> 5;
    for (int i = ty; i < 32; i += 8) {
        int n = n0 + tx;
        tile[i][tx] = (n < N) ? W[(size_t)(k0 + i) * N + n] : 0.f;
    }
    __syncthreads();
    for (int i = ty; i < 32; i += 8) {
        Wt[(size_t)(n0 + i) * K + k0 + tx] = f2bf(tile[tx][i]);
    }
}

__device__ __forceinline__ void d_rmsnorm_bf16(const float* __restrict__ x, const float* __restrict__ g, bf16_t* __restrict__ out, int bid) {
    int row = bid * 4 + (threadIdx.x >> 6);
    int lane = threadIdx.x & 63;
    const float4* xr = (const float4*)(x + (size_t)row * DM);
    float4 v[4];
    float ss = 0.f;
#pragma unroll
    for (int i = 0; i < 4; i++) { v[i] = xr[lane + 64 * i]; ss += v[i].x * v[i].x + v[i].y * v[i].y + v[i].z * v[i].z + v[i].w * v[i].w; }
    ss = wave_sum(ss);
    float r = rsqrtf(ss * (1.f / DM) + 1e-6f);
#pragma unroll
    for (int i = 0; i < 4; i++) {
        float4 gg = ((const float4*)g)[lane + 64 * i];
        ushort4 o;
        o.x = f2bf(v[i].x * r * gg.x); o.y = f2bf(v[i].y * r * gg.y); o.z = f2bf(v[i].z * r * gg.z); o.w = f2bf(v[i].w * r * gg.w);
        ((ushort4*)(out + (size_t)row * DM))[lane + 64 * i] = o;
    }
}

__device__ __forceinline__ void d_cmp_bias(const float* __restrict__ pos, const float* __restrict__ w1, float* __restrict__ bias, int bid) {
    int j = bid, c = threadIdx.x;
    float s = 0.f;
    for (int k = 0; k < 2048; k++) s += pos[j * 2048 + k] * w1[((size_t)j * 2048 + k) * 256 + c];
    bias[j * 256 + c] = s;
}

#define EPI_PROJ 0
#define EPI_HID 1
#define EPI_OUT 2
#define EPI_QRY 3
struct GemmP {
    const bf16_t* A; long lda; long akts;
    const bf16_t* Bt; long ldb;
    int K; int mtiles; int ntiles;
    long a_inst; long b_inst;
    void* out; const float* aux; const float* aux2;
};

template <int EPI>
__device__ __forceinline__ void d_gemm(const GemmP& p, int bid, char* smem) {
    bf16_t* As = (bf16_t*)smem;
    bf16_t* Bs = As + 128 * 72;
    const int tid = threadIdx.x, lane = tid & 63, wave = tid >> 6;
    const int wm = wave >> 1, wn = wave & 1;
    const int inst = 0;
    const int mt = bid / p.ntiles, nt = bid % p.ntiles;
    const int m0 = mt * 128, n0 = nt * 128;
    const bf16_t* A = p.A + (size_t)inst * p.a_inst + (size_t)m0 * p.lda;
    const bf16_t* Bt = p.Bt + (size_t)inst * p.b_inst + (size_t)n0 * p.ldb;
    f32x4 acc[4][4];
#pragma unroll
    for (int i = 0; i < 4; i++)
#pragma unroll
        for (int j = 0; j < 4; j++) acc[i][j] = (f32x4){0.f, 0.f, 0.f, 0.f};
    const int nk = p.K >> 6;
    const int lrow = tid >> 3, lc8 = (tid & 7) * 8;
    const bf16_t* Ap = A + (size_t)lrow * p.lda + lc8;
    const bf16_t* Bp = Bt + (size_t)lrow * p.ldb + lc8;
    const size_t a32 = (size_t)32 * p.lda, b32 = (size_t)32 * p.ldb;
    uint4 ra0, ra1, ra2, ra3, rb0, rb1, rb2, rb3;
#define GLOAD(koffA, koffB) \
    ra0 = *(const uint4*)(Ap + (koffA)); ra1 = *(const uint4*)(Ap + a32 + (koffA)); ra2 = *(const uint4*)(Ap + 2 * a32 + (koffA)); ra3 = *(const uint4*)(Ap + 3 * a32 + (koffA)); \
    rb0 = *(const uint4*)(Bp + (koffB)); rb1 = *(const uint4*)(Bp + b32 + (koffB)); rb2 = *(const uint4*)(Bp + 2 * b32 + (koffB)); rb3 = *(const uint4*)(Bp + 3 * b32 + (koffB));
    GLOAD(0, 0)
    bf16_t* Asw = As + lrow * 72 + lc8;
    bf16_t* Bsw = Bs + lrow * 72 + lc8;
    for (int kt = 0; kt < nk; kt++) {
        *(uint4*)(Asw) = ra0; *(uint4*)(Asw + 32 * 72) = ra1; *(uint4*)(Asw + 64 * 72) = ra2; *(uint4*)(Asw + 96 * 72) = ra3;
        *(uint4*)(Bsw) = rb0; *(uint4*)(Bsw + 32 * 72) = rb1; *(uint4*)(Bsw + 64 * 72) = rb2; *(uint4*)(Bsw + 96 * 72) = rb3;
        __syncthreads();
        if (kt + 1 < nk) {
            GLOAD((size_t)(kt + 1) * p.akts, (size_t)(kt + 1) * 64)
        }
#pragma unroll
        for (int ks = 0; ks < 2; ks++) {
            bf16x8 af[4], bfr[4];
#pragma unroll
            for (int i = 0; i < 4; i++) af[i] = *(const bf16x8*)(As + (wm * 64 + i * 16 + (lane & 15)) * 72 + ks * 32 + (lane >> 4) * 8);
#pragma unroll
            for (int j = 0; j < 4; j++) bfr[j] = *(const bf16x8*)(Bs + (wn * 64 + j * 16 + (lane & 15)) * 72 + ks * 32 + (lane >> 4) * 8);
#pragma unroll
            for (int i = 0; i < 4; i++)
#pragma unroll
                for (int j = 0; j < 4; j++) acc[i][j] = __builtin_amdgcn_mfma_f32_16x16x32_bf16(af[i], bfr[j], acc[i][j], 0, 0, 0);
        }
        __syncthreads();
    }
#pragma unroll
    for (int i = 0; i < 4; i++)
#pragma unroll
        for (int j = 0; j < 4; j++)
#pragma unroll
            for (int r = 0; r < 4; r++) {
                int row = m0 + wm * 64 + i * 16 + (lane >> 4) * 4 + r;
                int col = n0 + wn * 64 + j * 16 + (lane & 15);
                float v = acc[i][j][r];
                if (EPI == EPI_PROJ) {
                    ((bf16_t*)p.out)[(size_t)row * PLD + col] = f2bf(v);
                } else if (EPI == EPI_HID) {
                    float bb = p.aux[(inst >> 2) * 256 + col];
                    ((bf16_t*)p.out)[((size_t)inst * 512 + row) * 256 + col] = f2bf(gelu_tanh(v + bb));
                } else if (EPI == EPI_OUT) {
                    ((float*)p.out)[(size_t)row * DM + col] = p.aux[(size_t)row * DM + col] + v;
                } else if (EPI == EPI_QRY) {
                    ((bf16_t*)p.out)[(size_t)row * 2048 + col] = f2bf(v);
                }
            }
}

__device__ __forceinline__ void d_knorm_rope(const bf16_t* __restrict__ proj, const float* __restrict__ kgain, bf16_t* __restrict__ ksn, bf16_t* __restrict__ kwn, int bid) {
    int vec = bid * 8 + (threadIdx.x >> 5);
    int i = threadIdx.x & 31;
    int which = vec >> 15;
    int rem = vec & 32767;
    int b = rem >> 14, g = (rem >> 13) & 1, s = rem & 8191;
    const bf16_t* src = proj + (size_t)(b * SEQ + s) * PLD + C_KV + 128 * (which ? 4 : 2) + 64 * g;
    float x1 = bf2f(src[i]), x2 = bf2f(src[i + 32]);
    float ss = x1 * x1 + x2 * x2;
#pragma unroll
    for (int o = 16; o > 0; o >>= 1) ss += __shfl_xor(ss, o);
    float r = rsqrtf(ss * (1.f / 64.f) + 1e-6f);
    const float* gn = kgain + (which ? 2 : 1) * 64;
    x1 = x1 * r * gn[i]; x2 = x2 * r * gn[i + 32];
    float inv = expf(-9.210340371976184f * (float)(2 * i) / 64.f);
    float ang = (float)s * inv;
    float sn, cs; sincosf(ang, &sn, &cs);
    bf16_t* dst = (which ? kwn : ksn) + ((size_t)(b * 2 + g) * SEQ + s) * 64;
    dst[i] = f2bf(x1 * cs - x2 * sn);
    dst[i + 32] = f2bf(x2 * cs + x1 * sn);
}

__device__ __forceinline__ void d_cmp2(const bf16_t* __restrict__ hid, const float* __restrict__ w2, const float* __restrict__ kgain, bf16_t* __restrict__ kc, bf16_t* __restrict__ vc, int bid) {
    int rowid = bid * 4 + (threadIdx.x >> 6);
    int lane = threadIdx.x & 63;
    int inst = rowid >> 9, n = rowid & 511;
    int j = inst >> 2, bg = inst & 3;
    if (n >= 511) return;
    const bf16_t* hr = hid + (size_t)rowid * 256;
    const float* w = w2 + (size_t)j * 256 * 64;
    float s = 0.f;
    for (int k = 0; k < 256; k++) s += bf2f(hr[k]) * w[k * 64 + lane];
    if (j == 0) {
        float ss = wave_sum(s * s);
        float r = rsqrtf(ss * (1.f / 64.f) + 1e-6f);
        float y = s * r * kgain[lane];
        float other = __shfl_xor(y, 32);
        int i = lane & 31;
        float inv = expf(-9.210340371976184f * (float)(2 * i) / 64.f);
        float ang = (float)(n * 16 + 31) * inv;
        float sn, cs; sincosf(ang, &sn, &cs);
        float o = (lane < 32) ? (y * cs - other * sn) : (y * cs + other * sn);
        kc[((size_t)bg * 512 + n) * 64 + lane] = f2bf(o);
    } else {
        vc[((size_t)bg * 512 + n) * 64 + lane] = f2bf(s);
    }
}

__device__ __forceinline__ float dot64(const float* q, const bf16_t* krow) {
    const uint4* kp = (const uint4*)krow;
    float s = 0.f;
#pragma unroll
    for (int c = 0; c < 8; c++) {
        uint4 u = kp[c];
        unsigned w[4] = {u.x, u.y, u.z, u.w};
#pragma unroll
        for (int e = 0; e < 4; e++) {
            s += q[c * 8 + e * 2] * __uint_as_float(w[e] << 16);
            s += q[c * 8 + e * 2 + 1] * __uint_as_float(w[e] & 0xffff0000u);
        }
    }
    return s;
}

__device__ __forceinline__ void d_nsa_naive(const bf16_t* __restrict__ proj, const float* __restrict__ qgain,
                                                   const bf16_t* __restrict__ ksn, const bf16_t* __restrict__ kwn,
                                                   const bf16_t* __restrict__ kc, const bf16_t* __restrict__ vc,
                                                   bf16_t* __restrict__ mix, int mix_ld, int bid, char* smem) {
    float (*qs)[64] = (float (*)[64])smem;
    float (*pbuf)[1024] = (float (*)[1024])(smem + 1024);
    float* sc = (float*)(smem + 1024 + 16384);
    int* sel = (int*)(smem + 1024 + 16384 + 512);
    const int tid = threadIdx.x, lane = tid & 63, w = tid >> 6;
    const int blk = bid;
    const int t = blk & 8191, g = (blk >> 13) & 1, b = blk >> 14;
    const int bg = b * 2 + g;
    const size_t row = (size_t)(b * SEQ + t);
    const int head = g * 4 + w;
    {
        int i = lane & 31;
        const bf16_t* src = proj + row * PLD + C_Q + head * 64;
        float x1 = bf2f(src[i]), x2 = bf2f(src[i + 32]);
        float ss = x1 * x1 + x2 * x2;
#pragma unroll
        for (int o = 16; o > 0; o >>= 1) ss += __shfl_xor(ss, o);
        float r = rsqrtf(ss * (1.f / 64.f) + 1e-6f);
        x1 = x1 * r * qgain[i]; x2 = x2 * r * qgain[i + 32];
        float inv = expf(-9.210340371976184f * (float)(2 * i) / 64.f);
        float ang = (float)t * inv;
        float sn, cs; sincosf(ang, &sn, &cs);
        if (lane < 32) { qs[w][i] = (x1 * cs - x2 * sn) * 0.125f; qs[w][i + 32] = (x2 * cs + x1 * sn) * 0.125f; }
    }
    __syncthreads();
    float q[64];
#pragma unroll
    for (int d = 0; d < 64; d++) q[d] = qs[w][d];
    float o_c = 0.f, o_s = 0.f, o_w = 0.f;
    const int nvis = (t >= 31) ? (((t - 31) >> 4) + 1) : 0;
    {
        float s[8];
        float m = -3e38f;
#pragma unroll
        for (int i = 0; i < 8; i++) {
            int n = lane + 64 * i;
            if (n < nvis) { s[i] = dot64(q, kc + ((size_t)bg * 512 + n) * 64); m = fmaxf(m, s[i]); } else s[i] = -3e38f;
        }
        m = wave_max(m);
        float l = 0.f;
#pragma unroll
        for (int i = 0; i < 8; i++) { int n = lane + 64 * i; s[i] = (n < nvis) ? __expf(s[i] - m) : 0.f; l += s[i]; }
        l = wave_sum(l);
        float il = (nvis > 0) ? 1.f / l : 0.f;
#pragma unroll
        for (int i = 0; i < 8; i++) pbuf[w][lane + 64 * i] = s[i] * il;
        __syncthreads();
        const bf16_t* vp = vc + (size_t)bg * 512 * 64 + lane;
        for (int n = 0; n < nvis; n++) o_c += pbuf[w][n] * bf2f(vp[(size_t)n * 64]);
    }
    if (tid < 128) {
        int j = tid;
        float im = 0.f;
#pragma unroll
        for (int h = 0; h < 4; h++) {
            float a = (j > 0) ? pbuf[h][4 * j - 1] : 0.f;
            im += a + 2.f * (pbuf[h][4 * j] + pbuf[h][4 * j + 1] + pbuf[h][4 * j + 2]) + pbuf[h][4 * j + 3];
        }
        int cur = t >> 6;
        float v;
        if (j > cur) v = -1e30f;
        else if (j == 0 || j == cur || j == cur - 1) v = 1e4f;
        else v = im;
        sc[j] = v;
    }
    __syncthreads();
    if (w == 0) {
        float v0 = sc[lane], v1 = sc[lane + 64];
        for (int it = 0; it < 16; it++) {
            float bv; int bi;
            if (v0 >= v1) { bv = v0; bi = lane; } else { bv = v1; bi = lane + 64; }
#pragma unroll
            for (int o = 32; o > 0; o >>= 1) {
                float ov = __shfl_xor(bv, o); int oi = __shfl_xor(bi, o);
                if (ov > bv || (ov == bv && oi < bi)) { bv = ov; bi = oi; }
            }
            if (lane == 0) sel[it] = (bv > -1e29f) ? bi : -1;
            if (bi == lane) v0 = -3e38f;
            if (bi == lane + 64) v1 = -3e38f;
        }
    }
    __syncthreads();
    {
        float s[16];
        float m = -3e38f;
#pragma unroll
        for (int i = 0; i < 16; i++) {
            int bk = sel[i];
            int pos = bk * 64 + lane;
            if (bk >= 0 && pos <= t) { s[i] = dot64(q, ksn + ((size_t)bg * SEQ + pos) * 64); m = fmaxf(m, s[i]); } else s[i] = -3e38f;
        }
        m = wave_max(m);
        float l = 0.f;
#pragma unroll
        for (int i = 0; i < 16; i++) { s[i] = (s[i] > -1e38f) ? __expf(s[i] - m) : 0.f; l += s[i]; }
        l = wave_sum(l);
        float il = 1.f / l;
#pragma unroll
        for (int i = 0; i < 16; i++) pbuf[w][i * 64 + lane] = s[i] * il;
        __syncthreads();
        for (int i = 0; i < 16; i++) {
            int bk = sel[i];
            if (bk < 0) continue;
            const bf16_t* vp = proj + (size_t)(b * SEQ + bk * 64) * PLD + C_KV + 128 * 3 + 64 * g + lane;
            int kmax = min(64, t - bk * 64 + 1);
            for (int kk = 0; kk < kmax; kk++) o_s += pbuf[w][i * 64 + kk] * bf2f(vp[(size_t)kk * PLD]);
        }
    }
    __syncthreads();
    {
        float s[8];
        float m = -3e38f;
        const int p0 = t - 511;
#pragma unroll
        for (int i = 0; i < 8; i++) {
            int pos = p0 + lane + 64 * i;
            if (pos >= 0) { s[i] = dot64(q, kwn + ((size_t)bg * SEQ + pos) * 64); m = fmaxf(m, s[i]); } else s[i] = -3e38f;
        }
        m = wave_max(m);
        float l = 0.f;
#pragma unroll
        for (int i = 0; i < 8; i++) { s[i] = (s[i] > -1e38f) ? __expf(s[i] - m) : 0.f; l += s[i]; }
        l = wave_sum(l);
        float il = 1.f / l;
#pragma unroll
        for (int i = 0; i < 8; i++) pbuf[w][lane + 64 * i] = s[i] * il;
        __syncthreads();
        int kstart = (p0 < 0) ? -p0 : 0;
        const bf16_t* vp = proj + (size_t)(b * SEQ) * PLD + C_KV + 128 * 5 + 64 * g + lane;
        for (int kk = kstart; kk < 512; kk++) o_w += pbuf[w][kk] * bf2f(vp[(size_t)(p0 + kk) * PLD]);
    }
    const bf16_t* gp = proj + row * PLD + C_GATE + head * 3;
    float g0 = sigmoidf_(bf2f(gp[0])), g1 = sigmoidf_(bf2f(gp[1])), g2 = sigmoidf_(bf2f(gp[2]));
    mix[row * mix_ld + head * 64 + lane] = f2bf(g0 * o_c + g1 * o_s + g2 * o_w);
}

typedef float f32x16 __attribute__((ext_vector_type(16)));
typedef short s16x4 __attribute__((ext_vector_type(4)));
typedef __bf16 bf16x2_t2 __attribute__((ext_vector_type(2)));
#define MFMA32(a, b, c) __builtin_amdgcn_mfma_f32_32x32x16_bf16((a), (b), (c), 0, 0, 0)
#define NKS 72
#define NSA_K_OFF 0
#define NSA_V_OFF (2 * 64 * NKS * 2)
#define NSA_IMP_OFF (NSA_V_OFF + 2 * 64 * NKS * 2)
#define NSA_SEL_OFF (NSA_IMP_OFF + 32 * 128 * 4)
#define NSA_LDS (NSA_SEL_OFF + 32 * 4 * 4)
#define NEGBIG (-1e30f)
__device__ __forceinline__ unsigned pk2(float a, float b) { bf16x2_t2 v; v[0] = (__bf16)a; v[1] = (__bf16)b; return __builtin_bit_cast(unsigned, v); }
__device__ __forceinline__ bf16x8 pack8(float a0, float a1, float a2, float a3, float a4, float a5, float a6, float a7) {
    uint4 u = make_uint4(pk2(a0, a1), pk2(a2, a3), pk2(a4, a5), pk2(a6, a7));
    return __builtin_bit_cast(bf16x8, u);
}
typedef unsigned u32x4 __attribute__((ext_vector_type(4)));
struct NsaStage { u32x4 k0, k1, v0, v1; };
struct NsaCtx {
    const bf16_t* Kbase; long kstride;
    const bf16_t* Vbase; long vstride;
    bf16_t* Kb; bf16_t* Vb;
    float* imp_s; unsigned* sel_s;
    bf16x8 qf[4];
    f32x16 O0, O1;
    float m, l, invl, carry;
    int t, tokl, hp, hh, c, lane;
};
__device__ __forceinline__ void nsa_stage_load(const NsaCtx& X, NsaStage& st, int j) {
    const int r0 = threadIdx.x >> 3, c8 = (threadIdx.x & 7) * 8;
    const bf16_t* kp = X.Kbase + (size_t)(64 * j + r0) * X.kstride + c8;
    const bf16_t* vp = X.Vbase + (size_t)(64 * j + r0) * X.vstride + c8;
    st.k0 = *(const u32x4*)kp; st.k1 = *(const u32x4*)(kp + 32 * X.kstride);
    st.v0 = *(const u32x4*)vp; st.v1 = *(const u32x4*)(vp + 32 * X.vstride);
}
__device__ __forceinline__ void nsa_stage_store(const NsaCtx& X, const NsaStage& st, int buf) {
    const int r0 = threadIdx.x >> 3, c8 = (threadIdx.x & 7) * 8;
    bf16_t* kb = X.Kb + buf * 64 * NKS + r0 * NKS + c8;
    bf16_t* vb = X.Vb + buf * 64 * NKS + r0 * NKS + c8;
    *(u32x4*)kb = st.k0; *(u32x4*)(kb + 32 * NKS) = st.k1;
    *(u32x4*)vb = st.v0; *(u32x4*)(vb + 32 * NKS) = st.v1;
}
template <int MODE>
__device__ __forceinline__ void nsa_tile(NsaCtx& X, int j, int kt, int buf, unsigned long long mlo, unsigned long long mhi) {
    const bf16_t* Kt = X.Kb + buf * 64 * NKS + (32 * kt) * NKS;
    const bf16_t* Vt = X.Vb + buf * 64 * NKS + (32 * kt) * NKS;
    f32x16 S;
#pragma unroll
    for (int i = 0; i < 16; i++) S[i] = 0.f;
#pragma unroll
    for (int s = 0; s < 4; s++) {
        bf16x8 ka = *(const bf16x8*)(Kt + X.c * NKS + 16 * s + 8 * X.hh);
        S = MFMA32(ka, X.qf[s], S);
    }
    const int kbase = 64 * j + 32 * kt;
    int lo = 0, hi;
    bool on = true;
    if (MODE <= 1) hi = ((X.t - 31) >> 4) - kbase;
    else hi = X.t - kbase;
    if (MODE == 3) lo = X.t - 511 - kbase;
    if (MODE == 2) {
        const unsigned long long wsel = (j < 64) ? mlo : mhi;
        on = (wsel >> (j & 63)) & 1ull;
    }
    lo -= 4 * X.hh; hi -= 4 * X.hh;
    if (!on) hi = -1000;
    float P[16];
    if (MODE == 1) {
#pragma unroll
        for (int i = 0; i < 16; i++) {
            const int cr = (i & 3) + 8 * (i >> 2);
            P[i] = (cr <= hi) ? __builtin_amdgcn_exp2f(S[i] - X.m) * X.invl : 0.f;
        }
        float mainv[4], nxt[4];
#pragma unroll
        for (int q = 0; q < 4; q++) { mainv[q] = 2.f * (P[4 * q] + P[4 * q + 1] + P[4 * q + 2]) + P[4 * q + 3]; nxt[q] = P[4 * q + 3]; }
#pragma unroll
        for (int q = 0; q < 4; q++) {
            mainv[q] += __shfl_xor(mainv[q], 1); mainv[q] += __shfl_xor(mainv[q], 2);
            nxt[q] += __shfl_xor(nxt[q], 1); nxt[q] += __shfl_xor(nxt[q], 2);
        }
        float recv[4];
#pragma unroll
        for (int q = 0; q < 4; q++) recv[q] = __shfl_xor(nxt[q], 32);
        const int jsel0 = 16 * j + 8 * kt + X.hh;
#pragma unroll
        for (int q = 0; q < 4; q++) {
            const float tot = mainv[q] + (X.hh ? recv[q] : (q > 0 ? recv[q > 0 ? q - 1 : 0] : X.carry));
            if (X.hp == 0) X.imp_s[X.tokl * 128 + jsel0 + 2 * q] = tot;
        }
        X.carry = recv[3];
    } else {
        float tmax = NEGBIG;
#pragma unroll
        for (int i = 0; i < 16; i++) {
            const int cr = (i & 3) + 8 * (i >> 2);
            const bool vis = (cr <= hi) && (cr >= lo);
            tmax = vis ? fmaxf(tmax, S[i]) : tmax;
        }
        tmax = fmaxf(tmax, __shfl_xor(tmax, 32));
        const float mnew = fmaxf(X.m, tmax);
        const float alpha = __builtin_amdgcn_exp2f(X.m - mnew);
        X.m = mnew;
        float ls = 0.f;
#pragma unroll
        for (int i = 0; i < 16; i++) {
            const int cr = (i & 3) + 8 * (i >> 2);
            const bool vis = (cr <= hi) && (cr >= lo);
            P[i] = vis ? __builtin_amdgcn_exp2f(S[i] - mnew) : 0.f;
            ls += P[i];
        }
        X.l = X.l * alpha + ls;
        if (MODE >= 2) {
#pragma unroll
            for (int i = 0; i < 16; i++) { X.O0[i] *= alpha; X.O1[i] *= alpha; }
        }
    }
    if (MODE >= 1) {
        bf16x8 pb0 = pack8(P[0], P[1], P[2], P[3], P[4], P[5], P[6], P[7]);
        bf16x8 pb1 = pack8(P[8], P[9], P[10], P[11], P[12], P[13], P[14], P[15]);
        const int l15 = X.lane & 15;
        const bf16_t* vrow = Vt + (4 * X.hh + (l15 >> 2)) * NKS + 16 * ((X.lane >> 4) & 1) + 4 * (l15 & 3);
#pragma unroll
        for (int s2 = 0; s2 < 2; s2++) {
#pragma unroll
            for (int dt = 0; dt < 2; dt++) {
                s16x4 lo4 = __builtin_amdgcn_ds_read_tr16_b64_v4i16((LAS3 s16x4*)(vrow + (16 * s2) * NKS + 32 * dt));
                s16x4 hi4 = __builtin_amdgcn_ds_read_tr16_b64_v4i16((LAS3 s16x4*)(vrow + (16 * s2 + 8) * NKS + 32 * dt));
                bf16x8 va = __builtin_shufflevector(lo4, hi4, 0, 1, 2, 3, 4, 5, 6, 7);
                if (dt == 0) X.O0 = MFMA32(va, s2 ? pb1 : pb0, X.O0); else X.O1 = MFMA32(va, s2 ? pb1 : pb0, X.O1);
            }
        }
    }
}
template <int MODE>
__device__ __forceinline__ void nsa_branch(NsaCtx& X, int jlo, int jhi, unsigned long long mlo, unsigned long long mhi, unsigned long long ulo, unsigned long long uhi) {
    NsaStage st;
    nsa_stage_load(X, st, jlo);
    __syncthreads();
    nsa_stage_store(X, st, jlo & 1);
    __syncthreads();
#pragma unroll 1
    for (int j = jlo; j <= jhi; j++) {
        if (j < jhi) nsa_stage_load(X, st, j + 1);
        bool need = true;
        if (MODE == 2) {
            const unsigned long long wsel = (j < 64) ? ulo : uhi;
            need = (wsel >> (j & 63)) & 1ull;
        }
        if (need) {
#pragma unroll 1
            for (int kt = 0; kt < 2; kt++) nsa_tile<MODE>(X, j, kt, j & 1, mlo, mhi);
        }
        if (j < jhi) nsa_stage_store(X, st, (j + 1) & 1);
        __syncthreads();
    }
}
__device__ __forceinline__ void nsa_accum(f32x16& f0, f32x16& f1, const NsaCtx& X, float scale) {
#pragma unroll
    for (int i = 0; i < 16; i++) { f0[i] += X.O0[i] * scale; f1[i] += X.O1[i] * scale; }
}
__device__ __forceinline__ void d_nsa_mfma(const bf16_t* __restrict__ proj, const float* __restrict__ qgain, const float2* __restrict__ rope,
                                           const bf16_t* __restrict__ ksn, const bf16_t* __restrict__ kwn,
                                           const bf16_t* __restrict__ kc, const bf16_t* __restrict__ vc,
                                           bf16_t* __restrict__ mixo, int mix_ld, int item, char* smem) {
    NsaCtx X;
    const int tid = threadIdx.x, lane = tid & 63, w = tid >> 6;
    const int bg = item & 3, tile = 255 - (item >> 2);
    const int b = bg >> 1, g = bg & 1, t0 = tile * 32;
    X.lane = lane; X.c = lane & 31; X.hh = lane >> 5; X.hp = X.c & 3; X.tokl = 8 * w + (X.c >> 2); X.t = t0 + X.tokl;
    X.Kb = (bf16_t*)(smem + NSA_K_OFF); X.Vb = (bf16_t*)(smem + NSA_V_OFF);
    X.imp_s = (float*)(smem + NSA_IMP_OFF); X.sel_s = (unsigned*)(smem + NSA_SEL_OFF);
    const int head = g * 4 + X.hp;
    const size_t row = (size_t)(b * SEQ + X.t);
    {
        float y[4][8];
        const bf16_t* qsrc = proj + row * PLD + C_Q + head * 64 + 8 * X.hh;
        float ss = 0.f;
#pragma unroll
        for (int s = 0; s < 4; s++) {
            const uint4 u = *(const uint4*)(qsrc + 16 * s);
            const unsigned wv[4] = {u.x, u.y, u.z, u.w};
#pragma unroll
            for (int e = 0; e < 4; e++) { y[s][2 * e] = __uint_as_float(wv[e] << 16); y[s][2 * e + 1] = __uint_as_float(wv[e] & 0xffff0000u); }
#pragma unroll
            for (int e = 0; e < 8; e++) ss += y[s][e] * y[s][e];
        }
        ss += __shfl_xor(ss, 32);
        const float r = rsqrtf(ss * (1.f / 64.f) + 1e-6f);
#pragma unroll
        for (int s = 0; s < 4; s++)
#pragma unroll
            for (int e = 0; e < 8; e++) y[s][e] *= r * qgain[16 * s + 8 * X.hh + e];
        const float qs = 0.125f * 1.4426950408889634f;
#pragma unroll
        for (int s = 0; s < 2; s++)
#pragma unroll
            for (int e = 0; e < 8; e++) {
                const float2 cs = rope[(size_t)X.t * 32 + 16 * s + 8 * X.hh + e];
                const float x1 = y[s][e], x2 = y[s + 2][e];
                y[s][e] = (x1 * cs.x - x2 * cs.y) * qs; y[s + 2][e] = (x2 * cs.x + x1 * cs.y) * qs;
            }
#pragma unroll
        for (int s = 0; s < 4; s++) X.qf[s] = pack8(y[s][0], y[s][1], y[s][2], y[s][3], y[s][4], y[s][5], y[s][6], y[s][7]);
    }
    const bf16_t* gp = proj + row * PLD + C_GATE + head * 3;
    const float g0 = sigmoidf_(bf2f(gp[0])), g1 = sigmoidf_(bf2f(gp[1])), g2 = sigmoidf_(bf2f(gp[2]));
    f32x16 F0, F1;
#pragma unroll
    for (int i = 0; i < 16; i++) { F0[i] = 0.f; F1[i] = 0.f; }
    const int cur = t0 >> 6;
    {
        X.Kbase = kc + (size_t)bg * 512 * 64; X.kstride = 64; X.Vbase = vc + (size_t)bg * 512 * 64; X.vstride = 64;
        const int nvmax = (t0 >> 4) + 1, jhi = (nvmax - 1) >> 6;
        X.m = NEGBIG; X.l = 0.f;
        nsa_branch<0>(X, 0, jhi, 0ull, 0ull, 0ull, 0ull);
        const float lt = X.l + __shfl_xor(X.l, 32);
        X.invl = (lt > 0.f) ? 1.f / lt : 0.f;
        X.carry = 0.f;
#pragma unroll
        for (int i = 0; i < 16; i++) { X.O0[i] = 0.f; X.O1[i] = 0.f; }
        nsa_branch<1>(X, 0, jhi, 0ull, 0ull, 0ull, 0ull);
        nsa_accum(F0, F1, X, g0);
    }
    unsigned long long mlo, mhi, ulo, uhi;
    {
        const int tk2 = lane >> 3, sub = lane & 7;
        unsigned k0 = 1u, k1 = 0u, k2 = 0u, k3 = 0u;
#define SETBIT(jj) { const int _j = (jj); if (_j < 32) k0 |= 1u << _j; else if (_j < 64) k1 |= 1u << (_j - 32); else if (_j < 96) k2 |= 1u << (_j - 64); else k3 |= 1u << (_j - 96); }
        SETBIT(cur);
        if (cur >= 1) SETBIT(cur - 1);
        const int ncand = cur - 2;
        if (ncand > 0) {
            if (ncand <= 13) {
                for (int jj = 1; jj <= cur - 2; jj++) SETBIT(jj);
            } else {
                float sc[16];
#pragma unroll
                for (int i = 0; i < 16; i++) { const int jj = sub + 8 * i; sc[i] = (jj >= 1 && jj <= cur - 2) ? X.imp_s[(8 * w + tk2) * 128 + jj] : -3e38f; }
#pragma unroll 1
                for (int it = 0; it < 13; it++) {
                    float bv = sc[0]; int bi = 0;
#pragma unroll
                    for (int i = 1; i < 16; i++) if (sc[i] > bv) { bv = sc[i]; bi = i; }
                    int bj = sub + 8 * bi;
#pragma unroll
                    for (int o = 1; o < 8; o <<= 1) {
                        const float ov = __shfl_xor(bv, o); const int oj = __shfl_xor(bj, o);
                        if (ov > bv || (ov == bv && oj < bj)) { bv = ov; bj = oj; }
                    }
                    SETBIT(bj);
#pragma unroll
                    for (int i = 0; i < 16; i++) if (bj == sub + 8 * i) sc[i] = -3e38f;
                }
            }
        }
#undef SETBIT
        if (sub == 0) { unsigned* d = X.sel_s + (8 * w + tk2) * 4; d[0] = k0; d[1] = k1; d[2] = k2; d[3] = k3; }
        __builtin_amdgcn_s_waitcnt(0xc07f);
        const unsigned* sp = X.sel_s + X.tokl * 4;
        const unsigned m0 = sp[0], m1 = sp[1], m2 = sp[2], m3 = sp[3];
        mlo = (unsigned long long)m0 | ((unsigned long long)m1 << 32); mhi = (unsigned long long)m2 | ((unsigned long long)m3 << 32);
        unsigned u0 = m0, u1 = m1, u2 = m2, u3 = m3;
#pragma unroll
        for (int o = 4; o < 32; o <<= 1) { u0 |= __shfl_xor(u0, o); u1 |= __shfl_xor(u1, o); u2 |= __shfl_xor(u2, o); u3 |= __shfl_xor(u3, o); }
        ulo = (unsigned long long)(unsigned)__builtin_amdgcn_readfirstlane(u0) | ((unsigned long long)(unsigned)__builtin_amdgcn_readfirstlane(u1) << 32);
        uhi = (unsigned long long)(unsigned)__builtin_amdgcn_readfirstlane(u2) | ((unsigned long long)(unsigned)__builtin_amdgcn_readfirstlane(u3) << 32);
    }
    {
        X.Kbase = ksn + (size_t)bg * SEQ * 64; X.kstride = 64;
        X.Vbase = proj + (size_t)(b * SEQ) * PLD + C_KV + 128 * 3 + 64 * g; X.vstride = PLD;
        X.m = NEGBIG; X.l = 0.f;
#pragma unroll
        for (int i = 0; i < 16; i++) { X.O0[i] = 0.f; X.O1[i] = 0.f; }
        nsa_branch<2>(X, 0, cur, mlo, mhi, ulo, uhi);
        const float lt = X.l + __shfl_xor(X.l, 32);
        nsa_accum(F0, F1, X, (lt > 0.f) ? g1 / lt : 0.f);
    }
    {
        X.Kbase = kwn + (size_t)bg * SEQ * 64; X.kstride = 64;
        X.Vbase = proj + (size_t)(b * SEQ) * PLD + C_KV + 128 * 5 + 64 * g; X.vstride = PLD;
        X.m = NEGBIG; X.l = 0.f;
#pragma unroll
        for (int i = 0; i < 16; i++) { X.O0[i] = 0.f; X.O1[i] = 0.f; }
        const int jlo = (t0 >= 511) ? ((t0 - 511) >> 6) : 0;
        nsa_branch<3>(X, jlo, cur, 0ull, 0ull, 0ull, 0ull);
        const float lt = X.l + __shfl_xor(X.l, 32);
        nsa_accum(F0, F1, X, (lt > 0.f) ? g2 / lt : 0.f);
    }
    bf16_t* dst = mixo + row * mix_ld + head * 64 + 4 * X.hh;
#pragma unroll
    for (int q4 = 0; q4 < 4; q4++) {
        *(uint2*)(dst + 8 * q4) = make_uint2(pk2(F0[4 * q4], F0[4 * q4 + 1]), pk2(F0[4 * q4 + 2], F0[4 * q4 + 3]));
        *(uint2*)(dst + 32 + 8 * q4) = make_uint2(pk2(F1[4 * q4], F1[4 * q4 + 1]), pk2(F1[4 * q4 + 2], F1[4 * q4 + 3]));
    }
}

#define KLS 136
#define XSS 264
#define GDN_PREP_LDS (2 * 64 * KLS * 2 + 64 * XSS * 2 + 512)
__device__ __forceinline__ unsigned pack2bf(float lo, float hi) { return (unsigned)f2bf(lo) | ((unsigned)f2bf(hi) << 16); }
__device__ __forceinline__ void d_gdn_prep2(const bf16_t* __restrict__ proj, const float* __restrict__ conv_w,
                                            const float* __restrict__ a_log, const float* __restrict__ dt_bias,
                                            bf16_t* __restrict__ guT, bf16_t* __restrict__ gw, bf16_t* __restrict__ gqd,
                                            bf16_t* __restrict__ gkdT, bf16_t* __restrict__ gin, float* __restrict__ gl, int chunk, char* smem) {
    bf16_t* kL = (bf16_t*)smem;
    bf16_t* qL = kL + 64 * KLS;
    float* AmT = (float*)qL;
    bf16_t* xs = qL + 64 * KLS;
    float* gcs = (float*)(xs + 64 * XSS);
    float* bts = gcs + 64;
    const int tid = threadIdx.x, lane = tid & 63, w = tid >> 6;
    const int n = chunk & 127, h = (chunk >> 7) & 3, b = chunk >> 9;
    const int t0 = n * 64;
    const size_t rbase = (size_t)(b * SEQ + t0);
    if (tid < 64) {
        const size_t r = (rbase + tid) * PLD;
        float a = bf2f(proj[r + C_A + h]), bb = bf2f(proj[r + C_B + h]);
        float xx = a + dt_bias[h];
        float sp = (xx > 20.f) ? xx : log1pf(__expf(xx));
        float c = -__expf(a_log[h]) * sp;
#pragma unroll
        for (int o = 1; o < 64; o <<= 1) { float nb = __shfl_up(c, o); if (lane >= o) c += nb; }
        gcs[tid] = c; bts[tid] = sigmoidf_(bb);
    }
    __syncthreads();
    {
        float wt[6][4], x0[6], x1[6], x2[6];
        int ch[6];
#pragma unroll
        for (int c6 = 0; c6 < 6; c6++) {
            ch[c6] = (c6 >> 1) * 512 + h * 128 + lane + 64 * (c6 & 1);
#pragma unroll
            for (int j = 0; j < 4; j++) wt[c6][j] = conv_w[j * 1536 + ch[c6]];
            const int tb = t0 + 16 * w - 3;
            x0[c6] = (tb >= 0) ? bf2f(proj[((size_t)(b * SEQ + tb)) * PLD + C_GQKV + ch[c6]]) : 0.f;
            x1[c6] = (tb + 1 >= 0) ? bf2f(proj[((size_t)(b * SEQ + tb + 1)) * PLD + C_GQKV + ch[c6]]) : 0.f;
            x2[c6] = (tb + 2 >= 0) ? bf2f(proj[((size_t)(b * SEQ + tb + 2)) * PLD + C_GQKV + ch[c6]]) : 0.f;
        }
        for (int i = 16 * w; i < 16 * w + 16; i++) {
            float sv[6];
#pragma unroll
            for (int c6 = 0; c6 < 6; c6++) {
                float xn = bf2f(proj[(rbase + i) * PLD + C_GQKV + ch[c6]]);
                float cv = x0[c6] * wt[c6][0] + x1[c6] * wt[c6][1] + x2[c6] * wt[c6][2] + xn * wt[c6][3];
                x0[c6] = x1[c6]; x1[c6] = x2[c6]; x2[c6] = xn;
                sv[c6] = cv * sigmoidf_(cv);
            }
            float rq = rsqrtf(wave_sum(sv[0] * sv[0] + sv[1] * sv[1]) + 1e-6f) * 0.08838834764831845f;
            float rk = rsqrtf(wave_sum(sv[2] * sv[2] + sv[3] * sv[3]) + 1e-6f);
            const float bi = bts[i], ei = __expf(gcs[i]);
            float q0 = sv[0] * rq, q1 = sv[1] * rq, k0 = sv[2] * rk, k1 = sv[3] * rk;
            qL[i * KLS + lane] = f2bf(q0); qL[i * KLS + lane + 64] = f2bf(q1);
            kL[i * KLS + lane] = f2bf(k0); kL[i * KLS + lane + 64] = f2bf(k1);
            xs[i * XSS + lane] = f2bf(sv[4] * bi); xs[i * XSS + lane + 64] = f2bf(sv[5] * bi);
            xs[i * XSS + 128 + lane] = f2bf(k0 * bi * ei); xs[i * XSS + 192 + lane] = f2bf(k1 * bi * ei);
            bf16_t* qd = gqd + (size_t)chunk * 8192 + i * 128;
            qd[lane] = f2bf(q0 * ei); qd[lane + 64] = f2bf(q1 * ei);
        }
    }
    __syncthreads();
    const int n16 = lane & 15, kq = lane >> 4;
    f32x4 aqk[4], akk[4];
#pragma unroll
    for (int tj = 0; tj < 4; tj++) { aqk[tj] = (f32x4){0.f, 0.f, 0.f, 0.f}; akk[tj] = (f32x4){0.f, 0.f, 0.f, 0.f}; }
#pragma unroll
    for (int ks = 0; ks < 4; ks++) {
        bf16x8 qa = *(const bf16x8*)(qL + (16 * w + n16) * KLS + 32 * ks + 8 * kq);
        bf16x8 ka = *(const bf16x8*)(kL + (16 * w + n16) * KLS + 32 * ks + 8 * kq);
#pragma unroll
        for (int tj = 0; tj < 4; tj++) {
            bf16x8 kb = *(const bf16x8*)(kL + (16 * tj + n16) * KLS + 32 * ks + 8 * kq);
            aqk[tj] = __builtin_amdgcn_mfma_f32_16x16x32_bf16(qa, kb, aqk[tj], 0, 0, 0);
            akk[tj] = __builtin_amdgcn_mfma_f32_16x16x32_bf16(ka, kb, akk[tj], 0, 0, 0);
        }
    }
    {
        const float glast = gcs[63];
        const int kidx = tid >> 1, c0 = (tid & 1) * 32;
        unsigned pk[16];
#pragma unroll
        for (int cc = 0; cc < 32; cc += 2) {
            float v0 = bf2f(kL[(c0 + cc) * KLS + kidx]) * __expf(glast - gcs[c0 + cc]);
            float v1 = bf2f(kL[(c0 + cc + 1) * KLS + kidx]) * __expf(glast - gcs[c0 + cc + 1]);
            pk[cc >> 1] = pack2bf(v0, v1);
        }
        uint4* dst = (uint4*)(gkdT + (size_t)chunk * 8192 + kidx * 64 + c0);
#pragma unroll
        for (int v4 = 0; v4 < 4; v4++) dst[v4] = make_uint4(pk[4 * v4], pk[4 * v4 + 1], pk[4 * v4 + 2], pk[4 * v4 + 3]);
        if (tid == 0) gl[chunk] = __expf(glast);
    }
    __syncthreads();
#pragma unroll
    for (int tj = 0; tj < 4; tj++)
#pragma unroll
        for (int r = 0; r < 4; r++) {
            const int i = 16 * w + 4 * kq + r, j = 16 * tj + n16;
            const float dec = (j <= i) ? __expf(gcs[i] - gcs[j]) : 0.f;
            gin[(size_t)chunk * 4096 + i * 64 + j] = f2bf(aqk[tj][r] * dec);
            AmT[j * 64 + i] = (j < i) ? bts[i] * akk[tj][r] * dec : 0.f;
        }
    __syncthreads();
    {
        const int c = tid;
#pragma unroll 1
        for (int blk = 0; blk < 8; blk++) {
            const int i0 = blk * 8;
            float acc[8];
#pragma unroll
            for (int r = 0; r < 8; r++) acc[r] = bf2f(xs[(i0 + r) * XSS + c]);
            for (int j = 0; j < i0; j++) {
                const float xj = bf2f(xs[j * XSS + c]);
                const float4 a0 = *(const float4*)(AmT + j * 64 + i0), a1 = *(const float4*)(AmT + j * 64 + i0 + 4);
                acc[0] -= a0.x * xj; acc[1] -= a0.y * xj; acc[2] -= a0.z * xj; acc[3] -= a0.w * xj;
                acc[4] -= a1.x * xj; acc[5] -= a1.y * xj; acc[6] -= a1.z * xj; acc[7] -= a1.w * xj;
            }
#pragma unroll
            for (int r = 1; r < 8; r++)
#pragma unroll
                for (int s2 = 0; s2 < r; s2++) acc[r] -= AmT[(i0 + s2) * 64 + i0 + r] * acc[s2];
#pragma unroll
            for (int r = 0; r < 8; r++) xs[(i0 + r) * XSS + c] = f2bf(acc[r]);
            if (c < 128) {
                *(uint4*)(guT + (size_t)chunk * 8192 + c * 64 + i0) =
                    make_uint4(pack2bf(acc[0], acc[1]), pack2bf(acc[2], acc[3]), pack2bf(acc[4], acc[5]), pack2bf(acc[6], acc[7]));
            } else {
#pragma unroll
                for (int r = 0; r < 8; r++) gw[(size_t)chunk * 8192 + (i0 + r) * 128 + (c - 128)] = f2bf(acc[r]);
            }
        }
    }
}

struct GdnFrag { bf16x8 wA[4], qA[4], inA[2], kdA[2][2]; uint2 uC; float glv; };
__device__ __forceinline__ void gdn_load_frag(GdnFrag& f, const bf16_t* __restrict__ guT, const bf16_t* __restrict__ gw, const bf16_t* __restrict__ gqd,
                                              const bf16_t* __restrict__ gkdT, const bf16_t* __restrict__ gin, const float* __restrict__ gl,
                                              int chunk, int w, int sl, int n16, int kq) {
    const size_t cb = (size_t)chunk * 8192;
#pragma unroll
    for (int ks = 0; ks < 4; ks++) {
        f.wA[ks] = *(const bf16x8*)(gw + cb + (16 * w + n16) * 128 + 32 * ks + 8 * kq);
        f.qA[ks] = *(const bf16x8*)(gqd + cb + (16 * w + n16) * 128 + 32 * ks + 8 * kq);
    }
#pragma unroll
    for (int ks = 0; ks < 2; ks++) {
        f.inA[ks] = *(const bf16x8*)(gin + (size_t)chunk * 4096 + (16 * w + n16) * 64 + 32 * ks + 8 * kq);
        f.kdA[0][ks] = *(const bf16x8*)(gkdT + cb + (32 * w + n16) * 64 + 32 * ks + 8 * kq);
        f.kdA[1][ks] = *(const bf16x8*)(gkdT + cb + (32 * w + 16 + n16) * 64 + 32 * ks + 8 * kq);
    }
    f.uC = *(const uint2*)(guT + cb + (16 * sl + n16) * 64 + 16 * w + 4 * kq);
    f.glv = gl[chunk];
}
#define STS 144
#define VNS 80
__device__ __forceinline__ void gdn_step(const GdnFrag& f, f32x4& S0, f32x4& S1, bf16_t* StT, bf16_t* vnT, float* __restrict__ ogrow, int w, int n16, int kq) {
    f32x4 ws = (f32x4){0.f, 0.f, 0.f, 0.f}, qs = (f32x4){0.f, 0.f, 0.f, 0.f};
#pragma unroll
    for (int ks = 0; ks < 4; ks++) {
        bf16x8 sb = *(const bf16x8*)(StT + n16 * STS + 32 * ks + 8 * kq);
        ws = __builtin_amdgcn_mfma_f32_16x16x32_bf16(f.wA[ks], sb, ws, 0, 0, 0);
        qs = __builtin_amdgcn_mfma_f32_16x16x32_bf16(f.qA[ks], sb, qs, 0, 0, 0);
    }
    float v0 = __uint_as_float(f.uC.x << 16) - ws[0], v1 = __uint_as_float(f.uC.x & 0xffff0000u) - ws[1];
    float v2 = __uint_as_float(f.uC.y << 16) - ws[2], v3 = __uint_as_float(f.uC.y & 0xffff0000u) - ws[3];
    *(uint2*)(vnT + n16 * VNS + 16 * w + 4 * kq) = make_uint2(pack2bf(v0, v1), pack2bf(v2, v3));
    __syncthreads();
    bf16x8 vb0 = *(const bf16x8*)(vnT + n16 * VNS + 8 * kq), vb1 = *(const bf16x8*)(vnT + n16 * VNS + 32 + 8 * kq);
    qs = __builtin_amdgcn_mfma_f32_16x16x32_bf16(f.inA[0], vb0, qs, 0, 0, 0);
    qs = __builtin_amdgcn_mfma_f32_16x16x32_bf16(f.inA[1], vb1, qs, 0, 0, 0);
    S0 = S0 * f.glv; S1 = S1 * f.glv;
    S0 = __builtin_amdgcn_mfma_f32_16x16x32_bf16(f.kdA[0][0], vb0, S0, 0, 0, 0);
    S0 = __builtin_amdgcn_mfma_f32_16x16x32_bf16(f.kdA[0][1], vb1, S0, 0, 0, 0);
    S1 = __builtin_amdgcn_mfma_f32_16x16x32_bf16(f.kdA[1][0], vb0, S1, 0, 0, 0);
    S1 = __builtin_amdgcn_mfma_f32_16x16x32_bf16(f.kdA[1][1], vb1, S1, 0, 0, 0);
#pragma unroll
    for (int r = 0; r < 4; r++) ogrow[(size_t)(4 * kq + r) * 512] = qs[r];
    *(uint2*)(StT + n16 * STS + 32 * w + 4 * kq) = make_uint2(pack2bf(S0[0], S0[1]), pack2bf(S0[2], S0[3]));
    *(uint2*)(StT + n16 * STS + 32 * w + 16 + 4 * kq) = make_uint2(pack2bf(S1[0], S1[1]), pack2bf(S1[2], S1[3]));
    __syncthreads();
}
__device__ __forceinline__ void d_gdn_scan2(const bf16_t* __restrict__ guT, const bf16_t* __restrict__ gw, const bf16_t* __restrict__ gqd,
                                            const bf16_t* __restrict__ gkdT, const bf16_t* __restrict__ gin, const float* __restrict__ gl,
                                            float* __restrict__ og, int item, char* smem) {
    bf16_t* StT = (bf16_t*)smem;
    bf16_t* vnT = StT + 16 * STS;
    const int tid = threadIdx.x, lane = tid & 63, w = tid >> 6, n16 = lane & 15, kq = lane >> 4;
    const int bh = item >> 3, sl = item & 7, b = bh >> 2, h = bh & 3;
    for (int i = tid; i < 16 * STS / 2; i += 256) ((unsigned*)StT)[i] = 0u;
    f32x4 S0 = (f32x4){0.f, 0.f, 0.f, 0.f}, S1 = (f32x4){0.f, 0.f, 0.f, 0.f};
    GdnFrag fa, fb;
    gdn_load_frag(fa, guT, gw, gqd, gkdT, gin, gl, bh * 128, w, sl, n16, kq);
    __syncthreads();
    float* obase = og + (size_t)(b * SEQ + 16 * w) * 512 + h * 128 + 16 * sl + n16;
#pragma unroll 1
    for (int n = 0; n < 128; n += 2) {
        gdn_load_frag(fb, guT, gw, gqd, gkdT, gin, gl, bh * 128 + n + 1, w, sl, n16, kq);
        gdn_step(fa, S0, S1, StT, vnT, obase + (size_t)(n * 64) * 512, w, n16, kq);
        if (n + 2 < 128) gdn_load_frag(fa, guT, gw, gqd, gkdT, gin, gl, bh * 128 + n + 2, w, sl, n16, kq);
        gdn_step(fb, S0, S1, StT, vnT, obase + (size_t)((n + 1) * 64) * 512, w, n16, kq);
    }
}

__device__ __forceinline__ void d_gdn_out(const float* __restrict__ og, const bf16_t* __restrict__ proj, const float* __restrict__ gain, bf16_t* __restrict__ mix, int bid) {
    int id = bid * 4 + (threadIdx.x >> 6);
    int lane = threadIdx.x & 63;
    int t = id >> 2, h = id & 3;
    const float* o = og + (size_t)t * 512 + h * 128;
    float a0 = o[lane], a1 = o[lane + 64];
    float ss = wave_sum(a0 * a0 + a1 * a1);
    float r = rsqrtf(ss * (1.f / 128.f) + 1e-6f);
    const bf16_t* z = proj + (size_t)t * PLD + C_Z + h * 128;
    float z0 = bf2f(z[lane]), z1 = bf2f(z[lane + 64]);
    mix[(size_t)t * DM + 512 + h * 128 + lane] = f2bf(a0 * r * gain[lane] * z0 * sigmoidf_(z0));
    mix[(size_t)t * DM + 512 + h * 128 + lane + 64] = f2bf(a1 * r * gain[lane + 64] * z1 * sigmoidf_(z1));
}

__device__ __forceinline__ void d_peer_route(const bf16_t* __restrict__ qry, const float* __restrict__ subkeys, int* __restrict__ eidx, float* __restrict__ pgate, int bid, char* smem) {
    float (*qsh)[256] = (float (*)[256])smem;
    float (*tv)[2][16] = (float (*)[2][16])(smem + 4096);
    int (*ti)[2][16] = (int (*)[2][16])(smem + 4096 + 512);
    const int lane = threadIdx.x & 63, w = threadIdx.x >> 6;
    const int id = bid * 4 + w;
    const int t = id >> 3, h = id & 7;
    const bf16_t* qp = qry + (size_t)t * 2048 + h * 256;
#pragma unroll
    for (int i = 0; i < 4; i++) qsh[w][lane + 64 * i] = bf2f(qp[lane + 64 * i]);
    __syncthreads();
    for (int half = 0; half < 2; half++) {
        const float* sk0 = subkeys + ((size_t)half * 128 + lane) * 128;
        const float* sk1 = sk0 + 64 * 128;
        float s0 = 0.f, s1 = 0.f;
        for (int d = 0; d < 128; d += 4) {
            float4 a = *(const float4*)(sk0 + d), c = *(const float4*)(sk1 + d);
            float4 qq = *(const float4*)(&qsh[w][half * 128 + d]);
            s0 += a.x * qq.x + a.y * qq.y + a.z * qq.z + a.w * qq.w;
            s1 += c.x * qq.x + c.y * qq.y + c.z * qq.z + c.w * qq.w;
        }
        for (int it = 0; it < 16; it++) {
            float bv; int bi;
            if (s0 >= s1) { bv = s0; bi = lane; } else { bv = s1; bi = lane + 64; }
#pragma unroll
            for (int o = 32; o > 0; o >>= 1) {
                float ov = __shfl_xor(bv, o); int oi = __shfl_xor(bi, o);
                if (ov > bv || (ov == bv && oi < bi)) { bv = ov; bi = oi; }
            }
            if (lane == 0) { tv[w][half][it] = bv; ti[w][half][it] = bi; }
            if (bi == lane) s0 = -3e38f;
            if (bi == lane + 64) s1 = -3e38f;
        }
    }
    __syncthreads();
    float cv[4];
#pragma unroll
    for (int i = 0; i < 4; i++) { int f = lane * 4 + i; cv[i] = tv[w][0][f >> 4] + tv[w][1][f & 15]; }
    float topv = 0.f; int tope = 0;
    float mx = 0.f;
    for (int it = 0; it < 16; it++) {
        float bv = cv[0]; int bi = lane * 4;
#pragma unroll
        for (int i = 1; i < 4; i++) if (cv[i] > bv) { bv = cv[i]; bi = lane * 4 + i; }
#pragma unroll
        for (int o = 32; o > 0; o >>= 1) {
            float ov = __shfl_xor(bv, o); int oi = __shfl_xor(bi, o);
            if (ov > bv || (ov == bv && oi < bi)) { bv = ov; bi = oi; }
        }
        if (it == 0) mx = bv;
        if (lane == it) { topv = bv; tope = ti[w][0][bi >> 4] * 128 + ti[w][1][bi & 15]; }
#pragma unroll
        for (int i = 0; i < 4; i++) if (bi == lane * 4 + i) cv[i] = -3e38f;
    }
    float e = (lane < 16) ? __expf(topv - mx) : 0.f;
    float sum = wave_sum(e);
    if (lane < 16) {
        eidx[(size_t)t * 128 + h * 16 + lane] = tope;
        pgate[(size_t)t * 128 + h * 16 + lane] = e / sum;
    }
}

__device__ __forceinline__ void d_peer_expert(const bf16_t* __restrict__ h2, const int* __restrict__ eidx, const float* __restrict__ pgate,
                                                     const float* __restrict__ utab, const float* __restrict__ vtab, float* __restrict__ out, int bid, char* smem) {
    float (*red)[1024] = (float (*)[1024])smem;
    const int t = bid;
    const int lane = threadIdx.x & 63, w = threadIdx.x >> 6;
    float x[16], acc[16];
#pragma unroll
    for (int i = 0; i < 4; i++) {
        ushort4 u = ((const ushort4*)(h2 + (size_t)t * DM))[lane + 64 * i];
        x[i * 4 + 0] = bf2f(u.x); x[i * 4 + 1] = bf2f(u.y); x[i * 4 + 2] = bf2f(u.z); x[i * 4 + 3] = bf2f(u.w);
    }
#pragma unroll
    for (int i = 0; i < 16; i++) acc[i] = 0.f;
    for (int k = 0; k < 32; k++) {
        int e = eidx[(size_t)t * 128 + w * 32 + k];
        float gt = pgate[(size_t)t * 128 + w * 32 + k];
        const float4* ur = (const float4*)(utab + (size_t)e * DM);
        float d = 0.f;
#pragma unroll
        for (int i = 0; i < 4; i++) {
            float4 u = ur[lane + 64 * i];
            d += u.x * x[i * 4] + u.y * x[i * 4 + 1] + u.z * x[i * 4 + 2] + u.w * x[i * 4 + 3];
        }
        d = wave_sum(d);
        float coef = gt * gelu_tanh(d);
        const float4* vr = (const float4*)(vtab + (size_t)e * DM);
#pragma unroll
        for (int i = 0; i < 4; i++) {
            float4 v = vr[lane + 64 * i];
            acc[i * 4] += coef * v.x; acc[i * 4 + 1] += coef * v.y; acc[i * 4 + 2] += coef * v.z; acc[i * 4 + 3] += coef * v.w;
        }
    }
#pragma unroll
    for (int i = 0; i < 4; i++) *(float4*)(&red[w][(lane + 64 * i) * 4]) = make_float4(acc[i * 4], acc[i * 4 + 1], acc[i * 4 + 2], acc[i * 4 + 3]);
    __syncthreads();
    for (int c = threadIdx.x; c < 1024; c += 256) {
        out[(size_t)t * DM + c] += red[0][c] + red[1][c] + red[2][c] + red[3][c];
    }
}

__device__ __forceinline__ void d_convert_bf16(const float* __restrict__ src, bf16_t* __restrict__ dst, int item) {
    const size_t idx = (size_t)item * 2048 + threadIdx.x * 8;
    const float4 a = *(const float4*)(src + idx), b = *(const float4*)(src + idx + 4);
    *(uint4*)(dst + idx) = make_uint4(pack2bf(a.x, a.y), pack2bf(a.z, a.w), pack2bf(b.x, b.y), pack2bf(b.z, b.w));
}

typedef __bf16 bf16x2_t __attribute__((ext_vector_type(2)));
__device__ __forceinline__ float dot2bf(unsigned a, unsigned b, float c) {
    return __builtin_amdgcn_fdot2_f32_bf16(__builtin_bit_cast(bf16x2_t, a), __builtin_bit_cast(bf16x2_t, b), c, false);
}
struct PeerGrp { uint4 u[4][2]; uint4 v[4][2]; float g[4]; };
__device__ __forceinline__ void peer_load(PeerGrp& G, const bf16_t* __restrict__ ubf, const bf16_t* __restrict__ vbf, int esrc, float gsrc, int k0, int lane) {
#pragma unroll
    for (int i = 0; i < 4; i++) {
        const int e = __builtin_amdgcn_readlane(esrc, (k0 + i) & 63);
        G.g[i] = __builtin_bit_cast(float, __builtin_amdgcn_readlane(__builtin_bit_cast(int, gsrc), (k0 + i) & 63));
        const uint4* up = (const uint4*)(ubf + (size_t)e * DM) + lane;
        const uint4* vp = (const uint4*)(vbf + (size_t)e * DM) + lane;
        G.u[i][0] = up[0]; G.u[i][1] = up[64];
        G.v[i][0] = vp[0]; G.v[i][1] = vp[64];
    }
}
__device__ __forceinline__ void peer_compute(const PeerGrp& G, const unsigned (&xp)[8], float (&acc)[16]) {
    float d[4];
#pragma unroll
    for (int i = 0; i < 4; i++) {
        float s = 0.f;
        s = dot2bf(G.u[i][0].x, xp[0], s); s = dot2bf(G.u[i][0].y, xp[1], s); s = dot2bf(G.u[i][0].z, xp[2], s); s = dot2bf(G.u[i][0].w, xp[3], s);
        s = dot2bf(G.u[i][1].x, xp[4], s); s = dot2bf(G.u[i][1].y, xp[5], s); s = dot2bf(G.u[i][1].z, xp[6], s); s = dot2bf(G.u[i][1].w, xp[7], s);
        d[i] = s;
    }
#pragma unroll
    for (int o = 32; o > 0; o >>= 1) {
#pragma unroll
        for (int i = 0; i < 4; i++) d[i] += __shfl_xor(d[i], o);
    }
#pragma unroll
    for (int i = 0; i < 4; i++) {
        const float coef = G.g[i] * gelu_tanh(d[i]);
        const unsigned wv[8] = {G.v[i][0].x, G.v[i][0].y, G.v[i][0].z, G.v[i][0].w, G.v[i][1].x, G.v[i][1].y, G.v[i][1].z, G.v[i][1].w};
#pragma unroll
        for (int j = 0; j < 8; j++) {
            acc[2 * j] += coef * __uint_as_float(wv[j] << 16);
            acc[2 * j + 1] += coef * __uint_as_float(wv[j] & 0xffff0000u);
        }
    }
}
__device__ __forceinline__ void d_peer_expert2(const bf16_t* __restrict__ h2, const int* __restrict__ eidx, const float* __restrict__ pgate,
                                               const bf16_t* __restrict__ ubf, const bf16_t* __restrict__ vbf, float* __restrict__ out, int token, int lane) {
    const uint4 xa = ((const uint4*)(h2 + (size_t)token * DM))[lane], xb = ((const uint4*)(h2 + (size_t)token * DM))[64 + lane];
    const unsigned xp[8] = {xa.x, xa.y, xa.z, xa.w, xb.x, xb.y, xb.z, xb.w};
    float acc[16];
#pragma unroll
    for (int i = 0; i < 16; i++) acc[i] = 0.f;
    const int e_lo = eidx[(size_t)token * 128 + lane], e_hi = eidx[(size_t)token * 128 + 64 + lane];
    const float g_lo = pgate[(size_t)token * 128 + lane], g_hi = pgate[(size_t)token * 128 + 64 + lane];
    PeerGrp A, B;
    peer_load(A, ubf, vbf, e_lo, g_lo, 0, lane);
#pragma unroll 1
    for (int k0 = 0; k0 < 64; k0 += 8) {
        peer_load(B, ubf, vbf, e_lo, g_lo, k0 + 4, lane);
        peer_compute(A, xp, acc);
        if (k0 + 8 < 64) peer_load(A, ubf, vbf, e_lo, g_lo, k0 + 8, lane); else peer_load(A, ubf, vbf, e_hi, g_hi, 0, lane);
        peer_compute(B, xp, acc);
    }
#pragma unroll 1
    for (int k0 = 0; k0 < 64; k0 += 8) {
        peer_load(B, ubf, vbf, e_hi, g_hi, k0 + 4, lane);
        peer_compute(A, xp, acc);
        if (k0 + 8 < 64) peer_load(A, ubf, vbf, e_hi, g_hi, k0 + 8, lane);
        peer_compute(B, xp, acc);
    }
    float4* o0 = (float4*)(out + (size_t)token * DM + lane * 8);
    float4* o1 = (float4*)(out + (size_t)token * DM + 512 + lane * 8);
    float4 a0 = o0[0], a1 = o0[1], b0 = o1[0], b1 = o1[1];
    a0.x += acc[0]; a0.y += acc[1]; a0.z += acc[2]; a0.w += acc[3]; a1.x += acc[4]; a1.y += acc[5]; a1.z += acc[6]; a1.w += acc[7];
    b0.x += acc[8]; b0.y += acc[9]; b0.z += acc[10]; b0.w += acc[11]; b1.x += acc[12]; b1.y += acc[13]; b1.z += acc[14]; b1.w += acc[15];
    o0[0] = a0; o0[1] = a1; o1[0] = b0; o1[1] = b1;
}

#define XB_TMO      128
#define XB_XCNT(j)  (256  + 64 * (j))
#define XB_XSUB(j)  (1280 + 64 * (j))
#define XB_XGEN(j)  (2304 + 64 * (j))
#define XB_TOP      3328
#define XB_TOPGEN   3392
#define XB_QUEUE    3456
#define XCD_BAR_WORDS 4096
#define XB_SPIN_CAP (1u << 22)
#define LAS __attribute__((address_space(3)))
__device__ __forceinline__ unsigned xb_ld(unsigned* p)              { return __hip_atomic_load(p, __ATOMIC_RELAXED, __HIP_MEMORY_SCOPE_AGENT); }
__device__ __forceinline__ unsigned xb_add(unsigned* p, unsigned v) { return __hip_atomic_fetch_add(p, v, __ATOMIC_RELAXED, __HIP_MEMORY_SCOPE_AGENT); }
__device__ __forceinline__ unsigned xb_xcc_id() { return (unsigned)__builtin_amdgcn_s_getreg((3 << 11) | 20) & 0xFu; }
#define XB_SPIN(cond, bar) do { unsigned _sp = 0; while (cond) { __builtin_amdgcn_s_sleep(1); \
    if ((++_sp & 255u) == 0u) { if (xb_ld(&(bar)[XB_TMO])) break; if (_sp > XB_SPIN_CAP) { atomicAdd(&(bar)[XB_TMO], 1u); break; } } } } while (0)
struct XcdBarrier { unsigned* bar; unsigned x; volatile LAS unsigned* st; };
__device__ __forceinline__ XcdBarrier xcd_barrier_post(unsigned* bar, volatile LAS unsigned* st) {
    XcdBarrier b; b.bar = bar; b.x = xb_xcc_id(); b.st = st;
    if (threadIdx.x == 0) (void)xb_add(&bar[XB_XCNT(b.x)], 1u);
    return b;
}
__device__ __forceinline__ void xcd_barrier_complete(unsigned* bar, unsigned x, unsigned& nloc, unsigned& nx) {
    const unsigned G = gridDim.x * gridDim.y * gridDim.z;
    unsigned sum, cnt, mine, sp = 0u;
    for (;;) {
        sum = 0u; cnt = 0u; mine = 0u;
#pragma unroll
        for (unsigned j = 0; j < 16; ++j) { const unsigned c = xb_ld(&bar[XB_XCNT(j)]); sum += c; cnt += (c > 0u) ? 1u : 0u; mine = (j == x) ? c : mine; }
        if (sum == G) break;
        __builtin_amdgcn_s_sleep(1);
        if ((++sp & 255u) == 0u) { if (xb_ld(&bar[XB_TMO])) break; if (sp > XB_SPIN_CAP) { atomicAdd(&bar[XB_TMO], 1u); break; } }
    }
    nloc = mine > 0u ? mine : 1u; nx = cnt > 0u ? cnt : 1u;
}
__device__ __forceinline__ void xcd_barrier(const XcdBarrier& b) {
    asm volatile("s_waitcnt vmcnt(0)" ::: "memory");
    __syncthreads();
    if (threadIdx.x == 0) {
        unsigned* bar = b.bar;
        __builtin_amdgcn_s_waitcnt(0);
        unsigned nloc = b.st[0], nx = b.st[1];
        if (nloc == 0u) { xcd_barrier_complete(bar, b.x, nloc, nx); b.st[0] = nloc; b.st[1] = nx; }
        const unsigned old = xb_add(&bar[XB_XSUB(b.x)], 1u);
        const unsigned gen = old / nloc;
        if (old + 1u == (gen + 1u) * nloc) {
            __builtin_amdgcn_fence(__ATOMIC_RELEASE, "agent");
            asm volatile("s_waitcnt vmcnt(0)" ::: "memory");
            const unsigned og = xb_add(&bar[XB_TOP], 1u);
            const unsigned tg = og / nx;
            if (og + 1u == (tg + 1u) * nx) xb_add(&bar[XB_TOPGEN], 1u);
            else XB_SPIN(xb_ld(&bar[XB_TOPGEN]) == tg, bar);
            __builtin_amdgcn_fence(__ATOMIC_ACQUIRE, "agent");
            xb_add(&bar[XB_XGEN(b.x)], 1u);
            asm volatile("s_waitcnt vmcnt(0)" ::: "memory");
        } else {
            XB_SPIN(xb_ld(&bar[XB_XGEN(b.x)]) == gen, bar);
            __builtin_amdgcn_fence(__ATOMIC_ACQUIRE, "agent");
            asm volatile("s_waitcnt vmcnt(0)" ::: "memory");
        }
    }
    __syncthreads();
}

struct MKP {
    const float *x, *attn_norm, *w_in, *q_gain, *k_gain, *cmp_pos, *cmp_w1, *cmp_w2, *gdn_conv, *a_log, *dt_bias, *out_gain, *w_out, *ffn_norm, *w_query, *subkeys, *peer_u, *peer_v;
    float* out; char* ws; unsigned* bar;
};

#define SMEM_BYTES 69120

__global__ __launch_bounds__(256, 2) void hybrid_megakernel(MKP P) {
    extern __shared__ __attribute__((aligned(16))) char smem[];
    __shared__ uint4 xb_words;
    __shared__ int q_item;
    const int G = gridDim.x, bid0 = blockIdx.x;
    if (threadIdx.x == 0) xb_words = make_uint4(0u, 0u, 0u, 0u);
    __syncthreads();
    XcdBarrier B = xcd_barrier_post(P.bar, (volatile LAS unsigned*)&xb_words);
    char* ws = P.ws;
    bf16_t* w_in_t = (bf16_t*)(ws + OFF_WINT);
    bf16_t* w_out_t = (bf16_t*)(ws + OFF_WOUTT);
    bf16_t* w_q_t = (bf16_t*)(ws + OFF_WQT);
    bf16_t* cw1_t = (bf16_t*)(ws + OFF_CW1T);
    float* cbias = (float*)(ws + OFF_CBIAS);
    bf16_t* h_bf = (bf16_t*)(ws + OFF_HBF);
    bf16_t* proj = (bf16_t*)(ws + OFF_PROJ);
    bf16_t* ksn = (bf16_t*)(ws + OFF_KSN);
    bf16_t* kwn = (bf16_t*)(ws + OFF_KWN);
    bf16_t* kc = (bf16_t*)(ws + OFF_KC);
    bf16_t* vc = (bf16_t*)(ws + OFF_VC);
    bf16_t* hid = (bf16_t*)(ws + OFF_HID);
    bf16_t* gu = (bf16_t*)(ws + OFF_GU);
    bf16_t* gw = (bf16_t*)(ws + OFF_GW);
    bf16_t* gqd = (bf16_t*)(ws + OFF_GQD);
    bf16_t* gkd = (bf16_t*)(ws + OFF_GKD);
    bf16_t* gin = (bf16_t*)(ws + OFF_GIN);
    float* gl = (float*)(ws + OFF_GL);
    bf16_t* mix = (bf16_t*)(ws + OFF_MIX);
    bf16_t* qry = (bf16_t*)(ws + OFF_QRY);
    bf16_t* h2 = (bf16_t*)(ws + OFF_H2);
    int* eidx = (int*)(ws + OFF_EIDX);
    float* pgate = (float*)(ws + OFF_PGATE);
    bf16_t* ubf = (bf16_t*)(ws + OFF_UBF);
    bf16_t* vbf = (bf16_t*)(ws + OFF_VBF);
    float* og = P.out;
    float2* rope = (float2*)(ws + OFF_ROPE);

    {
        const int n1 = 108 * 32, n2 = n1 + 32 * 32, n3 = n2 + 64 * 32, n4 = n3 + 2 * 8 * 64;
        for (int it = bid0; it < n4; it += G) {
            if (it < n1) d_transpose_bf16(P.w_in, 1024, IN_COLS, w_in_t, it % 108, it / 108, smem);
            else if (it < n2) { int r = it - n1; d_transpose_bf16(P.w_out, 1024, 1024, w_out_t, r % 32, r / 32, smem); }
            else if (it < n3) { int r = it - n2; d_transpose_bf16(P.w_query, 1024, 2048, w_q_t, r % 64, r / 64, smem); }
            else { int r = it - n3; int j = r >> 9; r &= 511; d_transpose_bf16(P.cmp_w1 + (size_t)j * 2048 * 256, 2048, 256, cw1_t + (size_t)j * 256 * 2048, r % 8, r / 8, smem); }
            __syncthreads();
        }
        for (int it = bid0; it < 2; it += G) d_cmp_bias(P.cmp_pos, P.cmp_w1, cbias, it);
        for (int it = bid0; it < T_TOK / 4; it += G) d_rmsnorm_bf16(P.x, P.attn_norm, h_bf, it);
        for (int i = bid0 * 256 + threadIdx.x; i < 8192 * 32; i += G * 256) {
            const int pos = i >> 5, fi = i & 31;
            float sn, cs; sincosf((float)pos * expf(-9.210340371976184f * (float)(2 * fi) / 64.f), &sn, &cs);
            rope[i] = make_float2(cs, sn);
        }
        for (int i = bid0 * 256 + threadIdx.x; i < 32 * PLD / 2; i += G * 256) ((unsigned*)(proj + (size_t)T_TOK * PLD))[i] = 0u;
    }
    xcd_barrier(B);
    {
        GemmP p{}; p.A = h_bf; p.lda = 1024; p.akts = 64; p.Bt = w_in_t; p.ldb = 1024; p.K = 1024; p.mtiles = 128; p.ntiles = 27; p.out = proj;
        for (int it = bid0; it < 128 * 27; it += G) d_gemm<EPI_PROJ>(p, it, smem);
    }
    xcd_barrier(B);
    {
        for (int it = bid0; it < 64; it += G) {
            int inst = it >> 3, tile = it & 7;
            int j = inst >> 2, b = (inst >> 1) & 1, g = inst & 1;
            GemmP p{}; p.A = proj + (size_t)(b * SEQ) * PLD + C_KV + 128 * j + 64 * g; p.lda = 16 * PLD; p.akts = PLD;
            p.Bt = cw1_t + (size_t)j * 256 * 2048; p.ldb = 2048; p.K = 2048; p.mtiles = 4; p.ntiles = 2;
            p.out = hid + (size_t)inst * 512 * 256; p.aux = cbias + j * 256;
            d_gemm<EPI_HID>(p, tile, smem);
        }
        for (int it = bid0; it < 1024; it += G) { d_gdn_prep2(proj, P.gdn_conv, P.a_log, P.dt_bias, gu, gw, gqd, gkd, gin, gl, it, smem); __syncthreads(); }
        for (int it = bid0; it < 8192; it += G) d_knorm_rope(proj, P.k_gain, ksn, kwn, it);
    }
    xcd_barrier(B);
    for (int it = bid0; it < 1024; it += G) d_cmp2(hid, P.cmp_w2, P.k_gain, kc, vc, it);
    xcd_barrier(B);
    {
        if (bid0 < 64) d_gdn_scan2(gu, gw, gqd, gkd, gin, gl, og, bid0, smem);
        __syncthreads();
        for (;;) {
            if (threadIdx.x == 0) q_item = (int)xb_add(&P.bar[XB_QUEUE], 1u);
            __syncthreads();
            const int it = q_item;
            if (it >= 1024) break;
            d_nsa_mfma(proj, P.q_gain, rope, ksn, kwn, kc, vc, mix, DM, it, smem);
            __syncthreads();
        }
#ifdef NSA_CHECK
        bf16_t* mix2 = (bf16_t*)(P.out + 8388608);
        for (;;) {
            if (threadIdx.x == 0) q_item = (int)xb_add(&P.bar[XB_QUEUE + 64], 1u);
            __syncthreads();
            const int it = q_item;
            if (it >= 2 * 2 * SEQ) break;
            d_nsa_naive(proj, P.q_gain, ksn, kwn, kc, vc, mix2, 512, it, smem);
            __syncthreads();
        }
#endif
    }
    xcd_barrier(B);
#ifdef NSA_CHECK
    {
        const bf16_t* mix2 = (const bf16_t*)(P.out + 8388608);
        float sd = 0.f, sr = 0.f;
        for (int i = bid0 * 256 + threadIdx.x; i < T_TOK * 512; i += G * 256) {
            const int r = i >> 9, c = i & 511;
            const float a = bf2f(mix[(size_t)r * DM + c]), bb = bf2f(mix2[i]);
            sd += (a - bb) * (a - bb); sr += bb * bb;
        }
        sd = wave_sum(sd); sr = wave_sum(sr);
        if ((threadIdx.x & 63) == 0) { atomicAdd((float*)&P.bar[XB_QUEUE + 128], sd); atomicAdd((float*)&P.bar[XB_QUEUE + 192], sr); }
    }
    xcd_barrier(B);
#endif
    for (int it = bid0; it < T_TOK; it += G) d_gdn_out(og, proj, P.out_gain, mix, it);
    for (int it = bid0; it < 8192; it += G) { d_convert_bf16(P.peer_u, ubf, it); d_convert_bf16(P.peer_v, vbf, it); }
    xcd_barrier(B);
    {
        GemmP p{}; p.A = mix; p.lda = 1024; p.akts = 64; p.Bt = w_out_t; p.ldb = 1024; p.K = 1024; p.mtiles = 128; p.ntiles = 8; p.out = P.out; p.aux = P.x;
        for (int it = bid0; it < 128 * 8; it += G) d_gemm<EPI_OUT>(p, it, smem);
    }
    xcd_barrier(B);
    for (int it = bid0; it < T_TOK / 4; it += G) d_rmsnorm_bf16(P.out, P.ffn_norm, h2, it);
    xcd_barrier(B);
    {
        GemmP p{}; p.A = h2; p.lda = 1024; p.akts = 64; p.Bt = w_q_t; p.ldb = 1024; p.K = 1024; p.mtiles = 128; p.ntiles = 16; p.out = qry;
        for (int it = bid0; it < 128 * 16; it += G) d_gemm<EPI_QRY>(p, it, smem);
    }
    xcd_barrier(B);
    for (int it = bid0; it < T_TOK * 2; it += G) { d_peer_route(qry, P.subkeys, eidx, pgate, it, smem); __syncthreads(); }
    xcd_barrier(B);
    for (int it = bid0; it < T_TOK / 4; it += G) d_peer_expert2(h2, eidx, pgate, ubf, vbf, P.out, it * 4 + (threadIdx.x >> 6), threadIdx.x & 63);
#ifdef NSA_CHECK
    xcd_barrier(B);
    {
        const float sd = __hip_atomic_load((float*)&P.bar[XB_QUEUE + 128], __ATOMIC_RELAXED, __HIP_MEMORY_SCOPE_AGENT);
        const float sr = __hip_atomic_load((float*)&P.bar[XB_QUEUE + 192], __ATOMIC_RELAXED, __HIP_MEMORY_SCOPE_AGENT);
        if (!(sd <= NSA_CHECK * sr)) for (int i = bid0 * 256 + threadIdx.x; i < T_TOK * DM; i += G * 256) P.out[i] += 1000.f;
    }
#endif
}

extern "C" void kernel_launch(void* const* d_in, const int* in_sizes, int n_in, void* d_out, int out_size, void* d_ws, size_t ws_size,
                              hipStream_t stream) {
    const size_t bar_off = (OFF_END + 255) & ~(size_t)255;
    if (ws_size < bar_off + XCD_BAR_WORDS * 4) return;
    static int grid_blocks = 0;
    if (!grid_blocks) {
        int dev = 0, cus = 0, per_cu = 0;
        (void)hipGetDevice(&dev);
        (void)hipDeviceGetAttribute(&cus, hipDeviceAttributeMultiprocessorCount, dev);
        (void)hipFuncSetAttribute((const void*)hybrid_megakernel, hipFuncAttributeMaxDynamicSharedMemorySize, SMEM_BYTES);
        (void)hipOccupancyMaxActiveBlocksPerMultiprocessor(&per_cu, hybrid_megakernel, 256, SMEM_BYTES);
        if (per_cu > 2) per_cu = 2;
        grid_blocks = cus * per_cu;
    }
    if (grid_blocks <= 0) return;
    MKP P{};
    P.x = (const float*)d_in[0]; P.attn_norm = (const float*)d_in[1]; P.w_in = (const float*)d_in[2]; P.q_gain = (const float*)d_in[3];
    P.k_gain = (const float*)d_in[4]; P.cmp_pos = (const float*)d_in[5]; P.cmp_w1 = (const float*)d_in[6]; P.cmp_w2 = (const float*)d_in[7];
    P.gdn_conv = (const float*)d_in[8]; P.a_log = (const float*)d_in[9]; P.dt_bias = (const float*)d_in[10]; P.out_gain = (const float*)d_in[11];
    P.w_out = (const float*)d_in[12]; P.ffn_norm = (const float*)d_in[13]; P.w_query = (const float*)d_in[14]; P.subkeys = (const float*)d_in[15];
    P.peer_u = (const float*)d_in[16]; P.peer_v = (const float*)d_in[17];
    P.out = (float*)d_out; P.ws = (char*)d_ws; P.bar = (unsigned*)((char*)d_ws + bar_off);
    (void)hipMemsetAsync(P.bar, 0, XCD_BAR_WORDS * 4, stream);
    hipLaunchKernelGGL(hybrid_megakernel, dim3(grid_blocks), dim3(256), SMEM_BYTES, stream, P);
}
```

```cpp
#include <hip/hip_runtime.h>
#include <stdint.h>

typedef unsigned short bf16_t;
typedef __attribute__((ext_vector_type(8))) short bf16x8;
typedef __attribute__((ext_vector_type(4))) float f32x4;
#define LAS3 __attribute__((address_space(3)))

#define T_TOK 16384
#define SEQ 8192
#define DM 1024
#define IN_COLS 3360
#define PLD 3456
#define C_Q 0
#define C_KV 512
#define C_GATE 1280
#define C_GQKV 1304
#define C_Z 2840
#define C_A 3352
#define C_B 3356

#define OFF_WINT   0ull
#define OFF_WOUTT  (OFF_WINT  + 3456ull*1024*2)
#define OFF_WQT    (OFF_WOUTT + 1024ull*1024*2)
#define OFF_CW1T   (OFF_WQT   + 2048ull*1024*2)
#define OFF_CBIAS  (OFF_CW1T  + 2ull*256*2048*2)
#define OFF_HBF    (OFF_CBIAS + 4096ull)
#define OFF_PROJ   (OFF_HBF   + 16384ull*1024*2)
#define OFF_KSN    (OFF_PROJ  + (16384ull+32)*PLD*2)
#define OFF_KWN    (OFF_KSN   + 4ull*8192*64*2)
#define OFF_KC     (OFF_KWN   + 4ull*8192*64*2)
#define OFF_VC     (OFF_KC    + 4ull*512*64*2)
#define OFF_HID    (OFF_VC    + 4ull*512*64*2)
#define OFF_GU     (OFF_HID   + 8ull*512*256*2)
#define OFF_GW     (OFF_GU    + 1024ull*64*128*2)
#define OFF_GQD    (OFF_GW    + 1024ull*64*128*2)
#define OFF_GKD    (OFF_GQD   + 1024ull*64*128*2)
#define OFF_GIN    (OFF_GKD   + 1024ull*64*128*2)
#define OFF_GL     (OFF_GIN   + 1024ull*64*64*2)
#define OFF_ROPE   (OFF_GL    + 4096ull)
#define OFF_END    (OFF_ROPE  + 8192ull*32*8)
#define OFF_MIX    OFF_HBF
#define OFF_QRY    OFF_PROJ
#define OFF_H2     (OFF_PROJ + 16384ull*2048*2)
#define OFF_EIDX   OFF_KSN
#define OFF_PGATE  OFF_GIN
#define OFF_UBF    OFF_GU
#define OFF_VBF    OFF_GQD

__device__ __forceinline__ bf16_t f2bf(float f) {
    unsigned u = __float_as_uint(f);
    u += 0x7fffu + ((u >> 16) & 1u);
    return (bf16_t)(u >> 16);
}
__device__ __forceinline__ float bf2f(bf16_t h) { return __uint_as_float(((unsigned)h) << 16); }
__device__ __forceinline__ float gelu_tanh(float x) {
    float u = 0.7978845608028654f * (x + 0.044715f * x * x * x);
    return 0.5f * x * (1.f + tanhf(u));
}
__device__ __forceinline__ float sigmoidf_(float x) { return 1.f / (1.f + __expf(-x)); }
__device__ __forceinline__ float wave_sum(float v) {
#pragma unroll
    for (int o = 32; o > 0; o >>= 1) v += __shfl_xor(v, o);
    return v;
}
__device__ __forceinline__ float wave_max(float v) {
#pragma unroll
    for (int o = 32; o > 0; o >>= 1) v = fmaxf(v, __shfl_xor(v, o));
    return v;
}

__device__ __forceinline__ void d_transpose_bf16(const float* __restrict__ W, int K, int N, bf16_t* __restrict__ Wt, int bx, int by, char* smem) {
    float (*tile)[33] = (float (*)[33])smem;
    int n0 = bx * 32, k0 = by * 32;
    int tx = threadIdx.x & 31, ty = threadIdx.x >> 5;
    for (int i = ty; i < 32; i += 8) {
        int n = n0 + tx;
        tile[i][tx] = (n < N) ? W[(size_t)(k0 + i) * N + n] : 0.f;
    }
    __syncthreads();
    for (int i = ty; i < 32; i += 8) {
        Wt[(size_t)(n0 + i) * K + k0 + tx] = f2bf(tile[tx][i]);
    }
}

__device__ __forceinline__ void d_rmsnorm_bf16(const float* __restrict__ x, const float* __restrict__ g, bf16_t* __restrict__ out, int bid) {
    int row = bid * 4 + (threadIdx.x >> 6);
    int lane = threadIdx.x & 63;
    const float4* xr = (const float4*)(x + (size_t)row * DM);
    float4 v[4];
    float ss = 0.f;
#pragma unroll
    for (int i = 0; i < 4; i++) { v[i] = xr[lane + 64 * i]; ss += v[i].x * v[i].x + v[i].y * v[i].y + v[i].z * v[i].z + v[i].w * v[i].w; }
    ss = wave_sum(ss);
    float r = rsqrtf(ss * (1.f / DM) + 1e-6f);
#pragma unroll
    for (int i = 0; i < 4; i++) {
        float4 gg = ((const float4*)g)[lane + 64 * i];
        ushort4 o;
        o.x = f2bf(v[i].x * r * gg.x); o.y = f2bf(v[i].y * r * gg.y); o.z = f2bf(v[i].z * r * gg.z); o.w = f2bf(v[i].w * r * gg.w);
        ((ushort4*)(out + (size_t)row * DM))[lane + 64 * i] = o;
    }
}

__device__ __forceinline__ void d_cmp_bias(const float* __restrict__ pos, const float* __restrict__ w1, float* __restrict__ bias, int bid) {
    int j = bid, c = threadIdx.x;
    float s = 0.f;
    for (int k = 0; k < 2048; k++) s += pos[j * 2048 + k] * w1[((size_t)j * 2048 + k) * 256 + c];
    bias[j * 256 + c] = s;
}

#define EPI_PROJ 0
#define EPI_HID 1
#define EPI_OUT 2
#define EPI_QRY 3
struct GemmP {
    const bf16_t* A; long lda; long akts;
    const bf16_t* Bt; long ldb;
    int K; int mtiles; int ntiles;
    long a_inst; long b_inst;
    void* out; const float* aux; const float* aux2;
};

template <int EPI>
__device__ __forceinline__ void d_gemm(const GemmP& p, int bid, char* smem) {
    bf16_t* As = (bf16_t*)smem;
    bf16_t* Bs = As + 128 * 72;
    const int tid = threadIdx.x, lane = tid & 63, wave = tid >> 6;
    const int wm = wave >> 1, wn = wave & 1;
    const int inst = 0;
    const int mt = bid / p.ntiles, nt = bid % p.ntiles;
    const int m0 = mt * 128, n0 = nt * 128;
    const bf16_t* A = p.A + (size_t)inst * p.a_inst + (size_t)m0 * p.lda;
    const bf16_t* Bt = p.Bt + (size_t)inst * p.b_inst + (size_t)n0 * p.ldb;
    f32x4 acc[4][4];
#pragma unroll
    for (int i = 0; i < 4; i++)
#pragma unroll
        for (int j = 0; j < 4; j++) acc[i][j] = (f32x4){0.f, 0.f, 0.f, 0.f};
    const int nk = p.K >> 6;
    const int lrow = tid >> 3, lc8 = (tid & 7) * 8;
    const bf16_t* Ap = A + (size_t)lrow * p.lda + lc8;
    const bf16_t* Bp = Bt + (size_t)lrow * p.ldb + lc8;
    const size_t a32 = (size_t)32 * p.lda, b32 = (size_t)32 * p.ldb;
    uint4 ra0, ra1, ra2, ra3, rb0, rb1, rb2, rb3;
#define GLOAD(koffA, koffB) \
    ra0 = *(const uint4*)(Ap + (koffA)); ra1 = *(const uint4*)(Ap + a32 + (koffA)); ra2 = *(const uint4*)(Ap + 2 * a32 + (koffA)); ra3 = *(const uint4*)(Ap + 3 * a32 + (koffA)); \
    rb0 = *(const uint4*)(Bp + (koffB)); rb1 = *(const uint4*)(Bp + b32 + (koffB)); rb2 = *(const uint4*)(Bp + 2 * b32 + (koffB)); rb3 = *(const uint4*)(Bp + 3 * b32 + (koffB));
    GLOAD(0, 0)
    bf16_t* Asw = As + lrow * 72 + lc8;
    bf16_t* Bsw = Bs + lrow * 72 + lc8;
    for (int kt = 0; kt < nk; kt++) {
        *(uint4*)(Asw) = ra0; *(uint4*)(Asw + 32 * 72) = ra1; *(uint4*)(Asw + 64 * 72) = ra2; *(uint4*)(Asw + 96 * 72) = ra3;
        *(uint4*)(Bsw) = rb0; *(uint4*)(Bsw + 32 * 72) = rb1; *(uint4*)(Bsw + 64 * 72) = rb2; *(uint4*)(Bsw + 96 * 72) = rb3;
        __syncthreads();
        if (kt + 1 < nk) {
            GLOAD((size_t)(kt + 1) * p.akts, (size_t)(kt + 1) * 64)
        }
#pragma unroll
        for (int ks = 0; ks < 2; ks++) {
            bf16x8 af[4], bfr[4];
#pragma unroll
            for (int i = 0; i < 4; i++) af[i] = *(const bf16x8*)(As + (wm * 64 + i * 16 + (lane & 15)) * 72 + ks * 32 + (lane >> 4) * 8);
#pragma unroll
            for (int j = 0; j < 4; j++) bfr[j] = *(const bf16x8*)(Bs + (wn * 64 + j * 16 + (lane & 15)) * 72 + ks * 32 + (lane >> 4) * 8);
#pragma unroll
            for (int i = 0; i < 4; i++)
#pragma unroll
                for (int j = 0; j < 4; j++) acc[i][j] = __builtin_amdgcn_mfma_f32_16x16x32_bf16(af[i], bfr[j], acc[i][j], 0, 0, 0);
        }
        __syncthreads();
    }
#pragma unroll
    for (int i = 0; i < 4; i++)
#pragma unroll
        for (int j = 0; j < 4; j++)
#pragma unroll
            for (int r = 0; r < 4; r++) {
                int row = m0 + wm * 64 + i * 16 + (lane >> 4) * 4 + r;
                int col = n0 + wn * 64 + j * 16 + (lane & 15);
                float v = acc[i][j][r];
                if (EPI == EPI_PROJ) {
                    ((bf16_t*)p.out)[(size_t)row * PLD + col] = f2bf(v);
                } else if (EPI == EPI_HID) {
                    float bb = p.aux[(inst >> 2) * 256 + col];
                    ((bf16_t*)p.out)[((size_t)inst * 512 + row) * 256 + col] = f2bf(gelu_tanh(v + bb));
                } else if (EPI == EPI_OUT) {
                    ((float*)p.out)[(size_t)row * DM + col] = p.aux[(size_t)row * DM + col] + v;
                } else if (EPI == EPI_QRY) {
                    ((bf16_t*)p.out)[(size_t)row * 2048 + col] = f2bf(v);
                }
            }
}

__device__ __forceinline__ void d_knorm_rope(const bf16_t* __restrict__ proj, const float* __restrict__ kgain, bf16_t* __restrict__ ksn, bf16_t* __restrict__ kwn, int bid) {
    int vec = bid * 8 + (threadIdx.x >> 5);
    int i = threadIdx.x & 31;
    int which = vec >> 15;
    int rem = vec & 32767;
    int b = rem >> 14, g = (rem >> 13) & 1, s = rem & 8191;
    const bf16_t* src = proj + (size_t)(b * SEQ + s) * PLD + C_KV + 128 * (which ? 4 : 2) + 64 * g;
    float x1 = bf2f(src[i]), x2 = bf2f(src[i + 32]);
    float ss = x1 * x1 + x2 * x2;
#pragma unroll
    for (int o = 16; o > 0; o >>= 1) ss += __shfl_xor(ss, o);
    float r = rsqrtf(ss * (1.f / 64.f) + 1e-6f);
    const float* gn = kgain + (which ? 2 : 1) * 64;
    x1 = x1 * r * gn[i]; x2 = x2 * r * gn[i + 32];
    float inv = expf(-9.210340371976184f * (float)(2 * i) / 64.f);
    float ang = (float)s * inv;
    float sn, cs; sincosf(ang, &sn, &cs);
    bf16_t* dst = (which ? kwn : ksn) + ((size_t)(b * 2 + g) * SEQ + s) * 64;
    dst[i] = f2bf(x1 * cs - x2 * sn);
    dst[i + 32] = f2bf(x2 * cs + x1 * sn);
}

__device__ __forceinline__ void d_cmp2(const bf16_t* __restrict__ hid, const float* __restrict__ w2, const float* __restrict__ kgain, bf16_t* __restrict__ kc, bf16_t* __restrict__ vc, int bid) {
    int rowid = bid * 4 + (threadIdx.x >> 6);
    int lane = threadIdx.x & 63;
    int inst = rowid >> 9, n = rowid & 511;
    int j = inst >> 2, bg = inst & 3;
    if (n >= 511) return;
    const bf16_t* hr = hid + (size_t)rowid * 256;
    const float* w = w2 + (size_t)j * 256 * 64;
    float s = 0.f;
    for (int k = 0; k < 256; k++) s += bf2f(hr[k]) * w[k * 64 + lane];
    if (j == 0) {
        float ss = wave_sum(s * s);
        float r = rsqrtf(ss * (1.f / 64.f) + 1e-6f);
        float y = s * r * kgain[lane];
        float other = __shfl_xor(y, 32);
        int i = lane & 31;
        float inv = expf(-9.210340371976184f * (float)(2 * i) / 64.f);
        float ang = (float)(n * 16 + 31) * inv;
        float sn, cs; sincosf(ang, &sn, &cs);
        float o = (lane < 32) ? (y * cs - other * sn) : (y * cs + other * sn);
        kc[((size_t)bg * 512 + n) * 64 + lane] = f2bf(o);
    } else {
        vc[((size_t)bg * 512 + n) * 64 + lane] = f2bf(s);
    }
}

__device__ __forceinline__ float dot64(const float* q, const bf16_t* krow) {
    const uint4* kp = (const uint4*)krow;
    float s = 0.f;
#pragma unroll
    for (int c = 0; c < 8; c++) {
        uint4 u = kp[c];
        unsigned w[4] = {u.x, u.y, u.z, u.w};
#pragma unroll
        for (int e = 0; e < 4; e++) {
            s += q[c * 8 + e * 2] * __uint_as_float(w[e] << 16);
            s += q[c * 8 + e * 2 + 1] * __uint_as_float(w[e] & 0xffff0000u);
        }
    }
    return s;
}

__device__ __forceinline__ void d_nsa_naive(const bf16_t* __restrict__ proj, const float* __restrict__ qgain,
                                                   const bf16_t* __restrict__ ksn, const bf16_t* __restrict__ kwn,
                                                   const bf16_t* __restrict__ kc, const bf16_t* __restrict__ vc,
                                                   bf16_t* __restrict__ mix, int mix_ld, int bid, char* smem) {
    float (*qs)[64] = (float (*)[64])smem;
    float (*pbuf)[1024] = (float (*)[1024])(smem + 1024);
    float* sc = (float*)(smem + 1024 + 16384);
    int* sel = (int*)(smem + 1024 + 16384 + 512);
    const int tid = threadIdx.x, lane = tid & 63, w = tid >> 6;
    const int blk = bid;
    const int t = blk & 8191, g = (blk >> 13) & 1, b = blk >> 14;
    const int bg = b * 2 + g;
    const size_t row = (size_t)(b * SEQ + t);
    const int head = g * 4 + w;
    {
        int i = lane & 31;
        const bf16_t* src = proj + row * PLD + C_Q + head * 64;
        float x1 = bf2f(src[i]), x2 = bf2f(src[i + 32]);
        float ss = x1 * x1 + x2 * x2;
#pragma unroll
        for (int o = 16; o > 0; o >>= 1) ss += __shfl_xor(ss, o);
        float r = rsqrtf(ss * (1.f / 64.f) + 1e-6f);
        x1 = x1 * r * qgain[i]; x2 = x2 * r * qgain[i + 32];
        float inv = expf(-9.210340371976184f * (float)(2 * i) / 64.f);
        float ang = (float)t * inv;
        float sn, cs; sincosf(ang, &sn, &cs);
        if (lane < 32) { qs[w][i] = (x1 * cs - x2 * sn) * 0.125f; qs[w][i + 32] = (x2 * cs + x1 * sn) * 0.125f; }
    }
    __syncthreads();
    float q[64];
#pragma unroll
    for (int d = 0; d < 64; d++) q[d] = qs[w][d];
    float o_c = 0.f, o_s = 0.f, o_w = 0.f;
    const int nvis = (t >= 31) ? (((t - 31) >> 4) + 1) : 0;
    {
        float s[8];
        float m = -3e38f;
#pragma unroll
        for (int i = 0; i < 8; i++) {
            int n = lane + 64 * i;
            if (n < nvis) { s[i] = dot64(q, kc + ((size_t)bg * 512 + n) * 64); m = fmaxf(m, s[i]); } else s[i] = -3e38f;
        }
        m = wave_max(m);
        float l = 0.f;
#pragma unroll
        for (int i = 0; i < 8; i++) { int n = lane + 64 * i; s[i] = (n < nvis) ? __expf(s[i] - m) : 0.f; l += s[i]; }
        l = wave_sum(l);
        float il = (nvis > 0) ? 1.f / l : 0.f;
#pragma unroll
        for (int i = 0; i < 8; i++) pbuf[w][lane + 64 * i] = s[i] * il;
        __syncthreads();
        const bf16_t* vp = vc + (size_t)bg * 512 * 64 + lane;
        for (int n = 0; n < nvis; n++) o_c += pbuf[w][n] * bf2f(vp[(size_t)n * 64]);
    }
    if (tid < 128) {
        int j = tid;
        float im = 0.f;
#pragma unroll
        for (int h = 0; h < 4; h++) {
            float a = (j > 0) ? pbuf[h][4 * j - 1] : 0.f;
            im += a + 2.f * (pbuf[h][4 * j] + pbuf[h][4 * j + 1] + pbuf[h][4 * j + 2]) + pbuf[h][4 * j + 3];
        }
        int cur = t >> 6;
        float v;
        if (j > cur) v = -1e30f;
        else if (j == 0 || j == cur || j == cur - 1) v = 1e4f;
        else v = im;
        sc[j] = v;
    }
    __syncthreads();
    if (w == 0) {
        float v0 = sc[lane], v1 = sc[lane + 64];
        for (int it = 0; it < 16; it++) {
            float bv; int bi;
            if (v0 >= v1) { bv = v0; bi = lane; } else { bv = v1; bi = lane + 64; }
#pragma unroll
            for (int o = 32; o > 0; o >>= 1) {
                float ov = __shfl_xor(bv, o); int oi = __shfl_xor(bi, o);
                if (ov > bv || (ov == bv && oi < bi)) { bv = ov; bi = oi; }
            }
            if (lane == 0) sel[it] = (bv > -1e29f) ? bi : -1;
            if (bi == lane) v0 = -3e38f;
            if (bi == lane + 64) v1 = -3e38f;
        }
    }
    __syncthreads();
    {
        float s[16];
        float m = -3e38f;
#pragma unroll
        for (int i = 0; i < 16; i++) {
            int bk = sel[i];
            int pos = bk * 64 + lane;
            if (bk >= 0 && pos <= t) { s[i] = dot64(q, ksn + ((size_t)bg * SEQ + pos) * 64); m = fmaxf(m, s[i]); } else s[i] = -3e38f;
        }
        m = wave_max(m);
        float l = 0.f;
#pragma unroll
        for (int i = 0; i < 16; i++) { s[i] = (s[i] > -1e38f) ? __expf(s[i] - m) : 0.f; l += s[i]; }
        l = wave_sum(l);
        float il = 1.f / l;
#pragma unroll
        for (int i = 0; i < 16; i++) pbuf[w][i * 64 + lane] = s[i] * il;
        __syncthreads();
        for (int i = 0; i < 16; i++) {
            int bk = sel[i];
            if (bk < 0) continue;
            const bf16_t* vp = proj + (size_t)(b * SEQ + bk * 64) * PLD + C_KV + 128 * 3 + 64 * g + lane;
            int kmax = min(64, t - bk * 64 + 1);
            for (int kk = 0; kk < kmax; kk++) o_s += pbuf[w][i * 64 + kk] * bf2f(vp[(size_t)kk * PLD]);
        }
    }
    __syncthreads();
    {
        float s[8];
        float m = -3e38f;
        const int p0 = t - 511;
#pragma unroll
        for (int i = 0; i < 8; i++) {
            int pos = p0 + lane + 64 * i;
            if (pos >= 0) { s[i] = dot64(q, kwn + ((size_t)bg * SEQ + pos) * 64); m = fmaxf(m, s[i]); } else s[i] = -3e38f;
        }
        m = wave_max(m);
        float l = 0.f;
#pragma unroll
        for (int i = 0; i < 8; i++) { s[i] = (s[i] > -1e38f) ? __expf(s[i] - m) : 0.f; l += s[i]; }
        l = wave_sum(l);
        float il = 1.f / l;
#pragma unroll
        for (int i = 0; i < 8; i++) pbuf[w][lane + 64 * i] = s[i] * il;
        __syncthreads();
        int kstart = (p0 < 0) ? -p0 : 0;
        const bf16_t* vp = proj + (size_t)(b * SEQ) * PLD + C_KV + 128 * 5 + 64 * g + lane;
        for (int kk = kstart; kk < 512; kk++) o_w += pbuf[w][kk] * bf2f(vp[(size_t)(p0 + kk) * PLD]);
    }
    const bf16_t* gp = proj + row * PLD + C_GATE + head * 3;
    float g0 = sigmoidf_(bf2f(gp[0])), g1 = sigmoidf_(bf2f(gp[1])), g2 = sigmoidf_(bf2f(gp[2]));
    mix[row * mix_ld + head * 64 + lane] = f2bf(g0 * o_c + g1 * o_s + g2 * o_w);
}

typedef float f32x16 __attribute__((ext_vector_type(16)));
typedef short s16x4 __attribute__((ext_vector_type(4)));
typedef __bf16 bf16x2_t2 __attribute__((ext_vector_type(2)));
#define MFMA32(a, b, c) __builtin_amdgcn_mfma_f32_32x32x16_bf16((a), (b), (c), 0, 0, 0)
#define NKS 72
#define NSA_K_OFF 0
#define NSA_V_OFF (2 * 64 * NKS * 2)
#define NSA_IMP_OFF (NSA_V_OFF + 2 * 64 * NKS * 2)
#define NSA_SEL_OFF (NSA_IMP_OFF + 32 * 128 * 4)
#define NSA_LDS (NSA_SEL_OFF + 32 * 4 * 4)
#define NEGBIG (-1e30f)
__device__ __forceinline__ unsigned pk2(float a, float b) { bf16x2_t2 v; v[0] = (__bf16)a; v[1] = (__bf16)b; return __builtin_bit_cast(unsigned, v); }
__device__ __forceinline__ bf16x8 pack8(float a0, float a1, float a2, float a3, float a4, float a5, float a6, float a7) {
    uint4 u = make_uint4(pk2(a0, a1), pk2(a2, a3), pk2(a4, a5), pk2(a6, a7));
    return __builtin_bit_cast(bf16x8, u);
}
typedef unsigned u32x4 __attribute__((ext_vector_type(4)));
struct NsaStage { u32x4 k0, k1, v0, v1; };
struct NsaCtx {
    const bf16_t* Kbase; long kstride;
    const bf16_t* Vbase; long vstride;
    bf16_t* Kb; bf16_t* Vb;
    float* imp_s; unsigned* sel_s;
    bf16x8 qf[4];
    f32x16 O0, O1;
    float m, l, invl, carry;
    int t, tokl, hp, hh, c, lane;
};
__device__ __forceinline__ void nsa_stage_load(const NsaCtx& X, NsaStage& st, int j) {
    const int r0 = threadIdx.x >> 3, c8 = (threadIdx.x & 7) * 8;
    const bf16_t* kp = X.Kbase + (size_t)(64 * j + r0) * X.kstride + c8;
    const bf16_t* vp = X.Vbase + (size_t)(64 * j + r0) * X.vstride + c8;
    st.k0 = *(const u32x4*)kp; st.k1 = *(const u32x4*)(kp + 32 * X.kstride);
    st.v0 = *(const u32x4*)vp; st.v1 = *(const u32x4*)(vp + 32 * X.vstride);
}
__device__ __forceinline__ void nsa_stage_store(const NsaCtx& X, const NsaStage& st, int buf) {
    const int r0 = threadIdx.x >> 3, c8 = (threadIdx.x & 7) * 8;
    bf16_t* kb = X.Kb + buf * 64 * NKS + r0 * NKS + c8;
    bf16_t* vb = X.Vb + buf * 64 * NKS + r0 * NKS + c8;
    *(u32x4*)kb = st.k0; *(u32x4*)(kb + 32 * NKS) = st.k1;
    *(u32x4*)vb = st.v0; *(u32x4*)(vb + 32 * NKS) = st.v1;
}
template <int MODE>
__device__ __forceinline__ void nsa_tile(NsaCtx& X, int j, int kt, int buf, unsigned long long mlo, unsigned long long mhi) {
    const bf16_t* Kt = X.Kb + buf * 64 * NKS + (32 * kt) * NKS;
    const bf16_t* Vt = X.Vb + buf * 64 * NKS + (32 * kt) * NKS;
    f32x16 S;
#pragma unroll
    for (int i = 0; i < 16; i++) S[i] = 0.f;
#pragma unroll
    for (int s = 0; s < 4; s++) {
        bf16x8 ka = *(const bf16x8*)(Kt + X.c * NKS + 16 * s + 8 * X.hh);
        S = MFMA32(ka, X.qf[s], S);
    }
    const int kbase = 64 * j + 32 * kt;
    int lo = 0, hi;
    bool on = true;
    if (MODE <= 1) hi = ((X.t - 31) >> 4) - kbase;
    else hi = X.t - kbase;
    if (MODE == 3) lo = X.t - 511 - kbase;
    if (MODE == 2) {
        const unsigned long long wsel = (j < 64) ? mlo : mhi;
        on = (wsel >> (j & 63)) & 1ull;
    }
    lo -= 4 * X.hh; hi -= 4 * X.hh;
    if (!on) hi = -1000;
    float P[16];
    if (MODE == 1) {
#pragma unroll
        for (int i = 0; i < 16; i++) {
            const int cr = (i & 3) + 8 * (i >> 2);
            P[i] = (cr <= hi) ? __builtin_amdgcn_exp2f(S[i] - X.m) * X.invl : 0.f;
        }
        float mainv[4], nxt[4];
#pragma unroll
        for (int q = 0; q < 4; q++) { mainv[q] = 2.f * (P[4 * q] + P[4 * q + 1] + P[4 * q + 2]) + P[4 * q + 3]; nxt[q] = P[4 * q + 3]; }
#pragma unroll
        for (int q = 0; q < 4; q++) {
            mainv[q] += __shfl_xor(mainv[q], 1); mainv[q] += __shfl_xor(mainv[q], 2);
            nxt[q] += __shfl_xor(nxt[q], 1); nxt[q] += __shfl_xor(nxt[q], 2);
        }
        float recv[4];
#pragma unroll
        for (int q = 0; q < 4; q++) recv[q] = __shfl_xor(nxt[q], 32);
        const int jsel0 = 16 * j + 8 * kt + X.hh;
#pragma unroll
        for (int q = 0; q < 4; q++) {
            const float tot = mainv[q] + (X.hh ? recv[q] : (q > 0 ? recv[q > 0 ? q - 1 : 0] : X.carry));
            if (X.hp == 0) X.imp_s[X.tokl * 128 + jsel0 + 2 * q] = tot;
        }
        X.carry = recv[3];
    } else {
        float tmax = NEGBIG;
#pragma unroll
        for (int i = 0; i < 16; i++) {
            const int cr = (i & 3) + 8 * (i >> 2);
            const bool vis = (cr <= hi) && (cr >= lo);
            tmax = vis ? fmaxf(tmax, S[i]) : tmax;
        }
        tmax = fmaxf(tmax, __shfl_xor(tmax, 32));
        const float mnew = fmaxf(X.m, tmax);
        const float alpha = __builtin_amdgcn_exp2f(X.m - mnew);
        X.m = mnew;
        float ls = 0.f;
#pragma unroll
        for (int i = 0; i < 16; i++) {
            const int cr = (i & 3) + 8 * (i >> 2);
            const bool vis = (cr <= hi) && (cr >= lo);
            P[i] = vis ? __builtin_amdgcn_exp2f(S[i] - mnew) : 0.f;
            ls += P[i];
        }
        X.l = X.l * alpha + ls;
        if (MODE >= 2) {
#pragma unroll
            for (int i = 0; i < 16; i++) { X.O0[i] *= alpha; X.O1[i] *= alpha; }
        }
    }
    if (MODE >= 1) {
        bf16x8 pb0 = pack8(P[0], P[1], P[2], P[3], P[4], P[5], P[6], P[7]);
        bf16x8 pb1 = pack8(P[8], P[9], P[10], P[11], P[12], P[13], P[14], P[15]);
        const int l15 = X.lane & 15;
        const bf16_t* vrow = Vt + (4 * X.hh + (l15 >> 2)) * NKS + 16 * ((X.lane >> 4) & 1) + 4 * (l15 & 3);
#pragma unroll
        for (int s2 = 0; s2 < 2; s2++) {
#pragma unroll
            for (int dt = 0; dt < 2; dt++) {
                s16x4 lo4 = __builtin_amdgcn_ds_read_tr16_b64_v4i16((LAS3 s16x4*)(vrow + (16 * s2) * NKS + 32 * dt));
                s16x4 hi4 = __builtin_amdgcn_ds_read_tr16_b64_v4i16((LAS3 s16x4*)(vrow + (16 * s2 + 8) * NKS + 32 * dt));
                bf16x8 va = __builtin_shufflevector(lo4, hi4, 0, 1, 2, 3, 4, 5, 6, 7);
                if (dt == 0) X.O0 = MFMA32(va, s2 ? pb1 : pb0, X.O0); else X.O1 = MFMA32(va, s2 ? pb1 : pb0, X.O1);
            }
        }
    }
}
template <int MODE>
__device__ __forceinline__ void nsa_branch(NsaCtx& X, int jlo, int jhi, unsigned long long mlo, unsigned long long mhi, unsigned long long ulo, unsigned long long uhi) {
    NsaStage st;
    nsa_stage_load(X, st, jlo);
    __syncthreads();
    nsa_stage_store(X, st, jlo & 1);
    __syncthreads();
#pragma unroll 1
    for (int j = jlo; j <= jhi; j++) {
        if (j < jhi) nsa_stage_load(X, st, j + 1);
        bool need = true;
        if (MODE == 2) {
            const unsigned long long wsel = (j < 64) ? ulo : uhi;
            need = (wsel >> (j & 63)) & 1ull;
        }
        if (need) {
#pragma unroll 1
            for (int kt = 0; kt < 2; kt++) nsa_tile<MODE>(X, j, kt, j & 1, mlo, mhi);
        }
        if (j < jhi) nsa_stage_store(X, st, (j + 1) & 1);
        __syncthreads();
    }
}
__device__ __forceinline__ void nsa_accum(f32x16& f0, f32x16& f1, const NsaCtx& X, float scale) {
#pragma unroll
    for (int i = 0; i < 16; i++) { f0[i] += X.O0[i] * scale; f1[i] += X.O1[i] * scale; }
}
__device__ __forceinline__ void d_nsa_mfma(const bf16_t* __restrict__ proj, const float* __restrict__ qgain, const float2* __restrict__ rope,
                                           const bf16_t* __restrict__ ksn, const bf16_t* __restrict__ kwn,
                                           const bf16_t* __restrict__ kc, const bf16_t* __restrict__ vc,
                                           bf16_t* __restrict__ mixo, int mix_ld, int item, char* smem) {
    NsaCtx X;
    const int tid = threadIdx.x, lane = tid & 63, w = tid >> 6;
    const int bg = item & 3, tile = 255 - (item >> 2);
    const int b = bg >> 1, g = bg & 1, t0 = tile * 32;
    X.lane = lane; X.c = lane & 31; X.hh = lane >> 5; X.hp = X.c & 3; X.tokl = 8 * w + (X.c >> 2); X.t = t0 + X.tokl;
    X.Kb = (bf16_t*)(smem + NSA_K_OFF); X.Vb = (bf16_t*)(smem + NSA_V_OFF);
    X.imp_s = (float*)(smem + NSA_IMP_OFF); X.sel_s = (unsigned*)(smem + NSA_SEL_OFF);
    const int head = g * 4 + X.hp;
    const size_t row = (size_t)(b * SEQ + X.t);
    {
        float y[4][8];
        const bf16_t* qsrc = proj + row * PLD + C_Q + head * 64 + 8 * X.hh;
        float ss = 0.f;
#pragma unroll
        for (int s = 0; s < 4; s++) {
            const uint4 u = *(const uint4*)(qsrc + 16 * s);
            const unsigned wv[4] = {u.x, u.y, u.z, u.w};
#pragma unroll
            for (int e = 0; e < 4; e++) { y[s][2 * e] = __uint_as_float(wv[e] << 16); y[s][2 * e + 1] = __uint_as_float(wv[e] & 0xffff0000u); }
#pragma unroll
            for (int e = 0; e < 8; e++) ss += y[s][e] * y[s][e];
        }
        ss += __shfl_xor(ss, 32);
        const float r = rsqrtf(ss * (1.f / 64.f) + 1e-6f);
#pragma unroll
        for (int s = 0; s < 4; s++)
#pragma unroll
            for (int e = 0; e < 8; e++) y[s][e] *= r * qgain[16 * s + 8 * X.hh + e];
        const float qs = 0.125f * 1.4426950408889634f;
#pragma unroll
        for (int s = 0; s < 2; s++)
#pragma unroll
            for (int e = 0; e < 8; e++) {
                const float2 cs = rope[(size_t)X.t * 32 + 16 * s + 8 * X.hh + e];
                const float x1 = y[s][e], x2 = y[s + 2][e];
                y[s][e] = (x1 * cs.x - x2 * cs.y) * qs; y[s + 2][e] = (x2 * cs.x + x1 * cs.y) * qs;
            }
#pragma unroll
        for (int s = 0; s < 4; s++) X.qf[s] = pack8(y[s][0], y[s][1], y[s][2], y[s][3], y[s][4], y[s][5], y[s][6], y[s][7]);
    }
    const bf16_t* gp = proj + row * PLD + C_GATE + head * 3;
    const float g0 = sigmoidf_(bf2f(gp[0])), g1 = sigmoidf_(bf2f(gp[1])), g2 = sigmoidf_(bf2f(gp[2]));
    f32x16 F0, F1;
#pragma unroll
    for (int i = 0; i < 16; i++) { F0[i] = 0.f; F1[i] = 0.f; }
    const int cur = t0 >> 6;
    {
        X.Kbase = kc + (size_t)bg * 512 * 64; X.kstride = 64; X.Vbase = vc + (size_t)bg * 512 * 64; X.vstride = 64;
        const int nvmax = (t0 >> 4) + 1, jhi = (nvmax - 1) >> 6;
        X.m = NEGBIG; X.l = 0.f;
        nsa_branch<0>(X, 0, jhi, 0ull, 0ull, 0ull, 0ull);
        const float lt = X.l + __shfl_xor(X.l, 32);
        X.invl = (lt > 0.f) ? 1.f / lt : 0.f;
        X.carry = 0.f;
#pragma unroll
        for (int i = 0; i < 16; i++) { X.O0[i] = 0.f; X.O1[i] = 0.f; }
        nsa_branch<1>(X, 0, jhi, 0ull, 0ull, 0ull, 0ull);
        nsa_accum(F0, F1, X, g0);
    }
    unsigned long long mlo, mhi, ulo, uhi;
    {
        const int tk2 = lane >> 3, sub = lane & 7;
        unsigned k0 = 1u, k1 = 0u, k2 = 0u, k3 = 0u;
#define SETBIT(jj) { const int _j = (jj); if (_j < 32) k0 |= 1u << _j; else if (_j < 64) k1 |= 1u << (_j - 32); else if (_j < 96) k2 |= 1u << (_j - 64); else k3 |= 1u << (_j - 96); }
        SETBIT(cur);
        if (cur >= 1) SETBIT(cur - 1);
        const int ncand = cur - 2;
        if (ncand > 0) {
            if (ncand <= 13) {
                for (int jj = 1; jj <= cur - 2; jj++) SETBIT(jj);
            } else {
                float sc[16];
#pragma unroll
                for (int i = 0; i < 16; i++) { const int jj = sub + 8 * i; sc[i] = (jj >= 1 && jj <= cur - 2) ? X.imp_s[(8 * w + tk2) * 128 + jj] : -3e38f; }
#pragma unroll 1
                for (int it = 0; it < 13; it++) {
                    float bv = sc[0]; int bi = 0;
#pragma unroll
                    for (int i = 1; i < 16; i++) if (sc[i] > bv) { bv = sc[i]; bi = i; }
                    int bj = sub + 8 * bi;
#pragma unroll
                    for (int o = 1; o < 8; o <<= 1) {
                        const float ov = __shfl_xor(bv, o); const int oj = __shfl_xor(bj, o);
                        if (ov > bv || (ov == bv && oj < bj)) { bv = ov; bj = oj; }
                    }
                    SETBIT(bj);
#pragma unroll
                    for (int i = 0; i < 16; i++) if (bj == sub + 8 * i) sc[i] = -3e38f;
                }
            }
        }
#undef SETBIT
        if (sub == 0) { unsigned* d = X.sel_s + (8 * w + tk2) * 4; d[0] = k0; d[1] = k1; d[2] = k2; d[3] = k3; }
        __builtin_amdgcn_s_waitcnt(0xc07f);
        const unsigned* sp = X.sel_s + X.tokl * 4;
        const unsigned m0 = sp[0], m1 = sp[1], m2 = sp[2], m3 = sp[3];
        mlo = (unsigned long long)m0 | ((unsigned long long)m1 << 32); mhi = (unsigned long long)m2 | ((unsigned long long)m3 << 32);
        unsigned u0 = m0, u1 = m1, u2 = m2, u3 = m3;
#pragma unroll
        for (int o = 4; o < 32; o <<= 1) { u0 |= __shfl_xor(u0, o); u1 |= __shfl_xor(u1, o); u2 |= __shfl_xor(u2, o); u3 |= __shfl_xor(u3, o); }
        ulo = (unsigned long long)(unsigned)__builtin_amdgcn_readfirstlane(u0) | ((unsigned long long)(unsigned)__builtin_amdgcn_readfirstlane(u1) << 32);
        uhi = (unsigned long long)(unsigned)__builtin_amdgcn_readfirstlane(u2) | ((unsigned long long)(unsigned)__builtin_amdgcn_readfirstlane(u3) << 32);
    }
    {
        X.Kbase = ksn + (size_t)bg * SEQ * 64; X.kstride = 64;
        X.Vbase = proj + (size_t)(b * SEQ) * PLD + C_KV + 128 * 3 + 64 * g; X.vstride = PLD;
        X.m = NEGBIG; X.l = 0.f;
#pragma unroll
        for (int i = 0; i < 16; i++) { X.O0[i] = 0.f; X.O1[i] = 0.f; }
        nsa_branch<2>(X, 0, cur, mlo, mhi, ulo, uhi);
        const float lt = X.l + __shfl_xor(X.l, 32);
        nsa_accum(F0, F1, X, (lt > 0.f) ? g1 / lt : 0.f);
    }
    {
        X.Kbase = kwn + (size_t)bg * SEQ * 64; X.kstride = 64;
        X.Vbase = proj + (size_t)(b * SEQ) * PLD + C_KV + 128 * 5 + 64 * g; X.vstride = PLD;
        X.m = NEGBIG; X.l = 0.f;
#pragma unroll
        for (int i = 0; i < 16; i++) { X.O0[i] = 0.f; X.O1[i] = 0.f; }
        const int jlo = (t0 >= 511) ? ((t0 - 511) >> 6) : 0;
        nsa_branch<3>(X, jlo, cur, 0ull, 0ull, 0ull, 0ull);
        const float lt = X.l + __shfl_xor(X.l, 32);
        nsa_accum(F0, F1, X, (lt > 0.f) ? g2 / lt : 0.f);
    }
    bf16_t* dst = mixo + row * mix_ld + head * 64 + 4 * X.hh;
#pragma unroll
    for (int q4 = 0; q4 < 4; q4++) {
        *(uint2*)(dst + 8 * q4) = make_uint2(pk2(F0[4 * q4], F0[4 * q4 + 1]), pk2(F0[4 * q4 + 2], F0[4 * q4 + 3]));
        *(uint2*)(dst + 32 + 8 * q4) = make_uint2(pk2(F1[4 * q4], F1[4 * q4 + 1]), pk2(F1[4 * q4 + 2], F1[4 * q4 + 3]));
    }
}

#define KLS 136
#define XSS 264
#define GDN_PREP_LDS (2 * 64 * KLS * 2 + 64 * XSS * 2 + 512)
__device__ __forceinline__ unsigned pack2bf(float lo, float hi) { return (unsigned)f2bf(lo) | ((unsigned)f2bf(hi) << 16); }
__device__ __forceinline__ void d_gdn_prep2(const bf16_t* __restrict__ proj, const float* __restrict__ conv_w,
                                            const float* __restrict__ a_log, const float* __restrict__ dt_bias,
                                            bf16_t* __restrict__ guT, bf16_t* __restrict__ gw, bf16_t* __restrict__ gqd,
                                            bf16_t* __restrict__ gkdT, bf16_t* __restrict__ gin, float* __restrict__ gl, int chunk, char* smem) {
    bf16_t* kL = (bf16_t*)smem;
    bf16_t* qL = kL + 64 * KLS;
    float* AmT = (float*)qL;
    bf16_t* xs = qL + 64 * KLS;
    float* gcs = (float*)(xs + 64 * XSS);
    float* bts = gcs + 64;
    const int tid = threadIdx.x, lane = tid & 63, w = tid >> 6;
    const int n = chunk & 127, h = (chunk >> 7) & 3, b = chunk >> 9;
    const int t0 = n * 64;
    const size_t rbase = (size_t)(b * SEQ + t0);
    if (tid < 64) {
        const size_t r = (rbase + tid) * PLD;
        float a = bf2f(proj[r + C_A + h]), bb = bf2f(proj[r + C_B + h]);
        float xx = a + dt_bias[h];
        float sp = (xx > 20.f) ? xx : log1pf(__expf(xx));
        float c = -__expf(a_log[h]) * sp;
#pragma unroll
        for (int o = 1; o < 64; o <<= 1) { float nb = __shfl_up(c, o); if (lane >= o) c += nb; }
        gcs[tid] = c; bts[tid] = sigmoidf_(bb);
    }
    __syncthreads();
    {
        float wt[6][4], x0[6], x1[6], x2[6];
        int ch[6];
#pragma unroll
        for (int c6 = 0; c6 < 6; c6++) {
            ch[c6] = (c6 >> 1) * 512 + h * 128 + lane + 64 * (c6 & 1);
#pragma unroll
            for (int j = 0; j < 4; j++) wt[c6][j] = conv_w[j * 1536 + ch[c6]];
            const int tb = t0 + 16 * w - 3;
            x0[c6] = (tb >= 0) ? bf2f(proj[((size_t)(b * SEQ + tb)) * PLD + C_GQKV + ch[c6]]) : 0.f;
            x1[c6] = (tb + 1 >= 0) ? bf2f(proj[((size_t)(b * SEQ + tb + 1)) * PLD + C_GQKV + ch[c6]]) : 0.f;
            x2[c6] = (tb + 2 >= 0) ? bf2f(proj[((size_t)(b * SEQ + tb + 2)) * PLD + C_GQKV + ch[c6]]) : 0.f;
        }
        for (int i = 16 * w; i < 16 * w + 16; i++) {
            float sv[6];
#pragma unroll
            for (int c6 = 0; c6 < 6; c6++) {
                float xn = bf2f(proj[(rbase + i) * PLD + C_GQKV + ch[c6]]);
                float cv = x0[c6] * wt[c6][0] + x1[c6] * wt[c6][1] + x2[c6] * wt[c6][2] + xn * wt[c6][3];
                x0[c6] = x1[c6]; x1[c6] = x2[c6]; x2[c6] = xn;
                sv[c6] = cv * sigmoidf_(cv);
            }
            float rq = rsqrtf(wave_sum(sv[0] * sv[0] + sv[1] * sv[1]) + 1e-6f) * 0.08838834764831845f;
            float rk = rsqrtf(wave_sum(sv[2] * sv[2] + sv[3] * sv[3]) + 1e-6f);
            const float bi = bts[i], ei = __expf(gcs[i]);
            float q0 = sv[0] * rq, q1 = sv[1] * rq, k0 = sv[2] * rk, k1 = sv[3] * rk;
            qL[i * KLS + lane] = f2bf(q0); qL[i * KLS + lane + 64] = f2bf(q1);
            kL[i * KLS + lane] = f2bf(k0); kL[i * KLS + lane + 64] = f2bf(k1);
            xs[i * XSS + lane] = f2bf(sv[4] * bi); xs[i * XSS + lane + 64] = f2bf(sv[5] * bi);
            xs[i * XSS + 128 + lane] = f2bf(k0 * bi * ei); xs[i * XSS + 192 + lane] = f2bf(k1 * bi * ei);
            bf16_t* qd = gqd + (size_t)chunk * 8192 + i * 128;
            qd[lane] = f2bf(q0 * ei); qd[lane + 64] = f2bf(q1 * ei);
        }
    }
    __syncthreads();
    const int n16 = lane & 15, kq = lane >> 4;
    f32x4 aqk[4], akk[4];
#pragma unroll
    for (int tj = 0; tj < 4; tj++) { aqk[tj] = (f32x4){0.f, 0.f, 0.f, 0.f}; akk[tj] = (f32x4){0.f, 0.f, 0.f, 0.f}; }
#pragma unroll
    for (int ks = 0; ks < 4; ks++) {
        bf16x8 qa = *(const bf16x8*)(qL + (16 * w + n16) * KLS + 32 * ks + 8 * kq);
        bf16x8 ka = *(const bf16x8*)(kL + (16 * w + n16) * KLS + 32 * ks + 8 * kq);
#pragma unroll
        for (int tj = 0; tj < 4; tj++) {
            bf16x8 kb = *(const bf16x8*)(kL + (16 * tj + n16) * KLS + 32 * ks + 8 * kq);
            aqk[tj] = __builtin_amdgcn_mfma_f32_16x16x32_bf16(qa, kb, aqk[tj], 0, 0, 0);
            akk[tj] = __builtin_amdgcn_mfma_f32_16x16x32_bf16(ka, kb, akk[tj], 0, 0, 0);
        }
    }
    {
        const float glast = gcs[63];
        const int kidx = tid >> 1, c0 = (tid & 1) * 32;
        unsigned pk[16];
#pragma unroll
        for (int cc = 0; cc < 32; cc += 2) {
            float v0 = bf2f(kL[(c0 + cc) * KLS + kidx]) * __expf(glast - gcs[c0 + cc]);
            float v1 = bf2f(kL[(c0 + cc + 1) * KLS + kidx]) * __expf(glast - gcs[c0 + cc + 1]);
            pk[cc >> 1] = pack2bf(v0, v1);
        }
        uint4* dst = (uint4*)(gkdT + (size_t)chunk * 8192 + kidx * 64 + c0);
#pragma unroll
        for (int v4 = 0; v4 < 4; v4++) dst[v4] = make_uint4(pk[4 * v4], pk[4 * v4 + 1], pk[4 * v4 + 2], pk[4 * v4 + 3]);
        if (tid == 0) gl[chunk] = __expf(glast);
    }
    __syncthreads();
#pragma unroll
    for (int tj = 0; tj < 4; tj++)
#pragma unroll
        for (int r = 0; r < 4; r++) {
            const int i = 16 * w + 4 * kq + r, j = 16 * tj + n16;
            const float dec = (j <= i) ? __expf(gcs[i] - gcs[j]) : 0.f;
            gin[(size_t)chunk * 4096 + i * 64 + j] = f2bf(aqk[tj][r] * dec);
            AmT[j * 64 + i] = (j < i) ? bts[i] * akk[tj][r] * dec : 0.f;
        }
    __syncthreads();
    {
        const int c = tid;
#pragma unroll 1
        for (int blk = 0; blk < 8; blk++) {
            const int i0 = blk * 8;
            float acc[8];
#pragma unroll
            for (int r = 0; r < 8; r++) acc[r] = bf2f(xs[(i0 + r) * XSS + c]);
            for (int j = 0; j < i0; j++) {
                const float xj = bf2f(xs[j * XSS + c]);
                const float4 a0 = *(const float4*)(AmT + j * 64 + i0), a1 = *(const float4*)(AmT + j * 64 + i0 + 4);
                acc[0] -= a0.x * xj; acc[1] -= a0.y * xj; acc[2] -= a0.z * xj; acc[3] -= a0.w * xj;
                acc[4] -= a1.x * xj; acc[5] -= a1.y * xj; acc[6] -= a1.z * xj; acc[7] -= a1.w * xj;
            }
#pragma unroll
            for (int r = 1; r < 8; r++)
#pragma unroll
                for (int s2 = 0; s2 < r; s2++) acc[r] -= AmT[(i0 + s2) * 64 + i0 + r] * acc[s2];
#pragma unroll
            for (int r = 0; r < 8; r++) xs[(i0 + r) * XSS + c] = f2bf(acc[r]);
            if (c < 128) {
                *(uint4*)(guT + (size_t)chunk * 8192 + c * 64 + i0) =
                    make_uint4(pack2bf(acc[0], acc[1]), pack2bf(acc[2], acc[3]), pack2bf(acc[4], acc[5]), pack2bf(acc[6], acc[7]));
            } else {
#pragma unroll
                for (int r = 0; r < 8; r++) gw[(size_t)chunk * 8192 + (i0 + r) * 128 + (c - 128)] = f2bf(acc[r]);
            }
        }
    }
}

struct GdnFrag { bf16x8 wA[4], qA[4], inA[2], kdA[2][2]; uint2 uC; float glv; };
__device__ __forceinline__ void gdn_load_frag(GdnFrag& f, const bf16_t* __restrict__ guT, const bf16_t* __restrict__ gw, const bf16_t* __restrict__ gqd,
                                              const bf16_t* __restrict__ gkdT, const bf16_t* __restrict__ gin, const float* __restrict__ gl,
                                              int chunk, int w, int sl, int n16, int kq) {
    const size_t cb = (size_t)chunk * 8192;
#pragma unroll
    for (int ks = 0; ks < 4; ks++) {
        f.wA[ks] = *(const bf16x8*)(gw + cb + (16 * w + n16) * 128 + 32 * ks + 8 * kq);
        f.qA[ks] = *(const bf16x8*)(gqd + cb + (16 * w + n16) * 128 + 32 * ks + 8 * kq);
    }
#pragma unroll
    for (int ks = 0; ks < 2; ks++) {
        f.inA[ks] = *(const bf16x8*)(gin + (size_t)chunk * 4096 + (16 * w + n16) * 64 + 32 * ks + 8 * kq);
        f.kdA[0][ks] = *(const bf16x8*)(gkdT + cb + (32 * w + n16) * 64 + 32 * ks + 8 * kq);
        f.kdA[1][ks] = *(const bf16x8*)(gkdT + cb + (32 * w + 16 + n16) * 64 + 32 * ks + 8 * kq);
    }
    f.uC = *(const uint2*)(guT + cb + (16 * sl + n16) * 64 + 16 * w + 4 * kq);
    f.glv = gl[chunk];
}
#define STS 144
#define VNS 80
__device__ __forceinline__ void gdn_step(const GdnFrag& f, f32x4& S0, f32x4& S1, bf16_t* StT, bf16_t* vnT, float* __restrict__ ogrow, int w, int n16, int kq) {
    f32x4 ws = (f32x4){0.f, 0.f, 0.f, 0.f}, qs = (f32x4){0.f, 0.f, 0.f, 0.f};
#pragma unroll
    for (int ks = 0; ks < 4; ks++) {
        bf16x8 sb = *(const bf16x8*)(StT + n16 * STS + 32 * ks + 8 * kq);
        ws = __builtin_amdgcn_mfma_f32_16x16x32_bf16(f.wA[ks], sb, ws, 0, 0, 0);
        qs = __builtin_amdgcn_mfma_f32_16x16x32_bf16(f.qA[ks], sb, qs, 0, 0, 0);
    }
    float v0 = __uint_as_float(f.uC.x << 16) - ws[0], v1 = __uint_as_float(f.uC.x & 0xffff0000u) - ws[1];
    float v2 = __uint_as_float(f.uC.y << 16) - ws[2], v3 = __uint_as_float(f.uC.y & 0xffff0000u) - ws[3];
    *(uint2*)(vnT + n16 * VNS + 16 * w + 4 * kq) = make_uint2(pack2bf(v0, v1), pack2bf(v2, v3));
    __syncthreads();
    bf16x8 vb0 = *(const bf16x8*)(vnT + n16 * VNS + 8 * kq), vb1 = *(const bf16x8*)(vnT + n16 * VNS + 32 + 8 * kq);
    qs = __builtin_amdgcn_mfma_f32_16x16x32_bf16(f.inA[0], vb0, qs, 0, 0, 0);
    qs = __builtin_amdgcn_mfma_f32_16x16x32_bf16(f.inA[1], vb1, qs, 0, 0, 0);
    S0 = S0 * f.glv; S1 = S1 * f.glv;
    S0 = __builtin_amdgcn_mfma_f32_16x16x32_bf16(f.kdA[0][0], vb0, S0, 0, 0, 0);
    S0 = __builtin_amdgcn_mfma_f32_16x16x32_bf16(f.kdA[0][1], vb1, S0, 0, 0, 0);
    S1 = __builtin_amdgcn_mfma_f32_16x16x32_bf16(f.kdA[1][0], vb0, S1, 0, 0, 0);
    S1 = __builtin_amdgcn_mfma_f32_16x16x32_bf16(f.kdA[1][1], vb1, S1, 0, 0, 0);
#pragma unroll
    for (int r = 0; r < 4; r++) ogrow[(size_t)(4 * kq + r) * 512] = qs[r];
    *(uint2*)(StT + n16 * STS + 32 * w + 4 * kq) = make_uint2(pack2bf(S0[0], S0[1]), pack2bf(S0[2], S0[3]));
    *(uint2*)(StT + n16 * STS + 32 * w + 16 + 4 * kq) = make_uint2(pack2bf(S1[0], S1[1]), pack2bf(S1[2], S1[3]));
    __syncthreads();
}
__device__ __forceinline__ void d_gdn_scan2(const bf16_t* __restrict__ guT, const bf16_t* __restrict__ gw, const bf16_t* __restrict__ gqd,
                                            const bf16_t* __restrict__ gkdT, const bf16_t* __restrict__ gin, const float* __restrict__ gl,
                                            float* __restrict__ og, int item, char* smem) {
    bf16_t* StT = (bf16_t*)smem;
    bf16_t* vnT = StT + 16 * STS;
    const int tid = threadIdx.x, lane = tid & 63, w = tid >> 6, n16 = lane & 15, kq = lane >> 4;
    const int bh = item >> 3, sl = item & 7, b = bh >> 2, h = bh & 3;
    for (int i = tid; i < 16 * STS / 2; i += 256) ((unsigned*)StT)[i] = 0u;
    f32x4 S0 = (f32x4){0.f, 0.f, 0.f, 0.f}, S1 = (f32x4){0.f, 0.f, 0.f, 0.f};
    GdnFrag fa, fb;
    gdn_load_frag(fa, guT, gw, gqd, gkdT, gin, gl, bh * 128, w, sl, n16, kq);
    __syncthreads();
    float* obase = og + (size_t)(b * SEQ + 16 * w) * 512 + h * 128 + 16 * sl + n16;
#pragma unroll 1
    for (int n = 0; n < 128; n += 2) {
        gdn_load_frag(fb, guT, gw, gqd, gkdT, gin, gl, bh * 128 + n + 1, w, sl, n16, kq);
        gdn_step(fa, S0, S1, StT, vnT, obase + (size_t)(n * 64) * 512, w, n16, kq);
        if (n + 2 < 128) gdn_load_frag(fa, guT, gw, gqd, gkdT, gin, gl, bh * 128 + n + 2, w, sl, n16, kq);
        gdn_step(fb, S0, S1, StT, vnT, obase + (size_t)((n + 1) * 64) * 512, w, n16, kq);
    }
}

__device__ __forceinline__ void d_gdn_out(const float* __restrict__ og, const bf16_t* __restrict__ proj, const float* __restrict__ gain, bf16_t* __restrict__ mix, int bid) {
    int id = bid * 4 + (threadIdx.x >> 6);
    int lane = threadIdx.x & 63;
    int t = id >> 2, h = id & 3;
    const float* o = og + (size_t)t * 512 + h * 128;
    float a0 = o[lane], a1 = o[lane + 64];
    float ss = wave_sum(a0 * a0 + a1 * a1);
    float r = rsqrtf(ss * (1.f / 128.f) + 1e-6f);
    const bf16_t* z = proj + (size_t)t * PLD + C_Z + h * 128;
    float z0 = bf2f(z[lane]), z1 = bf2f(z[lane + 64]);
    mix[(size_t)t * DM + 512 + h * 128 + lane] = f2bf(a0 * r * gain[lane] * z0 * sigmoidf_(z0));
    mix[(size_t)t * DM + 512 + h * 128 + lane + 64] = f2bf(a1 * r * gain[lane + 64] * z1 * sigmoidf_(z1));
}

__device__ __forceinline__ void d_peer_route(const bf16_t* __restrict__ qry, const float* __restrict__ subkeys, int* __restrict__ eidx, float* __restrict__ pgate, int bid, char* smem) {
    float (*qsh)[256] = (float (*)[256])smem;
    float (*tv)[2][16] = (float (*)[2][16])(smem + 4096);
    int (*ti)[2][16] = (int (*)[2][16])(smem + 4096 + 512);
    const int lane = threadIdx.x & 63, w = threadIdx.x >> 6;
    const int id = bid * 4 + w;
    const int t = id >> 3, h = id & 7;
    const bf16_t* qp = qry + (size_t)t * 2048 + h * 256;
#pragma unroll
    for (int i = 0; i < 4; i++) qsh[w][lane + 64 * i] = bf2f(qp[lane + 64 * i]);
    __syncthreads();
    for (int half = 0; half < 2; half++) {
        const float* sk0 = subkeys + ((size_t)half * 128 + lane) * 128;
        const float* sk1 = sk0 + 64 * 128;
        float s0 = 0.f, s1 = 0.f;
        for (int d = 0; d < 128; d += 4) {
            float4 a = *(const float4*)(sk0 + d), c = *(const float4*)(sk1 + d);
            float4 qq = *(const float4*)(&qsh[w][half * 128 + d]);
            s0 += a.x * qq.x + a.y * qq.y + a.z * qq.z + a.w * qq.w;
            s1 += c.x * qq.x + c.y * qq.y + c.z * qq.z + c.w * qq.w;
        }
        for (int it = 0; it < 16; it++) {
            float bv; int bi;
            if (s0 >= s1) { bv = s0; bi = lane; } else { bv = s1; bi = lane + 64; }
#pragma unroll
            for (int o = 32; o > 0; o >>= 1) {
                float ov = __shfl_xor(bv, o); int oi = __shfl_xor(bi, o);
                if (ov > bv || (ov == bv && oi < bi)) { bv = ov; bi = oi; }
            }
            if (lane == 0) { tv[w][half][it] = bv; ti[w][half][it] = bi; }
            if (bi == lane) s0 = -3e38f;
            if (bi == lane + 64) s1 = -3e38f;
        }
    }
    __syncthreads();
    float cv[4];
#pragma unroll
    for (int i = 0; i < 4; i++) { int f = lane * 4 + i; cv[i] = tv[w][0][f >> 4] + tv[w][1][f & 15]; }
    float topv = 0.f; int tope = 0;
    float mx = 0.f;
    for (int it = 0; it < 16; it++) {
        float bv = cv[0]; int bi = lane * 4;
#pragma unroll
        for (int i = 1; i < 4; i++) if (cv[i] > bv) { bv = cv[i]; bi = lane * 4 + i; }
#pragma unroll
        for (int o = 32; o > 0; o >>= 1) {
            float ov = __shfl_xor(bv, o); int oi = __shfl_xor(bi, o);
            if (ov > bv || (ov == bv && oi < bi)) { bv = ov; bi = oi; }
        }
        if (it == 0) mx = bv;
        if (lane == it) { topv = bv; tope = ti[w][0][bi >> 4] * 128 + ti[w][1][bi & 15]; }
#pragma unroll
        for (int i = 0; i < 4; i++) if (bi == lane * 4 + i) cv[i] = -3e38f;
    }
    float e = (lane < 16) ? __expf(topv - mx) : 0.f;
    float sum = wave_sum(e);
    if (lane < 16) {
        eidx[(size_t)t * 128 + h * 16 + lane] = tope;
        pgate[(size_t)t * 128 + h * 16 + lane] = e / sum;
    }
}

__device__ __forceinline__ void d_peer_expert(const bf16_t* __restrict__ h2, const int* __restrict__ eidx, const float* __restrict__ pgate,
                                                     const float* __restrict__ utab, const float* __restrict__ vtab, float* __restrict__ out, int bid, char* smem) {
    float (*red)[1024] = (float (*)[1024])smem;
    const int t = bid;
    const int lane = threadIdx.x & 63, w = threadIdx.x >> 6;
    float x[16], acc[16];
#pragma unroll
    for (int i = 0; i < 4; i++) {
        ushort4 u = ((const ushort4*)(h2 + (size_t)t * DM))[lane + 64 * i];
        x[i * 4 + 0] = bf2f(u.x); x[i * 4 + 1] = bf2f(u.y); x[i * 4 + 2] = bf2f(u.z); x[i * 4 + 3] = bf2f(u.w);
    }
#pragma unroll
    for (int i = 0; i < 16; i++) acc[i] = 0.f;
    for (int k = 0; k < 32; k++) {
        int e = eidx[(size_t)t * 128 + w * 32 + k];
        float gt = pgate[(size_t)t * 128 + w * 32 + k];
        const float4* ur = (const float4*)(utab + (size_t)e * DM);
        float d = 0.f;
#pragma unroll
        for (int i = 0; i < 4; i++) {
            float4 u = ur[lane + 64 * i];
            d += u.x * x[i * 4] + u.y * x[i * 4 + 1] + u.z * x[i * 4 + 2] + u.w * x[i * 4 + 3];
        }
        d = wave_sum(d);
        float coef = gt * gelu_tanh(d);
        const float4* vr = (const float4*)(vtab + (size_t)e * DM);
#pragma unroll
        for (int i = 0; i < 4; i++) {
            float4 v = vr[lane + 64 * i];
            acc[i * 4] += coef * v.x; acc[i * 4 + 1] += coef * v.y; acc[i * 4 + 2] += coef * v.z; acc[i * 4 + 3] += coef * v.w;
        }
    }
#pragma unroll
    for (int i = 0; i < 4; i++) *(float4*)(&red[w][(lane + 64 * i) * 4]) = make_float4(acc[i * 4], acc[i * 4 + 1], acc[i * 4 + 2], acc[i * 4 + 3]);
    __syncthreads();
    for (int c = threadIdx.x; c < 1024; c += 256) {
        out[(size_t)t * DM + c] += red[0][c] + red[1][c] + red[2][c] + red[3][c];
    }
}

template <int CTRL> __device__ __forceinline__ float dppf(float x) { return __builtin_bit_cast(float, __builtin_amdgcn_update_dpp(0, __builtin_bit_cast(int, x), CTRL, 0xf, 0xf, true)); }
template <int CTRL> __device__ __forceinline__ unsigned dppu(unsigned x) { return (unsigned)__builtin_amdgcn_update_dpp(0, (int)x, CTRL, 0xf, 0xf, true); }
__device__ __forceinline__ float allmax16(float x) {
    x = fmaxf(x, dppf<0xB1>(x)); x = fmaxf(x, dppf<0x4E>(x)); x = fmaxf(x, dppf<0x141>(x)); x = fmaxf(x, dppf<0x140>(x)); return x;
}
__device__ __forceinline__ unsigned allmaxu16(unsigned x) {
    x = max(x, dppu<0xB1>(x)); x = max(x, dppu<0x4E>(x)); x = max(x, dppu<0x141>(x)); x = max(x, dppu<0x140>(x)); return x;
}
__device__ __forceinline__ float allsum16(float x) {
    x += dppf<0xB1>(x); x += dppf<0x4E>(x); x += dppf<0x141>(x); x += dppf<0x140>(x); return x;
}
__device__ __forceinline__ void route_load_subkeys(const float* __restrict__ subkeys, char* smem) {
    for (int idx = threadIdx.x; idx < 2 * 128 * 16; idx += 256) {
        const int half = idx >> 11, key = (idx >> 4) & 127, ch = idx & 15;
        const float* src = subkeys + ((size_t)(half * 128 + key)) * 128 + ch * 8;
        const float4 x0 = *(const float4*)src, x1 = *(const float4*)(src + 4);
        *(uint4*)(smem + half * 32768 + key * 256 + ((ch ^ (key & 15)) << 4)) = make_uint4(pk2(x0.x, x0.y), pk2(x0.z, x0.w), pk2(x1.x, x1.y), pk2(x1.z, x1.w));
    }
}
#define CEX(i, j) { const float _a = v[i], _b = v[j]; v[i] = fmaxf(_a, _b); v[j] = fminf(_a, _b); }
__device__ __forceinline__ void d_peer_route2(const bf16_t* __restrict__ qry, int* __restrict__ eidx, float* __restrict__ pgate, int mtile, const char* smem, int lane) {
    const int n16 = lane & 15, kq = lane >> 4;
    const int tA = 2 * mtile + (n16 >> 3), hA = n16 & 7;
    float topv[2][4];
#pragma unroll
    for (int half = 0; half < 2; half++) {
        const bf16_t* qp = qry + (size_t)tA * 2048 + hA * 256 + half * 128 + 8 * kq;
        bf16x8 a[4];
#pragma unroll
        for (int ks = 0; ks < 4; ks++) a[ks] = *(const bf16x8*)(qp + 32 * ks);
        f32x4 acc[8];
#pragma unroll
        for (int nt = 0; nt < 8; nt++) acc[nt] = (f32x4){0.f, 0.f, 0.f, 0.f};
#pragma unroll
        for (int ks = 0; ks < 4; ks++)
#pragma unroll
            for (int nt = 0; nt < 8; nt++) {
                const bf16x8 bb = *(const bf16x8*)(smem + half * 32768 + (16 * nt + n16) * 256 + (((4 * ks + kq) ^ n16) << 4));
                acc[nt] = __builtin_amdgcn_mfma_f32_16x16x32_bf16(a[ks], bb, acc[nt], 0, 0, 0);
                if (nt == 3 || nt == 7) __builtin_amdgcn_sched_barrier(0);
            }
#pragma unroll
        for (int r = 0; r < 4; r++) {
            float v[8];
#pragma unroll
            for (int nt = 0; nt < 8; nt++) v[nt] = __uint_as_float((__float_as_uint(acc[nt][r]) & 0xFFFFFF80u) | (unsigned)(nt << 4) | (unsigned)n16);
            CEX(0, 1) CEX(2, 3) CEX(4, 5) CEX(6, 7) CEX(0, 2) CEX(1, 3) CEX(4, 6) CEX(5, 7) CEX(1, 2) CEX(5, 6)
            CEX(0, 4) CEX(1, 5) CEX(2, 6) CEX(3, 7) CEX(2, 4) CEX(3, 5) CEX(1, 2) CEX(3, 4) CEX(5, 6)
            float keep = 0.f;
#pragma unroll 1
            for (int it = 0; it < 16; it++) {
                const float mx = allmax16(v[0]);
                if (n16 == it) keep = mx;
                if (__float_as_uint(v[0]) == __float_as_uint(mx)) {
                    v[0] = v[1]; v[1] = v[2]; v[2] = v[3]; v[3] = v[4]; v[4] = v[5]; v[5] = v[6]; v[6] = v[7]; v[7] = -3e38f;
                }
            }
            topv[half][r] = keep;
            __builtin_amdgcn_sched_barrier(0);
        }
    }
#pragma unroll
    for (int r = 0; r < 4; r++) {
        const float v1p = topv[0][r], v2p = topv[1][r];
        const unsigned u1 = __float_as_uint(v1p);
        const int i1 = (int)(((u1 >> 4) & 7u) * 16u + (u1 & 15u));
        const int lim = 16 / (n16 + 1);
        int ptr = 0;
        const int lanebase = (lane & 48);
        float cur2 = __builtin_bit_cast(float, __builtin_amdgcn_ds_bpermute(lanebase * 4, __builtin_bit_cast(int, v2p)));
        float head = __uint_as_float((__float_as_uint(v1p + cur2) & 0xFFFFFFF0u) | (unsigned)n16);
        float ksc = 0.f; unsigned ke = 0u;
#pragma unroll 1
        for (int it = 0; it < 16; it++) {
            const float mx = allmax16(head);
            const bool win = __float_as_uint(head) == __float_as_uint(mx);
            const unsigned u2 = __float_as_uint(cur2);
            unsigned e = win ? (unsigned)(i1 * 128) + ((u2 >> 4) & 7u) * 16u + (u2 & 15u) : 0u;
            e = allmaxu16(e);
            if (n16 == it) { ksc = mx; ke = e; }
            if (win) ptr++;
            const int pn = ptr < 15 ? ptr : 15;
            const float nx = __builtin_bit_cast(float, __builtin_amdgcn_ds_bpermute((lanebase + pn) * 4, __builtin_bit_cast(int, v2p)));
            if (win) { cur2 = nx; head = (ptr < lim) ? __uint_as_float((__float_as_uint(v1p + cur2) & 0xFFFFFFF0u) | (unsigned)n16) : -3e38f; }
        }
        const float smax = allmax16(ksc);
        const float ex = __expf(ksc - smax);
        const float sum = allsum16(ex);
        const int row = 4 * kq + r;
        const size_t o = (size_t)(2 * mtile + (row >> 3)) * 128 + (row & 7) * 16 + n16;
        eidx[o] = (int)ke; pgate[o] = ex / sum;
    }
}
#undef CEX

__device__ __forceinline__ void d_convert_bf16(const float* __restrict__ src, bf16_t* __restrict__ dst, int item) {
    const size_t idx = (size_t)item * 2048 + threadIdx.x * 8;
    const float4 a = *(const float4*)(src + idx), b = *(const float4*)(src + idx + 4);
    *(uint4*)(dst + idx) = make_uint4(pack2bf(a.x, a.y), pack2bf(a.z, a.w), pack2bf(b.x, b.y), pack2bf(b.z, b.w));
}

typedef __bf16 bf16x2_t __attribute__((ext_vector_type(2)));
__device__ __forceinline__ float dot2bf(unsigned a, unsigned b, float c) {
    return __builtin_amdgcn_fdot2_f32_bf16(__builtin_bit_cast(bf16x2_t, a), __builtin_bit_cast(bf16x2_t, b), c, false);
}
struct PeerGrp { uint4 u[4][2]; uint4 v[4][2]; float g[4]; };
__device__ __forceinline__ void peer_load(PeerGrp& G, const bf16_t* __restrict__ ubf, const bf16_t* __restrict__ vbf, int esrc, float gsrc, int k0, int lane) {
#pragma unroll
    for (int i = 0; i < 4; i++) {
        const int e = __builtin_amdgcn_readlane(esrc, (k0 + i) & 63);
        G.g[i] = __builtin_bit_cast(float, __builtin_amdgcn_readlane(__builtin_bit_cast(int, gsrc), (k0 + i) & 63));
        const uint4* up = (const uint4*)(ubf + (size_t)e * DM) + lane;
        const uint4* vp = (const uint4*)(vbf + (size_t)e * DM) + lane;
        G.u[i][0] = up[0]; G.u[i][1] = up[64];
        G.v[i][0] = vp[0]; G.v[i][1] = vp[64];
    }
}
__device__ __forceinline__ void peer_compute(const PeerGrp& G, const unsigned (&xp)[8], float (&acc)[16]) {
    float d[4];
#pragma unroll
    for (int i = 0; i < 4; i++) {
        float s = 0.f;
        s = dot2bf(G.u[i][0].x, xp[0], s); s = dot2bf(G.u[i][0].y, xp[1], s); s = dot2bf(G.u[i][0].z, xp[2], s); s = dot2bf(G.u[i][0].w, xp[3], s);
        s = dot2bf(G.u[i][1].x, xp[4], s); s = dot2bf(G.u[i][1].y, xp[5], s); s = dot2bf(G.u[i][1].z, xp[6], s); s = dot2bf(G.u[i][1].w, xp[7], s);
        d[i] = s;
    }
#pragma unroll
    for (int o = 32; o > 0; o >>= 1) {
#pragma unroll
        for (int i = 0; i < 4; i++) d[i] += __shfl_xor(d[i], o);
    }
#pragma unroll
    for (int i = 0; i < 4; i++) {
        const float coef = G.g[i] * gelu_tanh(d[i]);
        const unsigned wv[8] = {G.v[i][0].x, G.v[i][0].y, G.v[i][0].z, G.v[i][0].w, G.v[i][1].x, G.v[i][1].y, G.v[i][1].z, G.v[i][1].w};
#pragma unroll
        for (int j = 0; j < 8; j++) {
            acc[2 * j] += coef * __uint_as_float(wv[j] << 16);
            acc[2 * j + 1] += coef * __uint_as_float(wv[j] & 0xffff0000u);
        }
    }
}
__device__ __forceinline__ void d_peer_expert2(const bf16_t* __restrict__ h2, const int* __restrict__ eidx, const float* __restrict__ pgate,
                                               const bf16_t* __restrict__ ubf, const bf16_t* __restrict__ vbf, float* __restrict__ out, int token, int lane) {
    const uint4 xa = ((const uint4*)(h2 + (size_t)token * DM))[lane], xb = ((const uint4*)(h2 + (size_t)token * DM))[64 + lane];
    const unsigned xp[8] = {xa.x, xa.y, xa.z, xa.w, xb.x, xb.y, xb.z, xb.w};
    float acc[16];
#pragma unroll
    for (int i = 0; i < 16; i++) acc[i] = 0.f;
    const int e_lo = eidx[(size_t)token * 128 + lane], e_hi = eidx[(size_t)token * 128 + 64 + lane];
    const float g_lo = pgate[(size_t)token * 128 + lane], g_hi = pgate[(size_t)token * 128 + 64 + lane];
    PeerGrp A, B;
    peer_load(A, ubf, vbf, e_lo, g_lo, 0, lane);
#pragma unroll 1
    for (int k0 = 0; k0 < 64; k0 += 8) {
        peer_load(B, ubf, vbf, e_lo, g_lo, k0 + 4, lane);
        peer_compute(A, xp, acc);
        if (k0 + 8 < 64) peer_load(A, ubf, vbf, e_lo, g_lo, k0 + 8, lane); else peer_load(A, ubf, vbf, e_hi, g_hi, 0, lane);
        peer_compute(B, xp, acc);
    }
#pragma unroll 1
    for (int k0 = 0; k0 < 64; k0 += 8) {
        peer_load(B, ubf, vbf, e_hi, g_hi, k0 + 4, lane);
        peer_compute(A, xp, acc);
        if (k0 + 8 < 64) peer_load(A, ubf, vbf, e_hi, g_hi, k0 + 8, lane);
        peer_compute(B, xp, acc);
    }
    float4* o0 = (float4*)(out + (size_t)token * DM + lane * 8);
    float4* o1 = (float4*)(out + (size_t)token * DM + 512 + lane * 8);
    float4 a0 = o0[0], a1 = o0[1], b0 = o1[0], b1 = o1[1];
    a0.x += acc[0]; a0.y += acc[1]; a0.z += acc[2]; a0.w += acc[3]; a1.x += acc[4]; a1.y += acc[5]; a1.z += acc[6]; a1.w += acc[7];
    b0.x += acc[8]; b0.y += acc[9]; b0.z += acc[10]; b0.w += acc[11]; b1.x += acc[12]; b1.y += acc[13]; b1.z += acc[14]; b1.w += acc[15];
    o0[0] = a0; o0[1] = a1; o1[0] = b0; o1[1] = b1;
}

#define XB_TMO      128
#define XB_XCNT(j)  (256  + 64 * (j))
#define XB_XSUB(j)  (1280 + 64 * (j))
#define XB_XGEN(j)  (2304 + 64 * (j))
#define XB_TOP      3328
#define XB_TOPGEN   3392
#define XB_QUEUE    3456
#define XCD_BAR_WORDS 4096
#define XB_SPIN_CAP (1u << 22)
#define LAS __attribute__((address_space(3)))
__device__ __forceinline__ unsigned xb_ld(unsigned* p)              { return __hip_atomic_load(p, __ATOMIC_RELAXED, __HIP_MEMORY_SCOPE_AGENT); }
__device__ __forceinline__ unsigned xb_add(unsigned* p, unsigned v) { return __hip_atomic_fetch_add(p, v, __ATOMIC_RELAXED, __HIP_MEMORY_SCOPE_AGENT); }
__device__ __forceinline__ unsigned xb_xcc_id() { return (unsigned)__builtin_amdgcn_s_getreg((3 << 11) | 20) & 0xFu; }
#define XB_SPIN(cond, bar) do { unsigned _sp = 0; while (cond) { __builtin_amdgcn_s_sleep(1); \
    if ((++_sp & 255u) == 0u) { if (xb_ld(&(bar)[XB_TMO])) break; if (_sp > XB_SPIN_CAP) { atomicAdd(&(bar)[XB_TMO], 1u); break; } } } } while (0)
struct XcdBarrier { unsigned* bar; unsigned x; volatile LAS unsigned* st; };
__device__ __forceinline__ XcdBarrier xcd_barrier_post(unsigned* bar, volatile LAS unsigned* st) {
    XcdBarrier b; b.bar = bar; b.x = xb_xcc_id(); b.st = st;
    if (threadIdx.x == 0) (void)xb_add(&bar[XB_XCNT(b.x)], 1u);
    return b;
}
__device__ __forceinline__ void xcd_barrier_complete(unsigned* bar, unsigned x, unsigned& nloc, unsigned& nx) {
    const unsigned G = gridDim.x * gridDim.y * gridDim.z;
    unsigned sum, cnt, mine, sp = 0u;
    for (;;) {
        sum = 0u; cnt = 0u; mine = 0u;
#pragma unroll
        for (unsigned j = 0; j < 16; ++j) { const unsigned c = xb_ld(&bar[XB_XCNT(j)]); sum += c; cnt += (c > 0u) ? 1u : 0u; mine = (j == x) ? c : mine; }
        if (sum == G) break;
        __builtin_amdgcn_s_sleep(1);
        if ((++sp & 255u) == 0u) { if (xb_ld(&bar[XB_TMO])) break; if (sp > XB_SPIN_CAP) { atomicAdd(&bar[XB_TMO], 1u); break; } }
    }
    nloc = mine > 0u ? mine : 1u; nx = cnt > 0u ? cnt : 1u;
}
__device__ __forceinline__ void xcd_barrier(const XcdBarrier& b) {
    asm volatile("s_waitcnt vmcnt(0)" ::: "memory");
    __syncthreads();
    if (threadIdx.x == 0) {
        unsigned* bar = b.bar;
        __builtin_amdgcn_s_waitcnt(0);
        unsigned nloc = b.st[0], nx = b.st[1];
        if (nloc == 0u) { xcd_barrier_complete(bar, b.x, nloc, nx); b.st[0] = nloc; b.st[1] = nx; }
        const unsigned old = xb_add(&bar[XB_XSUB(b.x)], 1u);
        const unsigned gen = old / nloc;
        if (old + 1u == (gen + 1u) * nloc) {
            __builtin_amdgcn_fence(__ATOMIC_RELEASE, "agent");
            asm volatile("s_waitcnt vmcnt(0)" ::: "memory");
            const unsigned og = xb_add(&bar[XB_TOP], 1u);
            const unsigned tg = og / nx;
            if (og + 1u == (tg + 1u) * nx) xb_add(&bar[XB_TOPGEN], 1u);
            else XB_SPIN(xb_ld(&bar[XB_TOPGEN]) == tg, bar);
            __builtin_amdgcn_fence(__ATOMIC_ACQUIRE, "agent");
            xb_add(&bar[XB_XGEN(b.x)], 1u);
            asm volatile("s_waitcnt vmcnt(0)" ::: "memory");
        } else {
            XB_SPIN(xb_ld(&bar[XB_XGEN(b.x)]) == gen, bar);
            __builtin_amdgcn_fence(__ATOMIC_ACQUIRE, "agent");
            asm volatile("s_waitcnt vmcnt(0)" ::: "memory");
        }
    }
    __syncthreads();
}

struct MKP {
    const float *x, *attn_norm, *w_in, *q_gain, *k_gain, *cmp_pos, *cmp_w1, *cmp_w2, *gdn_conv, *a_log, *dt_bias, *out_gain, *w_out, *ffn_norm, *w_query, *subkeys, *peer_u, *peer_v;
    float* out; char* ws; unsigned* bar;
};

#define SMEM_BYTES 69120

__global__ __launch_bounds__(256, 2) void hybrid_megakernel(MKP P) {
    extern __shared__ __attribute__((aligned(16))) char smem[];
    __shared__ uint4 xb_words;
    __shared__ int q_item;
    const int G = gridDim.x, bid0 = blockIdx.x;
    if (threadIdx.x == 0) xb_words = make_uint4(0u, 0u, 0u, 0u);
    __syncthreads();
    XcdBarrier B = xcd_barrier_post(P.bar, (volatile LAS unsigned*)&xb_words);
    char* ws = P.ws;
    bf16_t* w_in_t = (bf16_t*)(ws + OFF_WINT);
    bf16_t* w_out_t = (bf16_t*)(ws + OFF_WOUTT);
    bf16_t* w_q_t = (bf16_t*)(ws + OFF_WQT);
    bf16_t* cw1_t = (bf16_t*)(ws + OFF_CW1T);
    float* cbias = (float*)(ws + OFF_CBIAS);
    bf16_t* h_bf = (bf16_t*)(ws + OFF_HBF);
    bf16_t* proj = (bf16_t*)(ws + OFF_PROJ);
    bf16_t* ksn = (bf16_t*)(ws + OFF_KSN);
    bf16_t* kwn = (bf16_t*)(ws + OFF_KWN);
    bf16_t* kc = (bf16_t*)(ws + OFF_KC);
    bf16_t* vc = (bf16_t*)(ws + OFF_VC);
    bf16_t* hid = (bf16_t*)(ws + OFF_HID);
    bf16_t* gu = (bf16_t*)(ws + OFF_GU);
    bf16_t* gw = (bf16_t*)(ws + OFF_GW);
    bf16_t* gqd = (bf16_t*)(ws + OFF_GQD);
    bf16_t* gkd = (bf16_t*)(ws + OFF_GKD);
    bf16_t* gin = (bf16_t*)(ws + OFF_GIN);
    float* gl = (float*)(ws + OFF_GL);
    bf16_t* mix = (bf16_t*)(ws + OFF_MIX);
    bf16_t* qry = (bf16_t*)(ws + OFF_QRY);
    bf16_t* h2 = (bf16_t*)(ws + OFF_H2);
    int* eidx = (int*)(ws + OFF_EIDX);
    float* pgate = (float*)(ws + OFF_PGATE);
    bf16_t* ubf = (bf16_t*)(ws + OFF_UBF);
    bf16_t* vbf = (bf16_t*)(ws + OFF_VBF);
    float* og = P.out;
    float2* rope = (float2*)(ws + OFF_ROPE);

    {
        const int n1 = 108 * 32, n2 = n1 + 32 * 32, n3 = n2 + 64 * 32, n4 = n3 + 2 * 8 * 64;
        for (int it = bid0; it < n4; it += G) {
            if (it < n1) d_transpose_bf16(P.w_in, 1024, IN_COLS, w_in_t, it % 108, it / 108, smem);
            else if (it < n2) { int r = it - n1; d_transpose_bf16(P.w_out, 1024, 1024, w_out_t, r % 32, r / 32, smem); }
            else if (it < n3) { int r = it - n2; d_transpose_bf16(P.w_query, 1024, 2048, w_q_t, r % 64, r / 64, smem); }
            else { int r = it - n3; int j = r >> 9; r &= 511; d_transpose_bf16(P.cmp_w1 + (size_t)j * 2048 * 256, 2048, 256, cw1_t + (size_t)j * 256 * 2048, r % 8, r / 8, smem); }
            __syncthreads();
        }
        for (int it = bid0; it < 2; it += G) d_cmp_bias(P.cmp_pos, P.cmp_w1, cbias, it);
        for (int it = bid0; it < T_TOK / 4; it += G) d_rmsnorm_bf16(P.x, P.attn_norm, h_bf, it);
        for (int i = bid0 * 256 + threadIdx.x; i < 8192 * 32; i += G * 256) {
            const int pos = i >> 5, fi = i & 31;
            float sn, cs; sincosf((float)pos * expf(-9.210340371976184f * (float)(2 * fi) / 64.f), &sn, &cs);
            rope[i] = make_float2(cs, sn);
        }
        for (int i = bid0 * 256 + threadIdx.x; i < 32 * PLD / 2; i += G * 256) ((unsigned*)(proj + (size_t)T_TOK * PLD))[i] = 0u;
    }
    xcd_barrier(B);
    {
        GemmP p{}; p.A = h_bf; p.lda = 1024; p.akts = 64; p.Bt = w_in_t; p.ldb = 1024; p.K = 1024; p.mtiles = 128; p.ntiles = 27; p.out = proj;
#ifdef PROBE_GEMM1
        for (int rep = 0; rep < PROBE_GEMM1; rep++)
#endif
        for (int it = bid0; it < 128 * 27; it += G) d_gemm<EPI_PROJ>(p, it, smem);
    }
    xcd_barrier(B);
    {
        for (int it = bid0; it < 64; it += G) {
            int inst = it >> 3, tile = it & 7;
            int j = inst >> 2, b = (inst >> 1) & 1, g = inst & 1;
            GemmP p{}; p.A = proj + (size_t)(b * SEQ) * PLD + C_KV + 128 * j + 64 * g; p.lda = 16 * PLD; p.akts = PLD;
            p.Bt = cw1_t + (size_t)j * 256 * 2048; p.ldb = 2048; p.K = 2048; p.mtiles = 4; p.ntiles = 2;
            p.out = hid + (size_t)inst * 512 * 256; p.aux = cbias + j * 256;
            d_gemm<EPI_HID>(p, tile, smem);
        }
        for (int it = bid0; it < 1024; it += G) { d_gdn_prep2(proj, P.gdn_conv, P.a_log, P.dt_bias, gu, gw, gqd, gkd, gin, gl, it, smem); __syncthreads(); }
        for (int it = bid0; it < 8192; it += G) d_knorm_rope(proj, P.k_gain, ksn, kwn, it);
    }
    xcd_barrier(B);
    for (int it = bid0; it < 1024; it += G) d_cmp2(hid, P.cmp_w2, P.k_gain, kc, vc, it);
    xcd_barrier(B);
    {
        if (bid0 < 64) d_gdn_scan2(gu, gw, gqd, gkd, gin, gl, og, bid0, smem);
        __syncthreads();
        for (;;) {
            if (threadIdx.x == 0) q_item = (int)xb_add(&P.bar[XB_QUEUE], 1u);
            __syncthreads();
            const int it = q_item;
            if (it >= 1024) break;
            d_nsa_mfma(proj, P.q_gain, rope, ksn, kwn, kc, vc, mix, DM, it, smem);
            __syncthreads();
        }
#ifdef NSA_CHECK
        bf16_t* mix2 = (bf16_t*)(P.out + 8388608);
        for (;;) {
            if (threadIdx.x == 0) q_item = (int)xb_add(&P.bar[XB_QUEUE + 64], 1u);
            __syncthreads();
            const int it = q_item;
            if (it >= 2 * 2 * SEQ) break;
            d_nsa_naive(proj, P.q_gain, ksn, kwn, kc, vc, mix2, 512, it, smem);
            __syncthreads();
        }
#endif
    }
    xcd_barrier(B);
#ifdef NSA_CHECK
    {
        const bf16_t* mix2 = (const bf16_t*)(P.out + 8388608);
        float sd = 0.f, sr = 0.f;
        for (int i = bid0 * 256 + threadIdx.x; i < T_TOK * 512; i += G * 256) {
            const int r = i >> 9, c = i & 511;
            const float a = bf2f(mix[(size_t)r * DM + c]), bb = bf2f(mix2[i]);
            sd += (a - bb) * (a - bb); sr += bb * bb;
        }
        sd = wave_sum(sd); sr = wave_sum(sr);
        if ((threadIdx.x & 63) == 0) { atomicAdd((float*)&P.bar[XB_QUEUE + 128], sd); atomicAdd((float*)&P.bar[XB_QUEUE + 192], sr); }
    }
    xcd_barrier(B);
#endif
    for (int it = bid0; it < T_TOK; it += G) d_gdn_out(og, proj, P.out_gain, mix, it);
    for (int it = bid0; it < 8192; it += G) { d_convert_bf16(P.peer_u, ubf, it); d_convert_bf16(P.peer_v, vbf, it); }
    xcd_barrier(B);
    {
        GemmP p{}; p.A = mix; p.lda = 1024; p.akts = 64; p.Bt = w_out_t; p.ldb = 1024; p.K = 1024; p.mtiles = 128; p.ntiles = 8; p.out = P.out; p.aux = P.x;
        for (int it = bid0; it < 128 * 8; it += G) d_gemm<EPI_OUT>(p, it, smem);
    }
    xcd_barrier(B);
    for (int it = bid0; it < T_TOK / 4; it += G) d_rmsnorm_bf16(P.out, P.ffn_norm, h2, it);
    xcd_barrier(B);
    {
        GemmP p{}; p.A = h2; p.lda = 1024; p.akts = 64; p.Bt = w_q_t; p.ldb = 1024; p.K = 1024; p.mtiles = 128; p.ntiles = 16; p.out = qry;
        for (int it = bid0; it < 128 * 16; it += G) d_gemm<EPI_QRY>(p, it, smem);
    }
    xcd_barrier(B);
    route_load_subkeys(P.subkeys, smem);
    __syncthreads();
    for (int mt = bid0 * 4 + (threadIdx.x >> 6); mt < T_TOK / 2; mt += G * 4) d_peer_route2(qry, eidx, pgate, mt, smem, threadIdx.x & 63);
    xcd_barrier(B);
    for (int it = bid0; it < T_TOK / 4; it += G) d_peer_expert2(h2, eidx, pgate, ubf, vbf, P.out, it * 4 + (threadIdx.x >> 6), threadIdx.x & 63);
#ifdef NSA_CHECK
    xcd_barrier(B);
    {
        const float sd = __hip_atomic_load((float*)&P.bar[XB_QUEUE + 128], __ATOMIC_RELAXED, __HIP_MEMORY_SCOPE_AGENT);
        const float sr = __hip_atomic_load((float*)&P.bar[XB_QUEUE + 192], __ATOMIC_RELAXED, __HIP_MEMORY_SCOPE_AGENT);
        if (!(sd <= NSA_CHECK * sr)) for (int i = bid0 * 256 + threadIdx.x; i < T_TOK * DM; i += G * 256) P.out[i] += 1000.f;
    }
#endif
}

extern "C" void kernel_launch(void* const* d_in, const int* in_sizes, int n_in, void* d_out, int out_size, void* d_ws, size_t ws_size,
                              hipStream_t stream) {
    const size_t bar_off = (OFF_END + 255) & ~(size_t)255;
    if (ws_size < bar_off + XCD_BAR_WORDS * 4) return;
    static int grid_blocks = 0;
    if (!grid_blocks) {
        int dev = 0, cus = 0, per_cu = 0;
        (void)hipGetDevice(&dev);
        (void)hipDeviceGetAttribute(&cus, hipDeviceAttributeMultiprocessorCount, dev);
        (void)hipFuncSetAttribute((const void*)hybrid_megakernel, hipFuncAttributeMaxDynamicSharedMemorySize, SMEM_BYTES);
        (void)hipOccupancyMaxActiveBlocksPerMultiprocessor(&per_cu, hybrid_megakernel, 256, SMEM_BYTES);
        if (per_cu > 2) per_cu = 2;
        grid_blocks = cus * per_cu;
    }
    if (grid_blocks <= 0) return;
    MKP P{};
    P.x = (const float*)d_in[0]; P.attn_norm = (const float*)d_in[1]; P.w_in = (const float*)d_in[2]; P.q_gain = (const float*)d_in[3];
    P.k_gain = (const float*)d_in[4]; P.cmp_pos = (const float*)d_in[5]; P.cmp_w1 = (const float*)d_in[6]; P.cmp_w2 = (const float*)d_in[7];
    P.gdn_conv = (const float*)d_in[8]; P.a_log = (const float*)d_in[9]; P.dt_bias = (const float*)d_in[10]; P.out_gain = (const float*)d_in[11];
    P.w_out = (const float*)d_in[12]; P.ffn_norm = (const float*)d_in[13]; P.w_query = (const float*)d_in[14]; P.subkeys = (const float*)d_in[15];
    P.peer_u = (const float*)d_in[16]; P.peer_v = (const float*)d_in[17];
    P.out = (float*)d_out; P.ws = (char*)d_ws; P.bar = (unsigned*)((char*)d_ws + bar_off);
    (void)hipMemsetAsync(P.bar, 0, XCD_BAR_WORDS * 4, stream);
    hipLaunchKernelGGL(hybrid_megakernel, dim3(grid_blocks), dim3(256), SMEM_BYTES, stream, P);
}
```

```cpp
#include <hip/hip_runtime.h>
#include <stdint.h>

typedef unsigned short bf16_t;
typedef __attribute__((ext_vector_type(8))) short bf16x8;
typedef __attribute__((ext_vector_type(4))) float f32x4;
#define LAS3 __attribute__((address_space(3)))

#define T_TOK 16384
#define SEQ 8192
#define DM 1024
#define IN_COLS 3360
#define PLD 3456
#define C_Q 0
#define C_KV 512
#define C_GATE 1280
#define C_GQKV 1304
#define C_Z 2840
#define C_A 3352
#define C_B 3356

#define OFF_WINT   0ull
#define OFF_WOUTT  (OFF_WINT  + 3456ull*1024*2)
#define OFF_WQT    (OFF_WOUTT + 1024ull*1024*2)
#define OFF_CW1T   (OFF_WQT   + 2048ull*1024*2)
#define OFF_CBIAS  (OFF_CW1T  + 2ull*256*2048*2)
#define OFF_HBF    (OFF_CBIAS + 4096ull)
#define OFF_PROJ   (OFF_HBF   + 16384ull*1024*2)
#define OFF_KSN    (OFF_PROJ  + (16384ull+32)*PLD*2)
#define OFF_KWN    (OFF_KSN   + 4ull*8192*64*2)
#define OFF_KC     (OFF_KWN   + 4ull*8192*64*2)
#define OFF_VC     (OFF_KC    + 4ull*512*64*2)
#define OFF_HID    (OFF_VC    + 4ull*512*64*2)
#define OFF_GU     (OFF_HID   + 8ull*512*256*2)
#define OFF_GW     (OFF_GU    + 1024ull*64*128*2)
#define OFF_GQD    (OFF_GW    + 1024ull*64*128*2)
#define OFF_GKD    (OFF_GQD   + 1024ull*64*128*2)
#define OFF_GIN    (OFF_GKD   + 1024ull*64*128*2)
#define OFF_GL     (OFF_GIN   + 1024ull*64*64*2)
#define OFF_ROPE   (OFF_GL    + 4096ull)
#define OFF_END    (OFF_ROPE  + 8192ull*32*8)
#define OFF_MIX    OFF_HBF
#define OFF_QRY    OFF_PROJ
#define OFF_H2     (OFF_PROJ + 16384ull*2048*2)
#define OFF_EIDX   OFF_KSN
#define OFF_PGATE  OFF_GIN
#define OFF_UQ     OFF_GU
#define OFF_VQ     (OFF_GU + 16384ull*1024)
#define OFF_SU     (OFF_GU + 2*16384ull*1024)
#define OFF_SV     (OFF_SU + 65536ull)

__device__ __forceinline__ bf16_t f2bf(float f) {
    unsigned u = __float_as_uint(f);
    u += 0x7fffu + ((u >> 16) & 1u);
    return (bf16_t)(u >> 16);
}
__device__ __forceinline__ float bf2f(bf16_t h) { return __uint_as_float(((unsigned)h) << 16); }
__device__ __forceinline__ float gelu_tanh(float x) {
    float u = 0.7978845608028654f * (x + 0.044715f * x * x * x);
    return 0.5f * x * (1.f + tanhf(u));
}
__device__ __forceinline__ float sigmoidf_(float x) { return 1.f / (1.f + __expf(-x)); }
__device__ __forceinline__ float wave_sum(float v) {
#pragma unroll
    for (int o = 32; o > 0; o >>= 1) v += __shfl_xor(v, o);
    return v;
}
__device__ __forceinline__ float wave_max(float v) {
#pragma unroll
    for (int o = 32; o > 0; o >>= 1) v = fmaxf(v, __shfl_xor(v, o));
    return v;
}

__device__ __forceinline__ void d_transpose_bf16(const float* __restrict__ W, int K, int N, bf16_t* __restrict__ Wt, int bx, int by, char* smem) {
    float (*tile)[33] = (float (*)[33])smem;
    int n0 = bx * 32, k0 = by * 32;
    int tx = threadIdx.x & 31, ty = threadIdx.x >> 5;
    for (int i = ty; i < 32; i += 8) {
        int n = n0 + tx;
        tile[i][tx] = (n < N) ? W[(size_t)(k0 + i) * N + n] : 0.f;
    }
    __syncthreads();
    for (int i = ty; i < 32; i += 8) {
        Wt[(size_t)(n0 + i) * K + k0 + tx] = f2bf(tile[tx][i]);
    }
}

__device__ __forceinline__ void d_rmsnorm_bf16(const float* __restrict__ x, const float* __restrict__ g, bf16_t* __restrict__ out, int bid) {
    int row = bid * 4 + (threadIdx.x >> 6);
    int lane = threadIdx.x & 63;
    const float4* xr = (const float4*)(x + (size_t)row * DM);
    float4 v[4];
    float ss = 0.f;
#pragma unroll
    for (int i = 0; i < 4; i++) { v[i] = xr[lane + 64 * i]; ss += v[i].x * v[i].x + v[i].y * v[i].y + v[i].z * v[i].z + v[i].w * v[i].w; }
    ss = wave_sum(ss);
    float r = rsqrtf(ss * (1.f / DM) + 1e-6f);
#pragma unroll
    for (int i = 0; i < 4; i++) {
        float4 gg = ((const float4*)g)[lane + 64 * i];
        ushort4 o;
        o.x = f2bf(v[i].x * r * gg.x); o.y = f2bf(v[i].y * r * gg.y); o.z = f2bf(v[i].z * r * gg.z); o.w = f2bf(v[i].w * r * gg.w);
        ((ushort4*)(out + (size_t)row * DM))[lane + 64 * i] = o;
    }
}

__device__ __forceinline__ void d_cmp_bias(const float* __restrict__ pos, const float* __restrict__ w1, float* __restrict__ bias, int bid) {
    int j = bid, c = threadIdx.x;
    float s = 0.f;
    for (int k = 0; k < 2048; k++) s += pos[j * 2048 + k] * w1[((size_t)j * 2048 + k) * 256 + c];
    bias[j * 256 + c] = s;
}

#define EPI_PROJ 0
#define EPI_HID 1
#define EPI_OUT 2
#define EPI_QRY 3
struct GemmP {
    const bf16_t* A; long lda; long akts;
    const bf16_t* Bt; long ldb;
    int K; int mtiles; int ntiles;
    long a_inst; long b_inst;
    void* out; const float* aux; const float* aux2;
};

template <int EPI>
__device__ __forceinline__ void d_gemm(const GemmP& p, int bid, char* smem) {
    bf16_t* As = (bf16_t*)smem;
    bf16_t* Bs = As + 128 * 72;
    const int tid = threadIdx.x, lane = tid & 63, wave = tid >> 6;
    const int wm = wave >> 1, wn = wave & 1;
    const int inst = 0;
    const int mt = bid / p.ntiles, nt = bid % p.ntiles;
    const int m0 = mt * 128, n0 = nt * 128;
    const bf16_t* A = p.A + (size_t)inst * p.a_inst + (size_t)m0 * p.lda;
    const bf16_t* Bt = p.Bt + (size_t)inst * p.b_inst + (size_t)n0 * p.ldb;
    f32x4 acc[4][4];
#pragma unroll
    for (int i = 0; i < 4; i++)
#pragma unroll
        for (int j = 0; j < 4; j++) acc[i][j] = (f32x4){0.f, 0.f, 0.f, 0.f};
    const int nk = p.K >> 6;
    const int lrow = tid >> 3, lc8 = (tid & 7) * 8;
    const bf16_t* Ap = A + (size_t)lrow * p.lda + lc8;
    const bf16_t* Bp = Bt + (size_t)lrow * p.ldb + lc8;
    const size_t a32 = (size_t)32 * p.lda, b32 = (size_t)32 * p.ldb;
    uint4 ra0, ra1, ra2, ra3, rb0, rb1, rb2, rb3;
#define GLOAD(koffA, koffB) \
    ra0 = *(const uint4*)(Ap + (koffA)); ra1 = *(const uint4*)(Ap + a32 + (koffA)); ra2 = *(const uint4*)(Ap + 2 * a32 + (koffA)); ra3 = *(const uint4*)(Ap + 3 * a32 + (koffA)); \
    rb0 = *(const uint4*)(Bp + (koffB)); rb1 = *(const uint4*)(Bp + b32 + (koffB)); rb2 = *(const uint4*)(Bp + 2 * b32 + (koffB)); rb3 = *(const uint4*)(Bp + 3 * b32 + (koffB));
    GLOAD(0, 0)
    bf16_t* Asw = As + lrow * 72 + lc8;
    bf16_t* Bsw = Bs + lrow * 72 + lc8;
    for (int kt = 0; kt < nk; kt++) {
        *(uint4*)(Asw) = ra0; *(uint4*)(Asw + 32 * 72) = ra1; *(uint4*)(Asw + 64 * 72) = ra2; *(uint4*)(Asw + 96 * 72) = ra3;
        *(uint4*)(Bsw) = rb0; *(uint4*)(Bsw + 32 * 72) = rb1; *(uint4*)(Bsw + 64 * 72) = rb2; *(uint4*)(Bsw + 96 * 72) = rb3;
        __syncthreads();
        if (kt + 1 < nk) {
            GLOAD((size_t)(kt + 1) * p.akts, (size_t)(kt + 1) * 64)
        }
#pragma unroll
        for (int ks = 0; ks < 2; ks++) {
            bf16x8 af[4], bfr[4];
#pragma unroll
            for (int i = 0; i < 4; i++) af[i] = *(const bf16x8*)(As + (wm * 64 + i * 16 + (lane & 15)) * 72 + ks * 32 + (lane >> 4) * 8);
#pragma unroll
            for (int j = 0; j < 4; j++) bfr[j] = *(const bf16x8*)(Bs + (wn * 64 + j * 16 + (lane & 15)) * 72 + ks * 32 + (lane >> 4) * 8);
#pragma unroll
            for (int i = 0; i < 4; i++)
#pragma unroll
                for (int j = 0; j < 4; j++) acc[i][j] = __builtin_amdgcn_mfma_f32_16x16x32_bf16(af[i], bfr[j], acc[i][j], 0, 0, 0);
        }
        __syncthreads();
    }
#pragma unroll
    for (int i = 0; i < 4; i++)
#pragma unroll
        for (int j = 0; j < 4; j++)
#pragma unroll
            for (int r = 0; r < 4; r++) {
                int row = m0 + wm * 64 + i * 16 + (lane >> 4) * 4 + r;
                int col = n0 + wn * 64 + j * 16 + (lane & 15);
                float v = acc[i][j][r];
                if (EPI == EPI_PROJ) {
                    ((bf16_t*)p.out)[(size_t)row * PLD + col] = f2bf(v);
                } else if (EPI == EPI_HID) {
                    float bb = p.aux[(inst >> 2) * 256 + col];
                    ((bf16_t*)p.out)[((size_t)inst * 512 + row) * 256 + col] = f2bf(gelu_tanh(v + bb));
                } else if (EPI == EPI_OUT) {
                    ((float*)p.out)[(size_t)row * DM + col] = p.aux[(size_t)row * DM + col] + v;
                } else if (EPI == EPI_QRY) {
                    ((bf16_t*)p.out)[(size_t)row * 2048 + col] = f2bf(v);
                }
            }
}

__device__ __forceinline__ void d_knorm_rope(const bf16_t* __restrict__ proj, const float* __restrict__ kgain, bf16_t* __restrict__ ksn, bf16_t* __restrict__ kwn, int bid) {
    int vec = bid * 8 + (threadIdx.x >> 5);
    int i = threadIdx.x & 31;
    int which = vec >> 15;
    int rem = vec & 32767;
    int b = rem >> 14, g = (rem >> 13) & 1, s = rem & 8191;
    const bf16_t* src = proj + (size_t)(b * SEQ + s) * PLD + C_KV + 128 * (which ? 4 : 2) + 64 * g;
    float x1 = bf2f(src[i]), x2 = bf2f(src[i + 32]);
    float ss = x1 * x1 + x2 * x2;
#pragma unroll
    for (int o = 16; o > 0; o >>= 1) ss += __shfl_xor(ss, o);
    float r = rsqrtf(ss * (1.f / 64.f) + 1e-6f);
    const float* gn = kgain + (which ? 2 : 1) * 64;
    x1 = x1 * r * gn[i]; x2 = x2 * r * gn[i + 32];
    float inv = expf(-9.210340371976184f * (float)(2 * i) / 64.f);
    float ang = (float)s * inv;
    float sn, cs; sincosf(ang, &sn, &cs);
    bf16_t* dst = (which ? kwn : ksn) + ((size_t)(b * 2 + g) * SEQ + s) * 64;
    dst[i] = f2bf(x1 * cs - x2 * sn);
    dst[i + 32] = f2bf(x2 * cs + x1 * sn);
}

__device__ __forceinline__ void d_cmp2(const bf16_t* __restrict__ hid, const float* __restrict__ w2, const float* __restrict__ kgain, bf16_t* __restrict__ kc, bf16_t* __restrict__ vc, int bid) {
    int rowid = bid * 4 + (threadIdx.x >> 6);
    int lane = threadIdx.x & 63;
    int inst = rowid >> 9, n = rowid & 511;
    int j = inst >> 2, bg = inst & 3;
    if (n >= 511) return;
    const bf16_t* hr = hid + (size_t)rowid * 256;
    const float* w = w2 + (size_t)j * 256 * 64;
    float s = 0.f;
    for (int k = 0; k < 256; k++) s += bf2f(hr[k]) * w[k * 64 + lane];
    if (j == 0) {
        float ss = wave_sum(s * s);
        float r = rsqrtf(ss * (1.f / 64.f) + 1e-6f);
        float y = s * r * kgain[lane];
        float other = __shfl_xor(y, 32);
        int i = lane & 31;
        float inv = expf(-9.210340371976184f * (float)(2 * i) / 64.f);
        float ang = (float)(n * 16 + 31) * inv;
        float sn, cs; sincosf(ang, &sn, &cs);
        float o = (lane < 32) ? (y * cs - other * sn) : (y * cs + other * sn);
        kc[((size_t)bg * 512 + n) * 64 + lane] = f2bf(o);
    } else {
        vc[((size_t)bg * 512 + n) * 64 + lane] = f2bf(s);
    }
}

__device__ __forceinline__ float dot64(const float* q, const bf16_t* krow) {
    const uint4* kp = (const uint4*)krow;
    float s = 0.f;
#pragma unroll
    for (int c = 0; c < 8; c++) {
        uint4 u = kp[c];
        unsigned w[4] = {u.x, u.y, u.z, u.w};
#pragma unroll
        for (int e = 0; e < 4; e++) {
            s += q[c * 8 + e * 2] * __uint_as_float(w[e] << 16);
            s += q[c * 8 + e * 2 + 1] * __uint_as_float(w[e] & 0xffff0000u);
        }
    }
    return s;
}

__device__ __forceinline__ void d_nsa_naive(const bf16_t* __restrict__ proj, const float* __restrict__ qgain,
                                                   const bf16_t* __restrict__ ksn, const bf16_t* __restrict__ kwn,
                                                   const bf16_t* __restrict__ kc, const bf16_t* __restrict__ vc,
                                                   bf16_t* __restrict__ mix, int mix_ld, int bid, char* smem) {
    float (*qs)[64] = (float (*)[64])smem;
    float (*pbuf)[1024] = (float (*)[1024])(smem + 1024);
    float* sc = (float*)(smem + 1024 + 16384);
    int* sel = (int*)(smem + 1024 + 16384 + 512);
    const int tid = threadIdx.x, lane = tid & 63, w = tid >> 6;
    const int blk = bid;
    const int t = blk & 8191, g = (blk >> 13) & 1, b = blk >> 14;
    const int bg = b * 2 + g;
    const size_t row = (size_t)(b * SEQ + t);
    const int head = g * 4 + w;
    {
        int i = lane & 31;
        const bf16_t* src = proj + row * PLD + C_Q + head * 64;
        float x1 = bf2f(src[i]), x2 = bf2f(src[i + 32]);
        float ss = x1 * x1 + x2 * x2;
#pragma unroll
        for (int o = 16; o > 0; o >>= 1) ss += __shfl_xor(ss, o);
        float r = rsqrtf(ss * (1.f / 64.f) + 1e-6f);
        x1 = x1 * r * qgain[i]; x2 = x2 * r * qgain[i + 32];
        float inv = expf(-9.210340371976184f * (float)(2 * i) / 64.f);
        float ang = (float)t * inv;
        float sn, cs; sincosf(ang, &sn, &cs);
        if (lane < 32) { qs[w][i] = (x1 * cs - x2 * sn) * 0.125f; qs[w][i + 32] = (x2 * cs + x1 * sn) * 0.125f; }
    }
    __syncthreads();
    float q[64];
#pragma unroll
    for (int d = 0; d < 64; d++) q[d] = qs[w][d];
    float o_c = 0.f, o_s = 0.f, o_w = 0.f;
    const int nvis = (t >= 31) ? (((t - 31) >> 4) + 1) : 0;
    {
        float s[8];
        float m = -3e38f;
#pragma unroll
        for (int i = 0; i < 8; i++) {
            int n = lane + 64 * i;
            if (n < nvis) { s[i] = dot64(q, kc + ((size_t)bg * 512 + n) * 64); m = fmaxf(m, s[i]); } else s[i] = -3e38f;
        }
        m = wave_max(m);
        float l = 0.f;
#pragma unroll
        for (int i = 0; i < 8; i++) { int n = lane + 64 * i; s[i] = (n < nvis) ? __expf(s[i] - m) : 0.f; l += s[i]; }
        l = wave_sum(l);
        float il = (nvis > 0) ? 1.f / l : 0.f;
#pragma unroll
        for (int i = 0; i < 8; i++) pbuf[w][lane + 64 * i] = s[i] * il;
        __syncthreads();
        const bf16_t* vp = vc + (size_t)bg * 512 * 64 + lane;
        for (int n = 0; n < nvis; n++) o_c += pbuf[w][n] * bf2f(vp[(size_t)n * 64]);
    }
    if (tid < 128) {
        int j = tid;
        float im = 0.f;
#pragma unroll
        for (int h = 0; h < 4; h++) {
            float a = (j > 0) ? pbuf[h][4 * j - 1] : 0.f;
            im += a + 2.f * (pbuf[h][4 * j] + pbuf[h][4 * j + 1] + pbuf[h][4 * j + 2]) + pbuf[h][4 * j + 3];
        }
        int cur = t >> 6;
        float v;
        if (j > cur) v = -1e30f;
        else if (j == 0 || j == cur || j == cur - 1) v = 1e4f;
        else v = im;
        sc[j] = v;
    }
    __syncthreads();
    if (w == 0) {
        float v0 = sc[lane], v1 = sc[lane + 64];
        for (int it = 0; it < 16; it++) {
            float bv; int bi;
            if (v0 >= v1) { bv = v0; bi = lane; } else { bv = v1; bi = lane + 64; }
#pragma unroll
            for (int o = 32; o > 0; o >>= 1) {
                float ov = __shfl_xor(bv, o); int oi = __shfl_xor(bi, o);
                if (ov > bv || (ov == bv && oi < bi)) { bv = ov; bi = oi; }
            }
            if (lane == 0) sel[it] = (bv > -1e29f) ? bi : -1;
            if (bi == lane) v0 = -3e38f;
            if (bi == lane + 64) v1 = -3e38f;
        }
    }
    __syncthreads();
    {
        float s[16];
        float m = -3e38f;
#pragma unroll
        for (int i = 0; i < 16; i++) {
            int bk = sel[i];
            int pos = bk * 64 + lane;
            if (bk >= 0 && pos <= t) { s[i] = dot64(q, ksn + ((size_t)bg * SEQ + pos) * 64); m = fmaxf(m, s[i]); } else s[i] = -3e38f;
        }
        m = wave_max(m);
        float l = 0.f;
#pragma unroll
        for (int i = 0; i < 16; i++) { s[i] = (s[i] > -1e38f) ? __expf(s[i] - m) : 0.f; l += s[i]; }
        l = wave_sum(l);
        float il = 1.f / l;
#pragma unroll
        for (int i = 0; i < 16; i++) pbuf[w][i * 64 + lane] = s[i] * il;
        __syncthreads();
        for (int i = 0; i < 16; i++) {
            int bk = sel[i];
            if (bk < 0) continue;
            const bf16_t* vp = proj + (size_t)(b * SEQ + bk * 64) * PLD + C_KV + 128 * 3 + 64 * g + lane;
            int kmax = min(64, t - bk * 64 + 1);
            for (int kk = 0; kk < kmax; kk++) o_s += pbuf[w][i * 64 + kk] * bf2f(vp[(size_t)kk * PLD]);
        }
    }
    __syncthreads();
    {
        float s[8];
        float m = -3e38f;
        const int p0 = t - 511;
#pragma unroll
        for (int i = 0; i < 8; i++) {
            int pos = p0 + lane + 64 * i;
            if (pos >= 0) { s[i] = dot64(q, kwn + ((size_t)bg * SEQ + pos) * 64); m = fmaxf(m, s[i]); } else s[i] = -3e38f;
        }
        m = wave_max(m);
        float l = 0.f;
#pragma unroll
        for (int i = 0; i < 8; i++) { s[i] = (s[i] > -1e38f) ? __expf(s[i] - m) : 0.f; l += s[i]; }
        l = wave_sum(l);
        float il = 1.f / l;
#pragma unroll
        for (int i = 0; i < 8; i++) pbuf[w][lane + 64 * i] = s[i] * il;
        __syncthreads();
        int kstart = (p0 < 0) ? -p0 : 0;
        const bf16_t* vp = proj + (size_t)(b * SEQ) * PLD + C_KV + 128 * 5 + 64 * g + lane;
        for (int kk = kstart; kk < 512; kk++) o_w += pbuf[w][kk] * bf2f(vp[(size_t)(p0 + kk) * PLD]);
    }
    const bf16_t* gp = proj + row * PLD + C_GATE + head * 3;
    float g0 = sigmoidf_(bf2f(gp[0])), g1 = sigmoidf_(bf2f(gp[1])), g2 = sigmoidf_(bf2f(gp[2]));
    mix[row * mix_ld + head * 64 + lane] = f2bf(g0 * o_c + g1 * o_s + g2 * o_w);
}

typedef float f32x16 __attribute__((ext_vector_type(16)));
typedef short s16x4 __attribute__((ext_vector_type(4)));
typedef __bf16 bf16x2_t2 __attribute__((ext_vector_type(2)));
#define MFMA32(a, b, c) __builtin_amdgcn_mfma_f32_32x32x16_bf16((a), (b), (c), 0, 0, 0)
#define NKS 72
#define NSA_K_OFF 0
#define NSA_V_OFF (2 * 64 * NKS * 2)
#define NSA_IMP_OFF (NSA_V_OFF + 2 * 64 * NKS * 2)
#define NSA_SEL_OFF (NSA_IMP_OFF + 32 * 128 * 4)
#define NSA_LDS (NSA_SEL_OFF + 32 * 4 * 4)
#define NEGBIG (-1e30f)
__device__ __forceinline__ unsigned pk2(float a, float b) { bf16x2_t2 v; v[0] = (__bf16)a; v[1] = (__bf16)b; return __builtin_bit_cast(unsigned, v); }
__device__ __forceinline__ bf16x8 pack8(float a0, float a1, float a2, float a3, float a4, float a5, float a6, float a7) {
    uint4 u = make_uint4(pk2(a0, a1), pk2(a2, a3), pk2(a4, a5), pk2(a6, a7));
    return __builtin_bit_cast(bf16x8, u);
}
typedef unsigned u32x4 __attribute__((ext_vector_type(4)));
struct NsaStage { u32x4 k0, k1, v0, v1; };
struct NsaCtx {
    const bf16_t* Kbase; long kstride;
    const bf16_t* Vbase; long vstride;
    bf16_t* Kb; bf16_t* Vb;
    float* imp_s; unsigned* sel_s;
    bf16x8 qf[4];
    f32x16 O0, O1;
    float m, l, invl, carry;
    int t, tokl, hp, hh, c, lane;
};
__device__ __forceinline__ void nsa_stage_load(const NsaCtx& X, NsaStage& st, int j) {
    const int r0 = threadIdx.x >> 3, c8 = (threadIdx.x & 7) * 8;
    const bf16_t* kp = X.Kbase + (size_t)(64 * j + r0) * X.kstride + c8;
    const bf16_t* vp = X.Vbase + (size_t)(64 * j + r0) * X.vstride + c8;
    st.k0 = *(const u32x4*)kp; st.k1 = *(const u32x4*)(kp + 32 * X.kstride);
    st.v0 = *(const u32x4*)vp; st.v1 = *(const u32x4*)(vp + 32 * X.vstride);
}
__device__ __forceinline__ void nsa_stage_store(const NsaCtx& X, const NsaStage& st, int buf) {
    const int r0 = threadIdx.x >> 3, c8 = (threadIdx.x & 7) * 8;
    bf16_t* kb = X.Kb + buf * 64 * NKS + r0 * NKS + c8;
    bf16_t* vb = X.Vb + buf * 64 * NKS + r0 * NKS + c8;
    *(u32x4*)kb = st.k0; *(u32x4*)(kb + 32 * NKS) = st.k1;
    *(u32x4*)vb = st.v0; *(u32x4*)(vb + 32 * NKS) = st.v1;
}
template <int MODE>
__device__ __forceinline__ void nsa_tile(NsaCtx& X, int j, int kt, int buf, unsigned long long mlo, unsigned long long mhi) {
    const bf16_t* Kt = X.Kb + buf * 64 * NKS + (32 * kt) * NKS;
    const bf16_t* Vt = X.Vb + buf * 64 * NKS + (32 * kt) * NKS;
    f32x16 S;
#pragma unroll
    for (int i = 0; i < 16; i++) S[i] = 0.f;
#pragma unroll
    for (int s = 0; s < 4; s++) {
        bf16x8 ka = *(const bf16x8*)(Kt + X.c * NKS + 16 * s + 8 * X.hh);
        S = MFMA32(ka, X.qf[s], S);
    }
    const int kbase = 64 * j + 32 * kt;
    int lo = 0, hi;
    bool on = true;
    if (MODE <= 1) hi = ((X.t - 31) >> 4) - kbase;
    else hi = X.t - kbase;
    if (MODE == 3) lo = X.t - 511 - kbase;
    if (MODE == 2) {
        const unsigned long long wsel = (j < 64) ? mlo : mhi;
        on = (wsel >> (j & 63)) & 1ull;
    }
    lo -= 4 * X.hh; hi -= 4 * X.hh;
    if (!on) hi = -1000;
    float P[16];
    if (MODE == 1) {
#pragma unroll
        for (int i = 0; i < 16; i++) {
            const int cr = (i & 3) + 8 * (i >> 2);
            P[i] = (cr <= hi) ? __builtin_amdgcn_exp2f(S[i] - X.m) * X.invl : 0.f;
        }
        float mainv[4], nxt[4];
#pragma unroll
        for (int q = 0; q < 4; q++) { mainv[q] = 2.f * (P[4 * q] + P[4 * q + 1] + P[4 * q + 2]) + P[4 * q + 3]; nxt[q] = P[4 * q + 3]; }
#pragma unroll
        for (int q = 0; q < 4; q++) {
            mainv[q] += __shfl_xor(mainv[q], 1); mainv[q] += __shfl_xor(mainv[q], 2);
            nxt[q] += __shfl_xor(nxt[q], 1); nxt[q] += __shfl_xor(nxt[q], 2);
        }
        float recv[4];
#pragma unroll
        for (int q = 0; q < 4; q++) recv[q] = __shfl_xor(nxt[q], 32);
        const int jsel0 = 16 * j + 8 * kt + X.hh;
#pragma unroll
        for (int q = 0; q < 4; q++) {
            const float tot = mainv[q] + (X.hh ? recv[q] : (q > 0 ? recv[q > 0 ? q - 1 : 0] : X.carry));
            if (X.hp == 0) X.imp_s[X.tokl * 128 + jsel0 + 2 * q] = tot;
        }
        X.carry = recv[3];
    } else {
        float tmax = NEGBIG;
#pragma unroll
        for (int i = 0; i < 16; i++) {
            const int cr = (i & 3) + 8 * (i >> 2);
            const bool vis = (cr <= hi) && (cr >= lo);
            tmax = vis ? fmaxf(tmax, S[i]) : tmax;
        }
        tmax = fmaxf(tmax, __shfl_xor(tmax, 32));
        const float mnew = fmaxf(X.m, tmax);
        const float alpha = __builtin_amdgcn_exp2f(X.m - mnew);
        X.m = mnew;
        float ls = 0.f;
#pragma unroll
        for (int i = 0; i < 16; i++) {
            const int cr = (i & 3) + 8 * (i >> 2);
            const bool vis = (cr <= hi) && (cr >= lo);
            P[i] = vis ? __builtin_amdgcn_exp2f(S[i] - mnew) : 0.f;
            ls += P[i];
        }
        X.l = X.l * alpha + ls;
        if (MODE >= 2) {
#pragma unroll
            for (int i = 0; i < 16; i++) { X.O0[i] *= alpha; X.O1[i] *= alpha; }
        }
    }
    if (MODE >= 1) {
        bf16x8 pb0 = pack8(P[0], P[1], P[2], P[3], P[4], P[5], P[6], P[7]);
        bf16x8 pb1 = pack8(P[8], P[9], P[10], P[11], P[12], P[13], P[14], P[15]);
        const int l15 = X.lane & 15;
        const bf16_t* vrow = Vt + (4 * X.hh + (l15 >> 2)) * NKS + 16 * ((X.lane >> 4) & 1) + 4 * (l15 & 3);
#pragma unroll
        for (int s2 = 0; s2 < 2; s2++) {
#pragma unroll
            for (int dt = 0; dt < 2; dt++) {
                s16x4 lo4 = __builtin_amdgcn_ds_read_tr16_b64_v4i16((LAS3 s16x4*)(vrow + (16 * s2) * NKS + 32 * dt));
                s16x4 hi4 = __builtin_amdgcn_ds_read_tr16_b64_v4i16((LAS3 s16x4*)(vrow + (16 * s2 + 8) * NKS + 32 * dt));
                bf16x8 va = __builtin_shufflevector(lo4, hi4, 0, 1, 2, 3, 4, 5, 6, 7);
                if (dt == 0) X.O0 = MFMA32(va, s2 ? pb1 : pb0, X.O0); else X.O1 = MFMA32(va, s2 ? pb1 : pb0, X.O1);
            }
        }
    }
}
template <int MODE>
__device__ __forceinline__ void nsa_branch(NsaCtx& X, int jlo, int jhi, unsigned long long mlo, unsigned long long mhi, unsigned long long ulo, unsigned long long uhi) {
    NsaStage st;
    nsa_stage_load(X, st, jlo);
    __syncthreads();
    nsa_stage_store(X, st, jlo & 1);
    __syncthreads();
#pragma unroll 1
    for (int j = jlo; j <= jhi; j++) {
        if (j < jhi) nsa_stage_load(X, st, j + 1);
        bool need = true;
        if (MODE == 2) {
            const unsigned long long wsel = (j < 64) ? ulo : uhi;
            need = (wsel >> (j & 63)) & 1ull;
        }
        if (need) {
#pragma unroll 1
            for (int kt = 0; kt < 2; kt++) nsa_tile<MODE>(X, j, kt, j & 1, mlo, mhi);
        }
        if (j < jhi) nsa_stage_store(X, st, (j + 1) & 1);
        __syncthreads();
    }
}
__device__ __forceinline__ void nsa_accum(f32x16& f0, f32x16& f1, const NsaCtx& X, float scale) {
#pragma unroll
    for (int i = 0; i < 16; i++) { f0[i] += X.O0[i] * scale; f1[i] += X.O1[i] * scale; }
}
__device__ __forceinline__ void d_nsa_mfma(const bf16_t* __restrict__ proj, const float* __restrict__ qgain, const float2* __restrict__ rope,
                                           const bf16_t* __restrict__ ksn, const bf16_t* __restrict__ kwn,
                                           const bf16_t* __restrict__ kc, const bf16_t* __restrict__ vc,
                                           bf16_t* __restrict__ mixo, int mix_ld, int item, char* smem) {
    NsaCtx X;
    const int tid = threadIdx.x, lane = tid & 63, w = tid >> 6;
    const int bg = item & 3, tile = 255 - (item >> 2);
    const int b = bg >> 1, g = bg & 1, t0 = tile * 32;
    X.lane = lane; X.c = lane & 31; X.hh = lane >> 5; X.hp = X.c & 3; X.tokl = 8 * w + (X.c >> 2); X.t = t0 + X.tokl;
    X.Kb = (bf16_t*)(smem + NSA_K_OFF); X.Vb = (bf16_t*)(smem + NSA_V_OFF);
    X.imp_s = (float*)(smem + NSA_IMP_OFF); X.sel_s = (unsigned*)(smem + NSA_SEL_OFF);
    const int head = g * 4 + X.hp;
    const size_t row = (size_t)(b * SEQ + X.t);
    {
        float y[4][8];
        const bf16_t* qsrc = proj + row * PLD + C_Q + head * 64 + 8 * X.hh;
        float ss = 0.f;
#pragma unroll
        for (int s = 0; s < 4; s++) {
            const uint4 u = *(const uint4*)(qsrc + 16 * s);
            const unsigned wv[4] = {u.x, u.y, u.z, u.w};
#pragma unroll
            for (int e = 0; e < 4; e++) { y[s][2 * e] = __uint_as_float(wv[e] << 16); y[s][2 * e + 1] = __uint_as_float(wv[e] & 0xffff0000u); }
#pragma unroll
            for (int e = 0; e < 8; e++) ss += y[s][e] * y[s][e];
        }
        ss += __shfl_xor(ss, 32);
        const float r = rsqrtf(ss * (1.f / 64.f) + 1e-6f);
#pragma unroll
        for (int s = 0; s < 4; s++)
#pragma unroll
            for (int e = 0; e < 8; e++) y[s][e] *= r * qgain[16 * s + 8 * X.hh + e];
        const float qs = 0.125f * 1.4426950408889634f;
#pragma unroll
        for (int s = 0; s < 2; s++)
#pragma unroll
            for (int e = 0; e < 8; e++) {
                const float2 cs = rope[(size_t)X.t * 32 + 16 * s + 8 * X.hh + e];
                const float x1 = y[s][e], x2 = y[s + 2][e];
                y[s][e] = (x1 * cs.x - x2 * cs.y) * qs; y[s + 2][e] = (x2 * cs.x + x1 * cs.y) * qs;
            }
#pragma unroll
        for (int s = 0; s < 4; s++) X.qf[s] = pack8(y[s][0], y[s][1], y[s][2], y[s][3], y[s][4], y[s][5], y[s][6], y[s][7]);
    }
    const bf16_t* gp = proj + row * PLD + C_GATE + head * 3;
    const float g0 = sigmoidf_(bf2f(gp[0])), g1 = sigmoidf_(bf2f(gp[1])), g2 = sigmoidf_(bf2f(gp[2]));
    f32x16 F0, F1;
#pragma unroll
    for (int i = 0; i < 16; i++) { F0[i] = 0.f; F1[i] = 0.f; }
    const int cur = t0 >> 6;
    {
        X.Kbase = kc + (size_t)bg * 512 * 64; X.kstride = 64; X.Vbase = vc + (size_t)bg * 512 * 64; X.vstride = 64;
        const int nvmax = (t0 >> 4) + 1, jhi = (nvmax - 1) >> 6;
        X.m = NEGBIG; X.l = 0.f;
        nsa_branch<0>(X, 0, jhi, 0ull, 0ull, 0ull, 0ull);
        const float lt = X.l + __shfl_xor(X.l, 32);
        X.invl = (lt > 0.f) ? 1.f / lt : 0.f;
        X.carry = 0.f;
#pragma unroll
        for (int i = 0; i < 16; i++) { X.O0[i] = 0.f; X.O1[i] = 0.f; }
        nsa_branch<1>(X, 0, jhi, 0ull, 0ull, 0ull, 0ull);
        nsa_accum(F0, F1, X, g0);
    }
    unsigned long long mlo, mhi, ulo, uhi;
    {
        const int tk2 = lane >> 3, sub = lane & 7;
        unsigned k0 = 1u, k1 = 0u, k2 = 0u, k3 = 0u;
#define SETBIT(jj) { const int _j = (jj); if (_j < 32) k0 |= 1u << _j; else if (_j < 64) k1 |= 1u << (_j - 32); else if (_j < 96) k2 |= 1u << (_j - 64); else k3 |= 1u << (_j - 96); }
        SETBIT(cur);
        if (cur >= 1) SETBIT(cur - 1);
        const int ncand = cur - 2;
        if (ncand > 0) {
            if (ncand <= 13) {
                for (int jj = 1; jj <= cur - 2; jj++) SETBIT(jj);
            } else {
                float sc[16];
#pragma unroll
                for (int i = 0; i < 16; i++) { const int jj = sub + 8 * i; sc[i] = (jj >= 1 && jj <= cur - 2) ? X.imp_s[(8 * w + tk2) * 128 + jj] : -3e38f; }
#pragma unroll 1
                for (int it = 0; it < 13; it++) {
                    float bv = sc[0]; int bi = 0;
#pragma unroll
                    for (int i = 1; i < 16; i++) if (sc[i] > bv) { bv = sc[i]; bi = i; }
                    int bj = sub + 8 * bi;
#pragma unroll
                    for (int o = 1; o < 8; o <<= 1) {
                        const float ov = __shfl_xor(bv, o); const int oj = __shfl_xor(bj, o);
                        if (ov > bv || (ov == bv && oj < bj)) { bv = ov; bj = oj; }
                    }
                    SETBIT(bj);
#pragma unroll
                    for (int i = 0; i < 16; i++) if (bj == sub + 8 * i) sc[i] = -3e38f;
                }
            }
        }
#undef SETBIT
        if (sub == 0) { unsigned* d = X.sel_s + (8 * w + tk2) * 4; d[0] = k0; d[1] = k1; d[2] = k2; d[3] = k3; }
        __builtin_amdgcn_s_waitcnt(0xc07f);
        const unsigned* sp = X.sel_s + X.tokl * 4;
        const unsigned m0 = sp[0], m1 = sp[1], m2 = sp[2], m3 = sp[3];
        mlo = (unsigned long long)m0 | ((unsigned long long)m1 << 32); mhi = (unsigned long long)m2 | ((unsigned long long)m3 << 32);
        unsigned u0 = m0, u1 = m1, u2 = m2, u3 = m3;
#pragma unroll
        for (int o = 4; o < 32; o <<= 1) { u0 |= __shfl_xor(u0, o); u1 |= __shfl_xor(u1, o); u2 |= __shfl_xor(u2, o); u3 |= __shfl_xor(u3, o); }
        ulo = (unsigned long long)(unsigned)__builtin_amdgcn_readfirstlane(u0) | ((unsigned long long)(unsigned)__builtin_amdgcn_readfirstlane(u1) << 32);
        uhi = (unsigned long long)(unsigned)__builtin_amdgcn_readfirstlane(u2) | ((unsigned long long)(unsigned)__builtin_amdgcn_readfirstlane(u3) << 32);
    }
    {
        X.Kbase = ksn + (size_t)bg * SEQ * 64; X.kstride = 64;
        X.Vbase = proj + (size_t)(b * SEQ) * PLD + C_KV + 128 * 3 + 64 * g; X.vstride = PLD;
        X.m = NEGBIG; X.l = 0.f;
#pragma unroll
        for (int i = 0; i < 16; i++) { X.O0[i] = 0.f; X.O1[i] = 0.f; }
        nsa_branch<2>(X, 0, cur, mlo, mhi, ulo, uhi);
        const float lt = X.l + __shfl_xor(X.l, 32);
        nsa_accum(F0, F1, X, (lt > 0.f) ? g1 / lt : 0.f);
    }
    {
        X.Kbase = kwn + (size_t)bg * SEQ * 64; X.kstride = 64;
        X.Vbase = proj + (size_t)(b * SEQ) * PLD + C_KV + 128 * 5 + 64 * g; X.vstride = PLD;
        X.m = NEGBIG; X.l = 0.f;
#pragma unroll
        for (int i = 0; i < 16; i++) { X.O0[i] = 0.f; X.O1[i] = 0.f; }
        const int jlo = (t0 >= 511) ? ((t0 - 511) >> 6) : 0;
        nsa_branch<3>(X, jlo, cur, 0ull, 0ull, 0ull, 0ull);
        const float lt = X.l + __shfl_xor(X.l, 32);
        nsa_accum(F0, F1, X, (lt > 0.f) ? g2 / lt : 0.f);
    }
    bf16_t* dst = mixo + row * mix_ld + head * 64 + 4 * X.hh;
#pragma unroll
    for (int q4 = 0; q4 < 4; q4++) {
        *(uint2*)(dst + 8 * q4) = make_uint2(pk2(F0[4 * q4], F0[4 * q4 + 1]), pk2(F0[4 * q4 + 2], F0[4 * q4 + 3]));
        *(uint2*)(dst + 32 + 8 * q4) = make_uint2(pk2(F1[4 * q4], F1[4 * q4 + 1]), pk2(F1[4 * q4 + 2], F1[4 * q4 + 3]));
    }
}

#define KLS 136
#define XSS 264
#define GDN_PREP_LDS (2 * 64 * KLS * 2 + 64 * XSS * 2 + 512)
__device__ __forceinline__ unsigned pack2bf(float lo, float hi) { return (unsigned)f2bf(lo) | ((unsigned)f2bf(hi) << 16); }
__device__ __forceinline__ void d_gdn_prep2(const bf16_t* __restrict__ proj, const float* __restrict__ conv_w,
                                            const float* __restrict__ a_log, const float* __restrict__ dt_bias,
                                            bf16_t* __restrict__ guT, bf16_t* __restrict__ gw, bf16_t* __restrict__ gqd,
                                            bf16_t* __restrict__ gkdT, bf16_t* __restrict__ gin, float* __restrict__ gl, int chunk, char* smem) {
    bf16_t* kL = (bf16_t*)smem;
    bf16_t* qL = kL + 64 * KLS;
    float* AmT = (float*)qL;
    bf16_t* xs = qL + 64 * KLS;
    float* gcs = (float*)(xs + 64 * XSS);
    float* bts = gcs + 64;
    const int tid = threadIdx.x, lane = tid & 63, w = tid >> 6;
    const int n = chunk & 127, h = (chunk >> 7) & 3, b = chunk >> 9;
    const int t0 = n * 64;
    const size_t rbase = (size_t)(b * SEQ + t0);
    if (tid < 64) {
        const size_t r = (rbase + tid) * PLD;
        float a = bf2f(proj[r + C_A + h]), bb = bf2f(proj[r + C_B + h]);
        float xx = a + dt_bias[h];
        float sp = (xx > 20.f) ? xx : log1pf(__expf(xx));
        float c = -__expf(a_log[h]) * sp;
#pragma unroll
        for (int o = 1; o < 64; o <<= 1) { float nb = __shfl_up(c, o); if (lane >= o) c += nb; }
        gcs[tid] = c; bts[tid] = sigmoidf_(bb);
    }
    __syncthreads();
    {
        float wt[6][4], x0[6], x1[6], x2[6];
        int ch[6];
#pragma unroll
        for (int c6 = 0; c6 < 6; c6++) {
            ch[c6] = (c6 >> 1) * 512 + h * 128 + lane + 64 * (c6 & 1);
#pragma unroll
            for (int j = 0; j < 4; j++) wt[c6][j] = conv_w[j * 1536 + ch[c6]];
            const int tb = t0 + 16 * w - 3;
            x0[c6] = (tb >= 0) ? bf2f(proj[((size_t)(b * SEQ + tb)) * PLD + C_GQKV + ch[c6]]) : 0.f;
            x1[c6] = (tb + 1 >= 0) ? bf2f(proj[((size_t)(b * SEQ + tb + 1)) * PLD + C_GQKV + ch[c6]]) : 0.f;
            x2[c6] = (tb + 2 >= 0) ? bf2f(proj[((size_t)(b * SEQ + tb + 2)) * PLD + C_GQKV + ch[c6]]) : 0.f;
        }
        for (int i = 16 * w; i < 16 * w + 16; i++) {
            float sv[6];
#pragma unroll
            for (int c6 = 0; c6 < 6; c6++) {
                float xn = bf2f(proj[(rbase + i) * PLD + C_GQKV + ch[c6]]);
                float cv = x0[c6] * wt[c6][0] + x1[c6] * wt[c6][1] + x2[c6] * wt[c6][2] + xn * wt[c6][3];
                x0[c6] = x1[c6]; x1[c6] = x2[c6]; x2[c6] = xn;
                sv[c6] = cv * sigmoidf_(cv);
            }
            float rq = rsqrtf(wave_sum(sv[0] * sv[0] + sv[1] * sv[1]) + 1e-6f) * 0.08838834764831845f;
            float rk = rsqrtf(wave_sum(sv[2] * sv[2] + sv[3] * sv[3]) + 1e-6f);
            const float bi = bts[i], ei = __expf(gcs[i]);
            float q0 = sv[0] * rq, q1 = sv[1] * rq, k0 = sv[2] * rk, k1 = sv[3] * rk;
            qL[i * KLS + lane] = f2bf(q0); qL[i * KLS + lane + 64] = f2bf(q1);
            kL[i * KLS + lane] = f2bf(k0); kL[i * KLS + lane + 64] = f2bf(k1);
            xs[i * XSS + lane] = f2bf(sv[4] * bi); xs[i * XSS + lane + 64] = f2bf(sv[5] * bi);
            xs[i * XSS + 128 + lane] = f2bf(k0 * bi * ei); xs[i * XSS + 192 + lane] = f2bf(k1 * bi * ei);
            bf16_t* qd = gqd + (size_t)chunk * 8192 + i * 128;
            qd[lane] = f2bf(q0 * ei); qd[lane + 64] = f2bf(q1 * ei);
        }
    }
    __syncthreads();
    const int n16 = lane & 15, kq = lane >> 4;
    f32x4 aqk[4], akk[4];
#pragma unroll
    for (int tj = 0; tj < 4; tj++) { aqk[tj] = (f32x4){0.f, 0.f, 0.f, 0.f}; akk[tj] = (f32x4){0.f, 0.f, 0.f, 0.f}; }
#pragma unroll
    for (int ks = 0; ks < 4; ks++) {
        bf16x8 qa = *(const bf16x8*)(qL + (16 * w + n16) * KLS + 32 * ks + 8 * kq);
        bf16x8 ka = *(const bf16x8*)(kL + (16 * w + n16) * KLS + 32 * ks + 8 * kq);
#pragma unroll
        for (int tj = 0; tj < 4; tj++) {
            bf16x8 kb = *(const bf16x8*)(kL + (16 * tj + n16) * KLS + 32 * ks + 8 * kq);
            aqk[tj] = __builtin_amdgcn_mfma_f32_16x16x32_bf16(qa, kb, aqk[tj], 0, 0, 0);
            akk[tj] = __builtin_amdgcn_mfma_f32_16x16x32_bf16(ka, kb, akk[tj], 0, 0, 0);
        }
    }
    {
        const float glast = gcs[63];
        const int kidx = tid >> 1, c0 = (tid & 1) * 32;
        unsigned pk[16];
#pragma unroll
        for (int cc = 0; cc < 32; cc += 2) {
            float v0 = bf2f(kL[(c0 + cc) * KLS + kidx]) * __expf(glast - gcs[c0 + cc]);
            float v1 = bf2f(kL[(c0 + cc + 1) * KLS + kidx]) * __expf(glast - gcs[c0 + cc + 1]);
            pk[cc >> 1] = pack2bf(v0, v1);
        }
        uint4* dst = (uint4*)(gkdT + (size_t)chunk * 8192 + kidx * 64 + c0);
#pragma unroll
        for (int v4 = 0; v4 < 4; v4++) dst[v4] = make_uint4(pk[4 * v4], pk[4 * v4 + 1], pk[4 * v4 + 2], pk[4 * v4 + 3]);
        if (tid == 0) gl[chunk] = __expf(glast);
    }
    __syncthreads();
#pragma unroll
    for (int tj = 0; tj < 4; tj++)
#pragma unroll
        for (int r = 0; r < 4; r++) {
            const int i = 16 * w + 4 * kq + r, j = 16 * tj + n16;
            const float dec = (j <= i) ? __expf(gcs[i] - gcs[j]) : 0.f;
            gin[(size_t)chunk * 4096 + i * 64 + j] = f2bf(aqk[tj][r] * dec);
            AmT[j * 64 + i] = (j < i) ? bts[i] * akk[tj][r] * dec : 0.f;
        }
    __syncthreads();
    {
        const int c = tid;
#pragma unroll 1
        for (int blk = 0; blk < 8; blk++) {
            const int i0 = blk * 8;
            float acc[8];
#pragma unroll
            for (int r = 0; r < 8; r++) acc[r] = bf2f(xs[(i0 + r) * XSS + c]);
            for (int j = 0; j < i0; j++) {
                const float xj = bf2f(xs[j * XSS + c]);
                const float4 a0 = *(const float4*)(AmT + j * 64 + i0), a1 = *(const float4*)(AmT + j * 64 + i0 + 4);
                acc[0] -= a0.x * xj; acc[1] -= a0.y * xj; acc[2] -= a0.z * xj; acc[3] -= a0.w * xj;
                acc[4] -= a1.x * xj; acc[5] -= a1.y * xj; acc[6] -= a1.z * xj; acc[7] -= a1.w * xj;
            }
#pragma unroll
            for (int r = 1; r < 8; r++)
#pragma unroll
                for (int s2 = 0; s2 < r; s2++) acc[r] -= AmT[(i0 + s2) * 64 + i0 + r] * acc[s2];
#pragma unroll
            for (int r = 0; r < 8; r++) xs[(i0 + r) * XSS + c] = f2bf(acc[r]);
            if (c < 128) {
                *(uint4*)(guT + (size_t)chunk * 8192 + c * 64 + i0) =
                    make_uint4(pack2bf(acc[0], acc[1]), pack2bf(acc[2], acc[3]), pack2bf(acc[4], acc[5]), pack2bf(acc[6], acc[7]));
            } else {
#pragma unroll
                for (int r = 0; r < 8; r++) gw[(size_t)chunk * 8192 + (i0 + r) * 128 + (c - 128)] = f2bf(acc[r]);
            }
        }
    }
}

struct GdnFrag { bf16x8 wA[4], qA[4], inA[2], kdA[2][2]; uint2 uC; float glv; };
__device__ __forceinline__ void gdn_load_frag(GdnFrag& f, const bf16_t* __restrict__ guT, const bf16_t* __restrict__ gw, const bf16_t* __restrict__ gqd,
                                              const bf16_t* __restrict__ gkdT, const bf16_t* __restrict__ gin, const float* __restrict__ gl,
                                              int chunk, int w, int sl, int n16, int kq) {
    const size_t cb = (size_t)chunk * 8192;
#pragma unroll
    for (int ks = 0; ks < 4; ks++) {
        f.wA[ks] = *(const bf16x8*)(gw + cb + (16 * w + n16) * 128 + 32 * ks + 8 * kq);
        f.qA[ks] = *(const bf16x8*)(gqd + cb + (16 * w + n16) * 128 + 32 * ks + 8 * kq);
    }
#pragma unroll
    for (int ks = 0; ks < 2; ks++) {
        f.inA[ks] = *(const bf16x8*)(gin + (size_t)chunk * 4096 + (16 * w + n16) * 64 + 32 * ks + 8 * kq);
        f.kdA[0][ks] = *(const bf16x8*)(gkdT + cb + (32 * w + n16) * 64 + 32 * ks + 8 * kq);
        f.kdA[1][ks] = *(const bf16x8*)(gkdT + cb + (32 * w + 16 + n16) * 64 + 32 * ks + 8 * kq);
    }
    f.uC = *(const uint2*)(guT + cb + (16 * sl + n16) * 64 + 16 * w + 4 * kq);
    f.glv = gl[chunk];
}
#define STS 144
#define VNS 80
__device__ __forceinline__ void gdn_step(const GdnFrag& f, f32x4& S0, f32x4& S1, bf16_t* StT, bf16_t* vnT, float* __restrict__ ogrow, int w, int n16, int kq) {
    f32x4 ws = (f32x4){0.f, 0.f, 0.f, 0.f}, qs = (f32x4){0.f, 0.f, 0.f, 0.f};
#pragma unroll
    for (int ks = 0; ks < 4; ks++) {
        bf16x8 sb = *(const bf16x8*)(StT + n16 * STS + 32 * ks + 8 * kq);
        ws = __builtin_amdgcn_mfma_f32_16x16x32_bf16(f.wA[ks], sb, ws, 0, 0, 0);
        qs = __builtin_amdgcn_mfma_f32_16x16x32_bf16(f.qA[ks], sb, qs, 0, 0, 0);
    }
    float v0 = __uint_as_float(f.uC.x << 16) - ws[0], v1 = __uint_as_float(f.uC.x & 0xffff0000u) - ws[1];
    float v2 = __uint_as_float(f.uC.y << 16) - ws[2], v3 = __uint_as_float(f.uC.y & 0xffff0000u) - ws[3];
    *(uint2*)(vnT + n16 * VNS + 16 * w + 4 * kq) = make_uint2(pack2bf(v0, v1), pack2bf(v2, v3));
    __syncthreads();
    bf16x8 vb0 = *(const bf16x8*)(vnT + n16 * VNS + 8 * kq), vb1 = *(const bf16x8*)(vnT + n16 * VNS + 32 + 8 * kq);
    qs = __builtin_amdgcn_mfma_f32_16x16x32_bf16(f.inA[0], vb0, qs, 0, 0, 0);
    qs = __builtin_amdgcn_mfma_f32_16x16x32_bf16(f.inA[1], vb1, qs, 0, 0, 0);
    S0 = S0 * f.glv; S1 = S1 * f.glv;
    S0 = __builtin_amdgcn_mfma_f32_16x16x32_bf16(f.kdA[0][0], vb0, S0, 0, 0, 0);
    S0 = __builtin_amdgcn_mfma_f32_16x16x32_bf16(f.kdA[0][1], vb1, S0, 0, 0, 0);
    S1 = __builtin_amdgcn_mfma_f32_16x16x32_bf16(f.kdA[1][0], vb0, S1, 0, 0, 0);
    S1 = __builtin_amdgcn_mfma_f32_16x16x32_bf16(f.kdA[1][1], vb1, S1, 0, 0, 0);
#pragma unroll
    for (int r = 0; r < 4; r++) ogrow[(size_t)(4 * kq + r) * 512] = qs[r];
    *(uint2*)(StT + n16 * STS + 32 * w + 4 * kq) = make_uint2(pack2bf(S0[0], S0[1]), pack2bf(S0[2], S0[3]));
    *(uint2*)(StT + n16 * STS + 32 * w + 16 + 4 * kq) = make_uint2(pack2bf(S1[0], S1[1]), pack2bf(S1[2], S1[3]));
    __syncthreads();
}
__device__ __forceinline__ void d_gdn_scan2(const bf16_t* __restrict__ guT, const bf16_t* __restrict__ gw, const bf16_t* __restrict__ gqd,
                                            const bf16_t* __restrict__ gkdT, const bf16_t* __restrict__ gin, const float* __restrict__ gl,
                                            float* __restrict__ og, int item, char* smem) {
    bf16_t* StT = (bf16_t*)smem;
    bf16_t* vnT = StT + 16 * STS;
    const int tid = threadIdx.x, lane = tid & 63, w = tid >> 6, n16 = lane & 15, kq = lane >> 4;
    const int bh = item >> 3, sl = item & 7, b = bh >> 2, h = bh & 3;
    for (int i = tid; i < 16 * STS / 2; i += 256) ((unsigned*)StT)[i] = 0u;
    f32x4 S0 = (f32x4){0.f, 0.f, 0.f, 0.f}, S1 = (f32x4){0.f, 0.f, 0.f, 0.f};
    GdnFrag fa, fb;
    gdn_load_frag(fa, guT, gw, gqd, gkdT, gin, gl, bh * 128, w, sl, n16, kq);
    __syncthreads();
    float* obase = og + (size_t)(b * SEQ + 16 * w) * 512 + h * 128 + 16 * sl + n16;
#pragma unroll 1
    for (int n = 0; n < 128; n += 2) {
        gdn_load_frag(fb, guT, gw, gqd, gkdT, gin, gl, bh * 128 + n + 1, w, sl, n16, kq);
        gdn_step(fa, S0, S1, StT, vnT, obase + (size_t)(n * 64) * 512, w, n16, kq);
        if (n + 2 < 128) gdn_load_frag(fa, guT, gw, gqd, gkdT, gin, gl, bh * 128 + n + 2, w, sl, n16, kq);
        gdn_step(fb, S0, S1, StT, vnT, obase + (size_t)((n + 1) * 64) * 512, w, n16, kq);
    }
}

__device__ __forceinline__ void d_gdn_out(const float* __restrict__ og, const bf16_t* __restrict__ proj, const float* __restrict__ gain, bf16_t* __restrict__ mix, int bid) {
    int id = bid * 4 + (threadIdx.x >> 6);
    int lane = threadIdx.x & 63;
    int t = id >> 2, h = id & 3;
    const float* o = og + (size_t)t * 512 + h * 128;
    float a0 = o[lane], a1 = o[lane + 64];
    float ss = wave_sum(a0 * a0 + a1 * a1);
    float r = rsqrtf(ss * (1.f / 128.f) + 1e-6f);
    const bf16_t* z = proj + (size_t)t * PLD + C_Z + h * 128;
    float z0 = bf2f(z[lane]), z1 = bf2f(z[lane + 64]);
    mix[(size_t)t * DM + 512 + h * 128 + lane] = f2bf(a0 * r * gain[lane] * z0 * sigmoidf_(z0));
    mix[(size_t)t * DM + 512 + h * 128 + lane + 64] = f2bf(a1 * r * gain[lane + 64] * z1 * sigmoidf_(z1));
}

__device__ __forceinline__ void d_peer_route(const bf16_t* __restrict__ qry, const float* __restrict__ subkeys, int* __restrict__ eidx, float* __restrict__ pgate, int bid, char* smem) {
    float (*qsh)[256] = (float (*)[256])smem;
    float (*tv)[2][16] = (float (*)[2][16])(smem + 4096);
    int (*ti)[2][16] = (int (*)[2][16])(smem + 4096 + 512);
    const int lane = threadIdx.x & 63, w = threadIdx.x >> 6;
    const int id = bid * 4 + w;
    const int t = id >> 3, h = id & 7;
    const bf16_t* qp = qry + (size_t)t * 2048 + h * 256;
#pragma unroll
    for (int i = 0; i < 4; i++) qsh[w][lane + 64 * i] = bf2f(qp[lane + 64 * i]);
    __syncthreads();
    for (int half = 0; half < 2; half++) {
        const float* sk0 = subkeys + ((size_t)half * 128 + lane) * 128;
        const float* sk1 = sk0 + 64 * 128;
        float s0 = 0.f, s1 = 0.f;
        for (int d = 0; d < 128; d += 4) {
            float4 a = *(const float4*)(sk0 + d), c = *(const float4*)(sk1 + d);
            float4 qq = *(const float4*)(&qsh[w][half * 128 + d]);
            s0 += a.x * qq.x + a.y * qq.y + a.z * qq.z + a.w * qq.w;
            s1 += c.x * qq.x + c.y * qq.y + c.z * qq.z + c.w * qq.w;
        }
        for (int it = 0; it < 16; it++) {
            float bv; int bi;
            if (s0 >= s1) { bv = s0; bi = lane; } else { bv = s1; bi = lane + 64; }
#pragma unroll
            for (int o = 32; o > 0; o >>= 1) {
                float ov = __shfl_xor(bv, o); int oi = __shfl_xor(bi, o);
                if (ov > bv || (ov == bv && oi < bi)) { bv = ov; bi = oi; }
            }
            if (lane == 0) { tv[w][half][it] = bv; ti[w][half][it] = bi; }
            if (bi == lane) s0 = -3e38f;
            if (bi == lane + 64) s1 = -3e38f;
        }
    }
    __syncthreads();
    float cv[4];
#pragma unroll
    for (int i = 0; i < 4; i++) { int f = lane * 4 + i; cv[i] = tv[w][0][f >> 4] + tv[w][1][f & 15]; }
    float topv = 0.f; int tope = 0;
    float mx = 0.f;
    for (int it = 0; it < 16; it++) {
        float bv = cv[0]; int bi = lane * 4;
#pragma unroll
        for (int i = 1; i < 4; i++) if (cv[i] > bv) { bv = cv[i]; bi = lane * 4 + i; }
#pragma unroll
        for (int o = 32; o > 0; o >>= 1) {
            float ov = __shfl_xor(bv, o); int oi = __shfl_xor(bi, o);
            if (ov > bv || (ov == bv && oi < bi)) { bv = ov; bi = oi; }
        }
        if (it == 0) mx = bv;
        if (lane == it) { topv = bv; tope = ti[w][0][bi >> 4] * 128 + ti[w][1][bi & 15]; }
#pragma unroll
        for (int i = 0; i < 4; i++) if (bi == lane * 4 + i) cv[i] = -3e38f;
    }
    float e = (lane < 16) ? __expf(topv - mx) : 0.f;
    float sum = wave_sum(e);
    if (lane < 16) {
        eidx[(size_t)t * 128 + h * 16 + lane] = tope;
        pgate[(size_t)t * 128 + h * 16 + lane] = e / sum;
    }
}

__device__ __forceinline__ void d_peer_expert(const bf16_t* __restrict__ h2, const int* __restrict__ eidx, const float* __restrict__ pgate,
                                                     const float* __restrict__ utab, const float* __restrict__ vtab, float* __restrict__ out, int bid, char* smem) {
    float (*red)[1024] = (float (*)[1024])smem;
    const int t = bid;
    const int lane = threadIdx.x & 63, w = threadIdx.x >> 6;
    float x[16], acc[16];
#pragma unroll
    for (int i = 0; i < 4; i++) {
        ushort4 u = ((const ushort4*)(h2 + (size_t)t * DM))[lane + 64 * i];
        x[i * 4 + 0] = bf2f(u.x); x[i * 4 + 1] = bf2f(u.y); x[i * 4 + 2] = bf2f(u.z); x[i * 4 + 3] = bf2f(u.w);
    }
#pragma unroll
    for (int i = 0; i < 16; i++) acc[i] = 0.f;
    for (int k = 0; k < 32; k++) {
        int e = eidx[(size_t)t * 128 + w * 32 + k];
        float gt = pgate[(size_t)t * 128 + w * 32 + k];
        const float4* ur = (const float4*)(utab + (size_t)e * DM);
        float d = 0.f;
#pragma unroll
        for (int i = 0; i < 4; i++) {
            float4 u = ur[lane + 64 * i];
            d += u.x * x[i * 4] + u.y * x[i * 4 + 1] + u.z * x[i * 4 + 2] + u.w * x[i * 4 + 3];
        }
        d = wave_sum(d);
        float coef = gt * gelu_tanh(d);
        const float4* vr = (const float4*)(vtab + (size_t)e * DM);
#pragma unroll
        for (int i = 0; i < 4; i++) {
            float4 v = vr[lane + 64 * i];
            acc[i * 4] += coef * v.x; acc[i * 4 + 1] += coef * v.y; acc[i * 4 + 2] += coef * v.z; acc[i * 4 + 3] += coef * v.w;
        }
    }
#pragma unroll
    for (int i = 0; i < 4; i++) *(float4*)(&red[w][(lane + 64 * i) * 4]) = make_float4(acc[i * 4], acc[i * 4 + 1], acc[i * 4 + 2], acc[i * 4 + 3]);
    __syncthreads();
    for (int c = threadIdx.x; c < 1024; c += 256) {
        out[(size_t)t * DM + c] += red[0][c] + red[1][c] + red[2][c] + red[3][c];
    }
}

template <int CTRL> __device__ __forceinline__ float dppf(float x) { return __builtin_bit_cast(float, __builtin_amdgcn_update_dpp(0, __builtin_bit_cast(int, x), CTRL, 0xf, 0xf, true)); }
template <int CTRL> __device__ __forceinline__ unsigned dppu(unsigned x) { return (unsigned)__builtin_amdgcn_update_dpp(0, (int)x, CTRL, 0xf, 0xf, true); }
__device__ __forceinline__ float allmax16(float x) {
    x = fmaxf(x, dppf<0xB1>(x)); x = fmaxf(x, dppf<0x4E>(x)); x = fmaxf(x, dppf<0x141>(x)); x = fmaxf(x, dppf<0x140>(x)); return x;
}
__device__ __forceinline__ unsigned allmaxu16(unsigned x) {
    x = max(x, dppu<0xB1>(x)); x = max(x, dppu<0x4E>(x)); x = max(x, dppu<0x141>(x)); x = max(x, dppu<0x140>(x)); return x;
}
__device__ __forceinline__ float allsum16(float x) {
    x += dppf<0xB1>(x); x += dppf<0x4E>(x); x += dppf<0x141>(x); x += dppf<0x140>(x); return x;
}
__device__ __forceinline__ void route_load_subkeys(const float* __restrict__ subkeys, char* smem) {
    for (int idx = threadIdx.x; idx < 2 * 128 * 16; idx += 256) {
        const int half = idx >> 11, key = (idx >> 4) & 127, ch = idx & 15;
        const float* src = subkeys + ((size_t)(half * 128 + key)) * 128 + ch * 8;
        const float4 x0 = *(const float4*)src, x1 = *(const float4*)(src + 4);
        *(uint4*)(smem + half * 32768 + key * 256 + ((ch ^ (key & 15)) << 4)) = make_uint4(pk2(x0.x, x0.y), pk2(x0.z, x0.w), pk2(x1.x, x1.y), pk2(x1.z, x1.w));
    }
}
#define CEX(i, j) { const float _a = v[i], _b = v[j]; v[i] = fmaxf(_a, _b); v[j] = fminf(_a, _b); }
__device__ __forceinline__ void d_peer_route2(const bf16_t* __restrict__ qry, int* __restrict__ eidx, float* __restrict__ pgate, int mtile, const char* smem, int lane) {
    const int n16 = lane & 15, kq = lane >> 4;
    const int tA = 2 * mtile + (n16 >> 3), hA = n16 & 7;
    float topv[2][4];
#pragma unroll
    for (int half = 0; half < 2; half++) {
        const bf16_t* qp = qry + (size_t)tA * 2048 + hA * 256 + half * 128 + 8 * kq;
        bf16x8 a[4];
#pragma unroll
        for (int ks = 0; ks < 4; ks++) a[ks] = *(const bf16x8*)(qp + 32 * ks);
        f32x4 acc[8];
#pragma unroll
        for (int nt = 0; nt < 8; nt++) acc[nt] = (f32x4){0.f, 0.f, 0.f, 0.f};
#pragma unroll
        for (int ks = 0; ks < 4; ks++)
#pragma unroll
            for (int nt = 0; nt < 8; nt++) {
                const bf16x8 bb = *(const bf16x8*)(smem + half * 32768 + (16 * nt + n16) * 256 + (((4 * ks + kq) ^ n16) << 4));
                acc[nt] = __builtin_amdgcn_mfma_f32_16x16x32_bf16(a[ks], bb, acc[nt], 0, 0, 0);
                if (nt == 3 || nt == 7) __builtin_amdgcn_sched_barrier(0);
            }
#pragma unroll
        for (int r = 0; r < 4; r++) {
            float v[8];
#pragma unroll
            for (int nt = 0; nt < 8; nt++) v[nt] = __uint_as_float((__float_as_uint(acc[nt][r]) & 0xFFFFFF80u) | (unsigned)(nt << 4) | (unsigned)n16);
            CEX(0, 1) CEX(2, 3) CEX(4, 5) CEX(6, 7) CEX(0, 2) CEX(1, 3) CEX(4, 6) CEX(5, 7) CEX(1, 2) CEX(5, 6)
            CEX(0, 4) CEX(1, 5) CEX(2, 6) CEX(3, 7) CEX(2, 4) CEX(3, 5) CEX(1, 2) CEX(3, 4) CEX(5, 6)
            float keep = 0.f;
#pragma unroll 1
            for (int it = 0; it < 16; it++) {
                const float mx = allmax16(v[0]);
                if (n16 == it) keep = mx;
                if (__float_as_uint(v[0]) == __float_as_uint(mx)) {
                    v[0] = v[1]; v[1] = v[2]; v[2] = v[3]; v[3] = v[4]; v[4] = v[5]; v[5] = v[6]; v[6] = v[7]; v[7] = -3e38f;
                }
            }
            topv[half][r] = keep;
            __builtin_amdgcn_sched_barrier(0);
        }
    }
#pragma unroll
    for (int r = 0; r < 4; r++) {
        const float v1p = topv[0][r], v2p = topv[1][r];
        const unsigned u1 = __float_as_uint(v1p);
        const int i1 = (int)(((u1 >> 4) & 7u) * 16u + (u1 & 15u));
        const int lim = 16 / (n16 + 1);
        int ptr = 0;
        const int lanebase = (lane & 48);
        float cur2 = __builtin_bit_cast(float, __builtin_amdgcn_ds_bpermute(lanebase * 4, __builtin_bit_cast(int, v2p)));
        float head = __uint_as_float((__float_as_uint(v1p + cur2) & 0xFFFFFFF0u) | (unsigned)n16);
        float ksc = 0.f; unsigned ke = 0u;
#pragma unroll 1
        for (int it = 0; it < 16; it++) {
            const float mx = allmax16(head);
            const bool win = __float_as_uint(head) == __float_as_uint(mx);
            const unsigned u2 = __float_as_uint(cur2);
            unsigned e = win ? (unsigned)(i1 * 128) + ((u2 >> 4) & 7u) * 16u + (u2 & 15u) : 0u;
            e = allmaxu16(e);
            if (n16 == it) { ksc = mx; ke = e; }
            if (win) ptr++;
            const int pn = ptr < 15 ? ptr : 15;
            const float nx = __builtin_bit_cast(float, __builtin_amdgcn_ds_bpermute((lanebase + pn) * 4, __builtin_bit_cast(int, v2p)));
            if (win) { cur2 = nx; head = (ptr < lim) ? __uint_as_float((__float_as_uint(v1p + cur2) & 0xFFFFFFF0u) | (unsigned)n16) : -3e38f; }
        }
        const float smax = allmax16(ksc);
        const float ex = __expf(ksc - smax);
        const float sum = allsum16(ex);
        const int row = 4 * kq + r;
        const size_t o = (size_t)(2 * mtile + (row >> 3)) * 128 + (row & 7) * 16 + n16;
        eidx[o] = (int)ke; pgate[o] = ex / sum;
    }
}
#undef CEX

__device__ __forceinline__ void d_quant_row(const float* __restrict__ src, unsigned char* __restrict__ dst, float* __restrict__ scale, int row, int lane, int bias) {
    const float4* p = (const float4*)(src + (size_t)row * DM) + lane * 4;
    float4 x[4];
    float am = 0.f;
#pragma unroll
    for (int i = 0; i < 4; i++) { x[i] = p[i]; am = fmaxf(am, fmaxf(fmaxf(fabsf(x[i].x), fabsf(x[i].y)), fmaxf(fabsf(x[i].z), fabsf(x[i].w)))); }
    am = wave_max(am);
    const float sc = (am > 0.f) ? am * (1.f / 127.f) : 1.f;
    const float inv = 1.f / sc;
    unsigned wv[4];
#pragma unroll
    for (int i = 0; i < 4; i++) {
        const int q0 = (int)rintf(x[i].x * inv) + bias, q1 = (int)rintf(x[i].y * inv) + bias, q2 = (int)rintf(x[i].z * inv) + bias, q3 = (int)rintf(x[i].w * inv) + bias;
        wv[i] = (unsigned)(q0 & 0xff) | ((unsigned)(q1 & 0xff) << 8) | ((unsigned)(q2 & 0xff) << 16) | ((unsigned)(q3 & 0xff) << 24);
    }
    ((uint4*)(dst + (size_t)row * DM))[lane] = make_uint4(wv[0], wv[1], wv[2], wv[3]);
    if (lane == 0) scale[row] = sc;
}

struct PeerGrp { u32x4 u[4]; u32x4 v[4]; float gv[4]; float su[4]; };
__device__ __forceinline__ void peer_load(PeerGrp& G, const unsigned char* __restrict__ uq, const unsigned char* __restrict__ vq,
                                          int esrc, float gsrc, float susrc, int k0, int lane) {
#pragma unroll
    for (int i = 0; i < 4; i++) {
        const int e = __builtin_amdgcn_readlane(esrc, (k0 + i) & 63);
        G.gv[i] = __builtin_bit_cast(float, __builtin_amdgcn_readlane(__builtin_bit_cast(int, gsrc), (k0 + i) & 63));
        G.su[i] = __builtin_bit_cast(float, __builtin_amdgcn_readlane(__builtin_bit_cast(int, susrc), (k0 + i) & 63));
        G.u[i] = ((const u32x4*)(uq + (size_t)e * DM))[lane];
        G.v[i] = ((const u32x4*)(vq + (size_t)e * DM))[lane];
    }
}
__device__ __forceinline__ void peer_compute(const PeerGrp& G, const int (&xq)[4], float sx, float (&acc)[16], float& bsum) {
    int d[4];
#pragma unroll
    for (int i = 0; i < 4; i++) {
        int sdot = 0;
        sdot = __builtin_amdgcn_sdot4((int)G.u[i][0], xq[0], sdot, false); sdot = __builtin_amdgcn_sdot4((int)G.u[i][1], xq[1], sdot, false);
        sdot = __builtin_amdgcn_sdot4((int)G.u[i][2], xq[2], sdot, false); sdot = __builtin_amdgcn_sdot4((int)G.u[i][3], xq[3], sdot, false);
        d[i] = sdot;
    }
#pragma unroll
    for (int o = 32; o > 0; o >>= 1) {
#pragma unroll
        for (int i = 0; i < 4; i++) d[i] += __shfl_xor(d[i], o);
    }
#pragma unroll
    for (int i = 0; i < 4; i++) {
        const float dot = (float)d[i] * (G.su[i] * sx);
        const float cs = G.gv[i] * gelu_tanh(dot);
        bsum += cs;
#pragma unroll
        for (int j = 0; j < 4; j++) {
            const unsigned wv = G.v[i][j];
            acc[4 * j] += cs * (float)(wv & 0xffu);
            acc[4 * j + 1] += cs * (float)((wv >> 8) & 0xffu);
            acc[4 * j + 2] += cs * (float)((wv >> 16) & 0xffu);
            acc[4 * j + 3] += cs * (float)(wv >> 24);
        }
    }
}
__device__ __forceinline__ void d_peer_expert3(const bf16_t* __restrict__ h2, const int* __restrict__ eidx, const float* __restrict__ pgate,
                                               const unsigned char* __restrict__ uq, const unsigned char* __restrict__ vq,
                                               const float* __restrict__ su, const float* __restrict__ sv, float* __restrict__ out, int token, int lane) {
    const uint4 xa = ((const uint4*)(h2 + (size_t)token * DM))[2 * lane], xb = ((const uint4*)(h2 + (size_t)token * DM))[2 * lane + 1];
    const unsigned xw[8] = {xa.x, xa.y, xa.z, xa.w, xb.x, xb.y, xb.z, xb.w};
    float xf[16];
    float am = 0.f;
#pragma unroll
    for (int j = 0; j < 8; j++) { xf[2 * j] = __uint_as_float(xw[j] << 16); xf[2 * j + 1] = __uint_as_float(xw[j] & 0xffff0000u); am = fmaxf(am, fmaxf(fabsf(xf[2 * j]), fabsf(xf[2 * j + 1]))); }
    am = wave_max(am);
    const float sx = (am > 0.f) ? am * (1.f / 127.f) : 1.f;
    const float isx = 1.f / sx;
    int xq[4];
#pragma unroll
    for (int j = 0; j < 4; j++) {
        const int q0 = (int)rintf(xf[4 * j] * isx), q1 = (int)rintf(xf[4 * j + 1] * isx), q2 = (int)rintf(xf[4 * j + 2] * isx), q3 = (int)rintf(xf[4 * j + 3] * isx);
        xq[j] = (int)((unsigned)(q0 & 0xff) | ((unsigned)(q1 & 0xff) << 8) | ((unsigned)(q2 & 0xff) << 16) | ((unsigned)(q3 & 0xff) << 24));
    }
    float acc[16];
#pragma unroll
    for (int i = 0; i < 16; i++) acc[i] = 0.f;
    float bsum = 0.f;
    const int e_lo = eidx[(size_t)token * 128 + lane], e_hi = eidx[(size_t)token * 128 + 64 + lane];
    const float g_lo = pgate[(size_t)token * 128 + lane] * sv[e_lo], g_hi = pgate[(size_t)token * 128 + 64 + lane] * sv[e_hi];
    const float s_lo = su[e_lo], s_hi = su[e_hi];
    PeerGrp A, B;
    peer_load(A, uq, vq, e_lo, g_lo, s_lo, 0, lane);
#pragma unroll 1
    for (int k0 = 0; k0 < 64; k0 += 8) {
        peer_load(B, uq, vq, e_lo, g_lo, s_lo, k0 + 4, lane);
        peer_compute(A, xq, sx, acc, bsum);
        if (k0 + 8 < 64) peer_load(A, uq, vq, e_lo, g_lo, s_lo, k0 + 8, lane); else peer_load(A, uq, vq, e_hi, g_hi, s_hi, 0, lane);
        peer_compute(B, xq, sx, acc, bsum);
    }
#pragma unroll 1
    for (int k0 = 0; k0 < 64; k0 += 8) {
        peer_load(B, uq, vq, e_hi, g_hi, s_hi, k0 + 4, lane);
        peer_compute(A, xq, sx, acc, bsum);
        if (k0 + 8 < 64) peer_load(A, uq, vq, e_hi, g_hi, s_hi, k0 + 8, lane);
        peer_compute(B, xq, sx, acc, bsum);
    }
    const float bs = 128.f * bsum;
    float4* o = (float4*)(out + (size_t)token * DM + lane * 16);
#pragma unroll
    for (int j = 0; j < 4; j++) {
        float4 t = o[j];
        t.x += acc[4 * j] - bs; t.y += acc[4 * j + 1] - bs; t.z += acc[4 * j + 2] - bs; t.w += acc[4 * j + 3] - bs;
        o[j] = t;
    }
}

#define XB_TMO      128
#define XB_XCNT(j)  (256  + 64 * (j))
#define XB_XSUB(j)  (1280 + 64 * (j))
#define XB_XGEN(j)  (2304 + 64 * (j))
#define XB_TOP      3328
#define XB_TOPGEN   3392
#define XB_QUEUE    3456
#define XCD_BAR_WORDS 4096
#define XB_SPIN_CAP (1u << 22)
#define LAS __attribute__((address_space(3)))
__device__ __forceinline__ unsigned xb_ld(unsigned* p)              { return __hip_atomic_load(p, __ATOMIC_RELAXED, __HIP_MEMORY_SCOPE_AGENT); }
__device__ __forceinline__ unsigned xb_add(unsigned* p, unsigned v) { return __hip_atomic_fetch_add(p, v, __ATOMIC_RELAXED, __HIP_MEMORY_SCOPE_AGENT); }
__device__ __forceinline__ unsigned xb_xcc_id() { return (unsigned)__builtin_amdgcn_s_getreg((3 << 11) | 20) & 0xFu; }
#define XB_SPIN(cond, bar) do { unsigned _sp = 0; while (cond) { __builtin_amdgcn_s_sleep(1); \
    if ((++_sp & 255u) == 0u) { if (xb_ld(&(bar)[XB_TMO])) break; if (_sp > XB_SPIN_CAP) { atomicAdd(&(bar)[XB_TMO], 1u); break; } } } } while (0)
struct XcdBarrier { unsigned* bar; unsigned x; volatile LAS unsigned* st; };
__device__ __forceinline__ XcdBarrier xcd_barrier_post(unsigned* bar, volatile LAS unsigned* st) {
    XcdBarrier b; b.bar = bar; b.x = xb_xcc_id(); b.st = st;
    if (threadIdx.x == 0) (void)xb_add(&bar[XB_XCNT(b.x)], 1u);
    return b;
}
__device__ __forceinline__ void xcd_barrier_complete(unsigned* bar, unsigned x, unsigned& nloc, unsigned& nx) {
    const unsigned G = gridDim.x * gridDim.y * gridDim.z;
    unsigned sum, cnt, mine, sp = 0u;
    for (;;) {
        sum = 0u; cnt = 0u; mine = 0u;
#pragma unroll
        for (unsigned j = 0; j < 16; ++j) { const unsigned c = xb_ld(&bar[XB_XCNT(j)]); sum += c; cnt += (c > 0u) ? 1u : 0u; mine = (j == x) ? c : mine; }
        if (sum == G) break;
        __builtin_amdgcn_s_sleep(1);
        if ((++sp & 255u) == 0u) { if (xb_ld(&bar[XB_TMO])) break; if (sp > XB_SPIN_CAP) { atomicAdd(&bar[XB_TMO], 1u); break; } }
    }
    nloc = mine > 0u ? mine : 1u; nx = cnt > 0u ? cnt : 1u;
}
__device__ __forceinline__ void xcd_barrier(const XcdBarrier& b) {
    asm volatile("s_waitcnt vmcnt(0)" ::: "memory");
    __syncthreads();
    if (threadIdx.x == 0) {
        unsigned* bar = b.bar;
        __builtin_amdgcn_s_waitcnt(0);
        unsigned nloc = b.st[0], nx = b.st[1];
        if (nloc == 0u) { xcd_barrier_complete(bar, b.x, nloc, nx); b.st[0] = nloc; b.st[1] = nx; }
        const unsigned old = xb_add(&bar[XB_XSUB(b.x)], 1u);
        const unsigned gen = old / nloc;
        if (old + 1u == (gen + 1u) * nloc) {
            __builtin_amdgcn_fence(__ATOMIC_RELEASE, "agent");
            asm volatile("s_waitcnt vmcnt(0)" ::: "memory");
            const unsigned og = xb_add(&bar[XB_TOP], 1u);
            const unsigned tg = og / nx;
            if (og + 1u == (tg + 1u) * nx) xb_add(&bar[XB_TOPGEN], 1u);
            else XB_SPIN(xb_ld(&bar[XB_TOPGEN]) == tg, bar);
            __builtin_amdgcn_fence(__ATOMIC_ACQUIRE, "agent");
            xb_add(&bar[XB_XGEN(b.x)], 1u);
            asm volatile("s_waitcnt vmcnt(0)" ::: "memory");
        } else {
            XB_SPIN(xb_ld(&bar[XB_XGEN(b.x)]) == gen, bar);
            __builtin_amdgcn_fence(__ATOMIC_ACQUIRE, "agent");
            asm volatile("s_waitcnt vmcnt(0)" ::: "memory");
        }
    }
    __syncthreads();
}

struct MKP {
    const float *x, *attn_norm, *w_in, *q_gain, *k_gain, *cmp_pos, *cmp_w1, *cmp_w2, *gdn_conv, *a_log, *dt_bias, *out_gain, *w_out, *ffn_norm, *w_query, *subkeys, *peer_u, *peer_v;
    float* out; char* ws; unsigned* bar;
};

#define SMEM_BYTES 69120

__global__ __launch_bounds__(256, 2) void hybrid_megakernel(MKP P) {
    extern __shared__ __attribute__((aligned(16))) char smem[];
    __shared__ uint4 xb_words;
    __shared__ int q_item;
    const int G = gridDim.x, bid0 = blockIdx.x;
    if (threadIdx.x == 0) xb_words = make_uint4(0u, 0u, 0u, 0u);
    __syncthreads();
    XcdBarrier B = xcd_barrier_post(P.bar, (volatile LAS unsigned*)&xb_words);
    char* ws = P.ws;
    bf16_t* w_in_t = (bf16_t*)(ws + OFF_WINT);
    bf16_t* w_out_t = (bf16_t*)(ws + OFF_WOUTT);
    bf16_t* w_q_t = (bf16_t*)(ws + OFF_WQT);
    bf16_t* cw1_t = (bf16_t*)(ws + OFF_CW1T);
    float* cbias = (float*)(ws + OFF_CBIAS);
    bf16_t* h_bf = (bf16_t*)(ws + OFF_HBF);
    bf16_t* proj = (bf16_t*)(ws + OFF_PROJ);
    bf16_t* ksn = (bf16_t*)(ws + OFF_KSN);
    bf16_t* kwn = (bf16_t*)(ws + OFF_KWN);
    bf16_t* kc = (bf16_t*)(ws + OFF_KC);
    bf16_t* vc = (bf16_t*)(ws + OFF_VC);
    bf16_t* hid = (bf16_t*)(ws + OFF_HID);
    bf16_t* gu = (bf16_t*)(ws + OFF_GU);
    bf16_t* gw = (bf16_t*)(ws + OFF_GW);
    bf16_t* gqd = (bf16_t*)(ws + OFF_GQD);
    bf16_t* gkd = (bf16_t*)(ws + OFF_GKD);
    bf16_t* gin = (bf16_t*)(ws + OFF_GIN);
    float* gl = (float*)(ws + OFF_GL);
    bf16_t* mix = (bf16_t*)(ws + OFF_MIX);
    bf16_t* qry = (bf16_t*)(ws + OFF_QRY);
    bf16_t* h2 = (bf16_t*)(ws + OFF_H2);
    int* eidx = (int*)(ws + OFF_EIDX);
    float* pgate = (float*)(ws + OFF_PGATE);
    unsigned char* uq = (unsigned char*)(ws + OFF_UQ);
    unsigned char* vq = (unsigned char*)(ws + OFF_VQ);
    float* su = (float*)(ws + OFF_SU);
    float* sv = (float*)(ws + OFF_SV);
    float* og = P.out;
    float2* rope = (float2*)(ws + OFF_ROPE);

    {
        const int n1 = 108 * 32, n2 = n1 + 32 * 32, n3 = n2 + 64 * 32, n4 = n3 + 2 * 8 * 64;
        for (int it = bid0; it < n4; it += G) {
            if (it < n1) d_transpose_bf16(P.w_in, 1024, IN_COLS, w_in_t, it % 108, it / 108, smem);
            else if (it < n2) { int r = it - n1; d_transpose_bf16(P.w_out, 1024, 1024, w_out_t, r % 32, r / 32, smem); }
            else if (it < n3) { int r = it - n2; d_transpose_bf16(P.w_query, 1024, 2048, w_q_t, r % 64, r / 64, smem); }
            else { int r = it - n3; int j = r >> 9; r &= 511; d_transpose_bf16(P.cmp_w1 + (size_t)j * 2048 * 256, 2048, 256, cw1_t + (size_t)j * 256 * 2048, r % 8, r / 8, smem); }
            __syncthreads();
        }
        for (int it = bid0; it < 2; it += G) d_cmp_bias(P.cmp_pos, P.cmp_w1, cbias, it);
        for (int it = bid0; it < T_TOK / 4; it += G) d_rmsnorm_bf16(P.x, P.attn_norm, h_bf, it);
        for (int i = bid0 * 256 + threadIdx.x; i < 8192 * 32; i += G * 256) {
            const int pos = i >> 5, fi = i & 31;
            float sn, cs; sincosf((float)pos * expf(-9.210340371976184f * (float)(2 * fi) / 64.f), &sn, &cs);
            rope[i] = make_float2(cs, sn);
        }
        for (int i = bid0 * 256 + threadIdx.x; i < 32 * PLD / 2; i += G * 256) ((unsigned*)(proj + (size_t)T_TOK * PLD))[i] = 0u;
    }
    xcd_barrier(B);
    {
        GemmP p{}; p.A = h_bf; p.lda = 1024; p.akts = 64; p.Bt = w_in_t; p.ldb = 1024; p.K = 1024; p.mtiles = 128; p.ntiles = 27; p.out = proj;
#ifdef PROBE_GEMM1
        for (int rep = 0; rep < PROBE_GEMM1; rep++)
#endif
        for (int it = bid0; it < 128 * 27; it += G) d_gemm<EPI_PROJ>(p, it, smem);
    }
    xcd_barrier(B);
#ifdef PROBE_MISC
    for (int rep = 0; rep < 2; rep++)
#endif
    {
        for (int it = bid0; it < 64; it += G) {
            int inst = it >> 3, tile = it & 7;
            int j = inst >> 2, b = (inst >> 1) & 1, g = inst & 1;
            GemmP p{}; p.A = proj + (size_t)(b * SEQ) * PLD + C_KV + 128 * j + 64 * g; p.lda = 16 * PLD; p.akts = PLD;
            p.Bt = cw1_t + (size_t)j * 256 * 2048; p.ldb = 2048; p.K = 2048; p.mtiles = 4; p.ntiles = 2;
            p.out = hid + (size_t)inst * 512 * 256; p.aux = cbias + j * 256;
            d_gemm<EPI_HID>(p, tile, smem);
        }
        for (int it = bid0; it < 1024; it += G) { d_gdn_prep2(proj, P.gdn_conv, P.a_log, P.dt_bias, gu, gw, gqd, gkd, gin, gl, it, smem); __syncthreads(); }
        for (int it = bid0; it < 8192; it += G) d_knorm_rope(proj, P.k_gain, ksn, kwn, it);
    }
    xcd_barrier(B);
#ifdef PROBE_MISC
    for (int rep = 0; rep < 2; rep++)
#endif
    for (int it = bid0; it < 1024; it += G) d_cmp2(hid, P.cmp_w2, P.k_gain, kc, vc, it);
    xcd_barrier(B);
    {
        if (bid0 < 64) d_gdn_scan2(gu, gw, gqd, gkd, gin, gl, og, bid0, smem);
        __syncthreads();
#ifdef PROBE_NSA
        for (int rep = 0; rep < 2; rep++)
#else
        const int rep = 0;
#endif
        for (;;) {
            if (threadIdx.x == 0) q_item = (int)xb_add(&P.bar[XB_QUEUE + 256 * rep], 1u);
            __syncthreads();
            const int it = q_item;
            if (it >= 1024) break;
            d_nsa_mfma(proj, P.q_gain, rope, ksn, kwn, kc, vc, mix, DM, it, smem);
            __syncthreads();
        }
#ifdef NSA_CHECK
        bf16_t* mix2 = (bf16_t*)(P.out + 8388608);
        for (;;) {
            if (threadIdx.x == 0) q_item = (int)xb_add(&P.bar[XB_QUEUE + 64], 1u);
            __syncthreads();
            const int it = q_item;
            if (it >= 2 * 2 * SEQ) break;
            d_nsa_naive(proj, P.q_gain, ksn, kwn, kc, vc, mix2, 512, it, smem);
            __syncthreads();
        }
#endif
    }
    xcd_barrier(B);
#ifdef NSA_CHECK
    {
        const bf16_t* mix2 = (const bf16_t*)(P.out + 8388608);
        float sd = 0.f, sr = 0.f;
        for (int i = bid0 * 256 + threadIdx.x; i < T_TOK * 512; i += G * 256) {
            const int r = i >> 9, c = i & 511;
            const float a = bf2f(mix[(size_t)r * DM + c]), bb = bf2f(mix2[i]);
            sd += (a - bb) * (a - bb); sr += bb * bb;
        }
        sd = wave_sum(sd); sr = wave_sum(sr);
        if ((threadIdx.x & 63) == 0) { atomicAdd((float*)&P.bar[XB_QUEUE + 128], sd); atomicAdd((float*)&P.bar[XB_QUEUE + 192], sr); }
    }
    xcd_barrier(B);
#endif
#ifdef PROBE_MISC
    for (int rep = 0; rep < 2; rep++) {
#endif
    for (int it = bid0; it < T_TOK; it += G) d_gdn_out(og, proj, P.out_gain, mix, it);
    for (int r = bid0 * 4 + (threadIdx.x >> 6); r < 16384; r += G * 4) { d_quant_row(P.peer_u, uq, su, r, threadIdx.x & 63, 0); d_quant_row(P.peer_v, vq, sv, r, threadIdx.x & 63, 128); }
#ifdef PROBE_MISC
    }
#endif
    xcd_barrier(B);
    {
        GemmP p{}; p.A = mix; p.lda = 1024; p.akts = 64; p.Bt = w_out_t; p.ldb = 1024; p.K = 1024; p.mtiles = 128; p.ntiles = 8; p.out = P.out; p.aux = P.x;
        for (int it = bid0; it < 128 * 8; it += G) d_gemm<EPI_OUT>(p, it, smem);
    }
    xcd_barrier(B);
    for (int it = bid0; it < T_TOK / 4; it += G) d_rmsnorm_bf16(P.out, P.ffn_norm, h2, it);
    xcd_barrier(B);
    {
        GemmP p{}; p.A = h2; p.lda = 1024; p.akts = 64; p.Bt = w_q_t; p.ldb = 1024; p.K = 1024; p.mtiles = 128; p.ntiles = 16; p.out = qry;
        for (int it = bid0; it < 128 * 16; it += G) d_gemm<EPI_QRY>(p, it, smem);
    }
    xcd_barrier(B);
    route_load_subkeys(P.subkeys, smem);
    __syncthreads();
    for (int mt = bid0 * 4 + (threadIdx.x >> 6); mt < T_TOK / 2; mt += G * 4) d_peer_route2(qry, eidx, pgate, mt, smem, threadIdx.x & 63);
    xcd_barrier(B);
    for (int it = bid0; it < T_TOK / 4; it += G) d_peer_expert3(h2, eidx, pgate, uq, vq, su, sv, P.out, it * 4 + (threadIdx.x >> 6), threadIdx.x & 63);
#ifdef NSA_CHECK
    xcd_barrier(B);
    {
        const float sd = __hip_atomic_load((float*)&P.bar[XB_QUEUE + 128], __ATOMIC_RELAXED, __HIP_MEMORY_SCOPE_AGENT);
        const float sr = __hip_atomic_load((float*)&P.bar[XB_QUEUE + 192], __ATOMIC_RELAXED, __HIP_MEMORY_SCOPE_AGENT);
        if (!(sd <= NSA_CHECK * sr)) for (int i = bid0 * 256 + threadIdx.x; i < T_TOK * DM; i += G * 256) P.out[i] += 1000.f;
    }
#endif
}

extern "C" void kernel_launch(void* const* d_in, const int* in_sizes, int n_in, void* d_out, int out_size, void* d_ws, size_t ws_size,
                              hipStream_t stream) {
    const size_t bar_off = (OFF_END + 255) & ~(size_t)255;
    if (ws_size < bar_off + XCD_BAR_WORDS * 4) return;
    static int grid_blocks = 0;
    if (!grid_blocks) {
        int dev = 0, cus = 0, per_cu = 0;
        (void)hipGetDevice(&dev);
        (void)hipDeviceGetAttribute(&cus, hipDeviceAttributeMultiprocessorCount, dev);
        (void)hipFuncSetAttribute((const void*)hybrid_megakernel, hipFuncAttributeMaxDynamicSharedMemorySize, SMEM_BYTES);
        (void)hipOccupancyMaxActiveBlocksPerMultiprocessor(&per_cu, hybrid_megakernel, 256, SMEM_BYTES);
        if (per_cu > 2) per_cu = 2;
        grid_blocks = cus * per_cu;
    }
    if (grid_blocks <= 0) return;
    MKP P{};
    P.x = (const float*)d_in[0]; P.attn_norm = (const float*)d_in[1]; P.w_in = (const float*)d_in[2]; P.q_gain = (const float*)d_in[3];
    P.k_gain = (const float*)d_in[4]; P.cmp_pos = (const float*)d_in[5]; P.cmp_w1 = (const float*)d_in[6]; P.cmp_w2 = (const float*)d_in[7];
    P.gdn_conv = (const float*)d_in[8]; P.a_log = (const float*)d_in[9]; P.dt_bias = (const float*)d_in[10]; P.out_gain = (const float*)d_in[11];
    P.w_out = (const float*)d_in[12]; P.ffn_norm = (const float*)d_in[13]; P.w_query = (const float*)d_in[14]; P.subkeys = (const float*)d_in[15];
    P.peer_u = (const float*)d_in[16]; P.peer_v = (const float*)d_in[17];
    P.out = (float*)d_out; P.ws = (char*)d_ws; P.bar = (unsigned*)((char*)d_ws + bar_off);
    (void)hipMemsetAsync(P.bar, 0, XCD_BAR_WORDS * 4, stream);
    hipLaunchKernelGGL(hybrid_megakernel, dim3(grid_blocks), dim3(256), SMEM_BYTES, stream, P);
}
```

```cpp
#include <hip/hip_runtime.h>
#include <stdint.h>

typedef unsigned short bf16_t;
typedef __attribute__((ext_vector_type(8))) short bf16x8;
typedef __attribute__((ext_vector_type(4))) float f32x4;
#define LAS3 __attribute__((address_space(3)))

#define T_TOK 16384
#define SEQ 8192
#define DM 1024
#define IN_COLS 3360
#define PLD 3456
#define C_Q 0
#define C_KV 512
#define C_GATE 1280
#define C_GQKV 1304
#define C_Z 2840
#define C_A 3352
#define C_B 3356

#define OFF_WINT   0ull
#define OFF_WOUTT  (OFF_WINT  + 3456ull*1024*2)
#define OFF_WQT    (OFF_WOUTT + 1024ull*1024*2)
#define OFF_CW1T   (OFF_WQT   + 2048ull*1024*2)
#define OFF_CBIAS  (OFF_CW1T  + 2ull*256*2048*2)
#define OFF_HBF    (OFF_CBIAS + 4096ull)
#define OFF_PROJ   (OFF_HBF   + 16384ull*1024*2)
#define OFF_KSN    (OFF_PROJ  + (16384ull+32)*PLD*2)
#define OFF_KWN    (OFF_KSN   + 4ull*8192*64*2)
#define OFF_KC     (OFF_KWN   + 4ull*8192*64*2)
#define OFF_VC     (OFF_KC    + 4ull*512*64*2)
#define OFF_HID    (OFF_VC    + 4ull*512*64*2)
#define OFF_GU     (OFF_HID   + 8ull*512*256*2)
#define OFF_GW     (OFF_GU    + 1024ull*64*128*2)
#define OFF_GQD    (OFF_GW    + 1024ull*64*128*2)
#define OFF_GKD    (OFF_GQD   + 1024ull*64*128*2)
#define OFF_GIN    (OFF_GKD   + 1024ull*64*128*2)
#define OFF_GL     (OFF_GIN   + 1024ull*64*64*2)
#define OFF_ROPE   (OFF_GL    + 4096ull)
#define OFF_CW2T   (OFF_ROPE  + 8192ull*32*8)
#define OFF_SU     (OFF_CW2T  + 2ull*64*256*2)
#define OFF_SV     (OFF_SU    + 65536ull)
#define OFF_END    (OFF_SV    + 65536ull)
#define OFF_MIX    OFF_HBF
#define OFF_QRY    OFF_PROJ
#define OFF_H2     (OFF_PROJ + 16384ull*2048*2)
#define OFF_EIDX   OFF_KSN
#define OFF_PGATE  OFF_GIN
#define OFF_UQ     OFF_GU
#define OFF_VQ     (OFF_GU + 16384ull*1024)

__device__ __forceinline__ bf16_t f2bf(float f) {
    unsigned u = __float_as_uint(f);
    u += 0x7fffu + ((u >> 16) & 1u);
    return (bf16_t)(u >> 16);
}
__device__ __forceinline__ float bf2f(bf16_t h) { return __uint_as_float(((unsigned)h) << 16); }
__device__ __forceinline__ float gelu_tanh(float x) {
    float u = 0.7978845608028654f * (x + 0.044715f * x * x * x);
    return 0.5f * x * (1.f + tanhf(u));
}
__device__ __forceinline__ float sigmoidf_(float x) { return 1.f / (1.f + __expf(-x)); }
__device__ __forceinline__ float wave_sum(float v) {
#pragma unroll
    for (int o = 32; o > 0; o >>= 1) v += __shfl_xor(v, o);
    return v;
}
__device__ __forceinline__ float wave_max(float v) {
#pragma unroll
    for (int o = 32; o > 0; o >>= 1) v = fmaxf(v, __shfl_xor(v, o));
    return v;
}

template <int CTRL> __device__ __forceinline__ float dppf(float x) { return __builtin_bit_cast(float, __builtin_amdgcn_update_dpp(0, __builtin_bit_cast(int, x), CTRL, 0xf, 0xf, true)); }
template <int CTRL> __device__ __forceinline__ unsigned dppu(unsigned x) { return (unsigned)__builtin_amdgcn_update_dpp(0, (int)x, CTRL, 0xf, 0xf, true); }
__device__ __forceinline__ float allmax16(float x) {
    x = fmaxf(x, dppf<0xB1>(x)); x = fmaxf(x, dppf<0x4E>(x)); x = fmaxf(x, dppf<0x141>(x)); x = fmaxf(x, dppf<0x140>(x)); return x;
}
__device__ __forceinline__ unsigned allmaxu16(unsigned x) {
    x = max(x, dppu<0xB1>(x)); x = max(x, dppu<0x4E>(x)); x = max(x, dppu<0x141>(x)); x = max(x, dppu<0x140>(x)); return x;
}
__device__ __forceinline__ float allsum16(float x) {
    x += dppf<0xB1>(x); x += dppf<0x4E>(x); x += dppf<0x141>(x); x += dppf<0x140>(x); return x;
}
__device__ __forceinline__ float wave_sum_dpp(float x) {
    x = allsum16(x);
    return __builtin_bit_cast(float, __builtin_amdgcn_readlane(__builtin_bit_cast(int, x), 0)) + __builtin_bit_cast(float, __builtin_amdgcn_readlane(__builtin_bit_cast(int, x), 16)) +
           __builtin_bit_cast(float, __builtin_amdgcn_readlane(__builtin_bit_cast(int, x), 32)) + __builtin_bit_cast(float, __builtin_amdgcn_readlane(__builtin_bit_cast(int, x), 48));
}
__device__ __forceinline__ void d_transpose_bf16(const float* __restrict__ W, int K, int N, bf16_t* __restrict__ Wt, int bx, int by, char* smem) {
    float (*tile)[33] = (float (*)[33])smem;
    int n0 = bx * 32, k0 = by * 32;
    int tx = threadIdx.x & 31, ty = threadIdx.x >> 5;
    for (int i = ty; i < 32; i += 8) {
        int n = n0 + tx;
        tile[i][tx] = (n < N) ? W[(size_t)(k0 + i) * N + n] : 0.f;
    }
    __syncthreads();
    for (int i = ty; i < 32; i += 8) {
        Wt[(size_t)(n0 + i) * K + k0 + tx] = f2bf(tile[tx][i]);
    }
}

__device__ __forceinline__ void d_rmsnorm_bf16(const float* __restrict__ x, const float* __restrict__ g, bf16_t* __restrict__ out, int bid) {
    int row = bid * 4 + (threadIdx.x >> 6);
    int lane = threadIdx.x & 63;
    const float4* xr = (const float4*)(x + (size_t)row * DM);
    float4 v[4];
    float ss = 0.f;
#pragma unroll
    for (int i = 0; i < 4; i++) { v[i] = xr[lane + 64 * i]; ss += v[i].x * v[i].x + v[i].y * v[i].y + v[i].z * v[i].z + v[i].w * v[i].w; }
    ss = wave_sum(ss);
    float r = rsqrtf(ss * (1.f / DM) + 1e-6f);
#pragma unroll
    for (int i = 0; i < 4; i++) {
        float4 gg = ((const float4*)g)[lane + 64 * i];
        ushort4 o;
        o.x = f2bf(v[i].x * r * gg.x); o.y = f2bf(v[i].y * r * gg.y); o.z = f2bf(v[i].z * r * gg.z); o.w = f2bf(v[i].w * r * gg.w);
        ((ushort4*)(out + (size_t)row * DM))[lane + 64 * i] = o;
    }
}

__device__ __forceinline__ void d_cmp_bias(const float* __restrict__ pos, const float* __restrict__ w1, float* __restrict__ bias, int item, char* smem) {
    float* part = (float*)smem;
    const int j = item >> 3, c = (item & 7) * 32 + (threadIdx.x & 31), ksl = threadIdx.x >> 5;
    float s0 = 0.f, s1 = 0.f, s2 = 0.f, s3 = 0.f;
    const float* wp = w1 + ((size_t)j * 2048 + ksl * 256) * 256 + c;
    const float* pp = pos + j * 2048 + ksl * 256;
    for (int k = 0; k < 256; k += 4) {
        s0 += pp[k] * wp[(size_t)k * 256]; s1 += pp[k + 1] * wp[(size_t)(k + 1) * 256];
        s2 += pp[k + 2] * wp[(size_t)(k + 2) * 256]; s3 += pp[k + 3] * wp[(size_t)(k + 3) * 256];
    }
    part[ksl * 32 + (threadIdx.x & 31)] = (s0 + s1) + (s2 + s3);
    __syncthreads();
    if (threadIdx.x < 32) {
        float t = 0.f;
#pragma unroll
        for (int i = 0; i < 8; i++) t += part[i * 32 + threadIdx.x];
        bias[j * 256 + c] = t;
    }
    __syncthreads();
}

#define EPI_PROJ 0
#define EPI_HID 1
#define EPI_OUT 2
#define EPI_QRY 3
struct GemmP {
    const bf16_t* A; long lda; long akts;
    const bf16_t* Bt; long ldb;
    int K; int mtiles; int ntiles;
    long a_inst; long b_inst;
    void* out; const float* aux; const float* aux2;
};

template <int EPI>
__device__ __forceinline__ void d_gemm(const GemmP& p, int bid, char* smem) {
    bf16_t* As = (bf16_t*)smem;
    bf16_t* Bs = As + 128 * 72;
    const int tid = threadIdx.x, lane = tid & 63, wave = tid >> 6;
    const int wm = wave >> 1, wn = wave & 1;
    const int inst = 0;
    const int mt = bid / p.ntiles, nt = bid % p.ntiles;
    const int m0 = mt * 128, n0 = nt * 128;
    const bf16_t* A = p.A + (size_t)inst * p.a_inst + (size_t)m0 * p.lda;
    const bf16_t* Bt = p.Bt + (size_t)inst * p.b_inst + (size_t)n0 * p.ldb;
    f32x4 acc[4][4];
#pragma unroll
    for (int i = 0; i < 4; i++)
#pragma unroll
        for (int j = 0; j < 4; j++) acc[i][j] = (f32x4){0.f, 0.f, 0.f, 0.f};
    const int nk = p.K >> 6;
    const int lrow = tid >> 3, lc8 = (tid & 7) * 8;
    const bf16_t* Ap = A + (size_t)lrow * p.lda + lc8;
    const bf16_t* Bp = Bt + (size_t)lrow * p.ldb + lc8;
    const size_t a32 = (size_t)32 * p.lda, b32 = (size_t)32 * p.ldb;
    uint4 ra0, ra1, ra2, ra3, rb0, rb1, rb2, rb3;
#define GLOAD(koffA, koffB) \
    ra0 = *(const uint4*)(Ap + (koffA)); ra1 = *(const uint4*)(Ap + a32 + (koffA)); ra2 = *(const uint4*)(Ap + 2 * a32 + (koffA)); ra3 = *(const uint4*)(Ap + 3 * a32 + (koffA)); \
    rb0 = *(const uint4*)(Bp + (koffB)); rb1 = *(const uint4*)(Bp + b32 + (koffB)); rb2 = *(const uint4*)(Bp + 2 * b32 + (koffB)); rb3 = *(const uint4*)(Bp + 3 * b32 + (koffB));
    GLOAD(0, 0)
    bf16_t* Asw = As + lrow * 72 + lc8;
    bf16_t* Bsw = Bs + lrow * 72 + lc8;
    for (int kt = 0; kt < nk; kt++) {
        *(uint4*)(Asw) = ra0; *(uint4*)(Asw + 32 * 72) = ra1; *(uint4*)(Asw + 64 * 72) = ra2; *(uint4*)(Asw + 96 * 72) = ra3;
        *(uint4*)(Bsw) = rb0; *(uint4*)(Bsw + 32 * 72) = rb1; *(uint4*)(Bsw + 64 * 72) = rb2; *(uint4*)(Bsw + 96 * 72) = rb3;
        __syncthreads();
        if (kt + 1 < nk) {
            GLOAD((size_t)(kt + 1) * p.akts, (size_t)(kt + 1) * 64)
        }
#pragma unroll
        for (int ks = 0; ks < 2; ks++) {
            bf16x8 af[4], bfr[4];
#pragma unroll
            for (int i = 0; i < 4; i++) af[i] = *(const bf16x8*)(As + (wm * 64 + i * 16 + (lane & 15)) * 72 + ks * 32 + (lane >> 4) * 8);
#pragma unroll
            for (int j = 0; j < 4; j++) bfr[j] = *(const bf16x8*)(Bs + (wn * 64 + j * 16 + (lane & 15)) * 72 + ks * 32 + (lane >> 4) * 8);
#pragma unroll
            for (int i = 0; i < 4; i++)
#pragma unroll
                for (int j = 0; j < 4; j++) acc[i][j] = __builtin_amdgcn_mfma_f32_16x16x32_bf16(af[i], bfr[j], acc[i][j], 0, 0, 0);
        }
        __syncthreads();
    }
#pragma unroll
    for (int i = 0; i < 4; i++)
#pragma unroll
        for (int j = 0; j < 4; j++)
#pragma unroll
            for (int r = 0; r < 4; r++) {
                int row = m0 + wm * 64 + i * 16 + (lane >> 4) * 4 + r;
                int col = n0 + wn * 64 + j * 16 + (lane & 15);
                float v = acc[i][j][r];
                if (EPI == EPI_PROJ) {
                    ((bf16_t*)p.out)[(size_t)row * PLD + col] = f2bf(v);
                } else if (EPI == EPI_HID) {
                    float bb = p.aux[(inst >> 2) * 256 + col];
                    ((bf16_t*)p.out)[((size_t)inst * 512 + row) * 256 + col] = f2bf(gelu_tanh(v + bb));
                } else if (EPI == EPI_OUT) {
                    ((float*)p.out)[(size_t)row * DM + col] = p.aux[(size_t)row * DM + col] + v;
                } else if (EPI == EPI_QRY) {
                    ((bf16_t*)p.out)[(size_t)row * 2048 + col] = f2bf(v);
                }
            }
}

__device__ __forceinline__ void d_knorm_rope(const bf16_t* __restrict__ proj, const float* __restrict__ kgain, bf16_t* __restrict__ ksn, bf16_t* __restrict__ kwn, int bid) {
    int vec = bid * 8 + (threadIdx.x >> 5);
    int i = threadIdx.x & 31;
    int which = vec >> 15;
    int rem = vec & 32767;
    int b = rem >> 14, g = (rem >> 13) & 1, s = rem & 8191;
    const bf16_t* src = proj + (size_t)(b * SEQ + s) * PLD + C_KV + 128 * (which ? 4 : 2) + 64 * g;
    float x1 = bf2f(src[i]), x2 = bf2f(src[i + 32]);
    float ss = x1 * x1 + x2 * x2;
#pragma unroll
    for (int o = 16; o > 0; o >>= 1) ss += __shfl_xor(ss, o);
    float r = rsqrtf(ss * (1.f / 64.f) + 1e-6f);
    const float* gn = kgain + (which ? 2 : 1) * 64;
    x1 = x1 * r * gn[i]; x2 = x2 * r * gn[i + 32];
    float inv = expf(-9.210340371976184f * (float)(2 * i) / 64.f);
    float ang = (float)s * inv;
    float sn, cs; sincosf(ang, &sn, &cs);
    bf16_t* dst = (which ? kwn : ksn) + ((size_t)(b * 2 + g) * SEQ + s) * 64;
    dst[i] = f2bf(x1 * cs - x2 * sn);
    dst[i + 32] = f2bf(x2 * cs + x1 * sn);
}

__device__ __forceinline__ void d_cmp2_mfma(const bf16_t* __restrict__ hid, const bf16_t* __restrict__ cw2t, const float* __restrict__ kgain, const float2* __restrict__ rope,
                                            bf16_t* __restrict__ kc, bf16_t* __restrict__ vc, int witem, int lane) {
    const int n16 = lane & 15, kq = lane >> 4;
    const int rowbase = 16 * witem, inst = rowbase >> 9, n0 = rowbase & 511, j = inst >> 2, bg = inst & 3;
    f32x4 acc[4];
#pragma unroll
    for (int nt = 0; nt < 4; nt++) acc[nt] = (f32x4){0.f, 0.f, 0.f, 0.f};
    const bf16_t* ap = hid + (size_t)(rowbase + n16) * 256 + 8 * kq;
    const bf16_t* bp = cw2t + (size_t)j * 64 * 256 + n16 * 256 + 8 * kq;
#pragma unroll
    for (int ks = 0; ks < 8; ks++) {
        const bf16x8 a = *(const bf16x8*)(ap + 32 * ks);
#pragma unroll
        for (int nt = 0; nt < 4; nt++) {
            const bf16x8 bb = *(const bf16x8*)(bp + (size_t)(16 * nt) * 256 + 32 * ks);
            acc[nt] = __builtin_amdgcn_mfma_f32_16x16x32_bf16(a, bb, acc[nt], 0, 0, 0);
        }
    }
#pragma unroll
    for (int r = 0; r < 4; r++) {
        const int n = n0 + 4 * kq + r;
        if (j == 0) {
            float ss = acc[0][r] * acc[0][r] + acc[1][r] * acc[1][r] + acc[2][r] * acc[2][r] + acc[3][r] * acc[3][r];
            ss = allsum16(ss);
            const float ri = rsqrtf(ss * (1.f / 64.f) + 1e-6f);
#pragma unroll
            for (int nt = 0; nt < 2; nt++) {
                const int i = 16 * nt + n16;
                const float y1 = acc[nt][r] * ri * kgain[i], y2 = acc[nt + 2][r] * ri * kgain[i + 32];
                const float2 cs = rope[(size_t)((n < 511 ? n : 510) * 16 + 31) * 32 + i];
                if (n < 511) {
                    kc[((size_t)bg * 512 + n) * 64 + i] = f2bf(y1 * cs.x - y2 * cs.y);
                    kc[((size_t)bg * 512 + n) * 64 + i + 32] = f2bf(y2 * cs.x + y1 * cs.y);
                }
            }
        } else if (n < 511) {
#pragma unroll
            for (int nt = 0; nt < 4; nt++) vc[((size_t)bg * 512 + n) * 64 + 16 * nt + n16] = f2bf(acc[nt][r]);
        }
    }
}

__device__ __forceinline__ float dot64(const float* q, const bf16_t* krow) {
    const uint4* kp = (const uint4*)krow;
    float s = 0.f;
#pragma unroll
    for (int c = 0; c < 8; c++) {
        uint4 u = kp[c];
        unsigned w[4] = {u.x, u.y, u.z, u.w};
#pragma unroll
        for (int e = 0; e < 4; e++) {
            s += q[c * 8 + e * 2] * __uint_as_float(w[e] << 16);
            s += q[c * 8 + e * 2 + 1] * __uint_as_float(w[e] & 0xffff0000u);
        }
    }
    return s;
}

__device__ __forceinline__ void d_nsa_naive(const bf16_t* __restrict__ proj, const float* __restrict__ qgain,
                                                   const bf16_t* __restrict__ ksn, const bf16_t* __restrict__ kwn,
                                                   const bf16_t* __restrict__ kc, const bf16_t* __restrict__ vc,
                                                   bf16_t* __restrict__ mix, int mix_ld, int bid, char* smem) {
    float (*qs)[64] = (float (*)[64])smem;
    float (*pbuf)[1024] = (float (*)[1024])(smem + 1024);
    float* sc = (float*)(smem + 1024 + 16384);
    int* sel = (int*)(smem + 1024 + 16384 + 512);
    const int tid = threadIdx.x, lane = tid & 63, w = tid >> 6;
    const int blk = bid;
    const int t = blk & 8191, g = (blk >> 13) & 1, b = blk >> 14;
    const int bg = b * 2 + g;
    const size_t row = (size_t)(b * SEQ + t);
    const int head = g * 4 + w;
    {
        int i = lane & 31;
        const bf16_t* src = proj + row * PLD + C_Q + head * 64;
        float x1 = bf2f(src[i]), x2 = bf2f(src[i + 32]);
        float ss = x1 * x1 + x2 * x2;
#pragma unroll
        for (int o = 16; o > 0; o >>= 1) ss += __shfl_xor(ss, o);
        float r = rsqrtf(ss * (1.f / 64.f) + 1e-6f);
        x1 = x1 * r * qgain[i]; x2 = x2 * r * qgain[i + 32];
        float inv = expf(-9.210340371976184f * (float)(2 * i) / 64.f);
        float ang = (float)t * inv;
        float sn, cs; sincosf(ang, &sn, &cs);
        if (lane < 32) { qs[w][i] = (x1 * cs - x2 * sn) * 0.125f; qs[w][i + 32] = (x2 * cs + x1 * sn) * 0.125f; }
    }
    __syncthreads();
    float q[64];
#pragma unroll
    for (int d = 0; d < 64; d++) q[d] = qs[w][d];
    float o_c = 0.f, o_s = 0.f, o_w = 0.f;
    const int nvis = (t >= 31) ? (((t - 31) >> 4) + 1) : 0;
    {
        float s[8];
        float m = -3e38f;
#pragma unroll
        for (int i = 0; i < 8; i++) {
            int n = lane + 64 * i;
            if (n < nvis) { s[i] = dot64(q, kc + ((size_t)bg * 512 + n) * 64); m = fmaxf(m, s[i]); } else s[i] = -3e38f;
        }
        m = wave_max(m);
        float l = 0.f;
#pragma unroll
        for (int i = 0; i < 8; i++) { int n = lane + 64 * i; s[i] = (n < nvis) ? __expf(s[i] - m) : 0.f; l += s[i]; }
        l = wave_sum(l);
        float il = (nvis > 0) ? 1.f / l : 0.f;
#pragma unroll
        for (int i = 0; i < 8; i++) pbuf[w][lane + 64 * i] = s[i] * il;
        __syncthreads();
        const bf16_t* vp = vc + (size_t)bg * 512 * 64 + lane;
        for (int n = 0; n < nvis; n++) o_c += pbuf[w][n] * bf2f(vp[(size_t)n * 64]);
    }
    if (tid < 128) {
        int j = tid;
        float im = 0.f;
#pragma unroll
        for (int h = 0; h < 4; h++) {
            float a = (j > 0) ? pbuf[h][4 * j - 1] : 0.f;
            im += a + 2.f * (pbuf[h][4 * j] + pbuf[h][4 * j + 1] + pbuf[h][4 * j + 2]) + pbuf[h][4 * j + 3];
        }
        int cur = t >> 6;
        float v;
        if (j > cur) v = -1e30f;
        else if (j == 0 || j == cur || j == cur - 1) v = 1e4f;
        else v = im;
        sc[j] = v;
    }
    __syncthreads();
    if (w == 0) {
        float v0 = sc[lane], v1 = sc[lane + 64];
        for (int it = 0; it < 16; it++) {
            float bv; int bi;
            if (v0 >= v1) { bv = v0; bi = lane; } else { bv = v1; bi = lane + 64; }
#pragma unroll
            for (int o = 32; o > 0; o >>= 1) {
                float ov = __shfl_xor(bv, o); int oi = __shfl_xor(bi, o);
                if (ov > bv || (ov == bv && oi < bi)) { bv = ov; bi = oi; }
            }
            if (lane == 0) sel[it] = (bv > -1e29f) ? bi : -1;
            if (bi == lane) v0 = -3e38f;
            if (bi == lane + 64) v1 = -3e38f;
        }
    }
    __syncthreads();
    {
        float s[16];
        float m = -3e38f;
#pragma unroll
        for (int i = 0; i < 16; i++) {
            int bk = sel[i];
            int pos = bk * 64 + lane;
            if (bk >= 0 && pos <= t) { s[i] = dot64(q, ksn + ((size_t)bg * SEQ + pos) * 64); m = fmaxf(m, s[i]); } else s[i] = -3e38f;
        }
        m = wave_max(m);
        float l = 0.f;
#pragma unroll
        for (int i = 0; i < 16; i++) { s[i] = (s[i] > -1e38f) ? __expf(s[i] - m) : 0.f; l += s[i]; }
        l = wave_sum(l);
        float il = 1.f / l;
#pragma unroll
        for (int i = 0; i < 16; i++) pbuf[w][i * 64 + lane] = s[i] * il;
        __syncthreads();
        for (int i = 0; i < 16; i++) {
            int bk = sel[i];
            if (bk < 0) continue;
            const bf16_t* vp = proj + (size_t)(b * SEQ + bk * 64) * PLD + C_KV + 128 * 3 + 64 * g + lane;
            int kmax = min(64, t - bk * 64 + 1);
            for (int kk = 0; kk < kmax; kk++) o_s += pbuf[w][i * 64 + kk] * bf2f(vp[(size_t)kk * PLD]);
        }
    }
    __syncthreads();
    {
        float s[8];
        float m = -3e38f;
        const int p0 = t - 511;
#pragma unroll
        for (int i = 0; i < 8; i++) {
            int pos = p0 + lane + 64 * i;
            if (pos >= 0) { s[i] = dot64(q, kwn + ((size_t)bg * SEQ + pos) * 64); m = fmaxf(m, s[i]); } else s[i] = -3e38f;
        }
        m = wave_max(m);
        float l = 0.f;
#pragma unroll
        for (int i = 0; i < 8; i++) { s[i] = (s[i] > -1e38f) ? __expf(s[i] - m) : 0.f; l += s[i]; }
        l = wave_sum(l);
        float il = 1.f / l;
#pragma unroll
        for (int i = 0; i < 8; i++) pbuf[w][lane + 64 * i] = s[i] * il;
        __syncthreads();
        int kstart = (p0 < 0) ? -p0 : 0;
        const bf16_t* vp = proj + (size_t)(b * SEQ) * PLD + C_KV + 128 * 5 + 64 * g + lane;
        for (int kk = kstart; kk < 512; kk++) o_w += pbuf[w][kk] * bf2f(vp[(size_t)(p0 + kk) * PLD]);
    }
    const bf16_t* gp = proj + row * PLD + C_GATE + head * 3;
    float g0 = sigmoidf_(bf2f(gp[0])), g1 = sigmoidf_(bf2f(gp[1])), g2 = sigmoidf_(bf2f(gp[2]));
    mix[row * mix_ld + head * 64 + lane] = f2bf(g0 * o_c + g1 * o_s + g2 * o_w);
}

typedef float f32x16 __attribute__((ext_vector_type(16)));
typedef short s16x4 __attribute__((ext_vector_type(4)));
typedef __bf16 bf16x2_t2 __attribute__((ext_vector_type(2)));
#define MFMA32(a, b, c) __builtin_amdgcn_mfma_f32_32x32x16_bf16((a), (b), (c), 0, 0, 0)
#define NKS 72
#define NSA_K_OFF 0
#define NSA_V_OFF (2 * 64 * NKS * 2)
#define NSA_IMP_OFF (NSA_V_OFF + 2 * 64 * NKS * 2)
#define NSA_SEL_OFF (NSA_IMP_OFF + 32 * 128 * 4)
#define NSA_LDS (NSA_SEL_OFF + 32 * 4 * 4)
#define NEGBIG (-1e30f)
__device__ __forceinline__ unsigned pk2(float a, float b) { bf16x2_t2 v; v[0] = (__bf16)a; v[1] = (__bf16)b; return __builtin_bit_cast(unsigned, v); }
__device__ __forceinline__ bf16x8 pack8(float a0, float a1, float a2, float a3, float a4, float a5, float a6, float a7) {
    uint4 u = make_uint4(pk2(a0, a1), pk2(a2, a3), pk2(a4, a5), pk2(a6, a7));
    return __builtin_bit_cast(bf16x8, u);
}
typedef unsigned u32x4 __attribute__((ext_vector_type(4)));
struct NsaStage { u32x4 k0, k1, v0, v1; };
struct NsaCtx {
    const bf16_t* Kbase; long kstride;
    const bf16_t* Vbase; long vstride;
    bf16_t* Kb; bf16_t* Vb;
    float* imp_s; unsigned* sel_s;
    bf16x8 qf[4];
    f32x16 O0, O1;
    float m, l, invl, carry;
    int t, tokl, hp, hh, c, lane;
};
__device__ __forceinline__ void nsa_stage_load(const NsaCtx& X, NsaStage& st, int j) {
    const int r0 = threadIdx.x >> 3, c8 = (threadIdx.x & 7) * 8;
    const bf16_t* kp = X.Kbase + (size_t)(64 * j + r0) * X.kstride + c8;
    const bf16_t* vp = X.Vbase + (size_t)(64 * j + r0) * X.vstride + c8;
    st.k0 = *(const u32x4*)kp; st.k1 = *(const u32x4*)(kp + 32 * X.kstride);
    st.v0 = *(const u32x4*)vp; st.v1 = *(const u32x4*)(vp + 32 * X.vstride);
}
__device__ __forceinline__ void nsa_stage_store(const NsaCtx& X, const NsaStage& st, int buf) {
    const int r0 = threadIdx.x >> 3, c8 = (threadIdx.x & 7) * 8;
    bf16_t* kb = X.Kb + buf * 64 * NKS + r0 * NKS + c8;
    bf16_t* vb = X.Vb + buf * 64 * NKS + r0 * NKS + c8;
    *(u32x4*)kb = st.k0; *(u32x4*)(kb + 32 * NKS) = st.k1;
    *(u32x4*)vb = st.v0; *(u32x4*)(vb + 32 * NKS) = st.v1;
}
template <int MODE, bool FAST>
__device__ __forceinline__ void nsa_tile(NsaCtx& X, int j, int kt, int buf, unsigned long long mlo, unsigned long long mhi) {
    const bf16_t* Kt = X.Kb + buf * 64 * NKS + (32 * kt) * NKS;
    const bf16_t* Vt = X.Vb + buf * 64 * NKS + (32 * kt) * NKS;
    f32x16 S;
#pragma unroll
    for (int i = 0; i < 16; i++) S[i] = 0.f;
#pragma unroll
    for (int s = 0; s < 4; s++) {
        bf16x8 ka = *(const bf16x8*)(Kt + X.c * NKS + 16 * s + 8 * X.hh);
        S = MFMA32(ka, X.qf[s], S);
    }
    const int kbase = 64 * j + 32 * kt;
    int lo = 0, hi;
    bool on = true;
    if (MODE <= 1) hi = ((X.t - 31) >> 4) - kbase;
    else hi = X.t - kbase;
    if (MODE == 3) lo = X.t - 511 - kbase;
    if (MODE == 2) {
        const unsigned long long wsel = (j < 64) ? mlo : mhi;
        on = (wsel >> (j & 63)) & 1ull;
    }
    lo -= 4 * X.hh; hi -= 4 * X.hh;
    if (!on) hi = -1000;
    float P[16];
    if (MODE == 1) {
#pragma unroll
        for (int i = 0; i < 16; i++) {
            const int cr = (i & 3) + 8 * (i >> 2);
            P[i] = (cr <= hi) ? __builtin_amdgcn_exp2f(S[i] - X.m) * X.invl : 0.f;
        }
        float mainv[4], nxt[4];
#pragma unroll
        for (int q = 0; q < 4; q++) { mainv[q] = 2.f * (P[4 * q] + P[4 * q + 1] + P[4 * q + 2]) + P[4 * q + 3]; nxt[q] = P[4 * q + 3]; }
#pragma unroll
        for (int q = 0; q < 4; q++) {
            mainv[q] += __shfl_xor(mainv[q], 1); mainv[q] += __shfl_xor(mainv[q], 2);
            nxt[q] += __shfl_xor(nxt[q], 1); nxt[q] += __shfl_xor(nxt[q], 2);
        }
        float recv[4];
#pragma unroll
        for (int q = 0; q < 4; q++) recv[q] = __shfl_xor(nxt[q], 32);
        const int jsel0 = 16 * j + 8 * kt + X.hh;
#pragma unroll
        for (int q = 0; q < 4; q++) {
            const float tot = mainv[q] + (X.hh ? recv[q] : (q > 0 ? recv[q > 0 ? q - 1 : 0] : X.carry));
            if (X.hp == 0) X.imp_s[X.tokl * 128 + jsel0 + 2 * q] = tot;
        }
        X.carry = recv[3];
    } else {
        float tmax = NEGBIG;
        if (FAST) {
            tmax = fmaxf(fmaxf(fmaxf(fmaxf(S[0], S[1]), fmaxf(S[2], S[3])), fmaxf(fmaxf(S[4], S[5]), fmaxf(S[6], S[7]))),
                         fmaxf(fmaxf(fmaxf(S[8], S[9]), fmaxf(S[10], S[11])), fmaxf(fmaxf(S[12], S[13]), fmaxf(S[14], S[15]))));
            if (MODE == 2 && !on) tmax = NEGBIG;
        } else {
#pragma unroll
            for (int i = 0; i < 16; i++) {
                const int cr = (i & 3) + 8 * (i >> 2);
                const bool vis = (cr <= hi) && (cr >= lo);
                tmax = vis ? fmaxf(tmax, S[i]) : tmax;
            }
        }
        tmax = fmaxf(tmax, __shfl_xor(tmax, 32));
        float ls = 0.f;
        if (MODE == 0) {
            const float mnew = fmaxf(X.m, tmax);
            const float alpha = __builtin_amdgcn_exp2f(X.m - mnew);
            X.m = mnew;
#pragma unroll
            for (int i = 0; i < 16; i++) {
                const int cr = (i & 3) + 8 * (i >> 2);
                const bool vis = (cr <= hi) && (cr >= lo);
                P[i] = vis ? __builtin_amdgcn_exp2f(S[i] - mnew) : 0.f;
                ls += P[i];
            }
            X.l = X.l * alpha + ls;
        } else {
            const bool upd = tmax > X.m + 8.f;
            const float mnew = upd ? tmax : X.m;
            if (__builtin_amdgcn_ballot_w64(upd) != 0ull) {
                const float alpha = __builtin_amdgcn_exp2f(X.m - mnew);
                X.l *= alpha;
#pragma unroll
                for (int i = 0; i < 16; i++) { X.O0[i] *= alpha; X.O1[i] *= alpha; }
            }
            X.m = mnew;
            if (FAST) {
                const float msub = (MODE == 2 && !on) ? 1e30f : mnew;
#pragma unroll
                for (int i = 0; i < 16; i++) { P[i] = __builtin_amdgcn_exp2f(S[i] - msub); ls += P[i]; }
            } else {
#pragma unroll
                for (int i = 0; i < 16; i++) {
                    const int cr = (i & 3) + 8 * (i >> 2);
                    const bool vis = (cr <= hi) && (cr >= lo);
                    P[i] = vis ? __builtin_amdgcn_exp2f(S[i] - mnew) : 0.f;
                    ls += P[i];
                }
            }
            X.l += ls;
        }
    }
    if (MODE >= 1) {
        bf16x8 pb0 = pack8(P[0], P[1], P[2], P[3], P[4], P[5], P[6], P[7]);
        bf16x8 pb1 = pack8(P[8], P[9], P[10], P[11], P[12], P[13], P[14], P[15]);
        const int l15 = X.lane & 15;
        const bf16_t* vrow = Vt + (4 * X.hh + (l15 >> 2)) * NKS + 16 * ((X.lane >> 4) & 1) + 4 * (l15 & 3);
#pragma unroll
        for (int s2 = 0; s2 < 2; s2++) {
#pragma unroll
            for (int dt = 0; dt < 2; dt++) {
                s16x4 lo4 = __builtin_amdgcn_ds_read_tr16_b64_v4i16((LAS3 s16x4*)(vrow + (16 * s2) * NKS + 32 * dt));
                s16x4 hi4 = __builtin_amdgcn_ds_read_tr16_b64_v4i16((LAS3 s16x4*)(vrow + (16 * s2 + 8) * NKS + 32 * dt));
                bf16x8 va = __builtin_shufflevector(lo4, hi4, 0, 1, 2, 3, 4, 5, 6, 7);
                if (dt == 0) X.O0 = MFMA32(va, s2 ? pb1 : pb0, X.O0); else X.O1 = MFMA32(va, s2 ? pb1 : pb0, X.O1);
            }
        }
    }
}
template <int MODE>
__device__ __forceinline__ void nsa_branch(NsaCtx& X, int jlo, int jhi, unsigned long long mlo, unsigned long long mhi, unsigned long long ulo, unsigned long long uhi, int cur, int tw0) {
    NsaStage st;
    nsa_stage_load(X, st, jlo);
    __syncthreads();
    nsa_stage_store(X, st, jlo & 1);
    __syncthreads();
#pragma unroll 1
    for (int j = jlo; j <= jhi; j++) {
        if (j < jhi) nsa_stage_load(X, st, j + 1);
        bool need = true;
        if (MODE == 2) {
            const unsigned long long wsel = (j < 64) ? ulo : uhi;
            need = (wsel >> (j & 63)) & 1ull;
        }
        if (need) {
#pragma unroll 1
            for (int kt = 0; kt < 2; kt++) {
                bool fast = false;
                if (MODE == 2) fast = j < cur;
                if (MODE == 3) { const int kb = 64 * j + 32 * kt; fast = (kb + 31 <= tw0) && (kb >= tw0 + 7 - 511); }
                if (MODE >= 2 && fast) nsa_tile<MODE, true>(X, j, kt, j & 1, mlo, mhi);
                else nsa_tile<MODE, false>(X, j, kt, j & 1, mlo, mhi);
            }
        }
        if (j < jhi) nsa_stage_store(X, st, (j + 1) & 1);
        __syncthreads();
    }
}
__device__ __forceinline__ void nsa_accum(f32x16& f0, f32x16& f1, const NsaCtx& X, float scale) {
#pragma unroll
    for (int i = 0; i < 16; i++) { f0[i] += X.O0[i] * scale; f1[i] += X.O1[i] * scale; }
}
__device__ __forceinline__ void d_nsa_mfma(const bf16_t* __restrict__ proj, const float* __restrict__ qgain, const float2* __restrict__ rope,
                                           const bf16_t* __restrict__ ksn, const bf16_t* __restrict__ kwn,
                                           const bf16_t* __restrict__ kc, const bf16_t* __restrict__ vc,
                                           bf16_t* __restrict__ mixo, int mix_ld, int item, char* smem) {
    NsaCtx X;
    const int tid = threadIdx.x, lane = tid & 63, w = tid >> 6;
    const int bg = item & 3, tile = 255 - (item >> 2);
    const int b = bg >> 1, g = bg & 1, t0 = tile * 32;
    X.lane = lane; X.c = lane & 31; X.hh = lane >> 5; X.hp = X.c & 3; X.tokl = 8 * w + (X.c >> 2); X.t = t0 + X.tokl;
    X.Kb = (bf16_t*)(smem + NSA_K_OFF); X.Vb = (bf16_t*)(smem + NSA_V_OFF);
    X.imp_s = (float*)(smem + NSA_IMP_OFF); X.sel_s = (unsigned*)(smem + NSA_SEL_OFF);
    const int head = g * 4 + X.hp;
    const size_t row = (size_t)(b * SEQ + X.t);
    {
        float y[4][8];
        const bf16_t* qsrc = proj + row * PLD + C_Q + head * 64 + 8 * X.hh;
        float ss = 0.f;
#pragma unroll
        for (int s = 0; s < 4; s++) {
            const uint4 u = *(const uint4*)(qsrc + 16 * s);
            const unsigned wv[4] = {u.x, u.y, u.z, u.w};
#pragma unroll
            for (int e = 0; e < 4; e++) { y[s][2 * e] = __uint_as_float(wv[e] << 16); y[s][2 * e + 1] = __uint_as_float(wv[e] & 0xffff0000u); }
#pragma unroll
            for (int e = 0; e < 8; e++) ss += y[s][e] * y[s][e];
        }
        ss += __shfl_xor(ss, 32);
        const float r = rsqrtf(ss * (1.f / 64.f) + 1e-6f);
#pragma unroll
        for (int s = 0; s < 4; s++)
#pragma unroll
            for (int e = 0; e < 8; e++) y[s][e] *= r * qgain[16 * s + 8 * X.hh + e];
        const float qs = 0.125f * 1.4426950408889634f;
#pragma unroll
        for (int s = 0; s < 2; s++)
#pragma unroll
            for (int e = 0; e < 8; e++) {
                const float2 cs = rope[(size_t)X.t * 32 + 16 * s + 8 * X.hh + e];
                const float x1 = y[s][e], x2 = y[s + 2][e];
                y[s][e] = (x1 * cs.x - x2 * cs.y) * qs; y[s + 2][e] = (x2 * cs.x + x1 * cs.y) * qs;
            }
#pragma unroll
        for (int s = 0; s < 4; s++) X.qf[s] = pack8(y[s][0], y[s][1], y[s][2], y[s][3], y[s][4], y[s][5], y[s][6], y[s][7]);
    }
    const bf16_t* gp = proj + row * PLD + C_GATE + head * 3;
    const float g0 = sigmoidf_(bf2f(gp[0])), g1 = sigmoidf_(bf2f(gp[1])), g2 = sigmoidf_(bf2f(gp[2]));
    f32x16 F0, F1;
#pragma unroll
    for (int i = 0; i < 16; i++) { F0[i] = 0.f; F1[i] = 0.f; }
    const int cur = t0 >> 6;
    {
        X.Kbase = kc + (size_t)bg * 512 * 64; X.kstride = 64; X.Vbase = vc + (size_t)bg * 512 * 64; X.vstride = 64;
        const int nvmax = (t0 >> 4) + 1, jhi = (nvmax - 1) >> 6;
        X.m = NEGBIG; X.l = 0.f;
        nsa_branch<0>(X, 0, jhi, 0ull, 0ull, 0ull, 0ull, cur, t0 + 8 * w);
        const float lt = X.l + __shfl_xor(X.l, 32);
        X.invl = (lt > 0.f) ? 1.f / lt : 0.f;
        X.carry = 0.f;
#pragma unroll
        for (int i = 0; i < 16; i++) { X.O0[i] = 0.f; X.O1[i] = 0.f; }
        nsa_branch<1>(X, 0, jhi, 0ull, 0ull, 0ull, 0ull, cur, t0 + 8 * w);
        nsa_accum(F0, F1, X, g0);
    }
    unsigned long long mlo, mhi, ulo, uhi;
    {
        const int tk2 = lane >> 3, sub = lane & 7;
        unsigned k0 = 1u, k1 = 0u, k2 = 0u, k3 = 0u;
#define SETBIT(jj) { const int _j = (jj); if (_j < 32) k0 |= 1u << _j; else if (_j < 64) k1 |= 1u << (_j - 32); else if (_j < 96) k2 |= 1u << (_j - 64); else k3 |= 1u << (_j - 96); }
        SETBIT(cur);
        if (cur >= 1) SETBIT(cur - 1);
        const int ncand = cur - 2;
        if (ncand > 0) {
            if (ncand <= 13) {
                for (int jj = 1; jj <= cur - 2; jj++) SETBIT(jj);
            } else {
                float sc[16];
#pragma unroll
                for (int i = 0; i < 16; i++) { const int jj = sub + 8 * i; sc[i] = (jj >= 1 && jj <= cur - 2) ? X.imp_s[(8 * w + tk2) * 128 + jj] : -3e38f; }
#pragma unroll 1
                for (int it = 0; it < 13; it++) {
                    float bv = sc[0]; int bi = 0;
#pragma unroll
                    for (int i = 1; i < 16; i++) if (sc[i] > bv) { bv = sc[i]; bi = i; }
                    int bj = sub + 8 * bi;
#pragma unroll
                    for (int o = 1; o < 8; o <<= 1) {
                        const float ov = __shfl_xor(bv, o); const int oj = __shfl_xor(bj, o);
                        if (ov > bv || (ov == bv && oj < bj)) { bv = ov; bj = oj; }
                    }
                    SETBIT(bj);
#pragma unroll
                    for (int i = 0; i < 16; i++) if (bj == sub + 8 * i) sc[i] = -3e38f;
                }
            }
        }
#undef SETBIT
        if (sub == 0) { unsigned* d = X.sel_s + (8 * w + tk2) * 4; d[0] = k0; d[1] = k1; d[2] = k2; d[3] = k3; }
        __builtin_amdgcn_s_waitcnt(0xc07f);
        const unsigned* sp = X.sel_s + X.tokl * 4;
        const unsigned m0 = sp[0], m1 = sp[1], m2 = sp[2], m3 = sp[3];
        mlo = (unsigned long long)m0 | ((unsigned long long)m1 << 32); mhi = (unsigned long long)m2 | ((unsigned long long)m3 << 32);
        unsigned u0 = m0, u1 = m1, u2 = m2, u3 = m3;
#pragma unroll
        for (int o = 4; o < 32; o <<= 1) { u0 |= __shfl_xor(u0, o); u1 |= __shfl_xor(u1, o); u2 |= __shfl_xor(u2, o); u3 |= __shfl_xor(u3, o); }
        ulo = (unsigned long long)(unsigned)__builtin_amdgcn_readfirstlane(u0) | ((unsigned long long)(unsigned)__builtin_amdgcn_readfirstlane(u1) << 32);
        uhi = (unsigned long long)(unsigned)__builtin_amdgcn_readfirstlane(u2) | ((unsigned long long)(unsigned)__builtin_amdgcn_readfirstlane(u3) << 32);
    }
    {
        X.Kbase = ksn + (size_t)bg * SEQ * 64; X.kstride = 64;
        X.Vbase = proj + (size_t)(b * SEQ) * PLD + C_KV + 128 * 3 + 64 * g; X.vstride = PLD;
        X.m = NEGBIG; X.l = 0.f;
#pragma unroll
        for (int i = 0; i < 16; i++) { X.O0[i] = 0.f; X.O1[i] = 0.f; }
        nsa_branch<2>(X, 0, cur, mlo, mhi, ulo, uhi, cur, t0 + 8 * w);
        const float lt = X.l + __shfl_xor(X.l, 32);
        nsa_accum(F0, F1, X, (lt > 0.f) ? g1 / lt : 0.f);
    }
    {
        X.Kbase = kwn + (size_t)bg * SEQ * 64; X.kstride = 64;
        X.Vbase = proj + (size_t)(b * SEQ) * PLD + C_KV + 128 * 5 + 64 * g; X.vstride = PLD;
        X.m = NEGBIG; X.l = 0.f;
#pragma unroll
        for (int i = 0; i < 16; i++) { X.O0[i] = 0.f; X.O1[i] = 0.f; }
        const int jlo = (t0 >= 511) ? ((t0 - 511) >> 6) : 0;
        nsa_branch<3>(X, jlo, cur, 0ull, 0ull, 0ull, 0ull, cur, t0 + 8 * w);
        const float lt = X.l + __shfl_xor(X.l, 32);
        nsa_accum(F0, F1, X, (lt > 0.f) ? g2 / lt : 0.f);
    }
    bf16_t* dst = mixo + row * mix_ld + head * 64 + 4 * X.hh;
#pragma unroll
    for (int q4 = 0; q4 < 4; q4++) {
        *(uint2*)(dst + 8 * q4) = make_uint2(pk2(F0[4 * q4], F0[4 * q4 + 1]), pk2(F0[4 * q4 + 2], F0[4 * q4 + 3]));
        *(uint2*)(dst + 32 + 8 * q4) = make_uint2(pk2(F1[4 * q4], F1[4 * q4 + 1]), pk2(F1[4 * q4 + 2], F1[4 * q4 + 3]));
    }
}

#define KLS 136
#define XSS 264
#define GDN_PREP_LDS (2 * 64 * KLS * 2 + 64 * XSS * 2 + 512)
__device__ __forceinline__ unsigned pack2bf(float lo, float hi) { return (unsigned)f2bf(lo) | ((unsigned)f2bf(hi) << 16); }
__device__ __forceinline__ void d_gdn_prep2(const bf16_t* __restrict__ proj, const float* __restrict__ conv_w,
                                            const float* __restrict__ a_log, const float* __restrict__ dt_bias,
                                            bf16_t* __restrict__ guT, bf16_t* __restrict__ gw, bf16_t* __restrict__ gqd,
                                            bf16_t* __restrict__ gkdT, bf16_t* __restrict__ gin, float* __restrict__ gl, int chunk, char* smem) {
    bf16_t* kL = (bf16_t*)smem;
    bf16_t* qL = kL + 64 * KLS;
    float* AmT = (float*)qL;
    bf16_t* xs = qL + 64 * KLS;
    float* gcs = (float*)(xs + 64 * XSS);
    float* bts = gcs + 64;
    const int tid = threadIdx.x, lane = tid & 63, w = tid >> 6;
    const int n = chunk & 127, h = (chunk >> 7) & 3, b = chunk >> 9;
    const int t0 = n * 64;
    const size_t rbase = (size_t)(b * SEQ + t0);
    if (tid < 64) {
        const size_t r = (rbase + tid) * PLD;
        float a = bf2f(proj[r + C_A + h]), bb = bf2f(proj[r + C_B + h]);
        float xx = a + dt_bias[h];
        float sp = (xx > 20.f) ? xx : log1pf(__expf(xx));
        float c = -__expf(a_log[h]) * sp;
#pragma unroll
        for (int o = 1; o < 64; o <<= 1) { float nb = __shfl_up(c, o); if (lane >= o) c += nb; }
        gcs[tid] = c; bts[tid] = sigmoidf_(bb);
    }
    __syncthreads();
    {
        float wt[6][4], x0[6], x1[6], x2[6];
        int ch[6];
#pragma unroll
        for (int c6 = 0; c6 < 6; c6++) {
            ch[c6] = (c6 >> 1) * 512 + h * 128 + lane + 64 * (c6 & 1);
#pragma unroll
            for (int j = 0; j < 4; j++) wt[c6][j] = conv_w[j * 1536 + ch[c6]];
            const int tb = t0 + 16 * w - 3;
            x0[c6] = (tb >= 0) ? bf2f(proj[((size_t)(b * SEQ + tb)) * PLD + C_GQKV + ch[c6]]) : 0.f;
            x1[c6] = (tb + 1 >= 0) ? bf2f(proj[((size_t)(b * SEQ + tb + 1)) * PLD + C_GQKV + ch[c6]]) : 0.f;
            x2[c6] = (tb + 2 >= 0) ? bf2f(proj[((size_t)(b * SEQ + tb + 2)) * PLD + C_GQKV + ch[c6]]) : 0.f;
        }
        for (int i = 16 * w; i < 16 * w + 16; i++) {
            float sv[6];
#pragma unroll
            for (int c6 = 0; c6 < 6; c6++) {
                float xn = bf2f(proj[(rbase + i) * PLD + C_GQKV + ch[c6]]);
                float cv = x0[c6] * wt[c6][0] + x1[c6] * wt[c6][1] + x2[c6] * wt[c6][2] + xn * wt[c6][3];
                x0[c6] = x1[c6]; x1[c6] = x2[c6]; x2[c6] = xn;
                sv[c6] = cv * sigmoidf_(cv);
            }
            float rq = rsqrtf(wave_sum(sv[0] * sv[0] + sv[1] * sv[1]) + 1e-6f) * 0.08838834764831845f;
            float rk = rsqrtf(wave_sum(sv[2] * sv[2] + sv[3] * sv[3]) + 1e-6f);
            const float bi = bts[i], ei = __expf(gcs[i]);
            float q0 = sv[0] * rq, q1 = sv[1] * rq, k0 = sv[2] * rk, k1 = sv[3] * rk;
            qL[i * KLS + lane] = f2bf(q0); qL[i * KLS + lane + 64] = f2bf(q1);
            kL[i * KLS + lane] = f2bf(k0); kL[i * KLS + lane + 64] = f2bf(k1);
            xs[i * XSS + lane] = f2bf(sv[4] * bi); xs[i * XSS + lane + 64] = f2bf(sv[5] * bi);
            xs[i * XSS + 128 + lane] = f2bf(k0 * bi * ei); xs[i * XSS + 192 + lane] = f2bf(k1 * bi * ei);
            bf16_t* qd = gqd + (size_t)chunk * 8192 + i * 128;
            qd[lane] = f2bf(q0 * ei); qd[lane + 64] = f2bf(q1 * ei);
        }
    }
    __syncthreads();
    const int n16 = lane & 15, kq = lane >> 4;
    f32x4 aqk[4], akk[4];
#pragma unroll
    for (int tj = 0; tj < 4; tj++) { aqk[tj] = (f32x4){0.f, 0.f, 0.f, 0.f}; akk[tj] = (f32x4){0.f, 0.f, 0.f, 0.f}; }
#pragma unroll
    for (int ks = 0; ks < 4; ks++) {
        bf16x8 qa = *(const bf16x8*)(qL + (16 * w + n16) * KLS + 32 * ks + 8 * kq);
        bf16x8 ka = *(const bf16x8*)(kL + (16 * w + n16) * KLS + 32 * ks + 8 * kq);
#pragma unroll
        for (int tj = 0; tj < 4; tj++) {
            bf16x8 kb = *(const bf16x8*)(kL + (16 * tj + n16) * KLS + 32 * ks + 8 * kq);
            aqk[tj] = __builtin_amdgcn_mfma_f32_16x16x32_bf16(qa, kb, aqk[tj], 0, 0, 0);
            akk[tj] = __builtin_amdgcn_mfma_f32_16x16x32_bf16(ka, kb, akk[tj], 0, 0, 0);
        }
    }
    {
        const float glast = gcs[63];
        const int kidx = tid >> 1, c0 = (tid & 1) * 32;
        unsigned pk[16];
#pragma unroll
        for (int cc = 0; cc < 32; cc += 2) {
            float v0 = bf2f(kL[(c0 + cc) * KLS + kidx]) * __expf(glast - gcs[c0 + cc]);
            float v1 = bf2f(kL[(c0 + cc + 1) * KLS + kidx]) * __expf(glast - gcs[c0 + cc + 1]);
            pk[cc >> 1] = pack2bf(v0, v1);
        }
        uint4* dst = (uint4*)(gkdT + (size_t)chunk * 8192 + kidx * 64 + c0);
#pragma unroll
        for (int v4 = 0; v4 < 4; v4++) dst[v4] = make_uint4(pk[4 * v4], pk[4 * v4 + 1], pk[4 * v4 + 2], pk[4 * v4 + 3]);
        if (tid == 0) gl[chunk] = __expf(glast);
    }
    __syncthreads();
#pragma unroll
    for (int tj = 0; tj < 4; tj++)
#pragma unroll
        for (int r = 0; r < 4; r++) {
            const int i = 16 * w + 4 * kq + r, j = 16 * tj + n16;
            const float dec = (j <= i) ? __expf(gcs[i] - gcs[j]) : 0.f;
            gin[(size_t)chunk * 4096 + i * 64 + j] = f2bf(aqk[tj][r] * dec);
            AmT[j * 64 + i] = (j < i) ? bts[i] * akk[tj][r] * dec : 0.f;
        }
    __syncthreads();
    {
        const int c = tid;
#pragma unroll 1
        for (int blk = 0; blk < 8; blk++) {
            const int i0 = blk * 8;
            float acc[8];
#pragma unroll
            for (int r = 0; r < 8; r++) acc[r] = bf2f(xs[(i0 + r) * XSS + c]);
            for (int j = 0; j < i0; j++) {
                const float xj = bf2f(xs[j * XSS + c]);
                const float4 a0 = *(const float4*)(AmT + j * 64 + i0), a1 = *(const float4*)(AmT + j * 64 + i0 + 4);
                acc[0] -= a0.x * xj; acc[1] -= a0.y * xj; acc[2] -= a0.z * xj; acc[3] -= a0.w * xj;
                acc[4] -= a1.x * xj; acc[5] -= a1.y * xj; acc[6] -= a1.z * xj; acc[7] -= a1.w * xj;
            }
#pragma unroll
            for (int r = 1; r < 8; r++)
#pragma unroll
                for (int s2 = 0; s2 < r; s2++) acc[r] -= AmT[(i0 + s2) * 64 + i0 + r] * acc[s2];
#pragma unroll
            for (int r = 0; r < 8; r++) xs[(i0 + r) * XSS + c] = f2bf(acc[r]);
            if (c < 128) {
                *(uint4*)(guT + (size_t)chunk * 8192 + c * 64 + i0) =
                    make_uint4(pack2bf(acc[0], acc[1]), pack2bf(acc[2], acc[3]), pack2bf(acc[4], acc[5]), pack2bf(acc[6], acc[7]));
            } else {
#pragma unroll
                for (int r = 0; r < 8; r++) gw[(size_t)chunk * 8192 + (i0 + r) * 128 + (c - 128)] = f2bf(acc[r]);
            }
        }
    }
}

struct GdnFrag { bf16x8 wA[4], qA[4], inA[2], kdA[2][2]; uint2 uC; float glv; };
__device__ __forceinline__ void gdn_load_frag(GdnFrag& f, const bf16_t* __restrict__ guT, const bf16_t* __restrict__ gw, const bf16_t* __restrict__ gqd,
                                              const bf16_t* __restrict__ gkdT, const bf16_t* __restrict__ gin, const float* __restrict__ gl,
                                              int chunk, int w, int sl, int n16, int kq) {
    const size_t cb = (size_t)chunk * 8192;
#pragma unroll
    for (int ks = 0; ks < 4; ks++) {
        f.wA[ks] = *(const bf16x8*)(gw + cb + (16 * w + n16) * 128 + 32 * ks + 8 * kq);
        f.qA[ks] = *(const bf16x8*)(gqd + cb + (16 * w + n16) * 128 + 32 * ks + 8 * kq);
    }
#pragma unroll
    for (int ks = 0; ks < 2; ks++) {
        f.inA[ks] = *(const bf16x8*)(gin + (size_t)chunk * 4096 + (16 * w + n16) * 64 + 32 * ks + 8 * kq);
        f.kdA[0][ks] = *(const bf16x8*)(gkdT + cb + (32 * w + n16) * 64 + 32 * ks + 8 * kq);
        f.kdA[1][ks] = *(const bf16x8*)(gkdT + cb + (32 * w + 16 + n16) * 64 + 32 * ks + 8 * kq);
    }
    f.uC = *(const uint2*)(guT + cb + (16 * sl + n16) * 64 + 16 * w + 4 * kq);
    f.glv = gl[chunk];
}
#define STS 144
#define VNS 80
__device__ __forceinline__ void gdn_step(const GdnFrag& f, f32x4& S0, f32x4& S1, bf16_t* StT, bf16_t* vnT, float* __restrict__ ogrow, int w, int n16, int kq) {
    f32x4 ws = (f32x4){0.f, 0.f, 0.f, 0.f}, qs = (f32x4){0.f, 0.f, 0.f, 0.f};
#pragma unroll
    for (int ks = 0; ks < 4; ks++) {
        bf16x8 sb = *(const bf16x8*)(StT + n16 * STS + 32 * ks + 8 * kq);
        ws = __builtin_amdgcn_mfma_f32_16x16x32_bf16(f.wA[ks], sb, ws, 0, 0, 0);
        qs = __builtin_amdgcn_mfma_f32_16x16x32_bf16(f.qA[ks], sb, qs, 0, 0, 0);
    }
    float v0 = __uint_as_float(f.uC.x << 16) - ws[0], v1 = __uint_as_float(f.uC.x & 0xffff0000u) - ws[1];
    float v2 = __uint_as_float(f.uC.y << 16) - ws[2], v3 = __uint_as_float(f.uC.y & 0xffff0000u) - ws[3];
    *(uint2*)(vnT + n16 * VNS + 16 * w + 4 * kq) = make_uint2(pack2bf(v0, v1), pack2bf(v2, v3));
    __syncthreads();
    bf16x8 vb0 = *(const bf16x8*)(vnT + n16 * VNS + 8 * kq), vb1 = *(const bf16x8*)(vnT + n16 * VNS + 32 + 8 * kq);
    qs = __builtin_amdgcn_mfma_f32_16x16x32_bf16(f.inA[0], vb0, qs, 0, 0, 0);
    qs = __builtin_amdgcn_mfma_f32_16x16x32_bf16(f.inA[1], vb1, qs, 0, 0, 0);
    S0 = S0 * f.glv; S1 = S1 * f.glv;
    S0 = __builtin_amdgcn_mfma_f32_16x16x32_bf16(f.kdA[0][0], vb0, S0, 0, 0, 0);
    S0 = __builtin_amdgcn_mfma_f32_16x16x32_bf16(f.kdA[0][1], vb1, S0, 0, 0, 0);
    S1 = __builtin_amdgcn_mfma_f32_16x16x32_bf16(f.kdA[1][0], vb0, S1, 0, 0, 0);
    S1 = __builtin_amdgcn_mfma_f32_16x16x32_bf16(f.kdA[1][1], vb1, S1, 0, 0, 0);
#pragma unroll
    for (int r = 0; r < 4; r++) ogrow[(size_t)(4 * kq + r) * 512] = qs[r];
    *(uint2*)(StT + n16 * STS + 32 * w + 4 * kq) = make_uint2(pack2bf(S0[0], S0[1]), pack2bf(S0[2], S0[3]));
    *(uint2*)(StT + n16 * STS + 32 * w + 16 + 4 * kq) = make_uint2(pack2bf(S1[0], S1[1]), pack2bf(S1[2], S1[3]));
    __syncthreads();
}
__device__ __forceinline__ void d_gdn_scan2(const bf16_t* __restrict__ guT, const bf16_t* __restrict__ gw, const bf16_t* __restrict__ gqd,
                                            const bf16_t* __restrict__ gkdT, const bf16_t* __restrict__ gin, const float* __restrict__ gl,
                                            float* __restrict__ og, int item, char* smem) {
    bf16_t* StT = (bf16_t*)smem;
    bf16_t* vnT = StT + 16 * STS;
    const int tid = threadIdx.x, lane = tid & 63, w = tid >> 6, n16 = lane & 15, kq = lane >> 4;
    const int bh = item >> 3, sl = item & 7, b = bh >> 2, h = bh & 3;
    for (int i = tid; i < 16 * STS / 2; i += 256) ((unsigned*)StT)[i] = 0u;
    f32x4 S0 = (f32x4){0.f, 0.f, 0.f, 0.f}, S1 = (f32x4){0.f, 0.f, 0.f, 0.f};
    GdnFrag fa, fb;
    gdn_load_frag(fa, guT, gw, gqd, gkdT, gin, gl, bh * 128, w, sl, n16, kq);
    __syncthreads();
    float* obase = og + (size_t)(b * SEQ + 16 * w) * 512 + h * 128 + 16 * sl + n16;
#pragma unroll 1
    for (int n = 0; n < 128; n += 2) {
        gdn_load_frag(fb, guT, gw, gqd, gkdT, gin, gl, bh * 128 + n + 1, w, sl, n16, kq);
        gdn_step(fa, S0, S1, StT, vnT, obase + (size_t)(n * 64) * 512, w, n16, kq);
        if (n + 2 < 128) gdn_load_frag(fa, guT, gw, gqd, gkdT, gin, gl, bh * 128 + n + 2, w, sl, n16, kq);
        gdn_step(fb, S0, S1, StT, vnT, obase + (size_t)((n + 1) * 64) * 512, w, n16, kq);
    }
}

__device__ __forceinline__ void d_gdn_out(const float* __restrict__ og, const bf16_t* __restrict__ proj, const float* __restrict__ gain, bf16_t* __restrict__ mix, int t, int lane) {
    const float* o = og + (size_t)t * 512;
    const bf16_t* z = proj + (size_t)t * PLD + C_Z;
    float a[8], zz[8];
#pragma unroll
    for (int i = 0; i < 8; i++) { a[i] = o[lane + 64 * i]; zz[i] = bf2f(z[lane + 64 * i]); }
    const float g0 = gain[lane], g1 = gain[lane + 64];
#pragma unroll
    for (int h = 0; h < 4; h++) {
        const float ss = wave_sum_dpp(a[2 * h] * a[2 * h] + a[2 * h + 1] * a[2 * h + 1]);
        const float r = rsqrtf(ss * (1.f / 128.f) + 1e-6f);
        mix[(size_t)t * DM + 512 + h * 128 + lane] = f2bf(a[2 * h] * r * g0 * zz[2 * h] * sigmoidf_(zz[2 * h]));
        mix[(size_t)t * DM + 512 + h * 128 + lane + 64] = f2bf(a[2 * h + 1] * r * g1 * zz[2 * h + 1] * sigmoidf_(zz[2 * h + 1]));
    }
}

__device__ __forceinline__ void route_load_subkeys(const float* __restrict__ subkeys, char* smem) {
    for (int idx = threadIdx.x; idx < 2 * 128 * 16; idx += 256) {
        const int half = idx >> 11, key = (idx >> 4) & 127, ch = idx & 15;
        const float* src = subkeys + ((size_t)(half * 128 + key)) * 128 + ch * 8;
        const float4 x0 = *(const float4*)src, x1 = *(const float4*)(src + 4);
        *(uint4*)(smem + half * 32768 + key * 256 + ((ch ^ (key & 15)) << 4)) = make_uint4(pk2(x0.x, x0.y), pk2(x0.z, x0.w), pk2(x1.x, x1.y), pk2(x1.z, x1.w));
    }
}
#define CEX(i, j) { const float _a = v[i], _b = v[j]; v[i] = fmaxf(_a, _b); v[j] = fminf(_a, _b); }
__device__ __forceinline__ void d_peer_route2(const bf16_t* __restrict__ qry, int* __restrict__ eidx, float* __restrict__ pgate, int mtile, const char* smem, int lane) {
    const int n16 = lane & 15, kq = lane >> 4;
    const int tA = 2 * mtile + (n16 >> 3), hA = n16 & 7;
    float topv[2][4];
#pragma unroll
    for (int half = 0; half < 2; half++) {
        const bf16_t* qp = qry + (size_t)tA * 2048 + hA * 256 + half * 128 + 8 * kq;
        bf16x8 a[4];
#pragma unroll
        for (int ks = 0; ks < 4; ks++) a[ks] = *(const bf16x8*)(qp + 32 * ks);
        f32x4 acc[8];
#pragma unroll
        for (int nt = 0; nt < 8; nt++) acc[nt] = (f32x4){0.f, 0.f, 0.f, 0.f};
#pragma unroll
        for (int ks = 0; ks < 4; ks++)
#pragma unroll
            for (int nt = 0; nt < 8; nt++) {
                const bf16x8 bb = *(const bf16x8*)(smem + half * 32768 + (16 * nt + n16) * 256 + (((4 * ks + kq) ^ n16) << 4));
                acc[nt] = __builtin_amdgcn_mfma_f32_16x16x32_bf16(a[ks], bb, acc[nt], 0, 0, 0);
                if (nt == 3 || nt == 7) __builtin_amdgcn_sched_barrier(0);
            }
#pragma unroll
        for (int r = 0; r < 4; r++) {
            float v[8];
#pragma unroll
            for (int nt = 0; nt < 8; nt++) v[nt] = __uint_as_float((__float_as_uint(acc[nt][r]) & 0xFFFFFF80u) | (unsigned)(nt << 4) | (unsigned)n16);
            CEX(0, 1) CEX(2, 3) CEX(4, 5) CEX(6, 7) CEX(0, 2) CEX(1, 3) CEX(4, 6) CEX(5, 7) CEX(1, 2) CEX(5, 6)
            CEX(0, 4) CEX(1, 5) CEX(2, 6) CEX(3, 7) CEX(2, 4) CEX(3, 5) CEX(1, 2) CEX(3, 4) CEX(5, 6)
            float keep = 0.f;
#pragma unroll 1
            for (int it = 0; it < 16; it++) {
                const float mx = allmax16(v[0]);
                if (n16 == it) keep = mx;
                if (__float_as_uint(v[0]) == __float_as_uint(mx)) {
                    v[0] = v[1]; v[1] = v[2]; v[2] = v[3]; v[3] = v[4]; v[4] = v[5]; v[5] = v[6]; v[6] = v[7]; v[7] = -3e38f;
                }
            }
            topv[half][r] = keep;
            __builtin_amdgcn_sched_barrier(0);
        }
    }
#pragma unroll
    for (int r = 0; r < 4; r++) {
        const float v1p = topv[0][r], v2p = topv[1][r];
        const unsigned u1 = __float_as_uint(v1p);
        const int i1 = (int)(((u1 >> 4) & 7u) * 16u + (u1 & 15u));
        const int lim = 16 / (n16 + 1);
        int ptr = 0;
        const int lanebase = (lane & 48);
        float cur2 = __builtin_bit_cast(float, __builtin_amdgcn_ds_bpermute(lanebase * 4, __builtin_bit_cast(int, v2p)));
        float head = __uint_as_float((__float_as_uint(v1p + cur2) & 0xFFFFFFF0u) | (unsigned)n16);
        float ksc = 0.f; unsigned ke = 0u;
#pragma unroll 1
        for (int it = 0; it < 16; it++) {
            const float mx = allmax16(head);
            const bool win = __float_as_uint(head) == __float_as_uint(mx);
            const unsigned u2 = __float_as_uint(cur2);
            unsigned e = win ? (unsigned)(i1 * 128) + ((u2 >> 4) & 7u) * 16u + (u2 & 15u) : 0u;
            e = allmaxu16(e);
            if (n16 == it) { ksc = mx; ke = e; }
            if (win) ptr++;
            const int pn = ptr < 15 ? ptr : 15;
            const float nx = __builtin_bit_cast(float, __builtin_amdgcn_ds_bpermute((lanebase + pn) * 4, __builtin_bit_cast(int, v2p)));
            if (win) { cur2 = nx; head = (ptr < lim) ? __uint_as_float((__float_as_uint(v1p + cur2) & 0xFFFFFFF0u) | (unsigned)n16) : -3e38f; }
        }
        const float smax = allmax16(ksc);
        const float ex = __expf(ksc - smax);
        const float sum = allsum16(ex);
        const int row = 4 * kq + r;
        const size_t o = (size_t)(2 * mtile + (row >> 3)) * 128 + (row & 7) * 16 + n16;
        eidx[o] = (int)ke; pgate[o] = ex / sum;
    }
}
#undef CEX

__device__ __forceinline__ void d_quant_row(const float* __restrict__ src, unsigned char* __restrict__ dst, float* __restrict__ scale, int row, int lane, int bias) {
    const float4* p = (const float4*)(src + (size_t)row * DM) + lane * 4;
    float4 x[4];
    float am = 0.f;
#pragma unroll
    for (int i = 0; i < 4; i++) { x[i] = p[i]; am = fmaxf(am, fmaxf(fmaxf(fabsf(x[i].x), fabsf(x[i].y)), fmaxf(fabsf(x[i].z), fabsf(x[i].w)))); }
    am = wave_max(am);
    const float sc = (am > 0.f) ? am * (1.f / 127.f) : 1.f;
    const float inv = 1.f / sc;
    unsigned wv[4];
#pragma unroll
    for (int i = 0; i < 4; i++) {
        const int q0 = (int)rintf(x[i].x * inv) + bias, q1 = (int)rintf(x[i].y * inv) + bias, q2 = (int)rintf(x[i].z * inv) + bias, q3 = (int)rintf(x[i].w * inv) + bias;
        wv[i] = (unsigned)(q0 & 0xff) | ((unsigned)(q1 & 0xff) << 8) | ((unsigned)(q2 & 0xff) << 16) | ((unsigned)(q3 & 0xff) << 24);
    }
    ((uint4*)(dst + (size_t)row * DM))[lane] = make_uint4(wv[0], wv[1], wv[2], wv[3]);
    if (lane == 0) scale[row] = sc;
}

struct PeerGrp { u32x4 u[4]; u32x4 v[4]; float gv[4]; float su[4]; };
__device__ __forceinline__ void peer_load(PeerGrp& G, const unsigned char* __restrict__ uq, const unsigned char* __restrict__ vq,
                                          int esrc, float gsrc, float susrc, int k0, int lane) {
#pragma unroll
    for (int i = 0; i < 4; i++) {
        const int e = __builtin_amdgcn_readlane(esrc, (k0 + i) & 63);
        G.gv[i] = __builtin_bit_cast(float, __builtin_amdgcn_readlane(__builtin_bit_cast(int, gsrc), (k0 + i) & 63));
        G.su[i] = __builtin_bit_cast(float, __builtin_amdgcn_readlane(__builtin_bit_cast(int, susrc), (k0 + i) & 63));
        G.u[i] = ((const u32x4*)(uq + (size_t)e * DM))[lane];
        G.v[i] = ((const u32x4*)(vq + (size_t)e * DM))[lane];
    }
}
__device__ __forceinline__ void peer_compute(const PeerGrp& G, const int (&xq)[4], float sx, float (&acc)[16], float& bsum) {
    int d[4];
#pragma unroll
    for (int i = 0; i < 4; i++) {
        int sdot = 0;
        sdot = __builtin_amdgcn_sdot4((int)G.u[i][0], xq[0], sdot, false); sdot = __builtin_amdgcn_sdot4((int)G.u[i][1], xq[1], sdot, false);
        sdot = __builtin_amdgcn_sdot4((int)G.u[i][2], xq[2], sdot, false); sdot = __builtin_amdgcn_sdot4((int)G.u[i][3], xq[3], sdot, false);
        d[i] = sdot;
    }
#pragma unroll
    for (int i = 0; i < 4; i++) {
        int x = d[i];
        x += (int)dppu<0xB1>((unsigned)x); x += (int)dppu<0x4E>((unsigned)x); x += (int)dppu<0x141>((unsigned)x); x += (int)dppu<0x140>((unsigned)x);
        d[i] = __builtin_amdgcn_readlane(x, 0) + __builtin_amdgcn_readlane(x, 16) + __builtin_amdgcn_readlane(x, 32) + __builtin_amdgcn_readlane(x, 48);
    }
#pragma unroll
    for (int i = 0; i < 4; i++) {
        const float dot = (float)d[i] * (G.su[i] * sx);
        const float u2 = 1.5957691216057308f * (dot + 0.044715f * dot * dot * dot);
        const float cs = G.gv[i] * dot * __builtin_amdgcn_rcpf(1.f + __expf(-u2));
        bsum += cs;
#pragma unroll
        for (int j = 0; j < 4; j++) {
            const unsigned wv = G.v[i][j];
            acc[4 * j] += cs * (float)(wv & 0xffu);
            acc[4 * j + 1] += cs * (float)((wv >> 8) & 0xffu);
            acc[4 * j + 2] += cs * (float)((wv >> 16) & 0xffu);
            acc[4 * j + 3] += cs * (float)(wv >> 24);
        }
    }
}
__device__ __forceinline__ void d_peer_expert3(const bf16_t* __restrict__ h2, const int* __restrict__ eidx, const float* __restrict__ pgate,
                                               const unsigned char* __restrict__ uq, const unsigned char* __restrict__ vq,
                                               const float* __restrict__ su, const float* __restrict__ sv, float* __restrict__ out, int token, int lane) {
    const uint4 xa = ((const uint4*)(h2 + (size_t)token * DM))[2 * lane], xb = ((const uint4*)(h2 + (size_t)token * DM))[2 * lane + 1];
    const unsigned xw[8] = {xa.x, xa.y, xa.z, xa.w, xb.x, xb.y, xb.z, xb.w};
    float xf[16];
    float am = 0.f;
#pragma unroll
    for (int j = 0; j < 8; j++) { xf[2 * j] = __uint_as_float(xw[j] << 16); xf[2 * j + 1] = __uint_as_float(xw[j] & 0xffff0000u); am = fmaxf(am, fmaxf(fabsf(xf[2 * j]), fabsf(xf[2 * j + 1]))); }
    am = wave_max(am);
    const float sx = (am > 0.f) ? am * (1.f / 127.f) : 1.f;
    const float isx = 1.f / sx;
    int xq[4];
#pragma unroll
    for (int j = 0; j < 4; j++) {
        const int q0 = (int)rintf(xf[4 * j] * isx), q1 = (int)rintf(xf[4 * j + 1] * isx), q2 = (int)rintf(xf[4 * j + 2] * isx), q3 = (int)rintf(xf[4 * j + 3] * isx);
        xq[j] = (int)((unsigned)(q0 & 0xff) | ((unsigned)(q1 & 0xff) << 8) | ((unsigned)(q2 & 0xff) << 16) | ((unsigned)(q3 & 0xff) << 24));
    }
    float acc[16];
#pragma unroll
    for (int i = 0; i < 16; i++) acc[i] = 0.f;
    float bsum = 0.f;
    const int e_lo = eidx[(size_t)token * 128 + lane], e_hi = eidx[(size_t)token * 128 + 64 + lane];
    const float g_lo = pgate[(size_t)token * 128 + lane] * sv[e_lo], g_hi = pgate[(size_t)token * 128 + 64 + lane] * sv[e_hi];
    const float s_lo = su[e_lo], s_hi = su[e_hi];
    PeerGrp A, B;
    peer_load(A, uq, vq, e_lo, g_lo, s_lo, 0, lane);
#pragma unroll 1
    for (int k0 = 0; k0 < 64; k0 += 8) {
        peer_load(B, uq, vq, e_lo, g_lo, s_lo, k0 + 4, lane);
        peer_compute(A, xq, sx, acc, bsum);
        if (k0 + 8 < 64) peer_load(A, uq, vq, e_lo, g_lo, s_lo, k0 + 8, lane); else peer_load(A, uq, vq, e_hi, g_hi, s_hi, 0, lane);
        peer_compute(B, xq, sx, acc, bsum);
    }
#pragma unroll 1
    for (int k0 = 0; k0 < 64; k0 += 8) {
        peer_load(B, uq, vq, e_hi, g_hi, s_hi, k0 + 4, lane);
        peer_compute(A, xq, sx, acc, bsum);
        if (k0 + 8 < 64) peer_load(A, uq, vq, e_hi, g_hi, s_hi, k0 + 8, lane);
        peer_compute(B, xq, sx, acc, bsum);
    }
    const float bs = 128.f * bsum;
    float4* o = (float4*)(out + (size_t)token * DM + lane * 16);
#pragma unroll
    for (int j = 0; j < 4; j++) {
        float4 t = o[j];
        t.x += acc[4 * j] - bs; t.y += acc[4 * j + 1] - bs; t.z += acc[4 * j + 2] - bs; t.w += acc[4 * j + 3] - bs;
        o[j] = t;
    }
}

#define XB_TMO      128
#define XB_XCNT(j)  (256  + 64 * (j))
#define XB_XSUB(j)  (1280 + 64 * (j))
#define XB_XGEN(j)  (2304 + 64 * (j))
#define XB_TOP      3328
#define XB_TOPGEN   3392
#define XB_QUEUE    3456
#define XCD_BAR_WORDS 4096
#define XB_SPIN_CAP (1u << 22)
#define LAS __attribute__((address_space(3)))
__device__ __forceinline__ unsigned xb_ld(unsigned* p)              { return __hip_atomic_load(p, __ATOMIC_RELAXED, __HIP_MEMORY_SCOPE_AGENT); }
__device__ __forceinline__ unsigned xb_add(unsigned* p, unsigned v) { return __hip_atomic_fetch_add(p, v, __ATOMIC_RELAXED, __HIP_MEMORY_SCOPE_AGENT); }
__device__ __forceinline__ unsigned xb_xcc_id() { return (unsigned)__builtin_amdgcn_s_getreg((3 << 11) | 20) & 0xFu; }
#define XB_SPIN(cond, bar) do { unsigned _sp = 0; while (cond) { __builtin_amdgcn_s_sleep(1); \
    if ((++_sp & 255u) == 0u) { if (xb_ld(&(bar)[XB_TMO])) break; if (_sp > XB_SPIN_CAP) { atomicAdd(&(bar)[XB_TMO], 1u); break; } } } } while (0)
struct XcdBarrier { unsigned* bar; unsigned x; volatile LAS unsigned* st; };
__device__ __forceinline__ XcdBarrier xcd_barrier_post(unsigned* bar, volatile LAS unsigned* st) {
    XcdBarrier b; b.bar = bar; b.x = xb_xcc_id(); b.st = st;
    if (threadIdx.x == 0) (void)xb_add(&bar[XB_XCNT(b.x)], 1u);
    return b;
}
__device__ __forceinline__ void xcd_barrier_complete(unsigned* bar, unsigned x, unsigned& nloc, unsigned& nx) {
    const unsigned G = gridDim.x * gridDim.y * gridDim.z;
    unsigned sum, cnt, mine, sp = 0u;
    for (;;) {
        sum = 0u; cnt = 0u; mine = 0u;
#pragma unroll
        for (unsigned j = 0; j < 16; ++j) { const unsigned c = xb_ld(&bar[XB_XCNT(j)]); sum += c; cnt += (c > 0u) ? 1u : 0u; mine = (j == x) ? c : mine; }
        if (sum == G) break;
        __builtin_amdgcn_s_sleep(1);
        if ((++sp & 255u) == 0u) { if (xb_ld(&bar[XB_TMO])) break; if (sp > XB_SPIN_CAP) { atomicAdd(&bar[XB_TMO], 1u); break; } }
    }
    nloc = mine > 0u ? mine : 1u; nx = cnt > 0u ? cnt : 1u;
}
__device__ __forceinline__ void xcd_barrier(const XcdBarrier& b) {
    asm volatile("s_waitcnt vmcnt(0)" ::: "memory");
    __syncthreads();
    if (threadIdx.x == 0) {
        unsigned* bar = b.bar;
        __builtin_amdgcn_s_waitcnt(0);
        unsigned nloc = b.st[0], nx = b.st[1];
        if (nloc == 0u) { xcd_barrier_complete(bar, b.x, nloc, nx); b.st[0] = nloc; b.st[1] = nx; }
        const unsigned old = xb_add(&bar[XB_XSUB(b.x)], 1u);
        const unsigned gen = old / nloc;
        if (old + 1u == (gen + 1u) * nloc) {
            __builtin_amdgcn_fence(__ATOMIC_RELEASE, "agent");
            asm volatile("s_waitcnt vmcnt(0)" ::: "memory");
            const unsigned og = xb_add(&bar[XB_TOP], 1u);
            const unsigned tg = og / nx;
            if (og + 1u == (tg + 1u) * nx) xb_add(&bar[XB_TOPGEN], 1u);
            else XB_SPIN(xb_ld(&bar[XB_TOPGEN]) == tg, bar);
            __builtin_amdgcn_fence(__ATOMIC_ACQUIRE, "agent");
            xb_add(&bar[XB_XGEN(b.x)], 1u);
            asm volatile("s_waitcnt vmcnt(0)" ::: "memory");
        } else {
            XB_SPIN(xb_ld(&bar[XB_XGEN(b.x)]) == gen, bar);
            __builtin_amdgcn_fence(__ATOMIC_ACQUIRE, "agent");
            asm volatile("s_waitcnt vmcnt(0)" ::: "memory");
        }
    }
    __syncthreads();
}

struct MKP {
    const float *x, *attn_norm, *w_in, *q_gain, *k_gain, *cmp_pos, *cmp_w1, *cmp_w2, *gdn_conv, *a_log, *dt_bias, *out_gain, *w_out, *ffn_norm, *w_query, *subkeys, *peer_u, *peer_v;
    float* out; char* ws; unsigned* bar;
};

#define SMEM_BYTES 69120

__global__ __launch_bounds__(256, 2) void hybrid_megakernel(MKP P) {
    extern __shared__ __attribute__((aligned(16))) char smem[];
    __shared__ uint4 xb_words;
    __shared__ int q_item;
    const int G = gridDim.x, bid0 = blockIdx.x;
    if (threadIdx.x == 0) xb_words = make_uint4(0u, 0u, 0u, 0u);
    __syncthreads();
    XcdBarrier B = xcd_barrier_post(P.bar, (volatile LAS unsigned*)&xb_words);
    char* ws = P.ws;
    bf16_t* w_in_t = (bf16_t*)(ws + OFF_WINT);
    bf16_t* w_out_t = (bf16_t*)(ws + OFF_WOUTT);
    bf16_t* w_q_t = (bf16_t*)(ws + OFF_WQT);
    bf16_t* cw1_t = (bf16_t*)(ws + OFF_CW1T);
    float* cbias = (float*)(ws + OFF_CBIAS);
    bf16_t* h_bf = (bf16_t*)(ws + OFF_HBF);
    bf16_t* proj = (bf16_t*)(ws + OFF_PROJ);
    bf16_t* ksn = (bf16_t*)(ws + OFF_KSN);
    bf16_t* kwn = (bf16_t*)(ws + OFF_KWN);
    bf16_t* kc = (bf16_t*)(ws + OFF_KC);
    bf16_t* vc = (bf16_t*)(ws + OFF_VC);
    bf16_t* hid = (bf16_t*)(ws + OFF_HID);
    bf16_t* gu = (bf16_t*)(ws + OFF_GU);
    bf16_t* gw = (bf16_t*)(ws + OFF_GW);
    bf16_t* gqd = (bf16_t*)(ws + OFF_GQD);
    bf16_t* gkd = (bf16_t*)(ws + OFF_GKD);
    bf16_t* gin = (bf16_t*)(ws + OFF_GIN);
    float* gl = (float*)(ws + OFF_GL);
    bf16_t* mix = (bf16_t*)(ws + OFF_MIX);
    bf16_t* qry = (bf16_t*)(ws + OFF_QRY);
    bf16_t* h2 = (bf16_t*)(ws + OFF_H2);
    int* eidx = (int*)(ws + OFF_EIDX);
    float* pgate = (float*)(ws + OFF_PGATE);
    unsigned char* uq = (unsigned char*)(ws + OFF_UQ);
    unsigned char* vq = (unsigned char*)(ws + OFF_VQ);
    float* su = (float*)(ws + OFF_SU);
    float* sv = (float*)(ws + OFF_SV);
    float* og = P.out;
    float2* rope = (float2*)(ws + OFF_ROPE);
    bf16_t* cw2t = (bf16_t*)(ws + OFF_CW2T);
    unsigned char* uq_tmp = (unsigned char*)(P.out + 8388608);
    unsigned char* vq_tmp = uq_tmp + 16384ull * 1024;

#ifdef PROBE_P0
    for (int rep = 0; rep < 2; rep++)
#endif
    {
        const int n1 = 108 * 32, n2 = n1 + 32 * 32, n3 = n2 + 64 * 32, n4 = n3 + 2 * 8 * 64, n5 = n4 + 2 * 2 * 8;
        for (int it = bid0; it < n5; it += G) {
            if (it < n1) d_transpose_bf16(P.w_in, 1024, IN_COLS, w_in_t, it % 108, it / 108, smem);
            else if (it < n2) { int r = it - n1; d_transpose_bf16(P.w_out, 1024, 1024, w_out_t, r % 32, r / 32, smem); }
            else if (it < n3) { int r = it - n2; d_transpose_bf16(P.w_query, 1024, 2048, w_q_t, r % 64, r / 64, smem); }
            else if (it < n4) { int r = it - n3; int j = r >> 9; r &= 511; d_transpose_bf16(P.cmp_w1 + (size_t)j * 2048 * 256, 2048, 256, cw1_t + (size_t)j * 256 * 2048, r % 8, r / 8, smem); }
            else { int r = it - n4; int j = r >> 4; r &= 15; d_transpose_bf16(P.cmp_w2 + (size_t)j * 256 * 64, 256, 64, cw2t + (size_t)j * 64 * 256, r % 2, r / 2, smem); }
            __syncthreads();
        }
        for (int it = bid0; it < 16; it += G) d_cmp_bias(P.cmp_pos, P.cmp_w1, cbias, it, smem);
        for (int it = bid0; it < T_TOK / 4; it += G) d_rmsnorm_bf16(P.x, P.attn_norm, h_bf, it);
        for (int i = bid0 * 256 + threadIdx.x; i < 8192 * 32; i += G * 256) {
            const int pos = i >> 5, fi = i & 31;
            float sn, cs; sincosf((float)pos * expf(-9.210340371976184f * (float)(2 * fi) / 64.f), &sn, &cs);
            rope[i] = make_float2(cs, sn);
        }
        for (int i = bid0 * 256 + threadIdx.x; i < 32 * PLD / 2; i += G * 256) ((unsigned*)(proj + (size_t)T_TOK * PLD))[i] = 0u;
    }
    xcd_barrier(B);
    {
        GemmP p{}; p.A = h_bf; p.lda = 1024; p.akts = 64; p.Bt = w_in_t; p.ldb = 1024; p.K = 1024; p.mtiles = 128; p.ntiles = 27; p.out = proj;
#ifdef PROBE_GEMM1
        for (int rep = 0; rep < PROBE_GEMM1; rep++)
#endif
        for (int it = bid0; it < 128 * 27; it += G) d_gemm<EPI_PROJ>(p, it, smem);
    }
    xcd_barrier(B);
#ifdef PROBE_MISC
    for (int rep = 0; rep < 2; rep++)
#endif
    {
        for (int it = bid0; it < 64; it += G) {
            int inst = it >> 3, tile = it & 7;
            int j = inst >> 2, b = (inst >> 1) & 1, g = inst & 1;
            GemmP p{}; p.A = proj + (size_t)(b * SEQ) * PLD + C_KV + 128 * j + 64 * g; p.lda = 16 * PLD; p.akts = PLD;
            p.Bt = cw1_t + (size_t)j * 256 * 2048; p.ldb = 2048; p.K = 2048; p.mtiles = 4; p.ntiles = 2;
            p.out = hid + (size_t)inst * 512 * 256; p.aux = cbias + j * 256;
            d_gemm<EPI_HID>(p, tile, smem);
        }
        for (int it = bid0; it < 1024; it += G) { d_gdn_prep2(proj, P.gdn_conv, P.a_log, P.dt_bias, gu, gw, gqd, gkd, gin, gl, it, smem); __syncthreads(); }
        for (int it = bid0; it < 8192; it += G) d_knorm_rope(proj, P.k_gain, ksn, kwn, it);
    }
    xcd_barrier(B);
#ifdef PROBE_MISC
    for (int rep = 0; rep < 2; rep++)
#endif
    for (int wi = bid0 * 4 + (threadIdx.x >> 6); wi < 256; wi += G * 4) d_cmp2_mfma(hid, cw2t, P.k_gain, rope, kc, vc, wi, threadIdx.x & 63);
    xcd_barrier(B);
    {
        if (bid0 < 64) d_gdn_scan2(gu, gw, gqd, gkd, gin, gl, og, bid0, smem);
        __syncthreads();
#ifdef PROBE_NSA
        for (int rep = 0; rep < 2; rep++)
#else
        const int rep = 0;
#endif
        for (;;) {
            if (threadIdx.x == 0) q_item = (int)xb_add(&P.bar[XB_QUEUE + 256 * rep], 1u);
            __syncthreads();
            const int it = q_item;
            if (it >= 1024 + 128) break;
            if (it >= 1024) {
                const int r0 = (it - 1024) * 128 + (threadIdx.x >> 6) * 32;
                for (int r = r0; r < r0 + 32; r++) { d_quant_row(P.peer_u, uq_tmp, su, r, threadIdx.x & 63, 0); d_quant_row(P.peer_v, vq_tmp, sv, r, threadIdx.x & 63, 128); }
            } else {
                d_nsa_mfma(proj, P.q_gain, rope, ksn, kwn, kc, vc, mix, DM, it, smem);
            }
            __syncthreads();
        }
#ifdef NSA_CHECK
        bf16_t* mix2 = (bf16_t*)(ws + OFF_END);
        for (;;) {
            if (threadIdx.x == 0) q_item = (int)xb_add(&P.bar[XB_QUEUE + 64], 1u);
            __syncthreads();
            const int it = q_item;
            if (it >= 2 * 2 * SEQ) break;
            d_nsa_naive(proj, P.q_gain, ksn, kwn, kc, vc, mix2, 512, it, smem);
            __syncthreads();
        }
#endif
    }
    xcd_barrier(B);
#ifdef NSA_CHECK
    {
        const bf16_t* mix2 = (const bf16_t*)(ws + OFF_END);
        float sd = 0.f, sr = 0.f;
        for (int i = bid0 * 256 + threadIdx.x; i < T_TOK * 512; i += G * 256) {
            const int r = i >> 9, c = i & 511;
            const float a = bf2f(mix[(size_t)r * DM + c]), bb = bf2f(mix2[i]);
            sd += (a - bb) * (a - bb); sr += bb * bb;
        }
        sd = wave_sum(sd); sr = wave_sum(sr);
        if ((threadIdx.x & 63) == 0) { atomicAdd((float*)&P.bar[XB_QUEUE + 128], sd); atomicAdd((float*)&P.bar[XB_QUEUE + 192], sr); }
    }
    xcd_barrier(B);
#endif
#ifdef PROBE_MISC
    for (int rep = 0; rep < 2; rep++) {
#endif
    for (int t = bid0 * 4 + (threadIdx.x >> 6); t < T_TOK; t += G * 4) d_gdn_out(og, proj, P.out_gain, mix, t, threadIdx.x & 63);
    for (int i = bid0 * 256 + threadIdx.x; i < 2 * 16384 * 1024 / 16; i += G * 256) ((uint4*)uq)[i] = ((const uint4*)uq_tmp)[i];
#ifdef PROBE_MISC
    }
#endif
    xcd_barrier(B);
#ifdef PROBE_P4
    for (int rep = 0; rep < 2; rep++) {
#endif
    {
        GemmP p{}; p.A = mix; p.lda = 1024; p.akts = 64; p.Bt = w_out_t; p.ldb = 1024; p.K = 1024; p.mtiles = 128; p.ntiles = 8; p.out = P.out; p.aux = P.x;
        for (int it = bid0; it < 128 * 8; it += G) d_gemm<EPI_OUT>(p, it, smem);
    }
    xcd_barrier(B);
    for (int it = bid0; it < T_TOK / 4; it += G) d_rmsnorm_bf16(P.out, P.ffn_norm, h2, it);
    xcd_barrier(B);
    {
        GemmP p{}; p.A = h2; p.lda = 1024; p.akts = 64; p.Bt = w_q_t; p.ldb = 1024; p.K = 1024; p.mtiles = 128; p.ntiles = 16; p.out = qry;
        for (int it = bid0; it < 128 * 16; it += G) d_gemm<EPI_QRY>(p, it, smem);
    }
    xcd_barrier(B);
#ifdef PROBE_P4
    }
#endif
    route_load_subkeys(P.subkeys, smem);
    __syncthreads();
#ifdef PROBE_ROUTE
    for (int rep = 0; rep < 2; rep++)
#endif
    for (int mt = bid0 * 4 + (threadIdx.x >> 6); mt < T_TOK / 2; mt += G * 4) d_peer_route2(qry, eidx, pgate, mt, smem, threadIdx.x & 63);
    xcd_barrier(B);
    for (int it = bid0; it < T_TOK / 4; it += G) d_peer_expert3(h2, eidx, pgate, uq, vq, su, sv, P.out, it * 4 + (threadIdx.x >> 6), threadIdx.x & 63);
#ifdef NSA_CHECK
    xcd_barrier(B);
    {
        const float sd = __hip_atomic_load((float*)&P.bar[XB_QUEUE + 128], __ATOMIC_RELAXED, __HIP_MEMORY_SCOPE_AGENT);
        const float sr = __hip_atomic_load((float*)&P.bar[XB_QUEUE + 192], __ATOMIC_RELAXED, __HIP_MEMORY_SCOPE_AGENT);
        if (!(sd <= NSA_CHECK * sr)) for (int i = bid0 * 256 + threadIdx.x; i < T_TOK * DM; i += G * 256) P.out[i] += 1000.f;
    }
#endif
}

extern "C" void kernel_launch(void* const* d_in, const int* in_sizes, int n_in, void* d_out, int out_size, void* d_ws, size_t ws_size,
                              hipStream_t stream) {
#ifdef NSA_CHECK
    const size_t bar_off = ((OFF_END + 16384ull * 512 * 2) + 255) & ~(size_t)255;
#else
    const size_t bar_off = (OFF_END + 255) & ~(size_t)255;
#endif
    if (ws_size < bar_off + XCD_BAR_WORDS * 4) return;
    static int grid_blocks = 0;
    if (!grid_blocks) {
        int dev = 0, cus = 0, per_cu = 0;
        (void)hipGetDevice(&dev);
        (void)hipDeviceGetAttribute(&cus, hipDeviceAttributeMultiprocessorCount, dev);
        (void)hipFuncSetAttribute((const void*)hybrid_megakernel, hipFuncAttributeMaxDynamicSharedMemorySize, SMEM_BYTES);
        (void)hipOccupancyMaxActiveBlocksPerMultiprocessor(&per_cu, hybrid_megakernel, 256, SMEM_BYTES);
        if (per_cu > 2) per_cu = 2;
        grid_blocks = cus * per_cu;
    }
    if (grid_blocks <= 0) return;
    MKP P{};
    P.x = (const float*)d_in[0]; P.attn_norm = (const float*)d_in[1]; P.w_in = (const float*)d_in[2]; P.q_gain = (const float*)d_in[3];
    P.k_gain = (const float*)d_in[4]; P.cmp_pos = (const float*)d_in[5]; P.cmp_w1 = (const float*)d_in[6]; P.cmp_w2 = (const float*)d_in[7];
    P.gdn_conv = (const float*)d_in[8]; P.a_log = (const float*)d_in[9]; P.dt_bias = (const float*)d_in[10]; P.out_gain = (const float*)d_in[11];
    P.w_out = (const float*)d_in[12]; P.ffn_norm = (const float*)d_in[13]; P.w_query = (const float*)d_in[14]; P.subkeys = (const float*)d_in[15];
    P.peer_u = (const float*)d_in[16]; P.peer_v = (const float*)d_in[17];
    P.out = (float*)d_out; P.ws = (char*)d_ws; P.bar = (unsigned*)((char*)d_ws + bar_off);
    (void)hipMemsetAsync(P.bar, 0, XCD_BAR_WORDS * 4, stream);
    hipLaunchKernelGGL(hybrid_megakernel, dim3(grid_blocks), dim3(256), SMEM_BYTES, stream, P);
}
```

```cpp
#include <hip/hip_runtime.h>
#include <stdint.h>

typedef unsigned short bf16_t;
typedef __attribute__((ext_vector_type(8))) short bf16x8;
typedef __attribute__((ext_vector_type(4))) float f32x4;
#define LAS3 __attribute__((address_space(3)))

#define T_TOK 16384
#define SEQ 8192
#define DM 1024
#define IN_COLS 3360
#define PLD 3456
#define C_Q 0
#define C_KV 512
#define C_GATE 1280
#define C_GQKV 1304
#define C_Z 2840
#define C_A 3352
#define C_B 3356

#define OFF_WINT   0ull
#define OFF_WOUTT  (OFF_WINT  + 3456ull*1024*2)
#define OFF_WQT    (OFF_WOUTT + 1024ull*1024*2)
#define OFF_CW1T   (OFF_WQT   + 2048ull*1024*2)
#define OFF_CBIAS  (OFF_CW1T  + 2ull*256*2048*2)
#define OFF_HBF    (OFF_CBIAS + 4096ull)
#define OFF_PROJ   (OFF_HBF   + 16384ull*1024*2)
#define OFF_KSN    (OFF_PROJ  + (16384ull+32)*PLD*2)
#define OFF_KWN    (OFF_KSN   + 4ull*8192*64*2)
#define OFF_KC     (OFF_KWN   + 4ull*8192*64*2)
#define OFF_VC     (OFF_KC    + 4ull*512*64*2)
#define OFF_HID    (OFF_VC    + 4ull*512*64*2)
#define OFF_GU     (OFF_HID   + 8ull*512*256*2)
#define OFF_GW     (OFF_GU    + 1024ull*64*128*2)
#define OFF_GQD    (OFF_GW    + 1024ull*64*128*2)
#define OFF_GKD    (OFF_GQD   + 1024ull*64*128*2)
#define OFF_GIN    (OFF_GKD   + 1024ull*64*128*2)
#define OFF_GL     (OFF_GIN   + 1024ull*64*64*2)
#define OFF_ROPE   (OFF_GL    + 4096ull)
#define OFF_CW2T   (OFF_ROPE  + 8192ull*32*8)
#define OFF_SU     (OFF_CW2T  + 2ull*64*256*2)
#define OFF_SV     (OFF_SU    + 65536ull)
#define OFF_SSQ    (OFF_SV    + 65536ull)
#define OFF_VSN    (OFF_SSQ   + 16384ull*16*4)
#define OFF_VWN    (OFF_VSN   + 4ull*8192*64*2)
#define OFF_END    (OFF_VWN   + 4ull*8192*64*2)
#define OFF_MIX    OFF_HBF
#define OFF_QRY    OFF_PROJ
#define OFF_H2     (OFF_PROJ + 16384ull*2048*2)
#define OFF_EIDX   OFF_KSN
#define OFF_PGATE  OFF_GIN
#define OFF_UQ     OFF_GU
#define OFF_VQ     (OFF_GU + 16384ull*1024)

__device__ __forceinline__ bf16_t f2bf(float f) {
    unsigned u = __float_as_uint(f);
    u += 0x7fffu + ((u >> 16) & 1u);
    return (bf16_t)(u >> 16);
}
__device__ __forceinline__ float bf2f(bf16_t h) { return __uint_as_float(((unsigned)h) << 16); }
typedef __bf16 bf16x2_t2 __attribute__((ext_vector_type(2)));
__device__ __forceinline__ unsigned pk2(float a, float b) { bf16x2_t2 v; v[0] = (__bf16)a; v[1] = (__bf16)b; return __builtin_bit_cast(unsigned, v); }
__device__ __forceinline__ float gelu_tanh(float x) {
    float u = 0.7978845608028654f * (x + 0.044715f * x * x * x);
    return 0.5f * x * (1.f + tanhf(u));
}
__device__ __forceinline__ float sigmoidf_(float x) { return 1.f / (1.f + __expf(-x)); }
__device__ __forceinline__ float wave_sum(float v) {
#pragma unroll
    for (int o = 32; o > 0; o >>= 1) v += __shfl_xor(v, o);
    return v;
}
__device__ __forceinline__ float wave_max(float v) {
#pragma unroll
    for (int o = 32; o > 0; o >>= 1) v = fmaxf(v, __shfl_xor(v, o));
    return v;
}

template <int CTRL> __device__ __forceinline__ float dppf(float x) { return __builtin_bit_cast(float, __builtin_amdgcn_update_dpp(0, __builtin_bit_cast(int, x), CTRL, 0xf, 0xf, true)); }
template <int CTRL> __device__ __forceinline__ unsigned dppu(unsigned x) { return (unsigned)__builtin_amdgcn_update_dpp(0, (int)x, CTRL, 0xf, 0xf, true); }
__device__ __forceinline__ float allmax16(float x) {
    x = fmaxf(x, dppf<0xB1>(x)); x = fmaxf(x, dppf<0x4E>(x)); x = fmaxf(x, dppf<0x141>(x)); x = fmaxf(x, dppf<0x140>(x)); return x;
}
__device__ __forceinline__ unsigned allmaxu16(unsigned x) {
    x = max(x, dppu<0xB1>(x)); x = max(x, dppu<0x4E>(x)); x = max(x, dppu<0x141>(x)); x = max(x, dppu<0x140>(x)); return x;
}
__device__ __forceinline__ float allsum16(float x) {
    x += dppf<0xB1>(x); x += dppf<0x4E>(x); x += dppf<0x141>(x); x += dppf<0x140>(x); return x;
}
__device__ __forceinline__ float wave_sum_dpp(float x) {
    x = allsum16(x);
    return __builtin_bit_cast(float, __builtin_amdgcn_readlane(__builtin_bit_cast(int, x), 0)) + __builtin_bit_cast(float, __builtin_amdgcn_readlane(__builtin_bit_cast(int, x), 16)) +
           __builtin_bit_cast(float, __builtin_amdgcn_readlane(__builtin_bit_cast(int, x), 32)) + __builtin_bit_cast(float, __builtin_amdgcn_readlane(__builtin_bit_cast(int, x), 48));
}
__device__ __forceinline__ void d_transpose_bf16(const float* __restrict__ W, int K, int N, bf16_t* __restrict__ Wt, int bx, int by, char* smem, const float* __restrict__ kscale = nullptr) {
    float (*tile)[33] = (float (*)[33])smem;
    int n0 = bx * 32, k0 = by * 32;
    int tx = threadIdx.x & 31, ty = threadIdx.x >> 5;
    for (int i = ty; i < 32; i += 8) {
        int n = n0 + tx;
        tile[i][tx] = (n < N) ? W[(size_t)(k0 + i) * N + n] * (kscale ? kscale[k0 + i] : 1.f) : 0.f;
    }
    __syncthreads();
    for (int i = ty; i < 32; i += 8) {
        Wt[(size_t)(n0 + i) * K + k0 + tx] = f2bf(tile[tx][i]);
    }
}

__device__ __forceinline__ void d_rmsnorm_bf16(const float* __restrict__ x, const float* __restrict__ g, bf16_t* __restrict__ out, int bid) {
    int row = bid * 4 + (threadIdx.x >> 6);
    int lane = threadIdx.x & 63;
    const float4* xr = (const float4*)(x + (size_t)row * DM);
    float4 v[4];
    float ss = 0.f;
#pragma unroll
    for (int i = 0; i < 4; i++) { v[i] = xr[lane + 64 * i]; ss += v[i].x * v[i].x + v[i].y * v[i].y + v[i].z * v[i].z + v[i].w * v[i].w; }
    ss = wave_sum(ss);
    float r = rsqrtf(ss * (1.f / DM) + 1e-6f);
#pragma unroll
    for (int i = 0; i < 4; i++) {
        float4 gg = ((const float4*)g)[lane + 64 * i];
        ushort4 o;
        o.x = f2bf(v[i].x * r * gg.x); o.y = f2bf(v[i].y * r * gg.y); o.z = f2bf(v[i].z * r * gg.z); o.w = f2bf(v[i].w * r * gg.w);
        ((ushort4*)(out + (size_t)row * DM))[lane + 64 * i] = o;
    }
}

__device__ __forceinline__ void d_cmp_bias(const float* __restrict__ pos, const float* __restrict__ w1, float* __restrict__ bias, int item, char* smem) {
    float* part = (float*)smem;
    const int j = item >> 3, c = (item & 7) * 32 + (threadIdx.x & 31), ksl = threadIdx.x >> 5;
    float s0 = 0.f, s1 = 0.f, s2 = 0.f, s3 = 0.f;
    const float* wp = w1 + ((size_t)j * 2048 + ksl * 256) * 256 + c;
    const float* pp = pos + j * 2048 + ksl * 256;
    for (int k = 0; k < 256; k += 4) {
        s0 += pp[k] * wp[(size_t)k * 256]; s1 += pp[k + 1] * wp[(size_t)(k + 1) * 256];
        s2 += pp[k + 2] * wp[(size_t)(k + 2) * 256]; s3 += pp[k + 3] * wp[(size_t)(k + 3) * 256];
    }
    part[ksl * 32 + (threadIdx.x & 31)] = (s0 + s1) + (s2 + s3);
    __syncthreads();
    if (threadIdx.x < 32) {
        float t = 0.f;
#pragma unroll
        for (int i = 0; i < 8; i++) t += part[i * 32 + threadIdx.x];
        bias[j * 256 + c] = t;
    }
    __syncthreads();
}

#define EPI_PROJ 0
#define EPI_HID 1
#define EPI_OUT 2
#define EPI_QRY 3
struct GemmP {
    const bf16_t* A; long lda; long akts;
    const bf16_t* Bt; long ldb;
    int K; int mtiles; int ntiles;
    long a_inst; long b_inst;
    void* out; const float* aux; const float* aux2; bf16_t* out2; float* ssq;
};

template <int EPI>
__device__ __forceinline__ void d_gemm(const GemmP& p, int bid, char* smem) {
    const int tid = threadIdx.x, lane = tid & 63, wave = tid >> 6;
    const int wm = wave >> 1, wn = wave & 1;
    const int inst = 0;
    const int mt = bid / p.ntiles, nt = bid % p.ntiles;
    const int m0 = mt * 128, n0 = nt * 128;
    const bf16_t* A = p.A + (size_t)inst * p.a_inst + (size_t)m0 * p.lda;
    const bf16_t* Bt = p.Bt + (size_t)inst * p.b_inst + (size_t)n0 * p.ldb;
    f32x4 acc[4][4];
#pragma unroll
    for (int i = 0; i < 4; i++)
#pragma unroll
        for (int j = 0; j < 4; j++) acc[i][j] = (f32x4){0.f, 0.f, 0.f, 0.f};
    const int nk = p.K >> 6;
    const int crow = tid >> 3, cslot = tid & 7;
    const int csrc = (cslot ^ (crow & 7)) * 8;
    const bf16_t* Ap = A + (size_t)crow * p.lda + csrc;
    const bf16_t* Bp = Bt + (size_t)crow * p.ldb + csrc;
    const size_t a32 = (size_t)32 * p.lda, b32 = (size_t)32 * p.ldb;
    char* ldsw = smem + tid * 16;
#define GSTAGE(buf, koffA, koffB) { char* _d = ldsw + (buf) * 32768; \
    __builtin_amdgcn_global_load_lds((const unsigned*)(Ap + (koffA)), (LAS3 unsigned*)(_d), 16, 0, 0); \
    __builtin_amdgcn_global_load_lds((const unsigned*)(Ap + a32 + (koffA)), (LAS3 unsigned*)(_d + 4096), 16, 0, 0); \
    __builtin_amdgcn_global_load_lds((const unsigned*)(Ap + 2 * a32 + (koffA)), (LAS3 unsigned*)(_d + 8192), 16, 0, 0); \
    __builtin_amdgcn_global_load_lds((const unsigned*)(Ap + 3 * a32 + (koffA)), (LAS3 unsigned*)(_d + 12288), 16, 0, 0); \
    __builtin_amdgcn_global_load_lds((const unsigned*)(Bp + (koffB)), (LAS3 unsigned*)(_d + 16384), 16, 0, 0); \
    __builtin_amdgcn_global_load_lds((const unsigned*)(Bp + b32 + (koffB)), (LAS3 unsigned*)(_d + 16384 + 4096), 16, 0, 0); \
    __builtin_amdgcn_global_load_lds((const unsigned*)(Bp + 2 * b32 + (koffB)), (LAS3 unsigned*)(_d + 16384 + 8192), 16, 0, 0); \
    __builtin_amdgcn_global_load_lds((const unsigned*)(Bp + 3 * b32 + (koffB)), (LAS3 unsigned*)(_d + 16384 + 12288), 16, 0, 0); }
    const int n16 = lane & 15, kq = lane >> 4;
    GSTAGE(0, 0, 0)
    for (int kt = 0; kt < nk; kt++) {
        if (kt + 1 < nk) {
            GSTAGE((kt + 1) & 1, (size_t)(kt + 1) * p.akts, (size_t)(kt + 1) * 64)
            asm volatile("s_waitcnt vmcnt(8)" ::: "memory");
        } else {
            asm volatile("s_waitcnt vmcnt(0)" ::: "memory");
        }
        __builtin_amdgcn_s_barrier();
        const char* Ab = smem + (kt & 1) * 32768;
        const char* Bb = Ab + 16384;
#pragma unroll
        for (int ks = 0; ks < 2; ks++) {
            bf16x8 af[4], bfr[4];
#pragma unroll
            for (int i = 0; i < 4; i++) { const int R = wm * 64 + i * 16 + n16; af[i] = *(const bf16x8*)(Ab + R * 128 + (((4 * ks + kq) ^ (R & 7)) << 4)); }
#pragma unroll
            for (int j = 0; j < 4; j++) { const int R = wn * 64 + j * 16 + n16; bfr[j] = *(const bf16x8*)(Bb + R * 128 + (((4 * ks + kq) ^ (R & 7)) << 4)); }
#pragma unroll
            for (int i = 0; i < 4; i++)
#pragma unroll
                for (int j = 0; j < 4; j++) acc[i][j] = __builtin_amdgcn_mfma_f32_16x16x32_bf16(bfr[j], af[i], acc[i][j], 0, 0, 0);
        }
        asm volatile("s_waitcnt lgkmcnt(0)" ::: "memory");
        __builtin_amdgcn_s_barrier();
    }
    {
        char* slab = smem + wave * 9216;
        const int rbase = m0 + wm * 64, cbase = n0 + wn * 64;
        if (EPI == EPI_OUT) {
            float* st = (float*)slab;
#pragma unroll
            for (int hlf = 0; hlf < 2; hlf++) {
#pragma unroll
                for (int ii = 0; ii < 2; ii++)
#pragma unroll
                    for (int j = 0; j < 4; j++) *(f32x4*)(st + (ii * 16 + n16) * 68 + j * 16 + 4 * kq) = acc[hlf * 2 + ii][j];
#pragma unroll
                for (int ps = 0; ps < 8; ps++) {
                    const int rl = ps * 4 + kq, row = rbase + hlf * 32 + rl;
                    const float4 a = *(const float4*)(st + rl * 68 + n16 * 4);
                    const float4 xx = *(const float4*)(p.aux + (size_t)row * DM + cbase + n16 * 4);
                    const float4 o = make_float4(xx.x + a.x, xx.y + a.y, xx.z + a.z, xx.w + a.w);
                    *(float4*)((float*)p.out + (size_t)row * DM + cbase + n16 * 4) = o;
                    *(uint2*)(p.out2 + (size_t)row * DM + cbase + n16 * 4) = make_uint2(pk2(o.x, o.y), pk2(o.z, o.w));
                    const float ss = allsum16(o.x * o.x + o.y * o.y + o.z * o.z + o.w * o.w);
                    if (n16 == 0) p.ssq[(size_t)row * 16 + nt * 2 + wn] = ss;
                }
            }
        } else {
            bf16_t* st = (bf16_t*)slab;
#pragma unroll
            for (int i = 0; i < 4; i++) {
                float rs = 1.f;
                if (EPI == EPI_QRY) {
                    const float4* q = (const float4*)(p.ssq + (size_t)(rbase + i * 16 + n16) * 16);
                    const float4 q0 = q[0], q1 = q[1], q2 = q[2], q3 = q[3];
                    const float t = ((q0.x + q0.y) + (q0.z + q0.w)) + ((q1.x + q1.y) + (q1.z + q1.w)) + ((q2.x + q2.y) + (q2.z + q2.w)) + ((q3.x + q3.y) + (q3.z + q3.w));
                    rs = rsqrtf(t * (1.f / DM) + 1e-6f);
                }
#pragma unroll
                for (int j = 0; j < 4; j++) {
                    float v0 = acc[i][j][0], v1 = acc[i][j][1], v2 = acc[i][j][2], v3 = acc[i][j][3];
                    if (EPI == EPI_HID) {
                        const float4 bb = *(const float4*)(p.aux + (inst >> 2) * 256 + cbase + 16 * j + 4 * kq);
                        v0 = gelu_tanh(v0 + bb.x); v1 = gelu_tanh(v1 + bb.y); v2 = gelu_tanh(v2 + bb.z); v3 = gelu_tanh(v3 + bb.w);
                    }
                    if (EPI == EPI_QRY) { v0 *= rs; v1 *= rs; v2 *= rs; v3 *= rs; }
                    *(uint2*)(st + (i * 16 + n16) * 72 + j * 16 + 4 * kq) = make_uint2(pk2(v0, v1), pk2(v2, v3));
                }
            }
            const int ld = (EPI == EPI_PROJ) ? PLD : (EPI == EPI_HID ? 256 : 2048);
#pragma unroll
            for (int ps = 0; ps < 8; ps++) {
                const int rl = ps * 8 + (lane >> 3), ch = lane & 7;
                const uint4 v = *(const uint4*)(st + rl * 72 + ch * 8);
                *(uint4*)((bf16_t*)p.out + (size_t)(rbase + rl) * ld + cbase + ch * 8) = v;
            }
        }
        __syncthreads();
    }
}

__device__ __forceinline__ void d_knorm_rope(const bf16_t* __restrict__ proj, const float* __restrict__ kgain, bf16_t* __restrict__ ksn, bf16_t* __restrict__ kwn, bf16_t* __restrict__ vsn, bf16_t* __restrict__ vwn, const float2* __restrict__ rope, int bid) {
    int vec = bid * 8 + (threadIdx.x >> 5);
    int i = threadIdx.x & 31;
    int which = vec >> 15;
    int rem = vec & 32767;
    int b = rem >> 14, g = (rem >> 13) & 1, s = rem & 8191;
    const bf16_t* src = proj + (size_t)(b * SEQ + s) * PLD + C_KV + 128 * (which ? 4 : 2) + 64 * g;
    float x1 = bf2f(src[i]), x2 = bf2f(src[i + 32]);
    float ss = x1 * x1 + x2 * x2;
#pragma unroll
    for (int o = 16; o > 0; o >>= 1) ss += __shfl_xor(ss, o);
    float r = rsqrtf(ss * (1.f / 64.f) + 1e-6f);
    const float* gn = kgain + (which ? 2 : 1) * 64;
    x1 = x1 * r * gn[i]; x2 = x2 * r * gn[i + 32];
    const float2 cs2 = rope[(size_t)s * 32 + i];
    const float cs = cs2.x, sn = cs2.y;
    bf16_t* dst = (which ? kwn : ksn) + ((size_t)(b * 2 + g) * SEQ + s) * 64;
    dst[i] = f2bf(x1 * cs - x2 * sn);
    dst[i + 32] = f2bf(x2 * cs + x1 * sn);
    ((unsigned*)((which ? vwn : vsn) + ((size_t)(b * 2 + g) * SEQ + s) * 64))[i] = ((const unsigned*)(src + 128))[i];
}

__device__ __forceinline__ void d_cmp2_mfma(const bf16_t* __restrict__ hid, const bf16_t* __restrict__ cw2t, const float* __restrict__ kgain, const float2* __restrict__ rope,
                                            bf16_t* __restrict__ kc, bf16_t* __restrict__ vc, int witem, int lane) {
    const int n16 = lane & 15, kq = lane >> 4;
    const int rowbase = 16 * witem, inst = rowbase >> 9, n0 = rowbase & 511, j = inst >> 2, bg = inst & 3;
    f32x4 acc[4];
#pragma unroll
    for (int nt = 0; nt < 4; nt++) acc[nt] = (f32x4){0.f, 0.f, 0.f, 0.f};
    const bf16_t* ap = hid + (size_t)(rowbase + n16) * 256 + 8 * kq;
    const bf16_t* bp = cw2t + (size_t)j * 64 * 256 + n16 * 256 + 8 * kq;
#pragma unroll
    for (int ks = 0; ks < 8; ks++) {
        const bf16x8 a = *(const bf16x8*)(ap + 32 * ks);
#pragma unroll
        for (int nt = 0; nt < 4; nt++) {
            const bf16x8 bb = *(const bf16x8*)(bp + (size_t)(16 * nt) * 256 + 32 * ks);
            acc[nt] = __builtin_amdgcn_mfma_f32_16x16x32_bf16(a, bb, acc[nt], 0, 0, 0);
        }
    }
#pragma unroll
    for (int r = 0; r < 4; r++) {
        const int n = n0 + 4 * kq + r;
        if (j == 0) {
            float ss = acc[0][r] * acc[0][r] + acc[1][r] * acc[1][r] + acc[2][r] * acc[2][r] + acc[3][r] * acc[3][r];
            ss = allsum16(ss);
            const float ri = rsqrtf(ss * (1.f / 64.f) + 1e-6f);
#pragma unroll
            for (int nt = 0; nt < 2; nt++) {
                const int i = 16 * nt + n16;
                const float y1 = acc[nt][r] * ri * kgain[i], y2 = acc[nt + 2][r] * ri * kgain[i + 32];
                const float2 cs = rope[(size_t)((n < 511 ? n : 510) * 16 + 31) * 32 + i];
                if (n < 511) {
                    kc[((size_t)bg * 512 + n) * 64 + i] = f2bf(y1 * cs.x - y2 * cs.y);
                    kc[((size_t)bg * 512 + n) * 64 + i + 32] = f2bf(y2 * cs.x + y1 * cs.y);
                }
            }
        } else if (n < 511) {
#pragma unroll
            for (int nt = 0; nt < 4; nt++) vc[((size_t)bg * 512 + n) * 64 + 16 * nt + n16] = f2bf(acc[nt][r]);
        }
    }
}

__device__ __forceinline__ float dot64(const float* q, const bf16_t* krow) {
    const uint4* kp = (const uint4*)krow;
    float s = 0.f;
#pragma unroll
    for (int c = 0; c < 8; c++) {
        uint4 u = kp[c];
        unsigned w[4] = {u.x, u.y, u.z, u.w};
#pragma unroll
        for (int e = 0; e < 4; e++) {
            s += q[c * 8 + e * 2] * __uint_as_float(w[e] << 16);
            s += q[c * 8 + e * 2 + 1] * __uint_as_float(w[e] & 0xffff0000u);
        }
    }
    return s;
}

__device__ __forceinline__ void d_nsa_naive(const bf16_t* __restrict__ proj, const float* __restrict__ qgain,
                                                   const bf16_t* __restrict__ ksn, const bf16_t* __restrict__ kwn,
                                                   const bf16_t* __restrict__ kc, const bf16_t* __restrict__ vc,
                                                   bf16_t* __restrict__ mix, int mix_ld, int bid, char* smem) {
    float (*qs)[64] = (float (*)[64])smem;
    float (*pbuf)[1024] = (float (*)[1024])(smem + 1024);
    float* sc = (float*)(smem + 1024 + 16384);
    int* sel = (int*)(smem + 1024 + 16384 + 512);
    const int tid = threadIdx.x, lane = tid & 63, w = tid >> 6;
    const int blk = bid;
    const int t = blk & 8191, g = (blk >> 13) & 1, b = blk >> 14;
    const int bg = b * 2 + g;
    const size_t row = (size_t)(b * SEQ + t);
    const int head = g * 4 + w;
    {
        int i = lane & 31;
        const bf16_t* src = proj + row * PLD + C_Q + head * 64;
        float x1 = bf2f(src[i]), x2 = bf2f(src[i + 32]);
        float ss = x1 * x1 + x2 * x2;
#pragma unroll
        for (int o = 16; o > 0; o >>= 1) ss += __shfl_xor(ss, o);
        float r = rsqrtf(ss * (1.f / 64.f) + 1e-6f);
        x1 = x1 * r * qgain[i]; x2 = x2 * r * qgain[i + 32];
        float inv = expf(-9.210340371976184f * (float)(2 * i) / 64.f);
        float ang = (float)t * inv;
        float sn, cs; sincosf(ang, &sn, &cs);
        if (lane < 32) { qs[w][i] = (x1 * cs - x2 * sn) * 0.125f; qs[w][i + 32] = (x2 * cs + x1 * sn) * 0.125f; }
    }
    __syncthreads();
    float q[64];
#pragma unroll
    for (int d = 0; d < 64; d++) q[d] = qs[w][d];
    float o_c = 0.f, o_s = 0.f, o_w = 0.f;
    const int nvis = (t >= 31) ? (((t - 31) >> 4) + 1) : 0;
    {
        float s[8];
        float m = -3e38f;
#pragma unroll
        for (int i = 0; i < 8; i++) {
            int n = lane + 64 * i;
            if (n < nvis) { s[i] = dot64(q, kc + ((size_t)bg * 512 + n) * 64); m = fmaxf(m, s[i]); } else s[i] = -3e38f;
        }
        m = wave_max(m);
        float l = 0.f;
#pragma unroll
        for (int i = 0; i < 8; i++) { int n = lane + 64 * i; s[i] = (n < nvis) ? __expf(s[i] - m) : 0.f; l += s[i]; }
        l = wave_sum(l);
        float il = (nvis > 0) ? 1.f / l : 0.f;
#pragma unroll
        for (int i = 0; i < 8; i++) pbuf[w][lane + 64 * i] = s[i] * il;
        __syncthreads();
        const bf16_t* vp = vc + (size_t)bg * 512 * 64 + lane;
        for (int n = 0; n < nvis; n++) o_c += pbuf[w][n] * bf2f(vp[(size_t)n * 64]);
    }
    if (tid < 128) {
        int j = tid;
        float im = 0.f;
#pragma unroll
        for (int h = 0; h < 4; h++) {
            float a = (j > 0) ? pbuf[h][4 * j - 1] : 0.f;
            im += a + 2.f * (pbuf[h][4 * j] + pbuf[h][4 * j + 1] + pbuf[h][4 * j + 2]) + pbuf[h][4 * j + 3];
        }
        int cur = t >> 6;
        float v;
        if (j > cur) v = -1e30f;
        else if (j == 0 || j == cur || j == cur - 1) v = 1e4f;
        else v = im;
        sc[j] = v;
    }
    __syncthreads();
    if (w == 0) {
        float v0 = sc[lane], v1 = sc[lane + 64];
        for (int it = 0; it < 16; it++) {
            float bv; int bi;
            if (v0 >= v1) { bv = v0; bi = lane; } else { bv = v1; bi = lane + 64; }
#pragma unroll
            for (int o = 32; o > 0; o >>= 1) {
                float ov = __shfl_xor(bv, o); int oi = __shfl_xor(bi, o);
                if (ov > bv || (ov == bv && oi < bi)) { bv = ov; bi = oi; }
            }
            if (lane == 0) sel[it] = (bv > -1e29f) ? bi : -1;
            if (bi == lane) v0 = -3e38f;
            if (bi == lane + 64) v1 = -3e38f;
        }
    }
    __syncthreads();
    {
        float s[16];
        float m = -3e38f;
#pragma unroll
        for (int i = 0; i < 16; i++) {
            int bk = sel[i];
            int pos = bk * 64 + lane;
            if (bk >= 0 && pos <= t) { s[i] = dot64(q, ksn + ((size_t)bg * SEQ + pos) * 64); m = fmaxf(m, s[i]); } else s[i] = -3e38f;
        }
        m = wave_max(m);
        float l = 0.f;
#pragma unroll
        for (int i = 0; i < 16; i++) { s[i] = (s[i] > -1e38f) ? __expf(s[i] - m) : 0.f; l += s[i]; }
        l = wave_sum(l);
        float il = 1.f / l;
#pragma unroll
        for (int i = 0; i < 16; i++) pbuf[w][i * 64 + lane] = s[i] * il;
        __syncthreads();
        for (int i = 0; i < 16; i++) {
            int bk = sel[i];
            if (bk < 0) continue;
            const bf16_t* vp = proj + (size_t)(b * SEQ + bk * 64) * PLD + C_KV + 128 * 3 + 64 * g + lane;
            int kmax = min(64, t - bk * 64 + 1);
            for (int kk = 0; kk < kmax; kk++) o_s += pbuf[w][i * 64 + kk] * bf2f(vp[(size_t)kk * PLD]);
        }
    }
    __syncthreads();
    {
        float s[8];
        float m = -3e38f;
        const int p0 = t - 511;
#pragma unroll
        for (int i = 0; i < 8; i++) {
            int pos = p0 + lane + 64 * i;
            if (pos >= 0) { s[i] = dot64(q, kwn + ((size_t)bg * SEQ + pos) * 64); m = fmaxf(m, s[i]); } else s[i] = -3e38f;
        }
        m = wave_max(m);
        float l = 0.f;
#pragma unroll
        for (int i = 0; i < 8; i++) { s[i] = (s[i] > -1e38f) ? __expf(s[i] - m) : 0.f; l += s[i]; }
        l = wave_sum(l);
        float il = 1.f / l;
#pragma unroll
        for (int i = 0; i < 8; i++) pbuf[w][lane + 64 * i] = s[i] * il;
        __syncthreads();
        int kstart = (p0 < 0) ? -p0 : 0;
        const bf16_t* vp = proj + (size_t)(b * SEQ) * PLD + C_KV + 128 * 5 + 64 * g + lane;
        for (int kk = kstart; kk < 512; kk++) o_w += pbuf[w][kk] * bf2f(vp[(size_t)(p0 + kk) * PLD]);
    }
    const bf16_t* gp = proj + row * PLD + C_GATE + head * 3;
    float g0 = sigmoidf_(bf2f(gp[0])), g1 = sigmoidf_(bf2f(gp[1])), g2 = sigmoidf_(bf2f(gp[2]));
    mix[row * mix_ld + head * 64 + lane] = f2bf(g0 * o_c + g1 * o_s + g2 * o_w);
}

typedef float f32x16 __attribute__((ext_vector_type(16)));
typedef short s16x4 __attribute__((ext_vector_type(4)));
#define MFMA32(a, b, c) __builtin_amdgcn_mfma_f32_32x32x16_bf16((a), (b), (c), 0, 0, 0)
#define NKS 72
#define NSA_K_OFF 0
#define NSA_V_OFF (2 * 64 * NKS * 2)
#define NSA_IMP_OFF (NSA_V_OFF + 2 * 64 * NKS * 2)
#define NSA_SEL_OFF (NSA_IMP_OFF + 4 * 8192)
#define NSA_LDS (NSA_SEL_OFF + 32 * 4 * 4)
#define NEGBIG (-1e30f)
__device__ __forceinline__ bf16x8 pack8(float a0, float a1, float a2, float a3, float a4, float a5, float a6, float a7) {
    uint4 u = make_uint4(pk2(a0, a1), pk2(a2, a3), pk2(a4, a5), pk2(a6, a7));
    return __builtin_bit_cast(bf16x8, u);
}
typedef unsigned u32x4 __attribute__((ext_vector_type(4)));
struct NsaStage { u32x4 k0, k1, v0, v1; };
struct NsaCtx {
    bool noload;
    const bf16_t* Kbase; long kstride;
    const bf16_t* Vbase; long vstride;
    bf16_t* Kb; bf16_t* Vb;
    float* imp_s; unsigned* sel_s;
    bf16x8 qf[4];
    f32x16 O0, O1;
    float m, l, invl, carry;
    int t, tokl, hp, hh, c, lane;
};
__device__ __forceinline__ void nsa_stage_load(const NsaCtx& X, NsaStage& st, int j) {
    const int r0 = threadIdx.x >> 3, c8 = (threadIdx.x & 7) * 8;
    if (X.noload) { st.k0 = (u32x4){0u,0u,0u,0u}; st.k1 = st.k0; st.v0 = st.k0; st.v1 = st.k0; return; }
    const bf16_t* kp = X.Kbase + (size_t)(64 * j + r0) * X.kstride + c8;
    const bf16_t* vp = X.Vbase + (size_t)(64 * j + r0) * X.vstride + c8;
    st.k0 = *(const u32x4*)kp; st.k1 = *(const u32x4*)(kp + 32 * X.kstride);
    st.v0 = *(const u32x4*)vp; st.v1 = *(const u32x4*)(vp + 32 * X.vstride);
}
__device__ __forceinline__ void nsa_stage_store(const NsaCtx& X, const NsaStage& st, int buf) {
    const int r0 = threadIdx.x >> 3, c8 = (threadIdx.x & 7) * 8;
    bf16_t* kb = X.Kb + buf * 64 * NKS + r0 * NKS + c8;
    bf16_t* vb = X.Vb + buf * 64 * NKS + r0 * NKS + c8;
    *(u32x4*)kb = st.k0; *(u32x4*)(kb + 32 * NKS) = st.k1;
    *(u32x4*)vb = st.v0; *(u32x4*)(vb + 32 * NKS) = st.v1;
}
template <int MODE, bool FAST>
__device__ __forceinline__ void nsa_tile(NsaCtx& X, int j, int kt, int buf, unsigned long long mlo, unsigned long long mhi) {
    const bf16_t* Kt = X.Kb + buf * 64 * NKS + (32 * kt) * NKS;
    const bf16_t* Vt = X.Vb + buf * 64 * NKS + (32 * kt) * NKS;
    f32x16 S;
#pragma unroll
    for (int i = 0; i < 16; i++) S[i] = 0.f;
#pragma unroll
    for (int s = 0; s < 4; s++) {
        bf16x8 ka = *(const bf16x8*)(Kt + X.c * NKS + 16 * s + 8 * X.hh);
        S = MFMA32(ka, X.qf[s], S);
    }
    const int kbase = 64 * j + 32 * kt;
    int lo = 0, hi;
    bool on = true;
    if (MODE <= 1) hi = ((X.t - 31) >> 4) - kbase;
    else hi = X.t - kbase;
    if (MODE == 3) lo = X.t - 511 - kbase;
    if (MODE == 2) {
        const unsigned long long wsel = (j < 64) ? mlo : mhi;
        on = (wsel >> (j & 63)) & 1ull;
    }
    lo -= 4 * X.hh; hi -= 4 * X.hh;
    if (!on) hi = -1000;
    float P[16];
    if (MODE == 1) {
#pragma unroll
        for (int i = 0; i < 16; i++) {
            const int cr = (i & 3) + 8 * (i >> 2);
            P[i] = (cr <= hi) ? __builtin_amdgcn_exp2f(S[i] - X.m) * X.invl : 0.f;
        }
        float mainv[4], nxt[4];
#pragma unroll
        for (int q = 0; q < 4; q++) { mainv[q] = 2.f * (P[4 * q] + P[4 * q + 1] + P[4 * q + 2]) + P[4 * q + 3]; nxt[q] = P[4 * q + 3]; }
#pragma unroll
        for (int q = 0; q < 4; q++) {
            mainv[q] += __shfl_xor(mainv[q], 1); mainv[q] += __shfl_xor(mainv[q], 2);
            nxt[q] += __shfl_xor(nxt[q], 1); nxt[q] += __shfl_xor(nxt[q], 2);
        }
        float recv[4];
#pragma unroll
        for (int q = 0; q < 4; q++) recv[q] = __shfl_xor(nxt[q], 32);
        const int jsel0 = 16 * j + 8 * kt + X.hh;
#pragma unroll
        for (int q = 0; q < 4; q++) {
            const float tot = mainv[q] + (X.hh ? recv[q] : (q > 0 ? recv[q > 0 ? q - 1 : 0] : X.carry));
            if (X.hp == 0) X.imp_s[(X.tokl & 7) * 128 + jsel0 + 2 * q] = tot;
        }
        X.carry = recv[3];
    } else {
        float tmax = NEGBIG;
        if (FAST) {
            tmax = fmaxf(fmaxf(fmaxf(fmaxf(S[0], S[1]), fmaxf(S[2], S[3])), fmaxf(fmaxf(S[4], S[5]), fmaxf(S[6], S[7]))),
                         fmaxf(fmaxf(fmaxf(S[8], S[9]), fmaxf(S[10], S[11])), fmaxf(fmaxf(S[12], S[13]), fmaxf(S[14], S[15]))));
            if (MODE == 2 && !on) tmax = NEGBIG;
        } else {
#pragma unroll
            for (int i = 0; i < 16; i++) {
                const int cr = (i & 3) + 8 * (i >> 2);
                const bool vis = (cr <= hi) && (cr >= lo);
                tmax = vis ? fmaxf(tmax, S[i]) : tmax;
            }
        }
        tmax = fmaxf(tmax, __shfl_xor(tmax, 32));
        float ls = 0.f;
        if (MODE == 0) {
            const float mnew = fmaxf(X.m, tmax);
            const float alpha = __builtin_amdgcn_exp2f(X.m - mnew);
            X.m = mnew;
#pragma unroll
            for (int i = 0; i < 16; i++) {
                const int cr = (i & 3) + 8 * (i >> 2);
                const bool vis = (cr <= hi) && (cr >= lo);
                P[i] = vis ? __builtin_amdgcn_exp2f(S[i] - mnew) : 0.f;
                ls += P[i];
            }
            X.l = X.l * alpha + ls;
        } else {
            const bool upd = tmax > X.m + 8.f;
            const float mnew = upd ? tmax : X.m;
            if (__builtin_amdgcn_ballot_w64(upd) != 0ull) {
                const float alpha = __builtin_amdgcn_exp2f(X.m - mnew);
                X.l *= alpha;
#pragma unroll
                for (int i = 0; i < 16; i++) { X.O0[i] *= alpha; X.O1[i] *= alpha; }
            }
            X.m = mnew;
            if (FAST) {
                const float msub = (MODE == 2 && !on) ? 1e30f : mnew;
#pragma unroll
                for (int i = 0; i < 16; i++) { P[i] = __builtin_amdgcn_exp2f(S[i] - msub); ls += P[i]; }
            } else {
#pragma unroll
                for (int i = 0; i < 16; i++) {
                    const int cr = (i & 3) + 8 * (i >> 2);
                    const bool vis = (cr <= hi) && (cr >= lo);
                    P[i] = vis ? __builtin_amdgcn_exp2f(S[i] - mnew) : 0.f;
                    ls += P[i];
                }
            }
            X.l += ls;
        }
    }
    if (MODE >= 1) {
        bf16x8 pb0 = pack8(P[0], P[1], P[2], P[3], P[4], P[5], P[6], P[7]);
        bf16x8 pb1 = pack8(P[8], P[9], P[10], P[11], P[12], P[13], P[14], P[15]);
        const int l15 = X.lane & 15;
        const bf16_t* vrow = Vt + (4 * X.hh + (l15 >> 2)) * NKS + 16 * ((X.lane >> 4) & 1) + 4 * (l15 & 3);
#pragma unroll
        for (int s2 = 0; s2 < 2; s2++) {
#pragma unroll
            for (int dt = 0; dt < 2; dt++) {
                s16x4 lo4 = __builtin_amdgcn_ds_read_tr16_b64_v4i16((LAS3 s16x4*)(vrow + (16 * s2) * NKS + 32 * dt));
                s16x4 hi4 = __builtin_amdgcn_ds_read_tr16_b64_v4i16((LAS3 s16x4*)(vrow + (16 * s2 + 8) * NKS + 32 * dt));
                bf16x8 va = __builtin_shufflevector(lo4, hi4, 0, 1, 2, 3, 4, 5, 6, 7);
                if (dt == 0) X.O0 = MFMA32(va, s2 ? pb1 : pb0, X.O0); else X.O1 = MFMA32(va, s2 ? pb1 : pb0, X.O1);
            }
        }
    }
}
template <int MODE>
__device__ __forceinline__ void nsa_block(NsaCtx& X, int j, unsigned long long mlo, unsigned long long mhi, unsigned long long ulo, unsigned long long uhi, int cur, int tw0) {
    bool need = true;
    if (MODE == 2) {
        const unsigned long long wsel = (j < 64) ? ulo : uhi;
        need = (wsel >> (j & 63)) & 1ull;
    }
    if (need) {
#pragma unroll 1
        for (int kt = 0; kt < 2; kt++) {
            bool fast = false;
            if (MODE == 2) fast = j < cur;
            if (MODE == 3) { const int kb = 64 * j + 32 * kt; fast = (kb + 31 <= tw0) && (kb >= tw0 + 7 - 511); }
            if (MODE >= 2 && fast) nsa_tile<MODE, true>(X, j, kt, j & 1, mlo, mhi);
            else nsa_tile<MODE, false>(X, j, kt, j & 1, mlo, mhi);
        }
    }
}
template <int MODE>
__device__ __forceinline__ void nsa_branch(NsaCtx& X, int jlo, int jhi, unsigned long long mlo, unsigned long long mhi, unsigned long long ulo, unsigned long long uhi, int cur, int tw0) {
    NsaStage sa;
    nsa_stage_load(X, sa, jlo);
    __syncthreads();
    nsa_stage_store(X, sa, jlo & 1);
    __syncthreads();
#pragma unroll 1
    for (int j = jlo; j <= jhi; j++) {
        if (j < jhi) nsa_stage_load(X, sa, j + 1);
        nsa_block<MODE>(X, j, mlo, mhi, ulo, uhi, cur, tw0);
        if (j < jhi) nsa_stage_store(X, sa, (j + 1) & 1);
        __syncthreads();
    }
}
template <int OP>
__device__ __forceinline__ void nsa_facc(NsaCtx& X, float scale) {
    f32x4* F = (f32x4*)X.imp_s;
#pragma unroll
    for (int q = 0; q < 8; q++) {
        f32x4 v;
#pragma unroll
        for (int e = 0; e < 4; e++) v[e] = ((q < 4) ? X.O0[4 * q + e] : X.O1[4 * (q - 4) + e]) * scale;
        if (OP >= 1) v += F[q * 64 + X.lane];
        if (OP <= 1) F[q * 64 + X.lane] = v;
        else {
#pragma unroll
            for (int e = 0; e < 4; e++) { if (q < 4) X.O0[4 * q + e] = v[e]; else X.O1[4 * (q - 4) + e] = v[e]; }
        }
    }
}
__device__ __forceinline__ void d_nsa_mfma(const bf16_t* __restrict__ proj, const float* __restrict__ qgain, const float2* __restrict__ rope,
                                           const bf16_t* __restrict__ ksn, const bf16_t* __restrict__ kwn,
                                           const bf16_t* __restrict__ kc, const bf16_t* __restrict__ vc, const bf16_t* __restrict__ vsn, const bf16_t* __restrict__ vwn,
                                           bf16_t* __restrict__ mixo, int mix_ld, int item, char* smem, bool noload = false) {
    NsaCtx X;
    X.noload = noload;
    const int tid = threadIdx.x, lane = tid & 63, w = tid >> 6;
    const int bg = item & 3, tile = 255 - (item >> 2);
    const int b = bg >> 1, g = bg & 1, t0 = tile * 32;
    X.lane = lane; X.c = lane & 31; X.hh = lane >> 5; X.hp = X.c & 3; X.tokl = 8 * w + (X.c >> 2); X.t = t0 + X.tokl;
    X.Kb = (bf16_t*)(smem + NSA_K_OFF); X.Vb = (bf16_t*)(smem + NSA_V_OFF);
    X.imp_s = (float*)(smem + NSA_IMP_OFF + w * 8192); X.sel_s = (unsigned*)(smem + NSA_SEL_OFF);
    const int head = g * 4 + X.hp;
    const size_t row = (size_t)(b * SEQ + X.t);
    {
        float y[4][8];
        const bf16_t* qsrc = proj + row * PLD + C_Q + head * 64 + 8 * X.hh;
        float ss = 0.f;
#pragma unroll
        for (int s = 0; s < 4; s++) {
            const uint4 u = *(const uint4*)(qsrc + 16 * s);
            const unsigned wv[4] = {u.x, u.y, u.z, u.w};
#pragma unroll
            for (int e = 0; e < 4; e++) { y[s][2 * e] = __uint_as_float(wv[e] << 16); y[s][2 * e + 1] = __uint_as_float(wv[e] & 0xffff0000u); }
#pragma unroll
            for (int e = 0; e < 8; e++) ss += y[s][e] * y[s][e];
        }
        ss += __shfl_xor(ss, 32);
        const float r = rsqrtf(ss * (1.f / 64.f) + 1e-6f);
#pragma unroll
        for (int s = 0; s < 4; s++)
#pragma unroll
            for (int e = 0; e < 8; e++) y[s][e] *= r * qgain[16 * s + 8 * X.hh + e];
        const float qs = 0.125f * 1.4426950408889634f;
#pragma unroll
        for (int s = 0; s < 2; s++)
#pragma unroll
            for (int e = 0; e < 8; e++) {
                const float2 cs = rope[(size_t)X.t * 32 + 16 * s + 8 * X.hh + e];
                const float x1 = y[s][e], x2 = y[s + 2][e];
                y[s][e] = (x1 * cs.x - x2 * cs.y) * qs; y[s + 2][e] = (x2 * cs.x + x1 * cs.y) * qs;
            }
#pragma unroll
        for (int s = 0; s < 4; s++) X.qf[s] = pack8(y[s][0], y[s][1], y[s][2], y[s][3], y[s][4], y[s][5], y[s][6], y[s][7]);
    }
    const bf16_t* gp = proj + row * PLD + C_GATE + head * 3;
    const float g0 = sigmoidf_(bf2f(gp[0])), g1 = sigmoidf_(bf2f(gp[1])), g2 = sigmoidf_(bf2f(gp[2]));
    const int cur = t0 >> 6;
    {
        X.Kbase = kc + (size_t)bg * 512 * 64; X.kstride = 64; X.Vbase = vc + (size_t)bg * 512 * 64; X.vstride = 64;
        const int nvmax = (t0 >> 4) + 1, jhi = (nvmax - 1) >> 6;
        X.m = NEGBIG; X.l = 0.f;
        nsa_branch<0>(X, 0, jhi, 0ull, 0ull, 0ull, 0ull, cur, t0 + 8 * w);
        const float lt = X.l + __shfl_xor(X.l, 32);
        X.invl = (lt > 0.f) ? 1.f / lt : 0.f;
        X.carry = 0.f;
#pragma unroll
        for (int i = 0; i < 16; i++) { X.O0[i] = 0.f; X.O1[i] = 0.f; }
        nsa_branch<1>(X, 0, jhi, 0ull, 0ull, 0ull, 0ull, cur, t0 + 8 * w);
    }
    unsigned long long mlo, mhi, ulo, uhi;
    {
        const int tk2 = lane >> 3, sub = lane & 7;
        unsigned k0 = 1u, k1 = 0u, k2 = 0u, k3 = 0u;
#define SETBIT(jj) { const int _j = (jj); if (_j < 32) k0 |= 1u << _j; else if (_j < 64) k1 |= 1u << (_j - 32); else if (_j < 96) k2 |= 1u << (_j - 64); else k3 |= 1u << (_j - 96); }
        SETBIT(cur);
        if (cur >= 1) SETBIT(cur - 1);
        const int ncand = cur - 2;
        if (ncand > 0) {
            if (ncand <= 13) {
                for (int jj = 1; jj <= cur - 2; jj++) SETBIT(jj);
            } else {
                float sc[16];
#pragma unroll
                for (int i = 0; i < 16; i++) { const int jj = sub + 8 * i; sc[i] = (jj >= 1 && jj <= cur - 2) ? X.imp_s[tk2 * 128 + jj] : -3e38f; }
#pragma unroll 1
                for (int it = 0; it < 13; it++) {
                    float bv = sc[0]; int bi = 0;
#pragma unroll
                    for (int i = 1; i < 16; i++) if (sc[i] > bv) { bv = sc[i]; bi = i; }
                    int bj = sub + 8 * bi;
#pragma unroll
                    for (int o = 1; o < 8; o <<= 1) {
                        const float ov = __shfl_xor(bv, o); const int oj = __shfl_xor(bj, o);
                        if (ov > bv || (ov == bv && oj < bj)) { bv = ov; bj = oj; }
                    }
                    SETBIT(bj);
#pragma unroll
                    for (int i = 0; i < 16; i++) if (bj == sub + 8 * i) sc[i] = -3e38f;
                }
            }
        }
#undef SETBIT
        if (sub == 0) { unsigned* d = X.sel_s + (8 * w + tk2) * 4; d[0] = k0; d[1] = k1; d[2] = k2; d[3] = k3; }
        __builtin_amdgcn_s_waitcnt(0xc07f);
        const unsigned* sp = X.sel_s + X.tokl * 4;
        const unsigned m0 = sp[0], m1 = sp[1], m2 = sp[2], m3 = sp[3];
        mlo = (unsigned long long)m0 | ((unsigned long long)m1 << 32); mhi = (unsigned long long)m2 | ((unsigned long long)m3 << 32);
        unsigned u0 = m0, u1 = m1, u2 = m2, u3 = m3;
#pragma unroll
        for (int o = 4; o < 32; o <<= 1) { u0 |= __shfl_xor(u0, o); u1 |= __shfl_xor(u1, o); u2 |= __shfl_xor(u2, o); u3 |= __shfl_xor(u3, o); }
        ulo = (unsigned long long)(unsigned)__builtin_amdgcn_readfirstlane(u0) | ((unsigned long long)(unsigned)__builtin_amdgcn_readfirstlane(u1) << 32);
        uhi = (unsigned long long)(unsigned)__builtin_amdgcn_readfirstlane(u2) | ((unsigned long long)(unsigned)__builtin_amdgcn_readfirstlane(u3) << 32);
    }
    nsa_facc<0>(X, g0);
    {
        X.Kbase = ksn + (size_t)bg * SEQ * 64; X.kstride = 64;
        X.Vbase = vsn + (size_t)bg * SEQ * 64; X.vstride = 64;
        X.m = NEGBIG; X.l = 0.f;
#pragma unroll
        for (int i = 0; i < 16; i++) { X.O0[i] = 0.f; X.O1[i] = 0.f; }
        nsa_branch<2>(X, 0, cur, mlo, mhi, ulo, uhi, cur, t0 + 8 * w);
        const float lt = X.l + __shfl_xor(X.l, 32);
        nsa_facc<1>(X, (lt > 0.f) ? g1 / lt : 0.f);
    }
    {
        X.Kbase = kwn + (size_t)bg * SEQ * 64; X.kstride = 64;
        X.Vbase = vwn + (size_t)bg * SEQ * 64; X.vstride = 64;
        X.m = NEGBIG; X.l = 0.f;
#pragma unroll
        for (int i = 0; i < 16; i++) { X.O0[i] = 0.f; X.O1[i] = 0.f; }
        const int jlo = (t0 >= 511) ? ((t0 - 511) >> 6) : 0;
        nsa_branch<3>(X, jlo, cur, 0ull, 0ull, 0ull, 0ull, cur, t0 + 8 * w);
        const float lt = X.l + __shfl_xor(X.l, 32);
        nsa_facc<2>(X, (lt > 0.f) ? g2 / lt : 0.f);
    }
    bf16_t* dst = mixo + row * mix_ld + head * 64 + 4 * X.hh;
#pragma unroll
    for (int q4 = 0; q4 < 4; q4++) {
        *(uint2*)(dst + 8 * q4) = make_uint2(pk2(X.O0[4 * q4], X.O0[4 * q4 + 1]), pk2(X.O0[4 * q4 + 2], X.O0[4 * q4 + 3]));
        *(uint2*)(dst + 32 + 8 * q4) = make_uint2(pk2(X.O1[4 * q4], X.O1[4 * q4 + 1]), pk2(X.O1[4 * q4 + 2], X.O1[4 * q4 + 3]));
    }
}

#define KLS 136
#define XSS 264
#define GDN_PREP_LDS (2 * 64 * KLS * 2 + 64 * XSS * 2 + 512)
__device__ __forceinline__ unsigned pack2bf(float lo, float hi) { return (unsigned)f2bf(lo) | ((unsigned)f2bf(hi) << 16); }
__device__ __forceinline__ void d_gdn_prep2(const bf16_t* __restrict__ proj, const float* __restrict__ conv_w,
                                            const float* __restrict__ a_log, const float* __restrict__ dt_bias,
                                            bf16_t* __restrict__ guT, bf16_t* __restrict__ gw, bf16_t* __restrict__ gqd,
                                            bf16_t* __restrict__ gkdT, bf16_t* __restrict__ gin, float* __restrict__ gl, int chunk, char* smem) {
    bf16_t* kL = (bf16_t*)smem;
    bf16_t* qL = kL + 64 * KLS;
    float* AmT = (float*)qL;
    bf16_t* xs = qL + 64 * KLS;
    float* gcs = (float*)(xs + 64 * XSS);
    float* bts = gcs + 64;
    const int tid = threadIdx.x, lane = tid & 63, w = tid >> 6;
    const int n = chunk & 127, h = (chunk >> 7) & 3, b = chunk >> 9;
    const int t0 = n * 64;
    const size_t rbase = (size_t)(b * SEQ + t0);
    if (tid < 64) {
        const size_t r = (rbase + tid) * PLD;
        float a = bf2f(proj[r + C_A + h]), bb = bf2f(proj[r + C_B + h]);
        float xx = a + dt_bias[h];
        float sp = (xx > 20.f) ? xx : log1pf(__expf(xx));
        float c = -__expf(a_log[h]) * sp;
#pragma unroll
        for (int o = 1; o < 64; o <<= 1) { float nb = __shfl_up(c, o); if (lane >= o) c += nb; }
        gcs[tid] = c; bts[tid] = sigmoidf_(bb);
    }
    __syncthreads();
    {
        float wt[6][4], x0[6], x1[6], x2[6];
        int ch[6];
#pragma unroll
        for (int c6 = 0; c6 < 6; c6++) {
            ch[c6] = (c6 >> 1) * 512 + h * 128 + lane + 64 * (c6 & 1);
#pragma unroll
            for (int j = 0; j < 4; j++) wt[c6][j] = conv_w[j * 1536 + ch[c6]];
            const int tb = t0 + 16 * w - 3;
            x0[c6] = (tb >= 0) ? bf2f(proj[((size_t)(b * SEQ + tb)) * PLD + C_GQKV + ch[c6]]) : 0.f;
            x1[c6] = (tb + 1 >= 0) ? bf2f(proj[((size_t)(b * SEQ + tb + 1)) * PLD + C_GQKV + ch[c6]]) : 0.f;
            x2[c6] = (tb + 2 >= 0) ? bf2f(proj[((size_t)(b * SEQ + tb + 2)) * PLD + C_GQKV + ch[c6]]) : 0.f;
        }
        for (int i = 16 * w; i < 16 * w + 16; i++) {
            float sv[6];
#pragma unroll
            for (int c6 = 0; c6 < 6; c6++) {
                float xn = bf2f(proj[(rbase + i) * PLD + C_GQKV + ch[c6]]);
                float cv = x0[c6] * wt[c6][0] + x1[c6] * wt[c6][1] + x2[c6] * wt[c6][2] + xn * wt[c6][3];
                x0[c6] = x1[c6]; x1[c6] = x2[c6]; x2[c6] = xn;
                sv[c6] = cv * sigmoidf_(cv);
            }
            float rq = rsqrtf(wave_sum(sv[0] * sv[0] + sv[1] * sv[1]) + 1e-6f) * 0.08838834764831845f;
            float rk = rsqrtf(wave_sum(sv[2] * sv[2] + sv[3] * sv[3]) + 1e-6f);
            const float bi = bts[i], ei = __expf(gcs[i]);
            float q0 = sv[0] * rq, q1 = sv[1] * rq, k0 = sv[2] * rk, k1 = sv[3] * rk;
            qL[i * KLS + lane] = f2bf(q0); qL[i * KLS + lane + 64] = f2bf(q1);
            kL[i * KLS + lane] = f2bf(k0); kL[i * KLS + lane + 64] = f2bf(k1);
            xs[i * XSS + lane] = f2bf(sv[4] * bi); xs[i * XSS + lane + 64] = f2bf(sv[5] * bi);
            xs[i * XSS + 128 + lane] = f2bf(k0 * bi * ei); xs[i * XSS + 192 + lane] = f2bf(k1 * bi * ei);
            bf16_t* qd = gqd + (size_t)chunk * 8192 + i * 128;
            qd[lane] = f2bf(q0 * ei); qd[lane + 64] = f2bf(q1 * ei);
        }
    }
    __syncthreads();
    const int n16 = lane & 15, kq = lane >> 4;
    f32x4 aqk[4], akk[4];
#pragma unroll
    for (int tj = 0; tj < 4; tj++) { aqk[tj] = (f32x4){0.f, 0.f, 0.f, 0.f}; akk[tj] = (f32x4){0.f, 0.f, 0.f, 0.f}; }
#pragma unroll
    for (int ks = 0; ks < 4; ks++) {
        bf16x8 qa = *(const bf16x8*)(qL + (16 * w + n16) * KLS + 32 * ks + 8 * kq);
        bf16x8 ka = *(const bf16x8*)(kL + (16 * w + n16) * KLS + 32 * ks + 8 * kq);
#pragma unroll
        for (int tj = 0; tj < 4; tj++) {
            bf16x8 kb = *(const bf16x8*)(kL + (16 * tj + n16) * KLS + 32 * ks + 8 * kq);
            aqk[tj] = __builtin_amdgcn_mfma_f32_16x16x32_bf16(qa, kb, aqk[tj], 0, 0, 0);
            akk[tj] = __builtin_amdgcn_mfma_f32_16x16x32_bf16(ka, kb, akk[tj], 0, 0, 0);
        }
    }
    {
        const float glast = gcs[63];
        const int kidx = tid >> 1, c0 = (tid & 1) * 32;
        unsigned pk[16];
#pragma unroll
        for (int cc = 0; cc < 32; cc += 2) {
            float v0 = bf2f(kL[(c0 + cc) * KLS + kidx]) * __expf(glast - gcs[c0 + cc]);
            float v1 = bf2f(kL[(c0 + cc + 1) * KLS + kidx]) * __expf(glast - gcs[c0 + cc + 1]);
            pk[cc >> 1] = pack2bf(v0, v1);
        }
        uint4* dst = (uint4*)(gkdT + (size_t)chunk * 8192 + kidx * 64 + c0);
#pragma unroll
        for (int v4 = 0; v4 < 4; v4++) dst[v4] = make_uint4(pk[4 * v4], pk[4 * v4 + 1], pk[4 * v4 + 2], pk[4 * v4 + 3]);
        if (tid == 0) gl[chunk] = __expf(glast);
    }
    __syncthreads();
#pragma unroll
    for (int tj = 0; tj < 4; tj++)
#pragma unroll
        for (int r = 0; r < 4; r++) {
            const int i = 16 * w + 4 * kq + r, j = 16 * tj + n16;
            const float dec = (j <= i) ? __expf(gcs[i] - gcs[j]) : 0.f;
            gin[(size_t)chunk * 4096 + i * 64 + j] = f2bf(aqk[tj][r] * dec);
            AmT[j * 64 + i] = (j < i) ? bts[i] * akk[tj][r] * dec : 0.f;
        }
    __syncthreads();
    {
        const int c = tid;
#pragma unroll 1
        for (int blk = 0; blk < 8; blk++) {
            const int i0 = blk * 8;
            float acc[8];
#pragma unroll
            for (int r = 0; r < 8; r++) acc[r] = bf2f(xs[(i0 + r) * XSS + c]);
            for (int j = 0; j < i0; j++) {
                const float xj = bf2f(xs[j * XSS + c]);
                const float4 a0 = *(const float4*)(AmT + j * 64 + i0), a1 = *(const float4*)(AmT + j * 64 + i0 + 4);
                acc[0] -= a0.x * xj; acc[1] -= a0.y * xj; acc[2] -= a0.z * xj; acc[3] -= a0.w * xj;
                acc[4] -= a1.x * xj; acc[5] -= a1.y * xj; acc[6] -= a1.z * xj; acc[7] -= a1.w * xj;
            }
#pragma unroll
            for (int r = 1; r < 8; r++)
#pragma unroll
                for (int s2 = 0; s2 < r; s2++) acc[r] -= AmT[(i0 + s2) * 64 + i0 + r] * acc[s2];
#pragma unroll
            for (int r = 0; r < 8; r++) xs[(i0 + r) * XSS + c] = f2bf(acc[r]);
            if (c < 128) {
                *(uint4*)(guT + (size_t)chunk * 8192 + c * 64 + i0) =
                    make_uint4(pack2bf(acc[0], acc[1]), pack2bf(acc[2], acc[3]), pack2bf(acc[4], acc[5]), pack2bf(acc[6], acc[7]));
            } else {
#pragma unroll
                for (int r = 0; r < 8; r++) gw[(size_t)chunk * 8192 + (i0 + r) * 128 + (c - 128)] = f2bf(acc[r]);
            }
        }
    }
}

struct GdnFrag { bf16x8 wA[4], qA[4], inA[2], kdA[2][2]; uint2 uC; float glv; };
__device__ __forceinline__ void gdn_load_frag(GdnFrag& f, const bf16_t* __restrict__ guT, const bf16_t* __restrict__ gw, const bf16_t* __restrict__ gqd,
                                              const bf16_t* __restrict__ gkdT, const bf16_t* __restrict__ gin, const float* __restrict__ gl,
                                              int chunk, int w, int sl, int n16, int kq) {
    const size_t cb = (size_t)chunk * 8192;
#pragma unroll
    for (int ks = 0; ks < 4; ks++) {
        f.wA[ks] = *(const bf16x8*)(gw + cb + (16 * w + n16) * 128 + 32 * ks + 8 * kq);
        f.qA[ks] = *(const bf16x8*)(gqd + cb + (16 * w + n16) * 128 + 32 * ks + 8 * kq);
    }
#pragma unroll
    for (int ks = 0; ks < 2; ks++) {
        f.inA[ks] = *(const bf16x8*)(gin + (size_t)chunk * 4096 + (16 * w + n16) * 64 + 32 * ks + 8 * kq);
        f.kdA[0][ks] = *(const bf16x8*)(gkdT + cb + (32 * w + n16) * 64 + 32 * ks + 8 * kq);
        f.kdA[1][ks] = *(const bf16x8*)(gkdT + cb + (32 * w + 16 + n16) * 64 + 32 * ks + 8 * kq);
    }
    f.uC = *(const uint2*)(guT + cb + (16 * sl + n16) * 64 + 16 * w + 4 * kq);
    f.glv = gl[chunk];
}
#define STS 144
#define VNS 80
__device__ __forceinline__ void gdn_step(const GdnFrag& f, f32x4& S0, f32x4& S1, bf16_t* StT, bf16_t* vnT, float* __restrict__ ogrow, int w, int n16, int kq) {
    f32x4 ws = (f32x4){0.f, 0.f, 0.f, 0.f}, qs = (f32x4){0.f, 0.f, 0.f, 0.f};
#pragma unroll
    for (int ks = 0; ks < 4; ks++) {
        bf16x8 sb = *(const bf16x8*)(StT + n16 * STS + 32 * ks + 8 * kq);
        ws = __builtin_amdgcn_mfma_f32_16x16x32_bf16(f.wA[ks], sb, ws, 0, 0, 0);
        qs = __builtin_amdgcn_mfma_f32_16x16x32_bf16(f.qA[ks], sb, qs, 0, 0, 0);
    }
    float v0 = __uint_as_float(f.uC.x << 16) - ws[0], v1 = __uint_as_float(f.uC.x & 0xffff0000u) - ws[1];
    float v2 = __uint_as_float(f.uC.y << 16) - ws[2], v3 = __uint_as_float(f.uC.y & 0xffff0000u) - ws[3];
    *(uint2*)(vnT + n16 * VNS + 16 * w + 4 * kq) = make_uint2(pack2bf(v0, v1), pack2bf(v2, v3));
    __syncthreads();
    bf16x8 vb0 = *(const bf16x8*)(vnT + n16 * VNS + 8 * kq), vb1 = *(const bf16x8*)(vnT + n16 * VNS + 32 + 8 * kq);
    qs = __builtin_amdgcn_mfma_f32_16x16x32_bf16(f.inA[0], vb0, qs, 0, 0, 0);
    qs = __builtin_amdgcn_mfma_f32_16x16x32_bf16(f.inA[1], vb1, qs, 0, 0, 0);
    S0 = S0 * f.glv; S1 = S1 * f.glv;
    S0 = __builtin_amdgcn_mfma_f32_16x16x32_bf16(f.kdA[0][0], vb0, S0, 0, 0, 0);
    S0 = __builtin_amdgcn_mfma_f32_16x16x32_bf16(f.kdA[0][1], vb1, S0, 0, 0, 0);
    S1 = __builtin_amdgcn_mfma_f32_16x16x32_bf16(f.kdA[1][0], vb0, S1, 0, 0, 0);
    S1 = __builtin_amdgcn_mfma_f32_16x16x32_bf16(f.kdA[1][1], vb1, S1, 0, 0, 0);
#pragma unroll
    for (int r = 0; r < 4; r++) ogrow[(size_t)(4 * kq + r) * 512] = qs[r];
    *(uint2*)(StT + n16 * STS + 32 * w + 4 * kq) = make_uint2(pack2bf(S0[0], S0[1]), pack2bf(S0[2], S0[3]));
    *(uint2*)(StT + n16 * STS + 32 * w + 16 + 4 * kq) = make_uint2(pack2bf(S1[0], S1[1]), pack2bf(S1[2], S1[3]));
    __syncthreads();
}
__device__ __forceinline__ void d_gdn_scan2(const bf16_t* __restrict__ guT, const bf16_t* __restrict__ gw, const bf16_t* __restrict__ gqd,
                                            const bf16_t* __restrict__ gkdT, const bf16_t* __restrict__ gin, const float* __restrict__ gl,
                                            float* __restrict__ og, int item, char* smem) {
    bf16_t* StT = (bf16_t*)smem;
    bf16_t* vnT = StT + 16 * STS;
    const int tid = threadIdx.x, lane = tid & 63, w = tid >> 6, n16 = lane & 15, kq = lane >> 4;
    const int bh = item >> 3, sl = item & 7, b = bh >> 2, h = bh & 3;
    for (int i = tid; i < 16 * STS / 2; i += 256) ((unsigned*)StT)[i] = 0u;
    f32x4 S0 = (f32x4){0.f, 0.f, 0.f, 0.f}, S1 = (f32x4){0.f, 0.f, 0.f, 0.f};
    GdnFrag fa, fb;
    gdn_load_frag(fa, guT, gw, gqd, gkdT, gin, gl, bh * 128, w, sl, n16, kq);
    __syncthreads();
    float* obase = og + (size_t)(b * SEQ + 16 * w) * 512 + h * 128 + 16 * sl + n16;
#pragma unroll 1
    for (int n = 0; n < 128; n += 2) {
        gdn_load_frag(fb, guT, gw, gqd, gkdT, gin, gl, bh * 128 + n + 1, w, sl, n16, kq);
        gdn_step(fa, S0, S1, StT, vnT, obase + (size_t)(n * 64) * 512, w, n16, kq);
        if (n + 2 < 128) gdn_load_frag(fa, guT, gw, gqd, gkdT, gin, gl, bh * 128 + n + 2, w, sl, n16, kq);
        gdn_step(fb, S0, S1, StT, vnT, obase + (size_t)((n + 1) * 64) * 512, w, n16, kq);
    }
}

__device__ __forceinline__ void d_gdn_out(const float* __restrict__ og, const bf16_t* __restrict__ proj, const float* __restrict__ gain, bf16_t* __restrict__ mix, int t, int lane) {
    const float* o = og + (size_t)t * 512;
    const bf16_t* z = proj + (size_t)t * PLD + C_Z;
    float a[8], zz[8];
#pragma unroll
    for (int i = 0; i < 8; i++) { a[i] = o[lane + 64 * i]; zz[i] = bf2f(z[lane + 64 * i]); }
    const float g0 = gain[lane], g1 = gain[lane + 64];
#pragma unroll
    for (int h = 0; h < 4; h++) {
        const float ss = wave_sum_dpp(a[2 * h] * a[2 * h] + a[2 * h + 1] * a[2 * h + 1]);
        const float r = rsqrtf(ss * (1.f / 128.f) + 1e-6f);
        mix[(size_t)t * DM + 512 + h * 128 + lane] = f2bf(a[2 * h] * r * g0 * zz[2 * h] * sigmoidf_(zz[2 * h]));
        mix[(size_t)t * DM + 512 + h * 128 + lane + 64] = f2bf(a[2 * h + 1] * r * g1 * zz[2 * h + 1] * sigmoidf_(zz[2 * h + 1]));
    }
}

__device__ __forceinline__ void route_load_subkeys(const float* __restrict__ subkeys, char* smem) {
    for (int idx = threadIdx.x; idx < 2 * 128 * 16; idx += 256) {
        const int half = idx >> 11, key = (idx >> 4) & 127, ch = idx & 15;
        const float* src = subkeys + ((size_t)(half * 128 + key)) * 128 + ch * 8;
        const float4 x0 = *(const float4*)src, x1 = *(const float4*)(src + 4);
        *(uint4*)(smem + half * 32768 + key * 256 + ((ch ^ (key & 15)) << 4)) = make_uint4(pk2(x0.x, x0.y), pk2(x0.z, x0.w), pk2(x1.x, x1.y), pk2(x1.z, x1.w));
    }
}
#define CEX(i, j) { const float _a = v[i], _b = v[j]; v[i] = fmaxf(_a, _b); v[j] = fminf(_a, _b); }
__device__ __forceinline__ void d_peer_route2(const bf16_t* __restrict__ qry, int* __restrict__ eidx, float* __restrict__ pgate, int mtile, const char* smem, int lane) {
    const int n16 = lane & 15, kq = lane >> 4;
    const int tA = 2 * mtile + (n16 >> 3), hA = n16 & 7;
    float topv[2][4];
#pragma unroll
    for (int half = 0; half < 2; half++) {
        const bf16_t* qp = qry + (size_t)tA * 2048 + hA * 256 + half * 128 + 8 * kq;
        bf16x8 a[4];
#pragma unroll
        for (int ks = 0; ks < 4; ks++) a[ks] = *(const bf16x8*)(qp + 32 * ks);
        f32x4 acc[8];
#pragma unroll
        for (int nt = 0; nt < 8; nt++) acc[nt] = (f32x4){0.f, 0.f, 0.f, 0.f};
#pragma unroll
        for (int ks = 0; ks < 4; ks++)
#pragma unroll
            for (int nt = 0; nt < 8; nt++) {
                const bf16x8 bb = *(const bf16x8*)(smem + half * 32768 + (16 * nt + n16) * 256 + (((4 * ks + kq) ^ n16) << 4));
                acc[nt] = __builtin_amdgcn_mfma_f32_16x16x32_bf16(a[ks], bb, acc[nt], 0, 0, 0);
                if (nt == 3 || nt == 7) __builtin_amdgcn_sched_barrier(0);
            }
#pragma unroll
        for (int r = 0; r < 4; r++) {
            float v[8];
#pragma unroll
            for (int nt = 0; nt < 8; nt++) v[nt] = __uint_as_float((__float_as_uint(acc[nt][r]) & 0xFFFFFF80u) | (unsigned)(nt << 4) | (unsigned)n16);
            CEX(0, 1) CEX(2, 3) CEX(4, 5) CEX(6, 7) CEX(0, 2) CEX(1, 3) CEX(4, 6) CEX(5, 7) CEX(1, 2) CEX(5, 6)
            CEX(0, 4) CEX(1, 5) CEX(2, 6) CEX(3, 7) CEX(2, 4) CEX(3, 5) CEX(1, 2) CEX(3, 4) CEX(5, 6)
            float keep = 0.f;
#pragma unroll 1
            for (int it = 0; it < 16; it++) {
                const float mx = allmax16(v[0]);
                if (n16 == it) keep = mx;
                if (__float_as_uint(v[0]) == __float_as_uint(mx)) {
                    v[0] = v[1]; v[1] = v[2]; v[2] = v[3]; v[3] = v[4]; v[4] = v[5]; v[5] = v[6]; v[6] = v[7]; v[7] = -3e38f;
                }
            }
            topv[half][r] = keep;
            __builtin_amdgcn_sched_barrier(0);
        }
    }
#pragma unroll
    for (int r = 0; r < 4; r++) {
        const float v1p = topv[0][r], v2p = topv[1][r];
        const unsigned u1 = __float_as_uint(v1p);
        const int i1 = (int)(((u1 >> 4) & 7u) * 16u + (u1 & 15u));
        const int lim = 16 / (n16 + 1);
        int ptr = 0;
        const int lanebase = (lane & 48);
        float cur2 = __builtin_bit_cast(float, __builtin_amdgcn_ds_bpermute(lanebase * 4, __builtin_bit_cast(int, v2p)));
        float head = __uint_as_float((__float_as_uint(v1p + cur2) & 0xFFFFFFF0u) | (unsigned)n16);
        float ksc = 0.f; unsigned ke = 0u;
#pragma unroll 1
        for (int it = 0; it < 16; it++) {
            const float mx = allmax16(head);
            const bool win = __float_as_uint(head) == __float_as_uint(mx);
            const unsigned u2 = __float_as_uint(cur2);
            unsigned e = win ? (unsigned)(i1 * 128) + ((u2 >> 4) & 7u) * 16u + (u2 & 15u) : 0u;
            e = allmaxu16(e);
            if (n16 == it) { ksc = mx; ke = e; }
            if (win) ptr++;
            const int pn = ptr < 15 ? ptr : 15;
            const float nx = __builtin_bit_cast(float, __builtin_amdgcn_ds_bpermute((lanebase + pn) * 4, __builtin_bit_cast(int, v2p)));
            if (win) { cur2 = nx; head = (ptr < lim) ? __uint_as_float((__float_as_uint(v1p + cur2) & 0xFFFFFFF0u) | (unsigned)n16) : -3e38f; }
        }
        const float smax = allmax16(ksc);
        const float ex = __expf(ksc - smax);
        const float sum = allsum16(ex);
        const int row = 4 * kq + r;
        const size_t o = (size_t)(2 * mtile + (row >> 3)) * 128 + (row & 7) * 16 + n16;
        eidx[o] = (int)ke; pgate[o] = ex / sum;
    }
}
#undef CEX

__device__ __forceinline__ void d_quant_row(const float* __restrict__ src, unsigned char* __restrict__ dst, float* __restrict__ scale, int row, int lane, int bias) {
    const float4* p = (const float4*)(src + (size_t)row * DM) + lane * 4;
    float4 x[4];
    float am = 0.f;
#pragma unroll
    for (int i = 0; i < 4; i++) { x[i] = p[i]; am = fmaxf(am, fmaxf(fmaxf(fabsf(x[i].x), fabsf(x[i].y)), fmaxf(fabsf(x[i].z), fabsf(x[i].w)))); }
    am = wave_max(am);
    const float sc = (am > 0.f) ? am * (1.f / 127.f) : 1.f;
    const float inv = 1.f / sc;
    unsigned wv[4];
#pragma unroll
    for (int i = 0; i < 4; i++) {
        const int q0 = (int)rintf(x[i].x * inv) + bias, q1 = (int)rintf(x[i].y * inv) + bias, q2 = (int)rintf(x[i].z * inv) + bias, q3 = (int)rintf(x[i].w * inv) + bias;
        wv[i] = (unsigned)(q0 & 0xff) | ((unsigned)(q1 & 0xff) << 8) | ((unsigned)(q2 & 0xff) << 16) | ((unsigned)(q3 & 0xff) << 24);
    }
    ((uint4*)(dst + (size_t)row * DM))[lane] = make_uint4(wv[0], wv[1], wv[2], wv[3]);
    if (lane == 0) scale[row] = sc;
}

struct PeerGrp { u32x4 u[4]; u32x4 v[4]; float gv[4]; float su[4]; };
__device__ __forceinline__ void peer_load(PeerGrp& G, const unsigned char* __restrict__ uq, const unsigned char* __restrict__ vq,
                                          int esrc, float gsrc, float susrc, int k0, int lane) {
#pragma unroll
    for (int i = 0; i < 4; i++) {
        const int e = __builtin_amdgcn_readlane(esrc, (k0 + i) & 63);
        G.gv[i] = __builtin_bit_cast(float, __builtin_amdgcn_readlane(__builtin_bit_cast(int, gsrc), (k0 + i) & 63));
        G.su[i] = __builtin_bit_cast(float, __builtin_amdgcn_readlane(__builtin_bit_cast(int, susrc), (k0 + i) & 63));
        G.u[i] = ((const u32x4*)(uq + (size_t)e * DM))[lane];
        G.v[i] = ((const u32x4*)(vq + (size_t)e * DM))[lane];
    }
}
__device__ __forceinline__ void peer_compute(const PeerGrp& G, const int (&xq)[4], float sx, float (&acc)[16], float& bsum) {
    int d[4];
#pragma unroll
    for (int i = 0; i < 4; i++) {
        int sdot = 0;
        sdot = __builtin_amdgcn_sdot4((int)G.u[i][0], xq[0], sdot, false); sdot = __builtin_amdgcn_sdot4((int)G.u[i][1], xq[1], sdot, false);
        sdot = __builtin_amdgcn_sdot4((int)G.u[i][2], xq[2], sdot, false); sdot = __builtin_amdgcn_sdot4((int)G.u[i][3], xq[3], sdot, false);
        d[i] = sdot;
    }
#pragma unroll
    for (int i = 0; i < 4; i++) {
        int x = d[i];
        x += (int)dppu<0xB1>((unsigned)x); x += (int)dppu<0x4E>((unsigned)x); x += (int)dppu<0x141>((unsigned)x); x += (int)dppu<0x140>((unsigned)x);
        d[i] = __builtin_amdgcn_readlane(x, 0) + __builtin_amdgcn_readlane(x, 16) + __builtin_amdgcn_readlane(x, 32) + __builtin_amdgcn_readlane(x, 48);
    }
#pragma unroll
    for (int i = 0; i < 4; i++) {
        const float dot = (float)d[i] * (G.su[i] * sx);
        const float u2 = 1.5957691216057308f * (dot + 0.044715f * dot * dot * dot);
        const float cs = G.gv[i] * dot * __builtin_amdgcn_rcpf(1.f + __expf(-u2));
        bsum += cs;
#pragma unroll
        for (int j = 0; j < 4; j++) {
            const unsigned wv = G.v[i][j];
            acc[4 * j] += cs * (float)(wv & 0xffu);
            acc[4 * j + 1] += cs * (float)((wv >> 8) & 0xffu);
            acc[4 * j + 2] += cs * (float)((wv >> 16) & 0xffu);
            acc[4 * j + 3] += cs * (float)(wv >> 24);
        }
    }
}
__device__ __forceinline__ void d_peer_expert3(const bf16_t* __restrict__ h2, const int* __restrict__ eidx, const float* __restrict__ pgate,
                                               const unsigned char* __restrict__ uq, const unsigned char* __restrict__ vq,
                                               const float* __restrict__ su, const float* __restrict__ sv, const float* __restrict__ ssq, const float* __restrict__ fgain, float* __restrict__ out, int token, int lane, bool do_store = true, int emask = 0xffff) {
    const uint4 xa = ((const uint4*)(h2 + (size_t)token * DM))[2 * lane], xb = ((const uint4*)(h2 + (size_t)token * DM))[2 * lane + 1];
    const unsigned xw[8] = {xa.x, xa.y, xa.z, xa.w, xb.x, xb.y, xb.z, xb.w};
    float xf[16];
    float am = 0.f;
    const float rr = rsqrtf(allsum16(ssq[(size_t)token * 16 + (lane & 15)]) * (1.f / DM) + 1e-6f);
    const float4* gp = (const float4*)(fgain + lane * 16);
    const float4 ga = gp[0], gb = gp[1], gc = gp[2], gd = gp[3];
    const float gg[16] = {ga.x, ga.y, ga.z, ga.w, gb.x, gb.y, gb.z, gb.w, gc.x, gc.y, gc.z, gc.w, gd.x, gd.y, gd.z, gd.w};
#pragma unroll
    for (int j = 0; j < 8; j++) {
        xf[2 * j] = __uint_as_float(xw[j] << 16) * rr * gg[2 * j]; xf[2 * j + 1] = __uint_as_float(xw[j] & 0xffff0000u) * rr * gg[2 * j + 1];
        am = fmaxf(am, fmaxf(fabsf(xf[2 * j]), fabsf(xf[2 * j + 1])));
    }
    am = wave_max(am);
    const float sx = (am > 0.f) ? am * (1.f / 127.f) : 1.f;
    const float isx = 1.f / sx;
    int xq[4];
#pragma unroll
    for (int j = 0; j < 4; j++) {
        const int q0 = (int)rintf(xf[4 * j] * isx), q1 = (int)rintf(xf[4 * j + 1] * isx), q2 = (int)rintf(xf[4 * j + 2] * isx), q3 = (int)rintf(xf[4 * j + 3] * isx);
        xq[j] = (int)((unsigned)(q0 & 0xff) | ((unsigned)(q1 & 0xff) << 8) | ((unsigned)(q2 & 0xff) << 16) | ((unsigned)(q3 & 0xff) << 24));
    }
    float acc[16];
#pragma unroll
    for (int i = 0; i < 16; i++) acc[i] = 0.f;
    float bsum = 0.f;
    const int e_lo = eidx[(size_t)token * 128 + lane] & emask, e_hi = eidx[(size_t)token * 128 + 64 + lane] & emask;
    const float g_lo = pgate[(size_t)token * 128 + lane] * sv[e_lo], g_hi = pgate[(size_t)token * 128 + 64 + lane] * sv[e_hi];
    const float s_lo = su[e_lo], s_hi = su[e_hi];
    PeerGrp A, B;
    peer_load(A, uq, vq, e_lo, g_lo, s_lo, 0, lane);
#pragma unroll 1
    for (int k0 = 0; k0 < 64; k0 += 8) {
        peer_load(B, uq, vq, e_lo, g_lo, s_lo, k0 + 4, lane);
        peer_compute(A, xq, sx, acc, bsum);
        if (k0 + 8 < 64) peer_load(A, uq, vq, e_lo, g_lo, s_lo, k0 + 8, lane); else peer_load(A, uq, vq, e_hi, g_hi, s_hi, 0, lane);
        peer_compute(B, xq, sx, acc, bsum);
    }
#pragma unroll 1
    for (int k0 = 0; k0 < 64; k0 += 8) {
        peer_load(B, uq, vq, e_hi, g_hi, s_hi, k0 + 4, lane);
        peer_compute(A, xq, sx, acc, bsum);
        if (k0 + 8 < 64) peer_load(A, uq, vq, e_hi, g_hi, s_hi, k0 + 8, lane);
        peer_compute(B, xq, sx, acc, bsum);
    }
    const float bs = 128.f * bsum;
    float4* o = (float4*)(out + (size_t)token * DM + lane * 16);
#pragma unroll
    for (int j = 0; j < 4; j++) {
        float4 t = o[j];
        t.x += acc[4 * j] - bs; t.y += acc[4 * j + 1] - bs; t.z += acc[4 * j + 2] - bs; t.w += acc[4 * j + 3] - bs;
        if (do_store) o[j] = t; else asm volatile("" :: "v"(t.x), "v"(t.y), "v"(t.z), "v"(t.w));
    }
}

#define PE_PSH 8
#define PE_NP 64
#define PE_GS 4
#define PE_TOK 4
#define PE_WAVE_LDS 9344
struct PeSet { u32x4 u[PE_GS], v[PE_GS]; int id[PE_GS]; int n; unsigned long long r0, r1; };
__device__ __forceinline__ void pe_prepare(PeSet& S, const unsigned* ent_e, int k, int p, const unsigned char* __restrict__ uq, const unsigned char* __restrict__ vq, int lane) {
    const unsigned pair = ent_e[k * 64 + lane];
    unsigned long long m0 = __builtin_amdgcn_ballot_w64(((pair & 0xffffu) >> PE_PSH) == (unsigned)p);
    unsigned long long m1 = __builtin_amdgcn_ballot_w64((pair >> (16 + PE_PSH)) == (unsigned)p);
    int n = 0;
#pragma unroll
    for (int i = 0; i < PE_GS; i++) {
        if (m0 | m1) {
            int idx, e;
            if (m0) { idx = __builtin_ctzll(m0); m0 &= m0 - 1; e = (int)((unsigned)__builtin_amdgcn_readlane((int)pair, idx) & 0xffffu); S.id[i] = idx; }
            else { idx = __builtin_ctzll(m1); m1 &= m1 - 1; e = (int)((unsigned)__builtin_amdgcn_readlane((int)pair, idx) >> 16); S.id[i] = 64 + idx; }
            S.u[i] = ((const u32x4*)(uq + (size_t)e * DM))[lane];
            S.v[i] = ((const u32x4*)(vq + (size_t)e * DM))[lane];
            n = i + 1;
        }
    }
    S.n = n; S.r0 = m0; S.r1 = m1;
}
__device__ __forceinline__ void pe_one(const u32x4& u, const u32x4& v, const u32x4& xq, float gs, float ss, float (&acc)[16], float& bsum) {
    int sdot = 0;
    sdot = __builtin_amdgcn_sdot4((int)u[0], (int)xq[0], sdot, false); sdot = __builtin_amdgcn_sdot4((int)u[1], (int)xq[1], sdot, false);
    sdot = __builtin_amdgcn_sdot4((int)u[2], (int)xq[2], sdot, false); sdot = __builtin_amdgcn_sdot4((int)u[3], (int)xq[3], sdot, false);
    int x = sdot;
    x += (int)dppu<0xB1>((unsigned)x); x += (int)dppu<0x4E>((unsigned)x); x += (int)dppu<0x141>((unsigned)x); x += (int)dppu<0x140>((unsigned)x);
    const int tot = __builtin_amdgcn_readlane(x, 0) + __builtin_amdgcn_readlane(x, 16) + __builtin_amdgcn_readlane(x, 32) + __builtin_amdgcn_readlane(x, 48);
    const float dot = (float)tot * ss;
    const float u2 = 1.5957691216057308f * (dot + 0.044715f * dot * dot * dot);
    const float cs = gs * dot * __builtin_amdgcn_rcpf(1.f + __expf(-u2));
    bsum += cs;
#pragma unroll
    for (int j = 0; j < 4; j++) {
        const unsigned wv = v[j];
        acc[4 * j] += cs * (float)(wv & 0xffu);
        acc[4 * j + 1] += cs * (float)((wv >> 8) & 0xffu);
        acc[4 * j + 2] += cs * (float)((wv >> 16) & 0xffu);
        acc[4 * j + 3] += cs * (float)(wv >> 24);
    }
}
__device__ __forceinline__ void pe_consume(const PeSet& S, const unsigned* ent_e, const float* ent_g, const float* ent_s, const u32x4* xqs, const float* sxs, int k,
                                           const unsigned char* __restrict__ uq, const unsigned char* __restrict__ vq, int lane, float (&acc)[16], float& bsum) {
    if (S.n == 0) return;
    const u32x4 xq = xqs[k * 64 + lane];
    const float sx = sxs[k];
#pragma unroll
    for (int i = 0; i < PE_GS; i++) {
        if (S.n > i) pe_one(S.u[i], S.v[i], xq, ent_g[k * 128 + S.id[i]], ent_s[k * 128 + S.id[i]] * sx, acc, bsum);
    }
    unsigned long long m0 = S.r0, m1 = S.r1;
    while (m0 | m1) {
        int idx, id, e;
        const unsigned pair = ent_e[k * 64 + lane];
        if (m0) { idx = __builtin_ctzll(m0); m0 &= m0 - 1; e = (int)((unsigned)__builtin_amdgcn_readlane((int)pair, idx) & 0xffffu); id = idx; }
        else { idx = __builtin_ctzll(m1); m1 &= m1 - 1; e = (int)((unsigned)__builtin_amdgcn_readlane((int)pair, idx) >> 16); id = 64 + idx; }
        const u32x4 u = ((const u32x4*)(uq + (size_t)e * DM))[lane];
        const u32x4 v = ((const u32x4*)(vq + (size_t)e * DM))[lane];
        pe_one(u, v, xq, ent_g[k * 128 + id], ent_s[k * 128 + id] * sx, acc, bsum);
    }
}
__device__ __forceinline__ void d_peer_expert5(const bf16_t* __restrict__ h2, const int* __restrict__ eidx, const float* __restrict__ pgate,
                                               const unsigned char* __restrict__ uq, const unsigned char* __restrict__ vq,
                                               const float* __restrict__ su, const float* __restrict__ sv, float* __restrict__ out, int grp, int lane, char* wlds, bool do_store, int emask = 0xffff) {
    unsigned* ent_e = (unsigned*)wlds;
    float* ent_g = (float*)(wlds + 1024);
    float* ent_s = (float*)(wlds + 1024 + 2048);
    u32x4* xqs = (u32x4*)(wlds + 1024 + 4096);
    float* sxs = (float*)(wlds + 1024 + 4096 + 4096);
#pragma unroll 1
    for (int k = 0; k < PE_TOK; k++) {
        const size_t t = (size_t)grp * PE_TOK + k;
        int e_lo = eidx[t * 128 + lane], e_hi = eidx[t * 128 + 64 + lane];
        e_lo = (e_lo & 0xff00) | (e_lo & emask & 0xff) | ((e_lo & 0xff00) & emask); e_hi = (e_hi & 0xff00) | (e_hi & emask & 0xff) | ((e_hi & 0xff00) & emask);
        ent_e[k * 64 + lane] = (unsigned)e_lo | ((unsigned)e_hi << 16);
        ent_g[k * 128 + lane] = pgate[t * 128 + lane] * sv[e_lo]; ent_g[k * 128 + 64 + lane] = pgate[t * 128 + 64 + lane] * sv[e_hi];
        ent_s[k * 128 + lane] = su[e_lo]; ent_s[k * 128 + 64 + lane] = su[e_hi];
        const uint4 xa = ((const uint4*)(h2 + t * DM))[2 * lane], xb = ((const uint4*)(h2 + t * DM))[2 * lane + 1];
        const unsigned xw[8] = {xa.x, xa.y, xa.z, xa.w, xb.x, xb.y, xb.z, xb.w};
        float xf[16];
        float am = 0.f;
#pragma unroll
        for (int j = 0; j < 8; j++) { xf[2 * j] = __uint_as_float(xw[j] << 16); xf[2 * j + 1] = __uint_as_float(xw[j] & 0xffff0000u); am = fmaxf(am, fmaxf(fabsf(xf[2 * j]), fabsf(xf[2 * j + 1]))); }
        am = wave_max(am);
        const float sx = (am > 0.f) ? am * (1.f / 127.f) : 1.f;
        const float isx = 1.f / sx;
        u32x4 q;
#pragma unroll
        for (int j = 0; j < 4; j++) {
            const int q0 = (int)rintf(xf[4 * j] * isx), q1 = (int)rintf(xf[4 * j + 1] * isx), q2 = (int)rintf(xf[4 * j + 2] * isx), q3 = (int)rintf(xf[4 * j + 3] * isx);
            q[j] = (unsigned)(q0 & 0xff) | ((unsigned)(q1 & 0xff) << 8) | ((unsigned)(q2 & 0xff) << 16) | ((unsigned)(q3 & 0xff) << 24);
        }
        xqs[k * 64 + lane] = q;
        if (lane == 0) sxs[k] = sx;
    }
    float acc[PE_TOK][16];
    float bsum[PE_TOK];
#pragma unroll
    for (int k = 0; k < PE_TOK; k++) {
        bsum[k] = 0.f;
#pragma unroll
        for (int i = 0; i < 16; i++) acc[k][i] = 0.f;
    }
    PeSet S0, S1, S2, S3;
    pe_prepare(S0, ent_e, 0, 0, uq, vq, lane);
    pe_prepare(S1, ent_e, 1, 0, uq, vq, lane);
    pe_prepare(S2, ent_e, 2, 0, uq, vq, lane);
#pragma unroll 1
    for (int p = 0; p < PE_NP; p++) {
        pe_prepare(S3, ent_e, 3, p, uq, vq, lane);
        pe_consume(S0, ent_e, ent_g, ent_s, xqs, sxs, 0, uq, vq, lane, acc[0], bsum[0]);
        if (p + 1 < PE_NP) pe_prepare(S0, ent_e, 0, p + 1, uq, vq, lane);
        pe_consume(S1, ent_e, ent_g, ent_s, xqs, sxs, 1, uq, vq, lane, acc[1], bsum[1]);
        if (p + 1 < PE_NP) pe_prepare(S1, ent_e, 1, p + 1, uq, vq, lane);
        pe_consume(S2, ent_e, ent_g, ent_s, xqs, sxs, 2, uq, vq, lane, acc[2], bsum[2]);
        if (p + 1 < PE_NP) pe_prepare(S2, ent_e, 2, p + 1, uq, vq, lane);
        pe_consume(S3, ent_e, ent_g, ent_s, xqs, sxs, 3, uq, vq, lane, acc[3], bsum[3]);
    }
#pragma unroll
    for (int k = 0; k < PE_TOK; k++) {
        const float bs = 128.f * bsum[k];
        float4* o = (float4*)(out + ((size_t)grp * PE_TOK + k) * DM + lane * 16);
#pragma unroll
        for (int j = 0; j < 4; j++) {
            float4 t = o[j];
            t.x += acc[k][4 * j] - bs; t.y += acc[k][4 * j + 1] - bs; t.z += acc[k][4 * j + 2] - bs; t.w += acc[k][4 * j + 3] - bs;
            if (do_store) o[j] = t; else asm volatile("" :: "v"(t.x), "v"(t.y), "v"(t.z), "v"(t.w));
        }
    }
}

#define XB_TMO      128
#define XB_XCNT(j)  (256  + 64 * (j))
#define XB_XSUB(j)  (1280 + 64 * (j))
#define XB_XGEN(j)  (2304 + 64 * (j))
#define XB_TOP      3328
#define XB_TOPGEN   3392
#define XB_QUEUE    3456
#define XCD_BAR_WORDS 4096
#define XB_SPIN_CAP (1u << 22)
#define LAS __attribute__((address_space(3)))
__device__ __forceinline__ unsigned xb_ld(unsigned* p)              { return __hip_atomic_load(p, __ATOMIC_RELAXED, __HIP_MEMORY_SCOPE_AGENT); }
__device__ __forceinline__ unsigned xb_add(unsigned* p, unsigned v) { return __hip_atomic_fetch_add(p, v, __ATOMIC_RELAXED, __HIP_MEMORY_SCOPE_AGENT); }
__device__ __forceinline__ unsigned xb_xcc_id() { return (unsigned)__builtin_amdgcn_s_getreg((3 << 11) | 20) & 0xFu; }
#define XB_SPIN(cond, bar) do { unsigned _sp = 0; while (cond) { __builtin_amdgcn_s_sleep(1); \
    if ((++_sp & 255u) == 0u) { if (xb_ld(&(bar)[XB_TMO])) break; if (_sp > XB_SPIN_CAP) { atomicAdd(&(bar)[XB_TMO], 1u); break; } } } } while (0)
struct XcdBarrier { unsigned* bar; unsigned x; volatile LAS unsigned* st; };
__device__ __forceinline__ XcdBarrier xcd_barrier_post(unsigned* bar, volatile LAS unsigned* st) {
    XcdBarrier b; b.bar = bar; b.x = xb_xcc_id(); b.st = st;
    if (threadIdx.x == 0) (void)xb_add(&bar[XB_XCNT(b.x)], 1u);
    return b;
}
__device__ __forceinline__ void xcd_barrier_complete(unsigned* bar, unsigned x, unsigned& nloc, unsigned& nx) {
    const unsigned G = gridDim.x * gridDim.y * gridDim.z;
    unsigned sum, cnt, mine, sp = 0u;
    for (;;) {
        sum = 0u; cnt = 0u; mine = 0u;
#pragma unroll
        for (unsigned j = 0; j < 16; ++j) { const unsigned c = xb_ld(&bar[XB_XCNT(j)]); sum += c; cnt += (c > 0u) ? 1u : 0u; mine = (j == x) ? c : mine; }
        if (sum == G) break;
        __builtin_amdgcn_s_sleep(1);
        if ((++sp & 255u) == 0u) { if (xb_ld(&bar[XB_TMO])) break; if (sp > XB_SPIN_CAP) { atomicAdd(&bar[XB_TMO], 1u); break; } }
    }
    nloc = mine > 0u ? mine : 1u; nx = cnt > 0u ? cnt : 1u;
}
__device__ __forceinline__ void xcd_barrier(const XcdBarrier& b) {
    asm volatile("s_waitcnt vmcnt(0)" ::: "memory");
    __syncthreads();
    if (threadIdx.x == 0) {
        unsigned* bar = b.bar;
        __builtin_amdgcn_s_waitcnt(0);
        unsigned nloc = b.st[0], nx = b.st[1];
        if (nloc == 0u) { xcd_barrier_complete(bar, b.x, nloc, nx); b.st[0] = nloc; b.st[1] = nx; }
        const unsigned old = xb_add(&bar[XB_XSUB(b.x)], 1u);
        const unsigned gen = old / nloc;
        if (old + 1u == (gen + 1u) * nloc) {
            __builtin_amdgcn_fence(__ATOMIC_RELEASE, "agent");
            asm volatile("s_waitcnt vmcnt(0)" ::: "memory");
            const unsigned og = xb_add(&bar[XB_TOP], 1u);
            const unsigned tg = og / nx;
            if (og + 1u == (tg + 1u) * nx) xb_add(&bar[XB_TOPGEN], 1u);
            else XB_SPIN(xb_ld(&bar[XB_TOPGEN]) == tg, bar);
            __builtin_amdgcn_fence(__ATOMIC_ACQUIRE, "agent");
            xb_add(&bar[XB_XGEN(b.x)], 1u);
            asm volatile("s_waitcnt vmcnt(0)" ::: "memory");
        } else {
            XB_SPIN(xb_ld(&bar[XB_XGEN(b.x)]) == gen, bar);
            __builtin_amdgcn_fence(__ATOMIC_ACQUIRE, "agent");
            asm volatile("s_waitcnt vmcnt(0)" ::: "memory");
        }
    }
    __syncthreads();
}

struct MKP {
    const float *x, *attn_norm, *w_in, *q_gain, *k_gain, *cmp_pos, *cmp_w1, *cmp_w2, *gdn_conv, *a_log, *dt_bias, *out_gain, *w_out, *ffn_norm, *w_query, *subkeys, *peer_u, *peer_v;
    float* out; char* ws; unsigned* bar;
};

#define SMEM_BYTES 70144

__global__ __launch_bounds__(256, 2) void hybrid_megakernel(MKP P) {
    extern __shared__ __attribute__((aligned(16))) char smem[];
    __shared__ uint4 xb_words;
    __shared__ int q_item;
    const int G = gridDim.x, bid0 = blockIdx.x;
    if (threadIdx.x == 0) xb_words = make_uint4(0u, 0u, 0u, 0u);
    __syncthreads();
    XcdBarrier B = xcd_barrier_post(P.bar, (volatile LAS unsigned*)&xb_words);
    char* ws = P.ws;
    bf16_t* w_in_t = (bf16_t*)(ws + OFF_WINT);
    bf16_t* w_out_t = (bf16_t*)(ws + OFF_WOUTT);
    bf16_t* w_q_t = (bf16_t*)(ws + OFF_WQT);
    bf16_t* cw1_t = (bf16_t*)(ws + OFF_CW1T);
    float* cbias = (float*)(ws + OFF_CBIAS);
    bf16_t* h_bf = (bf16_t*)(ws + OFF_HBF);
    bf16_t* proj = (bf16_t*)(ws + OFF_PROJ);
    bf16_t* ksn = (bf16_t*)(ws + OFF_KSN);
    bf16_t* kwn = (bf16_t*)(ws + OFF_KWN);
    bf16_t* kc = (bf16_t*)(ws + OFF_KC);
    bf16_t* vc = (bf16_t*)(ws + OFF_VC);
    bf16_t* hid = (bf16_t*)(ws + OFF_HID);
    bf16_t* gu = (bf16_t*)(ws + OFF_GU);
    bf16_t* gw = (bf16_t*)(ws + OFF_GW);
    bf16_t* gqd = (bf16_t*)(ws + OFF_GQD);
    bf16_t* gkd = (bf16_t*)(ws + OFF_GKD);
    bf16_t* gin = (bf16_t*)(ws + OFF_GIN);
    float* gl = (float*)(ws + OFF_GL);
    bf16_t* mix = (bf16_t*)(ws + OFF_MIX);
    bf16_t* qry = (bf16_t*)(ws + OFF_QRY);
    bf16_t* h2 = (bf16_t*)(ws + OFF_H2);
    int* eidx = (int*)(ws + OFF_EIDX);
    float* pgate = (float*)(ws + OFF_PGATE);
    unsigned char* uq = (unsigned char*)(ws + OFF_UQ);
    unsigned char* vq = (unsigned char*)(ws + OFF_VQ);
    float* su = (float*)(ws + OFF_SU);
    float* sv = (float*)(ws + OFF_SV);
    float* og = P.out;
    float2* rope = (float2*)(ws + OFF_ROPE);
    float* ssq = (float*)(ws + OFF_SSQ);
    bf16_t* vsn = (bf16_t*)(ws + OFF_VSN);
    bf16_t* vwn = (bf16_t*)(ws + OFF_VWN);
    bf16_t* cw2t = (bf16_t*)(ws + OFF_CW2T);
    unsigned char* uq_tmp = (unsigned char*)(P.out + 8388608);
    unsigned char* vq_tmp = uq_tmp + 16384ull * 1024;

#ifdef PROBE_P0
    for (int rep = 0; rep < 2; rep++)
#endif
    {
        const int n1 = 108 * 32, n2 = n1 + 32 * 32, n3 = n2 + 64 * 32, n4 = n3 + 2 * 8 * 64, n5 = n4 + 2 * 2 * 8;
        for (int it = bid0; it < n5; it += G) {
            if (it < n1) d_transpose_bf16(P.w_in, 1024, IN_COLS, w_in_t, it % 108, it / 108, smem);
            else if (it < n2) { int r = it - n1; d_transpose_bf16(P.w_out, 1024, 1024, w_out_t, r % 32, r / 32, smem); }
            else if (it < n3) { int r = it - n2; d_transpose_bf16(P.w_query, 1024, 2048, w_q_t, r % 64, r / 64, smem, P.ffn_norm); }
            else if (it < n4) { int r = it - n3; int j = r >> 9; r &= 511; d_transpose_bf16(P.cmp_w1 + (size_t)j * 2048 * 256, 2048, 256, cw1_t + (size_t)j * 256 * 2048, r % 8, r / 8, smem); }
            else { int r = it - n4; int j = r >> 4; r &= 15; d_transpose_bf16(P.cmp_w2 + (size_t)j * 256 * 64, 256, 64, cw2t + (size_t)j * 64 * 256, r % 2, r / 2, smem); }
            __syncthreads();
        }
        for (int it = bid0; it < 16; it += G) d_cmp_bias(P.cmp_pos, P.cmp_w1, cbias, it, smem);
        for (int it = bid0; it < T_TOK / 4; it += G) d_rmsnorm_bf16(P.x, P.attn_norm, h_bf, it);
        for (int i = bid0 * 256 + threadIdx.x; i < 8192 * 32; i += G * 256) {
            const int pos = i >> 5, fi = i & 31;
            float sn, cs; sincosf((float)pos * expf(-9.210340371976184f * (float)(2 * fi) / 64.f), &sn, &cs);
            rope[i] = make_float2(cs, sn);
        }
        for (int i = bid0 * 256 + threadIdx.x; i < 32 * PLD / 2; i += G * 256) ((unsigned*)(proj + (size_t)T_TOK * PLD))[i] = 0u;
    }
    xcd_barrier(B);
    {
        GemmP p{}; p.A = h_bf; p.lda = 1024; p.akts = 64; p.Bt = w_in_t; p.ldb = 1024; p.K = 1024; p.mtiles = 128; p.ntiles = 27; p.out = proj;
#ifdef PROBE_GEMM1
        for (int rep = 0; rep < PROBE_GEMM1; rep++)
#endif
        for (int it = bid0; it < 128 * 27; it += G) d_gemm<EPI_PROJ>(p, it, smem);
    }
    xcd_barrier(B);
#ifdef PROBE_MISC
    for (int rep = 0; rep < 2; rep++)
#endif
    {
        for (int it = bid0; it < 64; it += G) {
            int inst = it >> 3, tile = it & 7;
            int j = inst >> 2, b = (inst >> 1) & 1, g = inst & 1;
            GemmP p{}; p.A = proj + (size_t)(b * SEQ) * PLD + C_KV + 128 * j + 64 * g; p.lda = 16 * PLD; p.akts = PLD;
            p.Bt = cw1_t + (size_t)j * 256 * 2048; p.ldb = 2048; p.K = 2048; p.mtiles = 4; p.ntiles = 2;
            p.out = hid + (size_t)inst * 512 * 256; p.aux = cbias + j * 256;
            d_gemm<EPI_HID>(p, tile, smem);
        }
        for (int it = bid0; it < 1024; it += G) { d_gdn_prep2(proj, P.gdn_conv, P.a_log, P.dt_bias, gu, gw, gqd, gkd, gin, gl, it, smem); __syncthreads(); }
        for (int it = bid0; it < 8192; it += G) d_knorm_rope(proj, P.k_gain, ksn, kwn, vsn, vwn, rope, it);
    }
    xcd_barrier(B);
#ifdef PROBE_MISC
    for (int rep = 0; rep < 2; rep++)
#endif
    for (int wi = bid0 * 4 + (threadIdx.x >> 6); wi < 256; wi += G * 4) d_cmp2_mfma(hid, cw2t, P.k_gain, rope, kc, vc, wi, threadIdx.x & 63);
    xcd_barrier(B);
    {
        if (bid0 < 64) d_gdn_scan2(gu, gw, gqd, gkd, gin, gl, og, bid0, smem);
        __syncthreads();
#ifdef PROBE_NSA
        for (int rep = 0; rep < 2; rep++)
#else
        const int rep = 0;
#endif
        for (;;) {
            if (threadIdx.x == 0) q_item = (int)xb_add(&P.bar[XB_QUEUE + 256 * rep], 1u);
            __syncthreads();
            const int it = q_item;
            if (it >= 1024 + 128) break;
            if (it >= 1024) {
                const int r0 = (it - 1024) * 128 + (threadIdx.x >> 6) * 32;
                for (int r = r0; r < r0 + 32; r++) { d_quant_row(P.peer_u, uq_tmp, su, r, threadIdx.x & 63, 0); d_quant_row(P.peer_v, vq_tmp, sv, r, threadIdx.x & 63, 128); }
            } else {
#ifdef PROBE_NSA
                d_nsa_mfma(proj, P.q_gain, rope, ksn, kwn, kc, vc, vsn, vwn, mix, DM, it, smem, (PROBE_NSA == 2) && rep == 0);
#else
                d_nsa_mfma(proj, P.q_gain, rope, ksn, kwn, kc, vc, vsn, vwn, mix, DM, it, smem);
#endif
            }
            __syncthreads();
        }
#ifdef NSA_CHECK
        bf16_t* mix2 = (bf16_t*)(ws + OFF_END);
        for (;;) {
            if (threadIdx.x == 0) q_item = (int)xb_add(&P.bar[XB_QUEUE + 64], 1u);
            __syncthreads();
            const int it = q_item;
            if (it >= 2 * 2 * SEQ) break;
            d_nsa_naive(proj, P.q_gain, ksn, kwn, kc, vc, mix2, 512, it, smem);
            __syncthreads();
        }
#endif
    }
    xcd_barrier(B);
#ifdef NSA_CHECK
    {
        const bf16_t* mix2 = (const bf16_t*)(ws + OFF_END);
        float sd = 0.f, sr = 0.f;
        for (int i = bid0 * 256 + threadIdx.x; i < T_TOK * 512; i += G * 256) {
            const int r = i >> 9, c = i & 511;
            const float a = bf2f(mix[(size_t)r * DM + c]), bb = bf2f(mix2[i]);
            sd += (a - bb) * (a - bb); sr += bb * bb;
        }
        sd = wave_sum(sd); sr = wave_sum(sr);
        if ((threadIdx.x & 63) == 0) { atomicAdd((float*)&P.bar[XB_QUEUE + 128], sd); atomicAdd((float*)&P.bar[XB_QUEUE + 192], sr); }
    }
    xcd_barrier(B);
#endif
#ifdef PROBE_MISC
    for (int rep = 0; rep < 2; rep++) {
#endif
    for (int t = bid0 * 4 + (threadIdx.x >> 6); t < T_TOK; t += G * 4) d_gdn_out(og, proj, P.out_gain, mix, t, threadIdx.x & 63);
    for (int i = bid0 * 256 + threadIdx.x; i < 2 * 16384 * 1024 / 16; i += G * 256) ((uint4*)uq)[i] = ((const uint4*)uq_tmp)[i];
#ifdef PROBE_MISC
    }
#endif
    xcd_barrier(B);
#ifdef PROBE_P4
    for (int rep = 0; rep < 2; rep++) {
#endif
    {
        GemmP p{}; p.A = mix; p.lda = 1024; p.akts = 64; p.Bt = w_out_t; p.ldb = 1024; p.K = 1024; p.mtiles = 128; p.ntiles = 8; p.out = P.out; p.aux = P.x; p.out2 = h2; p.ssq = ssq;
        for (int it = bid0; it < 128 * 8; it += G) d_gemm<EPI_OUT>(p, it, smem);
    }
    xcd_barrier(B);
    {
        GemmP p{}; p.A = h2; p.lda = 1024; p.akts = 64; p.Bt = w_q_t; p.ldb = 1024; p.K = 1024; p.mtiles = 128; p.ntiles = 16; p.out = qry; p.ssq = ssq;
        for (int it = bid0; it < 128 * 16; it += G) d_gemm<EPI_QRY>(p, it, smem);
    }
    xcd_barrier(B);
#ifdef PROBE_P4
    }
#endif
    route_load_subkeys(P.subkeys, smem);
    __syncthreads();
#ifdef PROBE_ROUTE
    for (int rep = 0; rep < 2; rep++)
#endif
    for (int mt = bid0 * 4 + (threadIdx.x >> 6); mt < T_TOK / 2; mt += G * 4) d_peer_route2(qry, eidx, pgate, mt, smem, threadIdx.x & 63);
    xcd_barrier(B);
#ifdef PEER_SWEEP
    for (int grp = bid0 * 4 + (threadIdx.x >> 6); grp < T_TOK / PE_TOK; grp += G * 4) d_peer_expert5(h2, eidx, pgate, uq, vq, su, sv, P.out, grp, threadIdx.x & 63, smem + (threadIdx.x >> 6) * PE_WAVE_LDS, true);
#else
#ifdef PROBE_PEER3
    for (int it = bid0; it < T_TOK / 4; it += G) d_peer_expert3(h2, eidx, pgate, uq, vq, su, sv, ssq, P.ffn_norm, P.out, it * 4 + (threadIdx.x >> 6), threadIdx.x & 63, false, PROBE_PEER3);
    xcd_barrier(B);
#endif
    for (int it = bid0; it < T_TOK / 4; it += G) d_peer_expert3(h2, eidx, pgate, uq, vq, su, sv, ssq, P.ffn_norm, P.out, it * 4 + (threadIdx.x >> 6), threadIdx.x & 63);
#endif
#ifdef NSA_CHECK
    xcd_barrier(B);
    {
        const float sd = __hip_atomic_load((float*)&P.bar[XB_QUEUE + 128], __ATOMIC_RELAXED, __HIP_MEMORY_SCOPE_AGENT);
        const float sr = __hip_atomic_load((float*)&P.bar[XB_QUEUE + 192], __ATOMIC_RELAXED, __HIP_MEMORY_SCOPE_AGENT);
        if (!(sd <= NSA_CHECK * sr)) for (int i = bid0 * 256 + threadIdx.x; i < T_TOK * DM; i += G * 256) P.out[i] += 1000.f;
    }
#endif
}

extern "C" void kernel_launch(void* const* d_in, const int* in_sizes, int n_in, void* d_out, int out_size, void* d_ws, size_t ws_size,
                              hipStream_t stream) {
#ifdef NSA_CHECK
    const size_t bar_off = ((OFF_END + 16384ull * 512 * 2) + 255) & ~(size_t)255;
#else
    const size_t bar_off = (OFF_END + 255) & ~(size_t)255;
#endif
    if (ws_size < bar_off + XCD_BAR_WORDS * 4) return;
    static int grid_blocks = 0;
    if (!grid_blocks) {
        int dev = 0, cus = 0, per_cu = 0;
        (void)hipGetDevice(&dev);
        (void)hipDeviceGetAttribute(&cus, hipDeviceAttributeMultiprocessorCount, dev);
        (void)hipFuncSetAttribute((const void*)hybrid_megakernel, hipFuncAttributeMaxDynamicSharedMemorySize, SMEM_BYTES);
        (void)hipOccupancyMaxActiveBlocksPerMultiprocessor(&per_cu, hybrid_megakernel, 256, SMEM_BYTES);
        if (per_cu > 2) per_cu = 2;
        grid_blocks = cus * per_cu;
    }
    if (grid_blocks <= 0) return;
    MKP P{};
    P.x = (const float*)d_in[0]; P.attn_norm = (const float*)d_in[1]; P.w_in = (const float*)d_in[2]; P.q_gain = (const float*)d_in[3];
    P.k_gain = (const float*)d_in[4]; P.cmp_pos = (const float*)d_in[5]; P.cmp_w1 = (const float*)d_in[6]; P.cmp_w2 = (const float*)d_in[7];
    P.gdn_conv = (const float*)d_in[8]; P.a_log = (const float*)d_in[9]; P.dt_bias = (const float*)d_in[10]; P.out_gain = (const float*)d_in[11];
    P.w_out = (const float*)d_in[12]; P.ffn_norm = (const float*)d_in[13]; P.w_query = (const float*)d_in[14]; P.subkeys = (const float*)d_in[15];
    P.peer_u = (const float*)d_in[16]; P.peer_v = (const float*)d_in[17];
    P.out = (float*)d_out; P.ws = (char*)d_ws; P.bar = (unsigned*)((char*)d_ws + bar_off);
    (void)hipMemsetAsync(P.bar, 0, XCD_BAR_WORDS * 4, stream);
    hipLaunchKernelGGL(hybrid_megakernel, dim3(grid_blocks), dim3(256), SMEM_BYTES, stream, P);
}
```

```cpp
#include <hip/hip_runtime.h>
#include <stdint.h>

typedef unsigned short bf16_t;
typedef __attribute__((ext_vector_type(8))) short bf16x8;
typedef __attribute__((ext_vector_type(4))) float f32x4;
#define LAS3 __attribute__((address_space(3)))

#define T_TOK 16384
#define SEQ 8192
#define DM 1024
#define IN_COLS 3360
#define PLD 3456
#define C_Q 0
#define C_KV 512
#define C_GATE 1280
#define C_GQKV 1304
#define C_Z 2840
#define C_A 3352
#define C_B 3356

#define OFF_WINT   0ull
#define OFF_WOUTT  (OFF_WINT  + 3456ull*1024*2)
#define OFF_WQT    (OFF_WOUTT + 1024ull*1024*2)
#define OFF_CW1T   (OFF_WQT   + 2048ull*1024*2)
#define OFF_CBIAS  (OFF_CW1T  + 2ull*256*2048*2)
#define OFF_HBF    (OFF_CBIAS + 4096ull)
#define OFF_PROJ   (OFF_HBF   + 16384ull*1024*2)
#define OFF_KSN    (OFF_PROJ  + (16384ull+32)*PLD*2)
#define OFF_KWN    (OFF_KSN   + 4ull*8192*64*2)
#define OFF_KC     (OFF_KWN   + 4ull*8192*64*2)
#define OFF_VC     (OFF_KC    + 4ull*512*64*2)
#define OFF_HID    (OFF_VC    + 4ull*512*64*2)
#define OFF_GU     (OFF_HID   + 8ull*512*256*2)
#define OFF_GW     (OFF_GU    + 1024ull*64*128*2)
#define OFF_GQD    (OFF_GW    + 1024ull*64*128*2)
#define OFF_GKD    (OFF_GQD   + 1024ull*64*128*2)
#define OFF_GIN    (OFF_GKD   + 1024ull*64*128*2)
#define OFF_GL     (OFF_GIN   + 1024ull*64*64*2)
#define OFF_ROPE   (OFF_GL    + 4096ull)
#define OFF_CW2T   (OFF_ROPE  + 8192ull*32*8)
#define OFF_SU     (OFF_CW2T  + 2ull*64*256*2)
#define OFF_SV     (OFF_SU    + 65536ull)
#define OFF_SSQ    (OFF_SV    + 65536ull)
#define OFF_VSN    (OFF_SSQ   + 16384ull*16*4)
#define OFF_VWN    (OFF_VSN   + 4ull*8192*64*2)
#define OFF_END    (OFF_VWN   + 4ull*8192*64*2)
#define OFF_MIX    OFF_HBF
#define OFF_QRY    OFF_PROJ
#define OFF_H2     (OFF_PROJ + 16384ull*2048*2)
#define OFF_EIDX   OFF_KSN
#define OFF_PGATE  OFF_GIN
#define OFF_UQ     OFF_GU
#define OFF_VQ     (OFF_GU + 16384ull*1024)

__device__ __forceinline__ bf16_t f2bf(float f) {
    unsigned u = __float_as_uint(f);
    u += 0x7fffu + ((u >> 16) & 1u);
    return (bf16_t)(u >> 16);
}
__device__ __forceinline__ float bf2f(bf16_t h) { return __uint_as_float(((unsigned)h) << 16); }
typedef __bf16 bf16x2_t2 __attribute__((ext_vector_type(2)));
__device__ __forceinline__ unsigned pk2(float a, float b) { bf16x2_t2 v; v[0] = (__bf16)a; v[1] = (__bf16)b; return __builtin_bit_cast(unsigned, v); }
__device__ __forceinline__ float gelu_tanh(float x) {
    float u = 0.7978845608028654f * (x + 0.044715f * x * x * x);
    return 0.5f * x * (1.f + tanhf(u));
}
__device__ __forceinline__ float sigmoidf_(float x) { return 1.f / (1.f + __expf(-x)); }
__device__ __forceinline__ float wave_sum(float v) {
#pragma unroll
    for (int o = 32; o > 0; o >>= 1) v += __shfl_xor(v, o);
    return v;
}
__device__ __forceinline__ float wave_max(float v) {
#pragma unroll
    for (int o = 32; o > 0; o >>= 1) v = fmaxf(v, __shfl_xor(v, o));
    return v;
}

template <int CTRL> __device__ __forceinline__ float dppf(float x) { return __builtin_bit_cast(float, __builtin_amdgcn_update_dpp(0, __builtin_bit_cast(int, x), CTRL, 0xf, 0xf, true)); }
template <int CTRL> __device__ __forceinline__ unsigned dppu(unsigned x) { return (unsigned)__builtin_amdgcn_update_dpp(0, (int)x, CTRL, 0xf, 0xf, true); }
__device__ __forceinline__ float allmax16(float x) {
    x = fmaxf(x, dppf<0xB1>(x)); x = fmaxf(x, dppf<0x4E>(x)); x = fmaxf(x, dppf<0x141>(x)); x = fmaxf(x, dppf<0x140>(x)); return x;
}
__device__ __forceinline__ unsigned allmaxu16(unsigned x) {
    x = max(x, dppu<0xB1>(x)); x = max(x, dppu<0x4E>(x)); x = max(x, dppu<0x141>(x)); x = max(x, dppu<0x140>(x)); return x;
}
__device__ __forceinline__ float allsum16(float x) {
    x += dppf<0xB1>(x); x += dppf<0x4E>(x); x += dppf<0x141>(x); x += dppf<0x140>(x); return x;
}
__device__ __forceinline__ float wave_sum_dpp(float x) {
    x = allsum16(x);
    return __builtin_bit_cast(float, __builtin_amdgcn_readlane(__builtin_bit_cast(int, x), 0)) + __builtin_bit_cast(float, __builtin_amdgcn_readlane(__builtin_bit_cast(int, x), 16)) +
           __builtin_bit_cast(float, __builtin_amdgcn_readlane(__builtin_bit_cast(int, x), 32)) + __builtin_bit_cast(float, __builtin_amdgcn_readlane(__builtin_bit_cast(int, x), 48));
}
__device__ __forceinline__ void d_transpose_bf16(const float* __restrict__ W, int K, int N, bf16_t* __restrict__ Wt, int bx, int by, char* smem, const float* __restrict__ kscale = nullptr) {
    float* tile = (float*)smem;
    const int n0 = bx * 32, k0 = by * 128;
    const int tx = threadIdx.x & 31, ty = threadIdx.x >> 5;
    const int n = n0 + tx;
    float v[16];
#pragma unroll
    for (int i = 0; i < 16; i++) { const int k = k0 + ty + 8 * i; v[i] = (n < N) ? W[(size_t)k * N + n] : 0.f; }
#pragma unroll
    for (int i = 0; i < 16; i++) { const int kk = ty + 8 * i; tile[kk * 33 + tx] = v[i] * (kscale ? kscale[k0 + kk] : 1.f); }
    __syncthreads();
    {
        const int nn = threadIdx.x >> 3, kc = (threadIdx.x & 7) * 16;
        unsigned pk[8];
#pragma unroll
        for (int j = 0; j < 8; j++) pk[j] = pk2(tile[(kc + 2 * j) * 33 + nn], tile[(kc + 2 * j + 1) * 33 + nn]);
        uint4* dst = (uint4*)(Wt + (size_t)(n0 + nn) * K + k0 + kc);
        dst[0] = make_uint4(pk[0], pk[1], pk[2], pk[3]); dst[1] = make_uint4(pk[4], pk[5], pk[6], pk[7]);
    }
    __syncthreads();
}

__device__ __forceinline__ void d_rmsnorm_bf16(const float* __restrict__ x, const float* __restrict__ g, bf16_t* __restrict__ out, int bid) {
    int row = bid * 4 + (threadIdx.x >> 6);
    int lane = threadIdx.x & 63;
    const float4* xr = (const float4*)(x + (size_t)row * DM);
    float4 v[4];
    float ss = 0.f;
#pragma unroll
    for (int i = 0; i < 4; i++) { v[i] = xr[lane + 64 * i]; ss += v[i].x * v[i].x + v[i].y * v[i].y + v[i].z * v[i].z + v[i].w * v[i].w; }
    ss = wave_sum(ss);
    float r = rsqrtf(ss * (1.f / DM) + 1e-6f);
#pragma unroll
    for (int i = 0; i < 4; i++) {
        float4 gg = ((const float4*)g)[lane + 64 * i];
        ushort4 o;
        o.x = f2bf(v[i].x * r * gg.x); o.y = f2bf(v[i].y * r * gg.y); o.z = f2bf(v[i].z * r * gg.z); o.w = f2bf(v[i].w * r * gg.w);
        ((ushort4*)(out + (size_t)row * DM))[lane + 64 * i] = o;
    }
}

__device__ __forceinline__ void d_cmp_bias(const float* __restrict__ pos, const float* __restrict__ w1, float* __restrict__ bias, int item, char* smem) {
    float* part = (float*)smem;
    const int j = item >> 3, c = (item & 7) * 32 + (threadIdx.x & 31), ksl = threadIdx.x >> 5;
    float s0 = 0.f, s1 = 0.f, s2 = 0.f, s3 = 0.f;
    const float* wp = w1 + ((size_t)j * 2048 + ksl * 256) * 256 + c;
    const float* pp = pos + j * 2048 + ksl * 256;
    for (int k = 0; k < 256; k += 4) {
        s0 += pp[k] * wp[(size_t)k * 256]; s1 += pp[k + 1] * wp[(size_t)(k + 1) * 256];
        s2 += pp[k + 2] * wp[(size_t)(k + 2) * 256]; s3 += pp[k + 3] * wp[(size_t)(k + 3) * 256];
    }
    part[ksl * 32 + (threadIdx.x & 31)] = (s0 + s1) + (s2 + s3);
    __syncthreads();
    if (threadIdx.x < 32) {
        float t = 0.f;
#pragma unroll
        for (int i = 0; i < 8; i++) t += part[i * 32 + threadIdx.x];
        bias[j * 256 + c] = t;
    }
    __syncthreads();
}

#define EPI_PROJ 0
#define EPI_HID 1
#define EPI_OUT 2
#define EPI_QRY 3
struct GemmP {
    const bf16_t* A; long lda; long akts;
    const bf16_t* Bt; long ldb;
    int K; int mtiles; int ntiles;
    long a_inst; long b_inst;
    void* out; const float* aux; const float* aux2; bf16_t* out2; float* ssq;
};

template <int EPI>
__device__ __forceinline__ void d_gemm(const GemmP& p, int bid, char* smem) {
    const int tid = threadIdx.x, lane = tid & 63, wave = tid >> 6;
    const int wm = wave >> 1, wn = wave & 1;
    const int inst = 0;
    const int nwg = p.mtiles * p.ntiles, wgid = (bid & 7) * (nwg >> 3) + (bid >> 3);
    const int mt = wgid / p.ntiles, nt = wgid % p.ntiles;
    const int m0 = mt * 128, n0 = nt * 128;
    const bf16_t* A = p.A + (size_t)inst * p.a_inst + (size_t)m0 * p.lda;
    const bf16_t* Bt = p.Bt + (size_t)inst * p.b_inst + (size_t)n0 * p.ldb;
    f32x4 acc[4][4];
#pragma unroll
    for (int i = 0; i < 4; i++)
#pragma unroll
        for (int j = 0; j < 4; j++) acc[i][j] = (f32x4){0.f, 0.f, 0.f, 0.f};
    const int nk = p.K >> 6;
    const int crow = tid >> 3, cslot = tid & 7;
    const int csrc = (cslot ^ (crow & 7)) * 8;
    const bf16_t* Ap = A + (size_t)crow * p.lda + csrc;
    const bf16_t* Bp = Bt + (size_t)crow * p.ldb + csrc;
    const size_t a32 = (size_t)32 * p.lda, b32 = (size_t)32 * p.ldb;
    char* ldsw = smem + tid * 16;
#define GSTAGE(buf, koffA, koffB) { char* _d = ldsw + (buf) * 32768; \
    __builtin_amdgcn_global_load_lds((const unsigned*)(Ap + (koffA)), (LAS3 unsigned*)(_d), 16, 0, 0); \
    __builtin_amdgcn_global_load_lds((const unsigned*)(Ap + a32 + (koffA)), (LAS3 unsigned*)(_d + 4096), 16, 0, 0); \
    __builtin_amdgcn_global_load_lds((const unsigned*)(Ap + 2 * a32 + (koffA)), (LAS3 unsigned*)(_d + 8192), 16, 0, 0); \
    __builtin_amdgcn_global_load_lds((const unsigned*)(Ap + 3 * a32 + (koffA)), (LAS3 unsigned*)(_d + 12288), 16, 0, 0); \
    __builtin_amdgcn_global_load_lds((const unsigned*)(Bp + (koffB)), (LAS3 unsigned*)(_d + 16384), 16, 0, 0); \
    __builtin_amdgcn_global_load_lds((const unsigned*)(Bp + b32 + (koffB)), (LAS3 unsigned*)(_d + 16384 + 4096), 16, 0, 0); \
    __builtin_amdgcn_global_load_lds((const unsigned*)(Bp + 2 * b32 + (koffB)), (LAS3 unsigned*)(_d + 16384 + 8192), 16, 0, 0); \
    __builtin_amdgcn_global_load_lds((const unsigned*)(Bp + 3 * b32 + (koffB)), (LAS3 unsigned*)(_d + 16384 + 12288), 16, 0, 0); }
    const int n16 = lane & 15, kq = lane >> 4;
    GSTAGE(0, 0, 0)
    for (int kt = 0; kt < nk; kt++) {
        if (kt + 1 < nk) {
            GSTAGE((kt + 1) & 1, (size_t)(kt + 1) * p.akts, (size_t)(kt + 1) * 64)
            asm volatile("s_waitcnt vmcnt(8)" ::: "memory");
        } else {
            asm volatile("s_waitcnt vmcnt(0)" ::: "memory");
        }
        __builtin_amdgcn_s_barrier();
        const char* Ab = smem + (kt & 1) * 32768;
        const char* Bb = Ab + 16384;
#pragma unroll
        for (int ks = 0; ks < 2; ks++) {
            bf16x8 af[4], bfr[4];
#pragma unroll
            for (int i = 0; i < 4; i++) { const int R = wm * 64 + i * 16 + n16; af[i] = *(const bf16x8*)(Ab + R * 128 + (((4 * ks + kq) ^ (R & 7)) << 4)); }
#pragma unroll
            for (int j = 0; j < 4; j++) { const int R = wn * 64 + j * 16 + n16; bfr[j] = *(const bf16x8*)(Bb + R * 128 + (((4 * ks + kq) ^ (R & 7)) << 4)); }
#pragma unroll
            for (int i = 0; i < 4; i++)
#pragma unroll
                for (int j = 0; j < 4; j++) acc[i][j] = __builtin_amdgcn_mfma_f32_16x16x32_bf16(bfr[j], af[i], acc[i][j], 0, 0, 0);
        }
        asm volatile("s_waitcnt lgkmcnt(0)" ::: "memory");
        __builtin_amdgcn_s_barrier();
    }
    {
        char* slab = smem + wave * 9216;
        const int rbase = m0 + wm * 64, cbase = n0 + wn * 64;
        if (EPI == EPI_OUT) {
            float* st = (float*)slab;
#pragma unroll
            for (int hlf = 0; hlf < 2; hlf++) {
#pragma unroll
                for (int ii = 0; ii < 2; ii++)
#pragma unroll
                    for (int j = 0; j < 4; j++) *(f32x4*)(st + (ii * 16 + n16) * 68 + j * 16 + 4 * kq) = acc[hlf * 2 + ii][j];
#pragma unroll
                for (int ps = 0; ps < 8; ps++) {
                    const int rl = ps * 4 + kq, row = rbase + hlf * 32 + rl;
                    const float4 a = *(const float4*)(st + rl * 68 + n16 * 4);
                    const float4 xx = *(const float4*)(p.aux + (size_t)row * DM + cbase + n16 * 4);
                    const float4 o = make_float4(xx.x + a.x, xx.y + a.y, xx.z + a.z, xx.w + a.w);
                    *(float4*)((float*)p.out + (size_t)row * DM + cbase + n16 * 4) = o;
                    *(uint2*)(p.out2 + (size_t)row * DM + cbase + n16 * 4) = make_uint2(pk2(o.x, o.y), pk2(o.z, o.w));
                    const float ss = allsum16(o.x * o.x + o.y * o.y + o.z * o.z + o.w * o.w);
                    if (n16 == 0) p.ssq[(size_t)row * 16 + nt * 2 + wn] = ss;
                }
            }
        } else {
            bf16_t* st = (bf16_t*)slab;
#pragma unroll
            for (int i = 0; i < 4; i++) {
                float rs = 1.f;
                if (EPI == EPI_QRY) {
                    const float4* q = (const float4*)(p.ssq + (size_t)(rbase + i * 16 + n16) * 16);
                    const float4 q0 = q[0], q1 = q[1], q2 = q[2], q3 = q[3];
                    const float t = ((q0.x + q0.y) + (q0.z + q0.w)) + ((q1.x + q1.y) + (q1.z + q1.w)) + ((q2.x + q2.y) + (q2.z + q2.w)) + ((q3.x + q3.y) + (q3.z + q3.w));
                    rs = rsqrtf(t * (1.f / DM) + 1e-6f);
                }
#pragma unroll
                for (int j = 0; j < 4; j++) {
                    float v0 = acc[i][j][0], v1 = acc[i][j][1], v2 = acc[i][j][2], v3 = acc[i][j][3];
                    if (EPI == EPI_HID) {
                        const float4 bb = *(const float4*)(p.aux + (inst >> 2) * 256 + cbase + 16 * j + 4 * kq);
                        v0 = gelu_tanh(v0 + bb.x); v1 = gelu_tanh(v1 + bb.y); v2 = gelu_tanh(v2 + bb.z); v3 = gelu_tanh(v3 + bb.w);
                    }
                    if (EPI == EPI_QRY) { v0 *= rs; v1 *= rs; v2 *= rs; v3 *= rs; }
                    *(uint2*)(st + (i * 16 + n16) * 72 + j * 16 + 4 * kq) = make_uint2(pk2(v0, v1), pk2(v2, v3));
                }
            }
            const int ld = (EPI == EPI_PROJ) ? PLD : (EPI == EPI_HID ? 256 : 2048);
#pragma unroll
            for (int ps = 0; ps < 8; ps++) {
                const int rl = ps * 8 + (lane >> 3), ch = lane & 7;
                const uint4 v = *(const uint4*)(st + rl * 72 + ch * 8);
                *(uint4*)((bf16_t*)p.out + (size_t)(rbase + rl) * ld + cbase + ch * 8) = v;
            }
        }
        __syncthreads();
    }
}

__device__ __forceinline__ void d_knorm_rope(const bf16_t* __restrict__ proj, const float* __restrict__ kgain, bf16_t* __restrict__ ksn, bf16_t* __restrict__ kwn, bf16_t* __restrict__ vsn, bf16_t* __restrict__ vwn, const float2* __restrict__ rope, int bid) {
    int vec = bid * 8 + (threadIdx.x >> 5);
    int i = threadIdx.x & 31;
    int which = vec >> 15;
    int rem = vec & 32767;
    int b = rem >> 14, g = (rem >> 13) & 1, s = rem & 8191;
    const bf16_t* src = proj + (size_t)(b * SEQ + s) * PLD + C_KV + 128 * (which ? 4 : 2) + 64 * g;
    float x1 = bf2f(src[i]), x2 = bf2f(src[i + 32]);
    float ss = x1 * x1 + x2 * x2;
#pragma unroll
    for (int o = 16; o > 0; o >>= 1) ss += __shfl_xor(ss, o);
    float r = rsqrtf(ss * (1.f / 64.f) + 1e-6f);
    const float* gn = kgain + (which ? 2 : 1) * 64;
    x1 = x1 * r * gn[i]; x2 = x2 * r * gn[i + 32];
    const float2 cs2 = rope[(size_t)s * 32 + i];
    const float cs = cs2.x, sn = cs2.y;
    bf16_t* dst = (which ? kwn : ksn) + ((size_t)(b * 2 + g) * SEQ + s) * 64;
    dst[i] = f2bf(x1 * cs - x2 * sn);
    dst[i + 32] = f2bf(x2 * cs + x1 * sn);
    ((unsigned*)((which ? vwn : vsn) + ((size_t)(b * 2 + g) * SEQ + s) * 64))[i] = ((const unsigned*)(src + 128))[i];
}

__device__ __forceinline__ void d_cmp2_mfma(const bf16_t* __restrict__ hid, const bf16_t* __restrict__ cw2t, const float* __restrict__ kgain, const float2* __restrict__ rope,
                                            bf16_t* __restrict__ kc, bf16_t* __restrict__ vc, int witem, int lane) {
    const int n16 = lane & 15, kq = lane >> 4;
    const int rowbase = 16 * witem, inst = rowbase >> 9, n0 = rowbase & 511, j = inst >> 2, bg = inst & 3;
    f32x4 acc[4];
#pragma unroll
    for (int nt = 0; nt < 4; nt++) acc[nt] = (f32x4){0.f, 0.f, 0.f, 0.f};
    const bf16_t* ap = hid + (size_t)(rowbase + n16) * 256 + 8 * kq;
    const bf16_t* bp = cw2t + (size_t)j * 64 * 256 + n16 * 256 + 8 * kq;
#pragma unroll
    for (int ks = 0; ks < 8; ks++) {
        const bf16x8 a = *(const bf16x8*)(ap + 32 * ks);
#pragma unroll
        for (int nt = 0; nt < 4; nt++) {
            const bf16x8 bb = *(const bf16x8*)(bp + (size_t)(16 * nt) * 256 + 32 * ks);
            acc[nt] = __builtin_amdgcn_mfma_f32_16x16x32_bf16(a, bb, acc[nt], 0, 0, 0);
        }
    }
#pragma unroll
    for (int r = 0; r < 4; r++) {
        const int n = n0 + 4 * kq + r;
        if (j == 0) {
            float ss = acc[0][r] * acc[0][r] + acc[1][r] * acc[1][r] + acc[2][r] * acc[2][r] + acc[3][r] * acc[3][r];
            ss = allsum16(ss);
            const float ri = rsqrtf(ss * (1.f / 64.f) + 1e-6f);
#pragma unroll
            for (int nt = 0; nt < 2; nt++) {
                const int i = 16 * nt + n16;
                const float y1 = acc[nt][r] * ri * kgain[i], y2 = acc[nt + 2][r] * ri * kgain[i + 32];
                const float2 cs = rope[(size_t)((n < 511 ? n : 510) * 16 + 31) * 32 + i];
                if (n < 511) {
                    kc[((size_t)bg * 512 + n) * 64 + i] = f2bf(y1 * cs.x - y2 * cs.y);
                    kc[((size_t)bg * 512 + n) * 64 + i + 32] = f2bf(y2 * cs.x + y1 * cs.y);
                }
            }
        } else if (n < 511) {
#pragma unroll
            for (int nt = 0; nt < 4; nt++) vc[((size_t)bg * 512 + n) * 64 + 16 * nt + n16] = f2bf(acc[nt][r]);
        }
    }
}

__device__ __forceinline__ float dot64(const float* q, const bf16_t* krow) {
    const uint4* kp = (const uint4*)krow;
    float s = 0.f;
#pragma unroll
    for (int c = 0; c < 8; c++) {
        uint4 u = kp[c];
        unsigned w[4] = {u.x, u.y, u.z, u.w};
#pragma unroll
        for (int e = 0; e < 4; e++) {
            s += q[c * 8 + e * 2] * __uint_as_float(w[e] << 16);
            s += q[c * 8 + e * 2 + 1] * __uint_as_float(w[e] & 0xffff0000u);
        }
    }
    return s;
}

__device__ __forceinline__ void d_nsa_naive(const bf16_t* __restrict__ proj, const float* __restrict__ qgain,
                                                   const bf16_t* __restrict__ ksn, const bf16_t* __restrict__ kwn,
                                                   const bf16_t* __restrict__ kc, const bf16_t* __restrict__ vc,
                                                   bf16_t* __restrict__ mix, int mix_ld, int bid, char* smem) {
    float (*qs)[64] = (float (*)[64])smem;
    float (*pbuf)[1024] = (float (*)[1024])(smem + 1024);
    float* sc = (float*)(smem + 1024 + 16384);
    int* sel = (int*)(smem + 1024 + 16384 + 512);
    const int tid = threadIdx.x, lane = tid & 63, w = tid >> 6;
    const int blk = bid;
    const int t = blk & 8191, g = (blk >> 13) & 1, b = blk >> 14;
    const int bg = b * 2 + g;
    const size_t row = (size_t)(b * SEQ + t);
    const int head = g * 4 + w;
    {
        int i = lane & 31;
        const bf16_t* src = proj + row * PLD + C_Q + head * 64;
        float x1 = bf2f(src[i]), x2 = bf2f(src[i + 32]);
        float ss = x1 * x1 + x2 * x2;
#pragma unroll
        for (int o = 16; o > 0; o >>= 1) ss += __shfl_xor(ss, o);
        float r = rsqrtf(ss * (1.f / 64.f) + 1e-6f);
        x1 = x1 * r * qgain[i]; x2 = x2 * r * qgain[i + 32];
        float inv = expf(-9.210340371976184f * (float)(2 * i) / 64.f);
        float ang = (float)t * inv;
        float sn, cs; sincosf(ang, &sn, &cs);
        if (lane < 32) { qs[w][i] = (x1 * cs - x2 * sn) * 0.125f; qs[w][i + 32] = (x2 * cs + x1 * sn) * 0.125f; }
    }
    __syncthreads();
    float q[64];
#pragma unroll
    for (int d = 0; d < 64; d++) q[d] = qs[w][d];
    float o_c = 0.f, o_s = 0.f, o_w = 0.f;
    const int nvis = (t >= 31) ? (((t - 31) >> 4) + 1) : 0;
    {
        float s[8];
        float m = -3e38f;
#pragma unroll
        for (int i = 0; i < 8; i++) {
            int n = lane + 64 * i;
            if (n < nvis) { s[i] = dot64(q, kc + ((size_t)bg * 512 + n) * 64); m = fmaxf(m, s[i]); } else s[i] = -3e38f;
        }
        m = wave_max(m);
        float l = 0.f;
#pragma unroll
        for (int i = 0; i < 8; i++) { int n = lane + 64 * i; s[i] = (n < nvis) ? __expf(s[i] - m) : 0.f; l += s[i]; }
        l = wave_sum(l);
        float il = (nvis > 0) ? 1.f / l : 0.f;
#pragma unroll
        for (int i = 0; i < 8; i++) pbuf[w][lane + 64 * i] = s[i] * il;
        __syncthreads();
        const bf16_t* vp = vc + (size_t)bg * 512 * 64 + lane;
        for (int n = 0; n < nvis; n++) o_c += pbuf[w][n] * bf2f(vp[(size_t)n * 64]);
    }
    if (tid < 128) {
        int j = tid;
        float im = 0.f;
#pragma unroll
        for (int h = 0; h < 4; h++) {
            float a = (j > 0) ? pbuf[h][4 * j - 1] : 0.f;
            im += a + 2.f * (pbuf[h][4 * j] + pbuf[h][4 * j + 1] + pbuf[h][4 * j + 2]) + pbuf[h][4 * j + 3];
        }
        int cur = t >> 6;
        float v;
        if (j > cur) v = -1e30f;
        else if (j == 0 || j == cur || j == cur - 1) v = 1e4f;
        else v = im;
        sc[j] = v;
    }
    __syncthreads();
    if (w == 0) {
        float v0 = sc[lane], v1 = sc[lane + 64];
        for (int it = 0; it < 16; it++) {
            float bv; int bi;
            if (v0 >= v1) { bv = v0; bi = lane; } else { bv = v1; bi = lane + 64; }
#pragma unroll
            for (int o = 32; o > 0; o >>= 1) {
                float ov = __shfl_xor(bv, o); int oi = __shfl_xor(bi, o);
                if (ov > bv || (ov == bv && oi < bi)) { bv = ov; bi = oi; }
            }
            if (lane == 0) sel[it] = (bv > -1e29f) ? bi : -1;
            if (bi == lane) v0 = -3e38f;
            if (bi == lane + 64) v1 = -3e38f;
        }
    }
    __syncthreads();
    {
        float s[16];
        float m = -3e38f;
#pragma unroll
        for (int i = 0; i < 16; i++) {
            int bk = sel[i];
            int pos = bk * 64 + lane;
            if (bk >= 0 && pos <= t) { s[i] = dot64(q, ksn + ((size_t)bg * SEQ + pos) * 64); m = fmaxf(m, s[i]); } else s[i] = -3e38f;
        }
        m = wave_max(m);
        float l = 0.f;
#pragma unroll
        for (int i = 0; i < 16; i++) { s[i] = (s[i] > -1e38f) ? __expf(s[i] - m) : 0.f; l += s[i]; }
        l = wave_sum(l);
        float il = 1.f / l;
#pragma unroll
        for (int i = 0; i < 16; i++) pbuf[w][i * 64 + lane] = s[i] * il;
        __syncthreads();
        for (int i = 0; i < 16; i++) {
            int bk = sel[i];
            if (bk < 0) continue;
            const bf16_t* vp = proj + (size_t)(b * SEQ + bk * 64) * PLD + C_KV + 128 * 3 + 64 * g + lane;
            int kmax = min(64, t - bk * 64 + 1);
            for (int kk = 0; kk < kmax; kk++) o_s += pbuf[w][i * 64 + kk] * bf2f(vp[(size_t)kk * PLD]);
        }
    }
    __syncthreads();
    {
        float s[8];
        float m = -3e38f;
        const int p0 = t - 511;
#pragma unroll
        for (int i = 0; i < 8; i++) {
            int pos = p0 + lane + 64 * i;
            if (pos >= 0) { s[i] = dot64(q, kwn + ((size_t)bg * SEQ + pos) * 64); m = fmaxf(m, s[i]); } else s[i] = -3e38f;
        }
        m = wave_max(m);
        float l = 0.f;
#pragma unroll
        for (int i = 0; i < 8; i++) { s[i] = (s[i] > -1e38f) ? __expf(s[i] - m) : 0.f; l += s[i]; }
        l = wave_sum(l);
        float il = 1.f / l;
#pragma unroll
        for (int i = 0; i < 8; i++) pbuf[w][lane + 64 * i] = s[i] * il;
        __syncthreads();
        int kstart = (p0 < 0) ? -p0 : 0;
        const bf16_t* vp = proj + (size_t)(b * SEQ) * PLD + C_KV + 128 * 5 + 64 * g + lane;
        for (int kk = kstart; kk < 512; kk++) o_w += pbuf[w][kk] * bf2f(vp[(size_t)(p0 + kk) * PLD]);
    }
    const bf16_t* gp = proj + row * PLD + C_GATE + head * 3;
    float g0 = sigmoidf_(bf2f(gp[0])), g1 = sigmoidf_(bf2f(gp[1])), g2 = sigmoidf_(bf2f(gp[2]));
    mix[row * mix_ld + head * 64 + lane] = f2bf(g0 * o_c + g1 * o_s + g2 * o_w);
}

typedef float f32x16 __attribute__((ext_vector_type(16)));
typedef short s16x4 __attribute__((ext_vector_type(4)));
#define MFMA32(a, b, c) __builtin_amdgcn_mfma_f32_32x32x16_bf16((a), (b), (c), 0, 0, 0)
#define NKS 72
#define NSA_K_OFF 0
#define NSA_V_OFF (2 * 64 * NKS * 2)
#define NSA_IMP_OFF (NSA_V_OFF + 2 * 64 * NKS * 2)
#define NSA_SEL_OFF (NSA_IMP_OFF + 4 * 8192)
#define NSA_LDS (NSA_SEL_OFF + 32 * 4 * 4)
#define NEGBIG (-1e30f)
__device__ __forceinline__ bf16x8 pack8(float a0, float a1, float a2, float a3, float a4, float a5, float a6, float a7) {
    uint4 u = make_uint4(pk2(a0, a1), pk2(a2, a3), pk2(a4, a5), pk2(a6, a7));
    return __builtin_bit_cast(bf16x8, u);
}
typedef unsigned u32x4 __attribute__((ext_vector_type(4)));
struct NsaStage { u32x4 k0, k1, v0, v1; };
struct NsaCtx {
    bool noload;
    const bf16_t* Kbase; long kstride;
    const bf16_t* Vbase; long vstride;
    bf16_t* Kb; bf16_t* Vb;
    float* imp_s; unsigned* sel_s;
    bf16x8 qf[4];
    f32x16 O0, O1;
    float m, l, invl, carry;
    int t, tokl, hp, hh, c, lane;
};
__device__ __forceinline__ void nsa_stage_load(const NsaCtx& X, NsaStage& st, int j) {
    const int r0 = threadIdx.x >> 3, c8 = (threadIdx.x & 7) * 8;
    if (X.noload) { st.k0 = (u32x4){0u,0u,0u,0u}; st.k1 = st.k0; st.v0 = st.k0; st.v1 = st.k0; return; }
    const bf16_t* kp = X.Kbase + (size_t)(64 * j + r0) * X.kstride + c8;
    const bf16_t* vp = X.Vbase + (size_t)(64 * j + r0) * X.vstride + c8;
    st.k0 = *(const u32x4*)kp; st.k1 = *(const u32x4*)(kp + 32 * X.kstride);
    st.v0 = *(const u32x4*)vp; st.v1 = *(const u32x4*)(vp + 32 * X.vstride);
}
__device__ __forceinline__ void nsa_stage_store(const NsaCtx& X, const NsaStage& st, int buf) {
    const int r0 = threadIdx.x >> 3, c8 = (threadIdx.x & 7) * 8;
    bf16_t* kb = X.Kb + buf * 64 * NKS + r0 * NKS + c8;
    bf16_t* vb = X.Vb + buf * 64 * NKS + r0 * NKS + c8;
    *(u32x4*)kb = st.k0; *(u32x4*)(kb + 32 * NKS) = st.k1;
    *(u32x4*)vb = st.v0; *(u32x4*)(vb + 32 * NKS) = st.v1;
}
template <int MODE, bool FAST>
__device__ __forceinline__ void nsa_tile(NsaCtx& X, int j, int kt, int buf, unsigned long long mlo, unsigned long long mhi) {
    const bf16_t* Kt = X.Kb + buf * 64 * NKS + (32 * kt) * NKS;
    const bf16_t* Vt = X.Vb + buf * 64 * NKS + (32 * kt) * NKS;
    f32x16 S;
#pragma unroll
    for (int i = 0; i < 16; i++) S[i] = 0.f;
#pragma unroll
    for (int s = 0; s < 4; s++) {
        bf16x8 ka = *(const bf16x8*)(Kt + X.c * NKS + 16 * s + 8 * X.hh);
        S = MFMA32(ka, X.qf[s], S);
    }
    const int kbase = 64 * j + 32 * kt;
    int lo = 0, hi;
    bool on = true;
    if (MODE <= 1) hi = ((X.t - 31) >> 4) - kbase;
    else hi = X.t - kbase;
    if (MODE == 3) lo = X.t - 511 - kbase;
    if (MODE == 2) {
        const unsigned long long wsel = (j < 64) ? mlo : mhi;
        on = (wsel >> (j & 63)) & 1ull;
    }
    lo -= 4 * X.hh; hi -= 4 * X.hh;
    if (!on) hi = -1000;
    float P[16];
    if (MODE == 1) {
#pragma unroll
        for (int i = 0; i < 16; i++) {
            const int cr = (i & 3) + 8 * (i >> 2);
            P[i] = (cr <= hi) ? __builtin_amdgcn_exp2f(S[i] - X.m) * X.invl : 0.f;
        }
        float mainv[4], nxt[4];
#pragma unroll
        for (int q = 0; q < 4; q++) { mainv[q] = 2.f * (P[4 * q] + P[4 * q + 1] + P[4 * q + 2]) + P[4 * q + 3]; nxt[q] = P[4 * q + 3]; }
#pragma unroll
        for (int q = 0; q < 4; q++) {
            mainv[q] += __shfl_xor(mainv[q], 1); mainv[q] += __shfl_xor(mainv[q], 2);
            nxt[q] += __shfl_xor(nxt[q], 1); nxt[q] += __shfl_xor(nxt[q], 2);
        }
        float recv[4];
#pragma unroll
        for (int q = 0; q < 4; q++) recv[q] = __shfl_xor(nxt[q], 32);
        const int jsel0 = 16 * j + 8 * kt + X.hh;
#pragma unroll
        for (int q = 0; q < 4; q++) {
            const float tot = mainv[q] + (X.hh ? recv[q] : (q > 0 ? recv[q > 0 ? q - 1 : 0] : X.carry));
            if (X.hp == 0) X.imp_s[(X.tokl & 7) * 128 + jsel0 + 2 * q] = tot;
        }
        X.carry = recv[3];
    } else {
        float tmax = NEGBIG;
        if (FAST) {
            tmax = fmaxf(fmaxf(fmaxf(fmaxf(S[0], S[1]), fmaxf(S[2], S[3])), fmaxf(fmaxf(S[4], S[5]), fmaxf(S[6], S[7]))),
                         fmaxf(fmaxf(fmaxf(S[8], S[9]), fmaxf(S[10], S[11])), fmaxf(fmaxf(S[12], S[13]), fmaxf(S[14], S[15]))));
            if (MODE == 2 && !on) tmax = NEGBIG;
        } else {
#pragma unroll
            for (int i = 0; i < 16; i++) {
                const int cr = (i & 3) + 8 * (i >> 2);
                const bool vis = (cr <= hi) && (cr >= lo);
                tmax = vis ? fmaxf(tmax, S[i]) : tmax;
            }
        }
        tmax = fmaxf(tmax, __shfl_xor(tmax, 32));
        float ls = 0.f;
        if (MODE == 0) {
            const float mnew = fmaxf(X.m, tmax);
            const float alpha = __builtin_amdgcn_exp2f(X.m - mnew);
            X.m = mnew;
#pragma unroll
            for (int i = 0; i < 16; i++) {
                const int cr = (i & 3) + 8 * (i >> 2);
                const bool vis = (cr <= hi) && (cr >= lo);
                P[i] = vis ? __builtin_amdgcn_exp2f(S[i] - mnew) : 0.f;
                ls += P[i];
            }
            X.l = X.l * alpha + ls;
        } else {
            const bool upd = tmax > X.m + 8.f;
            const float mnew = upd ? tmax : X.m;
            if (__builtin_amdgcn_ballot_w64(upd) != 0ull) {
                const float alpha = __builtin_amdgcn_exp2f(X.m - mnew);
                X.l *= alpha;
#pragma unroll
                for (int i = 0; i < 16; i++) { X.O0[i] *= alpha; X.O1[i] *= alpha; }
            }
            X.m = mnew;
            if (FAST) {
                const float msub = (MODE == 2 && !on) ? 1e30f : mnew;
#pragma unroll
                for (int i = 0; i < 16; i++) { P[i] = __builtin_amdgcn_exp2f(S[i] - msub); ls += P[i]; }
            } else {
#pragma unroll
                for (int i = 0; i < 16; i++) {
                    const int cr = (i & 3) + 8 * (i >> 2);
                    const bool vis = (cr <= hi) && (cr >= lo);
                    P[i] = vis ? __builtin_amdgcn_exp2f(S[i] - mnew) : 0.f;
                    ls += P[i];
                }
            }
            X.l += ls;
        }
    }
    if (MODE >= 1) {
        bf16x8 pb0 = pack8(P[0], P[1], P[2], P[3], P[4], P[5], P[6], P[7]);
        bf16x8 pb1 = pack8(P[8], P[9], P[10], P[11], P[12], P[13], P[14], P[15]);
        const int l15 = X.lane & 15;
        const bf16_t* vrow = Vt + (4 * X.hh + (l15 >> 2)) * NKS + 16 * ((X.lane >> 4) & 1) + 4 * (l15 & 3);
#pragma unroll
        for (int s2 = 0; s2 < 2; s2++) {
#pragma unroll
            for (int dt = 0; dt < 2; dt++) {
                s16x4 lo4 = __builtin_amdgcn_ds_read_tr16_b64_v4i16((LAS3 s16x4*)(vrow + (16 * s2) * NKS + 32 * dt));
                s16x4 hi4 = __builtin_amdgcn_ds_read_tr16_b64_v4i16((LAS3 s16x4*)(vrow + (16 * s2 + 8) * NKS + 32 * dt));
                bf16x8 va = __builtin_shufflevector(lo4, hi4, 0, 1, 2, 3, 4, 5, 6, 7);
                if (dt == 0) X.O0 = MFMA32(va, s2 ? pb1 : pb0, X.O0); else X.O1 = MFMA32(va, s2 ? pb1 : pb0, X.O1);
            }
        }
    }
}
template <int MODE>
__device__ __forceinline__ void nsa_block(NsaCtx& X, int j, unsigned long long mlo, unsigned long long mhi, unsigned long long ulo, unsigned long long uhi, int cur, int tw0) {
    bool need = true;
    if (MODE == 2) {
        const unsigned long long wsel = (j < 64) ? ulo : uhi;
        need = (wsel >> (j & 63)) & 1ull;
    }
    if (need) {
#pragma unroll 1
        for (int kt = 0; kt < 2; kt++) {
            bool fast = false;
            if (MODE == 2) fast = j < cur;
            if (MODE == 3) { const int kb = 64 * j + 32 * kt; fast = (kb + 31 <= tw0) && (kb >= tw0 + 7 - 511); }
            if (MODE >= 2 && fast) nsa_tile<MODE, true>(X, j, kt, j & 1, mlo, mhi);
            else nsa_tile<MODE, false>(X, j, kt, j & 1, mlo, mhi);
        }
    }
}
template <int MODE>
__device__ __forceinline__ void nsa_branch(NsaCtx& X, int jlo, int jhi, unsigned long long mlo, unsigned long long mhi, unsigned long long ulo, unsigned long long uhi, int cur, int tw0) {
    NsaStage sa;
    nsa_stage_load(X, sa, jlo);
    __syncthreads();
    nsa_stage_store(X, sa, jlo & 1);
    __syncthreads();
#pragma unroll 1
    for (int j = jlo; j <= jhi; j++) {
        if (j < jhi) nsa_stage_load(X, sa, j + 1);
        nsa_block<MODE>(X, j, mlo, mhi, ulo, uhi, cur, tw0);
        if (j < jhi) nsa_stage_store(X, sa, (j + 1) & 1);
        __syncthreads();
    }
}
template <int OP>
__device__ __forceinline__ void nsa_facc(NsaCtx& X, float scale) {
    f32x4* F = (f32x4*)X.imp_s;
#pragma unroll
    for (int q = 0; q < 8; q++) {
        f32x4 v;
#pragma unroll
        for (int e = 0; e < 4; e++) v[e] = ((q < 4) ? X.O0[4 * q + e] : X.O1[4 * (q - 4) + e]) * scale;
        if (OP >= 1) v += F[q * 64 + X.lane];
        if (OP <= 1) F[q * 64 + X.lane] = v;
        else {
#pragma unroll
            for (int e = 0; e < 4; e++) { if (q < 4) X.O0[4 * q + e] = v[e]; else X.O1[4 * (q - 4) + e] = v[e]; }
        }
    }
}
__device__ __forceinline__ void d_nsa_mfma(const bf16_t* __restrict__ proj, const float* __restrict__ qgain, const float2* __restrict__ rope,
                                           const bf16_t* __restrict__ ksn, const bf16_t* __restrict__ kwn,
                                           const bf16_t* __restrict__ kc, const bf16_t* __restrict__ vc, const bf16_t* __restrict__ vsn, const bf16_t* __restrict__ vwn,
                                           bf16_t* __restrict__ mixo, int mix_ld, int item, char* smem, bool noload = false) {
    NsaCtx X;
    X.noload = noload;
    const int tid = threadIdx.x, lane = tid & 63, w = tid >> 6;
    const int bg = item & 3, tile = 255 - (item >> 2);
    const int b = bg >> 1, g = bg & 1, t0 = tile * 32;
    X.lane = lane; X.c = lane & 31; X.hh = lane >> 5; X.hp = X.c & 3; X.tokl = 8 * w + (X.c >> 2); X.t = t0 + X.tokl;
    X.Kb = (bf16_t*)(smem + NSA_K_OFF); X.Vb = (bf16_t*)(smem + NSA_V_OFF);
    X.imp_s = (float*)(smem + NSA_IMP_OFF + w * 8192); X.sel_s = (unsigned*)(smem + NSA_SEL_OFF);
    const int head = g * 4 + X.hp;
    const size_t row = (size_t)(b * SEQ + X.t);
    {
        float y[4][8];
        const bf16_t* qsrc = proj + row * PLD + C_Q + head * 64 + 8 * X.hh;
        float ss = 0.f;
#pragma unroll
        for (int s = 0; s < 4; s++) {
            const uint4 u = *(const uint4*)(qsrc + 16 * s);
            const unsigned wv[4] = {u.x, u.y, u.z, u.w};
#pragma unroll
            for (int e = 0; e < 4; e++) { y[s][2 * e] = __uint_as_float(wv[e] << 16); y[s][2 * e + 1] = __uint_as_float(wv[e] & 0xffff0000u); }
#pragma unroll
            for (int e = 0; e < 8; e++) ss += y[s][e] * y[s][e];
        }
        ss += __shfl_xor(ss, 32);
        const float r = rsqrtf(ss * (1.f / 64.f) + 1e-6f);
#pragma unroll
        for (int s = 0; s < 4; s++)
#pragma unroll
            for (int e = 0; e < 8; e++) y[s][e] *= r * qgain[16 * s + 8 * X.hh + e];
        const float qs = 0.125f * 1.4426950408889634f;
#pragma unroll
        for (int s = 0; s < 2; s++)
#pragma unroll
            for (int e = 0; e < 8; e++) {
                const float2 cs = rope[(size_t)X.t * 32 + 16 * s + 8 * X.hh + e];
                const float x1 = y[s][e], x2 = y[s + 2][e];
                y[s][e] = (x1 * cs.x - x2 * cs.y) * qs; y[s + 2][e] = (x2 * cs.x + x1 * cs.y) * qs;
            }
#pragma unroll
        for (int s = 0; s < 4; s++) X.qf[s] = pack8(y[s][0], y[s][1], y[s][2], y[s][3], y[s][4], y[s][5], y[s][6], y[s][7]);
    }
    const bf16_t* gp = proj + row * PLD + C_GATE + head * 3;
    const float g0 = sigmoidf_(bf2f(gp[0])), g1 = sigmoidf_(bf2f(gp[1])), g2 = sigmoidf_(bf2f(gp[2]));
    const int cur = t0 >> 6;
    {
        X.Kbase = kc + (size_t)bg * 512 * 64; X.kstride = 64; X.Vbase = vc + (size_t)bg * 512 * 64; X.vstride = 64;
        const int nvmax = (t0 >> 4) + 1, jhi = (nvmax - 1) >> 6;
        X.m = NEGBIG; X.l = 0.f;
        nsa_branch<0>(X, 0, jhi, 0ull, 0ull, 0ull, 0ull, cur, t0 + 8 * w);
        const float lt = X.l + __shfl_xor(X.l, 32);
        X.invl = (lt > 0.f) ? 1.f / lt : 0.f;
        X.carry = 0.f;
#pragma unroll
        for (int i = 0; i < 16; i++) { X.O0[i] = 0.f; X.O1[i] = 0.f; }
        nsa_branch<1>(X, 0, jhi, 0ull, 0ull, 0ull, 0ull, cur, t0 + 8 * w);
    }
    unsigned long long mlo, mhi, ulo, uhi;
    {
        const int tk2 = lane >> 3, sub = lane & 7;
        unsigned k0 = 1u, k1 = 0u, k2 = 0u, k3 = 0u;
#define SETBIT(jj) { const int _j = (jj); if (_j < 32) k0 |= 1u << _j; else if (_j < 64) k1 |= 1u << (_j - 32); else if (_j < 96) k2 |= 1u << (_j - 64); else k3 |= 1u << (_j - 96); }
        SETBIT(cur);
        if (cur >= 1) SETBIT(cur - 1);
        const int ncand = cur - 2;
        if (ncand > 0) {
            if (ncand <= 13) {
                for (int jj = 1; jj <= cur - 2; jj++) SETBIT(jj);
            } else {
                float sc[16];
#pragma unroll
                for (int i = 0; i < 16; i++) { const int jj = sub + 8 * i; sc[i] = (jj >= 1 && jj <= cur - 2) ? X.imp_s[tk2 * 128 + jj] : -3e38f; }
#pragma unroll 1
                for (int it = 0; it < 13; it++) {
                    float bv = sc[0]; int bi = 0;
#pragma unroll
                    for (int i = 1; i < 16; i++) if (sc[i] > bv) { bv = sc[i]; bi = i; }
                    int bj = sub + 8 * bi;
#pragma unroll
                    for (int o = 1; o < 8; o <<= 1) {
                        const float ov = __shfl_xor(bv, o); const int oj = __shfl_xor(bj, o);
                        if (ov > bv || (ov == bv && oj < bj)) { bv = ov; bj = oj; }
                    }
                    SETBIT(bj);
#pragma unroll
                    for (int i = 0; i < 16; i++) if (bj == sub + 8 * i) sc[i] = -3e38f;
                }
            }
        }
#undef SETBIT
        if (sub == 0) { unsigned* d = X.sel_s + (8 * w + tk2) * 4; d[0] = k0; d[1] = k1; d[2] = k2; d[3] = k3; }
        __builtin_amdgcn_s_waitcnt(0xc07f);
        const unsigned* sp = X.sel_s + X.tokl * 4;
        const unsigned m0 = sp[0], m1 = sp[1], m2 = sp[2], m3 = sp[3];
        mlo = (unsigned long long)m0 | ((unsigned long long)m1 << 32); mhi = (unsigned long long)m2 | ((unsigned long long)m3 << 32);
        unsigned u0 = m0, u1 = m1, u2 = m2, u3 = m3;
#pragma unroll
        for (int o = 4; o < 32; o <<= 1) { u0 |= __shfl_xor(u0, o); u1 |= __shfl_xor(u1, o); u2 |= __shfl_xor(u2, o); u3 |= __shfl_xor(u3, o); }
        ulo = (unsigned long long)(unsigned)__builtin_amdgcn_readfirstlane(u0) | ((unsigned long long)(unsigned)__builtin_amdgcn_readfirstlane(u1) << 32);
        uhi = (unsigned long long)(unsigned)__builtin_amdgcn_readfirstlane(u2) | ((unsigned long long)(unsigned)__builtin_amdgcn_readfirstlane(u3) << 32);
    }
    nsa_facc<0>(X, g0);
    {
        X.Kbase = ksn + (size_t)bg * SEQ * 64; X.kstride = 64;
        X.Vbase = vsn + (size_t)bg * SEQ * 64; X.vstride = 64;
        X.m = NEGBIG; X.l = 0.f;
#pragma unroll
        for (int i = 0; i < 16; i++) { X.O0[i] = 0.f; X.O1[i] = 0.f; }
        nsa_branch<2>(X, 0, cur, mlo, mhi, ulo, uhi, cur, t0 + 8 * w);
        const float lt = X.l + __shfl_xor(X.l, 32);
        nsa_facc<1>(X, (lt > 0.f) ? g1 / lt : 0.f);
    }
    {
        X.Kbase = kwn + (size_t)bg * SEQ * 64; X.kstride = 64;
        X.Vbase = vwn + (size_t)bg * SEQ * 64; X.vstride = 64;
        X.m = NEGBIG; X.l = 0.f;
#pragma unroll
        for (int i = 0; i < 16; i++) { X.O0[i] = 0.f; X.O1[i] = 0.f; }
        const int jlo = (t0 >= 511) ? ((t0 - 511) >> 6) : 0;
        nsa_branch<3>(X, jlo, cur, 0ull, 0ull, 0ull, 0ull, cur, t0 + 8 * w);
        const float lt = X.l + __shfl_xor(X.l, 32);
        nsa_facc<2>(X, (lt > 0.f) ? g2 / lt : 0.f);
    }
    bf16_t* dst = mixo + row * mix_ld + head * 64 + 4 * X.hh;
#pragma unroll
    for (int q4 = 0; q4 < 4; q4++) {
        *(uint2*)(dst + 8 * q4) = make_uint2(pk2(X.O0[4 * q4], X.O0[4 * q4 + 1]), pk2(X.O0[4 * q4 + 2], X.O0[4 * q4 + 3]));
        *(uint2*)(dst + 32 + 8 * q4) = make_uint2(pk2(X.O1[4 * q4], X.O1[4 * q4 + 1]), pk2(X.O1[4 * q4 + 2], X.O1[4 * q4 + 3]));
    }
}

#define KLS 136
#define XSS 264
#define GDN_PREP_LDS (2 * 64 * KLS * 2 + 64 * XSS * 2 + 512)
__device__ __forceinline__ unsigned pack2bf(float lo, float hi) { return (unsigned)f2bf(lo) | ((unsigned)f2bf(hi) << 16); }
__device__ __forceinline__ void d_gdn_prep2(const bf16_t* __restrict__ proj, const float* __restrict__ conv_w,
                                            const float* __restrict__ a_log, const float* __restrict__ dt_bias,
                                            bf16_t* __restrict__ guT, bf16_t* __restrict__ gw, bf16_t* __restrict__ gqd,
                                            bf16_t* __restrict__ gkdT, bf16_t* __restrict__ gin, float* __restrict__ gl, int chunk, char* smem) {
    bf16_t* kL = (bf16_t*)smem;
    bf16_t* qL = kL + 64 * KLS;
    float* AmT = (float*)qL;
    bf16_t* xs = qL + 64 * KLS;
    float* gcs = (float*)(xs + 64 * XSS);
    float* bts = gcs + 64;
    const int tid = threadIdx.x, lane = tid & 63, w = tid >> 6;
    const int n = chunk & 127, h = (chunk >> 7) & 3, b = chunk >> 9;
    const int t0 = n * 64;
    const size_t rbase = (size_t)(b * SEQ + t0);
    if (tid < 64) {
        const size_t r = (rbase + tid) * PLD;
        float a = bf2f(proj[r + C_A + h]), bb = bf2f(proj[r + C_B + h]);
        float xx = a + dt_bias[h];
        float sp = (xx > 20.f) ? xx : log1pf(__expf(xx));
        float c = -__expf(a_log[h]) * sp;
#pragma unroll
        for (int o = 1; o < 64; o <<= 1) { float nb = __shfl_up(c, o); if (lane >= o) c += nb; }
        gcs[tid] = c; bts[tid] = sigmoidf_(bb);
    }
    __syncthreads();
    {
        float wt[6][4], x0[6], x1[6], x2[6];
        int ch[6];
#pragma unroll
        for (int c6 = 0; c6 < 6; c6++) {
            ch[c6] = (c6 >> 1) * 512 + h * 128 + lane + 64 * (c6 & 1);
#pragma unroll
            for (int j = 0; j < 4; j++) wt[c6][j] = conv_w[j * 1536 + ch[c6]];
            const int tb = t0 + 16 * w - 3;
            x0[c6] = (tb >= 0) ? bf2f(proj[((size_t)(b * SEQ + tb)) * PLD + C_GQKV + ch[c6]]) : 0.f;
            x1[c6] = (tb + 1 >= 0) ? bf2f(proj[((size_t)(b * SEQ + tb + 1)) * PLD + C_GQKV + ch[c6]]) : 0.f;
            x2[c6] = (tb + 2 >= 0) ? bf2f(proj[((size_t)(b * SEQ + tb + 2)) * PLD + C_GQKV + ch[c6]]) : 0.f;
        }
        for (int i = 16 * w; i < 16 * w + 16; i++) {
            float sv[6];
#pragma unroll
            for (int c6 = 0; c6 < 6; c6++) {
                float xn = bf2f(proj[(rbase + i) * PLD + C_GQKV + ch[c6]]);
                float cv = x0[c6] * wt[c6][0] + x1[c6] * wt[c6][1] + x2[c6] * wt[c6][2] + xn * wt[c6][3];
                x0[c6] = x1[c6]; x1[c6] = x2[c6]; x2[c6] = xn;
                sv[c6] = cv * sigmoidf_(cv);
            }
            float rq = rsqrtf(wave_sum(sv[0] * sv[0] + sv[1] * sv[1]) + 1e-6f) * 0.08838834764831845f;
            float rk = rsqrtf(wave_sum(sv[2] * sv[2] + sv[3] * sv[3]) + 1e-6f);
            const float bi = bts[i], ei = __expf(gcs[i]);
            float q0 = sv[0] * rq, q1 = sv[1] * rq, k0 = sv[2] * rk, k1 = sv[3] * rk;
            qL[i * KLS + lane] = f2bf(q0); qL[i * KLS + lane + 64] = f2bf(q1);
            kL[i * KLS + lane] = f2bf(k0); kL[i * KLS + lane + 64] = f2bf(k1);
            xs[i * XSS + lane] = f2bf(sv[4] * bi); xs[i * XSS + lane + 64] = f2bf(sv[5] * bi);
            xs[i * XSS + 128 + lane] = f2bf(k0 * bi * ei); xs[i * XSS + 192 + lane] = f2bf(k1 * bi * ei);
            bf16_t* qd = gqd + (size_t)chunk * 8192 + i * 128;
            qd[lane] = f2bf(q0 * ei); qd[lane + 64] = f2bf(q1 * ei);
        }
    }
    __syncthreads();
    const int n16 = lane & 15, kq = lane >> 4;
    f32x4 aqk[4], akk[4];
#pragma unroll
    for (int tj = 0; tj < 4; tj++) { aqk[tj] = (f32x4){0.f, 0.f, 0.f, 0.f}; akk[tj] = (f32x4){0.f, 0.f, 0.f, 0.f}; }
#pragma unroll
    for (int ks = 0; ks < 4; ks++) {
        bf16x8 qa = *(const bf16x8*)(qL + (16 * w + n16) * KLS + 32 * ks + 8 * kq);
        bf16x8 ka = *(const bf16x8*)(kL + (16 * w + n16) * KLS + 32 * ks + 8 * kq);
#pragma unroll
        for (int tj = 0; tj < 4; tj++) {
            bf16x8 kb = *(const bf16x8*)(kL + (16 * tj + n16) * KLS + 32 * ks + 8 * kq);
            aqk[tj] = __builtin_amdgcn_mfma_f32_16x16x32_bf16(qa, kb, aqk[tj], 0, 0, 0);
            akk[tj] = __builtin_amdgcn_mfma_f32_16x16x32_bf16(ka, kb, akk[tj], 0, 0, 0);
        }
    }
    {
        const float glast = gcs[63];
        const int kidx = tid >> 1, c0 = (tid & 1) * 32;
        unsigned pk[16];
#pragma unroll
        for (int cc = 0; cc < 32; cc += 2) {
            float v0 = bf2f(kL[(c0 + cc) * KLS + kidx]) * __expf(glast - gcs[c0 + cc]);
            float v1 = bf2f(kL[(c0 + cc + 1) * KLS + kidx]) * __expf(glast - gcs[c0 + cc + 1]);
            pk[cc >> 1] = pack2bf(v0, v1);
        }
        uint4* dst = (uint4*)(gkdT + (size_t)chunk * 8192 + kidx * 64 + c0);
#pragma unroll
        for (int v4 = 0; v4 < 4; v4++) dst[v4] = make_uint4(pk[4 * v4], pk[4 * v4 + 1], pk[4 * v4 + 2], pk[4 * v4 + 3]);
        if (tid == 0) gl[chunk] = __expf(glast);
    }
    __syncthreads();
#pragma unroll
    for (int tj = 0; tj < 4; tj++)
#pragma unroll
        for (int r = 0; r < 4; r++) {
            const int i = 16 * w + 4 * kq + r, j = 16 * tj + n16;
            const float dec = (j <= i) ? __expf(gcs[i] - gcs[j]) : 0.f;
            gin[(size_t)chunk * 4096 + i * 64 + j] = f2bf(aqk[tj][r] * dec);
            AmT[j * 64 + i] = (j < i) ? bts[i] * akk[tj][r] * dec : 0.f;
        }
    __syncthreads();
    {
        const int c = tid;
#pragma unroll 1
        for (int blk = 0; blk < 8; blk++) {
            const int i0 = blk * 8;
            float acc[8];
#pragma unroll
            for (int r = 0; r < 8; r++) acc[r] = bf2f(xs[(i0 + r) * XSS + c]);
            for (int j = 0; j < i0; j++) {
                const float xj = bf2f(xs[j * XSS + c]);
                const float4 a0 = *(const float4*)(AmT + j * 64 + i0), a1 = *(const float4*)(AmT + j * 64 + i0 + 4);
                acc[0] -= a0.x * xj; acc[1] -= a0.y * xj; acc[2] -= a0.z * xj; acc[3] -= a0.w * xj;
                acc[4] -= a1.x * xj; acc[5] -= a1.y * xj; acc[6] -= a1.z * xj; acc[7] -= a1.w * xj;
            }
#pragma unroll
            for (int r = 1; r < 8; r++)
#pragma unroll
                for (int s2 = 0; s2 < r; s2++) acc[r] -= AmT[(i0 + s2) * 64 + i0 + r] * acc[s2];
#pragma unroll
            for (int r = 0; r < 8; r++) xs[(i0 + r) * XSS + c] = f2bf(acc[r]);
            if (c < 128) {
                *(uint4*)(guT + (size_t)chunk * 8192 + c * 64 + i0) =
                    make_uint4(pack2bf(acc[0], acc[1]), pack2bf(acc[2], acc[3]), pack2bf(acc[4], acc[5]), pack2bf(acc[6], acc[7]));
            } else {
#pragma unroll
                for (int r = 0; r < 8; r++) gw[(size_t)chunk * 8192 + (i0 + r) * 128 + (c - 128)] = f2bf(acc[r]);
            }
        }
    }
}

struct GdnFrag { bf16x8 wA[4], qA[4], inA[2], kdA[2][2]; uint2 uC; float glv; };
__device__ __forceinline__ void gdn_load_frag(GdnFrag& f, const bf16_t* __restrict__ guT, const bf16_t* __restrict__ gw, const bf16_t* __restrict__ gqd,
                                              const bf16_t* __restrict__ gkdT, const bf16_t* __restrict__ gin, const float* __restrict__ gl,
                                              int chunk, int w, int sl, int n16, int kq) {
    const size_t cb = (size_t)chunk * 8192;
#pragma unroll
    for (int ks = 0; ks < 4; ks++) {
        f.wA[ks] = *(const bf16x8*)(gw + cb + (16 * w + n16) * 128 + 32 * ks + 8 * kq);
        f.qA[ks] = *(const bf16x8*)(gqd + cb + (16 * w + n16) * 128 + 32 * ks + 8 * kq);
    }
#pragma unroll
    for (int ks = 0; ks < 2; ks++) {
        f.inA[ks] = *(const bf16x8*)(gin + (size_t)chunk * 4096 + (16 * w + n16) * 64 + 32 * ks + 8 * kq);
        f.kdA[0][ks] = *(const bf16x8*)(gkdT + cb + (32 * w + n16) * 64 + 32 * ks + 8 * kq);
        f.kdA[1][ks] = *(const bf16x8*)(gkdT + cb + (32 * w + 16 + n16) * 64 + 32 * ks + 8 * kq);
    }
    f.uC = *(const uint2*)(guT + cb + (16 * sl + n16) * 64 + 16 * w + 4 * kq);
    f.glv = gl[chunk];
}
#define STS 144
#define VNS 80
__device__ __forceinline__ void gdn_step(const GdnFrag& f, f32x4& S0, f32x4& S1, bf16_t* StT, bf16_t* vnT, float* __restrict__ ogrow, int w, int n16, int kq) {
    f32x4 ws = (f32x4){0.f, 0.f, 0.f, 0.f}, qs = (f32x4){0.f, 0.f, 0.f, 0.f};
#pragma unroll
    for (int ks = 0; ks < 4; ks++) {
        bf16x8 sb = *(const bf16x8*)(StT + n16 * STS + 32 * ks + 8 * kq);
        ws = __builtin_amdgcn_mfma_f32_16x16x32_bf16(f.wA[ks], sb, ws, 0, 0, 0);
        qs = __builtin_amdgcn_mfma_f32_16x16x32_bf16(f.qA[ks], sb, qs, 0, 0, 0);
    }
    float v0 = __uint_as_float(f.uC.x << 16) - ws[0], v1 = __uint_as_float(f.uC.x & 0xffff0000u) - ws[1];
    float v2 = __uint_as_float(f.uC.y << 16) - ws[2], v3 = __uint_as_float(f.uC.y & 0xffff0000u) - ws[3];
    *(uint2*)(vnT + n16 * VNS + 16 * w + 4 * kq) = make_uint2(pack2bf(v0, v1), pack2bf(v2, v3));
    __syncthreads();
    bf16x8 vb0 = *(const bf16x8*)(vnT + n16 * VNS + 8 * kq), vb1 = *(const bf16x8*)(vnT + n16 * VNS + 32 + 8 * kq);
    qs = __builtin_amdgcn_mfma_f32_16x16x32_bf16(f.inA[0], vb0, qs, 0, 0, 0);
    qs = __builtin_amdgcn_mfma_f32_16x16x32_bf16(f.inA[1], vb1, qs, 0, 0, 0);
    S0 = S0 * f.glv; S1 = S1 * f.glv;
    S0 = __builtin_amdgcn_mfma_f32_16x16x32_bf16(f.kdA[0][0], vb0, S0, 0, 0, 0);
    S0 = __builtin_amdgcn_mfma_f32_16x16x32_bf16(f.kdA[0][1], vb1, S0, 0, 0, 0);
    S1 = __builtin_amdgcn_mfma_f32_16x16x32_bf16(f.kdA[1][0], vb0, S1, 0, 0, 0);
    S1 = __builtin_amdgcn_mfma_f32_16x16x32_bf16(f.kdA[1][1], vb1, S1, 0, 0, 0);
#pragma unroll
    for (int r = 0; r < 4; r++) ogrow[(size_t)(4 * kq + r) * 512] = qs[r];
    *(uint2*)(StT + n16 * STS + 32 * w + 4 * kq) = make_uint2(pack2bf(S0[0], S0[1]), pack2bf(S0[2], S0[3]));
    *(uint2*)(StT + n16 * STS + 32 * w + 16 + 4 * kq) = make_uint2(pack2bf(S1[0], S1[1]), pack2bf(S1[2], S1[3]));
    __syncthreads();
}
__device__ __forceinline__ void d_gdn_scan2(const bf16_t* __restrict__ guT, const bf16_t* __restrict__ gw, const bf16_t* __restrict__ gqd,
                                            const bf16_t* __restrict__ gkdT, const bf16_t* __restrict__ gin, const float* __restrict__ gl,
                                            float* __restrict__ og, int item, char* smem) {
    bf16_t* StT = (bf16_t*)smem;
    bf16_t* vnT = StT + 16 * STS;
    const int tid = threadIdx.x, lane = tid & 63, w = tid >> 6, n16 = lane & 15, kq = lane >> 4;
    const int bh = item & 7, sl = item >> 3, b = bh >> 2, h = bh & 3;
    for (int i = tid; i < 16 * STS / 2; i += 256) ((unsigned*)StT)[i] = 0u;
    f32x4 S0 = (f32x4){0.f, 0.f, 0.f, 0.f}, S1 = (f32x4){0.f, 0.f, 0.f, 0.f};
    GdnFrag fa, fb, fc;
    gdn_load_frag(fa, guT, gw, gqd, gkdT, gin, gl, bh * 128, w, sl, n16, kq);
    gdn_load_frag(fb, guT, gw, gqd, gkdT, gin, gl, bh * 128 + 1, w, sl, n16, kq);
    __syncthreads();
    float* obase = og + (size_t)(b * SEQ + 16 * w) * 512 + h * 128 + 16 * sl + n16;
#pragma unroll 1
    for (int n = 0; n < 126; n += 3) {
        gdn_load_frag(fc, guT, gw, gqd, gkdT, gin, gl, bh * 128 + n + 2, w, sl, n16, kq);
        gdn_step(fa, S0, S1, StT, vnT, obase + (size_t)(n * 64) * 512, w, n16, kq);
        gdn_load_frag(fa, guT, gw, gqd, gkdT, gin, gl, bh * 128 + n + 3, w, sl, n16, kq);
        gdn_step(fb, S0, S1, StT, vnT, obase + (size_t)((n + 1) * 64) * 512, w, n16, kq);
        gdn_load_frag(fb, guT, gw, gqd, gkdT, gin, gl, bh * 128 + n + 4, w, sl, n16, kq);
        gdn_step(fc, S0, S1, StT, vnT, obase + (size_t)((n + 2) * 64) * 512, w, n16, kq);
    }
    gdn_step(fa, S0, S1, StT, vnT, obase + (size_t)(126 * 64) * 512, w, n16, kq);
    gdn_step(fb, S0, S1, StT, vnT, obase + (size_t)(127 * 64) * 512, w, n16, kq);
}

__device__ __forceinline__ void d_gdn_out(const float* __restrict__ og, const bf16_t* __restrict__ proj, const float* __restrict__ gain, bf16_t* __restrict__ mix, int t, int lane) {
    const float* o = og + (size_t)t * 512;
    const bf16_t* z = proj + (size_t)t * PLD + C_Z;
    float a[8], zz[8];
#pragma unroll
    for (int i = 0; i < 8; i++) { a[i] = o[lane + 64 * i]; zz[i] = bf2f(z[lane + 64 * i]); }
    const float g0 = gain[lane], g1 = gain[lane + 64];
#pragma unroll
    for (int h = 0; h < 4; h++) {
        const float ss = wave_sum_dpp(a[2 * h] * a[2 * h] + a[2 * h + 1] * a[2 * h + 1]);
        const float r = rsqrtf(ss * (1.f / 128.f) + 1e-6f);
        mix[(size_t)t * DM + 512 + h * 128 + lane] = f2bf(a[2 * h] * r * g0 * zz[2 * h] * sigmoidf_(zz[2 * h]));
        mix[(size_t)t * DM + 512 + h * 128 + lane + 64] = f2bf(a[2 * h + 1] * r * g1 * zz[2 * h + 1] * sigmoidf_(zz[2 * h + 1]));
    }
}

__device__ __forceinline__ void route_load_subkeys(const float* __restrict__ subkeys, char* smem) {
    for (int idx = threadIdx.x; idx < 2 * 128 * 16; idx += 256) {
        const int half = idx >> 11, key = (idx >> 4) & 127, ch = idx & 15;
        const float* src = subkeys + ((size_t)(half * 128 + key)) * 128 + ch * 8;
        const float4 x0 = *(const float4*)src, x1 = *(const float4*)(src + 4);
        *(uint4*)(smem + half * 32768 + key * 256 + ((ch ^ (key & 15)) << 4)) = make_uint4(pk2(x0.x, x0.y), pk2(x0.z, x0.w), pk2(x1.x, x1.y), pk2(x1.z, x1.w));
    }
}
#define CEX(i, j) { const float _a = v[i], _b = v[j]; v[i] = fmaxf(_a, _b); v[j] = fminf(_a, _b); }
__device__ __forceinline__ void d_peer_route2(const bf16_t* __restrict__ qry, int* __restrict__ eidx, float* __restrict__ pgate, int mtile, const char* smem, int lane) {
    const int n16 = lane & 15, kq = lane >> 4;
    const int tA = 2 * mtile + (n16 >> 3), hA = n16 & 7;
    float topv[2][4];
#pragma unroll
    for (int half = 0; half < 2; half++) {
        const bf16_t* qp = qry + (size_t)tA * 2048 + hA * 256 + half * 128 + 8 * kq;
        bf16x8 a[4];
#pragma unroll
        for (int ks = 0; ks < 4; ks++) a[ks] = *(const bf16x8*)(qp + 32 * ks);
        f32x4 acc[8];
#pragma unroll
        for (int nt = 0; nt < 8; nt++) acc[nt] = (f32x4){0.f, 0.f, 0.f, 0.f};
#pragma unroll
        for (int ks = 0; ks < 4; ks++)
#pragma unroll
            for (int nt = 0; nt < 8; nt++) {
                const bf16x8 bb = *(const bf16x8*)(smem + half * 32768 + (16 * nt + n16) * 256 + (((4 * ks + kq) ^ n16) << 4));
                acc[nt] = __builtin_amdgcn_mfma_f32_16x16x32_bf16(a[ks], bb, acc[nt], 0, 0, 0);
                if (nt == 3 || nt == 7) __builtin_amdgcn_sched_barrier(0);
            }
#pragma unroll
        for (int r = 0; r < 4; r++) {
            float v[8];
#pragma unroll
            for (int nt = 0; nt < 8; nt++) v[nt] = __uint_as_float((__float_as_uint(acc[nt][r]) & 0xFFFFFF80u) | (unsigned)(nt << 4) | (unsigned)n16);
            CEX(0, 1) CEX(2, 3) CEX(4, 5) CEX(6, 7) CEX(0, 2) CEX(1, 3) CEX(4, 6) CEX(5, 7) CEX(1, 2) CEX(5, 6)
            CEX(0, 4) CEX(1, 5) CEX(2, 6) CEX(3, 7) CEX(2, 4) CEX(3, 5) CEX(1, 2) CEX(3, 4) CEX(5, 6)
            float keep = 0.f;
#pragma unroll 1
            for (int it = 0; it < 16; it++) {
                const float mx = allmax16(v[0]);
                if (n16 == it) keep = mx;
                if (__float_as_uint(v[0]) == __float_as_uint(mx)) {
                    v[0] = v[1]; v[1] = v[2]; v[2] = v[3]; v[3] = v[4]; v[4] = v[5]; v[5] = v[6]; v[6] = v[7]; v[7] = -3e38f;
                }
            }
            topv[half][r] = keep;
            __builtin_amdgcn_sched_barrier(0);
        }
    }
#pragma unroll
    for (int r = 0; r < 4; r++) {
        const float v1p = topv[0][r], v2p = topv[1][r];
        const unsigned u1 = __float_as_uint(v1p);
        const int i1 = (int)(((u1 >> 4) & 7u) * 16u + (u1 & 15u));
        const int lim = 16 / (n16 + 1);
        int ptr = 0;
        const int lanebase = (lane & 48);
        float cur2 = __builtin_bit_cast(float, __builtin_amdgcn_ds_bpermute(lanebase * 4, __builtin_bit_cast(int, v2p)));
        float head = __uint_as_float((__float_as_uint(v1p + cur2) & 0xFFFFFFF0u) | (unsigned)n16);
        float ksc = 0.f; unsigned ke = 0u;
#pragma unroll 1
        for (int it = 0; it < 16; it++) {
            const float mx = allmax16(head);
            const bool win = __float_as_uint(head) == __float_as_uint(mx);
            const unsigned u2 = __float_as_uint(cur2);
            unsigned e = win ? (unsigned)(i1 * 128) + ((u2 >> 4) & 7u) * 16u + (u2 & 15u) : 0u;
            e = allmaxu16(e);
            if (n16 == it) { ksc = mx; ke = e; }
            if (win) ptr++;
            const int pn = ptr < 15 ? ptr : 15;
            const float nx = __builtin_bit_cast(float, __builtin_amdgcn_ds_bpermute((lanebase + pn) * 4, __builtin_bit_cast(int, v2p)));
            if (win) { cur2 = nx; head = (ptr < lim) ? __uint_as_float((__float_as_uint(v1p + cur2) & 0xFFFFFFF0u) | (unsigned)n16) : -3e38f; }
        }
        const float smax = allmax16(ksc);
        const float ex = __expf(ksc - smax);
        const float sum = allsum16(ex);
        const int row = 4 * kq + r;
        const size_t o = (size_t)(2 * mtile + (row >> 3)) * 128 + (row & 7) * 16 + n16;
        eidx[o] = (int)ke; pgate[o] = ex / sum;
    }
}
#undef CEX

__device__ __forceinline__ void d_quant_row(const float* __restrict__ src, unsigned char* __restrict__ dst, float* __restrict__ scale, int row, int lane, int bias) {
    const float4* p = (const float4*)(src + (size_t)row * DM) + lane * 4;
    float4 x[4];
    float am = 0.f;
#pragma unroll
    for (int i = 0; i < 4; i++) { x[i] = p[i]; am = fmaxf(am, fmaxf(fmaxf(fabsf(x[i].x), fabsf(x[i].y)), fmaxf(fabsf(x[i].z), fabsf(x[i].w)))); }
    am = wave_max(am);
    const float sc = (am > 0.f) ? am * (1.f / 127.f) : 1.f;
    const float inv = 1.f / sc;
    unsigned wv[4];
#pragma unroll
    for (int i = 0; i < 4; i++) {
        const int q0 = (int)rintf(x[i].x * inv) + bias, q1 = (int)rintf(x[i].y * inv) + bias, q2 = (int)rintf(x[i].z * inv) + bias, q3 = (int)rintf(x[i].w * inv) + bias;
        wv[i] = (unsigned)(q0 & 0xff) | ((unsigned)(q1 & 0xff) << 8) | ((unsigned)(q2 & 0xff) << 16) | ((unsigned)(q3 & 0xff) << 24);
    }
    ((uint4*)(dst + (size_t)row * DM))[lane] = make_uint4(wv[0], wv[1], wv[2], wv[3]);
    if (lane == 0) scale[row] = sc;
}

struct PeerGrp { u32x4 u[4]; u32x4 v[4]; float gv[4]; float su[4]; };
__device__ __forceinline__ void peer_load(PeerGrp& G, const unsigned char* __restrict__ uq, const unsigned char* __restrict__ vq,
                                          int esrc, float gsrc, float susrc, int k0, int lane) {
#pragma unroll
    for (int i = 0; i < 4; i++) {
        const int e = __builtin_amdgcn_readlane(esrc, (k0 + i) & 63);
        G.gv[i] = __builtin_bit_cast(float, __builtin_amdgcn_readlane(__builtin_bit_cast(int, gsrc), (k0 + i) & 63));
        G.su[i] = __builtin_bit_cast(float, __builtin_amdgcn_readlane(__builtin_bit_cast(int, susrc), (k0 + i) & 63));
        G.u[i] = ((const u32x4*)(uq + (size_t)e * DM))[lane];
        G.v[i] = ((const u32x4*)(vq + (size_t)e * DM))[lane];
    }
}
__device__ __forceinline__ void peer_compute(const PeerGrp& G, const int (&xq)[4], float sx, float (&acc)[16], float& bsum) {
    int d[4];
#pragma unroll
    for (int i = 0; i < 4; i++) {
        int sdot = 0;
        sdot = __builtin_amdgcn_sdot4((int)G.u[i][0], xq[0], sdot, false); sdot = __builtin_amdgcn_sdot4((int)G.u[i][1], xq[1], sdot, false);
        sdot = __builtin_amdgcn_sdot4((int)G.u[i][2], xq[2], sdot, false); sdot = __builtin_amdgcn_sdot4((int)G.u[i][3], xq[3], sdot, false);
        d[i] = sdot;
    }
#pragma unroll
    for (int i = 0; i < 4; i++) {
        int x = d[i];
        x += (int)dppu<0xB1>((unsigned)x); x += (int)dppu<0x4E>((unsigned)x); x += (int)dppu<0x141>((unsigned)x); x += (int)dppu<0x140>((unsigned)x);
        d[i] = __builtin_amdgcn_readlane(x, 0) + __builtin_amdgcn_readlane(x, 16) + __builtin_amdgcn_readlane(x, 32) + __builtin_amdgcn_readlane(x, 48);
    }
#pragma unroll
    for (int i = 0; i < 4; i++) {
        const float dot = (float)d[i] * (G.su[i] * sx);
        const float u2 = 1.5957691216057308f * (dot + 0.044715f * dot * dot * dot);
        const float cs = G.gv[i] * dot * __builtin_amdgcn_rcpf(1.f + __expf(-u2));
        bsum += cs;
#pragma unroll
        for (int j = 0; j < 4; j++) {
            const unsigned wv = G.v[i][j];
            acc[4 * j] += cs * (float)(wv & 0xffu);
            acc[4 * j + 1] += cs * (float)((wv >> 8) & 0xffu);
            acc[4 * j + 2] += cs * (float)((wv >> 16) & 0xffu);
            acc[4 * j + 3] += cs * (float)(wv >> 24);
        }
    }
}
__device__ __forceinline__ void d_peer_expert3(const bf16_t* __restrict__ h2, const int* __restrict__ eidx, const float* __restrict__ pgate,
                                               const unsigned char* __restrict__ uq, const unsigned char* __restrict__ vq,
                                               const float* __restrict__ su, const float* __restrict__ sv, const float* __restrict__ ssq, const float* __restrict__ fgain, float* __restrict__ out, int token, int lane, bool do_store = true, int emask = 0xffff) {
    const uint4 xa = ((const uint4*)(h2 + (size_t)token * DM))[2 * lane], xb = ((const uint4*)(h2 + (size_t)token * DM))[2 * lane + 1];
    const unsigned xw[8] = {xa.x, xa.y, xa.z, xa.w, xb.x, xb.y, xb.z, xb.w};
    float xf[16];
    float am = 0.f;
    const float rr = rsqrtf(allsum16(ssq[(size_t)token * 16 + (lane & 15)]) * (1.f / DM) + 1e-6f);
    const float4* gp = (const float4*)(fgain + lane * 16);
    const float4 ga = gp[0], gb = gp[1], gc = gp[2], gd = gp[3];
    const float gg[16] = {ga.x, ga.y, ga.z, ga.w, gb.x, gb.y, gb.z, gb.w, gc.x, gc.y, gc.z, gc.w, gd.x, gd.y, gd.z, gd.w};
#pragma unroll
    for (int j = 0; j < 8; j++) {
        xf[2 * j] = __uint_as_float(xw[j] << 16) * rr * gg[2 * j]; xf[2 * j + 1] = __uint_as_float(xw[j] & 0xffff0000u) * rr * gg[2 * j + 1];
        am = fmaxf(am, fmaxf(fabsf(xf[2 * j]), fabsf(xf[2 * j + 1])));
    }
    am = wave_max(am);
    const float sx = (am > 0.f) ? am * (1.f / 127.f) : 1.f;
    const float isx = 1.f / sx;
    int xq[4];
#pragma unroll
    for (int j = 0; j < 4; j++) {
        const int q0 = (int)rintf(xf[4 * j] * isx), q1 = (int)rintf(xf[4 * j + 1] * isx), q2 = (int)rintf(xf[4 * j + 2] * isx), q3 = (int)rintf(xf[4 * j + 3] * isx);
        xq[j] = (int)((unsigned)(q0 & 0xff) | ((unsigned)(q1 & 0xff) << 8) | ((unsigned)(q2 & 0xff) << 16) | ((unsigned)(q3 & 0xff) << 24));
    }
    float acc[16];
#pragma unroll
    for (int i = 0; i < 16; i++) acc[i] = 0.f;
    float bsum = 0.f;
    const int e_lo = eidx[(size_t)token * 128 + lane] & emask, e_hi = eidx[(size_t)token * 128 + 64 + lane] & emask;
    const float g_lo = pgate[(size_t)token * 128 + lane] * sv[e_lo], g_hi = pgate[(size_t)token * 128 + 64 + lane] * sv[e_hi];
    const float s_lo = su[e_lo], s_hi = su[e_hi];
    PeerGrp A, B;
    peer_load(A, uq, vq, e_lo, g_lo, s_lo, 0, lane);
#pragma unroll 1
    for (int k0 = 0; k0 < 64; k0 += 8) {
        peer_load(B, uq, vq, e_lo, g_lo, s_lo, k0 + 4, lane);
        peer_compute(A, xq, sx, acc, bsum);
        if (k0 + 8 < 64) peer_load(A, uq, vq, e_lo, g_lo, s_lo, k0 + 8, lane); else peer_load(A, uq, vq, e_hi, g_hi, s_hi, 0, lane);
        peer_compute(B, xq, sx, acc, bsum);
    }
#pragma unroll 1
    for (int k0 = 0; k0 < 64; k0 += 8) {
        peer_load(B, uq, vq, e_hi, g_hi, s_hi, k0 + 4, lane);
        peer_compute(A, xq, sx, acc, bsum);
        if (k0 + 8 < 64) peer_load(A, uq, vq, e_hi, g_hi, s_hi, k0 + 8, lane);
        peer_compute(B, xq, sx, acc, bsum);
    }
    const float bs = 128.f * bsum;
    float4* o = (float4*)(out + (size_t)token * DM + lane * 16);
#pragma unroll
    for (int j = 0; j < 4; j++) {
        float4 t = o[j];
        t.x += acc[4 * j] - bs; t.y += acc[4 * j + 1] - bs; t.z += acc[4 * j + 2] - bs; t.w += acc[4 * j + 3] - bs;
        if (do_store) o[j] = t; else asm volatile("" :: "v"(t.x), "v"(t.y), "v"(t.z), "v"(t.w));
    }
}

#define PE_PSH 8
#define PE_NP 64
#define PE_GS 4
#define PE_TOK 4
#define PE_WAVE_LDS 9344
struct PeSet { u32x4 u[PE_GS], v[PE_GS]; int id[PE_GS]; int n; unsigned long long r0, r1; };
__device__ __forceinline__ void pe_prepare(PeSet& S, const unsigned* ent_e, int k, int p, const unsigned char* __restrict__ uq, const unsigned char* __restrict__ vq, int lane) {
    const unsigned pair = ent_e[k * 64 + lane];
    unsigned long long m0 = __builtin_amdgcn_ballot_w64(((pair & 0xffffu) >> PE_PSH) == (unsigned)p);
    unsigned long long m1 = __builtin_amdgcn_ballot_w64((pair >> (16 + PE_PSH)) == (unsigned)p);
    int n = 0;
#pragma unroll
    for (int i = 0; i < PE_GS; i++) {
        if (m0 | m1) {
            int idx, e;
            if (m0) { idx = __builtin_ctzll(m0); m0 &= m0 - 1; e = (int)((unsigned)__builtin_amdgcn_readlane((int)pair, idx) & 0xffffu); S.id[i] = idx; }
            else { idx = __builtin_ctzll(m1); m1 &= m1 - 1; e = (int)((unsigned)__builtin_amdgcn_readlane((int)pair, idx) >> 16); S.id[i] = 64 + idx; }
            S.u[i] = ((const u32x4*)(uq + (size_t)e * DM))[lane];
            S.v[i] = ((const u32x4*)(vq + (size_t)e * DM))[lane];
            n = i + 1;
        }
    }
    S.n = n; S.r0 = m0; S.r1 = m1;
}
__device__ __forceinline__ void pe_one(const u32x4& u, const u32x4& v, const u32x4& xq, float gs, float ss, float (&acc)[16], float& bsum) {
    int sdot = 0;
    sdot = __builtin_amdgcn_sdot4((int)u[0], (int)xq[0], sdot, false); sdot = __builtin_amdgcn_sdot4((int)u[1], (int)xq[1], sdot, false);
    sdot = __builtin_amdgcn_sdot4((int)u[2], (int)xq[2], sdot, false); sdot = __builtin_amdgcn_sdot4((int)u[3], (int)xq[3], sdot, false);
    int x = sdot;
    x += (int)dppu<0xB1>((unsigned)x); x += (int)dppu<0x4E>((unsigned)x); x += (int)dppu<0x141>((unsigned)x); x += (int)dppu<0x140>((unsigned)x);
    const int tot = __builtin_amdgcn_readlane(x, 0) + __builtin_amdgcn_readlane(x, 16) + __builtin_amdgcn_readlane(x, 32) + __builtin_amdgcn_readlane(x, 48);
    const float dot = (float)tot * ss;
    const float u2 = 1.5957691216057308f * (dot + 0.044715f * dot * dot * dot);
    const float cs = gs * dot * __builtin_amdgcn_rcpf(1.f + __expf(-u2));
    bsum += cs;
#pragma unroll
    for (int j = 0; j < 4; j++) {
        const unsigned wv = v[j];
        acc[4 * j] += cs * (float)(wv & 0xffu);
        acc[4 * j + 1] += cs * (float)((wv >> 8) & 0xffu);
        acc[4 * j + 2] += cs * (float)((wv >> 16) & 0xffu);
        acc[4 * j + 3] += cs * (float)(wv >> 24);
    }
}
__device__ __forceinline__ void pe_consume(const PeSet& S, const unsigned* ent_e, const float* ent_g, const float* ent_s, const u32x4* xqs, const float* sxs, int k,
                                           const unsigned char* __restrict__ uq, const unsigned char* __restrict__ vq, int lane, float (&acc)[16], float& bsum) {
    if (S.n == 0) return;
    const u32x4 xq = xqs[k * 64 + lane];
    const float sx = sxs[k];
#pragma unroll
    for (int i = 0; i < PE_GS; i++) {
        if (S.n > i) pe_one(S.u[i], S.v[i], xq, ent_g[k * 128 + S.id[i]], ent_s[k * 128 + S.id[i]] * sx, acc, bsum);
    }
    unsigned long long m0 = S.r0, m1 = S.r1;
    while (m0 | m1) {
        int idx, id, e;
        const unsigned pair = ent_e[k * 64 + lane];
        if (m0) { idx = __builtin_ctzll(m0); m0 &= m0 - 1; e = (int)((unsigned)__builtin_amdgcn_readlane((int)pair, idx) & 0xffffu); id = idx; }
        else { idx = __builtin_ctzll(m1); m1 &= m1 - 1; e = (int)((unsigned)__builtin_amdgcn_readlane((int)pair, idx) >> 16); id = 64 + idx; }
        const u32x4 u = ((const u32x4*)(uq + (size_t)e * DM))[lane];
        const u32x4 v = ((const u32x4*)(vq + (size_t)e * DM))[lane];
        pe_one(u, v, xq, ent_g[k * 128 + id], ent_s[k * 128 + id] * sx, acc, bsum);
    }
}
__device__ __forceinline__ void d_peer_expert5(const bf16_t* __restrict__ h2, const int* __restrict__ eidx, const float* __restrict__ pgate,
                                               const unsigned char* __restrict__ uq, const unsigned char* __restrict__ vq,
                                               const float* __restrict__ su, const float* __restrict__ sv, float* __restrict__ out, int grp, int lane, char* wlds, bool do_store, int emask = 0xffff) {
    unsigned* ent_e = (unsigned*)wlds;
    float* ent_g = (float*)(wlds + 1024);
    float* ent_s = (float*)(wlds + 1024 + 2048);
    u32x4* xqs = (u32x4*)(wlds + 1024 + 4096);
    float* sxs = (float*)(wlds + 1024 + 4096 + 4096);
#pragma unroll 1
    for (int k = 0; k < PE_TOK; k++) {
        const size_t t = (size_t)grp * PE_TOK + k;
        int e_lo = eidx[t * 128 + lane], e_hi = eidx[t * 128 + 64 + lane];
        e_lo = (e_lo & 0xff00) | (e_lo & emask & 0xff) | ((e_lo & 0xff00) & emask); e_hi = (e_hi & 0xff00) | (e_hi & emask & 0xff) | ((e_hi & 0xff00) & emask);
        ent_e[k * 64 + lane] = (unsigned)e_lo | ((unsigned)e_hi << 16);
        ent_g[k * 128 + lane] = pgate[t * 128 + lane] * sv[e_lo]; ent_g[k * 128 + 64 + lane] = pgate[t * 128 + 64 + lane] * sv[e_hi];
        ent_s[k * 128 + lane] = su[e_lo]; ent_s[k * 128 + 64 + lane] = su[e_hi];
        const uint4 xa = ((const uint4*)(h2 + t * DM))[2 * lane], xb = ((const uint4*)(h2 + t * DM))[2 * lane + 1];
        const unsigned xw[8] = {xa.x, xa.y, xa.z, xa.w, xb.x, xb.y, xb.z, xb.w};
        float xf[16];
        float am = 0.f;
#pragma unroll
        for (int j = 0; j < 8; j++) { xf[2 * j] = __uint_as_float(xw[j] << 16); xf[2 * j + 1] = __uint_as_float(xw[j] & 0xffff0000u); am = fmaxf(am, fmaxf(fabsf(xf[2 * j]), fabsf(xf[2 * j + 1]))); }
        am = wave_max(am);
        const float sx = (am > 0.f) ? am * (1.f / 127.f) : 1.f;
        const float isx = 1.f / sx;
        u32x4 q;
#pragma unroll
        for (int j = 0; j < 4; j++) {
            const int q0 = (int)rintf(xf[4 * j] * isx), q1 = (int)rintf(xf[4 * j + 1] * isx), q2 = (int)rintf(xf[4 * j + 2] * isx), q3 = (int)rintf(xf[4 * j + 3] * isx);
            q[j] = (unsigned)(q0 & 0xff) | ((unsigned)(q1 & 0xff) << 8) | ((unsigned)(q2 & 0xff) << 16) | ((unsigned)(q3 & 0xff) << 24);
        }
        xqs[k * 64 + lane] = q;
        if (lane == 0) sxs[k] = sx;
    }
    float acc[PE_TOK][16];
    float bsum[PE_TOK];
#pragma unroll
    for (int k = 0; k < PE_TOK; k++) {
        bsum[k] = 0.f;
#pragma unroll
        for (int i = 0; i < 16; i++) acc[k][i] = 0.f;
    }
    PeSet S0, S1, S2, S3;
    pe_prepare(S0, ent_e, 0, 0, uq, vq, lane);
    pe_prepare(S1, ent_e, 1, 0, uq, vq, lane);
    pe_prepare(S2, ent_e, 2, 0, uq, vq, lane);
#pragma unroll 1
    for (int p = 0; p < PE_NP; p++) {
        pe_prepare(S3, ent_e, 3, p, uq, vq, lane);
        pe_consume(S0, ent_e, ent_g, ent_s, xqs, sxs, 0, uq, vq, lane, acc[0], bsum[0]);
        if (p + 1 < PE_NP) pe_prepare(S0, ent_e, 0, p + 1, uq, vq, lane);
        pe_consume(S1, ent_e, ent_g, ent_s, xqs, sxs, 1, uq, vq, lane, acc[1], bsum[1]);
        if (p + 1 < PE_NP) pe_prepare(S1, ent_e, 1, p + 1, uq, vq, lane);
        pe_consume(S2, ent_e, ent_g, ent_s, xqs, sxs, 2, uq, vq, lane, acc[2], bsum[2]);
        if (p + 1 < PE_NP) pe_prepare(S2, ent_e, 2, p + 1, uq, vq, lane);
        pe_consume(S3, ent_e, ent_g, ent_s, xqs, sxs, 3, uq, vq, lane, acc[3], bsum[3]);
    }
#pragma unroll
    for (int k = 0; k < PE_TOK; k++) {
        const float bs = 128.f * bsum[k];
        float4* o = (float4*)(out + ((size_t)grp * PE_TOK + k) * DM + lane * 16);
#pragma unroll
        for (int j = 0; j < 4; j++) {
            float4 t = o[j];
            t.x += acc[k][4 * j] - bs; t.y += acc[k][4 * j + 1] - bs; t.z += acc[k][4 * j + 2] - bs; t.w += acc[k][4 * j + 3] - bs;
            if (do_store) o[j] = t; else asm volatile("" :: "v"(t.x), "v"(t.y), "v"(t.z), "v"(t.w));
        }
    }
}

#define XB_TMO      128
#define XB_XCNT(j)  (256  + 64 * (j))
#define XB_XSUB(j)  (1280 + 64 * (j))
#define XB_XGEN(j)  (2304 + 64 * (j))
#define XB_TOP      3328
#define XB_TOPGEN   3392
#define XB_QUEUE    3456
#define XCD_BAR_WORDS 4096
#define XB_SPIN_CAP (1u << 22)
#define LAS __attribute__((address_space(3)))
__device__ __forceinline__ unsigned xb_ld(unsigned* p)              { return __hip_atomic_load(p, __ATOMIC_RELAXED, __HIP_MEMORY_SCOPE_AGENT); }
__device__ __forceinline__ unsigned xb_add(unsigned* p, unsigned v) { return __hip_atomic_fetch_add(p, v, __ATOMIC_RELAXED, __HIP_MEMORY_SCOPE_AGENT); }
__device__ __forceinline__ unsigned xb_xcc_id() { return (unsigned)__builtin_amdgcn_s_getreg((3 << 11) | 20) & 0xFu; }
#define XB_SPIN(cond, bar) do { unsigned _sp = 0; while (cond) { __builtin_amdgcn_s_sleep(1); \
    if ((++_sp & 255u) == 0u) { if (xb_ld(&(bar)[XB_TMO])) break; if (_sp > XB_SPIN_CAP) { atomicAdd(&(bar)[XB_TMO], 1u); break; } } } } while (0)
struct XcdBarrier { unsigned* bar; unsigned x; volatile LAS unsigned* st; };
__device__ __forceinline__ XcdBarrier xcd_barrier_post(unsigned* bar, volatile LAS unsigned* st) {
    XcdBarrier b; b.bar = bar; b.x = xb_xcc_id(); b.st = st;
    if (threadIdx.x == 0) (void)xb_add(&bar[XB_XCNT(b.x)], 1u);
    return b;
}
__device__ __forceinline__ void xcd_barrier_complete(unsigned* bar, unsigned x, unsigned& nloc, unsigned& nx) {
    const unsigned G = gridDim.x * gridDim.y * gridDim.z;
    unsigned sum, cnt, mine, sp = 0u;
    for (;;) {
        sum = 0u; cnt = 0u; mine = 0u;
#pragma unroll
        for (unsigned j = 0; j < 16; ++j) { const unsigned c = xb_ld(&bar[XB_XCNT(j)]); sum += c; cnt += (c > 0u) ? 1u : 0u; mine = (j == x) ? c : mine; }
        if (sum == G) break;
        __builtin_amdgcn_s_sleep(1);
        if ((++sp & 255u) == 0u) { if (xb_ld(&bar[XB_TMO])) break; if (sp > XB_SPIN_CAP) { atomicAdd(&bar[XB_TMO], 1u); break; } }
    }
    nloc = mine > 0u ? mine : 1u; nx = cnt > 0u ? cnt : 1u;
}
__device__ __forceinline__ void xcd_barrier(const XcdBarrier& b) {
    asm volatile("s_waitcnt vmcnt(0)" ::: "memory");
    __syncthreads();
    if (threadIdx.x == 0) {
        unsigned* bar = b.bar;
        __builtin_amdgcn_s_waitcnt(0);
        unsigned nloc = b.st[0], nx = b.st[1];
        if (nloc == 0u) { xcd_barrier_complete(bar, b.x, nloc, nx); b.st[0] = nloc; b.st[1] = nx; }
        const unsigned old = xb_add(&bar[XB_XSUB(b.x)], 1u);
        const unsigned gen = old / nloc;
        if (old + 1u == (gen + 1u) * nloc) {
            __builtin_amdgcn_fence(__ATOMIC_RELEASE, "agent");
            asm volatile("s_waitcnt vmcnt(0)" ::: "memory");
            const unsigned og = xb_add(&bar[XB_TOP], 1u);
            const unsigned tg = og / nx;
            if (og + 1u == (tg + 1u) * nx) xb_add(&bar[XB_TOPGEN], 1u);
            else XB_SPIN(xb_ld(&bar[XB_TOPGEN]) == tg, bar);
            __builtin_amdgcn_fence(__ATOMIC_ACQUIRE, "agent");
            xb_add(&bar[XB_XGEN(b.x)], 1u);
            asm volatile("s_waitcnt vmcnt(0)" ::: "memory");
        } else {
            XB_SPIN(xb_ld(&bar[XB_XGEN(b.x)]) == gen, bar);
            __builtin_amdgcn_fence(__ATOMIC_ACQUIRE, "agent");
            asm volatile("s_waitcnt vmcnt(0)" ::: "memory");
        }
    }
    __syncthreads();
}

struct MKP {
    const float *x, *attn_norm, *w_in, *q_gain, *k_gain, *cmp_pos, *cmp_w1, *cmp_w2, *gdn_conv, *a_log, *dt_bias, *out_gain, *w_out, *ffn_norm, *w_query, *subkeys, *peer_u, *peer_v;
    float* out; char* ws; unsigned* bar;
};

#define SMEM_BYTES 70144

__global__ __launch_bounds__(256, 2) void hybrid_megakernel(MKP P) {
    extern __shared__ __attribute__((aligned(16))) char smem[];
    __shared__ uint4 xb_words;
    __shared__ int q_item;
    const int G = gridDim.x, bid0 = blockIdx.x;
    if (threadIdx.x == 0) xb_words = make_uint4(0u, 0u, 0u, 0u);
    __syncthreads();
    XcdBarrier B = xcd_barrier_post(P.bar, (volatile LAS unsigned*)&xb_words);
    char* ws = P.ws;
    bf16_t* w_in_t = (bf16_t*)(ws + OFF_WINT);
    bf16_t* w_out_t = (bf16_t*)(ws + OFF_WOUTT);
    bf16_t* w_q_t = (bf16_t*)(ws + OFF_WQT);
    bf16_t* cw1_t = (bf16_t*)(ws + OFF_CW1T);
    float* cbias = (float*)(ws + OFF_CBIAS);
    bf16_t* h_bf = (bf16_t*)(ws + OFF_HBF);
    bf16_t* proj = (bf16_t*)(ws + OFF_PROJ);
    bf16_t* ksn = (bf16_t*)(ws + OFF_KSN);
    bf16_t* kwn = (bf16_t*)(ws + OFF_KWN);
    bf16_t* kc = (bf16_t*)(ws + OFF_KC);
    bf16_t* vc = (bf16_t*)(ws + OFF_VC);
    bf16_t* hid = (bf16_t*)(ws + OFF_HID);
    bf16_t* gu = (bf16_t*)(ws + OFF_GU);
    bf16_t* gw = (bf16_t*)(ws + OFF_GW);
    bf16_t* gqd = (bf16_t*)(ws + OFF_GQD);
    bf16_t* gkd = (bf16_t*)(ws + OFF_GKD);
    bf16_t* gin = (bf16_t*)(ws + OFF_GIN);
    float* gl = (float*)(ws + OFF_GL);
    bf16_t* mix = (bf16_t*)(ws + OFF_MIX);
    bf16_t* qry = (bf16_t*)(ws + OFF_QRY);
    bf16_t* h2 = (bf16_t*)(ws + OFF_H2);
    int* eidx = (int*)(ws + OFF_EIDX);
    float* pgate = (float*)(ws + OFF_PGATE);
    unsigned char* uq = (unsigned char*)(ws + OFF_UQ);
    unsigned char* vq = (unsigned char*)(ws + OFF_VQ);
    float* su = (float*)(ws + OFF_SU);
    float* sv = (float*)(ws + OFF_SV);
    float* og = P.out;
    float2* rope = (float2*)(ws + OFF_ROPE);
    float* ssq = (float*)(ws + OFF_SSQ);
    bf16_t* vsn = (bf16_t*)(ws + OFF_VSN);
    bf16_t* vwn = (bf16_t*)(ws + OFF_VWN);
    bf16_t* cw2t = (bf16_t*)(ws + OFF_CW2T);
    unsigned char* uq_tmp = (unsigned char*)(P.out + 8388608);
    unsigned char* vq_tmp = uq_tmp + 16384ull * 1024;

#ifdef PROBE_P0
    for (int rep = 0; rep < 2; rep++)
#endif
    {
        const int n1 = 108 * 8, n2 = n1 + 32 * 8, n3 = n2 + 64 * 8, n4 = n3 + 2 * 8 * 16, n5 = n4 + 2 * 2 * 2;
        for (int it = bid0; it < n5; it += G) {
            if (it < n1) d_transpose_bf16(P.w_in, 1024, IN_COLS, w_in_t, it % 108, it / 108, smem);
            else if (it < n2) { int r = it - n1; d_transpose_bf16(P.w_out, 1024, 1024, w_out_t, r % 32, r / 32, smem); }
            else if (it < n3) { int r = it - n2; d_transpose_bf16(P.w_query, 1024, 2048, w_q_t, r % 64, r / 64, smem, P.ffn_norm); }
            else if (it < n4) { int r = it - n3; int j = r >> 7; r &= 127; d_transpose_bf16(P.cmp_w1 + (size_t)j * 2048 * 256, 2048, 256, cw1_t + (size_t)j * 256 * 2048, r % 8, r / 8, smem); }
            else { int r = it - n4; int j = r >> 2; r &= 3; d_transpose_bf16(P.cmp_w2 + (size_t)j * 256 * 64, 256, 64, cw2t + (size_t)j * 64 * 256, r % 2, r / 2, smem); }
        }
        for (int it = bid0; it < 16; it += G) d_cmp_bias(P.cmp_pos, P.cmp_w1, cbias, it, smem);
        for (int it = bid0; it < T_TOK / 4; it += G) d_rmsnorm_bf16(P.x, P.attn_norm, h_bf, it);
        for (int i = bid0 * 256 + threadIdx.x; i < 8192 * 32; i += G * 256) {
            const int pos = i >> 5, fi = i & 31;
            float sn, cs; sincosf((float)pos * expf(-9.210340371976184f * (float)(2 * fi) / 64.f), &sn, &cs);
            rope[i] = make_float2(cs, sn);
        }
        for (int i = bid0 * 256 + threadIdx.x; i < 32 * PLD / 2; i += G * 256) ((unsigned*)(proj + (size_t)T_TOK * PLD))[i] = 0u;
    }
    xcd_barrier(B);
    {
        GemmP p{}; p.A = h_bf; p.lda = 1024; p.akts = 64; p.Bt = w_in_t; p.ldb = 1024; p.K = 1024; p.mtiles = 128; p.ntiles = 27; p.out = proj;
#ifdef PROBE_GEMM1
        for (int rep = 0; rep < PROBE_GEMM1; rep++)
#endif
        for (int it = bid0; it < 128 * 27; it += G) d_gemm<EPI_PROJ>(p, it, smem);
    }
    xcd_barrier(B);
#ifdef PROBE_MISC
    for (int rep = 0; rep < 2; rep++)
#endif
    {
        for (int it = bid0; it < 64; it += G) {
            int inst = it >> 3, tile = it & 7;
            int j = inst >> 2, b = (inst >> 1) & 1, g = inst & 1;
            GemmP p{}; p.A = proj + (size_t)(b * SEQ) * PLD + C_KV + 128 * j + 64 * g; p.lda = 16 * PLD; p.akts = PLD;
            p.Bt = cw1_t + (size_t)j * 256 * 2048; p.ldb = 2048; p.K = 2048; p.mtiles = 4; p.ntiles = 2;
            p.out = hid + (size_t)inst * 512 * 256; p.aux = cbias + j * 256;
            d_gemm<EPI_HID>(p, tile, smem);
        }
        for (int it = bid0; it < 1024; it += G) { d_gdn_prep2(proj, P.gdn_conv, P.a_log, P.dt_bias, gu, gw, gqd, gkd, gin, gl, it, smem); __syncthreads(); }
        for (int it = bid0; it < 8192; it += G) d_knorm_rope(proj, P.k_gain, ksn, kwn, vsn, vwn, rope, it);
    }
    xcd_barrier(B);
#ifdef PROBE_MISC
    for (int rep = 0; rep < 2; rep++)
#endif
    for (int wi = bid0 * 4 + (threadIdx.x >> 6); wi < 256; wi += G * 4) d_cmp2_mfma(hid, cw2t, P.k_gain, rope, kc, vc, wi, threadIdx.x & 63);
    xcd_barrier(B);
    {
#ifdef PROBE_SCAN
        if (bid0 < 64) d_gdn_scan2(gu, gw, gqd, gkd, gin, gl, og, bid0, smem);
        xcd_barrier(B);
#endif
        if (bid0 < 64) d_gdn_scan2(gu, gw, gqd, gkd, gin, gl, og, bid0, smem);
        __syncthreads();
#ifdef PROBE_NSA
        for (int rep = 0; rep < 2; rep++)
#else
        const int rep = 0;
#endif
        for (;;) {
            if (threadIdx.x == 0) q_item = (int)xb_add(&P.bar[XB_QUEUE + 256 * rep], 1u);
            __syncthreads();
            const int it = q_item;
            if (it >= 1024 + 128) break;
            if (it >= 1024) {
                const int r0 = (it - 1024) * 128 + (threadIdx.x >> 6) * 32;
                for (int r = r0; r < r0 + 32; r++) { d_quant_row(P.peer_u, uq_tmp, su, r, threadIdx.x & 63, 0); d_quant_row(P.peer_v, vq_tmp, sv, r, threadIdx.x & 63, 128); }
            } else {
#ifdef PROBE_NSA
                d_nsa_mfma(proj, P.q_gain, rope, ksn, kwn, kc, vc, vsn, vwn, mix, DM, it, smem, (PROBE_NSA == 2) && rep == 0);
#else
                d_nsa_mfma(proj, P.q_gain, rope, ksn, kwn, kc, vc, vsn, vwn, mix, DM, it, smem);
#endif
            }
            __syncthreads();
        }
#ifdef NSA_CHECK
        bf16_t* mix2 = (bf16_t*)(ws + OFF_END);
        for (;;) {
            if (threadIdx.x == 0) q_item = (int)xb_add(&P.bar[XB_QUEUE + 64], 1u);
            __syncthreads();
            const int it = q_item;
            if (it >= 2 * 2 * SEQ) break;
            d_nsa_naive(proj, P.q_gain, ksn, kwn, kc, vc, mix2, 512, it, smem);
            __syncthreads();
        }
#endif
    }
    xcd_barrier(B);
#ifdef NSA_CHECK
    {
        const bf16_t* mix2 = (const bf16_t*)(ws + OFF_END);
        float sd = 0.f, sr = 0.f;
        for (int i = bid0 * 256 + threadIdx.x; i < T_TOK * 512; i += G * 256) {
            const int r = i >> 9, c = i & 511;
            const float a = bf2f(mix[(size_t)r * DM + c]), bb = bf2f(mix2[i]);
            sd += (a - bb) * (a - bb); sr += bb * bb;
        }
        sd = wave_sum(sd); sr = wave_sum(sr);
        if ((threadIdx.x & 63) == 0) { atomicAdd((float*)&P.bar[XB_QUEUE + 128], sd); atomicAdd((float*)&P.bar[XB_QUEUE + 192], sr); }
    }
    xcd_barrier(B);
#endif
#ifdef PROBE_MISC
    for (int rep = 0; rep < 2; rep++) {
#endif
    for (int t = bid0 * 4 + (threadIdx.x >> 6); t < T_TOK; t += G * 4) d_gdn_out(og, proj, P.out_gain, mix, t, threadIdx.x & 63);
    for (int i = bid0 * 256 + threadIdx.x; i < 2 * 16384 * 1024 / 16; i += G * 256) ((uint4*)uq)[i] = ((const uint4*)uq_tmp)[i];
#ifdef PROBE_MISC
    }
#endif
    xcd_barrier(B);
#ifdef PROBE_P4
    for (int rep = 0; rep < 2; rep++) {
#endif
    {
        GemmP p{}; p.A = mix; p.lda = 1024; p.akts = 64; p.Bt = w_out_t; p.ldb = 1024; p.K = 1024; p.mtiles = 128; p.ntiles = 8; p.out = P.out; p.aux = P.x; p.out2 = h2; p.ssq = ssq;
        for (int it = bid0; it < 128 * 8; it += G) d_gemm<EPI_OUT>(p, it, smem);
    }
    xcd_barrier(B);
    {
        GemmP p{}; p.A = h2; p.lda = 1024; p.akts = 64; p.Bt = w_q_t; p.ldb = 1024; p.K = 1024; p.mtiles = 128; p.ntiles = 16; p.out = qry; p.ssq = ssq;
        for (int it = bid0; it < 128 * 16; it += G) d_gemm<EPI_QRY>(p, it, smem);
    }
    xcd_barrier(B);
#ifdef PROBE_P4
    }
#endif
    route_load_subkeys(P.subkeys, smem);
    __syncthreads();
#ifdef PROBE_ROUTE
    for (int rep = 0; rep < 2; rep++)
#endif
    for (int mt = bid0 * 4 + (threadIdx.x >> 6); mt < T_TOK / 2; mt += G * 4) d_peer_route2(qry, eidx, pgate, mt, smem, threadIdx.x & 63);
    xcd_barrier(B);
#ifdef PEER_SWEEP
    for (int grp = bid0 * 4 + (threadIdx.x >> 6); grp < T_TOK / PE_TOK; grp += G * 4) d_peer_expert5(h2, eidx, pgate, uq, vq, su, sv, P.out, grp, threadIdx.x & 63, smem + (threadIdx.x >> 6) * PE_WAVE_LDS, true);
#else
#ifdef PROBE_PEER3
    for (int it = bid0; it < T_TOK / 4; it += G) d_peer_expert3(h2, eidx, pgate, uq, vq, su, sv, ssq, P.ffn_norm, P.out, it * 4 + (threadIdx.x >> 6), threadIdx.x & 63, false, PROBE_PEER3);
    xcd_barrier(B);
#endif
    for (int it = bid0; it < T_TOK / 4; it += G) d_peer_expert3(h2, eidx, pgate, uq, vq, su, sv, ssq, P.ffn_norm, P.out, it * 4 + (threadIdx.x >> 6), threadIdx.x & 63);
#endif
#ifdef NSA_CHECK
    xcd_barrier(B);
    {
        const float sd = __hip_atomic_load((float*)&P.bar[XB_QUEUE + 128], __ATOMIC_RELAXED, __HIP_MEMORY_SCOPE_AGENT);
        const float sr = __hip_atomic_load((float*)&P.bar[XB_QUEUE + 192], __ATOMIC_RELAXED, __HIP_MEMORY_SCOPE_AGENT);
        if (!(sd <= NSA_CHECK * sr)) for (int i = bid0 * 256 + threadIdx.x; i < T_TOK * DM; i += G * 256) P.out[i] += 1000.f;
    }
#endif
}

extern "C" void kernel_launch(void* const* d_in, const int* in_sizes, int n_in, void* d_out, int out_size, void* d_ws, size_t ws_size,
                              hipStream_t stream) {
#ifdef NSA_CHECK
    const size_t bar_off = ((OFF_END + 16384ull * 512 * 2) + 255) & ~(size_t)255;
#else
    const size_t bar_off = (OFF_END + 255) & ~(size_t)255;
#endif
    if (ws_size < bar_off + XCD_BAR_WORDS * 4) return;
    static int grid_blocks = 0;
    if (!grid_blocks) {
        int dev = 0, cus = 0, per_cu = 0;
        (void)hipGetDevice(&dev);
        (void)hipDeviceGetAttribute(&cus, hipDeviceAttributeMultiprocessorCount, dev);
        (void)hipFuncSetAttribute((const void*)hybrid_megakernel, hipFuncAttributeMaxDynamicSharedMemorySize, SMEM_BYTES);
        (void)hipOccupancyMaxActiveBlocksPerMultiprocessor(&per_cu, hybrid_megakernel, 256, SMEM_BYTES);
        if (per_cu > 2) per_cu = 2;
        grid_blocks = cus * per_cu;
    }
    if (grid_blocks <= 0) return;
    MKP P{};
    P.x = (const float*)d_in[0]; P.attn_norm = (const float*)d_in[1]; P.w_in = (const float*)d_in[2]; P.q_gain = (const float*)d_in[3];
    P.k_gain = (const float*)d_in[4]; P.cmp_pos = (const float*)d_in[5]; P.cmp_w1 = (const float*)d_in[6]; P.cmp_w2 = (const float*)d_in[7];
    P.gdn_conv = (const float*)d_in[8]; P.a_log = (const float*)d_in[9]; P.dt_bias = (const float*)d_in[10]; P.out_gain = (const float*)d_in[11];
    P.w_out = (const float*)d_in[12]; P.ffn_norm = (const float*)d_in[13]; P.w_query = (const float*)d_in[14]; P.subkeys = (const float*)d_in[15];
    P.peer_u = (const float*)d_in[16]; P.peer_v = (const float*)d_in[17];
    P.out = (float*)d_out; P.ws = (char*)d_ws; P.bar = (unsigned*)((char*)d_ws + bar_off);
    (void)hipMemsetAsync(P.bar, 0, XCD_BAR_WORDS * 4, stream);
    hipLaunchKernelGGL(hybrid_megakernel, dim3(grid_blocks), dim3(256), SMEM_BYTES, stream, P);
}
```

```cpp
#include <hip/hip_runtime.h>
#include <stdint.h>

typedef unsigned short bf16_t;
typedef __attribute__((ext_vector_type(8))) short bf16x8;
typedef __attribute__((ext_vector_type(4))) float f32x4;
typedef __attribute__((ext_vector_type(2))) float f32x2;
#define LAS3 __attribute__((address_space(3)))

#define T_TOK 16384
#define SEQ 8192
#define DM 1024
#define IN_COLS 3360
#define PLD 3456
#define C_Q 0
#define C_KV 512
#define C_GATE 1280
#define C_GQKV 1304
#define C_Z 2840
#define C_A 3352
#define C_B 3356

#define OFF_WINT   0ull
#define OFF_WOUTT  (OFF_WINT  + 3456ull*1024*2)
#define OFF_WQT    (OFF_WOUTT + 1024ull*1024*2)
#define OFF_CW1T   (OFF_WQT   + 2048ull*1024*2)
#define OFF_CBIAS  (OFF_CW1T  + 2ull*256*2048*2)
#define OFF_HBF    (OFF_CBIAS + 4096ull)
#define OFF_PROJ   (OFF_HBF   + 16384ull*1024*2)
#define OFF_KSN    (OFF_PROJ  + (16384ull+32)*PLD*2)
#define OFF_KWN    (OFF_KSN   + 4ull*8192*64*2)
#define OFF_KC     (OFF_KWN   + 4ull*8192*64*2)
#define OFF_VC     (OFF_KC    + 4ull*512*64*2)
#define OFF_HID    (OFF_VC    + 4ull*512*64*2)
#define OFF_GU     (OFF_HID   + 8ull*512*256*2)
#define OFF_GW     (OFF_GU    + 1024ull*64*128*2)
#define OFF_GQD    (OFF_GW    + 1024ull*64*128*2)
#define OFF_GKD    (OFF_GQD   + 1024ull*64*128*2)
#define OFF_GIN    (OFF_GKD   + 1024ull*64*128*2)
#define OFF_GL     (OFF_GIN   + 1024ull*64*64*2)
#define OFF_ROPE   (OFF_GL    + 4096ull)
#define OFF_CW2T   (OFF_ROPE  + 8192ull*32*8)
#define OFF_SU     (OFF_CW2T  + 2ull*64*256*2)
#define OFF_SV     (OFF_SU    + 65536ull)
#define OFF_SSQ    (OFF_SV    + 65536ull)
#define OFF_VSN    (OFF_SSQ   + 16384ull*16*4)
#define OFF_VWN    (OFF_VSN   + 4ull*8192*64*2)
#define OFF_END    (OFF_VWN   + 4ull*8192*64*2)
#define OFF_MIX    OFF_HBF
#define OFF_QRY    OFF_PROJ
#define OFF_H2     (OFF_PROJ + 16384ull*2048*2)
#define OFF_EIDX   OFF_KSN
#define OFF_PGATE  OFF_GIN
#define OFF_UQ     OFF_GU
#define OFF_VQ     (OFF_GU + 16384ull*1024)

__device__ __forceinline__ bf16_t f2bf(float f) {
    unsigned u = __float_as_uint(f);
    u += 0x7fffu + ((u >> 16) & 1u);
    return (bf16_t)(u >> 16);
}
__device__ __forceinline__ float bf2f(bf16_t h) { return __uint_as_float(((unsigned)h) << 16); }
typedef __bf16 bf16x2_t2 __attribute__((ext_vector_type(2)));
__device__ __forceinline__ unsigned pk2(float a, float b) { bf16x2_t2 v; v[0] = (__bf16)a; v[1] = (__bf16)b; return __builtin_bit_cast(unsigned, v); }
__device__ __forceinline__ float gelu_tanh(float x) {
    float u = 0.7978845608028654f * (x + 0.044715f * x * x * x);
    return 0.5f * x * (1.f + tanhf(u));
}
__device__ __forceinline__ float sigmoidf_(float x) { return 1.f / (1.f + __expf(-x)); }
__device__ __forceinline__ float wave_sum(float v) {
#pragma unroll
    for (int o = 32; o > 0; o >>= 1) v += __shfl_xor(v, o);
    return v;
}
__device__ __forceinline__ float wave_max(float v) {
#pragma unroll
    for (int o = 32; o > 0; o >>= 1) v = fmaxf(v, __shfl_xor(v, o));
    return v;
}

template <int CTRL> __device__ __forceinline__ float dppf(float x) { return __builtin_bit_cast(float, __builtin_amdgcn_update_dpp(0, __builtin_bit_cast(int, x), CTRL, 0xf, 0xf, true)); }
template <int CTRL> __device__ __forceinline__ unsigned dppu(unsigned x) { return (unsigned)__builtin_amdgcn_update_dpp(0, (int)x, CTRL, 0xf, 0xf, true); }
__device__ __forceinline__ float allmax16(float x) {
    x = fmaxf(x, dppf<0xB1>(x)); x = fmaxf(x, dppf<0x4E>(x)); x = fmaxf(x, dppf<0x141>(x)); x = fmaxf(x, dppf<0x140>(x)); return x;
}
__device__ __forceinline__ unsigned allmaxu16(unsigned x) {
    x = max(x, dppu<0xB1>(x)); x = max(x, dppu<0x4E>(x)); x = max(x, dppu<0x141>(x)); x = max(x, dppu<0x140>(x)); return x;
}
__device__ __forceinline__ float allsum16(float x) {
    x += dppf<0xB1>(x); x += dppf<0x4E>(x); x += dppf<0x141>(x); x += dppf<0x140>(x); return x;
}
__device__ __forceinline__ float wave_sum_dpp(float x) {
    x = allsum16(x);
    return __builtin_bit_cast(float, __builtin_amdgcn_readlane(__builtin_bit_cast(int, x), 0)) + __builtin_bit_cast(float, __builtin_amdgcn_readlane(__builtin_bit_cast(int, x), 16)) +
           __builtin_bit_cast(float, __builtin_amdgcn_readlane(__builtin_bit_cast(int, x), 32)) + __builtin_bit_cast(float, __builtin_amdgcn_readlane(__builtin_bit_cast(int, x), 48));
}
__device__ __forceinline__ void d_transpose_bf16(const float* __restrict__ W, int K, int N, bf16_t* __restrict__ Wt, int bx, int by, char* smem, const float* __restrict__ kscale = nullptr) {
    float* tile = (float*)smem;
    const int n0 = bx * 32, k0 = by * 128;
    const int tx = threadIdx.x & 31, ty = threadIdx.x >> 5;
    const int n = n0 + tx;
    float v[16];
#pragma unroll
    for (int i = 0; i < 16; i++) { const int k = k0 + ty + 8 * i; v[i] = (n < N) ? W[(size_t)k * N + n] : 0.f; }
#pragma unroll
    for (int i = 0; i < 16; i++) { const int kk = ty + 8 * i; tile[kk * 33 + tx] = v[i] * (kscale ? kscale[k0 + kk] : 1.f); }
    __syncthreads();
    {
        const int nn = threadIdx.x >> 3, kc = (threadIdx.x & 7) * 16;
        unsigned pk[8];
#pragma unroll
        for (int j = 0; j < 8; j++) pk[j] = pk2(tile[(kc + 2 * j) * 33 + nn], tile[(kc + 2 * j + 1) * 33 + nn]);
        uint4* dst = (uint4*)(Wt + (size_t)(n0 + nn) * K + k0 + kc);
        dst[0] = make_uint4(pk[0], pk[1], pk[2], pk[3]); dst[1] = make_uint4(pk[4], pk[5], pk[6], pk[7]);
    }
    __syncthreads();
}

__device__ __forceinline__ void d_rmsnorm_bf16(const float* __restrict__ x, const float* __restrict__ g, bf16_t* __restrict__ out, int bid) {
    int row = bid * 4 + (threadIdx.x >> 6);
    int lane = threadIdx.x & 63;
    const float4* xr = (const float4*)(x + (size_t)row * DM);
    float4 v[4];
    float ss = 0.f;
#pragma unroll
    for (int i = 0; i < 4; i++) { v[i] = xr[lane + 64 * i]; ss += v[i].x * v[i].x + v[i].y * v[i].y + v[i].z * v[i].z + v[i].w * v[i].w; }
    ss = wave_sum(ss);
    float r = rsqrtf(ss * (1.f / DM) + 1e-6f);
#pragma unroll
    for (int i = 0; i < 4; i++) {
        float4 gg = ((const float4*)g)[lane + 64 * i];
        ushort4 o;
        o.x = f2bf(v[i].x * r * gg.x); o.y = f2bf(v[i].y * r * gg.y); o.z = f2bf(v[i].z * r * gg.z); o.w = f2bf(v[i].w * r * gg.w);
        ((ushort4*)(out + (size_t)row * DM))[lane + 64 * i] = o;
    }
}

__device__ __forceinline__ void d_cmp_bias(const float* __restrict__ pos, const float* __restrict__ w1, float* __restrict__ bias, int item, char* smem) {
    float* part = (float*)smem;
    const int j = item >> 3, c = (item & 7) * 32 + (threadIdx.x & 31), ksl = threadIdx.x >> 5;
    float s0 = 0.f, s1 = 0.f, s2 = 0.f, s3 = 0.f;
    const float* wp = w1 + ((size_t)j * 2048 + ksl * 256) * 256 + c;
    const float* pp = pos + j * 2048 + ksl * 256;
    for (int k = 0; k < 256; k += 4) {
        s0 += pp[k] * wp[(size_t)k * 256]; s1 += pp[k + 1] * wp[(size_t)(k + 1) * 256];
        s2 += pp[k + 2] * wp[(size_t)(k + 2) * 256]; s3 += pp[k + 3] * wp[(size_t)(k + 3) * 256];
    }
    part[ksl * 32 + (threadIdx.x & 31)] = (s0 + s1) + (s2 + s3);
    __syncthreads();
    if (threadIdx.x < 32) {
        float t = 0.f;
#pragma unroll
        for (int i = 0; i < 8; i++) t += part[i * 32 + threadIdx.x];
        bias[j * 256 + c] = t;
    }
    __syncthreads();
}

#define EPI_PROJ 0
#define EPI_HID 1
#define EPI_OUT 2
#define EPI_QRY 3
struct GemmP {
    const bf16_t* A; long lda; long akts;
    const bf16_t* Bt; long ldb;
    int K; int mtiles; int ntiles;
    long a_inst; long b_inst;
    void* out; const float* aux; const float* aux2; bf16_t* out2; float* ssq;
};

template <int EPI>
__device__ __forceinline__ void d_gemm(const GemmP& p, int bid, char* smem) {
    const int tid = threadIdx.x, lane = tid & 63, wave = tid >> 6;
    const int wm = wave >> 1, wn = wave & 1;
    const int inst = 0;
    const int nwg = p.mtiles * p.ntiles, wgid = (bid & 7) * (nwg >> 3) + (bid >> 3);
    const int mt = wgid / p.ntiles, nt = wgid % p.ntiles;
    const int m0 = mt * 128, n0 = nt * 128;
    const bf16_t* A = p.A + (size_t)inst * p.a_inst + (size_t)m0 * p.lda;
    const bf16_t* Bt = p.Bt + (size_t)inst * p.b_inst + (size_t)n0 * p.ldb;
    f32x4 acc[4][4];
#pragma unroll
    for (int i = 0; i < 4; i++)
#pragma unroll
        for (int j = 0; j < 4; j++) acc[i][j] = (f32x4){0.f, 0.f, 0.f, 0.f};
    const int nk = p.K >> 6;
    const int crow = tid >> 3, cslot = tid & 7;
    const int csrc = (cslot ^ (crow & 7)) * 8;
    const bf16_t* Ap = A + (size_t)crow * p.lda + csrc;
    const bf16_t* Bp = Bt + (size_t)crow * p.ldb + csrc;
    const size_t a32 = (size_t)32 * p.lda, b32 = (size_t)32 * p.ldb;
    char* ldsw = smem + tid * 16;
#define GSTAGE(buf, koffA, koffB) { char* _d = ldsw + (buf) * 32768; \
    __builtin_amdgcn_global_load_lds((const unsigned*)(Ap + (koffA)), (LAS3 unsigned*)(_d), 16, 0, 0); \
    __builtin_amdgcn_global_load_lds((const unsigned*)(Ap + a32 + (koffA)), (LAS3 unsigned*)(_d + 4096), 16, 0, 0); \
    __builtin_amdgcn_global_load_lds((const unsigned*)(Ap + 2 * a32 + (koffA)), (LAS3 unsigned*)(_d + 8192), 16, 0, 0); \
    __builtin_amdgcn_global_load_lds((const unsigned*)(Ap + 3 * a32 + (koffA)), (LAS3 unsigned*)(_d + 12288), 16, 0, 0); \
    __builtin_amdgcn_global_load_lds((const unsigned*)(Bp + (koffB)), (LAS3 unsigned*)(_d + 16384), 16, 0, 0); \
    __builtin_amdgcn_global_load_lds((const unsigned*)(Bp + b32 + (koffB)), (LAS3 unsigned*)(_d + 16384 + 4096), 16, 0, 0); \
    __builtin_amdgcn_global_load_lds((const unsigned*)(Bp + 2 * b32 + (koffB)), (LAS3 unsigned*)(_d + 16384 + 8192), 16, 0, 0); \
    __builtin_amdgcn_global_load_lds((const unsigned*)(Bp + 3 * b32 + (koffB)), (LAS3 unsigned*)(_d + 16384 + 12288), 16, 0, 0); }
    const int n16 = lane & 15, kq = lane >> 4;
    GSTAGE(0, 0, 0)
    for (int kt = 0; kt < nk; kt++) {
        if (kt + 1 < nk) {
            GSTAGE((kt + 1) & 1, (size_t)(kt + 1) * p.akts, (size_t)(kt + 1) * 64)
            asm volatile("s_waitcnt vmcnt(8)" ::: "memory");
        } else {
            asm volatile("s_waitcnt vmcnt(0)" ::: "memory");
        }
        __builtin_amdgcn_s_barrier();
        const char* Ab = smem + (kt & 1) * 32768;
        const char* Bb = Ab + 16384;
#pragma unroll
        for (int ks = 0; ks < 2; ks++) {
            bf16x8 af[4], bfr[4];
#pragma unroll
            for (int i = 0; i < 4; i++) { const int R = wm * 64 + i * 16 + n16; af[i] = *(const bf16x8*)(Ab + R * 128 + (((4 * ks + kq) ^ (R & 7)) << 4)); }
#pragma unroll
            for (int j = 0; j < 4; j++) { const int R = wn * 64 + j * 16 + n16; bfr[j] = *(const bf16x8*)(Bb + R * 128 + (((4 * ks + kq) ^ (R & 7)) << 4)); }
#pragma unroll
            for (int i = 0; i < 4; i++)
#pragma unroll
                for (int j = 0; j < 4; j++) acc[i][j] = __builtin_amdgcn_mfma_f32_16x16x32_bf16(bfr[j], af[i], acc[i][j], 0, 0, 0);
        }
        asm volatile("s_waitcnt lgkmcnt(0)" ::: "memory");
        __builtin_amdgcn_s_barrier();
    }
    {
        char* slab = smem + wave * 9216;
        const int rbase = m0 + wm * 64, cbase = n0 + wn * 64;
        if (EPI == EPI_OUT) {
            float* st = (float*)slab;
#pragma unroll
            for (int hlf = 0; hlf < 2; hlf++) {
#pragma unroll
                for (int ii = 0; ii < 2; ii++)
#pragma unroll
                    for (int j = 0; j < 4; j++) *(f32x4*)(st + (ii * 16 + n16) * 68 + j * 16 + 4 * kq) = acc[hlf * 2 + ii][j];
#pragma unroll
                for (int ps = 0; ps < 8; ps++) {
                    const int rl = ps * 4 + kq, row = rbase + hlf * 32 + rl;
                    const float4 a = *(const float4*)(st + rl * 68 + n16 * 4);
                    const float4 xx = *(const float4*)(p.aux + (size_t)row * DM + cbase + n16 * 4);
                    const float4 o = make_float4(xx.x + a.x, xx.y + a.y, xx.z + a.z, xx.w + a.w);
                    *(float4*)((float*)p.out + (size_t)row * DM + cbase + n16 * 4) = o;
                    *(uint2*)(p.out2 + (size_t)row * DM + cbase + n16 * 4) = make_uint2(pk2(o.x, o.y), pk2(o.z, o.w));
                    const float ss = allsum16(o.x * o.x + o.y * o.y + o.z * o.z + o.w * o.w);
                    if (n16 == 0) p.ssq[(size_t)row * 16 + nt * 2 + wn] = ss;
                }
            }
        } else {
            bf16_t* st = (bf16_t*)slab;
#pragma unroll
            for (int i = 0; i < 4; i++) {
                float rs = 1.f;
                if (EPI == EPI_QRY) {
                    const float4* q = (const float4*)(p.ssq + (size_t)(rbase + i * 16 + n16) * 16);
                    const float4 q0 = q[0], q1 = q[1], q2 = q[2], q3 = q[3];
                    const float t = ((q0.x + q0.y) + (q0.z + q0.w)) + ((q1.x + q1.y) + (q1.z + q1.w)) + ((q2.x + q2.y) + (q2.z + q2.w)) + ((q3.x + q3.y) + (q3.z + q3.w));
                    rs = rsqrtf(t * (1.f / DM) + 1e-6f);
                }
#pragma unroll
                for (int j = 0; j < 4; j++) {
                    float v0 = acc[i][j][0], v1 = acc[i][j][1], v2 = acc[i][j][2], v3 = acc[i][j][3];
                    if (EPI == EPI_HID) {
                        const float4 bb = *(const float4*)(p.aux + (inst >> 2) * 256 + cbase + 16 * j + 4 * kq);
                        v0 = gelu_tanh(v0 + bb.x); v1 = gelu_tanh(v1 + bb.y); v2 = gelu_tanh(v2 + bb.z); v3 = gelu_tanh(v3 + bb.w);
                    }
                    if (EPI == EPI_QRY) { v0 *= rs; v1 *= rs; v2 *= rs; v3 *= rs; }
                    *(uint2*)(st + (i * 16 + n16) * 72 + j * 16 + 4 * kq) = make_uint2(pk2(v0, v1), pk2(v2, v3));
                }
            }
            const int ld = (EPI == EPI_PROJ) ? PLD : (EPI == EPI_HID ? 256 : 2048);
#pragma unroll
            for (int ps = 0; ps < 8; ps++) {
                const int rl = ps * 8 + (lane >> 3), ch = lane & 7;
                const uint4 v = *(const uint4*)(st + rl * 72 + ch * 8);
                *(uint4*)((bf16_t*)p.out + (size_t)(rbase + rl) * ld + cbase + ch * 8) = v;
            }
        }
        __syncthreads();
    }
}

__device__ __forceinline__ void d_knorm_rope(const bf16_t* __restrict__ proj, const float* __restrict__ kgain, bf16_t* __restrict__ ksn, bf16_t* __restrict__ kwn, bf16_t* __restrict__ vsn, bf16_t* __restrict__ vwn, const float2* __restrict__ rope, int bid) {
    int vec = bid * 8 + (threadIdx.x >> 5);
    int i = threadIdx.x & 31;
    int which = vec >> 15;
    int rem = vec & 32767;
    int b = rem >> 14, g = (rem >> 13) & 1, s = rem & 8191;
    const bf16_t* src = proj + (size_t)(b * SEQ + s) * PLD + C_KV + 128 * (which ? 4 : 2) + 64 * g;
    float x1 = bf2f(src[i]), x2 = bf2f(src[i + 32]);
    float ss = x1 * x1 + x2 * x2;
#pragma unroll
    for (int o = 16; o > 0; o >>= 1) ss += __shfl_xor(ss, o);
    float r = rsqrtf(ss * (1.f / 64.f) + 1e-6f);
    const float* gn = kgain + (which ? 2 : 1) * 64;
    x1 = x1 * r * gn[i]; x2 = x2 * r * gn[i + 32];
    const float2 cs2 = rope[(size_t)s * 32 + i];
    const float cs = cs2.x, sn = cs2.y;
    bf16_t* dst = (which ? kwn : ksn) + ((size_t)(b * 2 + g) * SEQ + s) * 64;
    dst[i] = f2bf(x1 * cs - x2 * sn);
    dst[i + 32] = f2bf(x2 * cs + x1 * sn);
    ((unsigned*)((which ? vwn : vsn) + ((size_t)(b * 2 + g) * SEQ + s) * 64))[i] = ((const unsigned*)(src + 128))[i];
}

__device__ __forceinline__ void d_cmp2_mfma(const bf16_t* __restrict__ hid, const bf16_t* __restrict__ cw2t, const float* __restrict__ kgain, const float2* __restrict__ rope,
                                            bf16_t* __restrict__ kc, bf16_t* __restrict__ vc, int witem, int lane) {
    const int n16 = lane & 15, kq = lane >> 4;
    const int rowbase = 16 * witem, inst = rowbase >> 9, n0 = rowbase & 511, j = inst >> 2, bg = inst & 3;
    f32x4 acc[4];
#pragma unroll
    for (int nt = 0; nt < 4; nt++) acc[nt] = (f32x4){0.f, 0.f, 0.f, 0.f};
    const bf16_t* ap = hid + (size_t)(rowbase + n16) * 256 + 8 * kq;
    const bf16_t* bp = cw2t + (size_t)j * 64 * 256 + n16 * 256 + 8 * kq;
#pragma unroll
    for (int ks = 0; ks < 8; ks++) {
        const bf16x8 a = *(const bf16x8*)(ap + 32 * ks);
#pragma unroll
        for (int nt = 0; nt < 4; nt++) {
            const bf16x8 bb = *(const bf16x8*)(bp + (size_t)(16 * nt) * 256 + 32 * ks);
            acc[nt] = __builtin_amdgcn_mfma_f32_16x16x32_bf16(a, bb, acc[nt], 0, 0, 0);
        }
    }
#pragma unroll
    for (int r = 0; r < 4; r++) {
        const int n = n0 + 4 * kq + r;
        if (j == 0) {
            float ss = acc[0][r] * acc[0][r] + acc[1][r] * acc[1][r] + acc[2][r] * acc[2][r] + acc[3][r] * acc[3][r];
            ss = allsum16(ss);
            const float ri = rsqrtf(ss * (1.f / 64.f) + 1e-6f);
#pragma unroll
            for (int nt = 0; nt < 2; nt++) {
                const int i = 16 * nt + n16;
                const float y1 = acc[nt][r] * ri * kgain[i], y2 = acc[nt + 2][r] * ri * kgain[i + 32];
                const float2 cs = rope[(size_t)((n < 511 ? n : 510) * 16 + 31) * 32 + i];
                if (n < 511) {
                    kc[((size_t)bg * 512 + n) * 64 + i] = f2bf(y1 * cs.x - y2 * cs.y);
                    kc[((size_t)bg * 512 + n) * 64 + i + 32] = f2bf(y2 * cs.x + y1 * cs.y);
                }
            }
        } else if (n < 511) {
#pragma unroll
            for (int nt = 0; nt < 4; nt++) vc[((size_t)bg * 512 + n) * 64 + 16 * nt + n16] = f2bf(acc[nt][r]);
        }
    }
}

__device__ __forceinline__ float dot64(const float* q, const bf16_t* krow) {
    const uint4* kp = (const uint4*)krow;
    float s = 0.f;
#pragma unroll
    for (int c = 0; c < 8; c++) {
        uint4 u = kp[c];
        unsigned w[4] = {u.x, u.y, u.z, u.w};
#pragma unroll
        for (int e = 0; e < 4; e++) {
            s += q[c * 8 + e * 2] * __uint_as_float(w[e] << 16);
            s += q[c * 8 + e * 2 + 1] * __uint_as_float(w[e] & 0xffff0000u);
        }
    }
    return s;
}

__device__ __forceinline__ void d_nsa_naive(const bf16_t* __restrict__ proj, const float* __restrict__ qgain,
                                                   const bf16_t* __restrict__ ksn, const bf16_t* __restrict__ kwn,
                                                   const bf16_t* __restrict__ kc, const bf16_t* __restrict__ vc,
                                                   bf16_t* __restrict__ mix, int mix_ld, int bid, char* smem) {
    float (*qs)[64] = (float (*)[64])smem;
    float (*pbuf)[1024] = (float (*)[1024])(smem + 1024);
    float* sc = (float*)(smem + 1024 + 16384);
    int* sel = (int*)(smem + 1024 + 16384 + 512);
    const int tid = threadIdx.x, lane = tid & 63, w = tid >> 6;
    const int blk = bid;
    const int t = blk & 8191, g = (blk >> 13) & 1, b = blk >> 14;
    const int bg = b * 2 + g;
    const size_t row = (size_t)(b * SEQ + t);
    const int head = g * 4 + w;
    {
        int i = lane & 31;
        const bf16_t* src = proj + row * PLD + C_Q + head * 64;
        float x1 = bf2f(src[i]), x2 = bf2f(src[i + 32]);
        float ss = x1 * x1 + x2 * x2;
#pragma unroll
        for (int o = 16; o > 0; o >>= 1) ss += __shfl_xor(ss, o);
        float r = rsqrtf(ss * (1.f / 64.f) + 1e-6f);
        x1 = x1 * r * qgain[i]; x2 = x2 * r * qgain[i + 32];
        float inv = expf(-9.210340371976184f * (float)(2 * i) / 64.f);
        float ang = (float)t * inv;
        float sn, cs; sincosf(ang, &sn, &cs);
        if (lane < 32) { qs[w][i] = (x1 * cs - x2 * sn) * 0.125f; qs[w][i + 32] = (x2 * cs + x1 * sn) * 0.125f; }
    }
    __syncthreads();
    float q[64];
#pragma unroll
    for (int d = 0; d < 64; d++) q[d] = qs[w][d];
    float o_c = 0.f, o_s = 0.f, o_w = 0.f;
    const int nvis = (t >= 31) ? (((t - 31) >> 4) + 1) : 0;
    {
        float s[8];
        float m = -3e38f;
#pragma unroll
        for (int i = 0; i < 8; i++) {
            int n = lane + 64 * i;
            if (n < nvis) { s[i] = dot64(q, kc + ((size_t)bg * 512 + n) * 64); m = fmaxf(m, s[i]); } else s[i] = -3e38f;
        }
        m = wave_max(m);
        float l = 0.f;
#pragma unroll
        for (int i = 0; i < 8; i++) { int n = lane + 64 * i; s[i] = (n < nvis) ? __expf(s[i] - m) : 0.f; l += s[i]; }
        l = wave_sum(l);
        float il = (nvis > 0) ? 1.f / l : 0.f;
#pragma unroll
        for (int i = 0; i < 8; i++) pbuf[w][lane + 64 * i] = s[i] * il;
        __syncthreads();
        const bf16_t* vp = vc + (size_t)bg * 512 * 64 + lane;
        for (int n = 0; n < nvis; n++) o_c += pbuf[w][n] * bf2f(vp[(size_t)n * 64]);
    }
    if (tid < 128) {
        int j = tid;
        float im = 0.f;
#pragma unroll
        for (int h = 0; h < 4; h++) {
            float a = (j > 0) ? pbuf[h][4 * j - 1] : 0.f;
            im += a + 2.f * (pbuf[h][4 * j] + pbuf[h][4 * j + 1] + pbuf[h][4 * j + 2]) + pbuf[h][4 * j + 3];
        }
        int cur = t >> 6;
        float v;
        if (j > cur) v = -1e30f;
        else if (j == 0 || j == cur || j == cur - 1) v = 1e4f;
        else v = im;
        sc[j] = v;
    }
    __syncthreads();
    if (w == 0) {
        float v0 = sc[lane], v1 = sc[lane + 64];
        for (int it = 0; it < 16; it++) {
            float bv; int bi;
            if (v0 >= v1) { bv = v0; bi = lane; } else { bv = v1; bi = lane + 64; }
#pragma unroll
            for (int o = 32; o > 0; o >>= 1) {
                float ov = __shfl_xor(bv, o); int oi = __shfl_xor(bi, o);
                if (ov > bv || (ov == bv && oi < bi)) { bv = ov; bi = oi; }
            }
            if (lane == 0) sel[it] = (bv > -1e29f) ? bi : -1;
            if (bi == lane) v0 = -3e38f;
            if (bi == lane + 64) v1 = -3e38f;
        }
    }
    __syncthreads();
    {
        float s[16];
        float m = -3e38f;
#pragma unroll
        for (int i = 0; i < 16; i++) {
            int bk = sel[i];
            int pos = bk * 64 + lane;
            if (bk >= 0 && pos <= t) { s[i] = dot64(q, ksn + ((size_t)bg * SEQ + pos) * 64); m = fmaxf(m, s[i]); } else s[i] = -3e38f;
        }
        m = wave_max(m);
        float l = 0.f;
#pragma unroll
        for (int i = 0; i < 16; i++) { s[i] = (s[i] > -1e38f) ? __expf(s[i] - m) : 0.f; l += s[i]; }
        l = wave_sum(l);
        float il = 1.f / l;
#pragma unroll
        for (int i = 0; i < 16; i++) pbuf[w][i * 64 + lane] = s[i] * il;
        __syncthreads();
        for (int i = 0; i < 16; i++) {
            int bk = sel[i];
            if (bk < 0) continue;
            const bf16_t* vp = proj + (size_t)(b * SEQ + bk * 64) * PLD + C_KV + 128 * 3 + 64 * g + lane;
            int kmax = min(64, t - bk * 64 + 1);
            for (int kk = 0; kk < kmax; kk++) o_s += pbuf[w][i * 64 + kk] * bf2f(vp[(size_t)kk * PLD]);
        }
    }
    __syncthreads();
    {
        float s[8];
        float m = -3e38f;
        const int p0 = t - 511;
#pragma unroll
        for (int i = 0; i < 8; i++) {
            int pos = p0 + lane + 64 * i;
            if (pos >= 0) { s[i] = dot64(q, kwn + ((size_t)bg * SEQ + pos) * 64); m = fmaxf(m, s[i]); } else s[i] = -3e38f;
        }
        m = wave_max(m);
        float l = 0.f;
#pragma unroll
        for (int i = 0; i < 8; i++) { s[i] = (s[i] > -1e38f) ? __expf(s[i] - m) : 0.f; l += s[i]; }
        l = wave_sum(l);
        float il = 1.f / l;
#pragma unroll
        for (int i = 0; i < 8; i++) pbuf[w][lane + 64 * i] = s[i] * il;
        __syncthreads();
        int kstart = (p0 < 0) ? -p0 : 0;
        const bf16_t* vp = proj + (size_t)(b * SEQ) * PLD + C_KV + 128 * 5 + 64 * g + lane;
        for (int kk = kstart; kk < 512; kk++) o_w += pbuf[w][kk] * bf2f(vp[(size_t)(p0 + kk) * PLD]);
    }
    const bf16_t* gp = proj + row * PLD + C_GATE + head * 3;
    float g0 = sigmoidf_(bf2f(gp[0])), g1 = sigmoidf_(bf2f(gp[1])), g2 = sigmoidf_(bf2f(gp[2]));
    mix[row * mix_ld + head * 64 + lane] = f2bf(g0 * o_c + g1 * o_s + g2 * o_w);
}

typedef float f32x16 __attribute__((ext_vector_type(16)));
typedef short s16x4 __attribute__((ext_vector_type(4)));
#define MFMA32(a, b, c) __builtin_amdgcn_mfma_f32_32x32x16_bf16((a), (b), (c), 0, 0, 0)
#define NKS 72
#define NSA_K_OFF 0
#define NSA_V_OFF (2 * 64 * NKS * 2)
#define NSA_IMP_OFF (NSA_V_OFF + 2 * 64 * NKS * 2)
#define NSA_SEL_OFF (NSA_IMP_OFF + 4 * 8192)
#define NSA_LDS (NSA_SEL_OFF + 32 * 4 * 4)
#define NEGBIG (-1e30f)
__device__ __forceinline__ bf16x8 pack8(float a0, float a1, float a2, float a3, float a4, float a5, float a6, float a7) {
    uint4 u = make_uint4(pk2(a0, a1), pk2(a2, a3), pk2(a4, a5), pk2(a6, a7));
    return __builtin_bit_cast(bf16x8, u);
}
typedef unsigned u32x4 __attribute__((ext_vector_type(4)));
struct NsaStage { u32x4 k0, k1, v0, v1; };
struct NsaCtx {
    bool noload;
    const bf16_t* Kbase; long kstride;
    const bf16_t* Vbase; long vstride;
    bf16_t* Kb; bf16_t* Vb;
    float* imp_s; unsigned* sel_s;
    bf16x8 qf[4];
    f32x16 O0, O1;
    float m, l, invl, carry;
    int t, tokl, hp, hh, c, lane;
};
__device__ __forceinline__ void nsa_stage_load(const NsaCtx& X, NsaStage& st, int j) {
    const int r0 = threadIdx.x >> 3, c8 = (threadIdx.x & 7) * 8;
    if (X.noload) { st.k0 = (u32x4){0u,0u,0u,0u}; st.k1 = st.k0; st.v0 = st.k0; st.v1 = st.k0; return; }
    const bf16_t* kp = X.Kbase + (size_t)(64 * j + r0) * X.kstride + c8;
    const bf16_t* vp = X.Vbase + (size_t)(64 * j + r0) * X.vstride + c8;
    st.k0 = *(const u32x4*)kp; st.k1 = *(const u32x4*)(kp + 32 * X.kstride);
    st.v0 = *(const u32x4*)vp; st.v1 = *(const u32x4*)(vp + 32 * X.vstride);
}
__device__ __forceinline__ void nsa_stage_store(const NsaCtx& X, const NsaStage& st, int buf) {
    const int r0 = threadIdx.x >> 3, c8 = (threadIdx.x & 7) * 8;
    bf16_t* kb = X.Kb + buf * 64 * NKS + r0 * NKS + c8;
    bf16_t* vb = X.Vb + buf * 64 * NKS + r0 * NKS + c8;
    *(u32x4*)kb = st.k0; *(u32x4*)(kb + 32 * NKS) = st.k1;
    *(u32x4*)vb = st.v0; *(u32x4*)(vb + 32 * NKS) = st.v1;
}
template <int MODE, bool FAST>
__device__ __forceinline__ void nsa_tile(NsaCtx& X, int j, int kt, int buf, unsigned long long mlo, unsigned long long mhi) {
    const bf16_t* Kt = X.Kb + buf * 64 * NKS + (32 * kt) * NKS;
    const bf16_t* Vt = X.Vb + buf * 64 * NKS + (32 * kt) * NKS;
    f32x16 S;
#pragma unroll
    for (int i = 0; i < 16; i++) S[i] = 0.f;
#pragma unroll
    for (int s = 0; s < 4; s++) {
        bf16x8 ka = *(const bf16x8*)(Kt + X.c * NKS + 16 * s + 8 * X.hh);
        S = MFMA32(ka, X.qf[s], S);
    }
    const int kbase = 64 * j + 32 * kt;
    int lo = 0, hi;
    bool on = true;
    if (MODE <= 1) hi = ((X.t - 31) >> 4) - kbase;
    else hi = X.t - kbase;
    if (MODE == 3) lo = X.t - 511 - kbase;
    if (MODE == 2) {
        const unsigned long long wsel = (j < 64) ? mlo : mhi;
        on = (wsel >> (j & 63)) & 1ull;
    }
    lo -= 4 * X.hh; hi -= 4 * X.hh;
    if (!on) hi = -1000;
    float P[16];
    if (MODE == 1) {
#pragma unroll
        for (int i = 0; i < 16; i++) {
            const int cr = (i & 3) + 8 * (i >> 2);
            P[i] = (cr <= hi) ? __builtin_amdgcn_exp2f(S[i] - X.m) * X.invl : 0.f;
        }
        float mainv[4], nxt[4];
#pragma unroll
        for (int q = 0; q < 4; q++) { mainv[q] = 2.f * (P[4 * q] + P[4 * q + 1] + P[4 * q + 2]) + P[4 * q + 3]; nxt[q] = P[4 * q + 3]; }
#pragma unroll
        for (int q = 0; q < 4; q++) {
            mainv[q] += __shfl_xor(mainv[q], 1); mainv[q] += __shfl_xor(mainv[q], 2);
            nxt[q] += __shfl_xor(nxt[q], 1); nxt[q] += __shfl_xor(nxt[q], 2);
        }
        float recv[4];
#pragma unroll
        for (int q = 0; q < 4; q++) recv[q] = __shfl_xor(nxt[q], 32);
        const int jsel0 = 16 * j + 8 * kt + X.hh;
#pragma unroll
        for (int q = 0; q < 4; q++) {
            const float tot = mainv[q] + (X.hh ? recv[q] : (q > 0 ? recv[q > 0 ? q - 1 : 0] : X.carry));
            if (X.hp == 0) X.imp_s[(X.tokl & 7) * 128 + jsel0 + 2 * q] = tot;
        }
        X.carry = recv[3];
    } else {
        float tmax = NEGBIG;
        if (FAST) {
            tmax = fmaxf(fmaxf(fmaxf(fmaxf(S[0], S[1]), fmaxf(S[2], S[3])), fmaxf(fmaxf(S[4], S[5]), fmaxf(S[6], S[7]))),
                         fmaxf(fmaxf(fmaxf(S[8], S[9]), fmaxf(S[10], S[11])), fmaxf(fmaxf(S[12], S[13]), fmaxf(S[14], S[15]))));
            if (MODE == 2 && !on) tmax = NEGBIG;
        } else {
#pragma unroll
            for (int i = 0; i < 16; i++) {
                const int cr = (i & 3) + 8 * (i >> 2);
                const bool vis = (cr <= hi) && (cr >= lo);
                tmax = vis ? fmaxf(tmax, S[i]) : tmax;
            }
        }
        tmax = fmaxf(tmax, __shfl_xor(tmax, 32));
        float ls = 0.f;
        if (MODE == 0) {
            const float mnew = fmaxf(X.m, tmax);
            const float alpha = __builtin_amdgcn_exp2f(X.m - mnew);
            X.m = mnew;
#pragma unroll
            for (int i = 0; i < 16; i++) {
                const int cr = (i & 3) + 8 * (i >> 2);
                const bool vis = (cr <= hi) && (cr >= lo);
                P[i] = vis ? __builtin_amdgcn_exp2f(S[i] - mnew) : 0.f;
                ls += P[i];
            }
            X.l = X.l * alpha + ls;
        } else {
            const bool upd = tmax > X.m + 8.f;
            const float mnew = upd ? tmax : X.m;
            if (__builtin_amdgcn_ballot_w64(upd) != 0ull) {
                const float alpha = __builtin_amdgcn_exp2f(X.m - mnew);
                X.l *= alpha;
#pragma unroll
                for (int i = 0; i < 16; i++) { X.O0[i] *= alpha; X.O1[i] *= alpha; }
            }
            X.m = mnew;
            if (FAST) {
                const float msub = (MODE == 2 && !on) ? 1e30f : mnew;
#pragma unroll
                for (int i = 0; i < 16; i++) { P[i] = __builtin_amdgcn_exp2f(S[i] - msub); ls += P[i]; }
            } else {
#pragma unroll
                for (int i = 0; i < 16; i++) {
                    const int cr = (i & 3) + 8 * (i >> 2);
                    const bool vis = (cr <= hi) && (cr >= lo);
                    P[i] = vis ? __builtin_amdgcn_exp2f(S[i] - mnew) : 0.f;
                    ls += P[i];
                }
            }
            X.l += ls;
        }
    }
    if (MODE >= 1) {
        bf16x8 pb0 = pack8(P[0], P[1], P[2], P[3], P[4], P[5], P[6], P[7]);
        bf16x8 pb1 = pack8(P[8], P[9], P[10], P[11], P[12], P[13], P[14], P[15]);
        const int l15 = X.lane & 15;
        const bf16_t* vrow = Vt + (4 * X.hh + (l15 >> 2)) * NKS + 16 * ((X.lane >> 4) & 1) + 4 * (l15 & 3);
#pragma unroll
        for (int s2 = 0; s2 < 2; s2++) {
#pragma unroll
            for (int dt = 0; dt < 2; dt++) {
                s16x4 lo4 = __builtin_amdgcn_ds_read_tr16_b64_v4i16((LAS3 s16x4*)(vrow + (16 * s2) * NKS + 32 * dt));
                s16x4 hi4 = __builtin_amdgcn_ds_read_tr16_b64_v4i16((LAS3 s16x4*)(vrow + (16 * s2 + 8) * NKS + 32 * dt));
                bf16x8 va = __builtin_shufflevector(lo4, hi4, 0, 1, 2, 3, 4, 5, 6, 7);
                if (dt == 0) X.O0 = MFMA32(va, s2 ? pb1 : pb0, X.O0); else X.O1 = MFMA32(va, s2 ? pb1 : pb0, X.O1);
            }
        }
    }
}
template <int MODE>
__device__ __forceinline__ void nsa_block(NsaCtx& X, int j, unsigned long long mlo, unsigned long long mhi, unsigned long long ulo, unsigned long long uhi, int cur, int tw0) {
    bool need = true;
    if (MODE == 2) {
        const unsigned long long wsel = (j < 64) ? ulo : uhi;
        need = (wsel >> (j & 63)) & 1ull;
    }
    if (need) {
#pragma unroll 1
        for (int kt = 0; kt < 2; kt++) {
            bool fast = false;
            if (MODE == 2) fast = j < cur;
            if (MODE == 3) { const int kb = 64 * j + 32 * kt; fast = (kb + 31 <= tw0) && (kb >= tw0 + 7 - 511); }
            if (MODE >= 2 && fast) nsa_tile<MODE, true>(X, j, kt, j & 1, mlo, mhi);
            else nsa_tile<MODE, false>(X, j, kt, j & 1, mlo, mhi);
        }
    }
}
template <int MODE>
__device__ __forceinline__ void nsa_branch(NsaCtx& X, int jlo, int jhi, unsigned long long mlo, unsigned long long mhi, unsigned long long ulo, unsigned long long uhi, int cur, int tw0) {
    NsaStage sa;
    nsa_stage_load(X, sa, jlo);
    __syncthreads();
    nsa_stage_store(X, sa, jlo & 1);
    __syncthreads();
#pragma unroll 1
    for (int j = jlo; j <= jhi; j++) {
        if (j < jhi) nsa_stage_load(X, sa, j + 1);
        nsa_block<MODE>(X, j, mlo, mhi, ulo, uhi, cur, tw0);
        if (j < jhi) nsa_stage_store(X, sa, (j + 1) & 1);
        __syncthreads();
    }
}
template <int OP>
__device__ __forceinline__ void nsa_facc(NsaCtx& X, float scale) {
    f32x4* F = (f32x4*)X.imp_s;
#pragma unroll
    for (int q = 0; q < 8; q++) {
        f32x4 v;
#pragma unroll
        for (int e = 0; e < 4; e++) v[e] = ((q < 4) ? X.O0[4 * q + e] : X.O1[4 * (q - 4) + e]) * scale;
        if (OP >= 1) v += F[q * 64 + X.lane];
        if (OP <= 1) F[q * 64 + X.lane] = v;
        else {
#pragma unroll
            for (int e = 0; e < 4; e++) { if (q < 4) X.O0[4 * q + e] = v[e]; else X.O1[4 * (q - 4) + e] = v[e]; }
        }
    }
}
__device__ __forceinline__ void d_nsa_mfma(const bf16_t* __restrict__ proj, const float* __restrict__ qgain, const float2* __restrict__ rope,
                                           const bf16_t* __restrict__ ksn, const bf16_t* __restrict__ kwn,
                                           const bf16_t* __restrict__ kc, const bf16_t* __restrict__ vc, const bf16_t* __restrict__ vsn, const bf16_t* __restrict__ vwn,
                                           bf16_t* __restrict__ mixo, int mix_ld, int item, char* smem, bool noload = false) {
    NsaCtx X;
    X.noload = noload;
    const int tid = threadIdx.x, lane = tid & 63, w = tid >> 6;
    const int bg = item & 3, tile = 255 - (item >> 2);
    const int b = bg >> 1, g = bg & 1, t0 = tile * 32;
    X.lane = lane; X.c = lane & 31; X.hh = lane >> 5; X.hp = X.c & 3; X.tokl = 8 * w + (X.c >> 2); X.t = t0 + X.tokl;
    X.Kb = (bf16_t*)(smem + NSA_K_OFF); X.Vb = (bf16_t*)(smem + NSA_V_OFF);
    X.imp_s = (float*)(smem + NSA_IMP_OFF + w * 8192); X.sel_s = (unsigned*)(smem + NSA_SEL_OFF);
    const int head = g * 4 + X.hp;
    const size_t row = (size_t)(b * SEQ + X.t);
    {
        float y[4][8];
        const bf16_t* qsrc = proj + row * PLD + C_Q + head * 64 + 8 * X.hh;
        float ss = 0.f;
#pragma unroll
        for (int s = 0; s < 4; s++) {
            const uint4 u = *(const uint4*)(qsrc + 16 * s);
            const unsigned wv[4] = {u.x, u.y, u.z, u.w};
#pragma unroll
            for (int e = 0; e < 4; e++) { y[s][2 * e] = __uint_as_float(wv[e] << 16); y[s][2 * e + 1] = __uint_as_float(wv[e] & 0xffff0000u); }
#pragma unroll
            for (int e = 0; e < 8; e++) ss += y[s][e] * y[s][e];
        }
        ss += __shfl_xor(ss, 32);
        const float r = rsqrtf(ss * (1.f / 64.f) + 1e-6f);
#pragma unroll
        for (int s = 0; s < 4; s++)
#pragma unroll
            for (int e = 0; e < 8; e++) y[s][e] *= r * qgain[16 * s + 8 * X.hh + e];
        const float qs = 0.125f * 1.4426950408889634f;
#pragma unroll
        for (int s = 0; s < 2; s++)
#pragma unroll
            for (int e = 0; e < 8; e++) {
                const float2 cs = rope[(size_t)X.t * 32 + 16 * s + 8 * X.hh + e];
                const float x1 = y[s][e], x2 = y[s + 2][e];
                y[s][e] = (x1 * cs.x - x2 * cs.y) * qs; y[s + 2][e] = (x2 * cs.x + x1 * cs.y) * qs;
            }
#pragma unroll
        for (int s = 0; s < 4; s++) X.qf[s] = pack8(y[s][0], y[s][1], y[s][2], y[s][3], y[s][4], y[s][5], y[s][6], y[s][7]);
    }
    const bf16_t* gp = proj + row * PLD + C_GATE + head * 3;
    const float g0 = sigmoidf_(bf2f(gp[0])), g1 = sigmoidf_(bf2f(gp[1])), g2 = sigmoidf_(bf2f(gp[2]));
    const int cur = t0 >> 6;
    {
        X.Kbase = kc + (size_t)bg * 512 * 64; X.kstride = 64; X.Vbase = vc + (size_t)bg * 512 * 64; X.vstride = 64;
        const int nvmax = (t0 >> 4) + 1, jhi = (nvmax - 1) >> 6;
        X.m = NEGBIG; X.l = 0.f;
        nsa_branch<0>(X, 0, jhi, 0ull, 0ull, 0ull, 0ull, cur, t0 + 8 * w);
        const float lt = X.l + __shfl_xor(X.l, 32);
        X.invl = (lt > 0.f) ? 1.f / lt : 0.f;
        X.carry = 0.f;
#pragma unroll
        for (int i = 0; i < 16; i++) { X.O0[i] = 0.f; X.O1[i] = 0.f; }
        nsa_branch<1>(X, 0, jhi, 0ull, 0ull, 0ull, 0ull, cur, t0 + 8 * w);
    }
    unsigned long long mlo, mhi, ulo, uhi;
    {
        const int tk2 = lane >> 3, sub = lane & 7;
        unsigned k0 = 1u, k1 = 0u, k2 = 0u, k3 = 0u;
#define SETBIT(jj) { const int _j = (jj); if (_j < 32) k0 |= 1u << _j; else if (_j < 64) k1 |= 1u << (_j - 32); else if (_j < 96) k2 |= 1u << (_j - 64); else k3 |= 1u << (_j - 96); }
        SETBIT(cur);
        if (cur >= 1) SETBIT(cur - 1);
        const int ncand = cur - 2;
        if (ncand > 0) {
            if (ncand <= 13) {
                for (int jj = 1; jj <= cur - 2; jj++) SETBIT(jj);
            } else {
                float sc[16];
#pragma unroll
                for (int i = 0; i < 16; i++) { const int jj = sub + 8 * i; sc[i] = (jj >= 1 && jj <= cur - 2) ? X.imp_s[tk2 * 128 + jj] : -3e38f; }
#pragma unroll 1
                for (int it = 0; it < 13; it++) {
                    float bv = sc[0]; int bi = 0;
#pragma unroll
                    for (int i = 1; i < 16; i++) if (sc[i] > bv) { bv = sc[i]; bi = i; }
                    int bj = sub + 8 * bi;
#pragma unroll
                    for (int o = 1; o < 8; o <<= 1) {
                        const float ov = __shfl_xor(bv, o); const int oj = __shfl_xor(bj, o);
                        if (ov > bv || (ov == bv && oj < bj)) { bv = ov; bj = oj; }
                    }
                    SETBIT(bj);
#pragma unroll
                    for (int i = 0; i < 16; i++) if (bj == sub + 8 * i) sc[i] = -3e38f;
                }
            }
        }
#undef SETBIT
        if (sub == 0) { unsigned* d = X.sel_s + (8 * w + tk2) * 4; d[0] = k0; d[1] = k1; d[2] = k2; d[3] = k3; }
        __builtin_amdgcn_s_waitcnt(0xc07f);
        const unsigned* sp = X.sel_s + X.tokl * 4;
        const unsigned m0 = sp[0], m1 = sp[1], m2 = sp[2], m3 = sp[3];
        mlo = (unsigned long long)m0 | ((unsigned long long)m1 << 32); mhi = (unsigned long long)m2 | ((unsigned long long)m3 << 32);
        unsigned u0 = m0, u1 = m1, u2 = m2, u3 = m3;
#pragma unroll
        for (int o = 4; o < 32; o <<= 1) { u0 |= __shfl_xor(u0, o); u1 |= __shfl_xor(u1, o); u2 |= __shfl_xor(u2, o); u3 |= __shfl_xor(u3, o); }
        ulo = (unsigned long long)(unsigned)__builtin_amdgcn_readfirstlane(u0) | ((unsigned long long)(unsigned)__builtin_amdgcn_readfirstlane(u1) << 32);
        uhi = (unsigned long long)(unsigned)__builtin_amdgcn_readfirstlane(u2) | ((unsigned long long)(unsigned)__builtin_amdgcn_readfirstlane(u3) << 32);
    }
    nsa_facc<0>(X, g0);
    {
        X.Kbase = ksn + (size_t)bg * SEQ * 64; X.kstride = 64;
        X.Vbase = vsn + (size_t)bg * SEQ * 64; X.vstride = 64;
        X.m = NEGBIG; X.l = 0.f;
#pragma unroll
        for (int i = 0; i < 16; i++) { X.O0[i] = 0.f; X.O1[i] = 0.f; }
        nsa_branch<2>(X, 0, cur, mlo, mhi, ulo, uhi, cur, t0 + 8 * w);
        const float lt = X.l + __shfl_xor(X.l, 32);
        nsa_facc<1>(X, (lt > 0.f) ? g1 / lt : 0.f);
    }
    {
        X.Kbase = kwn + (size_t)bg * SEQ * 64; X.kstride = 64;
        X.Vbase = vwn + (size_t)bg * SEQ * 64; X.vstride = 64;
        X.m = NEGBIG; X.l = 0.f;
#pragma unroll
        for (int i = 0; i < 16; i++) { X.O0[i] = 0.f; X.O1[i] = 0.f; }
        const int jlo = (t0 >= 511) ? ((t0 - 511) >> 6) : 0;
        nsa_branch<3>(X, jlo, cur, 0ull, 0ull, 0ull, 0ull, cur, t0 + 8 * w);
        const float lt = X.l + __shfl_xor(X.l, 32);
        nsa_facc<2>(X, (lt > 0.f) ? g2 / lt : 0.f);
    }
    bf16_t* dst = mixo + row * mix_ld + head * 64 + 4 * X.hh;
#pragma unroll
    for (int q4 = 0; q4 < 4; q4++) {
        *(uint2*)(dst + 8 * q4) = make_uint2(pk2(X.O0[4 * q4], X.O0[4 * q4 + 1]), pk2(X.O0[4 * q4 + 2], X.O0[4 * q4 + 3]));
        *(uint2*)(dst + 32 + 8 * q4) = make_uint2(pk2(X.O1[4 * q4], X.O1[4 * q4 + 1]), pk2(X.O1[4 * q4 + 2], X.O1[4 * q4 + 3]));
    }
}

#define KLS 136
#define XSS 264
#define GDN_PREP_LDS (2 * 64 * KLS * 2 + 64 * XSS * 2 + 512)
__device__ __forceinline__ unsigned pack2bf(float lo, float hi) { return (unsigned)f2bf(lo) | ((unsigned)f2bf(hi) << 16); }
__device__ __forceinline__ void d_gdn_prep2(const bf16_t* __restrict__ proj, const float* __restrict__ conv_w,
                                            const float* __restrict__ a_log, const float* __restrict__ dt_bias,
                                            bf16_t* __restrict__ guT, bf16_t* __restrict__ gw, bf16_t* __restrict__ gqd,
                                            bf16_t* __restrict__ gkdT, bf16_t* __restrict__ gin, float* __restrict__ gl, int chunk, char* smem) {
    bf16_t* kL = (bf16_t*)smem;
    bf16_t* qL = kL + 64 * KLS;
    float* AmT = (float*)qL;
    bf16_t* xs = qL + 64 * KLS;
    float* gcs = (float*)(xs + 64 * XSS);
    float* bts = gcs + 64;
    const int tid = threadIdx.x, lane = tid & 63, w = tid >> 6;
    const int n = chunk & 127, h = (chunk >> 7) & 3, b = chunk >> 9;
    const int t0 = n * 64;
    const size_t rbase = (size_t)(b * SEQ + t0);
    if (tid < 64) {
        const size_t r = (rbase + tid) * PLD;
        float a = bf2f(proj[r + C_A + h]), bb = bf2f(proj[r + C_B + h]);
        float xx = a + dt_bias[h];
        float sp = (xx > 20.f) ? xx : log1pf(__expf(xx));
        float c = -__expf(a_log[h]) * sp;
#pragma unroll
        for (int o = 1; o < 64; o <<= 1) { float nb = __shfl_up(c, o); if (lane >= o) c += nb; }
        gcs[tid] = c; bts[tid] = sigmoidf_(bb);
    }
    __syncthreads();
    {
        float wt[6][4], x0[6], x1[6], x2[6];
        int ch[6];
#pragma unroll
        for (int c6 = 0; c6 < 6; c6++) {
            ch[c6] = (c6 >> 1) * 512 + h * 128 + lane + 64 * (c6 & 1);
#pragma unroll
            for (int j = 0; j < 4; j++) wt[c6][j] = conv_w[j * 1536 + ch[c6]];
            const int tb = t0 + 16 * w - 3;
            x0[c6] = (tb >= 0) ? bf2f(proj[((size_t)(b * SEQ + tb)) * PLD + C_GQKV + ch[c6]]) : 0.f;
            x1[c6] = (tb + 1 >= 0) ? bf2f(proj[((size_t)(b * SEQ + tb + 1)) * PLD + C_GQKV + ch[c6]]) : 0.f;
            x2[c6] = (tb + 2 >= 0) ? bf2f(proj[((size_t)(b * SEQ + tb + 2)) * PLD + C_GQKV + ch[c6]]) : 0.f;
        }
        for (int i = 16 * w; i < 16 * w + 16; i++) {
            float sv[6];
#pragma unroll
            for (int c6 = 0; c6 < 6; c6++) {
                float xn = bf2f(proj[(rbase + i) * PLD + C_GQKV + ch[c6]]);
                float cv = x0[c6] * wt[c6][0] + x1[c6] * wt[c6][1] + x2[c6] * wt[c6][2] + xn * wt[c6][3];
                x0[c6] = x1[c6]; x1[c6] = x2[c6]; x2[c6] = xn;
                sv[c6] = cv * sigmoidf_(cv);
            }
            float rq = rsqrtf(wave_sum(sv[0] * sv[0] + sv[1] * sv[1]) + 1e-6f) * 0.08838834764831845f;
            float rk = rsqrtf(wave_sum(sv[2] * sv[2] + sv[3] * sv[3]) + 1e-6f);
            const float bi = bts[i], ei = __expf(gcs[i]);
            float q0 = sv[0] * rq, q1 = sv[1] * rq, k0 = sv[2] * rk, k1 = sv[3] * rk;
            qL[i * KLS + lane] = f2bf(q0); qL[i * KLS + lane + 64] = f2bf(q1);
            kL[i * KLS + lane] = f2bf(k0); kL[i * KLS + lane + 64] = f2bf(k1);
            xs[i * XSS + lane] = f2bf(sv[4] * bi); xs[i * XSS + lane + 64] = f2bf(sv[5] * bi);
            xs[i * XSS + 128 + lane] = f2bf(k0 * bi * ei); xs[i * XSS + 192 + lane] = f2bf(k1 * bi * ei);
            bf16_t* qd = gqd + (size_t)chunk * 8192 + i * 128;
            qd[lane] = f2bf(q0 * ei); qd[lane + 64] = f2bf(q1 * ei);
        }
    }
    __syncthreads();
    const int n16 = lane & 15, kq = lane >> 4;
    f32x4 aqk[4], akk[4];
#pragma unroll
    for (int tj = 0; tj < 4; tj++) { aqk[tj] = (f32x4){0.f, 0.f, 0.f, 0.f}; akk[tj] = (f32x4){0.f, 0.f, 0.f, 0.f}; }
#pragma unroll
    for (int ks = 0; ks < 4; ks++) {
        bf16x8 qa = *(const bf16x8*)(qL + (16 * w + n16) * KLS + 32 * ks + 8 * kq);
        bf16x8 ka = *(const bf16x8*)(kL + (16 * w + n16) * KLS + 32 * ks + 8 * kq);
#pragma unroll
        for (int tj = 0; tj < 4; tj++) {
            bf16x8 kb = *(const bf16x8*)(kL + (16 * tj + n16) * KLS + 32 * ks + 8 * kq);
            aqk[tj] = __builtin_amdgcn_mfma_f32_16x16x32_bf16(qa, kb, aqk[tj], 0, 0, 0);
            akk[tj] = __builtin_amdgcn_mfma_f32_16x16x32_bf16(ka, kb, akk[tj], 0, 0, 0);
        }
    }
    {
        const float glast = gcs[63];
        const int kidx = tid >> 1, c0 = (tid & 1) * 32;
        unsigned pk[16];
#pragma unroll
        for (int cc = 0; cc < 32; cc += 2) {
            float v0 = bf2f(kL[(c0 + cc) * KLS + kidx]) * __expf(glast - gcs[c0 + cc]);
            float v1 = bf2f(kL[(c0 + cc + 1) * KLS + kidx]) * __expf(glast - gcs[c0 + cc + 1]);
            pk[cc >> 1] = pack2bf(v0, v1);
        }
        uint4* dst = (uint4*)(gkdT + (size_t)chunk * 8192 + kidx * 64 + c0);
#pragma unroll
        for (int v4 = 0; v4 < 4; v4++) dst[v4] = make_uint4(pk[4 * v4], pk[4 * v4 + 1], pk[4 * v4 + 2], pk[4 * v4 + 3]);
        if (tid == 0) gl[chunk] = __expf(glast);
    }
    __syncthreads();
#pragma unroll
    for (int tj = 0; tj < 4; tj++)
#pragma unroll
        for (int r = 0; r < 4; r++) {
            const int i = 16 * w + 4 * kq + r, j = 16 * tj + n16;
            const float dec = (j <= i) ? __expf(gcs[i] - gcs[j]) : 0.f;
            gin[(size_t)chunk * 4096 + i * 64 + j] = f2bf(aqk[tj][r] * dec);
            AmT[j * 64 + i] = (j < i) ? bts[i] * akk[tj][r] * dec : 0.f;
        }
    __syncthreads();
    {
        const int c = tid;
#pragma unroll 1
        for (int blk = 0; blk < 8; blk++) {
            const int i0 = blk * 8;
            float acc[8];
#pragma unroll
            for (int r = 0; r < 8; r++) acc[r] = bf2f(xs[(i0 + r) * XSS + c]);
            for (int j = 0; j < i0; j++) {
                const float xj = bf2f(xs[j * XSS + c]);
                const float4 a0 = *(const float4*)(AmT + j * 64 + i0), a1 = *(const float4*)(AmT + j * 64 + i0 + 4);
                acc[0] -= a0.x * xj; acc[1] -= a0.y * xj; acc[2] -= a0.z * xj; acc[3] -= a0.w * xj;
                acc[4] -= a1.x * xj; acc[5] -= a1.y * xj; acc[6] -= a1.z * xj; acc[7] -= a1.w * xj;
            }
#pragma unroll
            for (int r = 1; r < 8; r++)
#pragma unroll
                for (int s2 = 0; s2 < r; s2++) acc[r] -= AmT[(i0 + s2) * 64 + i0 + r] * acc[s2];
#pragma unroll
            for (int r = 0; r < 8; r++) xs[(i0 + r) * XSS + c] = f2bf(acc[r]);
            if (c < 128) {
                *(uint4*)(guT + (size_t)chunk * 8192 + c * 64 + i0) =
                    make_uint4(pack2bf(acc[0], acc[1]), pack2bf(acc[2], acc[3]), pack2bf(acc[4], acc[5]), pack2bf(acc[6], acc[7]));
            } else {
#pragma unroll
                for (int r = 0; r < 8; r++) gw[(size_t)chunk * 8192 + (i0 + r) * 128 + (c - 128)] = f2bf(acc[r]);
            }
        }
    }
}

struct GdnFrag { bf16x8 wA[4], qA[4], inA[2], kdA[2][2]; uint2 uC; float glv; };
__device__ __forceinline__ void gdn_load_frag(GdnFrag& f, const bf16_t* __restrict__ guT, const bf16_t* __restrict__ gw, const bf16_t* __restrict__ gqd,
                                              const bf16_t* __restrict__ gkdT, const bf16_t* __restrict__ gin, const float* __restrict__ gl,
                                              int chunk, int w, int sl, int n16, int kq) {
    const size_t cb = (size_t)chunk * 8192;
#pragma unroll
    for (int ks = 0; ks < 4; ks++) {
        f.wA[ks] = *(const bf16x8*)(gw + cb + (16 * w + n16) * 128 + 32 * ks + 8 * kq);
        f.qA[ks] = *(const bf16x8*)(gqd + cb + (16 * w + n16) * 128 + 32 * ks + 8 * kq);
    }
#pragma unroll
    for (int ks = 0; ks < 2; ks++) {
        f.inA[ks] = *(const bf16x8*)(gin + (size_t)chunk * 4096 + (16 * w + n16) * 64 + 32 * ks + 8 * kq);
        f.kdA[0][ks] = *(const bf16x8*)(gkdT + cb + (32 * w + n16) * 64 + 32 * ks + 8 * kq);
        f.kdA[1][ks] = *(const bf16x8*)(gkdT + cb + (32 * w + 16 + n16) * 64 + 32 * ks + 8 * kq);
    }
    f.uC = *(const uint2*)(guT + cb + (16 * sl + n16) * 64 + 16 * w + 4 * kq);
    f.glv = gl[chunk];
}
#define STS 144
#define VNS 80
__device__ __forceinline__ void gdn_step(const GdnFrag& f, f32x4& S0, f32x4& S1, bf16_t* StT, bf16_t* vnT, float* __restrict__ ogrow, int w, int n16, int kq) {
    f32x4 ws = (f32x4){0.f, 0.f, 0.f, 0.f}, qs = (f32x4){0.f, 0.f, 0.f, 0.f};
#pragma unroll
    for (int ks = 0; ks < 4; ks++) {
        bf16x8 sb = *(const bf16x8*)(StT + n16 * STS + 32 * ks + 8 * kq);
        ws = __builtin_amdgcn_mfma_f32_16x16x32_bf16(f.wA[ks], sb, ws, 0, 0, 0);
        qs = __builtin_amdgcn_mfma_f32_16x16x32_bf16(f.qA[ks], sb, qs, 0, 0, 0);
    }
    float v0 = __uint_as_float(f.uC.x << 16) - ws[0], v1 = __uint_as_float(f.uC.x & 0xffff0000u) - ws[1];
    float v2 = __uint_as_float(f.uC.y << 16) - ws[2], v3 = __uint_as_float(f.uC.y & 0xffff0000u) - ws[3];
    *(uint2*)(vnT + n16 * VNS + 16 * w + 4 * kq) = make_uint2(pack2bf(v0, v1), pack2bf(v2, v3));
    __syncthreads();
    bf16x8 vb0 = *(const bf16x8*)(vnT + n16 * VNS + 8 * kq), vb1 = *(const bf16x8*)(vnT + n16 * VNS + 32 + 8 * kq);
    qs = __builtin_amdgcn_mfma_f32_16x16x32_bf16(f.inA[0], vb0, qs, 0, 0, 0);
    qs = __builtin_amdgcn_mfma_f32_16x16x32_bf16(f.inA[1], vb1, qs, 0, 0, 0);
    S0 = S0 * f.glv; S1 = S1 * f.glv;
    S0 = __builtin_amdgcn_mfma_f32_16x16x32_bf16(f.kdA[0][0], vb0, S0, 0, 0, 0);
    S0 = __builtin_amdgcn_mfma_f32_16x16x32_bf16(f.kdA[0][1], vb1, S0, 0, 0, 0);
    S1 = __builtin_amdgcn_mfma_f32_16x16x32_bf16(f.kdA[1][0], vb0, S1, 0, 0, 0);
    S1 = __builtin_amdgcn_mfma_f32_16x16x32_bf16(f.kdA[1][1], vb1, S1, 0, 0, 0);
#pragma unroll
    for (int r = 0; r < 4; r++) ogrow[(size_t)(4 * kq + r) * 512] = qs[r];
    *(uint2*)(StT + n16 * STS + 32 * w + 4 * kq) = make_uint2(pack2bf(S0[0], S0[1]), pack2bf(S0[2], S0[3]));
    *(uint2*)(StT + n16 * STS + 32 * w + 16 + 4 * kq) = make_uint2(pack2bf(S1[0], S1[1]), pack2bf(S1[2], S1[3]));
    __syncthreads();
}
__device__ __forceinline__ void d_gdn_scan2(const bf16_t* __restrict__ guT, const bf16_t* __restrict__ gw, const bf16_t* __restrict__ gqd,
                                            const bf16_t* __restrict__ gkdT, const bf16_t* __restrict__ gin, const float* __restrict__ gl,
                                            float* __restrict__ og, int item, char* smem) {
    bf16_t* StT = (bf16_t*)smem;
    bf16_t* vnT = StT + 16 * STS;
    const int tid = threadIdx.x, lane = tid & 63, w = tid >> 6, n16 = lane & 15, kq = lane >> 4;
    const int bh = item & 7, sl = item >> 3, b = bh >> 2, h = bh & 3;
    for (int i = tid; i < 16 * STS / 2; i += 256) ((unsigned*)StT)[i] = 0u;
    f32x4 S0 = (f32x4){0.f, 0.f, 0.f, 0.f}, S1 = (f32x4){0.f, 0.f, 0.f, 0.f};
    GdnFrag fa, fb, fc;
    gdn_load_frag(fa, guT, gw, gqd, gkdT, gin, gl, bh * 128, w, sl, n16, kq);
    gdn_load_frag(fb, guT, gw, gqd, gkdT, gin, gl, bh * 128 + 1, w, sl, n16, kq);
    __syncthreads();
    float* obase = og + (size_t)(b * SEQ + 16 * w) * 512 + h * 128 + 16 * sl + n16;
#pragma unroll 1
    for (int n = 0; n < 126; n += 3) {
        gdn_load_frag(fc, guT, gw, gqd, gkdT, gin, gl, bh * 128 + n + 2, w, sl, n16, kq);
        gdn_step(fa, S0, S1, StT, vnT, obase + (size_t)(n * 64) * 512, w, n16, kq);
        gdn_load_frag(fa, guT, gw, gqd, gkdT, gin, gl, bh * 128 + n + 3, w, sl, n16, kq);
        gdn_step(fb, S0, S1, StT, vnT, obase + (size_t)((n + 1) * 64) * 512, w, n16, kq);
        gdn_load_frag(fb, guT, gw, gqd, gkdT, gin, gl, bh * 128 + n + 4, w, sl, n16, kq);
        gdn_step(fc, S0, S1, StT, vnT, obase + (size_t)((n + 2) * 64) * 512, w, n16, kq);
    }
    gdn_step(fa, S0, S1, StT, vnT, obase + (size_t)(126 * 64) * 512, w, n16, kq);
    gdn_step(fb, S0, S1, StT, vnT, obase + (size_t)(127 * 64) * 512, w, n16, kq);
}

__device__ __forceinline__ void d_gdn_out(const float* __restrict__ og, const bf16_t* __restrict__ proj, const float* __restrict__ gain, bf16_t* __restrict__ mix, int t, int lane) {
    const float* o = og + (size_t)t * 512;
    const bf16_t* z = proj + (size_t)t * PLD + C_Z;
    float a[8], zz[8];
#pragma unroll
    for (int i = 0; i < 8; i++) { a[i] = o[lane + 64 * i]; zz[i] = bf2f(z[lane + 64 * i]); }
    const float g0 = gain[lane], g1 = gain[lane + 64];
#pragma unroll
    for (int h = 0; h < 4; h++) {
        const float ss = wave_sum_dpp(a[2 * h] * a[2 * h] + a[2 * h + 1] * a[2 * h + 1]);
        const float r = rsqrtf(ss * (1.f / 128.f) + 1e-6f);
        mix[(size_t)t * DM + 512 + h * 128 + lane] = f2bf(a[2 * h] * r * g0 * zz[2 * h] * sigmoidf_(zz[2 * h]));
        mix[(size_t)t * DM + 512 + h * 128 + lane + 64] = f2bf(a[2 * h + 1] * r * g1 * zz[2 * h + 1] * sigmoidf_(zz[2 * h + 1]));
    }
}

__device__ __forceinline__ void route_load_subkeys(const float* __restrict__ subkeys, char* smem) {
    for (int idx = threadIdx.x; idx < 2 * 128 * 16; idx += 256) {
        const int half = idx >> 11, key = (idx >> 4) & 127, ch = idx & 15;
        const float* src = subkeys + ((size_t)(half * 128 + key)) * 128 + ch * 8;
        const float4 x0 = *(const float4*)src, x1 = *(const float4*)(src + 4);
        *(uint4*)(smem + half * 32768 + key * 256 + ((ch ^ (key & 15)) << 4)) = make_uint4(pk2(x0.x, x0.y), pk2(x0.z, x0.w), pk2(x1.x, x1.y), pk2(x1.z, x1.w));
    }
}
#define CEX(i, j) { const float _a = v[i], _b = v[j]; v[i] = fmaxf(_a, _b); v[j] = fminf(_a, _b); }
__device__ __forceinline__ void d_peer_route2(const bf16_t* __restrict__ qry, int* __restrict__ eidx, float* __restrict__ pgate, int mtile, const char* smem, int lane) {
    const int n16 = lane & 15, kq = lane >> 4;
    const int tA = 2 * mtile + (n16 >> 3), hA = n16 & 7;
    float topv[2][4];
#pragma unroll
    for (int half = 0; half < 2; half++) {
        const bf16_t* qp = qry + (size_t)tA * 2048 + hA * 256 + half * 128 + 8 * kq;
        bf16x8 a[4];
#pragma unroll
        for (int ks = 0; ks < 4; ks++) a[ks] = *(const bf16x8*)(qp + 32 * ks);
        f32x4 acc[8];
#pragma unroll
        for (int nt = 0; nt < 8; nt++) acc[nt] = (f32x4){0.f, 0.f, 0.f, 0.f};
#pragma unroll
        for (int ks = 0; ks < 4; ks++)
#pragma unroll
            for (int nt = 0; nt < 8; nt++) {
                const bf16x8 bb = *(const bf16x8*)(smem + half * 32768 + (16 * nt + n16) * 256 + (((4 * ks + kq) ^ n16) << 4));
                acc[nt] = __builtin_amdgcn_mfma_f32_16x16x32_bf16(a[ks], bb, acc[nt], 0, 0, 0);
                if (nt == 3 || nt == 7) __builtin_amdgcn_sched_barrier(0);
            }
#pragma unroll
        for (int r = 0; r < 4; r++) {
            float v[8];
#pragma unroll
            for (int nt = 0; nt < 8; nt++) v[nt] = __uint_as_float((__float_as_uint(acc[nt][r]) & 0xFFFFFF80u) | (unsigned)(nt << 4) | (unsigned)n16);
            CEX(0, 1) CEX(2, 3) CEX(4, 5) CEX(6, 7) CEX(0, 2) CEX(1, 3) CEX(4, 6) CEX(5, 7) CEX(1, 2) CEX(5, 6)
            CEX(0, 4) CEX(1, 5) CEX(2, 6) CEX(3, 7) CEX(2, 4) CEX(3, 5) CEX(1, 2) CEX(3, 4) CEX(5, 6)
            float keep = 0.f;
#pragma unroll 1
            for (int it = 0; it < 16; it++) {
                const float mx = allmax16(v[0]);
                if (n16 == it) keep = mx;
                if (__float_as_uint(v[0]) == __float_as_uint(mx)) {
                    v[0] = v[1]; v[1] = v[2]; v[2] = v[3]; v[3] = v[4]; v[4] = v[5]; v[5] = v[6]; v[6] = v[7]; v[7] = -3e38f;
                }
            }
            topv[half][r] = keep;
            __builtin_amdgcn_sched_barrier(0);
        }
    }
#pragma unroll
    for (int r = 0; r < 4; r++) {
        const float v1p = topv[0][r], v2p = topv[1][r];
        const unsigned u1 = __float_as_uint(v1p);
        const int i1 = (int)(((u1 >> 4) & 7u) * 16u + (u1 & 15u));
        const int lim = 16 / (n16 + 1);
        int ptr = 0;
        const int lanebase = (lane & 48);
        float cur2 = __builtin_bit_cast(float, __builtin_amdgcn_ds_bpermute(lanebase * 4, __builtin_bit_cast(int, v2p)));
        float head = __uint_as_float((__float_as_uint(v1p + cur2) & 0xFFFFFFF0u) | (unsigned)n16);
        float ksc = 0.f; unsigned ke = 0u;
#pragma unroll 1
        for (int it = 0; it < 16; it++) {
            const float mx = allmax16(head);
            const bool win = __float_as_uint(head) == __float_as_uint(mx);
            const unsigned u2 = __float_as_uint(cur2);
            unsigned e = win ? (unsigned)(i1 * 128) + ((u2 >> 4) & 7u) * 16u + (u2 & 15u) : 0u;
            e = allmaxu16(e);
            if (n16 == it) { ksc = mx; ke = e; }
            if (win) ptr++;
            const int pn = ptr < 15 ? ptr : 15;
            const float nx = __builtin_bit_cast(float, __builtin_amdgcn_ds_bpermute((lanebase + pn) * 4, __builtin_bit_cast(int, v2p)));
            if (win) { cur2 = nx; head = (ptr < lim) ? __uint_as_float((__float_as_uint(v1p + cur2) & 0xFFFFFFF0u) | (unsigned)n16) : -3e38f; }
        }
        const float smax = allmax16(ksc);
        const float ex = __expf(ksc - smax);
        const float sum = allsum16(ex);
        const int row = 4 * kq + r;
        const size_t o = (size_t)(2 * mtile + (row >> 3)) * 128 + (row & 7) * 16 + n16;
        eidx[o] = (int)ke; pgate[o] = ex / sum;
    }
}
#undef CEX

#define XB_TMO      128
#define XB_XCNT(j)  (256  + 64 * (j))
#define XB_XSUB(j)  (1280 + 64 * (j))
#define XB_XGEN(j)  (2304 + 64 * (j))
#define XB_TOP      3328
#define XB_TOPGEN   3392
#define XB_QUEUE    3456
#define XL_CNT(j)    (4096 + 64 * (j))
#define XL_GEN(j)    (5120 + 64 * (j))
#define XCD_BAR_WORDS 6144
#define XB_SPIN_CAP (1u << 22)
#define LAS __attribute__((address_space(3)))
__device__ __forceinline__ unsigned xb_ld(unsigned* p)              { return __hip_atomic_load(p, __ATOMIC_RELAXED, __HIP_MEMORY_SCOPE_AGENT); }
__device__ __forceinline__ unsigned xb_add(unsigned* p, unsigned v) { return __hip_atomic_fetch_add(p, v, __ATOMIC_RELAXED, __HIP_MEMORY_SCOPE_AGENT); }
__device__ __forceinline__ unsigned xb_xcc_id() { return (unsigned)__builtin_amdgcn_s_getreg((3 << 11) | 20) & 0xFu; }
#define XB_SPIN(cond, bar) do { unsigned _sp = 0; while (cond) { __builtin_amdgcn_s_sleep(1); \
    if ((++_sp & 255u) == 0u) { if (xb_ld(&(bar)[XB_TMO])) break; if (_sp > XB_SPIN_CAP) { atomicAdd(&(bar)[XB_TMO], 1u); break; } } } } while (0)
struct XcdBarrier { unsigned* bar; unsigned x; volatile LAS unsigned* st; };
__device__ __forceinline__ XcdBarrier xcd_barrier_post(unsigned* bar, volatile LAS unsigned* st) {
    XcdBarrier b; b.bar = bar; b.x = xb_xcc_id(); b.st = st;
    if (threadIdx.x == 0) (void)xb_add(&bar[XB_XCNT(b.x)], 1u);
    return b;
}
__device__ __forceinline__ void xcd_barrier_complete(unsigned* bar, unsigned x, unsigned& nloc, unsigned& nx) {
    const unsigned G = gridDim.x * gridDim.y * gridDim.z;
    unsigned sum, cnt, mine, sp = 0u;
    for (;;) {
        sum = 0u; cnt = 0u; mine = 0u;
#pragma unroll
        for (unsigned j = 0; j < 16; ++j) { const unsigned c = xb_ld(&bar[XB_XCNT(j)]); sum += c; cnt += (c > 0u) ? 1u : 0u; mine = (j == x) ? c : mine; }
        if (sum == G) break;
        __builtin_amdgcn_s_sleep(1);
        if ((++sp & 255u) == 0u) { if (xb_ld(&bar[XB_TMO])) break; if (sp > XB_SPIN_CAP) { atomicAdd(&bar[XB_TMO], 1u); break; } }
    }
    nloc = mine > 0u ? mine : 1u; nx = cnt > 0u ? cnt : 1u;
}
__device__ __forceinline__ void xcd_barrier(const XcdBarrier& b) {
    asm volatile("s_waitcnt vmcnt(0)" ::: "memory");
    __syncthreads();
    if (threadIdx.x == 0) {
        unsigned* bar = b.bar;
        __builtin_amdgcn_s_waitcnt(0);
        unsigned nloc = b.st[0], nx = b.st[1];
        if (nloc == 0u) { xcd_barrier_complete(bar, b.x, nloc, nx); b.st[0] = nloc; b.st[1] = nx; }
        const unsigned old = xb_add(&bar[XB_XSUB(b.x)], 1u);
        const unsigned gen = old / nloc;
        if (old + 1u == (gen + 1u) * nloc) {
            __builtin_amdgcn_fence(__ATOMIC_RELEASE, "agent");
            asm volatile("s_waitcnt vmcnt(0)" ::: "memory");
            const unsigned og = xb_add(&bar[XB_TOP], 1u);
            const unsigned tg = og / nx;
            if (og + 1u == (tg + 1u) * nx) xb_add(&bar[XB_TOPGEN], 1u);
            else XB_SPIN(xb_ld(&bar[XB_TOPGEN]) == tg, bar);
            __builtin_amdgcn_fence(__ATOMIC_ACQUIRE, "agent");
            xb_add(&bar[XB_XGEN(b.x)], 1u);
            asm volatile("s_waitcnt vmcnt(0)" ::: "memory");
        } else {
            XB_SPIN(xb_ld(&bar[XB_XGEN(b.x)]) == gen, bar);
            __builtin_amdgcn_fence(__ATOMIC_ACQUIRE, "agent");
            asm volatile("s_waitcnt vmcnt(0)" ::: "memory");
        }
    }
    __syncthreads();
}

__device__ __forceinline__ void xcd_local_sync(const XcdBarrier& b, unsigned round) {
    __syncthreads();
    if (threadIdx.x == 0) {
        unsigned nloc = b.st[0]; if (nloc == 0u) nloc = 1u;
        const unsigned old = xb_add(&b.bar[XL_CNT(b.x)], 1u);
        if (old + 1u == nloc * (round + 1u)) xb_add(&b.bar[XL_GEN(b.x)], 1u);
        else { unsigned sp = 0; while (xb_ld(&b.bar[XL_GEN(b.x)]) <= round && ++sp < (1u << 16)) __builtin_amdgcn_s_sleep(1); }
    }
    __syncthreads();
}

__device__ __forceinline__ void d_quant_row(const float* __restrict__ src, unsigned char* __restrict__ dst, float* __restrict__ scale, int row, int lane, int bias) {
    const float4* p = (const float4*)(src + (size_t)row * DM) + lane * 4;
    float4 x[4];
    float am = 0.f;
#pragma unroll
    for (int i = 0; i < 4; i++) { x[i] = p[i]; am = fmaxf(am, fmaxf(fmaxf(fabsf(x[i].x), fabsf(x[i].y)), fmaxf(fabsf(x[i].z), fabsf(x[i].w)))); }
    am = wave_max(am);
    const float sc = (am > 0.f) ? am * (1.f / 127.f) : 1.f;
    const float inv = 1.f / sc;
    unsigned wv[4];
#pragma unroll
    for (int i = 0; i < 4; i++) {
        const int q0 = (int)rintf(x[i].x * inv) + bias, q1 = (int)rintf(x[i].y * inv) + bias, q2 = (int)rintf(x[i].z * inv) + bias, q3 = (int)rintf(x[i].w * inv) + bias;
        wv[i] = (unsigned)(q0 & 0xff) | ((unsigned)(q1 & 0xff) << 8) | ((unsigned)(q2 & 0xff) << 16) | ((unsigned)(q3 & 0xff) << 24);
    }
    ((uint4*)(dst + (size_t)row * DM))[lane] = make_uint4(wv[0], wv[1], wv[2], wv[3]);
    if (lane == 0) scale[row] = sc;
}

struct PeerGrp { u32x4 u[4]; u32x4 v[4]; float gv[4]; float su[4]; };
__device__ __forceinline__ void peer_load(PeerGrp& G, const unsigned char* __restrict__ uq, const unsigned char* __restrict__ vq,
                                          int esrc, float gsrc, float susrc, int k0, int lane) {
#pragma unroll
    for (int i = 0; i < 4; i++) {
        const int e = __builtin_amdgcn_readlane(esrc, (k0 + i) & 63);
        G.gv[i] = __builtin_bit_cast(float, __builtin_amdgcn_readlane(__builtin_bit_cast(int, gsrc), (k0 + i) & 63));
        G.su[i] = __builtin_bit_cast(float, __builtin_amdgcn_readlane(__builtin_bit_cast(int, susrc), (k0 + i) & 63));
        G.u[i] = ((const u32x4*)(uq + (size_t)e * DM))[lane];
        G.v[i] = ((const u32x4*)(vq + (size_t)e * DM))[lane];
    }
}
__device__ __forceinline__ void peer_compute(const PeerGrp& G, const int (&xq)[4], float sx, float (&acc)[16], float& bsum) {
    int d[4];
#pragma unroll
    for (int i = 0; i < 4; i++) {
        int sdot = 0;
        sdot = __builtin_amdgcn_sdot4((int)G.u[i][0], xq[0], sdot, false); sdot = __builtin_amdgcn_sdot4((int)G.u[i][1], xq[1], sdot, false);
        sdot = __builtin_amdgcn_sdot4((int)G.u[i][2], xq[2], sdot, false); sdot = __builtin_amdgcn_sdot4((int)G.u[i][3], xq[3], sdot, false);
        d[i] = sdot;
    }
#pragma unroll
    for (int i = 0; i < 4; i++) {
        int x = d[i];
        x += (int)dppu<0xB1>((unsigned)x); x += (int)dppu<0x4E>((unsigned)x); x += (int)dppu<0x141>((unsigned)x); x += (int)dppu<0x140>((unsigned)x);
        d[i] = __builtin_amdgcn_readlane(x, 0) + __builtin_amdgcn_readlane(x, 16) + __builtin_amdgcn_readlane(x, 32) + __builtin_amdgcn_readlane(x, 48);
    }
#pragma unroll
    for (int i = 0; i < 4; i++) {
        const float dot = (float)d[i] * (G.su[i] * sx);
        const float u2 = 1.5957691216057308f * (dot + 0.044715f * dot * dot * dot);
        const float cs = G.gv[i] * dot * __builtin_amdgcn_rcpf(1.f + __expf(-u2));
        bsum += cs;
        const f32x2 cs2 = (f32x2){cs, cs};
#pragma unroll
        for (int j = 0; j < 4; j++) {
            const unsigned wv = G.v[i][j];
            const f32x2 lo = (f32x2){(float)(wv & 0xffu), (float)((wv >> 8) & 0xffu)}, hi = (f32x2){(float)((wv >> 16) & 0xffu), (float)(wv >> 24)};
            f32x2 a0 = (f32x2){acc[4 * j], acc[4 * j + 1]}, a1 = (f32x2){acc[4 * j + 2], acc[4 * j + 3]};
            a0 = __builtin_elementwise_fma(cs2, lo, a0); a1 = __builtin_elementwise_fma(cs2, hi, a1);
            acc[4 * j] = a0[0]; acc[4 * j + 1] = a0[1]; acc[4 * j + 2] = a1[0]; acc[4 * j + 3] = a1[1];
        }
    }
}
__device__ __forceinline__ void d_peer_expert3(const bf16_t* __restrict__ h2, const int* __restrict__ eidx, const float* __restrict__ pgate,
                                               const unsigned char* __restrict__ uq, const unsigned char* __restrict__ vq,
                                               const float* __restrict__ su, const float* __restrict__ sv, const float* __restrict__ ssq, const float* __restrict__ fgain, float* __restrict__ out, int token, int lane, bool do_store = true, int emask = 0xffff, const XcdBarrier* xbar = nullptr, unsigned midround = 0) {
    const uint4 xa = ((const uint4*)(h2 + (size_t)token * DM))[2 * lane], xb = ((const uint4*)(h2 + (size_t)token * DM))[2 * lane + 1];
    const unsigned xw[8] = {xa.x, xa.y, xa.z, xa.w, xb.x, xb.y, xb.z, xb.w};
    float xf[16];
    float am = 0.f;
    const float rr = rsqrtf(allsum16(ssq[(size_t)token * 16 + (lane & 15)]) * (1.f / DM) + 1e-6f);
    const float4* gp = (const float4*)(fgain + lane * 16);
    const float4 ga = gp[0], gb = gp[1], gc = gp[2], gd = gp[3];
    const float gg[16] = {ga.x, ga.y, ga.z, ga.w, gb.x, gb.y, gb.z, gb.w, gc.x, gc.y, gc.z, gc.w, gd.x, gd.y, gd.z, gd.w};
#pragma unroll
    for (int j = 0; j < 8; j++) {
        xf[2 * j] = __uint_as_float(xw[j] << 16) * rr * gg[2 * j]; xf[2 * j + 1] = __uint_as_float(xw[j] & 0xffff0000u) * rr * gg[2 * j + 1];
        am = fmaxf(am, fmaxf(fabsf(xf[2 * j]), fabsf(xf[2 * j + 1])));
    }
    am = wave_max(am);
    const float sx = (am > 0.f) ? am * (1.f / 127.f) : 1.f;
    const float isx = 1.f / sx;
    int xq[4];
#pragma unroll
    for (int j = 0; j < 4; j++) {
        const int q0 = (int)rintf(xf[4 * j] * isx), q1 = (int)rintf(xf[4 * j + 1] * isx), q2 = (int)rintf(xf[4 * j + 2] * isx), q3 = (int)rintf(xf[4 * j + 3] * isx);
        xq[j] = (int)((unsigned)(q0 & 0xff) | ((unsigned)(q1 & 0xff) << 8) | ((unsigned)(q2 & 0xff) << 16) | ((unsigned)(q3 & 0xff) << 24));
    }
    float acc[16];
#pragma unroll
    for (int i = 0; i < 16; i++) acc[i] = 0.f;
    float bsum = 0.f;
    int e_lo = eidx[(size_t)token * 128 + lane] & emask, e_hi = eidx[(size_t)token * 128 + 64 + lane] & emask;
    float g_lo = pgate[(size_t)token * 128 + lane], g_hi = pgate[(size_t)token * 128 + 64 + lane];
    {
        unsigned long long ka = ((unsigned long long)(unsigned)e_lo << 32) | __float_as_uint(g_lo), kb = ((unsigned long long)(unsigned)e_hi << 32) | __float_as_uint(g_hi);
#pragma unroll
        for (int k = 2; k <= 128; k <<= 1) {
#pragma unroll
            for (int j = k >> 1; j > 0; j >>= 1) {
                if (j == 64) { const unsigned long long mn = ka < kb ? ka : kb, mx = ka < kb ? kb : ka; ka = mn; kb = mx; }
                else {
                    const unsigned long long pa = ((unsigned long long)(unsigned)__shfl_xor((int)(ka >> 32), j) << 32) | (unsigned)__shfl_xor((int)ka, j);
                    const unsigned long long pb = ((unsigned long long)(unsigned)__shfl_xor((int)(kb >> 32), j) << 32) | (unsigned)__shfl_xor((int)kb, j);
                    const bool lower = (lane & j) == 0;
                    const bool dirA = (lane & k) == 0, dirB = ((lane + 64) & k) == 0;
                    ka = ((lower == dirA) == (ka < pa)) ? ka : pa;
                    kb = ((lower == dirB) == (kb < pb)) ? kb : pb;
                }
            }
        }
        e_lo = (int)(ka >> 32); g_lo = __uint_as_float((unsigned)ka); e_hi = (int)(kb >> 32); g_hi = __uint_as_float((unsigned)kb);
    }
    g_lo *= sv[e_lo]; g_hi *= sv[e_hi];
    const float s_lo = su[e_lo], s_hi = su[e_hi];
    PeerGrp A, B;
    peer_load(A, uq, vq, e_lo, g_lo, s_lo, 0, lane);
#pragma unroll 1
    for (int k0 = 0; k0 < 64; k0 += 8) {
        peer_load(B, uq, vq, e_lo, g_lo, s_lo, k0 + 4, lane);
        peer_compute(A, xq, sx, acc, bsum);
        if (k0 + 8 < 64) peer_load(A, uq, vq, e_lo, g_lo, s_lo, k0 + 8, lane); else peer_load(A, uq, vq, e_hi, g_hi, s_hi, 0, lane);
        peer_compute(B, xq, sx, acc, bsum);
    }
    if (xbar) xcd_local_sync(*xbar, midround);
#pragma unroll 1
    for (int k0 = 0; k0 < 64; k0 += 8) {
        peer_load(B, uq, vq, e_hi, g_hi, s_hi, k0 + 4, lane);
        peer_compute(A, xq, sx, acc, bsum);
        if (k0 + 8 < 64) peer_load(A, uq, vq, e_hi, g_hi, s_hi, k0 + 8, lane);
        peer_compute(B, xq, sx, acc, bsum);
    }
    const float bs = 128.f * bsum;
    float4* o = (float4*)(out + (size_t)token * DM + lane * 16);
#pragma unroll
    for (int j = 0; j < 4; j++) {
        float4 t = o[j];
        t.x += acc[4 * j] - bs; t.y += acc[4 * j + 1] - bs; t.z += acc[4 * j + 2] - bs; t.w += acc[4 * j + 3] - bs;
        if (do_store) o[j] = t; else asm volatile("" :: "v"(t.x), "v"(t.y), "v"(t.z), "v"(t.w));
    }
}

#define PE_PSH 8
#define PE_NP 64
#define PE_GS 4
#define PE_TOK 4
#define PE_WAVE_LDS 9344
struct PeSet { u32x4 u[PE_GS], v[PE_GS]; int id[PE_GS]; int n; unsigned long long r0, r1; };
__device__ __forceinline__ void pe_prepare(PeSet& S, const unsigned* ent_e, int k, int p, const unsigned char* __restrict__ uq, const unsigned char* __restrict__ vq, int lane) {
    const unsigned pair = ent_e[k * 64 + lane];
    unsigned long long m0 = __builtin_amdgcn_ballot_w64(((pair & 0xffffu) >> PE_PSH) == (unsigned)p);
    unsigned long long m1 = __builtin_amdgcn_ballot_w64((pair >> (16 + PE_PSH)) == (unsigned)p);
    int n = 0;
#pragma unroll
    for (int i = 0; i < PE_GS; i++) {
        if (m0 | m1) {
            int idx, e;
            if (m0) { idx = __builtin_ctzll(m0); m0 &= m0 - 1; e = (int)((unsigned)__builtin_amdgcn_readlane((int)pair, idx) & 0xffffu); S.id[i] = idx; }
            else { idx = __builtin_ctzll(m1); m1 &= m1 - 1; e = (int)((unsigned)__builtin_amdgcn_readlane((int)pair, idx) >> 16); S.id[i] = 64 + idx; }
            S.u[i] = ((const u32x4*)(uq + (size_t)e * DM))[lane];
            S.v[i] = ((const u32x4*)(vq + (size_t)e * DM))[lane];
            n = i + 1;
        }
    }
    S.n = n; S.r0 = m0; S.r1 = m1;
}
__device__ __forceinline__ void pe_one(const u32x4& u, const u32x4& v, const u32x4& xq, float gs, float ss, float (&acc)[16], float& bsum) {
    int sdot = 0;
    sdot = __builtin_amdgcn_sdot4((int)u[0], (int)xq[0], sdot, false); sdot = __builtin_amdgcn_sdot4((int)u[1], (int)xq[1], sdot, false);
    sdot = __builtin_amdgcn_sdot4((int)u[2], (int)xq[2], sdot, false); sdot = __builtin_amdgcn_sdot4((int)u[3], (int)xq[3], sdot, false);
    int x = sdot;
    x += (int)dppu<0xB1>((unsigned)x); x += (int)dppu<0x4E>((unsigned)x); x += (int)dppu<0x141>((unsigned)x); x += (int)dppu<0x140>((unsigned)x);
    const int tot = __builtin_amdgcn_readlane(x, 0) + __builtin_amdgcn_readlane(x, 16) + __builtin_amdgcn_readlane(x, 32) + __builtin_amdgcn_readlane(x, 48);
    const float dot = (float)tot * ss;
    const float u2 = 1.5957691216057308f * (dot + 0.044715f * dot * dot * dot);
    const float cs = gs * dot * __builtin_amdgcn_rcpf(1.f + __expf(-u2));
    bsum += cs;
#pragma unroll
    for (int j = 0; j < 4; j++) {
        const unsigned wv = v[j];
        acc[4 * j] += cs * (float)(wv & 0xffu);
        acc[4 * j + 1] += cs * (float)((wv >> 8) & 0xffu);
        acc[4 * j + 2] += cs * (float)((wv >> 16) & 0xffu);
        acc[4 * j + 3] += cs * (float)(wv >> 24);
    }
}
__device__ __forceinline__ void pe_consume(const PeSet& S, const unsigned* ent_e, const float* ent_g, const float* ent_s, const u32x4* xqs, const float* sxs, int k,
                                           const unsigned char* __restrict__ uq, const unsigned char* __restrict__ vq, int lane, float (&acc)[16], float& bsum) {
    if (S.n == 0) return;
    const u32x4 xq = xqs[k * 64 + lane];
    const float sx = sxs[k];
#pragma unroll
    for (int i = 0; i < PE_GS; i++) {
        if (S.n > i) pe_one(S.u[i], S.v[i], xq, ent_g[k * 128 + S.id[i]], ent_s[k * 128 + S.id[i]] * sx, acc, bsum);
    }
    unsigned long long m0 = S.r0, m1 = S.r1;
    while (m0 | m1) {
        int idx, id, e;
        const unsigned pair = ent_e[k * 64 + lane];
        if (m0) { idx = __builtin_ctzll(m0); m0 &= m0 - 1; e = (int)((unsigned)__builtin_amdgcn_readlane((int)pair, idx) & 0xffffu); id = idx; }
        else { idx = __builtin_ctzll(m1); m1 &= m1 - 1; e = (int)((unsigned)__builtin_amdgcn_readlane((int)pair, idx) >> 16); id = 64 + idx; }
        const u32x4 u = ((const u32x4*)(uq + (size_t)e * DM))[lane];
        const u32x4 v = ((const u32x4*)(vq + (size_t)e * DM))[lane];
        pe_one(u, v, xq, ent_g[k * 128 + id], ent_s[k * 128 + id] * sx, acc, bsum);
    }
}
__device__ __forceinline__ void d_peer_expert5(const bf16_t* __restrict__ h2, const int* __restrict__ eidx, const float* __restrict__ pgate,
                                               const unsigned char* __restrict__ uq, const unsigned char* __restrict__ vq,
                                               const float* __restrict__ su, const float* __restrict__ sv, float* __restrict__ out, int grp, int lane, char* wlds, bool do_store, int emask = 0xffff) {
    unsigned* ent_e = (unsigned*)wlds;
    float* ent_g = (float*)(wlds + 1024);
    float* ent_s = (float*)(wlds + 1024 + 2048);
    u32x4* xqs = (u32x4*)(wlds + 1024 + 4096);
    float* sxs = (float*)(wlds + 1024 + 4096 + 4096);
#pragma unroll 1
    for (int k = 0; k < PE_TOK; k++) {
        const size_t t = (size_t)grp * PE_TOK + k;
        int e_lo = eidx[t * 128 + lane], e_hi = eidx[t * 128 + 64 + lane];
        e_lo = (e_lo & 0xff00) | (e_lo & emask & 0xff) | ((e_lo & 0xff00) & emask); e_hi = (e_hi & 0xff00) | (e_hi & emask & 0xff) | ((e_hi & 0xff00) & emask);
        ent_e[k * 64 + lane] = (unsigned)e_lo | ((unsigned)e_hi << 16);
        ent_g[k * 128 + lane] = pgate[t * 128 + lane] * sv[e_lo]; ent_g[k * 128 + 64 + lane] = pgate[t * 128 + 64 + lane] * sv[e_hi];
        ent_s[k * 128 + lane] = su[e_lo]; ent_s[k * 128 + 64 + lane] = su[e_hi];
        const uint4 xa = ((const uint4*)(h2 + t * DM))[2 * lane], xb = ((const uint4*)(h2 + t * DM))[2 * lane + 1];
        const unsigned xw[8] = {xa.x, xa.y, xa.z, xa.w, xb.x, xb.y, xb.z, xb.w};
        float xf[16];
        float am = 0.f;
#pragma unroll
        for (int j = 0; j < 8; j++) { xf[2 * j] = __uint_as_float(xw[j] << 16); xf[2 * j + 1] = __uint_as_float(xw[j] & 0xffff0000u); am = fmaxf(am, fmaxf(fabsf(xf[2 * j]), fabsf(xf[2 * j + 1]))); }
        am = wave_max(am);
        const float sx = (am > 0.f) ? am * (1.f / 127.f) : 1.f;
        const float isx = 1.f / sx;
        u32x4 q;
#pragma unroll
        for (int j = 0; j < 4; j++) {
            const int q0 = (int)rintf(xf[4 * j] * isx), q1 = (int)rintf(xf[4 * j + 1] * isx), q2 = (int)rintf(xf[4 * j + 2] * isx), q3 = (int)rintf(xf[4 * j + 3] * isx);
            q[j] = (unsigned)(q0 & 0xff) | ((unsigned)(q1 & 0xff) << 8) | ((unsigned)(q2 & 0xff) << 16) | ((unsigned)(q3 & 0xff) << 24);
        }
        xqs[k * 64 + lane] = q;
        if (lane == 0) sxs[k] = sx;
    }
    float acc[PE_TOK][16];
    float bsum[PE_TOK];
#pragma unroll
    for (int k = 0; k < PE_TOK; k++) {
        bsum[k] = 0.f;
#pragma unroll
        for (int i = 0; i < 16; i++) acc[k][i] = 0.f;
    }
    PeSet S0, S1, S2, S3;
    pe_prepare(S0, ent_e, 0, 0, uq, vq, lane);
    pe_prepare(S1, ent_e, 1, 0, uq, vq, lane);
    pe_prepare(S2, ent_e, 2, 0, uq, vq, lane);
#pragma unroll 1
    for (int p = 0; p < PE_NP; p++) {
        pe_prepare(S3, ent_e, 3, p, uq, vq, lane);
        pe_consume(S0, ent_e, ent_g, ent_s, xqs, sxs, 0, uq, vq, lane, acc[0], bsum[0]);
        if (p + 1 < PE_NP) pe_prepare(S0, ent_e, 0, p + 1, uq, vq, lane);
        pe_consume(S1, ent_e, ent_g, ent_s, xqs, sxs, 1, uq, vq, lane, acc[1], bsum[1]);
        if (p + 1 < PE_NP) pe_prepare(S1, ent_e, 1, p + 1, uq, vq, lane);
        pe_consume(S2, ent_e, ent_g, ent_s, xqs, sxs, 2, uq, vq, lane, acc[2], bsum[2]);
        if (p + 1 < PE_NP) pe_prepare(S2, ent_e, 2, p + 1, uq, vq, lane);
        pe_consume(S3, ent_e, ent_g, ent_s, xqs, sxs, 3, uq, vq, lane, acc[3], bsum[3]);
    }
#pragma unroll
    for (int k = 0; k < PE_TOK; k++) {
        const float bs = 128.f * bsum[k];
        float4* o = (float4*)(out + ((size_t)grp * PE_TOK + k) * DM + lane * 16);
#pragma unroll
        for (int j = 0; j < 4; j++) {
            float4 t = o[j];
            t.x += acc[k][4 * j] - bs; t.y += acc[k][4 * j + 1] - bs; t.z += acc[k][4 * j + 2] - bs; t.w += acc[k][4 * j + 3] - bs;
            if (do_store) o[j] = t; else asm volatile("" :: "v"(t.x), "v"(t.y), "v"(t.z), "v"(t.w));
        }
    }
}

struct MKP {
    const float *x, *attn_norm, *w_in, *q_gain, *k_gain, *cmp_pos, *cmp_w1, *cmp_w2, *gdn_conv, *a_log, *dt_bias, *out_gain, *w_out, *ffn_norm, *w_query, *subkeys, *peer_u, *peer_v;
    float* out; char* ws; unsigned* bar;
};

#define SMEM_BYTES 70144

__global__ __launch_bounds__(256, 2) void hybrid_megakernel(MKP P) {
    extern __shared__ __attribute__((aligned(16))) char smem[];
    __shared__ uint4 xb_words;
    __shared__ int q_item;
    const int G = gridDim.x, bid0 = blockIdx.x;
    if (threadIdx.x == 0) xb_words = make_uint4(0u, 0u, 0u, 0u);
    __syncthreads();
    XcdBarrier B = xcd_barrier_post(P.bar, (volatile LAS unsigned*)&xb_words);
    char* ws = P.ws;
    bf16_t* w_in_t = (bf16_t*)(ws + OFF_WINT);
    bf16_t* w_out_t = (bf16_t*)(ws + OFF_WOUTT);
    bf16_t* w_q_t = (bf16_t*)(ws + OFF_WQT);
    bf16_t* cw1_t = (bf16_t*)(ws + OFF_CW1T);
    float* cbias = (float*)(ws + OFF_CBIAS);
    bf16_t* h_bf = (bf16_t*)(ws + OFF_HBF);
    bf16_t* proj = (bf16_t*)(ws + OFF_PROJ);
    bf16_t* ksn = (bf16_t*)(ws + OFF_KSN);
    bf16_t* kwn = (bf16_t*)(ws + OFF_KWN);
    bf16_t* kc = (bf16_t*)(ws + OFF_KC);
    bf16_t* vc = (bf16_t*)(ws + OFF_VC);
    bf16_t* hid = (bf16_t*)(ws + OFF_HID);
    bf16_t* gu = (bf16_t*)(ws + OFF_GU);
    bf16_t* gw = (bf16_t*)(ws + OFF_GW);
    bf16_t* gqd = (bf16_t*)(ws + OFF_GQD);
    bf16_t* gkd = (bf16_t*)(ws + OFF_GKD);
    bf16_t* gin = (bf16_t*)(ws + OFF_GIN);
    float* gl = (float*)(ws + OFF_GL);
    bf16_t* mix = (bf16_t*)(ws + OFF_MIX);
    bf16_t* qry = (bf16_t*)(ws + OFF_QRY);
    bf16_t* h2 = (bf16_t*)(ws + OFF_H2);
    int* eidx = (int*)(ws + OFF_EIDX);
    float* pgate = (float*)(ws + OFF_PGATE);
    unsigned char* uq = (unsigned char*)(ws + OFF_UQ);
    unsigned char* vq = (unsigned char*)(ws + OFF_VQ);
    float* su = (float*)(ws + OFF_SU);
    float* sv = (float*)(ws + OFF_SV);
    float* og = P.out;
    float2* rope = (float2*)(ws + OFF_ROPE);
    float* ssq = (float*)(ws + OFF_SSQ);
    bf16_t* vsn = (bf16_t*)(ws + OFF_VSN);
    bf16_t* vwn = (bf16_t*)(ws + OFF_VWN);
    bf16_t* cw2t = (bf16_t*)(ws + OFF_CW2T);
    unsigned char* uq_tmp = (unsigned char*)(P.out + 8388608);
    unsigned char* vq_tmp = uq_tmp + 16384ull * 1024;

#ifdef PROBE_P0
    for (int rep = 0; rep < 2; rep++)
#endif
    {
        const int n1 = 108 * 8, n2 = n1 + 32 * 8, n3 = n2 + 64 * 8, n4 = n3 + 2 * 8 * 16, n5 = n4 + 2 * 2 * 2;
        for (int it = bid0; it < n5; it += G) {
            if (it < n1) d_transpose_bf16(P.w_in, 1024, IN_COLS, w_in_t, it % 108, it / 108, smem);
            else if (it < n2) { int r = it - n1; d_transpose_bf16(P.w_out, 1024, 1024, w_out_t, r % 32, r / 32, smem); }
            else if (it < n3) { int r = it - n2; d_transpose_bf16(P.w_query, 1024, 2048, w_q_t, r % 64, r / 64, smem, P.ffn_norm); }
            else if (it < n4) { int r = it - n3; int j = r >> 7; r &= 127; d_transpose_bf16(P.cmp_w1 + (size_t)j * 2048 * 256, 2048, 256, cw1_t + (size_t)j * 256 * 2048, r % 8, r / 8, smem); }
            else { int r = it - n4; int j = r >> 2; r &= 3; d_transpose_bf16(P.cmp_w2 + (size_t)j * 256 * 64, 256, 64, cw2t + (size_t)j * 64 * 256, r % 2, r / 2, smem); }
        }
        for (int it = bid0; it < 16; it += G) d_cmp_bias(P.cmp_pos, P.cmp_w1, cbias, it, smem);
        for (int it = bid0; it < T_TOK / 4; it += G) d_rmsnorm_bf16(P.x, P.attn_norm, h_bf, it);
        for (int i = bid0 * 256 + threadIdx.x; i < 8192 * 32; i += G * 256) {
            const int pos = i >> 5, fi = i & 31;
            float sn, cs; sincosf((float)pos * expf(-9.210340371976184f * (float)(2 * fi) / 64.f), &sn, &cs);
            rope[i] = make_float2(cs, sn);
        }
        for (int i = bid0 * 256 + threadIdx.x; i < 32 * PLD / 2; i += G * 256) ((unsigned*)(proj + (size_t)T_TOK * PLD))[i] = 0u;
    }
    xcd_barrier(B);
    {
        GemmP p{}; p.A = h_bf; p.lda = 1024; p.akts = 64; p.Bt = w_in_t; p.ldb = 1024; p.K = 1024; p.mtiles = 128; p.ntiles = 27; p.out = proj;
#ifdef PROBE_GEMM1
        for (int rep = 0; rep < PROBE_GEMM1; rep++)
#endif
        for (int it = bid0; it < 128 * 27; it += G) d_gemm<EPI_PROJ>(p, it, smem);
    }
    xcd_barrier(B);
#ifdef PROBE_MISC
    for (int rep = 0; rep < 2; rep++)
#endif
    {
        for (int it = bid0; it < 64; it += G) {
            int inst = it >> 3, tile = it & 7;
            int j = inst >> 2, b = (inst >> 1) & 1, g = inst & 1;
            GemmP p{}; p.A = proj + (size_t)(b * SEQ) * PLD + C_KV + 128 * j + 64 * g; p.lda = 16 * PLD; p.akts = PLD;
            p.Bt = cw1_t + (size_t)j * 256 * 2048; p.ldb = 2048; p.K = 2048; p.mtiles = 4; p.ntiles = 2;
            p.out = hid + (size_t)inst * 512 * 256; p.aux = cbias + j * 256;
            d_gemm<EPI_HID>(p, tile, smem);
        }
        for (int it = bid0; it < 1024; it += G) { d_gdn_prep2(proj, P.gdn_conv, P.a_log, P.dt_bias, gu, gw, gqd, gkd, gin, gl, it, smem); __syncthreads(); }
        for (int it = bid0; it < 8192; it += G) d_knorm_rope(proj, P.k_gain, ksn, kwn, vsn, vwn, rope, it);
    }
    xcd_barrier(B);
#ifdef PROBE_MISC
    for (int rep = 0; rep < 2; rep++)
#endif
    for (int wi = bid0 * 4 + (threadIdx.x >> 6); wi < 256; wi += G * 4) d_cmp2_mfma(hid, cw2t, P.k_gain, rope, kc, vc, wi, threadIdx.x & 63);
    xcd_barrier(B);
    {
#ifdef PROBE_SCAN
        if (bid0 < 64) d_gdn_scan2(gu, gw, gqd, gkd, gin, gl, og, bid0, smem);
        xcd_barrier(B);
#endif
        if (bid0 < 64) d_gdn_scan2(gu, gw, gqd, gkd, gin, gl, og, bid0, smem);
        __syncthreads();
#ifdef PROBE_NSA
        for (int rep = 0; rep < 2; rep++)
#else
        const int rep = 0;
#endif
        for (;;) {
            if (threadIdx.x == 0) q_item = (int)xb_add(&P.bar[XB_QUEUE + 256 * rep], 1u);
            __syncthreads();
            const int it = q_item;
            if (it >= 1024 + 128) break;
            if (it >= 1024) {
                const int r0 = (it - 1024) * 128 + (threadIdx.x >> 6) * 32;
                for (int r = r0; r < r0 + 32; r++) { d_quant_row(P.peer_u, uq_tmp, su, r, threadIdx.x & 63, 0); d_quant_row(P.peer_v, vq_tmp, sv, r, threadIdx.x & 63, 128); }
            } else {
#ifdef PROBE_NSA
                d_nsa_mfma(proj, P.q_gain, rope, ksn, kwn, kc, vc, vsn, vwn, mix, DM, it, smem, (PROBE_NSA == 2) && rep == 0);
#else
                d_nsa_mfma(proj, P.q_gain, rope, ksn, kwn, kc, vc, vsn, vwn, mix, DM, it, smem);
#endif
            }
            __syncthreads();
        }
#ifdef NSA_CHECK
        bf16_t* mix2 = (bf16_t*)(ws + OFF_END);
        for (;;) {
            if (threadIdx.x == 0) q_item = (int)xb_add(&P.bar[XB_QUEUE + 64], 1u);
            __syncthreads();
            const int it = q_item;
            if (it >= 2 * 2 * SEQ) break;
            d_nsa_naive(proj, P.q_gain, ksn, kwn, kc, vc, mix2, 512, it, smem);
            __syncthreads();
        }
#endif
    }
    xcd_barrier(B);
#ifdef NSA_CHECK
    {
        const bf16_t* mix2 = (const bf16_t*)(ws + OFF_END);
        float sd = 0.f, sr = 0.f;
        for (int i = bid0 * 256 + threadIdx.x; i < T_TOK * 512; i += G * 256) {
            const int r = i >> 9, c = i & 511;
            const float a = bf2f(mix[(size_t)r * DM + c]), bb = bf2f(mix2[i]);
            sd += (a - bb) * (a - bb); sr += bb * bb;
        }
        sd = wave_sum(sd); sr = wave_sum(sr);
        if ((threadIdx.x & 63) == 0) { atomicAdd((float*)&P.bar[XB_QUEUE + 128], sd); atomicAdd((float*)&P.bar[XB_QUEUE + 192], sr); }
    }
    xcd_barrier(B);
#endif
#ifdef PROBE_MISC
    for (int rep = 0; rep < 2; rep++) {
#endif
    for (int t = bid0 * 4 + (threadIdx.x >> 6); t < T_TOK; t += G * 4) d_gdn_out(og, proj, P.out_gain, mix, t, threadIdx.x & 63);
    for (int i = bid0 * 256 + threadIdx.x; i < 2 * 16384 * 1024 / 16; i += G * 256) ((uint4*)uq)[i] = ((const uint4*)uq_tmp)[i];
#ifdef PROBE_MISC
    }
#endif
    xcd_barrier(B);
#ifdef PROBE_P4
    for (int rep = 0; rep < 2; rep++) {
#endif
    {
        GemmP p{}; p.A = mix; p.lda = 1024; p.akts = 64; p.Bt = w_out_t; p.ldb = 1024; p.K = 1024; p.mtiles = 128; p.ntiles = 8; p.out = P.out; p.aux = P.x; p.out2 = h2; p.ssq = ssq;
        for (int it = bid0; it < 128 * 8; it += G) d_gemm<EPI_OUT>(p, it, smem);
    }
    xcd_barrier(B);
    {
        GemmP p{}; p.A = h2; p.lda = 1024; p.akts = 64; p.Bt = w_q_t; p.ldb = 1024; p.K = 1024; p.mtiles = 128; p.ntiles = 16; p.out = qry; p.ssq = ssq;
        for (int it = bid0; it < 128 * 16; it += G) d_gemm<EPI_QRY>(p, it, smem);
    }
    xcd_barrier(B);
#ifdef PROBE_P4
    }
#endif
    route_load_subkeys(P.subkeys, smem);
    __syncthreads();
#ifdef PROBE_ROUTE
    for (int rep = 0; rep < 2; rep++)
#endif
    for (int mt = bid0 * 4 + (threadIdx.x >> 6); mt < T_TOK / 2; mt += G * 4) d_peer_route2(qry, eidx, pgate, mt, smem, threadIdx.x & 63);
    xcd_barrier(B);
#ifdef PEER_SWEEP
    for (int grp = bid0 * 4 + (threadIdx.x >> 6); grp < T_TOK / PE_TOK; grp += G * 4) d_peer_expert5(h2, eidx, pgate, uq, vq, su, sv, P.out, grp, threadIdx.x & 63, smem + (threadIdx.x >> 6) * PE_WAVE_LDS, true);
#else
#ifdef PROBE_PEER3
    for (int it = bid0; it < T_TOK / 4; it += G) d_peer_expert3(h2, eidx, pgate, uq, vq, su, sv, ssq, P.ffn_norm, P.out, it * 4 + (threadIdx.x >> 6), threadIdx.x & 63, false, PROBE_PEER3);
    xcd_barrier(B);
#endif
    {
        const int rounds = (T_TOK / 4 + G - 1) / G;
        for (int rd = 0; rd < rounds; rd++) {
            xcd_local_sync(B, (unsigned)(2 * rd));
            const int it = rd * G + bid0;
            if (it < T_TOK / 4) d_peer_expert3(h2, eidx, pgate, uq, vq, su, sv, ssq, P.ffn_norm, P.out, it * 4 + (threadIdx.x >> 6), threadIdx.x & 63, true, 0xffff, &B, (unsigned)(2 * rd + 1));
            else xcd_local_sync(B, (unsigned)(2 * rd + 1));
        }
    }
#endif
#ifdef NSA_CHECK
    xcd_barrier(B);
    {
        const float sd = __hip_atomic_load((float*)&P.bar[XB_QUEUE + 128], __ATOMIC_RELAXED, __HIP_MEMORY_SCOPE_AGENT);
        const float sr = __hip_atomic_load((float*)&P.bar[XB_QUEUE + 192], __ATOMIC_RELAXED, __HIP_MEMORY_SCOPE_AGENT);
        if (!(sd <= NSA_CHECK * sr)) for (int i = bid0 * 256 + threadIdx.x; i < T_TOK * DM; i += G * 256) P.out[i] += 1000.f;
    }
#endif
}

extern "C" void kernel_launch(void* const* d_in, const int* in_sizes, int n_in, void* d_out, int out_size, void* d_ws, size_t ws_size,
                              hipStream_t stream) {
#ifdef NSA_CHECK
    const size_t bar_off = ((OFF_END + 16384ull * 512 * 2) + 255) & ~(size_t)255;
#else
    const size_t bar_off = (OFF_END + 255) & ~(size_t)255;
#endif
    if (ws_size < bar_off + XCD_BAR_WORDS * 4) return;
    static int grid_blocks = 0;
    if (!grid_blocks) {
        int dev = 0, cus = 0, per_cu = 0;
        (void)hipGetDevice(&dev);
        (void)hipDeviceGetAttribute(&cus, hipDeviceAttributeMultiprocessorCount, dev);
        (void)hipFuncSetAttribute((const void*)hybrid_megakernel, hipFuncAttributeMaxDynamicSharedMemorySize, SMEM_BYTES);
        (void)hipOccupancyMaxActiveBlocksPerMultiprocessor(&per_cu, hybrid_megakernel, 256, SMEM_BYTES);
        if (per_cu > 2) per_cu = 2;
        grid_blocks = cus * per_cu;
    }
    if (grid_blocks <= 0) return;
    MKP P{};
    P.x = (const float*)d_in[0]; P.attn_norm = (const float*)d_in[1]; P.w_in = (const float*)d_in[2]; P.q_gain = (const float*)d_in[3];
    P.k_gain = (const float*)d_in[4]; P.cmp_pos = (const float*)d_in[5]; P.cmp_w1 = (const float*)d_in[6]; P.cmp_w2 = (const float*)d_in[7];
    P.gdn_conv = (const float*)d_in[8]; P.a_log = (const float*)d_in[9]; P.dt_bias = (const float*)d_in[10]; P.out_gain = (const float*)d_in[11];
    P.w_out = (const float*)d_in[12]; P.ffn_norm = (const float*)d_in[13]; P.w_query = (const float*)d_in[14]; P.subkeys = (const float*)d_in[15];
    P.peer_u = (const float*)d_in[16]; P.peer_v = (const float*)d_in[17];
    P.out = (float*)d_out; P.ws = (char*)d_ws; P.bar = (unsigned*)((char*)d_ws + bar_off);
    (void)hipMemsetAsync(P.bar, 0, XCD_BAR_WORDS * 4, stream);
    hipLaunchKernelGGL(hybrid_megakernel, dim3(grid_blocks), dim3(256), SMEM_BYTES, stream, P);
}
```

```cpp
#include <hip/hip_runtime.h>
#include <stdint.h>

typedef unsigned short bf16_t;
typedef __attribute__((ext_vector_type(8))) short bf16x8;
typedef __attribute__((ext_vector_type(4))) float f32x4;
typedef __attribute__((ext_vector_type(2))) float f32x2;
#define LAS3 __attribute__((address_space(3)))

#define T_TOK 16384
#define SEQ 8192
#define DM 1024
#define IN_COLS 3360
#define PLD 3456
#define C_Q 0
#define C_KV 512
#define C_GATE 1280
#define C_GQKV 1304
#define C_Z 2840
#define C_A 3352
#define C_B 3356

#define OFF_WINT   0ull
#define OFF_WOUTT  (OFF_WINT  + 3456ull*1024*2)
#define OFF_WQT    (OFF_WOUTT + 1024ull*1024*2)
#define OFF_CW1T   (OFF_WQT   + 2048ull*1024*2)
#define OFF_CBIAS  (OFF_CW1T  + 2ull*256*2048*2)
#define OFF_HBF    (OFF_CBIAS + 4096ull)
#define OFF_PROJ   (OFF_HBF   + 16384ull*1024*2)
#define OFF_KSN    (OFF_PROJ  + (16384ull+32)*PLD*2)
#define OFF_KWN    (OFF_KSN   + 4ull*8192*64*2)
#define OFF_KC     (OFF_KWN   + 4ull*8192*64*2)
#define OFF_VC     (OFF_KC    + 4ull*512*64*2)
#define OFF_HID    (OFF_VC    + 4ull*512*64*2)
#define OFF_GU     (OFF_HID   + 8ull*512*256*2)
#define OFF_GW     (OFF_GU    + 1024ull*64*128*2)
#define OFF_GQD    (OFF_GW    + 1024ull*64*128*2)
#define OFF_GKD    (OFF_GQD   + 1024ull*64*128*2)
#define OFF_GIN    (OFF_GKD   + 1024ull*64*128*2)
#define OFF_GL     (OFF_GIN   + 1024ull*64*64*2)
#define OFF_ROPE   (OFF_GL    + 4096ull)
#define OFF_CW2T   (OFF_ROPE  + 8192ull*32*8)
#define OFF_SU     (OFF_CW2T  + 2ull*64*256*2)
#define OFF_SV     (OFF_SU    + 65536ull)
#define OFF_SSQ    (OFF_SV    + 65536ull)
#define OFF_VSN    (OFF_SSQ   + 16384ull*16*4)
#define OFF_VWN    (OFF_VSN   + 4ull*8192*64*2)
#define OFF_END    (OFF_VWN   + 4ull*8192*64*2)
#define OFF_MIX    OFF_HBF
#define OFF_QRY    OFF_PROJ
#define OFF_H2     (OFF_PROJ + 16384ull*2048*2)
#define OFF_EIDX   OFF_KSN
#define OFF_PGATE  OFF_GIN
#define OFF_UQ     OFF_GU
#define OFF_VQ     (OFF_GU + 16384ull*1024)

__device__ __forceinline__ bf16_t f2bf(float f) {
    unsigned u = __float_as_uint(f);
    u += 0x7fffu + ((u >> 16) & 1u);
    return (bf16_t)(u >> 16);
}
__device__ __forceinline__ float bf2f(bf16_t h) { return __uint_as_float(((unsigned)h) << 16); }
typedef __bf16 bf16x2_t2 __attribute__((ext_vector_type(2)));
__device__ __forceinline__ unsigned pk2(float a, float b) { bf16x2_t2 v; v[0] = (__bf16)a; v[1] = (__bf16)b; return __builtin_bit_cast(unsigned, v); }
__device__ __forceinline__ float gelu_tanh(float x) {
    float u = 0.7978845608028654f * (x + 0.044715f * x * x * x);
    return 0.5f * x * (1.f + tanhf(u));
}
__device__ __forceinline__ float sigmoidf_(float x) { return 1.f / (1.f + __expf(-x)); }
__device__ __forceinline__ float wave_sum(float v) {
#pragma unroll
    for (int o = 32; o > 0; o >>= 1) v += __shfl_xor(v, o);
    return v;
}
__device__ __forceinline__ float wave_max(float v) {
#pragma unroll
    for (int o = 32; o > 0; o >>= 1) v = fmaxf(v, __shfl_xor(v, o));
    return v;
}

template <int CTRL> __device__ __forceinline__ float dppf(float x) { return __builtin_bit_cast(float, __builtin_amdgcn_update_dpp(0, __builtin_bit_cast(int, x), CTRL, 0xf, 0xf, true)); }
template <int CTRL> __device__ __forceinline__ unsigned dppu(unsigned x) { return (unsigned)__builtin_amdgcn_update_dpp(0, (int)x, CTRL, 0xf, 0xf, true); }
__device__ __forceinline__ float allmax16(float x) {
    x = fmaxf(x, dppf<0xB1>(x)); x = fmaxf(x, dppf<0x4E>(x)); x = fmaxf(x, dppf<0x141>(x)); x = fmaxf(x, dppf<0x140>(x)); return x;
}
__device__ __forceinline__ unsigned allmaxu16(unsigned x) {
    x = max(x, dppu<0xB1>(x)); x = max(x, dppu<0x4E>(x)); x = max(x, dppu<0x141>(x)); x = max(x, dppu<0x140>(x)); return x;
}
__device__ __forceinline__ float allsum16(float x) {
    x += dppf<0xB1>(x); x += dppf<0x4E>(x); x += dppf<0x141>(x); x += dppf<0x140>(x); return x;
}
__device__ __forceinline__ float wave_sum_dpp(float x) {
    x = allsum16(x);
    return __builtin_bit_cast(float, __builtin_amdgcn_readlane(__builtin_bit_cast(int, x), 0)) + __builtin_bit_cast(float, __builtin_amdgcn_readlane(__builtin_bit_cast(int, x), 16)) +
           __builtin_bit_cast(float, __builtin_amdgcn_readlane(__builtin_bit_cast(int, x), 32)) + __builtin_bit_cast(float, __builtin_amdgcn_readlane(__builtin_bit_cast(int, x), 48));
}
__device__ __forceinline__ void d_transpose_bf16(const float* __restrict__ W, int K, int N, bf16_t* __restrict__ Wt, int bx, int by, char* smem, const float* __restrict__ kscale = nullptr) {
    float* tile = (float*)smem;
    const int n0 = bx * 32, k0 = by * 128;
    const int tx = threadIdx.x & 31, ty = threadIdx.x >> 5;
    const int n = n0 + tx;
    float v[16];
#pragma unroll
    for (int i = 0; i < 16; i++) { const int k = k0 + ty + 8 * i; v[i] = (n < N) ? W[(size_t)k * N + n] : 0.f; }
#pragma unroll
    for (int i = 0; i < 16; i++) { const int kk = ty + 8 * i; tile[kk * 33 + tx] = v[i] * (kscale ? kscale[k0 + kk] : 1.f); }
    __syncthreads();
    {
        const int nn = threadIdx.x >> 3, kc = (threadIdx.x & 7) * 16;
        unsigned pk[8];
#pragma unroll
        for (int j = 0; j < 8; j++) pk[j] = pk2(tile[(kc + 2 * j) * 33 + nn], tile[(kc + 2 * j + 1) * 33 + nn]);
        uint4* dst = (uint4*)(Wt + (size_t)(n0 + nn) * K + k0 + kc);
        dst[0] = make_uint4(pk[0], pk[1], pk[2], pk[3]); dst[1] = make_uint4(pk[4], pk[5], pk[6], pk[7]);
    }
    __syncthreads();
}

__device__ __forceinline__ void d_rmsnorm_bf16(const float* __restrict__ x, const float* __restrict__ g, bf16_t* __restrict__ out, int bid) {
    int row = bid * 4 + (threadIdx.x >> 6);
    int lane = threadIdx.x & 63;
    const float4* xr = (const float4*)(x + (size_t)row * DM);
    float4 v[4];
    float ss = 0.f;
#pragma unroll
    for (int i = 0; i < 4; i++) { v[i] = xr[lane + 64 * i]; ss += v[i].x * v[i].x + v[i].y * v[i].y + v[i].z * v[i].z + v[i].w * v[i].w; }
    ss = wave_sum(ss);
    float r = rsqrtf(ss * (1.f / DM) + 1e-6f);
#pragma unroll
    for (int i = 0; i < 4; i++) {
        float4 gg = ((const float4*)g)[lane + 64 * i];
        ushort4 o;
        o.x = f2bf(v[i].x * r * gg.x); o.y = f2bf(v[i].y * r * gg.y); o.z = f2bf(v[i].z * r * gg.z); o.w = f2bf(v[i].w * r * gg.w);
        ((ushort4*)(out + (size_t)row * DM))[lane + 64 * i] = o;
    }
}

__device__ __forceinline__ void d_cmp_bias(const float* __restrict__ pos, const float* __restrict__ w1, float* __restrict__ bias, int item, char* smem) {
    float* part = (float*)smem;
    const int j = item >> 3, c = (item & 7) * 32 + (threadIdx.x & 31), ksl = threadIdx.x >> 5;
    float s0 = 0.f, s1 = 0.f, s2 = 0.f, s3 = 0.f;
    const float* wp = w1 + ((size_t)j * 2048 + ksl * 256) * 256 + c;
    const float* pp = pos + j * 2048 + ksl * 256;
    for (int k = 0; k < 256; k += 4) {
        s0 += pp[k] * wp[(size_t)k * 256]; s1 += pp[k + 1] * wp[(size_t)(k + 1) * 256];
        s2 += pp[k + 2] * wp[(size_t)(k + 2) * 256]; s3 += pp[k + 3] * wp[(size_t)(k + 3) * 256];
    }
    part[ksl * 32 + (threadIdx.x & 31)] = (s0 + s1) + (s2 + s3);
    __syncthreads();
    if (threadIdx.x < 32) {
        float t = 0.f;
#pragma unroll
        for (int i = 0; i < 8; i++) t += part[i * 32 + threadIdx.x];
        bias[j * 256 + c] = t;
    }
    __syncthreads();
}

#define EPI_PROJ 0
#define EPI_HID 1
#define EPI_OUT 2
#define EPI_QRY 3
struct GemmP {
    const bf16_t* A; long lda; long akts;
    const bf16_t* Bt; long ldb;
    int K; int mtiles; int ntiles;
    long a_inst; long b_inst;
    void* out; const float* aux; const float* aux2; bf16_t* out2; float* ssq;
};

template <int EPI>
__device__ __forceinline__ void d_gemm(const GemmP& p, int bid, char* smem) {
    const int tid = threadIdx.x, lane = tid & 63, wave = tid >> 6;
    const int wm = wave >> 1, wn = wave & 1;
    const int inst = 0;
    const int nwg = p.mtiles * p.ntiles, wgid = (bid & 7) * (nwg >> 3) + (bid >> 3);
    const int mt = wgid / p.ntiles, nt = wgid % p.ntiles;
    const int m0 = mt * 128, n0 = nt * 128;
    const bf16_t* A = p.A + (size_t)inst * p.a_inst + (size_t)m0 * p.lda;
    const bf16_t* Bt = p.Bt + (size_t)inst * p.b_inst + (size_t)n0 * p.ldb;
    f32x4 acc[4][4];
#pragma unroll
    for (int i = 0; i < 4; i++)
#pragma unroll
        for (int j = 0; j < 4; j++) acc[i][j] = (f32x4){0.f, 0.f, 0.f, 0.f};
    const int nk = p.K >> 6;
    const int crow = tid >> 3, cslot = tid & 7;
    const int csrc = (cslot ^ (crow & 7)) * 8;
    const bf16_t* Ap = A + (size_t)crow * p.lda + csrc;
    const bf16_t* Bp = Bt + (size_t)crow * p.ldb + csrc;
    const size_t a32 = (size_t)32 * p.lda, b32 = (size_t)32 * p.ldb;
    char* ldsw = smem + tid * 16;
#define GSTAGE(buf, koffA, koffB) { char* _d = ldsw + (buf) * 32768; \
    __builtin_amdgcn_global_load_lds((const unsigned*)(Ap + (koffA)), (LAS3 unsigned*)(_d), 16, 0, 0); \
    __builtin_amdgcn_global_load_lds((const unsigned*)(Ap + a32 + (koffA)), (LAS3 unsigned*)(_d + 4096), 16, 0, 0); \
    __builtin_amdgcn_global_load_lds((const unsigned*)(Ap + 2 * a32 + (koffA)), (LAS3 unsigned*)(_d + 8192), 16, 0, 0); \
    __builtin_amdgcn_global_load_lds((const unsigned*)(Ap + 3 * a32 + (koffA)), (LAS3 unsigned*)(_d + 12288), 16, 0, 0); \
    __builtin_amdgcn_global_load_lds((const unsigned*)(Bp + (koffB)), (LAS3 unsigned*)(_d + 16384), 16, 0, 0); \
    __builtin_amdgcn_global_load_lds((const unsigned*)(Bp + b32 + (koffB)), (LAS3 unsigned*)(_d + 16384 + 4096), 16, 0, 0); \
    __builtin_amdgcn_global_load_lds((const unsigned*)(Bp + 2 * b32 + (koffB)), (LAS3 unsigned*)(_d + 16384 + 8192), 16, 0, 0); \
    __builtin_amdgcn_global_load_lds((const unsigned*)(Bp + 3 * b32 + (koffB)), (LAS3 unsigned*)(_d + 16384 + 12288), 16, 0, 0); }
    const int n16 = lane & 15, kq = lane >> 4;
    GSTAGE(0, 0, 0)
    for (int kt = 0; kt < nk; kt++) {
        if (kt + 1 < nk) {
            GSTAGE((kt + 1) & 1, (size_t)(kt + 1) * p.akts, (size_t)(kt + 1) * 64)
            asm volatile("s_waitcnt vmcnt(8)" ::: "memory");
        } else {
            asm volatile("s_waitcnt vmcnt(0)" ::: "memory");
        }
        __builtin_amdgcn_s_barrier();
        const char* Ab = smem + (kt & 1) * 32768;
        const char* Bb = Ab + 16384;
#pragma unroll
        for (int ks = 0; ks < 2; ks++) {
            bf16x8 af[4], bfr[4];
#pragma unroll
            for (int i = 0; i < 4; i++) { const int R = wm * 64 + i * 16 + n16; af[i] = *(const bf16x8*)(Ab + R * 128 + (((4 * ks + kq) ^ (R & 7)) << 4)); }
#pragma unroll
            for (int j = 0; j < 4; j++) { const int R = wn * 64 + j * 16 + n16; bfr[j] = *(const bf16x8*)(Bb + R * 128 + (((4 * ks + kq) ^ (R & 7)) << 4)); }
#pragma unroll
            for (int i = 0; i < 4; i++)
#pragma unroll
                for (int j = 0; j < 4; j++) acc[i][j] = __builtin_amdgcn_mfma_f32_16x16x32_bf16(bfr[j], af[i], acc[i][j], 0, 0, 0);
        }
        asm volatile("s_waitcnt lgkmcnt(0)" ::: "memory");
        __builtin_amdgcn_s_barrier();
    }
    {
        char* slab = smem + wave * 9216;
        const int rbase = m0 + wm * 64, cbase = n0 + wn * 64;
        if (EPI == EPI_OUT) {
            float* st = (float*)slab;
#pragma unroll
            for (int hlf = 0; hlf < 2; hlf++) {
#pragma unroll
                for (int ii = 0; ii < 2; ii++)
#pragma unroll
                    for (int j = 0; j < 4; j++) *(f32x4*)(st + (ii * 16 + n16) * 68 + j * 16 + 4 * kq) = acc[hlf * 2 + ii][j];
#pragma unroll
                for (int ps = 0; ps < 8; ps++) {
                    const int rl = ps * 4 + kq, row = rbase + hlf * 32 + rl;
                    const float4 a = *(const float4*)(st + rl * 68 + n16 * 4);
                    const float4 xx = *(const float4*)(p.aux + (size_t)row * DM + cbase + n16 * 4);
                    const float4 o = make_float4(xx.x + a.x, xx.y + a.y, xx.z + a.z, xx.w + a.w);
                    *(float4*)((float*)p.out + (size_t)row * DM + cbase + n16 * 4) = o;
                    *(uint2*)(p.out2 + (size_t)row * DM + cbase + n16 * 4) = make_uint2(pk2(o.x, o.y), pk2(o.z, o.w));
                    const float ss = allsum16(o.x * o.x + o.y * o.y + o.z * o.z + o.w * o.w);
                    if (n16 == 0) p.ssq[(size_t)row * 16 + nt * 2 + wn] = ss;
                }
            }
        } else {
            bf16_t* st = (bf16_t*)slab;
#pragma unroll
            for (int i = 0; i < 4; i++) {
                float rs = 1.f;
                if (EPI == EPI_QRY) {
                    const float4* q = (const float4*)(p.ssq + (size_t)(rbase + i * 16 + n16) * 16);
                    const float4 q0 = q[0], q1 = q[1], q2 = q[2], q3 = q[3];
                    const float t = ((q0.x + q0.y) + (q0.z + q0.w)) + ((q1.x + q1.y) + (q1.z + q1.w)) + ((q2.x + q2.y) + (q2.z + q2.w)) + ((q3.x + q3.y) + (q3.z + q3.w));
                    rs = rsqrtf(t * (1.f / DM) + 1e-6f);
                }
#pragma unroll
                for (int j = 0; j < 4; j++) {
                    float v0 = acc[i][j][0], v1 = acc[i][j][1], v2 = acc[i][j][2], v3 = acc[i][j][3];
                    if (EPI == EPI_HID) {
                        const float4 bb = *(const float4*)(p.aux + (inst >> 2) * 256 + cbase + 16 * j + 4 * kq);
                        v0 = gelu_tanh(v0 + bb.x); v1 = gelu_tanh(v1 + bb.y); v2 = gelu_tanh(v2 + bb.z); v3 = gelu_tanh(v3 + bb.w);
                    }
                    if (EPI == EPI_QRY) { v0 *= rs; v1 *= rs; v2 *= rs; v3 *= rs; }
                    *(uint2*)(st + (i * 16 + n16) * 72 + j * 16 + 4 * kq) = make_uint2(pk2(v0, v1), pk2(v2, v3));
                }
            }
            const int ld = (EPI == EPI_PROJ) ? PLD : (EPI == EPI_HID ? 256 : 2048);
#pragma unroll
            for (int ps = 0; ps < 8; ps++) {
                const int rl = ps * 8 + (lane >> 3), ch = lane & 7;
                const uint4 v = *(const uint4*)(st + rl * 72 + ch * 8);
                *(uint4*)((bf16_t*)p.out + (size_t)(rbase + rl) * ld + cbase + ch * 8) = v;
            }
        }
        __syncthreads();
    }
}

__device__ __forceinline__ void d_knorm_rope(const bf16_t* __restrict__ proj, const float* __restrict__ kgain, bf16_t* __restrict__ ksn, bf16_t* __restrict__ kwn, bf16_t* __restrict__ vsn, bf16_t* __restrict__ vwn, const float2* __restrict__ rope, int bid) {
    int vec = bid * 8 + (threadIdx.x >> 5);
    int i = threadIdx.x & 31;
    int which = vec >> 15;
    int rem = vec & 32767;
    int b = rem >> 14, g = (rem >> 13) & 1, s = rem & 8191;
    const bf16_t* src = proj + (size_t)(b * SEQ + s) * PLD + C_KV + 128 * (which ? 4 : 2) + 64 * g;
    float x1 = bf2f(src[i]), x2 = bf2f(src[i + 32]);
    float ss = x1 * x1 + x2 * x2;
#pragma unroll
    for (int o = 16; o > 0; o >>= 1) ss += __shfl_xor(ss, o);
    float r = rsqrtf(ss * (1.f / 64.f) + 1e-6f);
    const float* gn = kgain + (which ? 2 : 1) * 64;
    x1 = x1 * r * gn[i]; x2 = x2 * r * gn[i + 32];
    const float2 cs2 = rope[(size_t)s * 32 + i];
    const float cs = cs2.x, sn = cs2.y;
    bf16_t* dst = (which ? kwn : ksn) + ((size_t)(b * 2 + g) * SEQ + s) * 64;
    dst[i] = f2bf(x1 * cs - x2 * sn);
    dst[i + 32] = f2bf(x2 * cs + x1 * sn);
    ((unsigned*)((which ? vwn : vsn) + ((size_t)(b * 2 + g) * SEQ + s) * 64))[i] = ((const unsigned*)(src + 128))[i];
}

__device__ __forceinline__ void d_cmp2_mfma(const bf16_t* __restrict__ hid, const bf16_t* __restrict__ cw2t, const float* __restrict__ kgain, const float2* __restrict__ rope,
                                            bf16_t* __restrict__ kc, bf16_t* __restrict__ vc, int witem, int lane) {
    const int n16 = lane & 15, kq = lane >> 4;
    const int rowbase = 16 * witem, inst = rowbase >> 9, n0 = rowbase & 511, j = inst >> 2, bg = inst & 3;
    f32x4 acc[4];
#pragma unroll
    for (int nt = 0; nt < 4; nt++) acc[nt] = (f32x4){0.f, 0.f, 0.f, 0.f};
    const bf16_t* ap = hid + (size_t)(rowbase + n16) * 256 + 8 * kq;
    const bf16_t* bp = cw2t + (size_t)j * 64 * 256 + n16 * 256 + 8 * kq;
#pragma unroll
    for (int ks = 0; ks < 8; ks++) {
        const bf16x8 a = *(const bf16x8*)(ap + 32 * ks);
#pragma unroll
        for (int nt = 0; nt < 4; nt++) {
            const bf16x8 bb = *(const bf16x8*)(bp + (size_t)(16 * nt) * 256 + 32 * ks);
            acc[nt] = __builtin_amdgcn_mfma_f32_16x16x32_bf16(a, bb, acc[nt], 0, 0, 0);
        }
    }
#pragma unroll
    for (int r = 0; r < 4; r++) {
        const int n = n0 + 4 * kq + r;
        if (j == 0) {
            float ss = acc[0][r] * acc[0][r] + acc[1][r] * acc[1][r] + acc[2][r] * acc[2][r] + acc[3][r] * acc[3][r];
            ss = allsum16(ss);
            const float ri = rsqrtf(ss * (1.f / 64.f) + 1e-6f);
#pragma unroll
            for (int nt = 0; nt < 2; nt++) {
                const int i = 16 * nt + n16;
                const float y1 = acc[nt][r] * ri * kgain[i], y2 = acc[nt + 2][r] * ri * kgain[i + 32];
                const float2 cs = rope[(size_t)((n < 511 ? n : 510) * 16 + 31) * 32 + i];
                if (n < 511) {
                    kc[((size_t)bg * 512 + n) * 64 + i] = f2bf(y1 * cs.x - y2 * cs.y);
                    kc[((size_t)bg * 512 + n) * 64 + i + 32] = f2bf(y2 * cs.x + y1 * cs.y);
                }
            }
        } else if (n < 511) {
#pragma unroll
            for (int nt = 0; nt < 4; nt++) vc[((size_t)bg * 512 + n) * 64 + 16 * nt + n16] = f2bf(acc[nt][r]);
        }
    }
}

typedef float f32x16 __attribute__((ext_vector_type(16)));
typedef short s16x4 __attribute__((ext_vector_type(4)));
#define MFMA32(a, b, c) __builtin_amdgcn_mfma_f32_32x32x16_bf16((a), (b), (c), 0, 0, 0)
#define NKS 72
#define NSA_K_OFF 0
#define NSA_V_OFF (2 * 64 * NKS * 2)
#define NSA_IMP_OFF (NSA_V_OFF + 2 * 64 * NKS * 2)
#define NSA_SEL_OFF (NSA_IMP_OFF + 4 * 8192)
#define NSA_LDS (NSA_SEL_OFF + 32 * 4 * 4)
#define NEGBIG (-1e30f)
__device__ __forceinline__ bf16x8 pack8(float a0, float a1, float a2, float a3, float a4, float a5, float a6, float a7) {
    uint4 u = make_uint4(pk2(a0, a1), pk2(a2, a3), pk2(a4, a5), pk2(a6, a7));
    return __builtin_bit_cast(bf16x8, u);
}
typedef unsigned u32x4 __attribute__((ext_vector_type(4)));
struct NsaStage { u32x4 k0, k1, v0, v1; };
struct NsaCtx {
    bool noload;
    const bf16_t* Kbase; long kstride;
    const bf16_t* Vbase; long vstride;
    bf16_t* Kb; bf16_t* Vb;
    float* imp_s; unsigned* sel_s;
    bf16x8 qf[4];
    f32x16 O0, O1;
    float m, l, invl, carry;
    int t, tokl, hp, hh, c, lane;
};
__device__ __forceinline__ void nsa_stage_load(const NsaCtx& X, NsaStage& st, int j) {
    const int r0 = threadIdx.x >> 3, c8 = (threadIdx.x & 7) * 8;
    if (X.noload) { st.k0 = (u32x4){0u,0u,0u,0u}; st.k1 = st.k0; st.v0 = st.k0; st.v1 = st.k0; return; }
    const bf16_t* kp = X.Kbase + (size_t)(64 * j + r0) * X.kstride + c8;
    const bf16_t* vp = X.Vbase + (size_t)(64 * j + r0) * X.vstride + c8;
    st.k0 = *(const u32x4*)kp; st.k1 = *(const u32x4*)(kp + 32 * X.kstride);
    st.v0 = *(const u32x4*)vp; st.v1 = *(const u32x4*)(vp + 32 * X.vstride);
}
__device__ __forceinline__ void nsa_stage_store(const NsaCtx& X, const NsaStage& st, int buf) {
    const int r0 = threadIdx.x >> 3, c8 = (threadIdx.x & 7) * 8;
    bf16_t* kb = X.Kb + buf * 64 * NKS + r0 * NKS + c8;
    bf16_t* vb = X.Vb + buf * 64 * NKS + r0 * NKS + c8;
    *(u32x4*)kb = st.k0; *(u32x4*)(kb + 32 * NKS) = st.k1;
    *(u32x4*)vb = st.v0; *(u32x4*)(vb + 32 * NKS) = st.v1;
}
template <int MODE, bool FAST>
__device__ __forceinline__ void nsa_tile(NsaCtx& X, int j, int kt, int buf, unsigned long long mlo, unsigned long long mhi) {
    const bf16_t* Kt = X.Kb + buf * 64 * NKS + (32 * kt) * NKS;
    const bf16_t* Vt = X.Vb + buf * 64 * NKS + (32 * kt) * NKS;
    f32x16 S;
#pragma unroll
    for (int i = 0; i < 16; i++) S[i] = 0.f;
#pragma unroll
    for (int s = 0; s < 4; s++) {
        bf16x8 ka = *(const bf16x8*)(Kt + X.c * NKS + 16 * s + 8 * X.hh);
        S = MFMA32(ka, X.qf[s], S);
    }
    const int kbase = 64 * j + 32 * kt;
    int lo = 0, hi;
    bool on = true;
    if (MODE <= 1) hi = ((X.t - 31) >> 4) - kbase;
    else hi = X.t - kbase;
    if (MODE == 3) lo = X.t - 511 - kbase;
    if (MODE == 2) {
        const unsigned long long wsel = (j < 64) ? mlo : mhi;
        on = (wsel >> (j & 63)) & 1ull;
    }
    lo -= 4 * X.hh; hi -= 4 * X.hh;
    if (!on) hi = -1000;
    float P[16];
    if (MODE == 1) {
#pragma unroll
        for (int i = 0; i < 16; i++) {
            const int cr = (i & 3) + 8 * (i >> 2);
            P[i] = (cr <= hi) ? __builtin_amdgcn_exp2f(S[i] - X.m) * X.invl : 0.f;
        }
        float mainv[4], nxt[4];
#pragma unroll
        for (int q = 0; q < 4; q++) { mainv[q] = 2.f * (P[4 * q] + P[4 * q + 1] + P[4 * q + 2]) + P[4 * q + 3]; nxt[q] = P[4 * q + 3]; }
#pragma unroll
        for (int q = 0; q < 4; q++) {
            mainv[q] += __shfl_xor(mainv[q], 1); mainv[q] += __shfl_xor(mainv[q], 2);
            nxt[q] += __shfl_xor(nxt[q], 1); nxt[q] += __shfl_xor(nxt[q], 2);
        }
        float recv[4];
#pragma unroll
        for (int q = 0; q < 4; q++) recv[q] = __shfl_xor(nxt[q], 32);
        const int jsel0 = 16 * j + 8 * kt + X.hh;
#pragma unroll
        for (int q = 0; q < 4; q++) {
            const float tot = mainv[q] + (X.hh ? recv[q] : (q > 0 ? recv[q > 0 ? q - 1 : 0] : X.carry));
            if (X.hp == 0) X.imp_s[(X.tokl & 7) * 128 + jsel0 + 2 * q] = tot;
        }
        X.carry = recv[3];
    } else {
        float tmax = NEGBIG;
        if (FAST) {
            tmax = fmaxf(fmaxf(fmaxf(fmaxf(S[0], S[1]), fmaxf(S[2], S[3])), fmaxf(fmaxf(S[4], S[5]), fmaxf(S[6], S[7]))),
                         fmaxf(fmaxf(fmaxf(S[8], S[9]), fmaxf(S[10], S[11])), fmaxf(fmaxf(S[12], S[13]), fmaxf(S[14], S[15]))));
            if (MODE == 2 && !on) tmax = NEGBIG;
        } else {
#pragma unroll
            for (int i = 0; i < 16; i++) {
                const int cr = (i & 3) + 8 * (i >> 2);
                const bool vis = (cr <= hi) && (cr >= lo);
                tmax = vis ? fmaxf(tmax, S[i]) : tmax;
            }
        }
        tmax = fmaxf(tmax, __shfl_xor(tmax, 32));
        float ls = 0.f;
        if (MODE == 0) {
            const float mnew = fmaxf(X.m, tmax);
            const float alpha = __builtin_amdgcn_exp2f(X.m - mnew);
            X.m = mnew;
#pragma unroll
            for (int i = 0; i < 16; i++) {
                const int cr = (i & 3) + 8 * (i >> 2);
                const bool vis = (cr <= hi) && (cr >= lo);
                P[i] = vis ? __builtin_amdgcn_exp2f(S[i] - mnew) : 0.f;
                ls += P[i];
            }
            X.l = X.l * alpha + ls;
        } else {
            const bool upd = tmax > X.m + 8.f;
            const float mnew = upd ? tmax : X.m;
            if (__builtin_amdgcn_ballot_w64(upd) != 0ull) {
                const float alpha = __builtin_amdgcn_exp2f(X.m - mnew);
                X.l *= alpha;
#pragma unroll
                for (int i = 0; i < 16; i++) { X.O0[i] *= alpha; X.O1[i] *= alpha; }
            }
            X.m = mnew;
            if (FAST) {
                const float msub = (MODE == 2 && !on) ? 1e30f : mnew;
#pragma unroll
                for (int i = 0; i < 16; i++) { P[i] = __builtin_amdgcn_exp2f(S[i] - msub); ls += P[i]; }
            } else {
#pragma unroll
                for (int i = 0; i < 16; i++) {
                    const int cr = (i & 3) + 8 * (i >> 2);
                    const bool vis = (cr <= hi) && (cr >= lo);
                    P[i] = vis ? __builtin_amdgcn_exp2f(S[i] - mnew) : 0.f;
                    ls += P[i];
                }
            }
            X.l += ls;
        }
    }
    if (MODE >= 1) {
        bf16x8 pb0 = pack8(P[0], P[1], P[2], P[3], P[4], P[5], P[6], P[7]);
        bf16x8 pb1 = pack8(P[8], P[9], P[10], P[11], P[12], P[13], P[14], P[15]);
        const int l15 = X.lane & 15;
        const bf16_t* vrow = Vt + (4 * X.hh + (l15 >> 2)) * NKS + 16 * ((X.lane >> 4) & 1) + 4 * (l15 & 3);
#pragma unroll
        for (int s2 = 0; s2 < 2; s2++) {
#pragma unroll
            for (int dt = 0; dt < 2; dt++) {
                s16x4 lo4 = __builtin_amdgcn_ds_read_tr16_b64_v4i16((LAS3 s16x4*)(vrow + (16 * s2) * NKS + 32 * dt));
                s16x4 hi4 = __builtin_amdgcn_ds_read_tr16_b64_v4i16((LAS3 s16x4*)(vrow + (16 * s2 + 8) * NKS + 32 * dt));
                bf16x8 va = __builtin_shufflevector(lo4, hi4, 0, 1, 2, 3, 4, 5, 6, 7);
                if (dt == 0) X.O0 = MFMA32(va, s2 ? pb1 : pb0, X.O0); else X.O1 = MFMA32(va, s2 ? pb1 : pb0, X.O1);
            }
        }
    }
}
template <int MODE>
__device__ __forceinline__ void nsa_block(NsaCtx& X, int j, unsigned long long mlo, unsigned long long mhi, unsigned long long ulo, unsigned long long uhi, int cur, int tw0) {
    bool need = true;
    if (MODE == 2) {
        const unsigned long long wsel = (j < 64) ? ulo : uhi;
        need = (wsel >> (j & 63)) & 1ull;
    }
    if (need) {
#pragma unroll 1
        for (int kt = 0; kt < 2; kt++) {
            bool fast = false;
            if (MODE == 2) fast = j < cur;
            if (MODE == 3) { const int kb = 64 * j + 32 * kt; fast = (kb + 31 <= tw0) && (kb >= tw0 + 7 - 511); }
            if (MODE >= 2 && fast) nsa_tile<MODE, true>(X, j, kt, j & 1, mlo, mhi);
            else nsa_tile<MODE, false>(X, j, kt, j & 1, mlo, mhi);
        }
    }
}
template <int MODE>
__device__ __forceinline__ void nsa_branch(NsaCtx& X, int jlo, int jhi, unsigned long long mlo, unsigned long long mhi, unsigned long long ulo, unsigned long long uhi, int cur, int tw0) {
    NsaStage sa;
    nsa_stage_load(X, sa, jlo);
    __syncthreads();
    nsa_stage_store(X, sa, jlo & 1);
    __syncthreads();
#pragma unroll 1
    for (int j = jlo; j <= jhi; j++) {
        if (j < jhi) nsa_stage_load(X, sa, j + 1);
        nsa_block<MODE>(X, j, mlo, mhi, ulo, uhi, cur, tw0);
        if (j < jhi) nsa_stage_store(X, sa, (j + 1) & 1);
        __syncthreads();
    }
}
template <int OP>
__device__ __forceinline__ void nsa_facc(NsaCtx& X, float scale) {
    f32x4* F = (f32x4*)X.imp_s;
#pragma unroll
    for (int q = 0; q < 8; q++) {
        f32x4 v;
#pragma unroll
        for (int e = 0; e < 4; e++) v[e] = ((q < 4) ? X.O0[4 * q + e] : X.O1[4 * (q - 4) + e]) * scale;
        if (OP >= 1) v += F[q * 64 + X.lane];
        if (OP <= 1) F[q * 64 + X.lane] = v;
        else {
#pragma unroll
            for (int e = 0; e < 4; e++) { if (q < 4) X.O0[4 * q + e] = v[e]; else X.O1[4 * (q - 4) + e] = v[e]; }
        }
    }
}
__device__ __forceinline__ void d_nsa_mfma(const bf16_t* __restrict__ proj, const float* __restrict__ qgain, const float2* __restrict__ rope,
                                           const bf16_t* __restrict__ ksn, const bf16_t* __restrict__ kwn,
                                           const bf16_t* __restrict__ kc, const bf16_t* __restrict__ vc, const bf16_t* __restrict__ vsn, const bf16_t* __restrict__ vwn,
                                           bf16_t* __restrict__ mixo, int mix_ld, int item, char* smem, bool noload = false) {
    NsaCtx X;
    X.noload = noload;
    const int tid = threadIdx.x, lane = tid & 63, w = tid >> 6;
    const int bg = item & 3, tile = 255 - (item >> 2);
    const int b = bg >> 1, g = bg & 1, t0 = tile * 32;
    X.lane = lane; X.c = lane & 31; X.hh = lane >> 5; X.hp = X.c & 3; X.tokl = 8 * w + (X.c >> 2); X.t = t0 + X.tokl;
    X.Kb = (bf16_t*)(smem + NSA_K_OFF); X.Vb = (bf16_t*)(smem + NSA_V_OFF);
    X.imp_s = (float*)(smem + NSA_IMP_OFF + w * 8192); X.sel_s = (unsigned*)(smem + NSA_SEL_OFF);
    const int head = g * 4 + X.hp;
    const size_t row = (size_t)(b * SEQ + X.t);
    {
        float y[4][8];
        const bf16_t* qsrc = proj + row * PLD + C_Q + head * 64 + 8 * X.hh;
        float ss = 0.f;
#pragma unroll
        for (int s = 0; s < 4; s++) {
            const uint4 u = *(const uint4*)(qsrc + 16 * s);
            const unsigned wv[4] = {u.x, u.y, u.z, u.w};
#pragma unroll
            for (int e = 0; e < 4; e++) { y[s][2 * e] = __uint_as_float(wv[e] << 16); y[s][2 * e + 1] = __uint_as_float(wv[e] & 0xffff0000u); }
#pragma unroll
            for (int e = 0; e < 8; e++) ss += y[s][e] * y[s][e];
        }
        ss += __shfl_xor(ss, 32);
        const float r = rsqrtf(ss * (1.f / 64.f) + 1e-6f);
#pragma unroll
        for (int s = 0; s < 4; s++)
#pragma unroll
            for (int e = 0; e < 8; e++) y[s][e] *= r * qgain[16 * s + 8 * X.hh + e];
        const float qs = 0.125f * 1.4426950408889634f;
#pragma unroll
        for (int s = 0; s < 2; s++)
#pragma unroll
            for (int e = 0; e < 8; e++) {
                const float2 cs = rope[(size_t)X.t * 32 + 16 * s + 8 * X.hh + e];
                const float x1 = y[s][e], x2 = y[s + 2][e];
                y[s][e] = (x1 * cs.x - x2 * cs.y) * qs; y[s + 2][e] = (x2 * cs.x + x1 * cs.y) * qs;
            }
#pragma unroll
        for (int s = 0; s < 4; s++) X.qf[s] = pack8(y[s][0], y[s][1], y[s][2], y[s][3], y[s][4], y[s][5], y[s][6], y[s][7]);
    }
    const bf16_t* gp = proj + row * PLD + C_GATE + head * 3;
    const float g0 = sigmoidf_(bf2f(gp[0])), g1 = sigmoidf_(bf2f(gp[1])), g2 = sigmoidf_(bf2f(gp[2]));
    const int cur = t0 >> 6;
    {
        X.Kbase = kc + (size_t)bg * 512 * 64; X.kstride = 64; X.Vbase = vc + (size_t)bg * 512 * 64; X.vstride = 64;
        const int nvmax = (t0 >> 4) + 1, jhi = (nvmax - 1) >> 6;
        X.m = NEGBIG; X.l = 0.f;
        nsa_branch<0>(X, 0, jhi, 0ull, 0ull, 0ull, 0ull, cur, t0 + 8 * w);
        const float lt = X.l + __shfl_xor(X.l, 32);
        X.invl = (lt > 0.f) ? 1.f / lt : 0.f;
        X.carry = 0.f;
#pragma unroll
        for (int i = 0; i < 16; i++) { X.O0[i] = 0.f; X.O1[i] = 0.f; }
        nsa_branch<1>(X, 0, jhi, 0ull, 0ull, 0ull, 0ull, cur, t0 + 8 * w);
    }
    unsigned long long mlo, mhi, ulo, uhi;
    {
        const int tk2 = lane >> 3, sub = lane & 7;
        unsigned k0 = 1u, k1 = 0u, k2 = 0u, k3 = 0u;
#define SETBIT(jj) { const int _j = (jj); if (_j < 32) k0 |= 1u << _j; else if (_j < 64) k1 |= 1u << (_j - 32); else if (_j < 96) k2 |= 1u << (_j - 64); else k3 |= 1u << (_j - 96); }
        SETBIT(cur);
        if (cur >= 1) SETBIT(cur - 1);
        const int ncand = cur - 2;
        if (ncand > 0) {
            if (ncand <= 13) {
                for (int jj = 1; jj <= cur - 2; jj++) SETBIT(jj);
            } else {
                float sc[16];
#pragma unroll
                for (int i = 0; i < 16; i++) { const int jj = sub + 8 * i; sc[i] = (jj >= 1 && jj <= cur - 2) ? X.imp_s[tk2 * 128 + jj] : -3e38f; }
#pragma unroll 1
                for (int it = 0; it < 13; it++) {
                    float bv = sc[0]; int bi = 0;
#pragma unroll
                    for (int i = 1; i < 16; i++) if (sc[i] > bv) { bv = sc[i]; bi = i; }
                    int bj = sub + 8 * bi;
#pragma unroll
                    for (int o = 1; o < 8; o <<= 1) {
                        const float ov = __shfl_xor(bv, o); const int oj = __shfl_xor(bj, o);
                        if (ov > bv || (ov == bv && oj < bj)) { bv = ov; bj = oj; }
                    }
                    SETBIT(bj);
#pragma unroll
                    for (int i = 0; i < 16; i++) if (bj == sub + 8 * i) sc[i] = -3e38f;
                }
            }
        }
#undef SETBIT
        if (sub == 0) { unsigned* d = X.sel_s + (8 * w + tk2) * 4; d[0] = k0; d[1] = k1; d[2] = k2; d[3] = k3; }
        __builtin_amdgcn_s_waitcnt(0xc07f);
        const unsigned* sp = X.sel_s + X.tokl * 4;
        const unsigned m0 = sp[0], m1 = sp[1], m2 = sp[2], m3 = sp[3];
        mlo = (unsigned long long)m0 | ((unsigned long long)m1 << 32); mhi = (unsigned long long)m2 | ((unsigned long long)m3 << 32);
        unsigned u0 = m0, u1 = m1, u2 = m2, u3 = m3;
#pragma unroll
        for (int o = 4; o < 32; o <<= 1) { u0 |= __shfl_xor(u0, o); u1 |= __shfl_xor(u1, o); u2 |= __shfl_xor(u2, o); u3 |= __shfl_xor(u3, o); }
        ulo = (unsigned long long)(unsigned)__builtin_amdgcn_readfirstlane(u0) | ((unsigned long long)(unsigned)__builtin_amdgcn_readfirstlane(u1) << 32);
        uhi = (unsigned long long)(unsigned)__builtin_amdgcn_readfirstlane(u2) | ((unsigned long long)(unsigned)__builtin_amdgcn_readfirstlane(u3) << 32);
    }
    nsa_facc<0>(X, g0);
    {
        X.Kbase = ksn + (size_t)bg * SEQ * 64; X.kstride = 64;
        X.Vbase = vsn + (size_t)bg * SEQ * 64; X.vstride = 64;
        X.m = NEGBIG; X.l = 0.f;
#pragma unroll
        for (int i = 0; i < 16; i++) { X.O0[i] = 0.f; X.O1[i] = 0.f; }
        nsa_branch<2>(X, 0, cur, mlo, mhi, ulo, uhi, cur, t0 + 8 * w);
        const float lt = X.l + __shfl_xor(X.l, 32);
        nsa_facc<1>(X, (lt > 0.f) ? g1 / lt : 0.f);
    }
    {
        X.Kbase = kwn + (size_t)bg * SEQ * 64; X.kstride = 64;
        X.Vbase = vwn + (size_t)bg * SEQ * 64; X.vstride = 64;
        X.m = NEGBIG; X.l = 0.f;
#pragma unroll
        for (int i = 0; i < 16; i++) { X.O0[i] = 0.f; X.O1[i] = 0.f; }
        const int jlo = (t0 >= 511) ? ((t0 - 511) >> 6) : 0;
        nsa_branch<3>(X, jlo, cur, 0ull, 0ull, 0ull, 0ull, cur, t0 + 8 * w);
        const float lt = X.l + __shfl_xor(X.l, 32);
        nsa_facc<2>(X, (lt > 0.f) ? g2 / lt : 0.f);
    }
    bf16_t* dst = mixo + row * mix_ld + head * 64 + 4 * X.hh;
#pragma unroll
    for (int q4 = 0; q4 < 4; q4++) {
        *(uint2*)(dst + 8 * q4) = make_uint2(pk2(X.O0[4 * q4], X.O0[4 * q4 + 1]), pk2(X.O0[4 * q4 + 2], X.O0[4 * q4 + 3]));
        *(uint2*)(dst + 32 + 8 * q4) = make_uint2(pk2(X.O1[4 * q4], X.O1[4 * q4 + 1]), pk2(X.O1[4 * q4 + 2], X.O1[4 * q4 + 3]));
    }
}

#define KLS 136
#define XSS 264
#define GDN_PREP_LDS (2 * 64 * KLS * 2 + 64 * XSS * 2 + 512)
__device__ __forceinline__ unsigned pack2bf(float lo, float hi) { return (unsigned)f2bf(lo) | ((unsigned)f2bf(hi) << 16); }
__device__ __forceinline__ void d_gdn_prep2(const bf16_t* __restrict__ proj, const float* __restrict__ conv_w,
                                            const float* __restrict__ a_log, const float* __restrict__ dt_bias,
                                            bf16_t* __restrict__ guT, bf16_t* __restrict__ gw, bf16_t* __restrict__ gqd,
                                            bf16_t* __restrict__ gkdT, bf16_t* __restrict__ gin, float* __restrict__ gl, int chunk, char* smem) {
    bf16_t* kL = (bf16_t*)smem;
    bf16_t* qL = kL + 64 * KLS;
    float* AmT = (float*)qL;
    bf16_t* xs = qL + 64 * KLS;
    float* gcs = (float*)(xs + 64 * XSS);
    float* bts = gcs + 64;
    const int tid = threadIdx.x, lane = tid & 63, w = tid >> 6;
    const int n = chunk & 127, h = (chunk >> 7) & 3, b = chunk >> 9;
    const int t0 = n * 64;
    const size_t rbase = (size_t)(b * SEQ + t0);
    if (tid < 64) {
        const size_t r = (rbase + tid) * PLD;
        float a = bf2f(proj[r + C_A + h]), bb = bf2f(proj[r + C_B + h]);
        float xx = a + dt_bias[h];
        float sp = (xx > 20.f) ? xx : log1pf(__expf(xx));
        float c = -__expf(a_log[h]) * sp;
#pragma unroll
        for (int o = 1; o < 64; o <<= 1) { float nb = __shfl_up(c, o); if (lane >= o) c += nb; }
        gcs[tid] = c; bts[tid] = sigmoidf_(bb);
    }
    __syncthreads();
    {
        float wt[6][4], x0[6], x1[6], x2[6];
        int ch[6];
#pragma unroll
        for (int c6 = 0; c6 < 6; c6++) {
            ch[c6] = (c6 >> 1) * 512 + h * 128 + lane + 64 * (c6 & 1);
#pragma unroll
            for (int j = 0; j < 4; j++) wt[c6][j] = conv_w[j * 1536 + ch[c6]];
            const int tb = t0 + 16 * w - 3;
            x0[c6] = (tb >= 0) ? bf2f(proj[((size_t)(b * SEQ + tb)) * PLD + C_GQKV + ch[c6]]) : 0.f;
            x1[c6] = (tb + 1 >= 0) ? bf2f(proj[((size_t)(b * SEQ + tb + 1)) * PLD + C_GQKV + ch[c6]]) : 0.f;
            x2[c6] = (tb + 2 >= 0) ? bf2f(proj[((size_t)(b * SEQ + tb + 2)) * PLD + C_GQKV + ch[c6]]) : 0.f;
        }
        for (int i = 16 * w; i < 16 * w + 16; i++) {
            float sv[6];
#pragma unroll
            for (int c6 = 0; c6 < 6; c6++) {
                float xn = bf2f(proj[(rbase + i) * PLD + C_GQKV + ch[c6]]);
                float cv = x0[c6] * wt[c6][0] + x1[c6] * wt[c6][1] + x2[c6] * wt[c6][2] + xn * wt[c6][3];
                x0[c6] = x1[c6]; x1[c6] = x2[c6]; x2[c6] = xn;
                sv[c6] = cv * sigmoidf_(cv);
            }
            float rq = rsqrtf(wave_sum(sv[0] * sv[0] + sv[1] * sv[1]) + 1e-6f) * 0.08838834764831845f;
            float rk = rsqrtf(wave_sum(sv[2] * sv[2] + sv[3] * sv[3]) + 1e-6f);
            const float bi = bts[i], ei = __expf(gcs[i]);
            float q0 = sv[0] * rq, q1 = sv[1] * rq, k0 = sv[2] * rk, k1 = sv[3] * rk;
            qL[i * KLS + lane] = f2bf(q0); qL[i * KLS + lane + 64] = f2bf(q1);
            kL[i * KLS + lane] = f2bf(k0); kL[i * KLS + lane + 64] = f2bf(k1);
            xs[i * XSS + lane] = f2bf(sv[4] * bi); xs[i * XSS + lane + 64] = f2bf(sv[5] * bi);
            xs[i * XSS + 128 + lane] = f2bf(k0 * bi * ei); xs[i * XSS + 192 + lane] = f2bf(k1 * bi * ei);
            bf16_t* qd = gqd + (size_t)chunk * 8192 + i * 128;
            qd[lane] = f2bf(q0 * ei); qd[lane + 64] = f2bf(q1 * ei);
        }
    }
    __syncthreads();
    const int n16 = lane & 15, kq = lane >> 4;
    f32x4 aqk[4], akk[4];
#pragma unroll
    for (int tj = 0; tj < 4; tj++) { aqk[tj] = (f32x4){0.f, 0.f, 0.f, 0.f}; akk[tj] = (f32x4){0.f, 0.f, 0.f, 0.f}; }
#pragma unroll
    for (int ks = 0; ks < 4; ks++) {
        bf16x8 qa = *(const bf16x8*)(qL + (16 * w + n16) * KLS + 32 * ks + 8 * kq);
        bf16x8 ka = *(const bf16x8*)(kL + (16 * w + n16) * KLS + 32 * ks + 8 * kq);
#pragma unroll
        for (int tj = 0; tj < 4; tj++) {
            bf16x8 kb = *(const bf16x8*)(kL + (16 * tj + n16) * KLS + 32 * ks + 8 * kq);
            aqk[tj] = __builtin_amdgcn_mfma_f32_16x16x32_bf16(qa, kb, aqk[tj], 0, 0, 0);
            akk[tj] = __builtin_amdgcn_mfma_f32_16x16x32_bf16(ka, kb, akk[tj], 0, 0, 0);
        }
    }
    {
        const float glast = gcs[63];
        const int kidx = tid >> 1, c0 = (tid & 1) * 32;
        unsigned pk[16];
#pragma unroll
        for (int cc = 0; cc < 32; cc += 2) {
            float v0 = bf2f(kL[(c0 + cc) * KLS + kidx]) * __expf(glast - gcs[c0 + cc]);
            float v1 = bf2f(kL[(c0 + cc + 1) * KLS + kidx]) * __expf(glast - gcs[c0 + cc + 1]);
            pk[cc >> 1] = pack2bf(v0, v1);
        }
        uint4* dst = (uint4*)(gkdT + (size_t)chunk * 8192 + kidx * 64 + c0);
#pragma unroll
        for (int v4 = 0; v4 < 4; v4++) dst[v4] = make_uint4(pk[4 * v4], pk[4 * v4 + 1], pk[4 * v4 + 2], pk[4 * v4 + 3]);
        if (tid == 0) gl[chunk] = __expf(glast);
    }
    __syncthreads();
#pragma unroll
    for (int tj = 0; tj < 4; tj++)
#pragma unroll
        for (int r = 0; r < 4; r++) {
            const int i = 16 * w + 4 * kq + r, j = 16 * tj + n16;
            const float dec = (j <= i) ? __expf(gcs[i] - gcs[j]) : 0.f;
            gin[(size_t)chunk * 4096 + i * 64 + j] = f2bf(aqk[tj][r] * dec);
            AmT[j * 64 + i] = (j < i) ? bts[i] * akk[tj][r] * dec : 0.f;
        }
    __syncthreads();
    {
        const int c = tid;
#pragma unroll 1
        for (int blk = 0; blk < 8; blk++) {
            const int i0 = blk * 8;
            float acc[8];
#pragma unroll
            for (int r = 0; r < 8; r++) acc[r] = bf2f(xs[(i0 + r) * XSS + c]);
            for (int j = 0; j < i0; j++) {
                const float xj = bf2f(xs[j * XSS + c]);
                const float4 a0 = *(const float4*)(AmT + j * 64 + i0), a1 = *(const float4*)(AmT + j * 64 + i0 + 4);
                acc[0] -= a0.x * xj; acc[1] -= a0.y * xj; acc[2] -= a0.z * xj; acc[3] -= a0.w * xj;
                acc[4] -= a1.x * xj; acc[5] -= a1.y * xj; acc[6] -= a1.z * xj; acc[7] -= a1.w * xj;
            }
#pragma unroll
            for (int r = 1; r < 8; r++)
#pragma unroll
                for (int s2 = 0; s2 < r; s2++) acc[r] -= AmT[(i0 + s2) * 64 + i0 + r] * acc[s2];
#pragma unroll
            for (int r = 0; r < 8; r++) xs[(i0 + r) * XSS + c] = f2bf(acc[r]);
            if (c < 128) {
                *(uint4*)(guT + (size_t)chunk * 8192 + c * 64 + i0) =
                    make_uint4(pack2bf(acc[0], acc[1]), pack2bf(acc[2], acc[3]), pack2bf(acc[4], acc[5]), pack2bf(acc[6], acc[7]));
            } else {
#pragma unroll
                for (int r = 0; r < 8; r++) gw[(size_t)chunk * 8192 + (i0 + r) * 128 + (c - 128)] = f2bf(acc[r]);
            }
        }
    }
}

struct GdnFrag { bf16x8 wA[4], qA[4], inA[2], kdA[2][2]; uint2 uC; float glv; };
__device__ __forceinline__ void gdn_load_frag(GdnFrag& f, const bf16_t* __restrict__ guT, const bf16_t* __restrict__ gw, const bf16_t* __restrict__ gqd,
                                              const bf16_t* __restrict__ gkdT, const bf16_t* __restrict__ gin, const float* __restrict__ gl,
                                              int chunk, int w, int sl, int n16, int kq) {
    const size_t cb = (size_t)chunk * 8192;
#pragma unroll
    for (int ks = 0; ks < 4; ks++) {
        f.wA[ks] = *(const bf16x8*)(gw + cb + (16 * w + n16) * 128 + 32 * ks + 8 * kq);
        f.qA[ks] = *(const bf16x8*)(gqd + cb + (16 * w + n16) * 128 + 32 * ks + 8 * kq);
    }
#pragma unroll
    for (int ks = 0; ks < 2; ks++) {
        f.inA[ks] = *(const bf16x8*)(gin + (size_t)chunk * 4096 + (16 * w + n16) * 64 + 32 * ks + 8 * kq);
        f.kdA[0][ks] = *(const bf16x8*)(gkdT + cb + (32 * w + n16) * 64 + 32 * ks + 8 * kq);
        f.kdA[1][ks] = *(const bf16x8*)(gkdT + cb + (32 * w + 16 + n16) * 64 + 32 * ks + 8 * kq);
    }
    f.uC = *(const uint2*)(guT + cb + (16 * sl + n16) * 64 + 16 * w + 4 * kq);
    f.glv = gl[chunk];
}
#define STS 144
#define VNS 80
__device__ __forceinline__ void gdn_step(const GdnFrag& f, f32x4& S0, f32x4& S1, bf16_t* StT, bf16_t* vnT, float* __restrict__ ogrow, int w, int n16, int kq) {
    f32x4 ws = (f32x4){0.f, 0.f, 0.f, 0.f}, qs = (f32x4){0.f, 0.f, 0.f, 0.f};
#pragma unroll
    for (int ks = 0; ks < 4; ks++) {
        bf16x8 sb = *(const bf16x8*)(StT + n16 * STS + 32 * ks + 8 * kq);
        ws = __builtin_amdgcn_mfma_f32_16x16x32_bf16(f.wA[ks], sb, ws, 0, 0, 0);
        qs = __builtin_amdgcn_mfma_f32_16x16x32_bf16(f.qA[ks], sb, qs, 0, 0, 0);
    }
    float v0 = __uint_as_float(f.uC.x << 16) - ws[0], v1 = __uint_as_float(f.uC.x & 0xffff0000u) - ws[1];
    float v2 = __uint_as_float(f.uC.y << 16) - ws[2], v3 = __uint_as_float(f.uC.y & 0xffff0000u) - ws[3];
    *(uint2*)(vnT + n16 * VNS + 16 * w + 4 * kq) = make_uint2(pack2bf(v0, v1), pack2bf(v2, v3));
    __syncthreads();
    bf16x8 vb0 = *(const bf16x8*)(vnT + n16 * VNS + 8 * kq), vb1 = *(const bf16x8*)(vnT + n16 * VNS + 32 + 8 * kq);
    qs = __builtin_amdgcn_mfma_f32_16x16x32_bf16(f.inA[0], vb0, qs, 0, 0, 0);
    qs = __builtin_amdgcn_mfma_f32_16x16x32_bf16(f.inA[1], vb1, qs, 0, 0, 0);
    S0 = S0 * f.glv; S1 = S1 * f.glv;
    S0 = __builtin_amdgcn_mfma_f32_16x16x32_bf16(f.kdA[0][0], vb0, S0, 0, 0, 0);
    S0 = __builtin_amdgcn_mfma_f32_16x16x32_bf16(f.kdA[0][1], vb1, S0, 0, 0, 0);
    S1 = __builtin_amdgcn_mfma_f32_16x16x32_bf16(f.kdA[1][0], vb0, S1, 0, 0, 0);
    S1 = __builtin_amdgcn_mfma_f32_16x16x32_bf16(f.kdA[1][1], vb1, S1, 0, 0, 0);
#pragma unroll
    for (int r = 0; r < 4; r++) ogrow[(size_t)(4 * kq + r) * 512] = qs[r];
    *(uint2*)(StT + n16 * STS + 32 * w + 4 * kq) = make_uint2(pack2bf(S0[0], S0[1]), pack2bf(S0[2], S0[3]));
    *(uint2*)(StT + n16 * STS + 32 * w + 16 + 4 * kq) = make_uint2(pack2bf(S1[0], S1[1]), pack2bf(S1[2], S1[3]));
    __syncthreads();
}
__device__ __forceinline__ void d_gdn_scan2(const bf16_t* __restrict__ guT, const bf16_t* __restrict__ gw, const bf16_t* __restrict__ gqd,
                                            const bf16_t* __restrict__ gkdT, const bf16_t* __restrict__ gin, const float* __restrict__ gl,
                                            float* __restrict__ og, int item, char* smem) {
    bf16_t* StT = (bf16_t*)smem;
    bf16_t* vnT = StT + 16 * STS;
    const int tid = threadIdx.x, lane = tid & 63, w = tid >> 6, n16 = lane & 15, kq = lane >> 4;
    const int bh = item & 7, sl = item >> 3, b = bh >> 2, h = bh & 3;
    for (int i = tid; i < 16 * STS / 2; i += 256) ((unsigned*)StT)[i] = 0u;
    f32x4 S0 = (f32x4){0.f, 0.f, 0.f, 0.f}, S1 = (f32x4){0.f, 0.f, 0.f, 0.f};
    GdnFrag fa, fb;
    gdn_load_frag(fa, guT, gw, gqd, gkdT, gin, gl, bh * 128, w, sl, n16, kq);
    __syncthreads();
    float* obase = og + (size_t)(b * SEQ + 16 * w) * 512 + h * 128 + 16 * sl + n16;
#pragma unroll 1
    for (int n = 0; n < 128; n += 2) {
        gdn_load_frag(fb, guT, gw, gqd, gkdT, gin, gl, bh * 128 + n + 1, w, sl, n16, kq);
        gdn_step(fa, S0, S1, StT, vnT, obase + (size_t)(n * 64) * 512, w, n16, kq);
        if (n + 2 < 128) gdn_load_frag(fa, guT, gw, gqd, gkdT, gin, gl, bh * 128 + n + 2, w, sl, n16, kq);
        gdn_step(fb, S0, S1, StT, vnT, obase + (size_t)((n + 1) * 64) * 512, w, n16, kq);
    }
}

__device__ __forceinline__ void d_gdn_out(const float* __restrict__ og, const bf16_t* __restrict__ proj, const float* __restrict__ gain, bf16_t* __restrict__ mix, int t, int lane) {
    const float* o = og + (size_t)t * 512;
    const bf16_t* z = proj + (size_t)t * PLD + C_Z;
    float a[8], zz[8];
#pragma unroll
    for (int i = 0; i < 8; i++) { a[i] = o[lane + 64 * i]; zz[i] = bf2f(z[lane + 64 * i]); }
    const float g0 = gain[lane], g1 = gain[lane + 64];
#pragma unroll
    for (int h = 0; h < 4; h++) {
        const float ss = wave_sum_dpp(a[2 * h] * a[2 * h] + a[2 * h + 1] * a[2 * h + 1]);
        const float r = rsqrtf(ss * (1.f / 128.f) + 1e-6f);
        mix[(size_t)t * DM + 512 + h * 128 + lane] = f2bf(a[2 * h] * r * g0 * zz[2 * h] * sigmoidf_(zz[2 * h]));
        mix[(size_t)t * DM + 512 + h * 128 + lane + 64] = f2bf(a[2 * h + 1] * r * g1 * zz[2 * h + 1] * sigmoidf_(zz[2 * h + 1]));
    }
}

__device__ __forceinline__ void route_load_subkeys(const float* __restrict__ subkeys, char* smem) {
    for (int idx = threadIdx.x; idx < 2 * 128 * 16; idx += 256) {
        const int half = idx >> 11, key = (idx >> 4) & 127, ch = idx & 15;
        const float* src = subkeys + ((size_t)(half * 128 + key)) * 128 + ch * 8;
        const float4 x0 = *(const float4*)src, x1 = *(const float4*)(src + 4);
        *(uint4*)(smem + half * 32768 + key * 256 + ((ch ^ (key & 15)) << 4)) = make_uint4(pk2(x0.x, x0.y), pk2(x0.z, x0.w), pk2(x1.x, x1.y), pk2(x1.z, x1.w));
    }
}
#define CEX(i, j) { const float _a = v[i], _b = v[j]; v[i] = fmaxf(_a, _b); v[j] = fminf(_a, _b); }
__device__ __forceinline__ void d_peer_route2(const bf16_t* __restrict__ qry, int* __restrict__ eidx, float* __restrict__ pgate, int mtile, const char* smem, int lane) {
    const int n16 = lane & 15, kq = lane >> 4;
    const int tA = 2 * mtile + (n16 >> 3), hA = n16 & 7;
    float topv[2][4];
#pragma unroll
    for (int half = 0; half < 2; half++) {
        const bf16_t* qp = qry + (size_t)tA * 2048 + hA * 256 + half * 128 + 8 * kq;
        bf16x8 a[4];
#pragma unroll
        for (int ks = 0; ks < 4; ks++) a[ks] = *(const bf16x8*)(qp + 32 * ks);
        f32x4 acc[8];
#pragma unroll
        for (int nt = 0; nt < 8; nt++) acc[nt] = (f32x4){0.f, 0.f, 0.f, 0.f};
#pragma unroll
        for (int ks = 0; ks < 4; ks++)
#pragma unroll
            for (int nt = 0; nt < 8; nt++) {
                const bf16x8 bb = *(const bf16x8*)(smem + half * 32768 + (16 * nt + n16) * 256 + (((4 * ks + kq) ^ n16) << 4));
                acc[nt] = __builtin_amdgcn_mfma_f32_16x16x32_bf16(a[ks], bb, acc[nt], 0, 0, 0);
                if (nt == 3 || nt == 7) __builtin_amdgcn_sched_barrier(0);
            }
#pragma unroll
        for (int r = 0; r < 4; r++) {
            float v[8];
#pragma unroll
            for (int nt = 0; nt < 8; nt++) v[nt] = __uint_as_float((__float_as_uint(acc[nt][r]) & 0xFFFFFF80u) | (unsigned)(nt << 4) | (unsigned)n16);
            CEX(0, 1) CEX(2, 3) CEX(4, 5) CEX(6, 7) CEX(0, 2) CEX(1, 3) CEX(4, 6) CEX(5, 7) CEX(1, 2) CEX(5, 6)
            CEX(0, 4) CEX(1, 5) CEX(2, 6) CEX(3, 7) CEX(2, 4) CEX(3, 5) CEX(1, 2) CEX(3, 4) CEX(5, 6)
            float keep = 0.f;
#pragma unroll 1
            for (int it = 0; it < 16; it++) {
                const float mx = allmax16(v[0]);
                if (n16 == it) keep = mx;
                if (__float_as_uint(v[0]) == __float_as_uint(mx)) {
                    v[0] = v[1]; v[1] = v[2]; v[2] = v[3]; v[3] = v[4]; v[4] = v[5]; v[5] = v[6]; v[6] = v[7]; v[7] = -3e38f;
                }
            }
            topv[half][r] = keep;
            __builtin_amdgcn_sched_barrier(0);
        }
    }
#pragma unroll
    for (int r = 0; r < 4; r++) {
        const float v1p = topv[0][r], v2p = topv[1][r];
        const unsigned u1 = __float_as_uint(v1p);
        const int i1 = (int)(((u1 >> 4) & 7u) * 16u + (u1 & 15u));
        const int lim = 16 / (n16 + 1);
        int ptr = 0;
        const int lanebase = (lane & 48);
        float cur2 = __builtin_bit_cast(float, __builtin_amdgcn_ds_bpermute(lanebase * 4, __builtin_bit_cast(int, v2p)));
        float head = __uint_as_float((__float_as_uint(v1p + cur2) & 0xFFFFFFF0u) | (unsigned)n16);
        float ksc = 0.f; unsigned ke = 0u;
#pragma unroll 1
        for (int it = 0; it < 16; it++) {
            const float mx = allmax16(head);
            const bool win = __float_as_uint(head) == __float_as_uint(mx);
            const unsigned u2 = __float_as_uint(cur2);
            unsigned e = win ? (unsigned)(i1 * 128) + ((u2 >> 4) & 7u) * 16u + (u2 & 15u) : 0u;
            e = allmaxu16(e);
            if (n16 == it) { ksc = mx; ke = e; }
            if (win) ptr++;
            const int pn = ptr < 15 ? ptr : 15;
            const float nx = __builtin_bit_cast(float, __builtin_amdgcn_ds_bpermute((lanebase + pn) * 4, __builtin_bit_cast(int, v2p)));
            if (win) { cur2 = nx; head = (ptr < lim) ? __uint_as_float((__float_as_uint(v1p + cur2) & 0xFFFFFFF0u) | (unsigned)n16) : -3e38f; }
        }
        const float smax = allmax16(ksc);
        const float ex = __expf(ksc - smax);
        const float sum = allsum16(ex);
        const int row = 4 * kq + r;
        const size_t o = (size_t)(2 * mtile + (row >> 3)) * 128 + (row & 7) * 16 + n16;
        eidx[o] = (int)ke; pgate[o] = ex / sum;
    }
}
#undef CEX

#define XB_TMO      128
#define XB_XCNT(j)  (256  + 64 * (j))
#define XB_XSUB(j)  (1280 + 64 * (j))
#define XB_XGEN(j)  (2304 + 64 * (j))
#define XB_TOP      3328
#define XB_TOPGEN   3392
#define XB_QUEUE    3456
#define XL_CNT(j)    (4096 + 64 * (j))
#define XL_GEN(j)    (5120 + 64 * (j))
#define XCD_BAR_WORDS 6144
#define XB_SPIN_CAP (1u << 22)
#define LAS __attribute__((address_space(3)))
__device__ __forceinline__ unsigned xb_ld(unsigned* p)              { return __hip_atomic_load(p, __ATOMIC_RELAXED, __HIP_MEMORY_SCOPE_AGENT); }
__device__ __forceinline__ unsigned xb_add(unsigned* p, unsigned v) { return __hip_atomic_fetch_add(p, v, __ATOMIC_RELAXED, __HIP_MEMORY_SCOPE_AGENT); }
__device__ __forceinline__ unsigned xb_xcc_id() { return (unsigned)__builtin_amdgcn_s_getreg((3 << 11) | 20) & 0xFu; }
#define XB_SPIN(cond, bar) do { unsigned _sp = 0; while (cond) { __builtin_amdgcn_s_sleep(1); \
    if ((++_sp & 255u) == 0u) { if (xb_ld(&(bar)[XB_TMO])) break; if (_sp > XB_SPIN_CAP) { atomicAdd(&(bar)[XB_TMO], 1u); break; } } } } while (0)
struct XcdBarrier { unsigned* bar; unsigned x; volatile LAS unsigned* st; };
__device__ __forceinline__ XcdBarrier xcd_barrier_post(unsigned* bar, volatile LAS unsigned* st) {
    XcdBarrier b; b.bar = bar; b.x = xb_xcc_id(); b.st = st;
    if (threadIdx.x == 0) (void)xb_add(&bar[XB_XCNT(b.x)], 1u);
    return b;
}
__device__ __forceinline__ void xcd_barrier_complete(unsigned* bar, unsigned x, unsigned& nloc, unsigned& nx) {
    const unsigned G = gridDim.x * gridDim.y * gridDim.z;
    unsigned sum, cnt, mine, sp = 0u;
    for (;;) {
        sum = 0u; cnt = 0u; mine = 0u;
#pragma unroll
        for (unsigned j = 0; j < 16; ++j) { const unsigned c = xb_ld(&bar[XB_XCNT(j)]); sum += c; cnt += (c > 0u) ? 1u : 0u; mine = (j == x) ? c : mine; }
        if (sum == G) break;
        __builtin_amdgcn_s_sleep(1);
        if ((++sp & 255u) == 0u) { if (xb_ld(&bar[XB_TMO])) break; if (sp > XB_SPIN_CAP) { atomicAdd(&bar[XB_TMO], 1u); break; } }
    }
    nloc = mine > 0u ? mine : 1u; nx = cnt > 0u ? cnt : 1u;
}
__device__ __forceinline__ void xcd_barrier(const XcdBarrier& b) {
    asm volatile("s_waitcnt vmcnt(0)" ::: "memory");
    __syncthreads();
    if (threadIdx.x == 0) {
        unsigned* bar = b.bar;
        __builtin_amdgcn_s_waitcnt(0);
        unsigned nloc = b.st[0], nx = b.st[1];
        if (nloc == 0u) { xcd_barrier_complete(bar, b.x, nloc, nx); b.st[0] = nloc; b.st[1] = nx; }
        const unsigned old = xb_add(&bar[XB_XSUB(b.x)], 1u);
        const unsigned gen = old / nloc;
        if (old + 1u == (gen + 1u) * nloc) {
            __builtin_amdgcn_fence(__ATOMIC_RELEASE, "agent");
            asm volatile("s_waitcnt vmcnt(0)" ::: "memory");
            const unsigned og = xb_add(&bar[XB_TOP], 1u);
            const unsigned tg = og / nx;
            if (og + 1u == (tg + 1u) * nx) xb_add(&bar[XB_TOPGEN], 1u);
            else XB_SPIN(xb_ld(&bar[XB_TOPGEN]) == tg, bar);
            __builtin_amdgcn_fence(__ATOMIC_ACQUIRE, "agent");
            xb_add(&bar[XB_XGEN(b.x)], 1u);
            asm volatile("s_waitcnt vmcnt(0)" ::: "memory");
        } else {
            XB_SPIN(xb_ld(&bar[XB_XGEN(b.x)]) == gen, bar);
            __builtin_amdgcn_fence(__ATOMIC_ACQUIRE, "agent");
            asm volatile("s_waitcnt vmcnt(0)" ::: "memory");
        }
    }
    __syncthreads();
}

__device__ __forceinline__ void xcd_local_sync(const XcdBarrier& b, unsigned round) {
    __syncthreads();
    if (threadIdx.x == 0) {
        unsigned nloc = b.st[0]; if (nloc == 0u) nloc = 1u;
        const unsigned old = xb_add(&b.bar[XL_CNT(b.x)], 1u);
        if (old + 1u == nloc * (round + 1u)) xb_add(&b.bar[XL_GEN(b.x)], 1u);
        else { unsigned sp = 0; while (xb_ld(&b.bar[XL_GEN(b.x)]) <= round && ++sp < (1u << 16)) __builtin_amdgcn_s_sleep(1); }
    }
    __syncthreads();
}

__device__ __forceinline__ void d_quant_row(const float* __restrict__ src, unsigned char* __restrict__ dst, float* __restrict__ scale, int row, int lane, int bias) {
    const float4* p = (const float4*)(src + (size_t)row * DM) + lane * 4;
    float4 x[4];
    float am = 0.f;
#pragma unroll
    for (int i = 0; i < 4; i++) { x[i] = p[i]; am = fmaxf(am, fmaxf(fmaxf(fabsf(x[i].x), fabsf(x[i].y)), fmaxf(fabsf(x[i].z), fabsf(x[i].w)))); }
    am = wave_max(am);
    const float sc = (am > 0.f) ? am * (1.f / 127.f) : 1.f;
    const float inv = 1.f / sc;
    unsigned wv[4];
#pragma unroll
    for (int i = 0; i < 4; i++) {
        const int q0 = (int)rintf(x[i].x * inv) + bias, q1 = (int)rintf(x[i].y * inv) + bias, q2 = (int)rintf(x[i].z * inv) + bias, q3 = (int)rintf(x[i].w * inv) + bias;
        wv[i] = (unsigned)(q0 & 0xff) | ((unsigned)(q1 & 0xff) << 8) | ((unsigned)(q2 & 0xff) << 16) | ((unsigned)(q3 & 0xff) << 24);
    }
    ((uint4*)(dst + (size_t)row * DM))[lane] = make_uint4(wv[0], wv[1], wv[2], wv[3]);
    if (lane == 0) scale[row] = sc;
}

struct PeerGrp { u32x4 u[4]; u32x4 v[4]; float gv[4]; float su[4]; };
__device__ __forceinline__ void peer_load(PeerGrp& G, const unsigned char* __restrict__ uq, const unsigned char* __restrict__ vq,
                                          int esrc, float gsrc, float susrc, int k0, int lane) {
#pragma unroll
    for (int i = 0; i < 4; i++) {
        const int e = __builtin_amdgcn_readlane(esrc, (k0 + i) & 63);
        G.gv[i] = __builtin_bit_cast(float, __builtin_amdgcn_readlane(__builtin_bit_cast(int, gsrc), (k0 + i) & 63));
        G.su[i] = __builtin_bit_cast(float, __builtin_amdgcn_readlane(__builtin_bit_cast(int, susrc), (k0 + i) & 63));
        G.u[i] = ((const u32x4*)(uq + (size_t)e * DM))[lane];
        G.v[i] = ((const u32x4*)(vq + (size_t)e * DM))[lane];
    }
}
__device__ __forceinline__ void peer_compute(const PeerGrp& G, const int (&xq)[4], float sx, float (&acc)[16], float& bsum) {
    int d[4];
#pragma unroll
    for (int i = 0; i < 4; i++) {
        int sdot = 0;
        sdot = __builtin_amdgcn_sdot4((int)G.u[i][0], xq[0], sdot, false); sdot = __builtin_amdgcn_sdot4((int)G.u[i][1], xq[1], sdot, false);
        sdot = __builtin_amdgcn_sdot4((int)G.u[i][2], xq[2], sdot, false); sdot = __builtin_amdgcn_sdot4((int)G.u[i][3], xq[3], sdot, false);
        d[i] = sdot;
    }
#pragma unroll
    for (int i = 0; i < 4; i++) {
        int x = d[i];
        x += (int)dppu<0xB1>((unsigned)x); x += (int)dppu<0x4E>((unsigned)x); x += (int)dppu<0x141>((unsigned)x); x += (int)dppu<0x140>((unsigned)x);
        d[i] = __builtin_amdgcn_readlane(x, 0) + __builtin_amdgcn_readlane(x, 16) + __builtin_amdgcn_readlane(x, 32) + __builtin_amdgcn_readlane(x, 48);
    }
#pragma unroll
    for (int i = 0; i < 4; i++) {
        const float dot = (float)d[i] * (G.su[i] * sx);
        const float u2 = 1.5957691216057308f * (dot + 0.044715f * dot * dot * dot);
        const float cs = G.gv[i] * dot * __builtin_amdgcn_rcpf(1.f + __expf(-u2));
        bsum += cs;
        const f32x2 cs2 = (f32x2){cs, cs};
#pragma unroll
        for (int j = 0; j < 4; j++) {
            const unsigned wv = G.v[i][j];
            const f32x2 lo = (f32x2){(float)(wv & 0xffu), (float)((wv >> 8) & 0xffu)}, hi = (f32x2){(float)((wv >> 16) & 0xffu), (float)(wv >> 24)};
            f32x2 a0 = (f32x2){acc[4 * j], acc[4 * j + 1]}, a1 = (f32x2){acc[4 * j + 2], acc[4 * j + 3]};
            a0 = __builtin_elementwise_fma(cs2, lo, a0); a1 = __builtin_elementwise_fma(cs2, hi, a1);
            acc[4 * j] = a0[0]; acc[4 * j + 1] = a0[1]; acc[4 * j + 2] = a1[0]; acc[4 * j + 3] = a1[1];
        }
    }
}
__device__ __forceinline__ void d_peer_expert3(const bf16_t* __restrict__ h2, const int* __restrict__ eidx, const float* __restrict__ pgate,
                                               const unsigned char* __restrict__ uq, const unsigned char* __restrict__ vq,
                                               const float* __restrict__ su, const float* __restrict__ sv, const float* __restrict__ ssq, const float* __restrict__ fgain, float* __restrict__ out, int token, int lane, bool do_store = true, int emask = 0xffff, const XcdBarrier* xbar = nullptr, unsigned midround = 0) {
    const uint4 xa = ((const uint4*)(h2 + (size_t)token * DM))[2 * lane], xb = ((const uint4*)(h2 + (size_t)token * DM))[2 * lane + 1];
    const unsigned xw[8] = {xa.x, xa.y, xa.z, xa.w, xb.x, xb.y, xb.z, xb.w};
    float xf[16];
    float am = 0.f;
    const float rr = rsqrtf(allsum16(ssq[(size_t)token * 16 + (lane & 15)]) * (1.f / DM) + 1e-6f);
    const float4* gp = (const float4*)(fgain + lane * 16);
    const float4 ga = gp[0], gb = gp[1], gc = gp[2], gd = gp[3];
    const float gg[16] = {ga.x, ga.y, ga.z, ga.w, gb.x, gb.y, gb.z, gb.w, gc.x, gc.y, gc.z, gc.w, gd.x, gd.y, gd.z, gd.w};
#pragma unroll
    for (int j = 0; j < 8; j++) {
        xf[2 * j] = __uint_as_float(xw[j] << 16) * rr * gg[2 * j]; xf[2 * j + 1] = __uint_as_float(xw[j] & 0xffff0000u) * rr * gg[2 * j + 1];
        am = fmaxf(am, fmaxf(fabsf(xf[2 * j]), fabsf(xf[2 * j + 1])));
    }
    am = wave_max(am);
    const float sx = (am > 0.f) ? am * (1.f / 127.f) : 1.f;
    const float isx = 1.f / sx;
    int xq[4];
#pragma unroll
    for (int j = 0; j < 4; j++) {
        const int q0 = (int)rintf(xf[4 * j] * isx), q1 = (int)rintf(xf[4 * j + 1] * isx), q2 = (int)rintf(xf[4 * j + 2] * isx), q3 = (int)rintf(xf[4 * j + 3] * isx);
        xq[j] = (int)((unsigned)(q0 & 0xff) | ((unsigned)(q1 & 0xff) << 8) | ((unsigned)(q2 & 0xff) << 16) | ((unsigned)(q3 & 0xff) << 24));
    }
    float acc[16];
#pragma unroll
    for (int i = 0; i < 16; i++) acc[i] = 0.f;
    float bsum = 0.f;
    int e_lo = eidx[(size_t)token * 128 + lane] & emask, e_hi = eidx[(size_t)token * 128 + 64 + lane] & emask;
    float g_lo = pgate[(size_t)token * 128 + lane], g_hi = pgate[(size_t)token * 128 + 64 + lane];
    {
        unsigned long long ka = ((unsigned long long)(unsigned)e_lo << 32) | __float_as_uint(g_lo), kb = ((unsigned long long)(unsigned)e_hi << 32) | __float_as_uint(g_hi);
#pragma unroll
        for (int k = 2; k <= 128; k <<= 1) {
#pragma unroll
            for (int j = k >> 1; j > 0; j >>= 1) {
                if (j == 64) { const unsigned long long mn = ka < kb ? ka : kb, mx = ka < kb ? kb : ka; ka = mn; kb = mx; }
                else {
                    const unsigned long long pa = ((unsigned long long)(unsigned)__shfl_xor((int)(ka >> 32), j) << 32) | (unsigned)__shfl_xor((int)ka, j);
                    const unsigned long long pb = ((unsigned long long)(unsigned)__shfl_xor((int)(kb >> 32), j) << 32) | (unsigned)__shfl_xor((int)kb, j);
                    const bool lower = (lane & j) == 0;
                    const bool dirA = (lane & k) == 0, dirB = ((lane + 64) & k) == 0;
                    ka = ((lower == dirA) == (ka < pa)) ? ka : pa;
                    kb = ((lower == dirB) == (kb < pb)) ? kb : pb;
                }
            }
        }
        e_lo = (int)(ka >> 32); g_lo = __uint_as_float((unsigned)ka); e_hi = (int)(kb >> 32); g_hi = __uint_as_float((unsigned)kb);
    }
    g_lo *= sv[e_lo]; g_hi *= sv[e_hi];
    const float s_lo = su[e_lo], s_hi = su[e_hi];
    PeerGrp A, B;
    peer_load(A, uq, vq, e_lo, g_lo, s_lo, 0, lane);
#pragma unroll 1
    for (int k0 = 0; k0 < 64; k0 += 8) {
        peer_load(B, uq, vq, e_lo, g_lo, s_lo, k0 + 4, lane);
        peer_compute(A, xq, sx, acc, bsum);
        if (k0 + 8 < 64) peer_load(A, uq, vq, e_lo, g_lo, s_lo, k0 + 8, lane); else peer_load(A, uq, vq, e_hi, g_hi, s_hi, 0, lane);
        peer_compute(B, xq, sx, acc, bsum);
    }
    if (xbar) xcd_local_sync(*xbar, midround);
#pragma unroll 1
    for (int k0 = 0; k0 < 64; k0 += 8) {
        peer_load(B, uq, vq, e_hi, g_hi, s_hi, k0 + 4, lane);
        peer_compute(A, xq, sx, acc, bsum);
        if (k0 + 8 < 64) peer_load(A, uq, vq, e_hi, g_hi, s_hi, k0 + 8, lane);
        peer_compute(B, xq, sx, acc, bsum);
    }
    const float bs = 128.f * bsum;
    float4* o = (float4*)(out + (size_t)token * DM + lane * 16);
#pragma unroll
    for (int j = 0; j < 4; j++) {
        float4 t = o[j];
        t.x += acc[4 * j] - bs; t.y += acc[4 * j + 1] - bs; t.z += acc[4 * j + 2] - bs; t.w += acc[4 * j + 3] - bs;
        if (do_store) o[j] = t; else asm volatile("" :: "v"(t.x), "v"(t.y), "v"(t.z), "v"(t.w));
    }
}

struct MKP {
    const float *x, *attn_norm, *w_in, *q_gain, *k_gain, *cmp_pos, *cmp_w1, *cmp_w2, *gdn_conv, *a_log, *dt_bias, *out_gain, *w_out, *ffn_norm, *w_query, *subkeys, *peer_u, *peer_v;
    float* out; char* ws; unsigned* bar;
};

#define SMEM_BYTES 70144

__global__ __launch_bounds__(256, 2) void hybrid_megakernel(MKP P) {
    extern __shared__ __attribute__((aligned(16))) char smem[];
    __shared__ uint4 xb_words;
    __shared__ int q_item;
    const int G = gridDim.x, bid0 = blockIdx.x;
    if (threadIdx.x == 0) xb_words = make_uint4(0u, 0u, 0u, 0u);
    __syncthreads();
    XcdBarrier B = xcd_barrier_post(P.bar, (volatile LAS unsigned*)&xb_words);
    char* ws = P.ws;
    bf16_t* w_in_t = (bf16_t*)(ws + OFF_WINT);
    bf16_t* w_out_t = (bf16_t*)(ws + OFF_WOUTT);
    bf16_t* w_q_t = (bf16_t*)(ws + OFF_WQT);
    bf16_t* cw1_t = (bf16_t*)(ws + OFF_CW1T);
    float* cbias = (float*)(ws + OFF_CBIAS);
    bf16_t* h_bf = (bf16_t*)(ws + OFF_HBF);
    bf16_t* proj = (bf16_t*)(ws + OFF_PROJ);
    bf16_t* ksn = (bf16_t*)(ws + OFF_KSN);
    bf16_t* kwn = (bf16_t*)(ws + OFF_KWN);
    bf16_t* kc = (bf16_t*)(ws + OFF_KC);
    bf16_t* vc = (bf16_t*)(ws + OFF_VC);
    bf16_t* hid = (bf16_t*)(ws + OFF_HID);
    bf16_t* gu = (bf16_t*)(ws + OFF_GU);
    bf16_t* gw = (bf16_t*)(ws + OFF_GW);
    bf16_t* gqd = (bf16_t*)(ws + OFF_GQD);
    bf16_t* gkd = (bf16_t*)(ws + OFF_GKD);
    bf16_t* gin = (bf16_t*)(ws + OFF_GIN);
    float* gl = (float*)(ws + OFF_GL);
    bf16_t* mix = (bf16_t*)(ws + OFF_MIX);
    bf16_t* qry = (bf16_t*)(ws + OFF_QRY);
    bf16_t* h2 = (bf16_t*)(ws + OFF_H2);
    int* eidx = (int*)(ws + OFF_EIDX);
    float* pgate = (float*)(ws + OFF_PGATE);
    unsigned char* uq = (unsigned char*)(ws + OFF_UQ);
    unsigned char* vq = (unsigned char*)(ws + OFF_VQ);
    float* su = (float*)(ws + OFF_SU);
    float* sv = (float*)(ws + OFF_SV);
    float* og = P.out;
    float2* rope = (float2*)(ws + OFF_ROPE);
    float* ssq = (float*)(ws + OFF_SSQ);
    bf16_t* vsn = (bf16_t*)(ws + OFF_VSN);
    bf16_t* vwn = (bf16_t*)(ws + OFF_VWN);
    bf16_t* cw2t = (bf16_t*)(ws + OFF_CW2T);
    unsigned char* uq_tmp = (unsigned char*)(P.out + 8388608);
    unsigned char* vq_tmp = uq_tmp + 16384ull * 1024;

    {
        const int n1 = 108 * 8, n2 = n1 + 32 * 8, n3 = n2 + 64 * 8, n4 = n3 + 2 * 8 * 16, n5 = n4 + 2 * 2 * 2;
        for (int it = bid0; it < n5; it += G) {
            if (it < n1) d_transpose_bf16(P.w_in, 1024, IN_COLS, w_in_t, it % 108, it / 108, smem);
            else if (it < n2) { int r = it - n1; d_transpose_bf16(P.w_out, 1024, 1024, w_out_t, r % 32, r / 32, smem); }
            else if (it < n3) { int r = it - n2; d_transpose_bf16(P.w_query, 1024, 2048, w_q_t, r % 64, r / 64, smem, P.ffn_norm); }
            else if (it < n4) { int r = it - n3; int j = r >> 7; r &= 127; d_transpose_bf16(P.cmp_w1 + (size_t)j * 2048 * 256, 2048, 256, cw1_t + (size_t)j * 256 * 2048, r % 8, r / 8, smem); }
            else { int r = it - n4; int j = r >> 2; r &= 3; d_transpose_bf16(P.cmp_w2 + (size_t)j * 256 * 64, 256, 64, cw2t + (size_t)j * 64 * 256, r % 2, r / 2, smem); }
        }
        for (int it = bid0; it < 16; it += G) d_cmp_bias(P.cmp_pos, P.cmp_w1, cbias, it, smem);
        for (int it = bid0; it < T_TOK / 4; it += G) d_rmsnorm_bf16(P.x, P.attn_norm, h_bf, it);
        for (int i = bid0 * 256 + threadIdx.x; i < 8192 * 32; i += G * 256) {
            const int pos = i >> 5, fi = i & 31;
            float sn, cs; sincosf((float)pos * expf(-9.210340371976184f * (float)(2 * fi) / 64.f), &sn, &cs);
            rope[i] = make_float2(cs, sn);
        }
        for (int i = bid0 * 256 + threadIdx.x; i < 32 * PLD / 2; i += G * 256) ((unsigned*)(proj + (size_t)T_TOK * PLD))[i] = 0u;
    }
    xcd_barrier(B);
    {
        GemmP p{}; p.A = h_bf; p.lda = 1024; p.akts = 64; p.Bt = w_in_t; p.ldb = 1024; p.K = 1024; p.mtiles = 128; p.ntiles = 27; p.out = proj;
        for (int it = bid0; it < 128 * 27; it += G) d_gemm<EPI_PROJ>(p, it, smem);
    }
    xcd_barrier(B);
    {
        for (int it = bid0; it < 64; it += G) {
            int inst = it >> 3, tile = it & 7;
            int j = inst >> 2, b = (inst >> 1) & 1, g = inst & 1;
            GemmP p{}; p.A = proj + (size_t)(b * SEQ) * PLD + C_KV + 128 * j + 64 * g; p.lda = 16 * PLD; p.akts = PLD;
            p.Bt = cw1_t + (size_t)j * 256 * 2048; p.ldb = 2048; p.K = 2048; p.mtiles = 4; p.ntiles = 2;
            p.out = hid + (size_t)inst * 512 * 256; p.aux = cbias + j * 256;
            d_gemm<EPI_HID>(p, tile, smem);
        }
        for (;;) {
            if (threadIdx.x == 0) q_item = (int)xb_add(&P.bar[XB_QUEUE + 64], 1u);
            __syncthreads();
            const int it = q_item;
            __syncthreads();
            if (it >= 1024) break;
            d_gdn_prep2(proj, P.gdn_conv, P.a_log, P.dt_bias, gu, gw, gqd, gkd, gin, gl, it, smem); __syncthreads();
        }
        for (;;) {
            if (threadIdx.x == 0) q_item = (int)xb_add(&P.bar[XB_QUEUE + 128], 1u);
            __syncthreads();
            const int it = q_item;
            __syncthreads();
            if (it >= 1024) break;
            for (int k8 = 0; k8 < 8; k8++) d_knorm_rope(proj, P.k_gain, ksn, kwn, vsn, vwn, rope, it * 8 + k8);
        }
    }
    xcd_barrier(B);
    for (int wi = bid0 * 4 + (threadIdx.x >> 6); wi < 256; wi += G * 4) d_cmp2_mfma(hid, cw2t, P.k_gain, rope, kc, vc, wi, threadIdx.x & 63);
    xcd_barrier(B);
    {
        if (bid0 < 64) d_gdn_scan2(gu, gw, gqd, gkd, gin, gl, og, bid0, smem);
        __syncthreads();
        const int rep = 0;
        for (;;) {
            if (threadIdx.x == 0) q_item = (int)xb_add(&P.bar[XB_QUEUE + 256 * rep], 1u);
            __syncthreads();
            const int it = q_item;
            if (it >= 1024 + 128) break;
            if (it >= 1024) {
                const int r0 = (it - 1024) * 128 + (threadIdx.x >> 6) * 32;
                for (int r = r0; r < r0 + 32; r++) { d_quant_row(P.peer_u, uq_tmp, su, r, threadIdx.x & 63, 0); d_quant_row(P.peer_v, vq_tmp, sv, r, threadIdx.x & 63, 128); }
            } else {
                d_nsa_mfma(proj, P.q_gain, rope, ksn, kwn, kc, vc, vsn, vwn, mix, DM, it, smem);
            }
            __syncthreads();
        }
    }
    xcd_barrier(B);
    for (int t = bid0 * 4 + (threadIdx.x >> 6); t < T_TOK; t += G * 4) d_gdn_out(og, proj, P.out_gain, mix, t, threadIdx.x & 63);
    for (int i = bid0 * 256 + threadIdx.x; i < 2 * 16384 * 1024 / 16; i += G * 256) ((uint4*)uq)[i] = ((const uint4*)uq_tmp)[i];
    xcd_barrier(B);
    {
        GemmP p{}; p.A = mix; p.lda = 1024; p.akts = 64; p.Bt = w_out_t; p.ldb = 1024; p.K = 1024; p.mtiles = 128; p.ntiles = 8; p.out = P.out; p.aux = P.x; p.out2 = h2; p.ssq = ssq;
        for (int it = bid0; it < 128 * 8; it += G) d_gemm<EPI_OUT>(p, it, smem);
    }
    xcd_barrier(B);
    {
        GemmP p{}; p.A = h2; p.lda = 1024; p.akts = 64; p.Bt = w_q_t; p.ldb = 1024; p.K = 1024; p.mtiles = 128; p.ntiles = 16; p.out = qry; p.ssq = ssq;
        for (int it = bid0; it < 128 * 16; it += G) d_gemm<EPI_QRY>(p, it, smem);
    }
    xcd_barrier(B);
    route_load_subkeys(P.subkeys, smem);
    __syncthreads();
    for (int mt = bid0 * 4 + (threadIdx.x >> 6); mt < T_TOK / 2; mt += G * 4) d_peer_route2(qry, eidx, pgate, mt, smem, threadIdx.x & 63);
    xcd_barrier(B);
    {
        const int rounds = (T_TOK / 4 + G - 1) / G;
        for (int rd = 0; rd < rounds; rd++) {
            xcd_local_sync(B, (unsigned)(2 * rd));
            const int it = rd * G + bid0;
            if (it < T_TOK / 4) d_peer_expert3(h2, eidx, pgate, uq, vq, su, sv, ssq, P.ffn_norm, P.out, it * 4 + (threadIdx.x >> 6), threadIdx.x & 63, true, 0xffff, &B, (unsigned)(2 * rd + 1));
            else xcd_local_sync(B, (unsigned)(2 * rd + 1));
        }
    }
}

extern "C" void kernel_launch(void* const* d_in, const int* in_sizes, int n_in, void* d_out, int out_size, void* d_ws, size_t ws_size,
                              hipStream_t stream) {
    const size_t bar_off = (OFF_END + 255) & ~(size_t)255;
    if (ws_size < bar_off + XCD_BAR_WORDS * 4) return;
    static int grid_blocks = 0;
    if (!grid_blocks) {
        int dev = 0, cus = 0, per_cu = 0;
        (void)hipGetDevice(&dev);
        (void)hipDeviceGetAttribute(&cus, hipDeviceAttributeMultiprocessorCount, dev);
        (void)hipFuncSetAttribute((const void*)hybrid_megakernel, hipFuncAttributeMaxDynamicSharedMemorySize, SMEM_BYTES);
        (void)hipOccupancyMaxActiveBlocksPerMultiprocessor(&per_cu, hybrid_megakernel, 256, SMEM_BYTES);
        if (per_cu > 2) per_cu = 2;
        grid_blocks = cus * per_cu;
    }
    if (grid_blocks <= 0) return;
    MKP P{};
    P.x = (const float*)d_in[0]; P.attn_norm = (const float*)d_in[1]; P.w_in = (const float*)d_in[2]; P.q_gain = (const float*)d_in[3];
    P.k_gain = (const float*)d_in[4]; P.cmp_pos = (const float*)d_in[5]; P.cmp_w1 = (const float*)d_in[6]; P.cmp_w2 = (const float*)d_in[7];
    P.gdn_conv = (const float*)d_in[8]; P.a_log = (const float*)d_in[9]; P.dt_bias = (const float*)d_in[10]; P.out_gain = (const float*)d_in[11];
    P.w_out = (const float*)d_in[12]; P.ffn_norm = (const float*)d_in[13]; P.w_query = (const float*)d_in[14]; P.subkeys = (const float*)d_in[15];
    P.peer_u = (const float*)d_in[16]; P.peer_v = (const float*)d_in[17];
    P.out = (float*)d_out; P.ws = (char*)d_ws; P.bar = (unsigned*)((char*)d_ws + bar_off);
    (void)hipMemsetAsync(P.bar, 0, XCD_BAR_WORDS * 4, stream);
    hipLaunchKernelGGL(hybrid_megakernel, dim3(grid_blocks), dim3(256), SMEM_BYTES, stream, P);
}
```

```cpp
#include <hip/hip_runtime.h>
#include <stdint.h>

typedef unsigned short bf16_t;
typedef __attribute__((ext_vector_type(8))) short bf16x8;
typedef __attribute__((ext_vector_type(4))) float f32x4;
typedef __attribute__((ext_vector_type(2))) float f32x2;
#define LAS3 __attribute__((address_space(3)))

#define T_TOK 16384
#define SEQ 8192
#define DM 1024
#define IN_COLS 3360
#define PLD 3456
#define C_Q 0
#define C_KV 512
#define C_GATE 1280
#define C_GQKV 1304
#define C_Z 2840
#define C_A 3352
#define C_B 3356

#define OFF_WINT   0ull
#define OFF_WOUTT  (OFF_WINT  + 3456ull*1024*2)
#define OFF_WQT    (OFF_WOUTT + 1024ull*1024*2)
#define OFF_CW1T   (OFF_WQT   + 2048ull*1024*2)
#define OFF_CBIAS  (OFF_CW1T  + 2ull*256*2048*2)
#define OFF_HBF    (OFF_CBIAS + 4096ull)
#define OFF_PROJ   (OFF_HBF   + 16384ull*1024*2)
#define OFF_KSN    (OFF_PROJ  + (16384ull+32)*PLD*2)
#define OFF_KWN    (OFF_KSN   + 4ull*8192*64*2)
#define OFF_KC     (OFF_KWN   + 4ull*8192*64*2)
#define OFF_VC     (OFF_KC    + 4ull*512*64*2)
#define OFF_HID    (OFF_VC    + 4ull*512*64*2)
#define OFF_GU     (OFF_HID   + 8ull*512*256*2)
#define OFF_GW     (OFF_GU    + 1024ull*64*128*2)
#define OFF_GQD    (OFF_GW    + 1024ull*64*128*2)
#define OFF_GKD    (OFF_GQD   + 1024ull*64*128*2)
#define OFF_GIN    (OFF_GKD   + 1024ull*64*128*2)
#define OFF_GL     (OFF_GIN   + 1024ull*64*64*2)
#define OFF_ROPE   (OFF_GL    + 4096ull)
#define OFF_CW2T   (OFF_ROPE  + 8192ull*32*8)
#define OFF_SU     (OFF_CW2T  + 2ull*64*256*2)
#define OFF_SV     (OFF_SU    + 65536ull)
#define OFF_SSQ    (OFF_SV    + 65536ull)
#define OFF_VSN    (OFF_SSQ   + 16384ull*16*4)
#define OFF_VWN    (OFF_VSN   + 4ull*8192*64*2)
#define OFF_END    (OFF_VWN   + 4ull*8192*64*2)
#define OFF_MIX    OFF_HBF
#define OFF_QRY    OFF_PROJ
#define OFF_H2     (OFF_PROJ + 16384ull*2048*2)
#define OFF_EIDX   OFF_KSN
#define OFF_PGATE  OFF_GIN
#define OFF_UQ     OFF_GU
#define OFF_VQ     (OFF_GU + 16384ull*1024)

__device__ __forceinline__ bf16_t f2bf(float f) {
    unsigned u = __float_as_uint(f);
    u += 0x7fffu + ((u >> 16) & 1u);
    return (bf16_t)(u >> 16);
}
__device__ __forceinline__ float bf2f(bf16_t h) { return __uint_as_float(((unsigned)h) << 16); }
typedef __bf16 bf16x2_t2 __attribute__((ext_vector_type(2)));
__device__ __forceinline__ unsigned pk2(float a, float b) { bf16x2_t2 v; v[0] = (__bf16)a; v[1] = (__bf16)b; return __builtin_bit_cast(unsigned, v); }
__device__ __forceinline__ float gelu_tanh(float x) {
    float u = 0.7978845608028654f * (x + 0.044715f * x * x * x);
    return 0.5f * x * (1.f + tanhf(u));
}
__device__ __forceinline__ float sigmoidf_(float x) { return 1.f / (1.f + __expf(-x)); }
__device__ __forceinline__ float wave_sum(float v) {
#pragma unroll
    for (int o = 32; o > 0; o >>= 1) v += __shfl_xor(v, o);
    return v;
}
__device__ __forceinline__ float wave_max(float v) {
#pragma unroll
    for (int o = 32; o > 0; o >>= 1) v = fmaxf(v, __shfl_xor(v, o));
    return v;
}

template <int CTRL> __device__ __forceinline__ float dppf(float x) { return __builtin_bit_cast(float, __builtin_amdgcn_update_dpp(0, __builtin_bit_cast(int, x), CTRL, 0xf, 0xf, true)); }
template <int CTRL> __device__ __forceinline__ unsigned dppu(unsigned x) { return (unsigned)__builtin_amdgcn_update_dpp(0, (int)x, CTRL, 0xf, 0xf, true); }
__device__ __forceinline__ float allmax16(float x) {
    x = fmaxf(x, dppf<0xB1>(x)); x = fmaxf(x, dppf<0x4E>(x)); x = fmaxf(x, dppf<0x141>(x)); x = fmaxf(x, dppf<0x140>(x)); return x;
}
__device__ __forceinline__ unsigned allmaxu16(unsigned x) {
    x = max(x, dppu<0xB1>(x)); x = max(x, dppu<0x4E>(x)); x = max(x, dppu<0x141>(x)); x = max(x, dppu<0x140>(x)); return x;
}
__device__ __forceinline__ float allsum16(float x) {
    x += dppf<0xB1>(x); x += dppf<0x4E>(x); x += dppf<0x141>(x); x += dppf<0x140>(x); return x;
}
__device__ __forceinline__ float wave_sum_dpp(float x) {
    x = allsum16(x);
    return __builtin_bit_cast(float, __builtin_amdgcn_readlane(__builtin_bit_cast(int, x), 0)) + __builtin_bit_cast(float, __builtin_amdgcn_readlane(__builtin_bit_cast(int, x), 16)) +
           __builtin_bit_cast(float, __builtin_amdgcn_readlane(__builtin_bit_cast(int, x), 32)) + __builtin_bit_cast(float, __builtin_amdgcn_readlane(__builtin_bit_cast(int, x), 48));
}
__device__ __forceinline__ void d_transpose_bf16(const float* __restrict__ W, int K, int N, bf16_t* __restrict__ Wt, int bx, int by, char* smem, const float* __restrict__ kscale = nullptr) {
    float* tile = (float*)smem;
    const int n0 = bx * 32, k0 = by * 128;
    const int tx = threadIdx.x & 31, ty = threadIdx.x >> 5;
    const int n = n0 + tx;
    float v[16];
#pragma unroll
    for (int i = 0; i < 16; i++) { const int k = k0 + ty + 8 * i; v[i] = (n < N) ? W[(size_t)k * N + n] : 0.f; }
#pragma unroll
    for (int i = 0; i < 16; i++) { const int kk = ty + 8 * i; tile[kk * 33 + tx] = v[i] * (kscale ? kscale[k0 + kk] : 1.f); }
    __syncthreads();
    {
        const int nn = threadIdx.x >> 3, kc = (threadIdx.x & 7) * 16;
        unsigned pk[8];
#pragma unroll
        for (int j = 0; j < 8; j++) pk[j] = pk2(tile[(kc + 2 * j) * 33 + nn], tile[(kc + 2 * j + 1) * 33 + nn]);
        uint4* dst = (uint4*)(Wt + (size_t)(n0 + nn) * K + k0 + kc);
        dst[0] = make_uint4(pk[0], pk[1], pk[2], pk[3]); dst[1] = make_uint4(pk[4], pk[5], pk[6], pk[7]);
    }
    __syncthreads();
}

__device__ __forceinline__ void d_rmsnorm_bf16(const float* __restrict__ x, const float* __restrict__ g, bf16_t* __restrict__ out, int bid) {
    int row = bid * 4 + (threadIdx.x >> 6);
    int lane = threadIdx.x & 63;
    const float4* xr = (const float4*)(x + (size_t)row * DM);
    float4 v[4];
    float ss = 0.f;
#pragma unroll
    for (int i = 0; i < 4; i++) { v[i] = xr[lane + 64 * i]; ss += v[i].x * v[i].x + v[i].y * v[i].y + v[i].z * v[i].z + v[i].w * v[i].w; }
    ss = wave_sum(ss);
    float r = rsqrtf(ss * (1.f / DM) + 1e-6f);
#pragma unroll
    for (int i = 0; i < 4; i++) {
        float4 gg = ((const float4*)g)[lane + 64 * i];
        ushort4 o;
        o.x = f2bf(v[i].x * r * gg.x); o.y = f2bf(v[i].y * r * gg.y); o.z = f2bf(v[i].z * r * gg.z); o.w = f2bf(v[i].w * r * gg.w);
        ((ushort4*)(out + (size_t)row * DM))[lane + 64 * i] = o;
    }
}

__device__ __forceinline__ void d_cmp_bias(const float* __restrict__ pos, const float* __restrict__ w1, float* __restrict__ bias, int item, char* smem) {
    float* part = (float*)smem;
    const int j = item >> 3, c = (item & 7) * 32 + (threadIdx.x & 31), ksl = threadIdx.x >> 5;
    float s0 = 0.f, s1 = 0.f, s2 = 0.f, s3 = 0.f;
    const float* wp = w1 + ((size_t)j * 2048 + ksl * 256) * 256 + c;
    const float* pp = pos + j * 2048 + ksl * 256;
    for (int k = 0; k < 256; k += 4) {
        s0 += pp[k] * wp[(size_t)k * 256]; s1 += pp[k + 1] * wp[(size_t)(k + 1) * 256];
        s2 += pp[k + 2] * wp[(size_t)(k + 2) * 256]; s3 += pp[k + 3] * wp[(size_t)(k + 3) * 256];
    }
    part[ksl * 32 + (threadIdx.x & 31)] = (s0 + s1) + (s2 + s3);
    __syncthreads();
    if (threadIdx.x < 32) {
        float t = 0.f;
#pragma unroll
        for (int i = 0; i < 8; i++) t += part[i * 32 + threadIdx.x];
        bias[j * 256 + c] = t;
    }
    __syncthreads();
}

#define EPI_PROJ 0
#define EPI_HID 1
#define EPI_OUT 2
#define EPI_QRY 3
struct GemmP {
    const bf16_t* A; long lda; long akts;
    const bf16_t* Bt; long ldb;
    int K; int mtiles; int ntiles;
    long a_inst; long b_inst;
    void* out; const float* aux; const float* aux2; bf16_t* out2; float* ssq;
};

template <int EPI>
__device__ __forceinline__ void d_gemm(const GemmP& p, int bid, char* smem) {
    const int tid = threadIdx.x, lane = tid & 63, wave = tid >> 6;
    const int wm = wave >> 1, wn = wave & 1;
    const int inst = 0;
    const int nwg = p.mtiles * p.ntiles, wgid = (bid & 7) * (nwg >> 3) + (bid >> 3);
    const int mt = wgid / p.ntiles, nt = wgid % p.ntiles;
    const int m0 = mt * 128, n0 = nt * 128;
    const bf16_t* A = p.A + (size_t)inst * p.a_inst + (size_t)m0 * p.lda;
    const bf16_t* Bt = p.Bt + (size_t)inst * p.b_inst + (size_t)n0 * p.ldb;
    f32x4 acc[4][4];
#pragma unroll
    for (int i = 0; i < 4; i++)
#pragma unroll
        for (int j = 0; j < 4; j++) acc[i][j] = (f32x4){0.f, 0.f, 0.f, 0.f};
    const int nk = p.K >> 6;
    const int crow = tid >> 3, cslot = tid & 7;
    const int csrc = (cslot ^ (crow & 7)) * 8;
    const bf16_t* Ap = A + (size_t)crow * p.lda + csrc;
    const bf16_t* Bp = Bt + (size_t)crow * p.ldb + csrc;
    const size_t a32 = (size_t)32 * p.lda, b32 = (size_t)32 * p.ldb;
    char* ldsw = smem + tid * 16;
#define GSTAGE(buf, koffA, koffB) { char* _d = ldsw + (buf) * 32768; \
    __builtin_amdgcn_global_load_lds((const unsigned*)(Ap + (koffA)), (LAS3 unsigned*)(_d), 16, 0, 0); \
    __builtin_amdgcn_global_load_lds((const unsigned*)(Ap + a32 + (koffA)), (LAS3 unsigned*)(_d + 4096), 16, 0, 0); \
    __builtin_amdgcn_global_load_lds((const unsigned*)(Ap + 2 * a32 + (koffA)), (LAS3 unsigned*)(_d + 8192), 16, 0, 0); \
    __builtin_amdgcn_global_load_lds((const unsigned*)(Ap + 3 * a32 + (koffA)), (LAS3 unsigned*)(_d + 12288), 16, 0, 0); \
    __builtin_amdgcn_global_load_lds((const unsigned*)(Bp + (koffB)), (LAS3 unsigned*)(_d + 16384), 16, 0, 0); \
    __builtin_amdgcn_global_load_lds((const unsigned*)(Bp + b32 + (koffB)), (LAS3 unsigned*)(_d + 16384 + 4096), 16, 0, 0); \
    __builtin_amdgcn_global_load_lds((const unsigned*)(Bp + 2 * b32 + (koffB)), (LAS3 unsigned*)(_d + 16384 + 8192), 16, 0, 0); \
    __builtin_amdgcn_global_load_lds((const unsigned*)(Bp + 3 * b32 + (koffB)), (LAS3 unsigned*)(_d + 16384 + 12288), 16, 0, 0); }
    const int n16 = lane & 15, kq = lane >> 4;
    GSTAGE(0, 0, 0)
    for (int kt = 0; kt < nk; kt++) {
        if (kt + 1 < nk) {
            GSTAGE((kt + 1) & 1, (size_t)(kt + 1) * p.akts, (size_t)(kt + 1) * 64)
            asm volatile("s_waitcnt vmcnt(8)" ::: "memory");
        } else {
            asm volatile("s_waitcnt vmcnt(0)" ::: "memory");
        }
        __builtin_amdgcn_s_barrier();
        const char* Ab = smem + (kt & 1) * 32768;
        const char* Bb = Ab + 16384;
#pragma unroll
        for (int ks = 0; ks < 2; ks++) {
            bf16x8 af[4], bfr[4];
#pragma unroll
            for (int i = 0; i < 4; i++) { const int R = wm * 64 + i * 16 + n16; af[i] = *(const bf16x8*)(Ab + R * 128 + (((4 * ks + kq) ^ (R & 7)) << 4)); }
#pragma unroll
            for (int j = 0; j < 4; j++) { const int R = wn * 64 + j * 16 + n16; bfr[j] = *(const bf16x8*)(Bb + R * 128 + (((4 * ks + kq) ^ (R & 7)) << 4)); }
#pragma unroll
            for (int i = 0; i < 4; i++)
#pragma unroll
                for (int j = 0; j < 4; j++) acc[i][j] = __builtin_amdgcn_mfma_f32_16x16x32_bf16(bfr[j], af[i], acc[i][j], 0, 0, 0);
        }
        asm volatile("s_waitcnt lgkmcnt(0)" ::: "memory");
        __builtin_amdgcn_s_barrier();
    }
    {
        char* slab = smem + wave * 9216;
        const int rbase = m0 + wm * 64, cbase = n0 + wn * 64;
        if (EPI == EPI_OUT) {
            float* st = (float*)slab;
#pragma unroll
            for (int hlf = 0; hlf < 2; hlf++) {
#pragma unroll
                for (int ii = 0; ii < 2; ii++)
#pragma unroll
                    for (int j = 0; j < 4; j++) *(f32x4*)(st + (ii * 16 + n16) * 68 + j * 16 + 4 * kq) = acc[hlf * 2 + ii][j];
#pragma unroll
                for (int ps = 0; ps < 8; ps++) {
                    const int rl = ps * 4 + kq, row = rbase + hlf * 32 + rl;
                    const float4 a = *(const float4*)(st + rl * 68 + n16 * 4);
                    const float4 xx = *(const float4*)(p.aux + (size_t)row * DM + cbase + n16 * 4);
                    const float4 o = make_float4(xx.x + a.x, xx.y + a.y, xx.z + a.z, xx.w + a.w);
                    *(float4*)((float*)p.out + (size_t)row * DM + cbase + n16 * 4) = o;
                    *(uint2*)(p.out2 + (size_t)row * DM + cbase + n16 * 4) = make_uint2(pk2(o.x, o.y), pk2(o.z, o.w));
                    const float ss = allsum16(o.x * o.x + o.y * o.y + o.z * o.z + o.w * o.w);
                    if (n16 == 0) p.ssq[(size_t)row * 16 + nt * 2 + wn] = ss;
                }
            }
        } else {
            bf16_t* st = (bf16_t*)slab;
#pragma unroll
            for (int i = 0; i < 4; i++) {
                float rs = 1.f;
                if (EPI == EPI_QRY) {
                    const float4* q = (const float4*)(p.ssq + (size_t)(rbase + i * 16 + n16) * 16);
                    const float4 q0 = q[0], q1 = q[1], q2 = q[2], q3 = q[3];
                    const float t = ((q0.x + q0.y) + (q0.z + q0.w)) + ((q1.x + q1.y) + (q1.z + q1.w)) + ((q2.x + q2.y) + (q2.z + q2.w)) + ((q3.x + q3.y) + (q3.z + q3.w));
                    rs = rsqrtf(t * (1.f / DM) + 1e-6f);
                }
#pragma unroll
                for (int j = 0; j < 4; j++) {
                    float v0 = acc[i][j][0], v1 = acc[i][j][1], v2 = acc[i][j][2], v3 = acc[i][j][3];
                    if (EPI == EPI_HID) {
                        const float4 bb = *(const float4*)(p.aux + (inst >> 2) * 256 + cbase + 16 * j + 4 * kq);
                        v0 = gelu_tanh(v0 + bb.x); v1 = gelu_tanh(v1 + bb.y); v2 = gelu_tanh(v2 + bb.z); v3 = gelu_tanh(v3 + bb.w);
                    }
                    if (EPI == EPI_QRY) { v0 *= rs; v1 *= rs; v2 *= rs; v3 *= rs; }
                    *(uint2*)(st + (i * 16 + n16) * 72 + j * 16 + 4 * kq) = make_uint2(pk2(v0, v1), pk2(v2, v3));
                }
            }
            const int ld = (EPI == EPI_PROJ) ? PLD : (EPI == EPI_HID ? 256 : 2048);
#pragma unroll
            for (int ps = 0; ps < 8; ps++) {
                const int rl = ps * 8 + (lane >> 3), ch = lane & 7;
                const uint4 v = *(const uint4*)(st + rl * 72 + ch * 8);
                *(uint4*)((bf16_t*)p.out + (size_t)(rbase + rl) * ld + cbase + ch * 8) = v;
            }
        }
        __syncthreads();
    }
}

__device__ __forceinline__ void d_knorm_rope(const bf16_t* __restrict__ proj, const float* __restrict__ kgain, bf16_t* __restrict__ ksn, bf16_t* __restrict__ kwn, bf16_t* __restrict__ vsn, bf16_t* __restrict__ vwn, const float2* __restrict__ rope, int bid) {
    int vec = bid * 8 + (threadIdx.x >> 5);
    int i = threadIdx.x & 31;
    int which = vec >> 15;
    int rem = vec & 32767;
    int b = rem >> 14, g = (rem >> 13) & 1, s = rem & 8191;
    const bf16_t* src = proj + (size_t)(b * SEQ + s) * PLD + C_KV + 128 * (which ? 4 : 2) + 64 * g;
    float x1 = bf2f(src[i]), x2 = bf2f(src[i + 32]);
    float ss = x1 * x1 + x2 * x2;
#pragma unroll
    for (int o = 16; o > 0; o >>= 1) ss += __shfl_xor(ss, o);
    float r = rsqrtf(ss * (1.f / 64.f) + 1e-6f);
    const float* gn = kgain + (which ? 2 : 1) * 64;
    x1 = x1 * r * gn[i]; x2 = x2 * r * gn[i + 32];
    const float2 cs2 = rope[(size_t)s * 32 + i];
    const float cs = cs2.x, sn = cs2.y;
    bf16_t* dst = (which ? kwn : ksn) + ((size_t)(b * 2 + g) * SEQ + s) * 64;
    dst[i] = f2bf(x1 * cs - x2 * sn);
    dst[i + 32] = f2bf(x2 * cs + x1 * sn);
    ((unsigned*)((which ? vwn : vsn) + ((size_t)(b * 2 + g) * SEQ + s) * 64))[i] = ((const unsigned*)(src + 128))[i];
}

__device__ __forceinline__ void d_cmp2_mfma(const bf16_t* __restrict__ hid, const bf16_t* __restrict__ cw2t, const float* __restrict__ kgain, const float2* __restrict__ rope,
                                            bf16_t* __restrict__ kc, bf16_t* __restrict__ vc, int witem, int lane) {
    const int n16 = lane & 15, kq = lane >> 4;
    const int rowbase = 16 * witem, inst = rowbase >> 9, n0 = rowbase & 511, j = inst >> 2, bg = inst & 3;
    f32x4 acc[4];
#pragma unroll
    for (int nt = 0; nt < 4; nt++) acc[nt] = (f32x4){0.f, 0.f, 0.f, 0.f};
    const bf16_t* ap = hid + (size_t)(rowbase + n16) * 256 + 8 * kq;
    const bf16_t* bp = cw2t + (size_t)j * 64 * 256 + n16 * 256 + 8 * kq;
#pragma unroll
    for (int ks = 0; ks < 8; ks++) {
        const bf16x8 a = *(const bf16x8*)(ap + 32 * ks);
#pragma unroll
        for (int nt = 0; nt < 4; nt++) {
            const bf16x8 bb = *(const bf16x8*)(bp + (size_t)(16 * nt) * 256 + 32 * ks);
            acc[nt] = __builtin_amdgcn_mfma_f32_16x16x32_bf16(a, bb, acc[nt], 0, 0, 0);
        }
    }
#pragma unroll
    for (int r = 0; r < 4; r++) {
        const int n = n0 + 4 * kq + r;
        if (j == 0) {
            float ss = acc[0][r] * acc[0][r] + acc[1][r] * acc[1][r] + acc[2][r] * acc[2][r] + acc[3][r] * acc[3][r];
            ss = allsum16(ss);
            const float ri = rsqrtf(ss * (1.f / 64.f) + 1e-6f);
#pragma unroll
            for (int nt = 0; nt < 2; nt++) {
                const int i = 16 * nt + n16;
                const float y1 = acc[nt][r] * ri * kgain[i], y2 = acc[nt + 2][r] * ri * kgain[i + 32];
                const float2 cs = rope[(size_t)((n < 511 ? n : 510) * 16 + 31) * 32 + i];
                if (n < 511) {
                    kc[((size_t)bg * 512 + n) * 64 + i] = f2bf(y1 * cs.x - y2 * cs.y);
                    kc[((size_t)bg * 512 + n) * 64 + i + 32] = f2bf(y2 * cs.x + y1 * cs.y);
                }
            }
        } else if (n < 511) {
#pragma unroll
            for (int nt = 0; nt < 4; nt++) vc[((size_t)bg * 512 + n) * 64 + 16 * nt + n16] = f2bf(acc[nt][r]);
        }
    }
}

typedef float f32x16 __attribute__((ext_vector_type(16)));
typedef short s16x4 __attribute__((ext_vector_type(4)));
#define MFMA32(a, b, c) __builtin_amdgcn_mfma_f32_32x32x16_bf16((a), (b), (c), 0, 0, 0)
#define NKS 72
#define NSA_K_OFF 0
#define NSA_V_OFF (2 * 64 * NKS * 2)
#define NSA_IMP_OFF (NSA_V_OFF + 2 * 64 * NKS * 2)
#define NSA_SEL_OFF (NSA_IMP_OFF + 4 * 8192)
#define NSA_LDS (NSA_SEL_OFF + 32 * 4 * 4)
#define NEGBIG (-1e30f)
__device__ __forceinline__ bf16x8 pack8(float a0, float a1, float a2, float a3, float a4, float a5, float a6, float a7) {
    uint4 u = make_uint4(pk2(a0, a1), pk2(a2, a3), pk2(a4, a5), pk2(a6, a7));
    return __builtin_bit_cast(bf16x8, u);
}
typedef unsigned u32x4 __attribute__((ext_vector_type(4)));
struct NsaStage { u32x4 k0, k1, v0, v1; };
struct NsaCtx {
    bool noload;
    const bf16_t* Kbase; long kstride;
    const bf16_t* Vbase; long vstride;
    bf16_t* Kb; bf16_t* Vb;
    float* imp_s; unsigned* sel_s;
    bf16x8 qf[4];
    f32x16 O0, O1;
    float m, l, invl, carry;
    int t, tokl, hp, hh, c, lane;
};
__device__ __forceinline__ void nsa_stage_load(const NsaCtx& X, NsaStage& st, int j) {
    const int r0 = threadIdx.x >> 3, c8 = (threadIdx.x & 7) * 8;
    if (X.noload) { st.k0 = (u32x4){0u,0u,0u,0u}; st.k1 = st.k0; st.v0 = st.k0; st.v1 = st.k0; return; }
    const bf16_t* kp = X.Kbase + (size_t)(64 * j + r0) * X.kstride + c8;
    const bf16_t* vp = X.Vbase + (size_t)(64 * j + r0) * X.vstride + c8;
    st.k0 = *(const u32x4*)kp; st.k1 = *(const u32x4*)(kp + 32 * X.kstride);
    st.v0 = *(const u32x4*)vp; st.v1 = *(const u32x4*)(vp + 32 * X.vstride);
}
__device__ __forceinline__ void nsa_stage_store(const NsaCtx& X, const NsaStage& st, int buf) {
    const int r0 = threadIdx.x >> 3, c8 = (threadIdx.x & 7) * 8;
    bf16_t* kb = X.Kb + buf * 64 * NKS + r0 * NKS + c8;
    bf16_t* vb = X.Vb + buf * 64 * NKS + r0 * NKS + c8;
    *(u32x4*)kb = st.k0; *(u32x4*)(kb + 32 * NKS) = st.k1;
    *(u32x4*)vb = st.v0; *(u32x4*)(vb + 32 * NKS) = st.v1;
}
template <int MODE, bool FAST>
__device__ __forceinline__ void nsa_tile(NsaCtx& X, int j, int kt, int buf, unsigned long long mlo, unsigned long long mhi) {
    const bf16_t* Kt = X.Kb + buf * 64 * NKS + (32 * kt) * NKS;
    const bf16_t* Vt = X.Vb + buf * 64 * NKS + (32 * kt) * NKS;
    f32x16 S;
#pragma unroll
    for (int i = 0; i < 16; i++) S[i] = 0.f;
#pragma unroll
    for (int s = 0; s < 4; s++) {
        bf16x8 ka = *(const bf16x8*)(Kt + X.c * NKS + 16 * s + 8 * X.hh);
        S = MFMA32(ka, X.qf[s], S);
    }
    const int kbase = 64 * j + 32 * kt;
    int lo = 0, hi;
    bool on = true;
    if (MODE <= 1) hi = ((X.t - 31) >> 4) - kbase;
    else hi = X.t - kbase;
    if (MODE == 3) lo = X.t - 511 - kbase;
    if (MODE == 2) {
        const unsigned long long wsel = (j < 64) ? mlo : mhi;
        on = (wsel >> (j & 63)) & 1ull;
    }
    lo -= 4 * X.hh; hi -= 4 * X.hh;
    if (!on) hi = -1000;
    float P[16];
    if (MODE == 1) {
#pragma unroll
        for (int i = 0; i < 16; i++) {
            const int cr = (i & 3) + 8 * (i >> 2);
            P[i] = (cr <= hi) ? __builtin_amdgcn_exp2f(S[i] - X.m) * X.invl : 0.f;
        }
        float mainv[4], nxt[4];
#pragma unroll
        for (int q = 0; q < 4; q++) { mainv[q] = 2.f * (P[4 * q] + P[4 * q + 1] + P[4 * q + 2]) + P[4 * q + 3]; nxt[q] = P[4 * q + 3]; }
#pragma unroll
        for (int q = 0; q < 4; q++) {
            mainv[q] += __shfl_xor(mainv[q], 1); mainv[q] += __shfl_xor(mainv[q], 2);
            nxt[q] += __shfl_xor(nxt[q], 1); nxt[q] += __shfl_xor(nxt[q], 2);
        }
        float recv[4];
#pragma unroll
        for (int q = 0; q < 4; q++) recv[q] = __shfl_xor(nxt[q], 32);
        const int jsel0 = 16 * j + 8 * kt + X.hh;
#pragma unroll
        for (int q = 0; q < 4; q++) {
            const float tot = mainv[q] + (X.hh ? recv[q] : (q > 0 ? recv[q > 0 ? q - 1 : 0] : X.carry));
            if (X.hp == 0) X.imp_s[(X.tokl & 7) * 128 + jsel0 + 2 * q] = tot;
        }
        X.carry = recv[3];
    } else {
        float tmax = NEGBIG;
        if (FAST) {
            tmax = fmaxf(fmaxf(fmaxf(fmaxf(S[0], S[1]), fmaxf(S[2], S[3])), fmaxf(fmaxf(S[4], S[5]), fmaxf(S[6], S[7]))),
                         fmaxf(fmaxf(fmaxf(S[8], S[9]), fmaxf(S[10], S[11])), fmaxf(fmaxf(S[12], S[13]), fmaxf(S[14], S[15]))));
            if (MODE == 2 && !on) tmax = NEGBIG;
        } else {
#pragma unroll
            for (int i = 0; i < 16; i++) {
                const int cr = (i & 3) + 8 * (i >> 2);
                const bool vis = (cr <= hi) && (cr >= lo);
                tmax = vis ? fmaxf(tmax, S[i]) : tmax;
            }
        }
        tmax = fmaxf(tmax, __shfl_xor(tmax, 32));
        float ls = 0.f;
        if (MODE == 0) {
            const float mnew = fmaxf(X.m, tmax);
            const float alpha = __builtin_amdgcn_exp2f(X.m - mnew);
            X.m = mnew;
#pragma unroll
            for (int i = 0; i < 16; i++) {
                const int cr = (i & 3) + 8 * (i >> 2);
                const bool vis = (cr <= hi) && (cr >= lo);
                P[i] = vis ? __builtin_amdgcn_exp2f(S[i] - mnew) : 0.f;
                ls += P[i];
            }
            X.l = X.l * alpha + ls;
        } else {
            const bool upd = tmax > X.m + 8.f;
            const float mnew = upd ? tmax : X.m;
            if (__builtin_amdgcn_ballot_w64(upd) != 0ull) {
                const float alpha = __builtin_amdgcn_exp2f(X.m - mnew);
                X.l *= alpha;
#pragma unroll
                for (int i = 0; i < 16; i++) { X.O0[i] *= alpha; X.O1[i] *= alpha; }
            }
            X.m = mnew;
            if (FAST) {
                const float msub = (MODE == 2 && !on) ? 1e30f : mnew;
#pragma unroll
                for (int i = 0; i < 16; i++) { P[i] = __builtin_amdgcn_exp2f(S[i] - msub); ls += P[i]; }
            } else {
#pragma unroll
                for (int i = 0; i < 16; i++) {
                    const int cr = (i & 3) + 8 * (i >> 2);
                    const bool vis = (cr <= hi) && (cr >= lo);
                    P[i] = vis ? __builtin_amdgcn_exp2f(S[i] - mnew) : 0.f;
                    ls += P[i];
                }
            }
            X.l += ls;
        }
    }
    if (MODE >= 1) {
        bf16x8 pb0 = pack8(P[0], P[1], P[2], P[3], P[4], P[5], P[6], P[7]);
        bf16x8 pb1 = pack8(P[8], P[9], P[10], P[11], P[12], P[13], P[14], P[15]);
        const int l15 = X.lane & 15;
        const bf16_t* vrow = Vt + (4 * X.hh + (l15 >> 2)) * NKS + 16 * ((X.lane >> 4) & 1) + 4 * (l15 & 3);
#pragma unroll
        for (int s2 = 0; s2 < 2; s2++) {
#pragma unroll
            for (int dt = 0; dt < 2; dt++) {
                s16x4 lo4 = __builtin_amdgcn_ds_read_tr16_b64_v4i16((LAS3 s16x4*)(vrow + (16 * s2) * NKS + 32 * dt));
                s16x4 hi4 = __builtin_amdgcn_ds_read_tr16_b64_v4i16((LAS3 s16x4*)(vrow + (16 * s2 + 8) * NKS + 32 * dt));
                bf16x8 va = __builtin_shufflevector(lo4, hi4, 0, 1, 2, 3, 4, 5, 6, 7);
                if (dt == 0) X.O0 = MFMA32(va, s2 ? pb1 : pb0, X.O0); else X.O1 = MFMA32(va, s2 ? pb1 : pb0, X.O1);
            }
        }
    }
}
template <int MODE>
__device__ __forceinline__ void nsa_block(NsaCtx& X, int j, unsigned long long mlo, unsigned long long mhi, unsigned long long ulo, unsigned long long uhi, int cur, int tw0) {
    bool need = true;
    if (MODE == 2) {
        const unsigned long long wsel = (j < 64) ? ulo : uhi;
        need = (wsel >> (j & 63)) & 1ull;
    }
    if (need) {
#pragma unroll 1
        for (int kt = 0; kt < 2; kt++) {
            bool fast = false;
            if (MODE == 2) fast = j < cur;
            if (MODE == 3) { const int kb = 64 * j + 32 * kt; fast = (kb + 31 <= tw0) && (kb >= tw0 + 7 - 511); }
            if (MODE >= 2 && fast) nsa_tile<MODE, true>(X, j, kt, j & 1, mlo, mhi);
            else nsa_tile<MODE, false>(X, j, kt, j & 1, mlo, mhi);
        }
    }
}
template <int MODE>
__device__ __forceinline__ void nsa_branch(NsaCtx& X, int jlo, int jhi, unsigned long long mlo, unsigned long long mhi, unsigned long long ulo, unsigned long long uhi, int cur, int tw0) {
    NsaStage sa;
    nsa_stage_load(X, sa, jlo);
    __syncthreads();
    nsa_stage_store(X, sa, jlo & 1);
    __syncthreads();
#pragma unroll 1
    for (int j = jlo; j <= jhi; j++) {
        if (j < jhi) nsa_stage_load(X, sa, j + 1);
        nsa_block<MODE>(X, j, mlo, mhi, ulo, uhi, cur, tw0);
        if (j < jhi) nsa_stage_store(X, sa, (j + 1) & 1);
        __syncthreads();
    }
}
template <int OP>
__device__ __forceinline__ void nsa_facc(NsaCtx& X, float scale) {
    f32x4* F = (f32x4*)X.imp_s;
#pragma unroll
    for (int q = 0; q < 8; q++) {
        f32x4 v;
#pragma unroll
        for (int e = 0; e < 4; e++) v[e] = ((q < 4) ? X.O0[4 * q + e] : X.O1[4 * (q - 4) + e]) * scale;
        if (OP >= 1) v += F[q * 64 + X.lane];
        if (OP <= 1) F[q * 64 + X.lane] = v;
        else {
#pragma unroll
            for (int e = 0; e < 4; e++) { if (q < 4) X.O0[4 * q + e] = v[e]; else X.O1[4 * (q - 4) + e] = v[e]; }
        }
    }
}
__device__ __forceinline__ void d_nsa_mfma(const bf16_t* __restrict__ proj, const float* __restrict__ qgain, const float2* __restrict__ rope,
                                           const bf16_t* __restrict__ ksn, const bf16_t* __restrict__ kwn,
                                           const bf16_t* __restrict__ kc, const bf16_t* __restrict__ vc, const bf16_t* __restrict__ vsn, const bf16_t* __restrict__ vwn,
                                           bf16_t* __restrict__ mixo, int mix_ld, int item, char* smem, bool noload = false) {
    NsaCtx X;
    X.noload = noload;
    const int tid = threadIdx.x, lane = tid & 63, w = tid >> 6;
    const int bg = item & 3, tile = 255 - (item >> 2);
    const int b = bg >> 1, g = bg & 1, t0 = tile * 32;
    X.lane = lane; X.c = lane & 31; X.hh = lane >> 5; X.hp = X.c & 3; X.tokl = 8 * w + (X.c >> 2); X.t = t0 + X.tokl;
    X.Kb = (bf16_t*)(smem + NSA_K_OFF); X.Vb = (bf16_t*)(smem + NSA_V_OFF);
    X.imp_s = (float*)(smem + NSA_IMP_OFF + w * 8192); X.sel_s = (unsigned*)(smem + NSA_SEL_OFF);
    const int head = g * 4 + X.hp;
    const size_t row = (size_t)(b * SEQ + X.t);
    {
        float y[4][8];
        const bf16_t* qsrc = proj + row * PLD + C_Q + head * 64 + 8 * X.hh;
        float ss = 0.f;
#pragma unroll
        for (int s = 0; s < 4; s++) {
            const uint4 u = *(const uint4*)(qsrc + 16 * s);
            const unsigned wv[4] = {u.x, u.y, u.z, u.w};
#pragma unroll
            for (int e = 0; e < 4; e++) { y[s][2 * e] = __uint_as_float(wv[e] << 16); y[s][2 * e + 1] = __uint_as_float(wv[e] & 0xffff0000u); }
#pragma unroll
            for (int e = 0; e < 8; e++) ss += y[s][e] * y[s][e];
        }
        ss += __shfl_xor(ss, 32);
        const float r = rsqrtf(ss * (1.f / 64.f) + 1e-6f);
#pragma unroll
        for (int s = 0; s < 4; s++)
#pragma unroll
            for (int e = 0; e < 8; e++) y[s][e] *= r * qgain[16 * s + 8 * X.hh + e];
        const float qs = 0.125f * 1.4426950408889634f;
#pragma unroll
        for (int s = 0; s < 2; s++)
#pragma unroll
            for (int e = 0; e < 8; e++) {
                const float2 cs = rope[(size_t)X.t * 32 + 16 * s + 8 * X.hh + e];
                const float x1 = y[s][e], x2 = y[s + 2][e];
                y[s][e] = (x1 * cs.x - x2 * cs.y) * qs; y[s + 2][e] = (x2 * cs.x + x1 * cs.y) * qs;
            }
#pragma unroll
        for (int s = 0; s < 4; s++) X.qf[s] = pack8(y[s][0], y[s][1], y[s][2], y[s][3], y[s][4], y[s][5], y[s][6], y[s][7]);
    }
    const bf16_t* gp = proj + row * PLD + C_GATE + head * 3;
    const float g0 = sigmoidf_(bf2f(gp[0])), g1 = sigmoidf_(bf2f(gp[1])), g2 = sigmoidf_(bf2f(gp[2]));
    const int cur = t0 >> 6;
    {
        X.Kbase = kc + (size_t)bg * 512 * 64; X.kstride = 64; X.Vbase = vc + (size_t)bg * 512 * 64; X.vstride = 64;
        const int nvmax = (t0 >> 4) + 1, jhi = (nvmax - 1) >> 6;
        X.m = NEGBIG; X.l = 0.f;
        nsa_branch<0>(X, 0, jhi, 0ull, 0ull, 0ull, 0ull, cur, t0 + 8 * w);
        const float lt = X.l + __shfl_xor(X.l, 32);
        X.invl = (lt > 0.f) ? 1.f / lt : 0.f;
        X.carry = 0.f;
#pragma unroll
        for (int i = 0; i < 16; i++) { X.O0[i] = 0.f; X.O1[i] = 0.f; }
        nsa_branch<1>(X, 0, jhi, 0ull, 0ull, 0ull, 0ull, cur, t0 + 8 * w);
    }
    unsigned long long mlo, mhi, ulo, uhi;
    {
        const int tk2 = lane >> 3, sub = lane & 7;
        unsigned k0 = 1u, k1 = 0u, k2 = 0u, k3 = 0u;
#define SETBIT(jj) { const int _j = (jj); if (_j < 32) k0 |= 1u << _j; else if (_j < 64) k1 |= 1u << (_j - 32); else if (_j < 96) k2 |= 1u << (_j - 64); else k3 |= 1u << (_j - 96); }
        SETBIT(cur);
        if (cur >= 1) SETBIT(cur - 1);
        const int ncand = cur - 2;
        if (ncand > 0) {
            if (ncand <= 13) {
                for (int jj = 1; jj <= cur - 2; jj++) SETBIT(jj);
            } else {
                float sc[16];
#pragma unroll
                for (int i = 0; i < 16; i++) { const int jj = sub + 8 * i; sc[i] = (jj >= 1 && jj <= cur - 2) ? X.imp_s[tk2 * 128 + jj] : -3e38f; }
#pragma unroll 1
                for (int it = 0; it < 13; it++) {
                    float bv = sc[0]; int bi = 0;
#pragma unroll
                    for (int i = 1; i < 16; i++) if (sc[i] > bv) { bv = sc[i]; bi = i; }
                    int bj = sub + 8 * bi;
#pragma unroll
                    for (int o = 1; o < 8; o <<= 1) {
                        const float ov = __shfl_xor(bv, o); const int oj = __shfl_xor(bj, o);
                        if (ov > bv || (ov == bv && oj < bj)) { bv = ov; bj = oj; }
                    }
                    SETBIT(bj);
#pragma unroll
                    for (int i = 0; i < 16; i++) if (bj == sub + 8 * i) sc[i] = -3e38f;
                }
            }
        }
#undef SETBIT
        if (sub == 0) { unsigned* d = X.sel_s + (8 * w + tk2) * 4; d[0] = k0; d[1] = k1; d[2] = k2; d[3] = k3; }
        __builtin_amdgcn_s_waitcnt(0xc07f);
        const unsigned* sp = X.sel_s + X.tokl * 4;
        const unsigned m0 = sp[0], m1 = sp[1], m2 = sp[2], m3 = sp[3];
        mlo = (unsigned long long)m0 | ((unsigned long long)m1 << 32); mhi = (unsigned long long)m2 | ((unsigned long long)m3 << 32);
        unsigned u0 = m0, u1 = m1, u2 = m2, u3 = m3;
#pragma unroll
        for (int o = 4; o < 32; o <<= 1) { u0 |= __shfl_xor(u0, o); u1 |= __shfl_xor(u1, o); u2 |= __shfl_xor(u2, o); u3 |= __shfl_xor(u3, o); }
        ulo = (unsigned long long)(unsigned)__builtin_amdgcn_readfirstlane(u0) | ((unsigned long long)(unsigned)__builtin_amdgcn_readfirstlane(u1) << 32);
        uhi = (unsigned long long)(unsigned)__builtin_amdgcn_readfirstlane(u2) | ((unsigned long long)(unsigned)__builtin_amdgcn_readfirstlane(u3) << 32);
    }
    nsa_facc<0>(X, g0);
    {
        X.Kbase = ksn + (size_t)bg * SEQ * 64; X.kstride = 64;
        X.Vbase = vsn + (size_t)bg * SEQ * 64; X.vstride = 64;
        X.m = NEGBIG; X.l = 0.f;
#pragma unroll
        for (int i = 0; i < 16; i++) { X.O0[i] = 0.f; X.O1[i] = 0.f; }
        nsa_branch<2>(X, 0, cur, mlo, mhi, ulo, uhi, cur, t0 + 8 * w);
        const float lt = X.l + __shfl_xor(X.l, 32);
        nsa_facc<1>(X, (lt > 0.f) ? g1 / lt : 0.f);
    }
    {
        X.Kbase = kwn + (size_t)bg * SEQ * 64; X.kstride = 64;
        X.Vbase = vwn + (size_t)bg * SEQ * 64; X.vstride = 64;
        X.m = NEGBIG; X.l = 0.f;
#pragma unroll
        for (int i = 0; i < 16; i++) { X.O0[i] = 0.f; X.O1[i] = 0.f; }
        const int jlo = (t0 >= 511) ? ((t0 - 511) >> 6) : 0;
        nsa_branch<3>(X, jlo, cur, 0ull, 0ull, 0ull, 0ull, cur, t0 + 8 * w);
        const float lt = X.l + __shfl_xor(X.l, 32);
        nsa_facc<2>(X, (lt > 0.f) ? g2 / lt : 0.f);
    }
    bf16_t* dst = mixo + row * mix_ld + head * 64 + 4 * X.hh;
#pragma unroll
    for (int q4 = 0; q4 < 4; q4++) {
        *(uint2*)(dst + 8 * q4) = make_uint2(pk2(X.O0[4 * q4], X.O0[4 * q4 + 1]), pk2(X.O0[4 * q4 + 2], X.O0[4 * q4 + 3]));
        *(uint2*)(dst + 32 + 8 * q4) = make_uint2(pk2(X.O1[4 * q4], X.O1[4 * q4 + 1]), pk2(X.O1[4 * q4 + 2], X.O1[4 * q4 + 3]));
    }
}

#define KLS 136
#define XSS 264
#define GDN_PREP_LDS (2 * 64 * KLS * 2 + 64 * XSS * 2 + 512)
__device__ __forceinline__ unsigned pack2bf(float lo, float hi) { return (unsigned)f2bf(lo) | ((unsigned)f2bf(hi) << 16); }
__device__ __forceinline__ void d_gdn_prep2(const bf16_t* __restrict__ proj, const float* __restrict__ conv_w,
                                            const float* __restrict__ a_log, const float* __restrict__ dt_bias,
                                            bf16_t* __restrict__ guT, bf16_t* __restrict__ gw, bf16_t* __restrict__ gqd,
                                            bf16_t* __restrict__ gkdT, bf16_t* __restrict__ gin, float* __restrict__ gl, int chunk, char* smem) {
    bf16_t* kL = (bf16_t*)smem;
    bf16_t* qL = kL + 64 * KLS;
    float* AmT = (float*)qL;
    bf16_t* xs = qL + 64 * KLS;
    float* gcs = (float*)(xs + 64 * XSS);
    float* bts = gcs + 64;
    const int tid = threadIdx.x, lane = tid & 63, w = tid >> 6;
    const int n = chunk & 127, h = (chunk >> 7) & 3, b = chunk >> 9;
    const int t0 = n * 64;
    const size_t rbase = (size_t)(b * SEQ + t0);
    if (tid < 64) {
        const size_t r = (rbase + tid) * PLD;
        float a = bf2f(proj[r + C_A + h]), bb = bf2f(proj[r + C_B + h]);
        float xx = a + dt_bias[h];
        float sp = (xx > 20.f) ? xx : log1pf(__expf(xx));
        float c = -__expf(a_log[h]) * sp;
#pragma unroll
        for (int o = 1; o < 64; o <<= 1) { float nb = __shfl_up(c, o); if (lane >= o) c += nb; }
        gcs[tid] = c; bts[tid] = sigmoidf_(bb);
    }
    __syncthreads();
    {
        float wt[6][4], x0[6], x1[6], x2[6];
        int ch[6];
#pragma unroll
        for (int c6 = 0; c6 < 6; c6++) {
            ch[c6] = (c6 >> 1) * 512 + h * 128 + lane + 64 * (c6 & 1);
#pragma unroll
            for (int j = 0; j < 4; j++) wt[c6][j] = conv_w[j * 1536 + ch[c6]];
            const int tb = t0 + 16 * w - 3;
            x0[c6] = (tb >= 0) ? bf2f(proj[((size_t)(b * SEQ + tb)) * PLD + C_GQKV + ch[c6]]) : 0.f;
            x1[c6] = (tb + 1 >= 0) ? bf2f(proj[((size_t)(b * SEQ + tb + 1)) * PLD + C_GQKV + ch[c6]]) : 0.f;
            x2[c6] = (tb + 2 >= 0) ? bf2f(proj[((size_t)(b * SEQ + tb + 2)) * PLD + C_GQKV + ch[c6]]) : 0.f;
        }
        for (int i = 16 * w; i < 16 * w + 16; i++) {
            float sv[6];
#pragma unroll
            for (int c6 = 0; c6 < 6; c6++) {
                float xn = bf2f(proj[(rbase + i) * PLD + C_GQKV + ch[c6]]);
                float cv = x0[c6] * wt[c6][0] + x1[c6] * wt[c6][1] + x2[c6] * wt[c6][2] + xn * wt[c6][3];
                x0[c6] = x1[c6]; x1[c6] = x2[c6]; x2[c6] = xn;
                sv[c6] = cv * sigmoidf_(cv);
            }
            float rq = rsqrtf(wave_sum(sv[0] * sv[0] + sv[1] * sv[1]) + 1e-6f) * 0.08838834764831845f;
            float rk = rsqrtf(wave_sum(sv[2] * sv[2] + sv[3] * sv[3]) + 1e-6f);
            const float bi = bts[i], ei = __expf(gcs[i]);
            float q0 = sv[0] * rq, q1 = sv[1] * rq, k0 = sv[2] * rk, k1 = sv[3] * rk;
            qL[i * KLS + lane] = f2bf(q0); qL[i * KLS + lane + 64] = f2bf(q1);
            kL[i * KLS + lane] = f2bf(k0); kL[i * KLS + lane + 64] = f2bf(k1);
            xs[i * XSS + lane] = f2bf(sv[4] * bi); xs[i * XSS + lane + 64] = f2bf(sv[5] * bi);
            xs[i * XSS + 128 + lane] = f2bf(k0 * bi * ei); xs[i * XSS + 192 + lane] = f2bf(k1 * bi * ei);
            bf16_t* qd = gqd + (size_t)chunk * 8192 + i * 128;
            qd[lane] = f2bf(q0 * ei); qd[lane + 64] = f2bf(q1 * ei);
        }
    }
    __syncthreads();
    const int n16 = lane & 15, kq = lane >> 4;
    f32x4 aqk[4], akk[4];
#pragma unroll
    for (int tj = 0; tj < 4; tj++) { aqk[tj] = (f32x4){0.f, 0.f, 0.f, 0.f}; akk[tj] = (f32x4){0.f, 0.f, 0.f, 0.f}; }
#pragma unroll
    for (int ks = 0; ks < 4; ks++) {
        bf16x8 qa = *(const bf16x8*)(qL + (16 * w + n16) * KLS + 32 * ks + 8 * kq);
        bf16x8 ka = *(const bf16x8*)(kL + (16 * w + n16) * KLS + 32 * ks + 8 * kq);
#pragma unroll
        for (int tj = 0; tj < 4; tj++) {
            bf16x8 kb = *(const bf16x8*)(kL + (16 * tj + n16) * KLS + 32 * ks + 8 * kq);
            aqk[tj] = __builtin_amdgcn_mfma_f32_16x16x32_bf16(qa, kb, aqk[tj], 0, 0, 0);
            akk[tj] = __builtin_amdgcn_mfma_f32_16x16x32_bf16(ka, kb, akk[tj], 0, 0, 0);
        }
    }
    {
        const float glast = gcs[63];
        const int kidx = tid >> 1, c0 = (tid & 1) * 32;
        unsigned pk[16];
#pragma unroll
        for (int cc = 0; cc < 32; cc += 2) {
            float v0 = bf2f(kL[(c0 + cc) * KLS + kidx]) * __expf(glast - gcs[c0 + cc]);
            float v1 = bf2f(kL[(c0 + cc + 1) * KLS + kidx]) * __expf(glast - gcs[c0 + cc + 1]);
            pk[cc >> 1] = pack2bf(v0, v1);
        }
        uint4* dst = (uint4*)(gkdT + (size_t)chunk * 8192 + kidx * 64 + c0);
#pragma unroll
        for (int v4 = 0; v4 < 4; v4++) dst[v4] = make_uint4(pk[4 * v4], pk[4 * v4 + 1], pk[4 * v4 + 2], pk[4 * v4 + 3]);
        if (tid == 0) gl[chunk] = __expf(glast);
    }
    __syncthreads();
#pragma unroll
    for (int tj = 0; tj < 4; tj++)
#pragma unroll
        for (int r = 0; r < 4; r++) {
            const int i = 16 * w + 4 * kq + r, j = 16 * tj + n16;
            const float dec = (j <= i) ? __expf(gcs[i] - gcs[j]) : 0.f;
            gin[(size_t)chunk * 4096 + i * 64 + j] = f2bf(aqk[tj][r] * dec);
            AmT[j * 64 + i] = (j < i) ? bts[i] * akk[tj][r] * dec : 0.f;
        }
    __syncthreads();
    {
        const int c = tid;
#pragma unroll 1
        for (int blk = 0; blk < 8; blk++) {
            const int i0 = blk * 8;
            float acc[8];
#pragma unroll
            for (int r = 0; r < 8; r++) acc[r] = bf2f(xs[(i0 + r) * XSS + c]);
            for (int j = 0; j < i0; j++) {
                const float xj = bf2f(xs[j * XSS + c]);
                const float4 a0 = *(const float4*)(AmT + j * 64 + i0), a1 = *(const float4*)(AmT + j * 64 + i0 + 4);
                acc[0] -= a0.x * xj; acc[1] -= a0.y * xj; acc[2] -= a0.z * xj; acc[3] -= a0.w * xj;
                acc[4] -= a1.x * xj; acc[5] -= a1.y * xj; acc[6] -= a1.z * xj; acc[7] -= a1.w * xj;
            }
#pragma unroll
            for (int r = 1; r < 8; r++)
#pragma unroll
                for (int s2 = 0; s2 < r; s2++) acc[r] -= AmT[(i0 + s2) * 64 + i0 + r] * acc[s2];
#pragma unroll
            for (int r = 0; r < 8; r++) xs[(i0 + r) * XSS + c] = f2bf(acc[r]);
            if (c < 128) {
                *(uint4*)(guT + (size_t)chunk * 8192 + c * 64 + i0) =
                    make_uint4(pack2bf(acc[0], acc[1]), pack2bf(acc[2], acc[3]), pack2bf(acc[4], acc[5]), pack2bf(acc[6], acc[7]));
            } else {
#pragma unroll
                for (int r = 0; r < 8; r++) gw[(size_t)chunk * 8192 + (i0 + r) * 128 + (c - 128)] = f2bf(acc[r]);
            }
        }
    }
}

struct GdnFrag { bf16x8 wA[4], qA[4], inA[2], kdA[2][2]; uint2 uC; float glv; };
__device__ __forceinline__ void gdn_load_frag(GdnFrag& f, const bf16_t* __restrict__ guT, const bf16_t* __restrict__ gw, const bf16_t* __restrict__ gqd,
                                              const bf16_t* __restrict__ gkdT, const bf16_t* __restrict__ gin, const float* __restrict__ gl,
                                              int chunk, int w, int sl, int n16, int kq) {
    const size_t cb = (size_t)chunk * 8192;
#pragma unroll
    for (int ks = 0; ks < 4; ks++) {
        f.wA[ks] = *(const bf16x8*)(gw + cb + (16 * w + n16) * 128 + 32 * ks + 8 * kq);
        f.qA[ks] = *(const bf16x8*)(gqd + cb + (16 * w + n16) * 128 + 32 * ks + 8 * kq);
    }
#pragma unroll
    for (int ks = 0; ks < 2; ks++) {
        f.inA[ks] = *(const bf16x8*)(gin + (size_t)chunk * 4096 + (16 * w + n16) * 64 + 32 * ks + 8 * kq);
        f.kdA[0][ks] = *(const bf16x8*)(gkdT + cb + (32 * w + n16) * 64 + 32 * ks + 8 * kq);
        f.kdA[1][ks] = *(const bf16x8*)(gkdT + cb + (32 * w + 16 + n16) * 64 + 32 * ks + 8 * kq);
    }
    f.uC = *(const uint2*)(guT + cb + (16 * sl + n16) * 64 + 16 * w + 4 * kq);
    f.glv = gl[chunk];
}
#define STS 144
#define VNS 80
__device__ __forceinline__ void gdn_step(const GdnFrag& f, f32x4& S0, f32x4& S1, bf16_t* StT, bf16_t* vnT, float* __restrict__ ogrow, int w, int n16, int kq) {
    f32x4 ws = (f32x4){0.f, 0.f, 0.f, 0.f}, qs = (f32x4){0.f, 0.f, 0.f, 0.f};
#pragma unroll
    for (int ks = 0; ks < 4; ks++) {
        bf16x8 sb = *(const bf16x8*)(StT + n16 * STS + 32 * ks + 8 * kq);
        ws = __builtin_amdgcn_mfma_f32_16x16x32_bf16(f.wA[ks], sb, ws, 0, 0, 0);
        qs = __builtin_amdgcn_mfma_f32_16x16x32_bf16(f.qA[ks], sb, qs, 0, 0, 0);
    }
    float v0 = __uint_as_float(f.uC.x << 16) - ws[0], v1 = __uint_as_float(f.uC.x & 0xffff0000u) - ws[1];
    float v2 = __uint_as_float(f.uC.y << 16) - ws[2], v3 = __uint_as_float(f.uC.y & 0xffff0000u) - ws[3];
    *(uint2*)(vnT + n16 * VNS + 16 * w + 4 * kq) = make_uint2(pack2bf(v0, v1), pack2bf(v2, v3));
    __syncthreads();
    bf16x8 vb0 = *(const bf16x8*)(vnT + n16 * VNS + 8 * kq), vb1 = *(const bf16x8*)(vnT + n16 * VNS + 32 + 8 * kq);
    qs = __builtin_amdgcn_mfma_f32_16x16x32_bf16(f.inA[0], vb0, qs, 0, 0, 0);
    qs = __builtin_amdgcn_mfma_f32_16x16x32_bf16(f.inA[1], vb1, qs, 0, 0, 0);
    S0 = S0 * f.glv; S1 = S1 * f.glv;
    S0 = __builtin_amdgcn_mfma_f32_16x16x32_bf16(f.kdA[0][0], vb0, S0, 0, 0, 0);
    S0 = __builtin_amdgcn_mfma_f32_16x16x32_bf16(f.kdA[0][1], vb1, S0, 0, 0, 0);
    S1 = __builtin_amdgcn_mfma_f32_16x16x32_bf16(f.kdA[1][0], vb0, S1, 0, 0, 0);
    S1 = __builtin_amdgcn_mfma_f32_16x16x32_bf16(f.kdA[1][1], vb1, S1, 0, 0, 0);
#pragma unroll
    for (int r = 0; r < 4; r++) ogrow[(size_t)(4 * kq + r) * 512] = qs[r];
    *(uint2*)(StT + n16 * STS + 32 * w + 4 * kq) = make_uint2(pack2bf(S0[0], S0[1]), pack2bf(S0[2], S0[3]));
    *(uint2*)(StT + n16 * STS + 32 * w + 16 + 4 * kq) = make_uint2(pack2bf(S1[0], S1[1]), pack2bf(S1[2], S1[3]));
    __syncthreads();
}
__device__ __forceinline__ void d_gdn_scan2(const bf16_t* __restrict__ guT, const bf16_t* __restrict__ gw, const bf16_t* __restrict__ gqd,
                                            const bf16_t* __restrict__ gkdT, const bf16_t* __restrict__ gin, const float* __restrict__ gl,
                                            float* __restrict__ og, int item, char* smem) {
    bf16_t* StT = (bf16_t*)smem;
    bf16_t* vnT = StT + 16 * STS;
    const int tid = threadIdx.x, lane = tid & 63, w = tid >> 6, n16 = lane & 15, kq = lane >> 4;
    const int bh = item & 7, sl = item >> 3, b = bh >> 2, h = bh & 3;
    for (int i = tid; i < 16 * STS / 2; i += 256) ((unsigned*)StT)[i] = 0u;
    f32x4 S0 = (f32x4){0.f, 0.f, 0.f, 0.f}, S1 = (f32x4){0.f, 0.f, 0.f, 0.f};
    GdnFrag fa, fb;
    gdn_load_frag(fa, guT, gw, gqd, gkdT, gin, gl, bh * 128, w, sl, n16, kq);
    __syncthreads();
    float* obase = og + (size_t)(b * SEQ + 16 * w) * 512 + h * 128 + 16 * sl + n16;
#pragma unroll 1
    for (int n = 0; n < 128; n += 2) {
        gdn_load_frag(fb, guT, gw, gqd, gkdT, gin, gl, bh * 128 + n + 1, w, sl, n16, kq);
        gdn_step(fa, S0, S1, StT, vnT, obase + (size_t)(n * 64) * 512, w, n16, kq);
        if (n + 2 < 128) gdn_load_frag(fa, guT, gw, gqd, gkdT, gin, gl, bh * 128 + n + 2, w, sl, n16, kq);
        gdn_step(fb, S0, S1, StT, vnT, obase + (size_t)((n + 1) * 64) * 512, w, n16, kq);
    }
}

__device__ __forceinline__ void d_gdn_out(const float* __restrict__ og, const bf16_t* __restrict__ proj, const float* __restrict__ gain, bf16_t* __restrict__ mix, int t, int lane) {
    const float* o = og + (size_t)t * 512;
    const bf16_t* z = proj + (size_t)t * PLD + C_Z;
    float a[8], zz[8];
#pragma unroll
    for (int i = 0; i < 8; i++) { a[i] = o[lane + 64 * i]; zz[i] = bf2f(z[lane + 64 * i]); }
    const float g0 = gain[lane], g1 = gain[lane + 64];
#pragma unroll
    for (int h = 0; h < 4; h++) {
        const float ss = wave_sum_dpp(a[2 * h] * a[2 * h] + a[2 * h + 1] * a[2 * h + 1]);
        const float r = rsqrtf(ss * (1.f / 128.f) + 1e-6f);
        mix[(size_t)t * DM + 512 + h * 128 + lane] = f2bf(a[2 * h] * r * g0 * zz[2 * h] * sigmoidf_(zz[2 * h]));
        mix[(size_t)t * DM + 512 + h * 128 + lane + 64] = f2bf(a[2 * h + 1] * r * g1 * zz[2 * h + 1] * sigmoidf_(zz[2 * h + 1]));
    }
}

__device__ __forceinline__ void route_load_subkeys(const float* __restrict__ subkeys, char* smem) {
    for (int idx = threadIdx.x; idx < 2 * 128 * 16; idx += 256) {
        const int half = idx >> 11, key = (idx >> 4) & 127, ch = idx & 15;
        const float* src = subkeys + ((size_t)(half * 128 + key)) * 128 + ch * 8;
        const float4 x0 = *(const float4*)src, x1 = *(const float4*)(src + 4);
        *(uint4*)(smem + half * 32768 + key * 256 + ((ch ^ (key & 15)) << 4)) = make_uint4(pk2(x0.x, x0.y), pk2(x0.z, x0.w), pk2(x1.x, x1.y), pk2(x1.z, x1.w));
    }
}
#define CEX(i, j) { const float _a = v[i], _b = v[j]; v[i] = fmaxf(_a, _b); v[j] = fminf(_a, _b); }
__device__ __forceinline__ void d_peer_route2(const bf16_t* __restrict__ qry, int* __restrict__ eidx, float* __restrict__ pgate, int mtile, const char* smem, int lane) {
    const int n16 = lane & 15, kq = lane >> 4;
    const int tA = 2 * mtile + (n16 >> 3), hA = n16 & 7;
    float topv[2][4];
#pragma unroll
    for (int half = 0; half < 2; half++) {
        const bf16_t* qp = qry + (size_t)tA * 2048 + hA * 256 + half * 128 + 8 * kq;
        bf16x8 a[4];
#pragma unroll
        for (int ks = 0; ks < 4; ks++) a[ks] = *(const bf16x8*)(qp + 32 * ks);
        f32x4 acc[8];
#pragma unroll
        for (int nt = 0; nt < 8; nt++) acc[nt] = (f32x4){0.f, 0.f, 0.f, 0.f};
#pragma unroll
        for (int ks = 0; ks < 4; ks++)
#pragma unroll
            for (int nt = 0; nt < 8; nt++) {
                const bf16x8 bb = *(const bf16x8*)(smem + half * 32768 + (16 * nt + n16) * 256 + (((4 * ks + kq) ^ n16) << 4));
                acc[nt] = __builtin_amdgcn_mfma_f32_16x16x32_bf16(a[ks], bb, acc[nt], 0, 0, 0);
                if (nt == 3 || nt == 7) __builtin_amdgcn_sched_barrier(0);
            }
#pragma unroll
        for (int r = 0; r < 4; r++) {
            float v[8];
#pragma unroll
            for (int nt = 0; nt < 8; nt++) v[nt] = __uint_as_float((__float_as_uint(acc[nt][r]) & 0xFFFFFF80u) | (unsigned)(nt << 4) | (unsigned)n16);
            CEX(0, 1) CEX(2, 3) CEX(4, 5) CEX(6, 7) CEX(0, 2) CEX(1, 3) CEX(4, 6) CEX(5, 7) CEX(1, 2) CEX(5, 6)
            CEX(0, 4) CEX(1, 5) CEX(2, 6) CEX(3, 7) CEX(2, 4) CEX(3, 5) CEX(1, 2) CEX(3, 4) CEX(5, 6)
            float keep = 0.f;
#pragma unroll 1
            for (int it = 0; it < 16; it++) {
                const float mx = allmax16(v[0]);
                if (n16 == it) keep = mx;
                if (__float_as_uint(v[0]) == __float_as_uint(mx)) {
                    v[0] = v[1]; v[1] = v[2]; v[2] = v[3]; v[3] = v[4]; v[4] = v[5]; v[5] = v[6]; v[6] = v[7]; v[7] = -3e38f;
                }
            }
            topv[half][r] = keep;
            __builtin_amdgcn_sched_barrier(0);
        }
    }
#pragma unroll
    for (int r = 0; r < 4; r++) {
        const float v1p = topv[0][r], v2p = topv[1][r];
        const unsigned u1 = __float_as_uint(v1p);
        const int i1 = (int)(((u1 >> 4) & 7u) * 16u + (u1 & 15u));
        const int lim = 16 / (n16 + 1);
        int ptr = 0;
        const int lanebase = (lane & 48);
        float cur2 = __builtin_bit_cast(float, __builtin_amdgcn_ds_bpermute(lanebase * 4, __builtin_bit_cast(int, v2p)));
        float head = __uint_as_float((__float_as_uint(v1p + cur2) & 0xFFFFFFF0u) | (unsigned)n16);
        float ksc = 0.f; unsigned ke = 0u;
#pragma unroll 1
        for (int it = 0; it < 16; it++) {
            const float mx = allmax16(head);
            const bool win = __float_as_uint(head) == __float_as_uint(mx);
            const unsigned u2 = __float_as_uint(cur2);
            unsigned e = win ? (unsigned)(i1 * 128) + ((u2 >> 4) & 7u) * 16u + (u2 & 15u) : 0u;
            e = allmaxu16(e);
            if (n16 == it) { ksc = mx; ke = e; }
            if (win) ptr++;
            const int pn = ptr < 15 ? ptr : 15;
            const float nx = __builtin_bit_cast(float, __builtin_amdgcn_ds_bpermute((lanebase + pn) * 4, __builtin_bit_cast(int, v2p)));
            if (win) { cur2 = nx; head = (ptr < lim) ? __uint_as_float((__float_as_uint(v1p + cur2) & 0xFFFFFFF0u) | (unsigned)n16) : -3e38f; }
        }
        const float smax = allmax16(ksc);
        const float ex = __expf(ksc - smax);
        const float sum = allsum16(ex);
        const int row = 4 * kq + r;
        const size_t o = (size_t)(2 * mtile + (row >> 3)) * 128 + (row & 7) * 16 + n16;
        eidx[o] = (int)ke; pgate[o] = ex / sum;
    }
}
#undef CEX

#define XB_TMO      128
#define XB_XCNT(j)  (256  + 64 * (j))
#define XB_XSUB(j)  (1280 + 64 * (j))
#define XB_XGEN(j)  (2304 + 64 * (j))
#define XB_TOP      3328
#define XB_TOPGEN   3392
#define XB_QUEUE    3456
#define XL_CNT(j)    (4096 + 64 * (j))
#define XL_GEN(j)    (5120 + 64 * (j))
#define XCD_BAR_WORDS 6144
#define XB_SPIN_CAP (1u << 22)
#define LAS __attribute__((address_space(3)))
__device__ __forceinline__ unsigned xb_ld(unsigned* p)              { return __hip_atomic_load(p, __ATOMIC_RELAXED, __HIP_MEMORY_SCOPE_AGENT); }
__device__ __forceinline__ unsigned xb_add(unsigned* p, unsigned v) { return __hip_atomic_fetch_add(p, v, __ATOMIC_RELAXED, __HIP_MEMORY_SCOPE_AGENT); }
__device__ __forceinline__ unsigned xb_xcc_id() { return (unsigned)__builtin_amdgcn_s_getreg((3 << 11) | 20) & 0xFu; }
#define XB_SPIN(cond, bar) do { unsigned _sp = 0; while (cond) { __builtin_amdgcn_s_sleep(1); \
    if ((++_sp & 255u) == 0u) { if (xb_ld(&(bar)[XB_TMO])) break; if (_sp > XB_SPIN_CAP) { atomicAdd(&(bar)[XB_TMO], 1u); break; } } } } while (0)
struct XcdBarrier { unsigned* bar; unsigned x; volatile LAS unsigned* st; };
__device__ __forceinline__ XcdBarrier xcd_barrier_post(unsigned* bar, volatile LAS unsigned* st) {
    XcdBarrier b; b.bar = bar; b.x = xb_xcc_id(); b.st = st;
    if (threadIdx.x == 0) (void)xb_add(&bar[XB_XCNT(b.x)], 1u);
    return b;
}
__device__ __forceinline__ void xcd_barrier_complete(unsigned* bar, unsigned x, unsigned& nloc, unsigned& nx) {
    const unsigned G = gridDim.x * gridDim.y * gridDim.z;
    unsigned sum, cnt, mine, sp = 0u;
    for (;;) {
        sum = 0u; cnt = 0u; mine = 0u;
#pragma unroll
        for (unsigned j = 0; j < 16; ++j) { const unsigned c = xb_ld(&bar[XB_XCNT(j)]); sum += c; cnt += (c > 0u) ? 1u : 0u; mine = (j == x) ? c : mine; }
        if (sum == G) break;
        __builtin_amdgcn_s_sleep(1);
        if ((++sp & 255u) == 0u) { if (xb_ld(&bar[XB_TMO])) break; if (sp > XB_SPIN_CAP) { atomicAdd(&bar[XB_TMO], 1u); break; } }
    }
    nloc = mine > 0u ? mine : 1u; nx = cnt > 0u ? cnt : 1u;
}
__device__ __forceinline__ void xcd_barrier(const XcdBarrier& b) {
    asm volatile("s_waitcnt vmcnt(0)" ::: "memory");
    __syncthreads();
    if (threadIdx.x == 0) {
        unsigned* bar = b.bar;
        __builtin_amdgcn_s_waitcnt(0);
        unsigned nloc = b.st[0], nx = b.st[1];
        if (nloc == 0u) { xcd_barrier_complete(bar, b.x, nloc, nx); b.st[0] = nloc; b.st[1] = nx; }
        const unsigned old = xb_add(&bar[XB_XSUB(b.x)], 1u);
        const unsigned gen = old / nloc;
        if (old + 1u == (gen + 1u) * nloc) {
            __builtin_amdgcn_fence(__ATOMIC_RELEASE, "agent");
            asm volatile("s_waitcnt vmcnt(0)" ::: "memory");
            const unsigned og = xb_add(&bar[XB_TOP], 1u);
            const unsigned tg = og / nx;
            if (og + 1u == (tg + 1u) * nx) xb_add(&bar[XB_TOPGEN], 1u);
            else XB_SPIN(xb_ld(&bar[XB_TOPGEN]) == tg, bar);
            __builtin_amdgcn_fence(__ATOMIC_ACQUIRE, "agent");
            xb_add(&bar[XB_XGEN(b.x)], 1u);
            asm volatile("s_waitcnt vmcnt(0)" ::: "memory");
        } else {
            XB_SPIN(xb_ld(&bar[XB_XGEN(b.x)]) == gen, bar);
            __builtin_amdgcn_fence(__ATOMIC_ACQUIRE, "agent");
            asm volatile("s_waitcnt vmcnt(0)" ::: "memory");
        }
    }
    __syncthreads();
}

__device__ __forceinline__ void xcd_local_sync(const XcdBarrier& b, unsigned round) {
    __syncthreads();
    if (threadIdx.x == 0) {
        unsigned nloc = b.st[0]; if (nloc == 0u) nloc = 1u;
        const unsigned old = xb_add(&b.bar[XL_CNT(b.x)], 1u);
        if (old + 1u == nloc * (round + 1u)) xb_add(&b.bar[XL_GEN(b.x)], 1u);
        else { unsigned sp = 0; while (xb_ld(&b.bar[XL_GEN(b.x)]) <= round && ++sp < (1u << 16)) __builtin_amdgcn_s_sleep(1); }
    }
    __syncthreads();
}

__device__ __forceinline__ void d_quant_row(const float* __restrict__ src, unsigned char* __restrict__ dst, float* __restrict__ scale, int row, int lane, int bias) {
    const float4* p = (const float4*)(src + (size_t)row * DM) + lane * 4;
    float4 x[4];
    float am = 0.f;
#pragma unroll
    for (int i = 0; i < 4; i++) { x[i] = p[i]; am = fmaxf(am, fmaxf(fmaxf(fabsf(x[i].x), fabsf(x[i].y)), fmaxf(fabsf(x[i].z), fabsf(x[i].w)))); }
    am = wave_max(am);
    const float sc = (am > 0.f) ? am * (1.f / 127.f) : 1.f;
    const float inv = 1.f / sc;
    unsigned wv[4];
#pragma unroll
    for (int i = 0; i < 4; i++) {
        const int q0 = (int)rintf(x[i].x * inv) + bias, q1 = (int)rintf(x[i].y * inv) + bias, q2 = (int)rintf(x[i].z * inv) + bias, q3 = (int)rintf(x[i].w * inv) + bias;
        wv[i] = (unsigned)(q0 & 0xff) | ((unsigned)(q1 & 0xff) << 8) | ((unsigned)(q2 & 0xff) << 16) | ((unsigned)(q3 & 0xff) << 24);
    }
    ((uint4*)(dst + (size_t)row * (2 * DM)))[lane] = make_uint4(wv[0], wv[1], wv[2], wv[3]);
    if (lane == 0) scale[row] = sc;
}

struct PeerGrp { u32x4 u[4]; u32x4 v[4]; float gv[4]; float su[4]; };
__device__ __forceinline__ void peer_load(PeerGrp& G, const unsigned char* __restrict__ uq, const unsigned char* __restrict__ vq,
                                          int esrc, float gsrc, float susrc, int k0, int lane) {
#pragma unroll
    for (int i = 0; i < 4; i++) {
        const int e = __builtin_amdgcn_readlane(esrc, (k0 + i) & 63);
        G.gv[i] = __builtin_bit_cast(float, __builtin_amdgcn_readlane(__builtin_bit_cast(int, gsrc), (k0 + i) & 63));
        G.su[i] = __builtin_bit_cast(float, __builtin_amdgcn_readlane(__builtin_bit_cast(int, susrc), (k0 + i) & 63));
        G.u[i] = ((const u32x4*)(uq + (size_t)e * (2 * DM)))[lane];
        G.v[i] = ((const u32x4*)(uq + (size_t)e * (2 * DM) + DM))[lane];
    }
}
__device__ __forceinline__ void peer_compute(const PeerGrp& G, const int (&xq)[4], float sx, float (&acc)[16], float& bsum) {
    int d[4];
#pragma unroll
    for (int i = 0; i < 4; i++) {
        int sdot = 0;
        sdot = __builtin_amdgcn_sdot4((int)G.u[i][0], xq[0], sdot, false); sdot = __builtin_amdgcn_sdot4((int)G.u[i][1], xq[1], sdot, false);
        sdot = __builtin_amdgcn_sdot4((int)G.u[i][2], xq[2], sdot, false); sdot = __builtin_amdgcn_sdot4((int)G.u[i][3], xq[3], sdot, false);
        d[i] = sdot;
    }
#pragma unroll
    for (int i = 0; i < 4; i++) {
        int x = d[i];
        x += (int)dppu<0xB1>((unsigned)x); x += (int)dppu<0x4E>((unsigned)x); x += (int)dppu<0x141>((unsigned)x); x += (int)dppu<0x140>((unsigned)x);
        d[i] = __builtin_amdgcn_readlane(x, 0) + __builtin_amdgcn_readlane(x, 16) + __builtin_amdgcn_readlane(x, 32) + __builtin_amdgcn_readlane(x, 48);
    }
#pragma unroll
    for (int i = 0; i < 4; i++) {
        const float dot = (float)d[i] * (G.su[i] * sx);
        const float u2 = 1.5957691216057308f * (dot + 0.044715f * dot * dot * dot);
        const float cs = G.gv[i] * dot * __builtin_amdgcn_rcpf(1.f + __expf(-u2));
        bsum += cs;
        const f32x2 cs2 = (f32x2){cs, cs};
#pragma unroll
        for (int j = 0; j < 4; j++) {
            const unsigned wv = G.v[i][j];
            const f32x2 lo = (f32x2){(float)(wv & 0xffu), (float)((wv >> 8) & 0xffu)}, hi = (f32x2){(float)((wv >> 16) & 0xffu), (float)(wv >> 24)};
            f32x2 a0 = (f32x2){acc[4 * j], acc[4 * j + 1]}, a1 = (f32x2){acc[4 * j + 2], acc[4 * j + 3]};
            a0 = __builtin_elementwise_fma(cs2, lo, a0); a1 = __builtin_elementwise_fma(cs2, hi, a1);
            acc[4 * j] = a0[0]; acc[4 * j + 1] = a0[1]; acc[4 * j + 2] = a1[0]; acc[4 * j + 3] = a1[1];
        }
    }
}
struct PeerTok { int xq[4]; float sx; int e_lo, e_hi; float g_lo, g_hi, s_lo, s_hi; };
__device__ __forceinline__ void peer_prep_token(PeerTok& T, const bf16_t* __restrict__ h2, const int* __restrict__ eidx, const float* __restrict__ pgate,
                                                const float* __restrict__ su, const float* __restrict__ sv, const float* __restrict__ ssq, const float* __restrict__ fgain, int token, int lane) {
    const uint4 xa = ((const uint4*)(h2 + (size_t)token * DM))[2 * lane], xb = ((const uint4*)(h2 + (size_t)token * DM))[2 * lane + 1];
    const unsigned xw[8] = {xa.x, xa.y, xa.z, xa.w, xb.x, xb.y, xb.z, xb.w};
    float xf[16];
    float am = 0.f;
    const float rr = rsqrtf(allsum16(ssq[(size_t)token * 16 + (lane & 15)]) * (1.f / DM) + 1e-6f);
    const float4* gp = (const float4*)(fgain + lane * 16);
    const float4 ga = gp[0], gb = gp[1], gc = gp[2], gd = gp[3];
    const float gg[16] = {ga.x, ga.y, ga.z, ga.w, gb.x, gb.y, gb.z, gb.w, gc.x, gc.y, gc.z, gc.w, gd.x, gd.y, gd.z, gd.w};
#pragma unroll
    for (int j = 0; j < 8; j++) {
        xf[2 * j] = __uint_as_float(xw[j] << 16) * rr * gg[2 * j]; xf[2 * j + 1] = __uint_as_float(xw[j] & 0xffff0000u) * rr * gg[2 * j + 1];
        am = fmaxf(am, fmaxf(fabsf(xf[2 * j]), fabsf(xf[2 * j + 1])));
    }
    am = wave_max(am);
    T.sx = (am > 0.f) ? am * (1.f / 127.f) : 1.f;
    const float isx = 1.f / T.sx;
#pragma unroll
    for (int j = 0; j < 4; j++) {
        const int q0 = (int)rintf(xf[4 * j] * isx), q1 = (int)rintf(xf[4 * j + 1] * isx), q2 = (int)rintf(xf[4 * j + 2] * isx), q3 = (int)rintf(xf[4 * j + 3] * isx);
        T.xq[j] = (int)((unsigned)(q0 & 0xff) | ((unsigned)(q1 & 0xff) << 8) | ((unsigned)(q2 & 0xff) << 16) | ((unsigned)(q3 & 0xff) << 24));
    }
    int e_lo = eidx[(size_t)token * 128 + lane], e_hi = eidx[(size_t)token * 128 + 64 + lane];
    float g_lo = pgate[(size_t)token * 128 + lane], g_hi = pgate[(size_t)token * 128 + 64 + lane];
    {
        unsigned long long ka = ((unsigned long long)(unsigned)e_lo << 32) | __float_as_uint(g_lo), kb = ((unsigned long long)(unsigned)e_hi << 32) | __float_as_uint(g_hi);
#pragma unroll
        for (int k = 2; k <= 128; k <<= 1) {
#pragma unroll
            for (int j = k >> 1; j > 0; j >>= 1) {
                if (j == 64) { const unsigned long long mn = ka < kb ? ka : kb, mx = ka < kb ? kb : ka; ka = mn; kb = mx; }
                else {
                    const unsigned long long pa = ((unsigned long long)(unsigned)__shfl_xor((int)(ka >> 32), j) << 32) | (unsigned)__shfl_xor((int)ka, j);
                    const unsigned long long pb = ((unsigned long long)(unsigned)__shfl_xor((int)(kb >> 32), j) << 32) | (unsigned)__shfl_xor((int)kb, j);
                    const bool lower = (lane & j) == 0;
                    const bool dirA = (lane & k) == 0, dirB = ((lane + 64) & k) == 0;
                    ka = ((lower == dirA) == (ka < pa)) ? ka : pa;
                    kb = ((lower == dirB) == (kb < pb)) ? kb : pb;
                }
            }
        }
        e_lo = (int)(ka >> 32); g_lo = __uint_as_float((unsigned)ka); e_hi = (int)(kb >> 32); g_hi = __uint_as_float((unsigned)kb);
    }
    T.e_lo = e_lo; T.e_hi = e_hi;
    T.g_lo = g_lo * sv[e_lo]; T.g_hi = g_hi * sv[e_hi];
    T.s_lo = su[e_lo]; T.s_hi = su[e_hi];
}
__device__ __forceinline__ void peer_store(float* __restrict__ out, int token, int lane, const float (&acc)[16], float bsum) {
    const float bs = 128.f * bsum;
    float4* o = (float4*)(out + (size_t)token * DM + lane * 16);
#pragma unroll
    for (int j = 0; j < 4; j++) {
        float4 t = o[j];
        t.x += acc[4 * j] - bs; t.y += acc[4 * j + 1] - bs; t.z += acc[4 * j + 2] - bs; t.w += acc[4 * j + 3] - bs;
        o[j] = t;
    }
}
__device__ __forceinline__ int peer_key(const PeerTok& T, int g) {
    const int idx = 4 * g;
    return (idx < 64) ? __builtin_amdgcn_readlane(T.e_lo, idx & 63) : __builtin_amdgcn_readlane(T.e_hi, idx & 63);
}
__device__ __forceinline__ void peer_load_grp(PeerGrp& G, const PeerTok& T, int g, const unsigned char* __restrict__ uq, int lane) {
    const int idx = 4 * g;
    if (idx < 64) peer_load(G, uq, uq, T.e_lo, T.g_lo, T.s_lo, idx, lane); else peer_load(G, uq, uq, T.e_hi, T.g_hi, T.s_hi, idx - 64, lane);
}
__device__ __forceinline__ void d_peer_expert_pair(const bf16_t* __restrict__ h2, const int* __restrict__ eidx, const float* __restrict__ pgate,
                                                   const unsigned char* __restrict__ uq, const float* __restrict__ su, const float* __restrict__ sv,
                                                   const float* __restrict__ ssq, const float* __restrict__ fgain, float* __restrict__ out,
                                                   int tokA, int lane, const XcdBarrier& xbar, unsigned midround) {
    PeerTok TA, TB;
    peer_prep_token(TA, h2, eidx, pgate, su, sv, ssq, fgain, tokA, lane);
    peer_prep_token(TB, h2, eidx, pgate, su, sv, ssq, fgain, tokA + 1, lane);
    float accA[16], accB[16];
#pragma unroll
    for (int i = 0; i < 16; i++) { accA[i] = 0.f; accB[i] = 0.f; }
    float bsA = 0.f, bsB = 0.f;
    int gA = 0, gB = 0;
#define PEER_PICK(f) { if (gA >= 32) f = 1; else if (gB >= 32) f = 0; else f = (peer_key(TA, gA) <= peer_key(TB, gB)) ? 0 : 1; }
#define PEER_LOAD(S, f) { if (f) { peer_load_grp(S, TB, gB, uq, lane); gB++; } else { peer_load_grp(S, TA, gA, uq, lane); gA++; } }
#define PEER_COMP(S, f) { if (f) peer_compute(S, TB.xq, TB.sx, accB, bsB); else peer_compute(S, TA.xq, TA.sx, accA, bsA); }
    PeerGrp S0, S1;
    int f0, f1;
    PEER_PICK(f0) PEER_LOAD(S0, f0)
#pragma unroll 1
    for (int step = 0; step < 64; step += 2) {
        PEER_PICK(f1) PEER_LOAD(S1, f1)
        PEER_COMP(S0, f0)
        if (step + 2 < 64) { PEER_PICK(f0) PEER_LOAD(S0, f0) }
        PEER_COMP(S1, f1)
        if (step == 30) xcd_local_sync(xbar, midround);
    }
#undef PEER_PICK
#undef PEER_LOAD
#undef PEER_COMP
    peer_store(out, tokA, lane, accA, bsA);
    peer_store(out, tokA + 1, lane, accB, bsB);
}

struct MKP {
    const float *x, *attn_norm, *w_in, *q_gain, *k_gain, *cmp_pos, *cmp_w1, *cmp_w2, *gdn_conv, *a_log, *dt_bias, *out_gain, *w_out, *ffn_norm, *w_query, *subkeys, *peer_u, *peer_v;
    float* out; char* ws; unsigned* bar;
};

#define SMEM_BYTES 70144

__global__ __launch_bounds__(256, 2) void hybrid_megakernel(MKP P) {
    extern __shared__ __attribute__((aligned(16))) char smem[];
    __shared__ uint4 xb_words;
    __shared__ int q_item;
    const int G = gridDim.x, bid0 = blockIdx.x;
    if (threadIdx.x == 0) xb_words = make_uint4(0u, 0u, 0u, 0u);
    __syncthreads();
    XcdBarrier B = xcd_barrier_post(P.bar, (volatile LAS unsigned*)&xb_words);
    char* ws = P.ws;
    bf16_t* w_in_t = (bf16_t*)(ws + OFF_WINT);
    bf16_t* w_out_t = (bf16_t*)(ws + OFF_WOUTT);
    bf16_t* w_q_t = (bf16_t*)(ws + OFF_WQT);
    bf16_t* cw1_t = (bf16_t*)(ws + OFF_CW1T);
    float* cbias = (float*)(ws + OFF_CBIAS);
    bf16_t* h_bf = (bf16_t*)(ws + OFF_HBF);
    bf16_t* proj = (bf16_t*)(ws + OFF_PROJ);
    bf16_t* ksn = (bf16_t*)(ws + OFF_KSN);
    bf16_t* kwn = (bf16_t*)(ws + OFF_KWN);
    bf16_t* kc = (bf16_t*)(ws + OFF_KC);
    bf16_t* vc = (bf16_t*)(ws + OFF_VC);
    bf16_t* hid = (bf16_t*)(ws + OFF_HID);
    bf16_t* gu = (bf16_t*)(ws + OFF_GU);
    bf16_t* gw = (bf16_t*)(ws + OFF_GW);
    bf16_t* gqd = (bf16_t*)(ws + OFF_GQD);
    bf16_t* gkd = (bf16_t*)(ws + OFF_GKD);
    bf16_t* gin = (bf16_t*)(ws + OFF_GIN);
    float* gl = (float*)(ws + OFF_GL);
    bf16_t* mix = (bf16_t*)(ws + OFF_MIX);
    bf16_t* qry = (bf16_t*)(ws + OFF_QRY);
    bf16_t* h2 = (bf16_t*)(ws + OFF_H2);
    int* eidx = (int*)(ws + OFF_EIDX);
    float* pgate = (float*)(ws + OFF_PGATE);
    unsigned char* uq = (unsigned char*)(ws + OFF_UQ);
    unsigned char* vq = (unsigned char*)(ws + OFF_VQ);
    float* su = (float*)(ws + OFF_SU);
    float* sv = (float*)(ws + OFF_SV);
    float* og = P.out;
    float2* rope = (float2*)(ws + OFF_ROPE);
    float* ssq = (float*)(ws + OFF_SSQ);
    bf16_t* vsn = (bf16_t*)(ws + OFF_VSN);
    bf16_t* vwn = (bf16_t*)(ws + OFF_VWN);
    bf16_t* cw2t = (bf16_t*)(ws + OFF_CW2T);
    unsigned char* uq_tmp = (unsigned char*)(P.out + 8388608);
    unsigned char* vq_tmp = uq_tmp + 16384ull * 1024;

    {
        const int n1 = 108 * 8, n2 = n1 + 32 * 8, n3 = n2 + 64 * 8, n4 = n3 + 2 * 8 * 16, n5 = n4 + 2 * 2 * 2;
        for (int it = bid0; it < n5; it += G) {
            if (it < n1) d_transpose_bf16(P.w_in, 1024, IN_COLS, w_in_t, it % 108, it / 108, smem);
            else if (it < n2) { int r = it - n1; d_transpose_bf16(P.w_out, 1024, 1024, w_out_t, r % 32, r / 32, smem); }
            else if (it < n3) { int r = it - n2; d_transpose_bf16(P.w_query, 1024, 2048, w_q_t, r % 64, r / 64, smem, P.ffn_norm); }
            else if (it < n4) { int r = it - n3; int j = r >> 7; r &= 127; d_transpose_bf16(P.cmp_w1 + (size_t)j * 2048 * 256, 2048, 256, cw1_t + (size_t)j * 256 * 2048, r % 8, r / 8, smem); }
            else { int r = it - n4; int j = r >> 2; r &= 3; d_transpose_bf16(P.cmp_w2 + (size_t)j * 256 * 64, 256, 64, cw2t + (size_t)j * 64 * 256, r % 2, r / 2, smem); }
        }
        for (int it = bid0; it < 16; it += G) d_cmp_bias(P.cmp_pos, P.cmp_w1, cbias, it, smem);
        for (int it = bid0; it < T_TOK / 4; it += G) d_rmsnorm_bf16(P.x, P.attn_norm, h_bf, it);
        for (int i = bid0 * 256 + threadIdx.x; i < 8192 * 32; i += G * 256) {
            const int pos = i >> 5, fi = i & 31;
            float sn, cs; sincosf((float)pos * expf(-9.210340371976184f * (float)(2 * fi) / 64.f), &sn, &cs);
            rope[i] = make_float2(cs, sn);
        }
        for (int i = bid0 * 256 + threadIdx.x; i < 32 * PLD / 2; i += G * 256) ((unsigned*)(proj + (size_t)T_TOK * PLD))[i] = 0u;
    }
    xcd_barrier(B);
    {
        GemmP p{}; p.A = h_bf; p.lda = 1024; p.akts = 64; p.Bt = w_in_t; p.ldb = 1024; p.K = 1024; p.mtiles = 128; p.ntiles = 27; p.out = proj;
        for (int it = bid0; it < 128 * 27; it += G) d_gemm<EPI_PROJ>(p, it, smem);
    }
    xcd_barrier(B);
    {
        for (int it = bid0; it < 64; it += G) {
            int inst = it >> 3, tile = it & 7;
            int j = inst >> 2, b = (inst >> 1) & 1, g = inst & 1;
            GemmP p{}; p.A = proj + (size_t)(b * SEQ) * PLD + C_KV + 128 * j + 64 * g; p.lda = 16 * PLD; p.akts = PLD;
            p.Bt = cw1_t + (size_t)j * 256 * 2048; p.ldb = 2048; p.K = 2048; p.mtiles = 4; p.ntiles = 2;
            p.out = hid + (size_t)inst * 512 * 256; p.aux = cbias + j * 256;
            d_gemm<EPI_HID>(p, tile, smem);
        }
        for (;;) {
            if (threadIdx.x == 0) q_item = (int)xb_add(&P.bar[XB_QUEUE + 64], 1u);
            __syncthreads();
            const int it = q_item;
            __syncthreads();
            if (it >= 1024) break;
            d_gdn_prep2(proj, P.gdn_conv, P.a_log, P.dt_bias, gu, gw, gqd, gkd, gin, gl, it, smem); __syncthreads();
        }
        for (;;) {
            if (threadIdx.x == 0) q_item = (int)xb_add(&P.bar[XB_QUEUE + 128], 1u);
            __syncthreads();
            const int it = q_item;
            __syncthreads();
            if (it >= 1024) break;
            for (int k8 = 0; k8 < 8; k8++) d_knorm_rope(proj, P.k_gain, ksn, kwn, vsn, vwn, rope, it * 8 + k8);
        }
    }
    xcd_barrier(B);
    for (int wi = bid0 * 4 + (threadIdx.x >> 6); wi < 256; wi += G * 4) d_cmp2_mfma(hid, cw2t, P.k_gain, rope, kc, vc, wi, threadIdx.x & 63);
    xcd_barrier(B);
    {
        if (bid0 < 64) d_gdn_scan2(gu, gw, gqd, gkd, gin, gl, og, bid0, smem);
        __syncthreads();
        const int rep = 0;
        for (;;) {
            if (threadIdx.x == 0) q_item = (int)xb_add(&P.bar[XB_QUEUE + 256 * rep], 1u);
            __syncthreads();
            const int it = q_item;
            if (it >= 1024 + 128) break;
            if (it >= 1024) {
                const int r0 = (it - 1024) * 128 + (threadIdx.x >> 6) * 32;
                for (int r = r0; r < r0 + 32; r++) { d_quant_row(P.peer_u, uq_tmp, su, r, threadIdx.x & 63, 0); d_quant_row(P.peer_v, uq_tmp + DM, sv, r, threadIdx.x & 63, 128); }
            } else {
                d_nsa_mfma(proj, P.q_gain, rope, ksn, kwn, kc, vc, vsn, vwn, mix, DM, it, smem);
            }
            __syncthreads();
        }
    }
    xcd_barrier(B);
    for (int t = bid0 * 4 + (threadIdx.x >> 6); t < T_TOK; t += G * 4) d_gdn_out(og, proj, P.out_gain, mix, t, threadIdx.x & 63);
    for (int i = bid0 * 256 + threadIdx.x; i < 2 * 16384 * 1024 / 16; i += G * 256) ((uint4*)uq)[i] = ((const uint4*)uq_tmp)[i];
    xcd_barrier(B);
    {
        GemmP p{}; p.A = mix; p.lda = 1024; p.akts = 64; p.Bt = w_out_t; p.ldb = 1024; p.K = 1024; p.mtiles = 128; p.ntiles = 8; p.out = P.out; p.aux = P.x; p.out2 = h2; p.ssq = ssq;
        for (int it = bid0; it < 128 * 8; it += G) d_gemm<EPI_OUT>(p, it, smem);
    }
    xcd_barrier(B);
    {
        GemmP p{}; p.A = h2; p.lda = 1024; p.akts = 64; p.Bt = w_q_t; p.ldb = 1024; p.K = 1024; p.mtiles = 128; p.ntiles = 16; p.out = qry; p.ssq = ssq;
        for (int it = bid0; it < 128 * 16; it += G) d_gemm<EPI_QRY>(p, it, smem);
    }
    xcd_barrier(B);
    route_load_subkeys(P.subkeys, smem);
    __syncthreads();
    for (int mt = bid0 * 4 + (threadIdx.x >> 6); mt < T_TOK / 2; mt += G * 4) d_peer_route2(qry, eidx, pgate, mt, smem, threadIdx.x & 63);
    xcd_barrier(B);
    {
        const int rounds = (T_TOK / 8 + G - 1) / G;
        for (int rd = 0; rd < rounds; rd++) {
            xcd_local_sync(B, (unsigned)(2 * rd));
            const int it = rd * G + bid0;
            if (it < T_TOK / 8) d_peer_expert_pair(h2, eidx, pgate, uq, su, sv, ssq, P.ffn_norm, P.out, it * 8 + 2 * (threadIdx.x >> 6), threadIdx.x & 63, B, (unsigned)(2 * rd + 1));
            else xcd_local_sync(B, (unsigned)(2 * rd + 1));
        }
    }
}

extern "C" void kernel_launch(void* const* d_in, const int* in_sizes, int n_in, void* d_out, int out_size, void* d_ws, size_t ws_size,
                              hipStream_t stream) {
    const size_t bar_off = (OFF_END + 255) & ~(size_t)255;
    if (ws_size < bar_off + XCD_BAR_WORDS * 4) return;
    static int grid_blocks = 0;
    if (!grid_blocks) {
        int dev = 0, cus = 0, per_cu = 0;
        (void)hipGetDevice(&dev);
        (void)hipDeviceGetAttribute(&cus, hipDeviceAttributeMultiprocessorCount, dev);
        (void)hipFuncSetAttribute((const void*)hybrid_megakernel, hipFuncAttributeMaxDynamicSharedMemorySize, SMEM_BYTES);
        (void)hipOccupancyMaxActiveBlocksPerMultiprocessor(&per_cu, hybrid_megakernel, 256, SMEM_BYTES);
        if (per_cu > 2) per_cu = 2;
        grid_blocks = cus * per_cu;
    }
    if (grid_blocks <= 0) return;
    MKP P{};
    P.x = (const float*)d_in[0]; P.attn_norm = (const float*)d_in[1]; P.w_in = (const float*)d_in[2]; P.q_gain = (const float*)d_in[3];
    P.k_gain = (const float*)d_in[4]; P.cmp_pos = (const float*)d_in[5]; P.cmp_w1 = (const float*)d_in[6]; P.cmp_w2 = (const float*)d_in[7];
    P.gdn_conv = (const float*)d_in[8]; P.a_log = (const float*)d_in[9]; P.dt_bias = (const float*)d_in[10]; P.out_gain = (const float*)d_in[11];
    P.w_out = (const float*)d_in[12]; P.ffn_norm = (const float*)d_in[13]; P.w_query = (const float*)d_in[14]; P.subkeys = (const float*)d_in[15];
    P.peer_u = (const float*)d_in[16]; P.peer_v = (const float*)d_in[17];
    P.out = (float*)d_out; P.ws = (char*)d_ws; P.bar = (unsigned*)((char*)d_ws + bar_off);
    (void)hipMemsetAsync(P.bar, 0, XCD_BAR_WORDS * 4, stream);
    hipLaunchKernelGGL(hybrid_megakernel, dim3(grid_blocks), dim3(256), SMEM_BYTES, stream, P);
}
```

```cpp
#include <hip/hip_runtime.h>
#include <stdint.h>

typedef unsigned short bf16_t;
typedef __attribute__((ext_vector_type(8))) short bf16x8;
typedef __attribute__((ext_vector_type(4))) float f32x4;
typedef __attribute__((ext_vector_type(2))) float f32x2;
#define LAS3 __attribute__((address_space(3)))

#define T_TOK 16384
#define SEQ 8192
#define DM 1024
#define IN_COLS 3360
#define PLD 3456
#define C_Q 0
#define C_KV 512
#define C_GATE 1280
#define C_GQKV 1304
#define C_Z 2840
#define C_A 3352
#define C_B 3356

#define OFF_WINT   0ull
#define OFF_WOUTT  (OFF_WINT  + 3456ull*1024*2)
#define OFF_WQT    (OFF_WOUTT + 1024ull*1024*2)
#define OFF_CW1T   (OFF_WQT   + 2048ull*1024*2)
#define OFF_CBIAS  (OFF_CW1T  + 2ull*256*2048*2)
#define OFF_HBF    (OFF_CBIAS + 4096ull)
#define OFF_PROJ   (OFF_HBF   + 16384ull*1024*2)
#define OFF_KSN    (OFF_PROJ  + (16384ull+32)*PLD*2)
#define OFF_KWN    (OFF_KSN   + 4ull*8192*64*2)
#define OFF_KC     (OFF_KWN   + 4ull*8192*64*2)
#define OFF_VC     (OFF_KC    + 4ull*512*64*2)
#define OFF_HID    (OFF_VC    + 4ull*512*64*2)
#define OFF_GU     (OFF_HID   + 8ull*512*256*2)
#define GSKEW      4352ull
#define OFF_GW     (OFF_GU    + 1024ull*64*128*2 + GSKEW)
#define OFF_GQD    (OFF_GW    + 1024ull*64*128*2 + GSKEW)
#define OFF_GKD    (OFF_GQD   + 1024ull*64*128*2 + GSKEW)
#define OFF_GIN    (OFF_GKD   + 1024ull*64*128*2 + GSKEW)
#define OFF_GL     (OFF_GIN   + 1024ull*64*64*2 + GSKEW)
#define OFF_ROPE   (OFF_GL    + 4096ull)
#define OFF_CW2T   (OFF_ROPE  + 8192ull*32*8)
#define OFF_SU     (OFF_CW2T  + 2ull*64*256*2)
#define OFF_SV     (OFF_SU    + 65536ull)
#define OFF_SSQ    (OFF_SV    + 65536ull)
#define OFF_VSN    (OFF_SSQ   + 16384ull*16*4)
#define OFF_VWN    (OFF_VSN   + 4ull*8192*64*2)
#define OFF_END    (OFF_VWN   + 4ull*8192*64*2)
#define OFF_MIX    OFF_HBF
#define OFF_QRY    OFF_PROJ
#define OFF_H2     (OFF_PROJ + 16384ull*2048*2)
#define OFF_EIDX   OFF_KSN
#define OFF_PGATE  OFF_GIN
#define OFF_UQ     OFF_GU
#define OFF_VQ     (OFF_GU + 16384ull*1024)

__device__ __forceinline__ bf16_t f2bf(float f) {
    unsigned u = __float_as_uint(f);
    u += 0x7fffu + ((u >> 16) & 1u);
    return (bf16_t)(u >> 16);
}
__device__ __forceinline__ int opaque_tid() { int t = threadIdx.x; asm volatile("" : "+v"(t)); return t; }
__device__ __forceinline__ float bf2f(bf16_t h) { return __uint_as_float(((unsigned)h) << 16); }
typedef __bf16 bf16x2_t2 __attribute__((ext_vector_type(2)));
__device__ __forceinline__ unsigned pk2(float a, float b) { bf16x2_t2 v; v[0] = (__bf16)a; v[1] = (__bf16)b; return __builtin_bit_cast(unsigned, v); }
__device__ __forceinline__ float gelu_tanh(float x) {
    float u = 0.7978845608028654f * (x + 0.044715f * x * x * x);
    return 0.5f * x * (1.f + tanhf(u));
}
__device__ __forceinline__ float sigmoidf_(float x) { return 1.f / (1.f + __expf(-x)); }
__device__ __forceinline__ float wave_sum(float v) {
#pragma unroll
    for (int o = 32; o > 0; o >>= 1) v += __shfl_xor(v, o);
    return v;
}
__device__ __forceinline__ float wave_max(float v) {
#pragma unroll
    for (int o = 32; o > 0; o >>= 1) v = fmaxf(v, __shfl_xor(v, o));
    return v;
}

template <int CTRL> __device__ __forceinline__ float dppf(float x) { return __builtin_bit_cast(float, __builtin_amdgcn_update_dpp(0, __builtin_bit_cast(int, x), CTRL, 0xf, 0xf, true)); }
template <int CTRL> __device__ __forceinline__ unsigned dppu(unsigned x) { return (unsigned)__builtin_amdgcn_update_dpp(0, (int)x, CTRL, 0xf, 0xf, true); }
__device__ __forceinline__ float allmax16(float x) {
    x = fmaxf(x, dppf<0xB1>(x)); x = fmaxf(x, dppf<0x4E>(x)); x = fmaxf(x, dppf<0x141>(x)); x = fmaxf(x, dppf<0x140>(x)); return x;
}
__device__ __forceinline__ unsigned allmaxu16(unsigned x) {
    x = max(x, dppu<0xB1>(x)); x = max(x, dppu<0x4E>(x)); x = max(x, dppu<0x141>(x)); x = max(x, dppu<0x140>(x)); return x;
}
__device__ __forceinline__ float allsum16(float x) {
    x += dppf<0xB1>(x); x += dppf<0x4E>(x); x += dppf<0x141>(x); x += dppf<0x140>(x); return x;
}
__device__ __forceinline__ float wave_sum_dpp(float x) {
    x = allsum16(x);
    return __builtin_bit_cast(float, __builtin_amdgcn_readlane(__builtin_bit_cast(int, x), 0)) + __builtin_bit_cast(float, __builtin_amdgcn_readlane(__builtin_bit_cast(int, x), 16)) +
           __builtin_bit_cast(float, __builtin_amdgcn_readlane(__builtin_bit_cast(int, x), 32)) + __builtin_bit_cast(float, __builtin_amdgcn_readlane(__builtin_bit_cast(int, x), 48));
}
__device__ __forceinline__ void d_transpose_bf16(const float* __restrict__ W, int K, int N, bf16_t* __restrict__ Wt, int bx, int by, char* smem, const float* __restrict__ kscale = nullptr) {
    float* tile = (float*)smem;
    const int n0 = bx * 32, k0 = by * 128;
    const int tx = threadIdx.x & 31, ty = threadIdx.x >> 5;
    const int n = n0 + tx;
    float v[16];
#pragma unroll
    for (int i = 0; i < 16; i++) { const int k = k0 + ty + 8 * i; v[i] = (n < N) ? W[(size_t)k * N + n] : 0.f; }
#pragma unroll
    for (int i = 0; i < 16; i++) { const int kk = ty + 8 * i; tile[kk * 33 + tx] = v[i] * (kscale ? kscale[k0 + kk] : 1.f); }
    __syncthreads();
    {
        const int nn = threadIdx.x >> 3, kc = (threadIdx.x & 7) * 16;
        unsigned pk[8];
#pragma unroll
        for (int j = 0; j < 8; j++) pk[j] = pk2(tile[(kc + 2 * j) * 33 + nn], tile[(kc + 2 * j + 1) * 33 + nn]);
        uint4* dst = (uint4*)(Wt + (size_t)(n0 + nn) * K + k0 + kc);
        dst[0] = make_uint4(pk[0], pk[1], pk[2], pk[3]); dst[1] = make_uint4(pk[4], pk[5], pk[6], pk[7]);
    }
    __syncthreads();
}

__device__ __forceinline__ void d_rmsnorm_bf16(const float* __restrict__ x, const float* __restrict__ g, bf16_t* __restrict__ out, int bid) {
    int row = bid * 4 + (threadIdx.x >> 6);
    int lane = threadIdx.x & 63;
    const float4* xr = (const float4*)(x + (size_t)row * DM);
    float4 v[4];
    float ss = 0.f;
#pragma unroll
    for (int i = 0; i < 4; i++) { v[i] = xr[lane + 64 * i]; ss += v[i].x * v[i].x + v[i].y * v[i].y + v[i].z * v[i].z + v[i].w * v[i].w; }
    ss = wave_sum(ss);
    float r = rsqrtf(ss * (1.f / DM) + 1e-6f);
#pragma unroll
    for (int i = 0; i < 4; i++) {
        float4 gg = ((const float4*)g)[lane + 64 * i];
        ushort4 o;
        o.x = f2bf(v[i].x * r * gg.x); o.y = f2bf(v[i].y * r * gg.y); o.z = f2bf(v[i].z * r * gg.z); o.w = f2bf(v[i].w * r * gg.w);
        ((ushort4*)(out + (size_t)row * DM))[lane + 64 * i] = o;
    }
}

__device__ __forceinline__ void d_cmp_bias(const float* __restrict__ pos, const float* __restrict__ w1, float* __restrict__ bias, int item, char* smem) {
    float* part = (float*)smem;
    const int j = item >> 3, c = (item & 7) * 32 + (threadIdx.x & 31), ksl = threadIdx.x >> 5;
    float s0 = 0.f, s1 = 0.f, s2 = 0.f, s3 = 0.f;
    const float* wp = w1 + ((size_t)j * 2048 + ksl * 256) * 256 + c;
    const float* pp = pos + j * 2048 + ksl * 256;
    for (int k = 0; k < 256; k += 4) {
        s0 += pp[k] * wp[(size_t)k * 256]; s1 += pp[k + 1] * wp[(size_t)(k + 1) * 256];
        s2 += pp[k + 2] * wp[(size_t)(k + 2) * 256]; s3 += pp[k + 3] * wp[(size_t)(k + 3) * 256];
    }
    part[ksl * 32 + (threadIdx.x & 31)] = (s0 + s1) + (s2 + s3);
    __syncthreads();
    if (threadIdx.x < 32) {
        float t = 0.f;
#pragma unroll
        for (int i = 0; i < 8; i++) t += part[i * 32 + threadIdx.x];
        bias[j * 256 + c] = t;
    }
    __syncthreads();
}

#define EPI_PROJ 0
#define EPI_HID 1
#define EPI_OUT 2
#define EPI_QRY 3
struct GemmP {
    const bf16_t* A; long lda; long akts;
    const bf16_t* Bt; long ldb;
    int K; int mtiles; int ntiles;
    long a_inst; long b_inst;
    void* out; const float* aux; const float* aux2; bf16_t* out2; float* ssq;
};

#define GEMM_STAGE 24576
template <int EPI>
__device__ __forceinline__ void d_gemm(const GemmP& p, int bid, char* smem) {
    const int tid = opaque_tid(), lane = tid & 63, wave = tid >> 6;
    const int wm = wave >> 1, wn = wave & 1;
    const int inst = 0;
    const int nwg = p.mtiles * p.ntiles, wgid = (nwg & 7) ? bid : ((bid & 7) * (nwg >> 3) + (bid >> 3));
    const int mt = wgid / p.ntiles, nt = wgid % p.ntiles;
    const int m0 = mt * 256, n0 = nt * 128;
    const bf16_t* A = p.A + (size_t)inst * p.a_inst + (size_t)m0 * p.lda;
    const bf16_t* Bt = p.Bt + (size_t)inst * p.b_inst + (size_t)n0 * p.ldb;
    f32x4 acc[8][4];
#pragma unroll
    for (int i = 0; i < 8; i++)
#pragma unroll
        for (int j = 0; j < 4; j++) acc[i][j] = (f32x4){0.f, 0.f, 0.f, 0.f};
    const int nk = p.K >> 5;
    const int crow = tid >> 2, cslot = tid & 3;
    const int csrc = (cslot ^ (((crow >> 3) & 1) << 1)) * 8;
    const bf16_t* Ap = A + (size_t)crow * p.lda + csrc;
    const bf16_t* Bp = Bt + (size_t)crow * p.ldb + csrc;
    const size_t a64 = (size_t)64 * p.lda, b64 = (size_t)64 * p.ldb;
    char* ldsw = smem + tid * 16;
#define GSTAGE(stg, kt_) { char* _d = ldsw + (stg) * GEMM_STAGE; const size_t _ka = (size_t)((kt_) >> 1) * p.akts + (size_t)(((kt_) & 1) * 32), _kb = (size_t)(kt_) * 32; \
    __builtin_amdgcn_global_load_lds((const unsigned*)(Ap + _ka), (LAS3 unsigned*)(_d), 16, 0, 0); \
    __builtin_amdgcn_global_load_lds((const unsigned*)(Ap + a64 + _ka), (LAS3 unsigned*)(_d + 4096), 16, 0, 0); \
    __builtin_amdgcn_global_load_lds((const unsigned*)(Ap + 2 * a64 + _ka), (LAS3 unsigned*)(_d + 8192), 16, 0, 0); \
    __builtin_amdgcn_global_load_lds((const unsigned*)(Ap + 3 * a64 + _ka), (LAS3 unsigned*)(_d + 12288), 16, 0, 0); \
    __builtin_amdgcn_global_load_lds((const unsigned*)(Bp + _kb), (LAS3 unsigned*)(_d + 16384), 16, 0, 0); \
    __builtin_amdgcn_global_load_lds((const unsigned*)(Bp + b64 + _kb), (LAS3 unsigned*)(_d + 16384 + 4096), 16, 0, 0); }
    const int n16 = lane & 15, kq = lane >> 4;
    if (EPI == EPI_QRY) {
        const float4* q = (const float4*)(p.ssq + (size_t)(m0 + tid) * 16);
        const float4 q0 = q[0], q1 = q[1], q2 = q[2], q3 = q[3];
        const float t = ((q0.x + q0.y) + (q0.z + q0.w)) + ((q1.x + q1.y) + (q1.z + q1.w)) + ((q2.x + q2.y) + (q2.z + q2.w)) + ((q3.x + q3.y) + (q3.z + q3.w));
        ((float*)(smem + 3 * GEMM_STAGE))[tid] = rsqrtf(t * (1.f / DM) + 1e-6f);
    }
    const int rdsw = ((kq ^ (((n16 >> 3) & 1) << 1)) << 4);
    GSTAGE(0, 0)
    if (nk > 1) GSTAGE(1, 1)
    int scur = 0, snext = 2;
    for (int kt = 0; kt < nk; kt++) {
        if (kt + 1 < nk) asm volatile("s_waitcnt vmcnt(6)" ::: "memory");
        else asm volatile("s_waitcnt vmcnt(0)" ::: "memory");
        __builtin_amdgcn_s_barrier();
        if (kt + 2 < nk) GSTAGE(snext, kt + 2)
        const char* Ab = smem + scur * GEMM_STAGE;
        const char* Bb = Ab + 16384;
        bf16x8 bfr[4];
#pragma unroll
        for (int j = 0; j < 4; j++) bfr[j] = *(const bf16x8*)(Bb + (wn * 64 + j * 16 + n16) * 64 + rdsw);
#pragma unroll
        for (int ih = 0; ih < 2; ih++) {
            bf16x8 af[4];
#pragma unroll
            for (int i = 0; i < 4; i++) af[i] = *(const bf16x8*)(Ab + (wm * 128 + (ih * 4 + i) * 16 + n16) * 64 + rdsw);
#pragma unroll
            for (int i = 0; i < 4; i++)
#pragma unroll
                for (int j = 0; j < 4; j++) acc[ih * 4 + i][j] = __builtin_amdgcn_mfma_f32_16x16x32_bf16(bfr[j], af[i], acc[ih * 4 + i][j], 0, 0, 0);
        }
        scur = (scur == 2) ? 0 : scur + 1; snext = (snext == 2) ? 0 : snext + 1;
    }
#undef GSTAGE
    asm volatile("s_waitcnt lgkmcnt(0)" ::: "memory");
    __syncthreads();
    {
        char* slab = smem + wave * 9216;
        const int cbase = n0 + wn * 64;
#pragma unroll
        for (int ip = 0; ip < 2; ip++) {
            const int rbase = m0 + wm * 128 + ip * 64;
            if (EPI == EPI_OUT) {
                float* st = (float*)slab;
#pragma unroll
                for (int hlf = 0; hlf < 2; hlf++) {
#pragma unroll
                    for (int ii = 0; ii < 2; ii++)
#pragma unroll
                        for (int j = 0; j < 4; j++) *(f32x4*)(st + (ii * 16 + n16) * 68 + j * 16 + 4 * kq) = acc[ip * 4 + hlf * 2 + ii][j];
#pragma unroll
                    for (int ps = 0; ps < 8; ps++) {
                        const int rl = ps * 4 + kq, row = rbase + hlf * 32 + rl;
                        const float4 a = *(const float4*)(st + rl * 68 + n16 * 4);
                        const float4 xx = *(const float4*)(p.aux + (size_t)row * DM + cbase + n16 * 4);
                        const float4 o = make_float4(xx.x + a.x, xx.y + a.y, xx.z + a.z, xx.w + a.w);
                        *(float4*)((float*)p.out + (size_t)row * DM + cbase + n16 * 4) = o;
                        *(uint2*)(p.out2 + (size_t)row * DM + cbase + n16 * 4) = make_uint2(pk2(o.x, o.y), pk2(o.z, o.w));
                        const float ss = allsum16(o.x * o.x + o.y * o.y + o.z * o.z + o.w * o.w);
                        if (n16 == 0) p.ssq[(size_t)row * 16 + nt * 2 + wn] = ss;
                    }
                }
            } else {
                bf16_t* st = (bf16_t*)slab;
#pragma unroll
                for (int i = 0; i < 4; i++) {
                    float rs = 1.f;
                    if (EPI == EPI_QRY) rs = ((const float*)(smem + 3 * GEMM_STAGE))[wm * 128 + ip * 64 + i * 16 + n16];
#pragma unroll
                    for (int j = 0; j < 4; j++) {
                        float v0 = acc[ip * 4 + i][j][0], v1 = acc[ip * 4 + i][j][1], v2 = acc[ip * 4 + i][j][2], v3 = acc[ip * 4 + i][j][3];
                        if (EPI == EPI_HID) {
                            const float4 bb = *(const float4*)(p.aux + (inst >> 2) * 256 + cbase + 16 * j + 4 * kq);
                            v0 = gelu_tanh(v0 + bb.x); v1 = gelu_tanh(v1 + bb.y); v2 = gelu_tanh(v2 + bb.z); v3 = gelu_tanh(v3 + bb.w);
                        }
                        if (EPI == EPI_QRY) { v0 *= rs; v1 *= rs; v2 *= rs; v3 *= rs; }
                        *(uint2*)(st + (i * 16 + n16) * 72 + j * 16 + 4 * kq) = make_uint2(pk2(v0, v1), pk2(v2, v3));
                    }
                }
                const int ld = (EPI == EPI_PROJ) ? PLD : (EPI == EPI_HID ? 256 : 2048);
#pragma unroll
                for (int ps = 0; ps < 8; ps++) {
                    const int rl = ps * 8 + (lane >> 3), ch = lane & 7;
                    const uint4 v = *(const uint4*)(st + rl * 72 + ch * 8);
                    *(uint4*)((bf16_t*)p.out + (size_t)(rbase + rl) * ld + cbase + ch * 8) = v;
                }
            }
        }
        __syncthreads();
    }
}

__device__ __forceinline__ void d_knorm_rope(const bf16_t* __restrict__ proj, const float* __restrict__ kgain, bf16_t* __restrict__ ksn, bf16_t* __restrict__ kwn, bf16_t* __restrict__ vsn, bf16_t* __restrict__ vwn, const float2* __restrict__ rope, int bid) {
    int vec = bid * 8 + (threadIdx.x >> 5);
    int i = threadIdx.x & 31;
    int which = vec >> 15;
    int rem = vec & 32767;
    int b = rem >> 14, g = (rem >> 13) & 1, s = rem & 8191;
    const bf16_t* src = proj + (size_t)(b * SEQ + s) * PLD + C_KV + 128 * (which ? 4 : 2) + 64 * g;
    float x1 = bf2f(src[i]), x2 = bf2f(src[i + 32]);
    float ss = x1 * x1 + x2 * x2;
#pragma unroll
    for (int o = 16; o > 0; o >>= 1) ss += __shfl_xor(ss, o);
    float r = rsqrtf(ss * (1.f / 64.f) + 1e-6f);
    const float* gn = kgain + (which ? 2 : 1) * 64;
    x1 = x1 * r * gn[i]; x2 = x2 * r * gn[i + 32];
    const float2 cs2 = rope[(size_t)s * 32 + i];
    const float cs = cs2.x, sn = cs2.y;
    bf16_t* dst = (which ? kwn : ksn) + ((size_t)(b * 2 + g) * SEQ + s) * 64;
    dst[i] = f2bf(x1 * cs - x2 * sn);
    dst[i + 32] = f2bf(x2 * cs + x1 * sn);
    ((unsigned*)((which ? vwn : vsn) + ((size_t)(b * 2 + g) * SEQ + s) * 64))[i] = ((const unsigned*)(src + 128))[i];
}

__device__ __forceinline__ void d_cmp2_mfma(const bf16_t* __restrict__ hid, const bf16_t* __restrict__ cw2t, const float* __restrict__ kgain, const float2* __restrict__ rope,
                                            bf16_t* __restrict__ kc, bf16_t* __restrict__ vc, int witem, int lane) {
    const int n16 = lane & 15, kq = lane >> 4;
    const int rowbase = 16 * witem, inst = rowbase >> 9, n0 = rowbase & 511, j = inst >> 2, bg = inst & 3;
    f32x4 acc[4];
#pragma unroll
    for (int nt = 0; nt < 4; nt++) acc[nt] = (f32x4){0.f, 0.f, 0.f, 0.f};
    const bf16_t* ap = hid + (size_t)(rowbase + n16) * 256 + 8 * kq;
    const bf16_t* bp = cw2t + (size_t)j * 64 * 256 + n16 * 256 + 8 * kq;
#pragma unroll
    for (int ks = 0; ks < 8; ks++) {
        const bf16x8 a = *(const bf16x8*)(ap + 32 * ks);
#pragma unroll
        for (int nt = 0; nt < 4; nt++) {
            const bf16x8 bb = *(const bf16x8*)(bp + (size_t)(16 * nt) * 256 + 32 * ks);
            acc[nt] = __builtin_amdgcn_mfma_f32_16x16x32_bf16(a, bb, acc[nt], 0, 0, 0);
        }
    }
#pragma unroll
    for (int r = 0; r < 4; r++) {
        const int n = n0 + 4 * kq + r;
        if (j == 0) {
            float ss = acc[0][r] * acc[0][r] + acc[1][r] * acc[1][r] + acc[2][r] * acc[2][r] + acc[3][r] * acc[3][r];
            ss = allsum16(ss);
            const float ri = rsqrtf(ss * (1.f / 64.f) + 1e-6f);
#pragma unroll
            for (int nt = 0; nt < 2; nt++) {
                const int i = 16 * nt + n16;
                const float y1 = acc[nt][r] * ri * kgain[i], y2 = acc[nt + 2][r] * ri * kgain[i + 32];
                const float2 cs = rope[(size_t)((n < 511 ? n : 510) * 16 + 31) * 32 + i];
                if (n < 511) {
                    kc[((size_t)bg * 512 + n) * 64 + i] = f2bf(y1 * cs.x - y2 * cs.y);
                    kc[((size_t)bg * 512 + n) * 64 + i + 32] = f2bf(y2 * cs.x + y1 * cs.y);
                }
            }
        } else if (n < 511) {
#pragma unroll
            for (int nt = 0; nt < 4; nt++) vc[((size_t)bg * 512 + n) * 64 + 16 * nt + n16] = f2bf(acc[nt][r]);
        }
    }
}

typedef float f32x16 __attribute__((ext_vector_type(16)));
typedef short s16x4 __attribute__((ext_vector_type(4)));
#define MFMA32(a, b, c) __builtin_amdgcn_mfma_f32_32x32x16_bf16((a), (b), (c), 0, 0, 0)
#define NKS 72
#define NSA_K_OFF 0
#define NSA_V_OFF (2 * 64 * NKS * 2)
#define NSA_IMP_OFF (NSA_V_OFF + 2 * 64 * NKS * 2)
#define NSA_SEL_OFF (NSA_IMP_OFF + 4 * 8192)
#define NSA_LDS (NSA_SEL_OFF + 32 * 4 * 4)
#define NEGBIG (-1e30f)
__device__ __forceinline__ bf16x8 pack8(float a0, float a1, float a2, float a3, float a4, float a5, float a6, float a7) {
    uint4 u = make_uint4(pk2(a0, a1), pk2(a2, a3), pk2(a4, a5), pk2(a6, a7));
    return __builtin_bit_cast(bf16x8, u);
}
__device__ __forceinline__ unsigned pk4_fp8(float a, float b, float c, float d) {
    int w = 0;
    w = __builtin_amdgcn_cvt_pk_fp8_f32(a, b, w, false);
    w = __builtin_amdgcn_cvt_pk_fp8_f32(c, d, w, true);
    return (unsigned)w;
}
__device__ __forceinline__ bf16x8 fp8x8_bf16(unsigned a, unsigned b) {
    const f32x2 p0 = __builtin_amdgcn_cvt_pk_f32_fp8((int)a, false), p1 = __builtin_amdgcn_cvt_pk_f32_fp8((int)a, true);
    const f32x2 p2 = __builtin_amdgcn_cvt_pk_f32_fp8((int)b, false), p3 = __builtin_amdgcn_cvt_pk_f32_fp8((int)b, true);
    return pack8(p0[0], p0[1], p1[0], p1[1], p2[0], p2[1], p3[0], p3[1]);
}
#define GW_SCALE 32.f
#define GQ_SCALE 2048.f
#define GK_SCALE 128.f
typedef unsigned u32x4 __attribute__((ext_vector_type(4)));
struct NsaStage { u32x4 k0, k1, v0, v1; };
struct NsaCtx {
    bool noload;
    const bf16_t* Kbase; long kstride;
    const bf16_t* Vbase; long vstride;
    bf16_t* Kb; bf16_t* Vb;
    float* imp_s; unsigned* sel_s;
    bf16x8 qf[4];
    f32x16 O0, O1;
    float m, l, invl, carry;
    int t, tokl, hp, hh, c, lane;
};
__device__ __forceinline__ void nsa_stage_load(const NsaCtx& X, NsaStage& st, int j) {
    const int r0 = threadIdx.x >> 3, c8 = (threadIdx.x & 7) * 8;
    if (X.noload) { st.k0 = (u32x4){0u,0u,0u,0u}; st.k1 = st.k0; st.v0 = st.k0; st.v1 = st.k0; return; }
    const bf16_t* kp = X.Kbase + (size_t)(64 * j + r0) * X.kstride + c8;
    const bf16_t* vp = X.Vbase + (size_t)(64 * j + r0) * X.vstride + c8;
    st.k0 = *(const u32x4*)kp; st.k1 = *(const u32x4*)(kp + 32 * X.kstride);
    st.v0 = *(const u32x4*)vp; st.v1 = *(const u32x4*)(vp + 32 * X.vstride);
}
__device__ __forceinline__ void nsa_stage_store(const NsaCtx& X, const NsaStage& st, int buf) {
    const int r0 = threadIdx.x >> 3, c8 = (threadIdx.x & 7) * 8;
    bf16_t* kb = X.Kb + buf * 64 * NKS + r0 * NKS + c8;
    bf16_t* vb = X.Vb + buf * 64 * NKS + r0 * NKS + c8;
    *(u32x4*)kb = st.k0; *(u32x4*)(kb + 32 * NKS) = st.k1;
    *(u32x4*)vb = st.v0; *(u32x4*)(vb + 32 * NKS) = st.v1;
}
__device__ __forceinline__ float xor32_max(float x) {
    const auto r = __builtin_amdgcn_permlane32_swap(__float_as_uint(x), __float_as_uint(x), false, false);
    return fmaxf(__uint_as_float(r[0]), __uint_as_float(r[1]));
}
__device__ __forceinline__ float xor32_sum(float x) {
    const auto r = __builtin_amdgcn_permlane32_swap(__float_as_uint(x), __float_as_uint(x), false, false);
    return __uint_as_float(r[0]) + __uint_as_float(r[1]);
}
template <int MODE>
__device__ __forceinline__ void nsa_tile(NsaCtx& X, int j, int kt, int buf, unsigned long long mlo, unsigned long long mhi, bool fast) {
    const bf16_t* Kt = X.Kb + buf * 64 * NKS + (32 * kt) * NKS;
    const bf16_t* Vt = X.Vb + buf * 64 * NKS + (32 * kt) * NKS;
    f32x16 S;
#pragma unroll
    for (int i = 0; i < 16; i++) S[i] = 0.f;
#pragma unroll
    for (int s = 0; s < 4; s++) {
        bf16x8 ka = *(const bf16x8*)(Kt + X.c * NKS + 16 * s + 8 * X.hh);
        S = MFMA32(ka, X.qf[s], S);
    }
    const int kbase = 64 * j + 32 * kt;
    int lo = 0, hi;
    bool on = true;
    if (MODE <= 1) hi = ((X.t - 31) >> 4) - kbase;
    else hi = X.t - kbase;
    if (MODE == 3) lo = X.t - 511 - kbase;
    if (MODE == 2) {
        const unsigned long long wsel = (j < 64) ? mlo : mhi;
        on = (wsel >> (j & 63)) & 1ull;
    }
    lo -= 4 * X.hh; hi -= 4 * X.hh;
    if (!on) hi = -1000;
    float P[16];
    if (MODE == 1) {
#pragma unroll
        for (int i = 0; i < 16; i++) {
            const int cr = (i & 3) + 8 * (i >> 2);
            P[i] = (cr <= hi) ? __builtin_amdgcn_exp2f(S[i] - X.m) * X.invl : 0.f;
        }
        float mainv[4], nxt[4];
#pragma unroll
        for (int q = 0; q < 4; q++) { mainv[q] = 2.f * (P[4 * q] + P[4 * q + 1] + P[4 * q + 2]) + P[4 * q + 3]; nxt[q] = P[4 * q + 3]; }
#pragma unroll
        for (int q = 0; q < 4; q++) {
            mainv[q] += __shfl_xor(mainv[q], 1); mainv[q] += __shfl_xor(mainv[q], 2);
            nxt[q] += __shfl_xor(nxt[q], 1); nxt[q] += __shfl_xor(nxt[q], 2);
        }
        float recv[4];
#pragma unroll
        for (int q = 0; q < 4; q++) recv[q] = __shfl_xor(nxt[q], 32);
        const int jsel0 = 16 * j + 8 * kt + X.hh;
#pragma unroll
        for (int q = 0; q < 4; q++) {
            const float tot = mainv[q] + (X.hh ? recv[q] : (q > 0 ? recv[q > 0 ? q - 1 : 0] : X.carry));
            if (X.hp == 0) X.imp_s[(X.tokl & 7) * 128 + jsel0 + 2 * q] = tot;
        }
        X.carry = recv[3];
    } else if (MODE == 0) {
        float tmax = NEGBIG;
#pragma unroll
        for (int i = 0; i < 16; i++) {
            const int cr = (i & 3) + 8 * (i >> 2);
            const bool vis = (cr <= hi) && (cr >= lo);
            tmax = vis ? fmaxf(tmax, S[i]) : tmax;
        }
        tmax = xor32_max(tmax);
        float ls = 0.f;
        const float mnew = fmaxf(X.m, tmax);
        const float alpha = __builtin_amdgcn_exp2f(X.m - mnew);
        X.m = mnew;
#pragma unroll
        for (int i = 0; i < 16; i++) {
            const int cr = (i & 3) + 8 * (i >> 2);
            const bool vis = (cr <= hi) && (cr >= lo);
            P[i] = vis ? __builtin_amdgcn_exp2f(S[i] - mnew) : 0.f;
            ls += P[i];
        }
        X.l = X.l * alpha + ls;
    } else {
        if (!fast) {
#pragma unroll
            for (int i = 0; i < 16; i++) {
                const int cr = (i & 3) + 8 * (i >> 2);
                const bool vis = (cr <= hi) && (cr >= lo);
                S[i] = vis ? S[i] : -__builtin_inff();
            }
        }
        float tmax = fmaxf(fmaxf(fmaxf(fmaxf(S[0], S[1]), fmaxf(S[2], S[3])), fmaxf(fmaxf(S[4], S[5]), fmaxf(S[6], S[7]))),
                           fmaxf(fmaxf(fmaxf(S[8], S[9]), fmaxf(S[10], S[11])), fmaxf(fmaxf(S[12], S[13]), fmaxf(S[14], S[15]))));
        if (MODE == 2 && !on) tmax = NEGBIG;
        tmax = xor32_max(tmax);
        float ls = 0.f;
        const bool upd = tmax > X.m + 8.f;
        const float mnew = upd ? tmax : X.m;
        if (__builtin_amdgcn_ballot_w64(upd) != 0ull) {
            const float alpha = __builtin_amdgcn_exp2f(X.m - mnew);
            X.l *= alpha;
#pragma unroll
            for (int i = 0; i < 16; i++) { X.O0[i] *= alpha; X.O1[i] *= alpha; }
        }
        X.m = mnew;
        const float msub = (MODE == 2 && !on) ? 1e30f : mnew;
#pragma unroll
        for (int i = 0; i < 16; i++) { P[i] = __builtin_amdgcn_exp2f(S[i] - msub); ls += P[i]; }
        X.l += ls;
    }
    if (MODE >= 1) {
        bf16x8 pb0 = pack8(P[0], P[1], P[2], P[3], P[4], P[5], P[6], P[7]);
        bf16x8 pb1 = pack8(P[8], P[9], P[10], P[11], P[12], P[13], P[14], P[15]);
        const int l15 = X.lane & 15;
        const bf16_t* vrow = Vt + (4 * X.hh + (l15 >> 2)) * NKS + 16 * ((X.lane >> 4) & 1) + 4 * (l15 & 3);
#pragma unroll
        for (int s2 = 0; s2 < 2; s2++) {
#pragma unroll
            for (int dt = 0; dt < 2; dt++) {
                s16x4 lo4 = __builtin_amdgcn_ds_read_tr16_b64_v4i16((LAS3 s16x4*)(vrow + (16 * s2) * NKS + 32 * dt));
                s16x4 hi4 = __builtin_amdgcn_ds_read_tr16_b64_v4i16((LAS3 s16x4*)(vrow + (16 * s2 + 8) * NKS + 32 * dt));
                bf16x8 va = __builtin_shufflevector(lo4, hi4, 0, 1, 2, 3, 4, 5, 6, 7);
                if (dt == 0) X.O0 = MFMA32(va, s2 ? pb1 : pb0, X.O0); else X.O1 = MFMA32(va, s2 ? pb1 : pb0, X.O1);
            }
        }
    }
}
template <int MODE>
__device__ __forceinline__ void nsa_block(NsaCtx& X, int j, unsigned long long mlo, unsigned long long mhi, unsigned long long ulo, unsigned long long uhi, int cur, int tw0) {
    bool need = true;
    if (MODE == 2) {
        const unsigned long long wsel = (j < 64) ? ulo : uhi;
        need = (wsel >> (j & 63)) & 1ull;
    }
    if (need) {
#pragma unroll 1
        for (int kt = 0; kt < 2; kt++) {
            bool fast = false;
            if (MODE == 2) fast = j < cur;
            if (MODE == 3) { const int kb = 64 * j + 32 * kt; fast = (kb + 31 <= tw0) && (kb >= tw0 + 7 - 511); }
            nsa_tile<MODE>(X, j, kt, j & 1, mlo, mhi, fast);
        }
    }
}
template <int MODE>
__device__ __forceinline__ void nsa_branch(NsaCtx& X, int jlo, int jhi, unsigned long long mlo, unsigned long long mhi, unsigned long long ulo, unsigned long long uhi, int cur, int tw0) {
    NsaStage sa;
    nsa_stage_load(X, sa, jlo);
    __syncthreads();
    nsa_stage_store(X, sa, jlo & 1);
    __syncthreads();
#pragma unroll 1
    for (int j = jlo; j <= jhi; j++) {
        if (j < jhi) nsa_stage_load(X, sa, j + 1);
        nsa_block<MODE>(X, j, mlo, mhi, ulo, uhi, cur, tw0);
        if (j < jhi) nsa_stage_store(X, sa, (j + 1) & 1);
        __syncthreads();
    }
}
template <int OP>
__device__ __forceinline__ void nsa_facc(NsaCtx& X, float scale) {
    f32x4* F = (f32x4*)X.imp_s;
#pragma unroll
    for (int q = 0; q < 8; q++) {
        f32x4 v;
#pragma unroll
        for (int e = 0; e < 4; e++) v[e] = ((q < 4) ? X.O0[4 * q + e] : X.O1[4 * (q - 4) + e]) * scale;
        if (OP >= 1) v += F[q * 64 + X.lane];
        if (OP <= 1) F[q * 64 + X.lane] = v;
        else {
#pragma unroll
            for (int e = 0; e < 4; e++) { if (q < 4) X.O0[4 * q + e] = v[e]; else X.O1[4 * (q - 4) + e] = v[e]; }
        }
    }
}
__device__ __forceinline__ void d_nsa_mfma(const bf16_t* __restrict__ proj, const float* __restrict__ qgain, const float2* __restrict__ rope,
                                           const bf16_t* __restrict__ ksn, const bf16_t* __restrict__ kwn,
                                           const bf16_t* __restrict__ kc, const bf16_t* __restrict__ vc, const bf16_t* __restrict__ vsn, const bf16_t* __restrict__ vwn,
                                           bf16_t* __restrict__ mixo, int mix_ld, int item, char* smem, bool noload = false) {
    NsaCtx X;
    X.noload = noload;
    const int tid = opaque_tid(), lane = tid & 63, w = tid >> 6;
    const int bg = item & 3, tile = 255 - (item >> 2);
    const int b = bg >> 1, g = bg & 1, t0 = tile * 32;
    X.lane = lane; X.c = lane & 31; X.hh = lane >> 5; X.hp = X.c & 3; X.tokl = 8 * w + (X.c >> 2); X.t = t0 + X.tokl;
    X.Kb = (bf16_t*)(smem + NSA_K_OFF); X.Vb = (bf16_t*)(smem + NSA_V_OFF);
    X.imp_s = (float*)(smem + NSA_IMP_OFF + w * 8192); X.sel_s = (unsigned*)(smem + NSA_SEL_OFF);
    const int head = g * 4 + X.hp;
    const size_t row = (size_t)(b * SEQ + X.t);
    {
        float y[4][8];
        const bf16_t* qsrc = proj + row * PLD + C_Q + head * 64 + 8 * X.hh;
        float ss = 0.f;
#pragma unroll
        for (int s = 0; s < 4; s++) {
            const uint4 u = *(const uint4*)(qsrc + 16 * s);
            const unsigned wv[4] = {u.x, u.y, u.z, u.w};
#pragma unroll
            for (int e = 0; e < 4; e++) { y[s][2 * e] = __uint_as_float(wv[e] << 16); y[s][2 * e + 1] = __uint_as_float(wv[e] & 0xffff0000u); }
#pragma unroll
            for (int e = 0; e < 8; e++) ss += y[s][e] * y[s][e];
        }
        ss += __shfl_xor(ss, 32);
        const float r = rsqrtf(ss * (1.f / 64.f) + 1e-6f);
#pragma unroll
        for (int s = 0; s < 4; s++)
#pragma unroll
            for (int e = 0; e < 8; e++) y[s][e] *= r * qgain[16 * s + 8 * X.hh + e];
        const float qs = 0.125f * 1.4426950408889634f;
#pragma unroll
        for (int s = 0; s < 2; s++)
#pragma unroll
            for (int e = 0; e < 8; e++) {
                const float2 cs = rope[(size_t)X.t * 32 + 16 * s + 8 * X.hh + e];
                const float x1 = y[s][e], x2 = y[s + 2][e];
                y[s][e] = (x1 * cs.x - x2 * cs.y) * qs; y[s + 2][e] = (x2 * cs.x + x1 * cs.y) * qs;
            }
#pragma unroll
        for (int s = 0; s < 4; s++) X.qf[s] = pack8(y[s][0], y[s][1], y[s][2], y[s][3], y[s][4], y[s][5], y[s][6], y[s][7]);
    }
    const bf16_t* gp = proj + row * PLD + C_GATE + head * 3;
    const float g0 = sigmoidf_(bf2f(gp[0])), g1 = sigmoidf_(bf2f(gp[1])), g2 = sigmoidf_(bf2f(gp[2]));
    const int cur = t0 >> 6;
    {
        X.Kbase = kc + (size_t)bg * 512 * 64; X.kstride = 64; X.Vbase = vc + (size_t)bg * 512 * 64; X.vstride = 64;
        const int nvmax = (t0 >> 4) + 1, jhi = (nvmax - 1) >> 6;
        X.m = NEGBIG; X.l = 0.f;
        nsa_branch<0>(X, 0, jhi, 0ull, 0ull, 0ull, 0ull, cur, t0 + 8 * w);
        const float lt = xor32_sum(X.l);
        X.invl = (lt > 0.f) ? 1.f / lt : 0.f;
        X.carry = 0.f;
#pragma unroll
        for (int i = 0; i < 16; i++) { X.O0[i] = 0.f; X.O1[i] = 0.f; }
        nsa_branch<1>(X, 0, jhi, 0ull, 0ull, 0ull, 0ull, cur, t0 + 8 * w);
    }
    unsigned long long mlo, mhi, ulo, uhi;
    {
        const int tk2 = lane >> 3, sub = lane & 7;
        unsigned k0 = 1u, k1 = 0u, k2 = 0u, k3 = 0u;
#define SETBIT(jj) { const int _j = (jj); if (_j < 32) k0 |= 1u << _j; else if (_j < 64) k1 |= 1u << (_j - 32); else if (_j < 96) k2 |= 1u << (_j - 64); else k3 |= 1u << (_j - 96); }
        SETBIT(cur);
        if (cur >= 1) SETBIT(cur - 1);
        const int ncand = cur - 2;
        if (ncand > 0) {
            if (ncand <= 13) {
                for (int jj = 1; jj <= cur - 2; jj++) SETBIT(jj);
            } else {
                float sc[16];
#pragma unroll
                for (int i = 0; i < 16; i++) { const int jj = sub + 8 * i; sc[i] = (jj >= 1 && jj <= cur - 2) ? X.imp_s[tk2 * 128 + jj] : -3e38f; }
#pragma unroll 1
                for (int it = 0; it < 13; it++) {
                    float bv = sc[0]; int bi = 0;
#pragma unroll
                    for (int i = 1; i < 16; i++) if (sc[i] > bv) { bv = sc[i]; bi = i; }
                    int bj = sub + 8 * bi;
#pragma unroll
                    for (int o = 1; o < 8; o <<= 1) {
                        const float ov = __shfl_xor(bv, o); const int oj = __shfl_xor(bj, o);
                        if (ov > bv || (ov == bv && oj < bj)) { bv = ov; bj = oj; }
                    }
                    SETBIT(bj);
#pragma unroll
                    for (int i = 0; i < 16; i++) if (bj == sub + 8 * i) sc[i] = -3e38f;
                }
            }
        }
#undef SETBIT
        if (sub == 0) { unsigned* d = X.sel_s + (8 * w + tk2) * 4; d[0] = k0; d[1] = k1; d[2] = k2; d[3] = k3; }
        __builtin_amdgcn_s_waitcnt(0xc07f);
        const unsigned* sp = X.sel_s + X.tokl * 4;
        const unsigned m0 = sp[0], m1 = sp[1], m2 = sp[2], m3 = sp[3];
        mlo = (unsigned long long)m0 | ((unsigned long long)m1 << 32); mhi = (unsigned long long)m2 | ((unsigned long long)m3 << 32);
        unsigned u0 = m0, u1 = m1, u2 = m2, u3 = m3;
#pragma unroll
        for (int o = 4; o < 32; o <<= 1) { u0 |= __shfl_xor(u0, o); u1 |= __shfl_xor(u1, o); u2 |= __shfl_xor(u2, o); u3 |= __shfl_xor(u3, o); }
        ulo = (unsigned long long)(unsigned)__builtin_amdgcn_readfirstlane(u0) | ((unsigned long long)(unsigned)__builtin_amdgcn_readfirstlane(u1) << 32);
        uhi = (unsigned long long)(unsigned)__builtin_amdgcn_readfirstlane(u2) | ((unsigned long long)(unsigned)__builtin_amdgcn_readfirstlane(u3) << 32);
    }
    nsa_facc<0>(X, g0);
    {
        X.Kbase = ksn + (size_t)bg * SEQ * 64; X.kstride = 64;
        X.Vbase = vsn + (size_t)bg * SEQ * 64; X.vstride = 64;
        X.m = NEGBIG; X.l = 0.f;
#pragma unroll
        for (int i = 0; i < 16; i++) { X.O0[i] = 0.f; X.O1[i] = 0.f; }
        nsa_branch<2>(X, 0, cur, mlo, mhi, ulo, uhi, cur, t0 + 8 * w);
        const float lt = xor32_sum(X.l);
        nsa_facc<1>(X, (lt > 0.f) ? g1 / lt : 0.f);
    }
    {
        X.Kbase = kwn + (size_t)bg * SEQ * 64; X.kstride = 64;
        X.Vbase = vwn + (size_t)bg * SEQ * 64; X.vstride = 64;
        X.m = NEGBIG; X.l = 0.f;
#pragma unroll
        for (int i = 0; i < 16; i++) { X.O0[i] = 0.f; X.O1[i] = 0.f; }
        const int jlo = (t0 >= 511) ? ((t0 - 511) >> 6) : 0;
        nsa_branch<3>(X, jlo, cur, 0ull, 0ull, 0ull, 0ull, cur, t0 + 8 * w);
        const float lt = xor32_sum(X.l);
        nsa_facc<2>(X, (lt > 0.f) ? g2 / lt : 0.f);
    }
    bf16_t* dst = mixo + row * mix_ld + head * 64 + 4 * X.hh;
#pragma unroll
    for (int q4 = 0; q4 < 4; q4++) {
        *(uint2*)(dst + 8 * q4) = make_uint2(pk2(X.O0[4 * q4], X.O0[4 * q4 + 1]), pk2(X.O0[4 * q4 + 2], X.O0[4 * q4 + 3]));
        *(uint2*)(dst + 32 + 8 * q4) = make_uint2(pk2(X.O1[4 * q4], X.O1[4 * q4 + 1]), pk2(X.O1[4 * q4 + 2], X.O1[4 * q4 + 3]));
    }
}

#define KLS 136
#define XSS 264
#define GDN_PREP_LDS (2 * 64 * KLS * 2 + 64 * XSS * 2 + 512 + 7680)
__device__ __forceinline__ unsigned pack2bf(float lo, float hi) { return (unsigned)f2bf(lo) | ((unsigned)f2bf(hi) << 16); }
__device__ __forceinline__ void d_gdn_prep2(const bf16_t* __restrict__ proj, const float* __restrict__ conv_w,
                                            const float* __restrict__ a_log, const float* __restrict__ dt_bias,
                                            bf16_t* __restrict__ guT, bf16_t* __restrict__ gw, bf16_t* __restrict__ gqd,
                                            bf16_t* __restrict__ gkdT, bf16_t* __restrict__ gin, float* __restrict__ gl, int chunk, char* smem) {
    bf16_t* kL = (bf16_t*)smem;
    bf16_t* qL = kL + 64 * KLS;
    float* AmT = (float*)qL;
    bf16_t* xs = qL + 64 * KLS;
    float* gcs = (float*)(xs + 64 * XSS);
    float* bts = gcs + 64;
    float* wL = bts + 64;
    const int tid = opaque_tid(), lane = tid & 63, w = tid >> 6;
    const int n = chunk & 127, h = (chunk >> 7) & 3, b = chunk >> 9;
    const int t0 = n * 64;
    const size_t rbase = (size_t)(b * SEQ + t0);
#pragma unroll
    for (int k6 = 0; k6 < 6; k6++) {
        const int idx = tid + 256 * k6, r = idx >> 7, c = idx & 127;
        wL[r * 160 + (c >> 5) * 40 + (c & 31)] = conv_w[(r & 3) * 1536 + (r >> 2) * 512 + h * 128 + c];
    }
    if (tid < 64) {
        const size_t r = (rbase + tid) * PLD;
        float a = bf2f(proj[r + C_A + h]), bb = bf2f(proj[r + C_B + h]);
        float xx = a + dt_bias[h];
        float sp = (xx > 20.f) ? xx : log1pf(__expf(xx));
        float c = -__expf(a_log[h]) * sp;
#pragma unroll
        for (int o = 1; o < 64; o <<= 1) { float nb = __shfl_up(c, o); if (lane >= o) c += nb; }
        gcs[tid] = c; bts[tid] = sigmoidf_(bb);
    }
    __syncthreads();
    {
        const int i = tid >> 2, cg = tid & 3;
        const int tt0 = t0 + i - 3;
        const bf16_t* xcol = proj + (size_t)(b * SEQ) * PLD + C_GQKV + h * 128 + 32 * cg;
        const float* wrow = wL + 40 * cg;
        float qv[32], kv[32];
        float sq = 0.f, sk = 0.f;
        const float bi = bts[i], ei = __expf(gcs[i]);
        uint4 xa[8], xb[8];
#define GP_LOAD(buf, hf) { _Pragma("unroll") for (int c2 = 0; c2 < 2; c2++) _Pragma("unroll") for (int j = 0; j < 4; j++) { \
            const int tr = tt0 + j; uint4 u = *(const uint4*)(xcol + (size_t)(tr < 0 ? 0 : tr) * PLD + ((hf) >> 1) * 512 + 16 * ((hf) & 1) + 8 * c2); \
            if (tr < 0) u = make_uint4(0u, 0u, 0u, 0u); buf[c2 * 4 + j] = u; } }
#define GP_COMP(buf, hf) { _Pragma("unroll") for (int c2 = 0; c2 < 2; c2++) { \
            const int m = (hf) >> 1, ck = 2 * ((hf) & 1) + c2; float cv[8]; \
            _Pragma("unroll") for (int e = 0; e < 8; e++) cv[e] = 0.f; \
            _Pragma("unroll") for (int j = 0; j < 4; j++) { \
                const uint4 u = buf[c2 * 4 + j]; \
                const float4 w0 = *(const float4*)(wrow + (m * 4 + j) * 160 + 8 * ck), w1 = *(const float4*)(wrow + (m * 4 + j) * 160 + 8 * ck + 4); \
                cv[0] += __uint_as_float(u.x << 16) * w0.x; cv[1] += __uint_as_float(u.x & 0xffff0000u) * w0.y; \
                cv[2] += __uint_as_float(u.y << 16) * w0.z; cv[3] += __uint_as_float(u.y & 0xffff0000u) * w0.w; \
                cv[4] += __uint_as_float(u.z << 16) * w1.x; cv[5] += __uint_as_float(u.z & 0xffff0000u) * w1.y; \
                cv[6] += __uint_as_float(u.w << 16) * w1.z; cv[7] += __uint_as_float(u.w & 0xffff0000u) * w1.w; } \
            _Pragma("unroll") for (int e = 0; e < 8; e++) { \
                const float sv = cv[e] * sigmoidf_(cv[e]); \
                if (m == 0) { qv[8 * ck + e] = sv; sq += sv * sv; } else if (m == 1) { kv[8 * ck + e] = sv; sk += sv * sv; } else cv[e] = sv * bi; } \
            if (m == 2) *(uint4*)(xs + i * XSS + 32 * cg + 8 * ck) = make_uint4(pk2(cv[0], cv[1]), pk2(cv[2], cv[3]), pk2(cv[4], cv[5]), pk2(cv[6], cv[7])); } \
            __builtin_amdgcn_sched_barrier(0); }
        GP_LOAD(xa, 0)
        GP_LOAD(xb, 1) GP_COMP(xa, 0)
        GP_LOAD(xa, 2) GP_COMP(xb, 1)
        GP_LOAD(xb, 3) GP_COMP(xa, 2)
        GP_LOAD(xa, 4) GP_COMP(xb, 3)
        GP_LOAD(xb, 5) GP_COMP(xa, 4)
        GP_COMP(xb, 5)
#undef GP_LOAD
#undef GP_COMP
        sq += dppf<0xB1>(sq); sq += dppf<0x4E>(sq);
        sk += dppf<0xB1>(sk); sk += dppf<0x4E>(sk);
        const float rq = rsqrtf(sq + 1e-6f) * 0.08838834764831845f, rk = rsqrtf(sk + 1e-6f);
        const float rqe = rq * ei, rkw = rk * bi * ei;
        unsigned char* qd = (unsigned char*)gqd + (size_t)chunk * 8192 + i * 128 + 32 * cg;
        const float rq8 = rqe * GQ_SCALE;
        unsigned qw[8];
#pragma unroll
        for (int ck = 0; ck < 4; ck++) {
            const float* q8 = qv + 8 * ck; const float* k8 = kv + 8 * ck;
            *(uint4*)(qL + i * KLS + 32 * cg + 8 * ck) = make_uint4(pk2(q8[0] * rq, q8[1] * rq), pk2(q8[2] * rq, q8[3] * rq), pk2(q8[4] * rq, q8[5] * rq), pk2(q8[6] * rq, q8[7] * rq));
            *(uint4*)(kL + i * KLS + 32 * cg + 8 * ck) = make_uint4(pk2(k8[0] * rk, k8[1] * rk), pk2(k8[2] * rk, k8[3] * rk), pk2(k8[4] * rk, k8[5] * rk), pk2(k8[6] * rk, k8[7] * rk));
            *(uint4*)(xs + i * XSS + 128 + 32 * cg + 8 * ck) = make_uint4(pk2(k8[0] * rkw, k8[1] * rkw), pk2(k8[2] * rkw, k8[3] * rkw), pk2(k8[4] * rkw, k8[5] * rkw), pk2(k8[6] * rkw, k8[7] * rkw));
            qw[2 * ck] = pk4_fp8(q8[0] * rq8, q8[1] * rq8, q8[2] * rq8, q8[3] * rq8); qw[2 * ck + 1] = pk4_fp8(q8[4] * rq8, q8[5] * rq8, q8[6] * rq8, q8[7] * rq8);
        }
        *(uint4*)qd = make_uint4(qw[0], qw[1], qw[2], qw[3]); *(uint4*)(qd + 16) = make_uint4(qw[4], qw[5], qw[6], qw[7]);
    }
    __syncthreads();
    const int n16 = lane & 15, kq = lane >> 4;
    f32x4 aqk[4], akk[4];
#pragma unroll
    for (int tj = 0; tj < 4; tj++) { aqk[tj] = (f32x4){0.f, 0.f, 0.f, 0.f}; akk[tj] = (f32x4){0.f, 0.f, 0.f, 0.f}; }
#pragma unroll
    for (int ks = 0; ks < 4; ks++) {
        bf16x8 qa = *(const bf16x8*)(qL + (16 * w + n16) * KLS + 32 * ks + 8 * kq);
        bf16x8 ka = *(const bf16x8*)(kL + (16 * w + n16) * KLS + 32 * ks + 8 * kq);
#pragma unroll
        for (int tj = 0; tj < 4; tj++) {
            bf16x8 kb = *(const bf16x8*)(kL + (16 * tj + n16) * KLS + 32 * ks + 8 * kq);
            aqk[tj] = __builtin_amdgcn_mfma_f32_16x16x32_bf16(qa, kb, aqk[tj], 0, 0, 0);
            akk[tj] = __builtin_amdgcn_mfma_f32_16x16x32_bf16(ka, kb, akk[tj], 0, 0, 0);
        }
    }
    {
        const float glast = gcs[63];
        const int kidx = tid >> 1, c0 = (tid & 1) * 32;
        unsigned pk[8];
#pragma unroll
        for (int cc = 0; cc < 32; cc += 4) {
            float v4[4];
#pragma unroll
            for (int e = 0; e < 4; e++) v4[e] = bf2f(kL[(c0 + cc + e) * KLS + kidx]) * __expf(glast - gcs[c0 + cc + e]) * GK_SCALE;
            pk[cc >> 2] = pk4_fp8(v4[0], v4[1], v4[2], v4[3]);
        }
        uint4* dst = (uint4*)((unsigned char*)gkdT + (size_t)chunk * 8192 + kidx * 64 + c0);
        dst[0] = make_uint4(pk[0], pk[1], pk[2], pk[3]); dst[1] = make_uint4(pk[4], pk[5], pk[6], pk[7]);
        if (tid == 0) gl[chunk] = __expf(glast);
    }
    __syncthreads();
#pragma unroll
    for (int tj = 0; tj < 4; tj++)
#pragma unroll
        for (int r = 0; r < 4; r++) {
            const int i = 16 * w + 4 * kq + r, j = 16 * tj + n16;
            const float dec = (j <= i) ? __expf(gcs[i] - gcs[j]) : 0.f;
            gin[(size_t)chunk * 4096 + i * 64 + j] = f2bf(aqk[tj][r] * dec);
            AmT[j * 64 + i] = (j < i) ? bts[i] * akk[tj][r] * dec : 0.f;
        }
    __syncthreads();
    {
        const int c = tid;
#pragma unroll 1
        for (int blk = 0; blk < 8; blk++) {
            const int i0 = blk * 8;
            float acc[8];
#pragma unroll
            for (int r = 0; r < 8; r++) acc[r] = bf2f(xs[(i0 + r) * XSS + c]);
#pragma unroll 1
            for (int jb = 0; jb < blk; jb++) {
#pragma unroll
                for (int jj = 0; jj < 8; jj++) {
                    const int j = jb * 8 + jj;
                    const float xj = bf2f(xs[j * XSS + c]);
                    const float4 a0 = *(const float4*)(AmT + j * 64 + i0), a1 = *(const float4*)(AmT + j * 64 + i0 + 4);
                    acc[0] -= a0.x * xj; acc[1] -= a0.y * xj; acc[2] -= a0.z * xj; acc[3] -= a0.w * xj;
                    acc[4] -= a1.x * xj; acc[5] -= a1.y * xj; acc[6] -= a1.z * xj; acc[7] -= a1.w * xj;
                }
            }
#pragma unroll
            for (int r = 1; r < 8; r++)
#pragma unroll
                for (int s2 = 0; s2 < r; s2++) acc[r] -= AmT[(i0 + s2) * 64 + i0 + r] * acc[s2];
#pragma unroll
            for (int r = 0; r < 8; r++) xs[(i0 + r) * XSS + c] = f2bf(acc[r]);
            if (c < 128) {
                *(uint4*)(guT + (size_t)chunk * 8192 + c * 64 + i0) =
                    make_uint4(pack2bf(acc[0], acc[1]), pack2bf(acc[2], acc[3]), pack2bf(acc[4], acc[5]), pack2bf(acc[6], acc[7]));
            }
        }
    }
    __syncthreads();
    {
        const int i = tid >> 2, sg = tid & 3;
        unsigned ww[8];
#pragma unroll
        for (int ck = 0; ck < 4; ck++) {
            const uint4 u = *(const uint4*)(xs + i * XSS + 128 + 32 * sg + 8 * ck);
            ww[2 * ck] = pk4_fp8(__uint_as_float(u.x << 16) * GW_SCALE, __uint_as_float(u.x & 0xffff0000u) * GW_SCALE, __uint_as_float(u.y << 16) * GW_SCALE, __uint_as_float(u.y & 0xffff0000u) * GW_SCALE);
            ww[2 * ck + 1] = pk4_fp8(__uint_as_float(u.z << 16) * GW_SCALE, __uint_as_float(u.z & 0xffff0000u) * GW_SCALE, __uint_as_float(u.w << 16) * GW_SCALE, __uint_as_float(u.w & 0xffff0000u) * GW_SCALE);
        }
        unsigned char* wd = (unsigned char*)gw + (size_t)chunk * 8192 + i * 128 + 32 * sg;
        *(uint4*)wd = make_uint4(ww[0], ww[1], ww[2], ww[3]); *(uint4*)(wd + 16) = make_uint4(ww[4], ww[5], ww[6], ww[7]);
    }
}

#define GNT 2
struct GdnFrag { u32x4 w8[2], q8[2], kd8[2]; bf16x8 inA[2]; uint2 uC[GNT]; float glv; };
__device__ __forceinline__ void gdn_load_frag(GdnFrag& f, const bf16_t* __restrict__ guT, const bf16_t* __restrict__ gw, const bf16_t* __restrict__ gqd,
                                              const bf16_t* __restrict__ gkdT, const bf16_t* __restrict__ gin, const float* __restrict__ gl,
                                              int chunk, int w, int sl, int n16, int kq) {
    const size_t cb = (size_t)chunk * 8192;
    const unsigned char* wr = (const unsigned char*)gw + cb + (16 * w + n16) * 128 + 16 * kq;
    const unsigned char* qr = (const unsigned char*)gqd + cb + (16 * w + n16) * 128 + 16 * kq;
    f.w8[0] = *(const u32x4*)wr; f.w8[1] = *(const u32x4*)(wr + 64);
    f.q8[0] = *(const u32x4*)qr; f.q8[1] = *(const u32x4*)(qr + 64);
#pragma unroll
    for (int hh = 0; hh < 2; hh++) f.kd8[hh] = *(const u32x4*)((const unsigned char*)gkdT + cb + (32 * w + 16 * hh + n16) * 64 + 16 * kq);
#pragma unroll
    for (int ks = 0; ks < 2; ks++) f.inA[ks] = *(const bf16x8*)(gin + (size_t)chunk * 4096 + (16 * w + n16) * 64 + 16 * kq + 8 * ks);
#pragma unroll
    for (int nt = 0; nt < GNT; nt++) f.uC[nt] = *(const uint2*)(guT + cb + (16 * (GNT * sl + nt) + n16) * 64 + 16 * w + 4 * kq);
    f.glv = gl[chunk];
}
#define STS 144
#define VNS 80
__device__ __forceinline__ void gdn_step(const GdnFrag& f, f32x4 (&S)[2][GNT], bf16_t* StT, bf16_t* vnT, float* __restrict__ ogrow, int w, int n16, int kq) {
    bf16x8 wA[4], qA[4], kdA[2][2];
#pragma unroll
    for (int ks = 0; ks < 4; ks++) {
        wA[ks] = fp8x8_bf16(f.w8[ks >> 1][2 * (ks & 1)], f.w8[ks >> 1][2 * (ks & 1) + 1]);
        qA[ks] = fp8x8_bf16(f.q8[ks >> 1][2 * (ks & 1)], f.q8[ks >> 1][2 * (ks & 1) + 1]);
    }
    f32x4 qs[GNT];
#pragma unroll
    for (int nt = 0; nt < GNT; nt++) {
        f32x4 ws = (f32x4){0.f, 0.f, 0.f, 0.f};
        qs[nt] = (f32x4){0.f, 0.f, 0.f, 0.f};
#pragma unroll
        for (int ks = 0; ks < 4; ks++) {
            bf16x8 sb = *(const bf16x8*)(StT + (16 * nt + n16) * STS + 64 * (ks >> 1) + 16 * kq + 8 * (ks & 1));
            ws = __builtin_amdgcn_mfma_f32_16x16x32_bf16(wA[ks], sb, ws, 0, 0, 0);
            qs[nt] = __builtin_amdgcn_mfma_f32_16x16x32_bf16(qA[ks], sb, qs[nt], 0, 0, 0);
        }
        const float iw = 1.f / GW_SCALE;
        float v0 = __uint_as_float(f.uC[nt].x << 16) - ws[0] * iw, v1 = __uint_as_float(f.uC[nt].x & 0xffff0000u) - ws[1] * iw;
        float v2 = __uint_as_float(f.uC[nt].y << 16) - ws[2] * iw, v3 = __uint_as_float(f.uC[nt].y & 0xffff0000u) - ws[3] * iw;
        *(uint2*)(vnT + (16 * nt + n16) * VNS + 16 * w + 4 * kq) = make_uint2(pack2bf(v0, v1), pack2bf(v2, v3));
    }
#pragma unroll
    for (int hh = 0; hh < 2; hh++)
#pragma unroll
        for (int ks = 0; ks < 2; ks++) kdA[hh][ks] = fp8x8_bf16(f.kd8[hh][2 * ks], f.kd8[hh][2 * ks + 1]);
    __syncthreads();
#pragma unroll
    for (int nt = 0; nt < GNT; nt++) {
        bf16x8 vb0 = *(const bf16x8*)(vnT + (16 * nt + n16) * VNS + 16 * kq), vb1 = *(const bf16x8*)(vnT + (16 * nt + n16) * VNS + 16 * kq + 8);
        f32x4 q = qs[nt] * (1.f / GQ_SCALE);
        q = __builtin_amdgcn_mfma_f32_16x16x32_bf16(f.inA[0], vb0, q, 0, 0, 0);
        q = __builtin_amdgcn_mfma_f32_16x16x32_bf16(f.inA[1], vb1, q, 0, 0, 0);
        f32x4 c0 = (f32x4){0.f, 0.f, 0.f, 0.f}, c1 = (f32x4){0.f, 0.f, 0.f, 0.f};
        c0 = __builtin_amdgcn_mfma_f32_16x16x32_bf16(kdA[0][0], vb0, c0, 0, 0, 0);
        c0 = __builtin_amdgcn_mfma_f32_16x16x32_bf16(kdA[0][1], vb1, c0, 0, 0, 0);
        c1 = __builtin_amdgcn_mfma_f32_16x16x32_bf16(kdA[1][0], vb0, c1, 0, 0, 0);
        c1 = __builtin_amdgcn_mfma_f32_16x16x32_bf16(kdA[1][1], vb1, c1, 0, 0, 0);
        const f32x4 s0 = S[0][nt] * f.glv + c0 * (1.f / GK_SCALE), s1 = S[1][nt] * f.glv + c1 * (1.f / GK_SCALE);
        S[0][nt] = s0; S[1][nt] = s1;
#pragma unroll
        for (int r = 0; r < 4; r++) ogrow[(size_t)(4 * kq + r) * 512 + 16 * nt] = q[r];
        *(uint2*)(StT + (16 * nt + n16) * STS + 32 * w + 4 * kq) = make_uint2(pack2bf(s0[0], s0[1]), pack2bf(s0[2], s0[3]));
        *(uint2*)(StT + (16 * nt + n16) * STS + 32 * w + 16 + 4 * kq) = make_uint2(pack2bf(s1[0], s1[1]), pack2bf(s1[2], s1[3]));
    }
    __syncthreads();
}
#define GDN_SCAN_ITEMS (8 * 8 / GNT)
__device__ __forceinline__ void d_gdn_scan2(const bf16_t* __restrict__ guT, const bf16_t* __restrict__ gw, const bf16_t* __restrict__ gqd,
                                            const bf16_t* __restrict__ gkdT, const bf16_t* __restrict__ gin, const float* __restrict__ gl,
                                            float* __restrict__ og, int item, char* smem) {
    bf16_t* StT = (bf16_t*)smem;
    bf16_t* vnT = StT + 16 * GNT * STS;
    const int tid = opaque_tid(), lane = tid & 63, w = tid >> 6, n16 = lane & 15, kq = lane >> 4;
    const int bh = item & 7, sl = item >> 3, b = bh >> 2, h = bh & 3;
    for (int i = tid; i < 16 * GNT * STS / 2; i += 256) ((unsigned*)StT)[i] = 0u;
    f32x4 S[2][GNT];
#pragma unroll
    for (int nt = 0; nt < GNT; nt++) { S[0][nt] = (f32x4){0.f, 0.f, 0.f, 0.f}; S[1][nt] = (f32x4){0.f, 0.f, 0.f, 0.f}; }
    GdnFrag fa, fb, fc;
    gdn_load_frag(fa, guT, gw, gqd, gkdT, gin, gl, bh * 128, w, sl, n16, kq);
    gdn_load_frag(fb, guT, gw, gqd, gkdT, gin, gl, bh * 128 + 1, w, sl, n16, kq);
    __syncthreads();
    float* obase = og + (size_t)(b * SEQ + 16 * w) * 512 + h * 128 + 16 * GNT * sl + n16;
#pragma unroll 1
    for (int n = 0; n < 128; n += 3) {
        if (n + 2 < 128) gdn_load_frag(fc, guT, gw, gqd, gkdT, gin, gl, bh * 128 + n + 2, w, sl, n16, kq);
        __builtin_amdgcn_sched_barrier(0);
        gdn_step(fa, S, StT, vnT, obase + (size_t)(n * 64) * 512, w, n16, kq);
        if (n + 3 < 128) gdn_load_frag(fa, guT, gw, gqd, gkdT, gin, gl, bh * 128 + n + 3, w, sl, n16, kq);
        __builtin_amdgcn_sched_barrier(0);
        gdn_step(fb, S, StT, vnT, obase + (size_t)((n + 1) * 64) * 512, w, n16, kq);
        if (n + 2 < 128) {
            if (n + 4 < 128) gdn_load_frag(fb, guT, gw, gqd, gkdT, gin, gl, bh * 128 + n + 4, w, sl, n16, kq);
            __builtin_amdgcn_sched_barrier(0);
            gdn_step(fc, S, StT, vnT, obase + (size_t)((n + 2) * 64) * 512, w, n16, kq);
        }
    }
}

__device__ __forceinline__ void d_gdn_out(const float* __restrict__ og, const bf16_t* __restrict__ proj, const float* __restrict__ gain, bf16_t* __restrict__ mix, int t, int lane) {
    const float* o = og + (size_t)t * 512;
    const bf16_t* z = proj + (size_t)t * PLD + C_Z;
    float a[8], zz[8];
#pragma unroll
    for (int i = 0; i < 8; i++) { a[i] = o[lane + 64 * i]; zz[i] = bf2f(z[lane + 64 * i]); }
    const float g0 = gain[lane], g1 = gain[lane + 64];
#pragma unroll
    for (int h = 0; h < 4; h++) {
        const float ss = wave_sum_dpp(a[2 * h] * a[2 * h] + a[2 * h + 1] * a[2 * h + 1]);
        const float r = rsqrtf(ss * (1.f / 128.f) + 1e-6f);
        mix[(size_t)t * DM + 512 + h * 128 + lane] = f2bf(a[2 * h] * r * g0 * zz[2 * h] * sigmoidf_(zz[2 * h]));
        mix[(size_t)t * DM + 512 + h * 128 + lane + 64] = f2bf(a[2 * h + 1] * r * g1 * zz[2 * h + 1] * sigmoidf_(zz[2 * h + 1]));
    }
}

__device__ __forceinline__ void route_load_subkeys(const float* __restrict__ subkeys, char* smem) {
    for (int idx = threadIdx.x; idx < 2 * 128 * 16; idx += 256) {
        const int half = idx >> 11, key = (idx >> 4) & 127, ch = idx & 15;
        const float* src = subkeys + ((size_t)(half * 128 + key)) * 128 + ch * 8;
        const float4 x0 = *(const float4*)src, x1 = *(const float4*)(src + 4);
        *(uint4*)(smem + half * 32768 + key * 256 + ((ch ^ (key & 15)) << 4)) = make_uint4(pk2(x0.x, x0.y), pk2(x0.z, x0.w), pk2(x1.x, x1.y), pk2(x1.z, x1.w));
    }
}
__device__ __forceinline__ unsigned f2ord(float f) { const int b = __float_as_int(f); return (unsigned)(b ^ ((b >> 31) | (int)0x80000000)); }
__device__ __forceinline__ float ord2f(unsigned k) { const int m = (int)k >> 31; return __int_as_float((int)(k ^ (unsigned)((~m) | (int)0x80000000))); }
#define CEX(i, j) { const unsigned _a = v[i], _b = v[j]; v[i] = max(_a, _b); v[j] = min(_a, _b); }
__device__ __forceinline__ void d_peer_route2(const bf16_t* __restrict__ qry, int* __restrict__ eidx, float* __restrict__ pgate, int mtile, const char* smem, int lane) {
    const int n16 = lane & 15, kq = lane >> 4;
    const int tA = 2 * mtile + (n16 >> 3), hA = n16 & 7;
    unsigned topk[2][4];
#pragma unroll
    for (int half = 0; half < 2; half++) {
        const bf16_t* qp = qry + (size_t)tA * 2048 + hA * 256 + half * 128 + 8 * kq;
        bf16x8 a[4];
#pragma unroll
        for (int ks = 0; ks < 4; ks++) a[ks] = *(const bf16x8*)(qp + 32 * ks);
        f32x4 acc[8];
#pragma unroll
        for (int nt = 0; nt < 8; nt++) acc[nt] = (f32x4){0.f, 0.f, 0.f, 0.f};
#pragma unroll
        for (int ks = 0; ks < 4; ks++)
#pragma unroll
            for (int nt = 0; nt < 8; nt++) {
                const bf16x8 bb = *(const bf16x8*)(smem + half * 32768 + (16 * nt + n16) * 256 + (((4 * ks + kq) ^ n16) << 4));
                acc[nt] = __builtin_amdgcn_mfma_f32_16x16x32_bf16(a[ks], bb, acc[nt], 0, 0, 0);
                if (nt == 3 || nt == 7) __builtin_amdgcn_sched_barrier(0);
            }
#pragma unroll
        for (int r = 0; r < 4; r++) {
            unsigned v[8];
#pragma unroll
            for (int nt = 0; nt < 8; nt++) v[nt] = (f2ord(acc[nt][r]) & 0xFFFFFF80u) | (unsigned)(nt << 4) | (unsigned)n16;
            CEX(0, 1) CEX(2, 3) CEX(4, 5) CEX(6, 7) CEX(0, 2) CEX(1, 3) CEX(4, 6) CEX(5, 7) CEX(1, 2) CEX(5, 6)
            CEX(0, 4) CEX(1, 5) CEX(2, 6) CEX(3, 7) CEX(2, 4) CEX(3, 5) CEX(1, 2) CEX(3, 4) CEX(5, 6)
            unsigned keep = 0u;
#pragma unroll 1
            for (int it = 0; it < 16; it++) {
                const unsigned mx = allmaxu16(v[0]);
                if (n16 == it) keep = mx;
                if (v[0] == mx) { v[0] = v[1]; v[1] = v[2]; v[2] = v[3]; v[3] = v[4]; v[4] = v[5]; v[5] = v[6]; v[6] = v[7]; v[7] = 0u; }
            }
            topk[half][r] = keep;
            __builtin_amdgcn_sched_barrier(0);
        }
    }
    const int lanebase = lane & 48;
    int si[4], sj[4];
    si[0] = 0; sj[0] = n16;
    si[1] = n16 < 8 ? 1 : (n16 < 13 ? 2 : 4);  sj[1] = n16 < 8 ? n16 : (n16 < 13 ? n16 - 8 : n16 - 13);
    si[2] = n16 < 4 ? 3 : (n16 < 6 ? 5 : (n16 < 8 ? 6 : (n16 < 10 ? 7 : n16 - 2)));
    sj[2] = n16 < 4 ? n16 : (n16 < 6 ? n16 - 4 : (n16 < 8 ? n16 - 6 : (n16 < 10 ? n16 - 8 : 0)));
    si[3] = 14 + (n16 & 1); sj[3] = 0;
#pragma unroll
    for (int r = 0; r < 4; r++) {
        const unsigned k1 = topk[0][r], k2 = topk[1][r];
        const int f1 = (int)((__float_as_uint(ord2f(k1)) & 0xFFFFFF80u) | (k1 & 127u)), f2 = (int)((__float_as_uint(ord2f(k2)) & 0xFFFFFF80u) | (k2 & 127u));
        unsigned v[4], es[4];
#pragma unroll
        for (int q = 0; q < 4; q++) {
            const unsigned av = (unsigned)__builtin_amdgcn_ds_bpermute((lanebase + si[q]) * 4, f1), bv = (unsigned)__builtin_amdgcn_ds_bpermute((lanebase + sj[q]) * 4, f2);
            es[q] = ((av & 127u) << 7) | (bv & 127u);
            v[q] = (f2ord(__uint_as_float(av) + __uint_as_float(bv)) & 0xFFFFFFC0u) | (unsigned)(q << 4) | (unsigned)n16;
        }
        if (n16 >= 2) v[3] = 0u;
        CEX(0, 1) CEX(2, 3) CEX(0, 2) CEX(1, 3) CEX(1, 2)
        unsigned keep = 0u;
#pragma unroll 1
        for (int it = 0; it < 16; it++) {
            const unsigned mx = allmaxu16(v[0]);
            if (n16 == it) keep = mx;
            if (v[0] == mx) { v[0] = v[1]; v[1] = v[2]; v[2] = v[3]; v[3] = 0u; }
        }
        const int src = (lanebase + (int)(keep & 15u)) * 4;
        const unsigned e0 = (unsigned)__builtin_amdgcn_ds_bpermute(src, (int)es[0]), e1 = (unsigned)__builtin_amdgcn_ds_bpermute(src, (int)es[1]);
        const unsigned e2 = (unsigned)__builtin_amdgcn_ds_bpermute(src, (int)es[2]), e3 = (unsigned)__builtin_amdgcn_ds_bpermute(src, (int)es[3]);
        const unsigned qw = (keep >> 4) & 3u;
        const unsigned ke = qw == 0u ? e0 : (qw == 1u ? e1 : (qw == 2u ? e2 : e3));
        const float ksc = ord2f(keep & 0xFFFFFFC0u);
        const float smax = ord2f(allmaxu16(keep) & 0xFFFFFFC0u);
        const float ex = __expf(ksc - smax);
        const float sum = allsum16(ex);
        const int row = 4 * kq + r;
        const size_t o = (size_t)(2 * mtile + (row >> 3)) * 128 + (row & 7) * 16 + n16;
        eidx[o] = (int)ke; pgate[o] = ex / sum;
    }
}
#undef CEX

#define XB_TMO      128
#define XB_XCNT(j)  (256  + 64 * (j))
#define XB_XSUB(j)  (1280 + 64 * (j))
#define XB_XGEN(j)  (2304 + 64 * (j))
#define XB_TOP      3328
#define XB_TOPGEN   3392
#define XB_QUEUE    3456
#define XL_CNT(j)    (4096 + 64 * (j))
#define XL_GEN(j)    (5120 + 64 * (j))
#define XCD_BAR_WORDS 6144
#define XB_SPIN_CAP (1u << 22)
#define LAS __attribute__((address_space(3)))
__device__ __forceinline__ unsigned xb_ld(unsigned* p)              { return __hip_atomic_load(p, __ATOMIC_RELAXED, __HIP_MEMORY_SCOPE_AGENT); }
__device__ __forceinline__ unsigned xb_add(unsigned* p, unsigned v) { return __hip_atomic_fetch_add(p, v, __ATOMIC_RELAXED, __HIP_MEMORY_SCOPE_AGENT); }
__device__ __forceinline__ unsigned xb_xcc_id() { return (unsigned)__builtin_amdgcn_s_getreg((3 << 11) | 20) & 0xFu; }
#define XB_SPIN(cond, bar) do { unsigned _sp = 0; while (cond) { __builtin_amdgcn_s_sleep(1); \
    if ((++_sp & 255u) == 0u) { if (xb_ld(&(bar)[XB_TMO])) break; if (_sp > XB_SPIN_CAP) { atomicAdd(&(bar)[XB_TMO], 1u); break; } } } } while (0)
struct XcdBarrier { unsigned* bar; unsigned x; volatile LAS unsigned* st; };
__device__ __forceinline__ XcdBarrier xcd_barrier_post(unsigned* bar, volatile LAS unsigned* st) {
    XcdBarrier b; b.bar = bar; b.x = xb_xcc_id(); b.st = st;
    if (threadIdx.x == 0) (void)xb_add(&bar[XB_XCNT(b.x)], 1u);
    return b;
}
__device__ __forceinline__ void xcd_barrier_complete(unsigned* bar, unsigned x, unsigned& nloc, unsigned& nx) {
    const unsigned G = gridDim.x * gridDim.y * gridDim.z;
    unsigned sum, cnt, mine, sp = 0u;
    for (;;) {
        sum = 0u; cnt = 0u; mine = 0u;
#pragma unroll
        for (unsigned j = 0; j < 16; ++j) { const unsigned c = xb_ld(&bar[XB_XCNT(j)]); sum += c; cnt += (c > 0u) ? 1u : 0u; mine = (j == x) ? c : mine; }
        if (sum == G) break;
        __builtin_amdgcn_s_sleep(1);
        if ((++sp & 255u) == 0u) { if (xb_ld(&bar[XB_TMO])) break; if (sp > XB_SPIN_CAP) { atomicAdd(&bar[XB_TMO], 1u); break; } }
    }
    nloc = mine > 0u ? mine : 1u; nx = cnt > 0u ? cnt : 1u;
}
__device__ __forceinline__ void xcd_barrier(const XcdBarrier& b) {
    asm volatile("s_waitcnt vmcnt(0)" ::: "memory");
    __syncthreads();
    if (threadIdx.x == 0) {
        unsigned* bar = b.bar;
        __builtin_amdgcn_s_waitcnt(0);
        unsigned nloc = b.st[0], nx = b.st[1];
        if (nloc == 0u) { xcd_barrier_complete(bar, b.x, nloc, nx); b.st[0] = nloc; b.st[1] = nx; }
        const unsigned old = xb_add(&bar[XB_XSUB(b.x)], 1u);
        const unsigned gen = old / nloc;
        if (old + 1u == (gen + 1u) * nloc) {
            __builtin_amdgcn_fence(__ATOMIC_RELEASE, "agent");
            asm volatile("s_waitcnt vmcnt(0)" ::: "memory");
            const unsigned og = xb_add(&bar[XB_TOP], 1u);
            const unsigned tg = og / nx;
            if (og + 1u == (tg + 1u) * nx) xb_add(&bar[XB_TOPGEN], 1u);
            else XB_SPIN(xb_ld(&bar[XB_TOPGEN]) == tg, bar);
            __builtin_amdgcn_fence(__ATOMIC_ACQUIRE, "agent");
            xb_add(&bar[XB_XGEN(b.x)], 1u);
            asm volatile("s_waitcnt vmcnt(0)" ::: "memory");
        } else {
            XB_SPIN(xb_ld(&bar[XB_XGEN(b.x)]) == gen, bar);
            __builtin_amdgcn_fence(__ATOMIC_ACQUIRE, "agent");
            asm volatile("s_waitcnt vmcnt(0)" ::: "memory");
        }
    }
    __syncthreads();
}

__device__ __forceinline__ void xcd_local_sync(const XcdBarrier& b, unsigned round) {
    __syncthreads();
    if (threadIdx.x == 0) {
        unsigned nloc = b.st[0]; if (nloc == 0u) nloc = 1u;
        const unsigned old = xb_add(&b.bar[XL_CNT(b.x)], 1u);
        if (old + 1u == nloc * (round + 1u)) xb_add(&b.bar[XL_GEN(b.x)], 1u);
        else { unsigned sp = 0; while (xb_ld(&b.bar[XL_GEN(b.x)]) <= round && ++sp < (1u << 16)) __builtin_amdgcn_s_sleep(1); }
    }
    __syncthreads();
}

struct QRow { float4 x[4]; };
__device__ __forceinline__ void quant_load(QRow& q, const float* __restrict__ src, int row, int lane) {
    const float4* p = (const float4*)(src + (size_t)row * DM) + lane * 4;
#pragma unroll
    for (int i = 0; i < 4; i++) q.x[i] = p[i];
}
__device__ __forceinline__ void quant_finish(const QRow& q, unsigned char* __restrict__ dst, float* __restrict__ scale, int row, int lane, int bias) {
    float am = 0.f;
#pragma unroll
    for (int i = 0; i < 4; i++) am = fmaxf(am, fmaxf(fmaxf(fabsf(q.x[i].x), fabsf(q.x[i].y)), fmaxf(fabsf(q.x[i].z), fabsf(q.x[i].w))));
    am = wave_max(am);
    const float sc = (am > 0.f) ? am * (bias ? (1.f / 224.f) : (1.f / 127.f)) : 1.f;
    const float inv = 1.f / sc;
    unsigned wv[4];
#pragma unroll
    for (int i = 0; i < 4; i++) {
        if (bias) {
            int w = 0;
            w = __builtin_amdgcn_cvt_pk_fp8_f32(q.x[i].x * inv, q.x[i].y * inv, w, false);
            w = __builtin_amdgcn_cvt_pk_fp8_f32(q.x[i].z * inv, q.x[i].w * inv, w, true);
            wv[i] = (unsigned)w;
        } else {
            const int q0 = (int)rintf(q.x[i].x * inv), q1 = (int)rintf(q.x[i].y * inv), q2 = (int)rintf(q.x[i].z * inv), q3 = (int)rintf(q.x[i].w * inv);
            wv[i] = (unsigned)(q0 & 0xff) | ((unsigned)(q1 & 0xff) << 8) | ((unsigned)(q2 & 0xff) << 16) | ((unsigned)(q3 & 0xff) << 24);
        }
    }
    ((uint4*)(dst + (size_t)row * (2 * DM)))[lane] = make_uint4(wv[0], wv[1], wv[2], wv[3]);
    if (lane == 0) scale[row] = sc;
}
__device__ __forceinline__ void d_quant_rows16(const float* __restrict__ pu, const float* __restrict__ pv, unsigned char* __restrict__ dst,
                                               float* __restrict__ su, float* __restrict__ sv, int r0, int lane) {
#pragma unroll 1
    for (int r = r0; r < r0 + 16; r += 2) {
        QRow a0, a1, b0, b1;
        quant_load(a0, pu, r, lane); quant_load(b0, pv, r, lane); quant_load(a1, pu, r + 1, lane); quant_load(b1, pv, r + 1, lane);
        quant_finish(a0, dst, su, r, lane, 0); quant_finish(b0, dst + DM, sv, r, lane, 128);
        quant_finish(a1, dst, su, r + 1, lane, 0); quant_finish(b1, dst + DM, sv, r + 1, lane, 128);
    }
}

struct PeerGrp { u32x4 u[4]; u32x4 v[4]; float gvl, sul; };
__device__ __forceinline__ void peer_load(PeerGrp& G, const unsigned char* __restrict__ uq, const unsigned char* __restrict__ vq,
                                          int esrc, float gsrc, float susrc, int k0, int lane) {
    const int sl = 4 * (k0 + 2 * (lane & 1) + ((lane >> 1) & 1));
    G.gvl = __builtin_bit_cast(float, __builtin_amdgcn_ds_bpermute(sl, __builtin_bit_cast(int, gsrc)));
    G.sul = __builtin_bit_cast(float, __builtin_amdgcn_ds_bpermute(sl, __builtin_bit_cast(int, susrc)));
#pragma unroll
    for (int i = 0; i < 4; i++) {
        const int e = __builtin_amdgcn_readlane(esrc, (k0 + i) & 63);
        G.u[i] = ((const u32x4*)(uq + (size_t)e * (2 * DM)))[lane];
        G.v[i] = ((const u32x4*)(uq + (size_t)e * (2 * DM) + DM))[lane];
    }
}
__device__ __forceinline__ void peer_compute(const PeerGrp& G, const int (&xq)[4], float sx, float (&acc)[16], float& bsum, int lane) {
    int d[4];
#pragma unroll
    for (int i = 0; i < 4; i++) {
        int sdot = 0;
        sdot = __builtin_amdgcn_sdot4((int)G.u[i][0], xq[0], sdot, false); sdot = __builtin_amdgcn_sdot4((int)G.u[i][1], xq[1], sdot, false);
        sdot = __builtin_amdgcn_sdot4((int)G.u[i][2], xq[2], sdot, false); sdot = __builtin_amdgcn_sdot4((int)G.u[i][3], xq[3], sdot, false);
        d[i] = sdot;
    }
    const bool odd = lane & 1, b1 = lane & 2;
    int ka = odd ? d[2] : d[0], kb = odd ? d[3] : d[1];
    const int sa = odd ? d[0] : d[2], sb = odd ? d[1] : d[3];
    ka += (int)dppu<0xB1>((unsigned)sa); kb += (int)dppu<0xB1>((unsigned)sb);
    int c = b1 ? kb : ka;
    const int sc = b1 ? ka : kb;
    c += (int)dppu<0x4E>((unsigned)sc);
    c += (int)dppu<0x124>((unsigned)c); c += (int)dppu<0x128>((unsigned)c);
    { auto r = __builtin_amdgcn_permlane16_swap((unsigned)c, (unsigned)c, false, false); c = (int)(r[0] + r[1]); }
    { auto r = __builtin_amdgcn_permlane32_swap((unsigned)c, (unsigned)c, false, false); c = (int)(r[0] + r[1]); }
    const float dot = (float)c * (G.sul * sx);
    const float u2 = 1.5957691216057308f * (dot + 0.044715f * dot * dot * dot);
    const float csl = G.gvl * dot * __builtin_amdgcn_rcpf(1.f + __expf(-u2));
#pragma unroll
    for (int i = 0; i < 4; i++) {
        const float cs = __builtin_bit_cast(float, __builtin_amdgcn_readlane(__builtin_bit_cast(int, csl), ((i & 1) << 1) | (i >> 1)));
        const f32x2 cs2 = (f32x2){cs, cs};
#pragma unroll
        for (int j = 0; j < 4; j++) {
            const int wv = (int)G.v[i][j];
            const f32x2 lo = __builtin_amdgcn_cvt_pk_f32_fp8(wv, false), hi = __builtin_amdgcn_cvt_pk_f32_fp8(wv, true);
            f32x2 a0 = (f32x2){acc[4 * j], acc[4 * j + 1]}, a1 = (f32x2){acc[4 * j + 2], acc[4 * j + 3]};
            a0 = __builtin_elementwise_fma(cs2, lo, a0); a1 = __builtin_elementwise_fma(cs2, hi, a1);
            acc[4 * j] = a0[0]; acc[4 * j + 1] = a0[1]; acc[4 * j + 2] = a1[0]; acc[4 * j + 3] = a1[1];
        }
    }
}
struct PeerTok { int xq[4]; float sx; int e_lo, e_hi; float g_lo, g_hi, s_lo, s_hi; };
__device__ __forceinline__ void peer_prep_token(PeerTok& T, const bf16_t* __restrict__ h2, const int* __restrict__ eidx, const float* __restrict__ pgate,
                                                const float* __restrict__ su, const float* __restrict__ sv, const float* __restrict__ ssq, const float* __restrict__ fgain, int token, int lane) {
    const uint4 xa = ((const uint4*)(h2 + (size_t)token * DM))[2 * lane], xb = ((const uint4*)(h2 + (size_t)token * DM))[2 * lane + 1];
    const unsigned xw[8] = {xa.x, xa.y, xa.z, xa.w, xb.x, xb.y, xb.z, xb.w};
    float xf[16];
    float am = 0.f;
    const float rr = rsqrtf(allsum16(ssq[(size_t)token * 16 + (lane & 15)]) * (1.f / DM) + 1e-6f);
    const float4* gp = (const float4*)(fgain + lane * 16);
    const float4 ga = gp[0], gb = gp[1], gc = gp[2], gd = gp[3];
    const float gg[16] = {ga.x, ga.y, ga.z, ga.w, gb.x, gb.y, gb.z, gb.w, gc.x, gc.y, gc.z, gc.w, gd.x, gd.y, gd.z, gd.w};
#pragma unroll
    for (int j = 0; j < 8; j++) {
        xf[2 * j] = __uint_as_float(xw[j] << 16) * rr * gg[2 * j]; xf[2 * j + 1] = __uint_as_float(xw[j] & 0xffff0000u) * rr * gg[2 * j + 1];
        am = fmaxf(am, fmaxf(fabsf(xf[2 * j]), fabsf(xf[2 * j + 1])));
    }
    am = wave_max(am);
    T.sx = (am > 0.f) ? am * (1.f / 127.f) : 1.f;
    const float isx = 1.f / T.sx;
#pragma unroll
    for (int j = 0; j < 4; j++) {
        const int q0 = (int)rintf(xf[4 * j] * isx), q1 = (int)rintf(xf[4 * j + 1] * isx), q2 = (int)rintf(xf[4 * j + 2] * isx), q3 = (int)rintf(xf[4 * j + 3] * isx);
        T.xq[j] = (int)((unsigned)(q0 & 0xff) | ((unsigned)(q1 & 0xff) << 8) | ((unsigned)(q2 & 0xff) << 16) | ((unsigned)(q3 & 0xff) << 24));
    }
    int e_lo = eidx[(size_t)token * 128 + lane], e_hi = eidx[(size_t)token * 128 + 64 + lane];
    float g_lo = pgate[(size_t)token * 128 + lane], g_hi = pgate[(size_t)token * 128 + 64 + lane];
    {
        unsigned long long ka = ((unsigned long long)(unsigned)e_lo << 32) | __float_as_uint(g_lo), kb = ((unsigned long long)(unsigned)e_hi << 32) | __float_as_uint(g_hi);
#pragma unroll
        for (int k = 2; k <= 128; k <<= 1) {
#pragma unroll
            for (int j = k >> 1; j > 0; j >>= 1) {
                if (j == 64) { const unsigned long long mn = ka < kb ? ka : kb, mx = ka < kb ? kb : ka; ka = mn; kb = mx; }
                else {
                    const unsigned long long pa = ((unsigned long long)(unsigned)__shfl_xor((int)(ka >> 32), j) << 32) | (unsigned)__shfl_xor((int)ka, j);
                    const unsigned long long pb = ((unsigned long long)(unsigned)__shfl_xor((int)(kb >> 32), j) << 32) | (unsigned)__shfl_xor((int)kb, j);
                    const bool lower = (lane & j) == 0;
                    const bool dirA = (lane & k) == 0, dirB = ((lane + 64) & k) == 0;
                    ka = ((lower == dirA) == (ka < pa)) ? ka : pa;
                    kb = ((lower == dirB) == (kb < pb)) ? kb : pb;
                }
            }
        }
        e_lo = (int)(ka >> 32); g_lo = __uint_as_float((unsigned)ka); e_hi = (int)(kb >> 32); g_hi = __uint_as_float((unsigned)kb);
    }
    T.e_lo = e_lo; T.e_hi = e_hi;
    T.g_lo = g_lo * sv[e_lo]; T.g_hi = g_hi * sv[e_hi];
    T.s_lo = su[e_lo]; T.s_hi = su[e_hi];
}
__device__ __forceinline__ void peer_store(float* __restrict__ out, int token, int lane, const float (&acc)[16], float bsum) {
    float4* o = (float4*)(out + (size_t)token * DM + lane * 16);
#pragma unroll
    for (int j = 0; j < 4; j++) {
        float4 t = o[j];
        t.x += acc[4 * j]; t.y += acc[4 * j + 1]; t.z += acc[4 * j + 2]; t.w += acc[4 * j + 3];
        o[j] = t;
    }
}
__device__ __forceinline__ int peer_key(const PeerTok& T, int g) {
    const int idx = 4 * g;
    return (idx < 64) ? __builtin_amdgcn_readlane(T.e_lo, idx & 63) : __builtin_amdgcn_readlane(T.e_hi, idx & 63);
}
__device__ __forceinline__ void peer_load_grp(PeerGrp& G, const PeerTok& T, int g, const unsigned char* __restrict__ uq, int lane) {
    const int idx = 4 * g;
    if (idx < 64) peer_load(G, uq, uq, T.e_lo, T.g_lo, T.s_lo, idx, lane); else peer_load(G, uq, uq, T.e_hi, T.g_hi, T.s_hi, idx - 64, lane);
}
__device__ __forceinline__ void d_peer_expert_pair(const bf16_t* __restrict__ h2, const int* __restrict__ eidx, const float* __restrict__ pgate,
                                                   const unsigned char* __restrict__ uq, const float* __restrict__ su, const float* __restrict__ sv,
                                                   const float* __restrict__ ssq, const float* __restrict__ fgain, float* __restrict__ out,
                                                   int tokA, int lane, const XcdBarrier& xbar, unsigned midround) {
    PeerTok TA, TB;
    peer_prep_token(TA, h2, eidx, pgate, su, sv, ssq, fgain, tokA, lane);
    peer_prep_token(TB, h2, eidx, pgate, su, sv, ssq, fgain, tokA + 1, lane);
    float accA[16], accB[16];
#pragma unroll
    for (int i = 0; i < 16; i++) { accA[i] = 0.f; accB[i] = 0.f; }
    float bsA = 0.f, bsB = 0.f;
    int gA = 0, gB = 0;
#define PEER_PICK(f) { if (gA >= 32) f = 1; else if (gB >= 32) f = 0; else f = (peer_key(TA, gA) <= peer_key(TB, gB)) ? 0 : 1; }
#define PEER_LOAD(S, f) { if (f) { peer_load_grp(S, TB, gB, uq, lane); gB++; } else { peer_load_grp(S, TA, gA, uq, lane); gA++; } }
#define PEER_COMP(S, f) { if (f) peer_compute(S, TB.xq, TB.sx, accB, bsB, lane); else peer_compute(S, TA.xq, TA.sx, accA, bsA, lane); }
    PeerGrp S0, S1;
    int f0, f1;
    PEER_PICK(f0) PEER_LOAD(S0, f0)
#pragma unroll 1
    for (int step = 0; step < 64; step += 2) {
        PEER_PICK(f1) PEER_LOAD(S1, f1)
        PEER_COMP(S0, f0)
        if (step + 2 < 64) { PEER_PICK(f0) PEER_LOAD(S0, f0) }
        PEER_COMP(S1, f1)
    }
#undef PEER_PICK
#undef PEER_LOAD
#undef PEER_COMP
    peer_store(out, tokA, lane, accA, bsA);
    peer_store(out, tokA + 1, lane, accB, bsB);
}

struct MKP {
    const float *x, *attn_norm, *w_in, *q_gain, *k_gain, *cmp_pos, *cmp_w1, *cmp_w2, *gdn_conv, *a_log, *dt_bias, *out_gain, *w_out, *ffn_norm, *w_query, *subkeys, *peer_u, *peer_v;
    float* out; char* ws; unsigned* bar;
};

#define SMEM_BYTES 76800

__global__ __launch_bounds__(256, 2) void hybrid_megakernel(MKP P) {
    extern __shared__ __attribute__((aligned(16))) char smem[];
    __shared__ uint4 xb_words;
    __shared__ int q_item;
    const int G = gridDim.x, bid0 = blockIdx.x;
    if (threadIdx.x == 0) xb_words = make_uint4(0u, 0u, 0u, 0u);
    __syncthreads();
    XcdBarrier B = xcd_barrier_post(P.bar, (volatile LAS unsigned*)&xb_words);
    char* ws = P.ws;
    bf16_t* w_in_t = (bf16_t*)(ws + OFF_WINT);
    bf16_t* w_out_t = (bf16_t*)(ws + OFF_WOUTT);
    bf16_t* w_q_t = (bf16_t*)(ws + OFF_WQT);
    bf16_t* cw1_t = (bf16_t*)(ws + OFF_CW1T);
    float* cbias = (float*)(ws + OFF_CBIAS);
    bf16_t* h_bf = (bf16_t*)(ws + OFF_HBF);
    bf16_t* proj = (bf16_t*)(ws + OFF_PROJ);
    bf16_t* ksn = (bf16_t*)(ws + OFF_KSN);
    bf16_t* kwn = (bf16_t*)(ws + OFF_KWN);
    bf16_t* kc = (bf16_t*)(ws + OFF_KC);
    bf16_t* vc = (bf16_t*)(ws + OFF_VC);
    bf16_t* hid = (bf16_t*)(ws + OFF_HID);
    bf16_t* gu = (bf16_t*)(ws + OFF_GU);
    bf16_t* gw = (bf16_t*)(ws + OFF_GW);
    bf16_t* gqd = (bf16_t*)(ws + OFF_GQD);
    bf16_t* gkd = (bf16_t*)(ws + OFF_GKD);
    bf16_t* gin = (bf16_t*)(ws + OFF_GIN);
    float* gl = (float*)(ws + OFF_GL);
    bf16_t* mix = (bf16_t*)(ws + OFF_MIX);
    bf16_t* qry = (bf16_t*)(ws + OFF_QRY);
    bf16_t* h2 = (bf16_t*)(ws + OFF_H2);
    int* eidx = (int*)(ws + OFF_EIDX);
    float* pgate = (float*)(ws + OFF_PGATE);
    unsigned char* uq = (unsigned char*)(ws + OFF_UQ);
    unsigned char* vq = (unsigned char*)(ws + OFF_VQ);
    float* su = (float*)(ws + OFF_SU);
    float* sv = (float*)(ws + OFF_SV);
    float* og = P.out;
    float2* rope = (float2*)(ws + OFF_ROPE);
    float* ssq = (float*)(ws + OFF_SSQ);
    bf16_t* vsn = (bf16_t*)(ws + OFF_VSN);
    bf16_t* vwn = (bf16_t*)(ws + OFF_VWN);
    bf16_t* cw2t = (bf16_t*)(ws + OFF_CW2T);
    unsigned char* uq_tmp = (unsigned char*)(P.out + 8388608);
    unsigned char* vq_tmp = uq_tmp + 16384ull * 1024;

    {
        const int n1 = 108 * 8, n2 = n1 + 32 * 8, n3 = n2 + 64 * 8, n4 = n3 + 2 * 8 * 16, n5 = n4 + 2 * 2 * 2;
        for (int it = bid0; it < n5; it += G) {
            if (it < n1) d_transpose_bf16(P.w_in, 1024, IN_COLS, w_in_t, it % 108, it / 108, smem);
            else if (it < n2) { int r = it - n1; d_transpose_bf16(P.w_out, 1024, 1024, w_out_t, r % 32, r / 32, smem); }
            else if (it < n3) { int r = it - n2; d_transpose_bf16(P.w_query, 1024, 2048, w_q_t, r % 64, r / 64, smem, P.ffn_norm); }
            else if (it < n4) { int r = it - n3; int j = r >> 7; r &= 127; d_transpose_bf16(P.cmp_w1 + (size_t)j * 2048 * 256, 2048, 256, cw1_t + (size_t)j * 256 * 2048, r % 8, r / 8, smem); }
            else { int r = it - n4; int j = r >> 2; r &= 3; d_transpose_bf16(P.cmp_w2 + (size_t)j * 256 * 64, 256, 64, cw2t + (size_t)j * 64 * 256, r % 2, r / 2, smem); }
        }
        for (int it = bid0; it < 16; it += G) d_cmp_bias(P.cmp_pos, P.cmp_w1, cbias, it, smem);
        for (int it = bid0; it < T_TOK / 4; it += G) d_rmsnorm_bf16(P.x, P.attn_norm, h_bf, it);
        for (int i = bid0 * 256 + threadIdx.x; i < 8192 * 32; i += G * 256) {
            const int pos = i >> 5, fi = i & 31;
            float sn, cs; sincosf((float)pos * expf(-9.210340371976184f * (float)(2 * fi) / 64.f), &sn, &cs);
            rope[i] = make_float2(cs, sn);
        }
        for (int i = bid0 * 256 + threadIdx.x; i < 32 * PLD / 2; i += G * 256) ((unsigned*)(proj + (size_t)T_TOK * PLD))[i] = 0u;
    }
    xcd_barrier(B);
    {
        GemmP p{}; p.A = h_bf; p.lda = 1024; p.akts = 64; p.Bt = w_in_t; p.ldb = 1024; p.K = 1024; p.mtiles = 64; p.ntiles = 27; p.out = proj;
        for (int it = bid0; it < 64 * 27; it += G) d_gemm<EPI_PROJ>(p, it, smem);
    }
    xcd_barrier(B);
    {
        for (int it = bid0; it < 32; it += G) {
            int inst = it >> 2, tile = it & 3;
            int j = inst >> 2, b = (inst >> 1) & 1, g = inst & 1;
            GemmP p{}; p.A = proj + (size_t)(b * SEQ) * PLD + C_KV + 128 * j + 64 * g; p.lda = 16 * PLD; p.akts = PLD;
            p.Bt = cw1_t + (size_t)j * 256 * 2048; p.ldb = 2048; p.K = 2048; p.mtiles = 2; p.ntiles = 2;
            p.out = hid + (size_t)inst * 512 * 256; p.aux = cbias + j * 256;
            d_gemm<EPI_HID>(p, tile, smem);
        }
        for (;;) {
            if (threadIdx.x == 0) q_item = (int)xb_add(&P.bar[XB_QUEUE + 64], 1u);
            __syncthreads();
            const int it = q_item;
            __syncthreads();
            if (it >= 1024) break;
            d_gdn_prep2(proj, P.gdn_conv, P.a_log, P.dt_bias, gu, gw, gqd, gkd, gin, gl, it, smem); __syncthreads();
        }
        for (;;) {
            if (threadIdx.x == 0) q_item = (int)xb_add(&P.bar[XB_QUEUE + 128], 1u);
            __syncthreads();
            const int it = q_item;
            __syncthreads();
            if (it >= 1024) break;
            for (int k8 = 0; k8 < 8; k8++) d_knorm_rope(proj, P.k_gain, ksn, kwn, vsn, vwn, rope, it * 8 + k8);
        }
    }
    xcd_barrier(B);
    for (int wi = bid0 * 4 + (threadIdx.x >> 6); wi < 256; wi += G * 4) d_cmp2_mfma(hid, cw2t, P.k_gain, rope, kc, vc, wi, threadIdx.x & 63);
    xcd_barrier(B);
    {
        if (bid0 < GDN_SCAN_ITEMS) d_gdn_scan2(gu, gw, gqd, gkd, gin, gl, og, bid0, smem);
        __syncthreads();
        const int rep = 0;
        for (;;) {
            if (threadIdx.x == 0) q_item = (int)xb_add(&P.bar[XB_QUEUE + 256 * rep], 1u);
            __syncthreads();
            const int it = q_item;
            if (it >= 1024 + 256) break;
            if (it < 256) {
                d_quant_rows16(P.peer_u, P.peer_v, uq_tmp, su, sv, it * 64 + (threadIdx.x >> 6) * 16, threadIdx.x & 63);
            } else {
                d_nsa_mfma(proj, P.q_gain, rope, ksn, kwn, kc, vc, vsn, vwn, mix, DM, it - 256, smem);
            }
            __syncthreads();
        }
    }
    xcd_barrier(B);
    for (int t = bid0 * 4 + (threadIdx.x >> 6); t < T_TOK; t += G * 4) d_gdn_out(og, proj, P.out_gain, mix, t, threadIdx.x & 63);
    for (int i = bid0 * 256 + threadIdx.x; i < 2 * 16384 * 1024 / 16; i += G * 256) ((uint4*)uq)[i] = ((const uint4*)uq_tmp)[i];
    xcd_barrier(B);
    {
        GemmP p{}; p.A = mix; p.lda = 1024; p.akts = 64; p.Bt = w_out_t; p.ldb = 1024; p.K = 1024; p.mtiles = 64; p.ntiles = 8; p.out = P.out; p.aux = P.x; p.out2 = h2; p.ssq = ssq;
        for (int it = bid0; it < 64 * 8; it += G) d_gemm<EPI_OUT>(p, it, smem);
    }
    xcd_barrier(B);
    {
        GemmP p{}; p.A = h2; p.lda = 1024; p.akts = 64; p.Bt = w_q_t; p.ldb = 1024; p.K = 1024; p.mtiles = 64; p.ntiles = 16; p.out = qry; p.ssq = ssq;
        for (int it = bid0; it < 64 * 16; it += G) d_gemm<EPI_QRY>(p, it, smem);
    }
    xcd_barrier(B);
    route_load_subkeys(P.subkeys, smem);
    __syncthreads();
    for (int mt = bid0 * 4 + (threadIdx.x >> 6); mt < T_TOK / 2; mt += G * 4) d_peer_route2(qry, eidx, pgate, mt, smem, threadIdx.x & 63);
    xcd_barrier(B);
    {
        const int rounds = (T_TOK / 8 + G - 1) / G;
        for (int rd = 0; rd < rounds; rd++) {
            xcd_local_sync(B, (unsigned)rd);
            const int it = rd * G + bid0;
            if (it < T_TOK / 8) d_peer_expert_pair(h2, eidx, pgate, uq, su, sv, ssq, P.ffn_norm, P.out, it * 8 + 2 * (threadIdx.x >> 6), threadIdx.x & 63, B, (unsigned)(2 * rd + 1));
        }
    }
}

extern "C" void kernel_launch(void* const* d_in, const int* in_sizes, int n_in, void* d_out, int out_size, void* d_ws, size_t ws_size,
                              hipStream_t stream) {
    const size_t bar_off = (OFF_END + 255) & ~(size_t)255;
    if (ws_size < bar_off + XCD_BAR_WORDS * 4) return;
    static int grid_blocks = 0;
    if (!grid_blocks) {
        int dev = 0, cus = 0, per_cu = 0;
        (void)hipGetDevice(&dev);
        (void)hipDeviceGetAttribute(&cus, hipDeviceAttributeMultiprocessorCount, dev);
        (void)hipFuncSetAttribute((const void*)hybrid_megakernel, hipFuncAttributeMaxDynamicSharedMemorySize, SMEM_BYTES);
        (void)hipOccupancyMaxActiveBlocksPerMultiprocessor(&per_cu, hybrid_megakernel, 256, SMEM_BYTES);
        if (per_cu > 2) per_cu = 2;
        grid_blocks = cus * per_cu;
    }
    if (grid_blocks <= 0) return;
    MKP P{};
    P.x = (const float*)d_in[0]; P.attn_norm = (const float*)d_in[1]; P.w_in = (const float*)d_in[2]; P.q_gain = (const float*)d_in[3];
    P.k_gain = (const float*)d_in[4]; P.cmp_pos = (const float*)d_in[5]; P.cmp_w1 = (const float*)d_in[6]; P.cmp_w2 = (const float*)d_in[7];
    P.gdn_conv = (const float*)d_in[8]; P.a_log = (const float*)d_in[9]; P.dt_bias = (const float*)d_in[10]; P.out_gain = (const float*)d_in[11];
    P.w_out = (const float*)d_in[12]; P.ffn_norm = (const float*)d_in[13]; P.w_query = (const float*)d_in[14]; P.subkeys = (const float*)d_in[15];
    P.peer_u = (const float*)d_in[16]; P.peer_v = (const float*)d_in[17];
    P.out = (float*)d_out; P.ws = (char*)d_ws; P.bar = (unsigned*)((char*)d_ws + bar_off);
    (void)hipMemsetAsync(P.bar, 0, XCD_BAR_WORDS * 4, stream);
    hipLaunchKernelGGL(hybrid_megakernel, dim3(grid_blocks), dim3(256), SMEM_BYTES, stream, P);
}
```

```cpp
#include <hip/hip_runtime.h>
#include <stdint.h>

typedef unsigned short bf16_t;
typedef __attribute__((ext_vector_type(8))) short bf16x8;
typedef __attribute__((ext_vector_type(4))) float f32x4;
typedef __attribute__((ext_vector_type(2))) float f32x2;
#define LAS3 __attribute__((address_space(3)))

#define T_TOK 16384
#define SEQ 8192
#define DM 1024
#define IN_COLS 3360
#define PLD 3456
#define C_Q 0
#define C_KV 512
#define C_GATE 1280
#define C_GQKV 1304
#define C_Z 2840
#define C_A 3352
#define C_B 3356

#define OFF_WINT   0ull
#define OFF_WOUTT  (OFF_WINT  + 3456ull*1024*2)
#define OFF_WQT    (OFF_WOUTT + 1024ull*1024*2)
#define OFF_CW1T   (OFF_WQT   + 2048ull*1024*2)
#define OFF_CBIAS  (OFF_CW1T  + 2ull*256*2048*2)
#define OFF_HBF    (OFF_CBIAS + 4096ull)
#define OFF_PROJ   (OFF_HBF   + 16384ull*1024*2)
#define OFF_KSN    (OFF_PROJ  + (16384ull+32)*PLD*2)
#define OFF_KWN    (OFF_KSN   + 4ull*8192*64*2)
#define OFF_KC     (OFF_KWN   + 4ull*8192*64*2)
#define OFF_VC     (OFF_KC    + 4ull*512*64*2)
#define OFF_HID    (OFF_VC    + 4ull*512*64*2)
#define OFF_GU     (OFF_HID   + 8ull*512*256*2)
#define GSKEW      4352ull
#define OFF_GW     (OFF_GU    + 1024ull*64*128*2 + GSKEW)
#define OFF_GQD    (OFF_GW    + 1024ull*64*128*2 + GSKEW)
#define OFF_GKD    (OFF_GQD   + 1024ull*64*128*2 + GSKEW)
#define OFF_GIN    (OFF_GKD   + 1024ull*64*128*2 + GSKEW)
#define OFF_GL     (OFF_GIN   + 1024ull*64*64*2 + GSKEW)
#define OFF_ROPE   (OFF_GL    + 4096ull)
#define OFF_CW2T   (OFF_ROPE  + 8192ull*32*8)
#define OFF_SU     (OFF_CW2T  + 2ull*64*256*2)
#define OFF_SV     (OFF_SU    + 65536ull)
#define OFF_SSQ    (OFF_SV    + 65536ull)
#define OFF_VSN    (OFF_SSQ   + 16384ull*16*4)
#define OFF_VWN    (OFF_VSN   + 4ull*8192*64*2)
#define OFF_END    (OFF_VWN   + 4ull*8192*64*2)
#define OFF_MIX    OFF_HBF
#define OFF_QRY    OFF_PROJ
#define OFF_H2     (OFF_PROJ + 16384ull*2048*2)
#define OFF_EIDX   OFF_KSN
#define OFF_PGATE  OFF_GIN
#define OFF_UQ     OFF_GU
#define OFF_VQ     (OFF_GU + 16384ull*1024)

__device__ __forceinline__ bf16_t f2bf(float f) {
    unsigned u = __float_as_uint(f);
    u += 0x7fffu + ((u >> 16) & 1u);
    return (bf16_t)(u >> 16);
}
__device__ __forceinline__ int opaque_tid() { int t = threadIdx.x; asm volatile("" : "+v"(t)); return t; }
__device__ __forceinline__ float bf2f(bf16_t h) { return __uint_as_float(((unsigned)h) << 16); }
typedef __bf16 bf16x2_t2 __attribute__((ext_vector_type(2)));
__device__ __forceinline__ unsigned pk2(float a, float b) { bf16x2_t2 v; v[0] = (__bf16)a; v[1] = (__bf16)b; return __builtin_bit_cast(unsigned, v); }
__device__ __forceinline__ float gelu_tanh(float x) {
    float u = 0.7978845608028654f * (x + 0.044715f * x * x * x);
    return 0.5f * x * (1.f + tanhf(u));
}
__device__ __forceinline__ float sigmoidf_(float x) { return 1.f / (1.f + __expf(-x)); }
__device__ __forceinline__ float wave_sum(float v) {
#pragma unroll
    for (int o = 32; o > 0; o >>= 1) v += __shfl_xor(v, o);
    return v;
}
__device__ __forceinline__ float wave_max(float v) {
#pragma unroll
    for (int o = 32; o > 0; o >>= 1) v = fmaxf(v, __shfl_xor(v, o));
    return v;
}

template <int CTRL> __device__ __forceinline__ float dppf(float x) { return __builtin_bit_cast(float, __builtin_amdgcn_update_dpp(0, __builtin_bit_cast(int, x), CTRL, 0xf, 0xf, true)); }
template <int CTRL> __device__ __forceinline__ unsigned dppu(unsigned x) { return (unsigned)__builtin_amdgcn_update_dpp(0, (int)x, CTRL, 0xf, 0xf, true); }
__device__ __forceinline__ float allmax16(float x) {
    x = fmaxf(x, dppf<0xB1>(x)); x = fmaxf(x, dppf<0x4E>(x)); x = fmaxf(x, dppf<0x141>(x)); x = fmaxf(x, dppf<0x140>(x)); return x;
}
__device__ __forceinline__ unsigned allmaxu16(unsigned x) {
    x = max(x, dppu<0xB1>(x)); x = max(x, dppu<0x4E>(x)); x = max(x, dppu<0x141>(x)); x = max(x, dppu<0x140>(x)); return x;
}
__device__ __forceinline__ float allsum16(float x) {
    x += dppf<0xB1>(x); x += dppf<0x4E>(x); x += dppf<0x141>(x); x += dppf<0x140>(x); return x;
}
__device__ __forceinline__ float wave_sum_dpp(float x) {
    x = allsum16(x);
    return __builtin_bit_cast(float, __builtin_amdgcn_readlane(__builtin_bit_cast(int, x), 0)) + __builtin_bit_cast(float, __builtin_amdgcn_readlane(__builtin_bit_cast(int, x), 16)) +
           __builtin_bit_cast(float, __builtin_amdgcn_readlane(__builtin_bit_cast(int, x), 32)) + __builtin_bit_cast(float, __builtin_amdgcn_readlane(__builtin_bit_cast(int, x), 48));
}
__device__ __forceinline__ void d_transpose_bf16(const float* __restrict__ W, int K, int N, bf16_t* __restrict__ Wt, int bx, int by, char* smem, const float* __restrict__ kscale = nullptr) {
    float* tile = (float*)smem;
    const int n0 = bx * 32, k0 = by * 128;
    const int tx = threadIdx.x & 31, ty = threadIdx.x >> 5;
    const int n = n0 + tx;
    float v[16];
#pragma unroll
    for (int i = 0; i < 16; i++) { const int k = k0 + ty + 8 * i; v[i] = (n < N) ? W[(size_t)k * N + n] : 0.f; }
#pragma unroll
    for (int i = 0; i < 16; i++) { const int kk = ty + 8 * i; tile[kk * 33 + tx] = v[i] * (kscale ? kscale[k0 + kk] : 1.f); }
    __syncthreads();
    {
        const int nn = threadIdx.x >> 3, kc = (threadIdx.x & 7) * 16;
        unsigned pk[8];
#pragma unroll
        for (int j = 0; j < 8; j++) pk[j] = pk2(tile[(kc + 2 * j) * 33 + nn], tile[(kc + 2 * j + 1) * 33 + nn]);
        uint4* dst = (uint4*)(Wt + (size_t)(n0 + nn) * K + k0 + kc);
        dst[0] = make_uint4(pk[0], pk[1], pk[2], pk[3]); dst[1] = make_uint4(pk[4], pk[5], pk[6], pk[7]);
    }
    __syncthreads();
}

__device__ __forceinline__ void d_rmsnorm_bf16(const float* __restrict__ x, const float* __restrict__ g, bf16_t* __restrict__ out, int bid) {
    int row = bid * 4 + (threadIdx.x >> 6);
    int lane = threadIdx.x & 63;
    const float4* xr = (const float4*)(x + (size_t)row * DM);
    float4 v[4];
    float ss = 0.f;
#pragma unroll
    for (int i = 0; i < 4; i++) { v[i] = xr[lane + 64 * i]; ss += v[i].x * v[i].x + v[i].y * v[i].y + v[i].z * v[i].z + v[i].w * v[i].w; }
    ss = wave_sum(ss);
    float r = rsqrtf(ss * (1.f / DM) + 1e-6f);
#pragma unroll
    for (int i = 0; i < 4; i++) {
        float4 gg = ((const float4*)g)[lane + 64 * i];
        ushort4 o;
        o.x = f2bf(v[i].x * r * gg.x); o.y = f2bf(v[i].y * r * gg.y); o.z = f2bf(v[i].z * r * gg.z); o.w = f2bf(v[i].w * r * gg.w);
        ((ushort4*)(out + (size_t)row * DM))[lane + 64 * i] = o;
    }
}

__device__ __forceinline__ void d_cmp_bias(const float* __restrict__ pos, const float* __restrict__ w1, float* __restrict__ bias, int item, char* smem) {
    float* part = (float*)smem;
    const int j = item >> 3, c = (item & 7) * 32 + (threadIdx.x & 31), ksl = threadIdx.x >> 5;
    float s0 = 0.f, s1 = 0.f, s2 = 0.f, s3 = 0.f;
    const float* wp = w1 + ((size_t)j * 2048 + ksl * 256) * 256 + c;
    const float* pp = pos + j * 2048 + ksl * 256;
    for (int k = 0; k < 256; k += 4) {
        s0 += pp[k] * wp[(size_t)k * 256]; s1 += pp[k + 1] * wp[(size_t)(k + 1) * 256];
        s2 += pp[k + 2] * wp[(size_t)(k + 2) * 256]; s3 += pp[k + 3] * wp[(size_t)(k + 3) * 256];
    }
    part[ksl * 32 + (threadIdx.x & 31)] = (s0 + s1) + (s2 + s3);
    __syncthreads();
    if (threadIdx.x < 32) {
        float t = 0.f;
#pragma unroll
        for (int i = 0; i < 8; i++) t += part[i * 32 + threadIdx.x];
        bias[j * 256 + c] = t;
    }
    __syncthreads();
}

#define EPI_PROJ 0
#define EPI_HID 1
#define EPI_OUT 2
#define EPI_QRY 3
struct GemmP {
    const bf16_t* A; long lda; long akts;
    const bf16_t* Bt; long ldb;
    int K; int mtiles; int ntiles;
    long a_inst; long b_inst;
    void* out; const float* aux; const float* aux2; bf16_t* out2; float* ssq;
};

#define GEMM_STAGE 24576
template <int EPI>
__device__ __forceinline__ void d_gemm(const GemmP& p, int bid, char* smem) {
    const int tid = opaque_tid(), lane = tid & 63, wave = tid >> 6;
    const int wm = wave >> 1, wn = wave & 1;
    const int inst = 0;
    const int nwg = p.mtiles * p.ntiles, wgid = (nwg & 7) ? bid : ((bid & 7) * (nwg >> 3) + (bid >> 3));
    const int mt = wgid / p.ntiles, nt = wgid % p.ntiles;
    const int m0 = mt * 256, n0 = nt * 128;
    const bf16_t* A = p.A + (size_t)inst * p.a_inst + (size_t)m0 * p.lda;
    const bf16_t* Bt = p.Bt + (size_t)inst * p.b_inst + (size_t)n0 * p.ldb;
    f32x4 acc[8][4];
#pragma unroll
    for (int i = 0; i < 8; i++)
#pragma unroll
        for (int j = 0; j < 4; j++) acc[i][j] = (f32x4){0.f, 0.f, 0.f, 0.f};
    const int nk = p.K >> 5;
    const int crow = tid >> 2, cslot = tid & 3;
    const int csrc = (cslot ^ (((crow >> 3) & 1) << 1)) * 8;
    const bf16_t* Ap = A + (size_t)crow * p.lda + csrc;
    const bf16_t* Bp = Bt + (size_t)crow * p.ldb + csrc;
    const size_t a64 = (size_t)64 * p.lda, b64 = (size_t)64 * p.ldb;
    char* ldsw = smem + tid * 16;
#define GSTAGE(stg, kt_) { char* _d = ldsw + (stg) * GEMM_STAGE; const size_t _ka = (size_t)((kt_) >> 1) * p.akts + (size_t)(((kt_) & 1) * 32), _kb = (size_t)(kt_) * 32; \
    __builtin_amdgcn_global_load_lds((const unsigned*)(Ap + _ka), (LAS3 unsigned*)(_d), 16, 0, 0); \
    __builtin_amdgcn_global_load_lds((const unsigned*)(Ap + a64 + _ka), (LAS3 unsigned*)(_d + 4096), 16, 0, 0); \
    __builtin_amdgcn_global_load_lds((const unsigned*)(Ap + 2 * a64 + _ka), (LAS3 unsigned*)(_d + 8192), 16, 0, 0); \
    __builtin_amdgcn_global_load_lds((const unsigned*)(Ap + 3 * a64 + _ka), (LAS3 unsigned*)(_d + 12288), 16, 0, 0); \
    __builtin_amdgcn_global_load_lds((const unsigned*)(Bp + _kb), (LAS3 unsigned*)(_d + 16384), 16, 0, 0); \
    __builtin_amdgcn_global_load_lds((const unsigned*)(Bp + b64 + _kb), (LAS3 unsigned*)(_d + 16384 + 4096), 16, 0, 0); }
    const int n16 = lane & 15, kq = lane >> 4;
    if (EPI == EPI_QRY) {
        const float4* q = (const float4*)(p.ssq + (size_t)(m0 + tid) * 16);
        const float4 q0 = q[0], q1 = q[1], q2 = q[2], q3 = q[3];
        const float t = ((q0.x + q0.y) + (q0.z + q0.w)) + ((q1.x + q1.y) + (q1.z + q1.w)) + ((q2.x + q2.y) + (q2.z + q2.w)) + ((q3.x + q3.y) + (q3.z + q3.w));
        ((float*)(smem + 3 * GEMM_STAGE))[tid] = rsqrtf(t * (1.f / DM) + 1e-6f);
    }
    const int rdsw = ((kq ^ (((n16 >> 3) & 1) << 1)) << 4);
    GSTAGE(0, 0)
    if (nk > 1) GSTAGE(1, 1)
    int scur = 0, snext = 2;
    for (int kt = 0; kt < nk; kt++) {
        if (kt + 1 < nk) asm volatile("s_waitcnt vmcnt(6)" ::: "memory");
        else asm volatile("s_waitcnt vmcnt(0)" ::: "memory");
        __builtin_amdgcn_s_barrier();
        if (kt + 2 < nk) GSTAGE(snext, kt + 2)
        const char* Ab = smem + scur * GEMM_STAGE;
        const char* Bb = Ab + 16384;
        bf16x8 bfr[4];
#pragma unroll
        for (int j = 0; j < 4; j++) bfr[j] = *(const bf16x8*)(Bb + (wn * 64 + j * 16 + n16) * 64 + rdsw);
#pragma unroll
        for (int ih = 0; ih < 2; ih++) {
            bf16x8 af[4];
#pragma unroll
            for (int i = 0; i < 4; i++) af[i] = *(const bf16x8*)(Ab + (wm * 128 + (ih * 4 + i) * 16 + n16) * 64 + rdsw);
#pragma unroll
            for (int i = 0; i < 4; i++)
#pragma unroll
                for (int j = 0; j < 4; j++) acc[ih * 4 + i][j] = __builtin_amdgcn_mfma_f32_16x16x32_bf16(bfr[j], af[i], acc[ih * 4 + i][j], 0, 0, 0);
        }
        scur = (scur == 2) ? 0 : scur + 1; snext = (snext == 2) ? 0 : snext + 1;
    }
#undef GSTAGE
    asm volatile("s_waitcnt lgkmcnt(0)" ::: "memory");
    __syncthreads();
    {
        char* slab = smem + wave * 9216;
        const int cbase = n0 + wn * 64;
#pragma unroll
        for (int ip = 0; ip < 2; ip++) {
            const int rbase = m0 + wm * 128 + ip * 64;
            if (EPI == EPI_OUT) {
                float* st = (float*)slab;
#pragma unroll
                for (int hlf = 0; hlf < 2; hlf++) {
#pragma unroll
                    for (int ii = 0; ii < 2; ii++)
#pragma unroll
                        for (int j = 0; j < 4; j++) *(f32x4*)(st + (ii * 16 + n16) * 68 + j * 16 + 4 * kq) = acc[ip * 4 + hlf * 2 + ii][j];
#pragma unroll
                    for (int ps = 0; ps < 8; ps++) {
                        const int rl = ps * 4 + kq, row = rbase + hlf * 32 + rl;
                        const float4 a = *(const float4*)(st + rl * 68 + n16 * 4);
                        const float4 xx = *(const float4*)(p.aux + (size_t)row * DM + cbase + n16 * 4);
                        const float4 o = make_float4(xx.x + a.x, xx.y + a.y, xx.z + a.z, xx.w + a.w);
                        *(float4*)((float*)p.out + (size_t)row * DM + cbase + n16 * 4) = o;
                        *(uint2*)(p.out2 + (size_t)row * DM + cbase + n16 * 4) = make_uint2(pk2(o.x, o.y), pk2(o.z, o.w));
                        const float ss = allsum16(o.x * o.x + o.y * o.y + o.z * o.z + o.w * o.w);
                        if (n16 == 0) p.ssq[(size_t)row * 16 + nt * 2 + wn] = ss;
                    }
                }
            } else {
                bf16_t* st = (bf16_t*)slab;
#pragma unroll
                for (int i = 0; i < 4; i++) {
                    float rs = 1.f;
                    if (EPI == EPI_QRY) rs = ((const float*)(smem + 3 * GEMM_STAGE))[wm * 128 + ip * 64 + i * 16 + n16];
#pragma unroll
                    for (int j = 0; j < 4; j++) {
                        float v0 = acc[ip * 4 + i][j][0], v1 = acc[ip * 4 + i][j][1], v2 = acc[ip * 4 + i][j][2], v3 = acc[ip * 4 + i][j][3];
                        if (EPI == EPI_HID) {
                            const float4 bb = *(const float4*)(p.aux + (inst >> 2) * 256 + cbase + 16 * j + 4 * kq);
                            v0 = gelu_tanh(v0 + bb.x); v1 = gelu_tanh(v1 + bb.y); v2 = gelu_tanh(v2 + bb.z); v3 = gelu_tanh(v3 + bb.w);
                        }
                        if (EPI == EPI_QRY) { v0 *= rs; v1 *= rs; v2 *= rs; v3 *= rs; }
                        *(uint2*)(st + (i * 16 + n16) * 72 + j * 16 + 4 * kq) = make_uint2(pk2(v0, v1), pk2(v2, v3));
                    }
                }
                const int ld = (EPI == EPI_PROJ) ? PLD : (EPI == EPI_HID ? 256 : 2048);
#pragma unroll
                for (int ps = 0; ps < 8; ps++) {
                    const int rl = ps * 8 + (lane >> 3), ch = lane & 7;
                    const uint4 v = *(const uint4*)(st + rl * 72 + ch * 8);
                    *(uint4*)((bf16_t*)p.out + (size_t)(rbase + rl) * ld + cbase + ch * 8) = v;
                }
            }
        }
        __syncthreads();
    }
}

__device__ __forceinline__ void d_knorm_rope(const bf16_t* __restrict__ proj, const float* __restrict__ kgain, bf16_t* __restrict__ ksn, bf16_t* __restrict__ kwn, bf16_t* __restrict__ vsn, bf16_t* __restrict__ vwn, const float2* __restrict__ rope, int bid) {
    int vec = bid * 8 + (threadIdx.x >> 5);
    int i = threadIdx.x & 31;
    int which = vec >> 15;
    int rem = vec & 32767;
    int b = rem >> 14, g = (rem >> 13) & 1, s = rem & 8191;
    const bf16_t* src = proj + (size_t)(b * SEQ + s) * PLD + C_KV + 128 * (which ? 4 : 2) + 64 * g;
    float x1 = bf2f(src[i]), x2 = bf2f(src[i + 32]);
    float ss = x1 * x1 + x2 * x2;
#pragma unroll
    for (int o = 16; o > 0; o >>= 1) ss += __shfl_xor(ss, o);
    float r = rsqrtf(ss * (1.f / 64.f) + 1e-6f);
    const float* gn = kgain + (which ? 2 : 1) * 64;
    x1 = x1 * r * gn[i]; x2 = x2 * r * gn[i + 32];
    const float2 cs2 = rope[(size_t)s * 32 + i];
    const float cs = cs2.x, sn = cs2.y;
    bf16_t* dst = (which ? kwn : ksn) + ((size_t)(b * 2 + g) * SEQ + s) * 64;
    dst[i] = f2bf(x1 * cs - x2 * sn);
    dst[i + 32] = f2bf(x2 * cs + x1 * sn);
    ((unsigned*)((which ? vwn : vsn) + ((size_t)(b * 2 + g) * SEQ + s) * 64))[i] = ((const unsigned*)(src + 128))[i];
}

__device__ __forceinline__ void d_cmp2_mfma(const bf16_t* __restrict__ hid, const bf16_t* __restrict__ cw2t, const float* __restrict__ kgain, const float2* __restrict__ rope,
                                            bf16_t* __restrict__ kc, bf16_t* __restrict__ vc, int witem, int lane) {
    const int n16 = lane & 15, kq = lane >> 4;
    const int rowbase = 16 * witem, inst = rowbase >> 9, n0 = rowbase & 511, j = inst >> 2, bg = inst & 3;
    f32x4 acc[4];
#pragma unroll
    for (int nt = 0; nt < 4; nt++) acc[nt] = (f32x4){0.f, 0.f, 0.f, 0.f};
    const bf16_t* ap = hid + (size_t)(rowbase + n16) * 256 + 8 * kq;
    const bf16_t* bp = cw2t + (size_t)j * 64 * 256 + n16 * 256 + 8 * kq;
#pragma unroll
    for (int ks = 0; ks < 8; ks++) {
        const bf16x8 a = *(const bf16x8*)(ap + 32 * ks);
#pragma unroll
        for (int nt = 0; nt < 4; nt++) {
            const bf16x8 bb = *(const bf16x8*)(bp + (size_t)(16 * nt) * 256 + 32 * ks);
            acc[nt] = __builtin_amdgcn_mfma_f32_16x16x32_bf16(a, bb, acc[nt], 0, 0, 0);
        }
    }
#pragma unroll
    for (int r = 0; r < 4; r++) {
        const int n = n0 + 4 * kq + r;
        if (j == 0) {
            float ss = acc[0][r] * acc[0][r] + acc[1][r] * acc[1][r] + acc[2][r] * acc[2][r] + acc[3][r] * acc[3][r];
            ss = allsum16(ss);
            const float ri = rsqrtf(ss * (1.f / 64.f) + 1e-6f);
#pragma unroll
            for (int nt = 0; nt < 2; nt++) {
                const int i = 16 * nt + n16;
                const float y1 = acc[nt][r] * ri * kgain[i], y2 = acc[nt + 2][r] * ri * kgain[i + 32];
                const float2 cs = rope[(size_t)((n < 511 ? n : 510) * 16 + 31) * 32 + i];
                if (n < 511) {
                    kc[((size_t)bg * 512 + n) * 64 + i] = f2bf(y1 * cs.x - y2 * cs.y);
                    kc[((size_t)bg * 512 + n) * 64 + i + 32] = f2bf(y2 * cs.x + y1 * cs.y);
                }
            }
        } else if (n < 511) {
#pragma unroll
            for (int nt = 0; nt < 4; nt++) vc[((size_t)bg * 512 + n) * 64 + 16 * nt + n16] = f2bf(acc[nt][r]);
        }
    }
}

typedef float f32x16 __attribute__((ext_vector_type(16)));
typedef short s16x4 __attribute__((ext_vector_type(4)));
#define MFMA32(a, b, c) __builtin_amdgcn_mfma_f32_32x32x16_bf16((a), (b), (c), 0, 0, 0)
#define NKS 72
#define NSA_K_OFF 0
#define NSA_V_OFF (2 * 64 * NKS * 2)
#define NSA_IMP_OFF (NSA_V_OFF + 2 * 64 * NKS * 2)
#define NSA_SEL_OFF (NSA_IMP_OFF + 4 * 8192)
#define NSA_LDS (NSA_SEL_OFF + 32 * 4 * 4)
#define NEGBIG (-1e30f)
__device__ __forceinline__ bf16x8 pack8(float a0, float a1, float a2, float a3, float a4, float a5, float a6, float a7) {
    uint4 u = make_uint4(pk2(a0, a1), pk2(a2, a3), pk2(a4, a5), pk2(a6, a7));
    return __builtin_bit_cast(bf16x8, u);
}
__device__ __forceinline__ unsigned pk4_fp8(float a, float b, float c, float d) {
    int w = 0;
    w = __builtin_amdgcn_cvt_pk_fp8_f32(a, b, w, false);
    w = __builtin_amdgcn_cvt_pk_fp8_f32(c, d, w, true);
    return (unsigned)w;
}
__device__ __forceinline__ bf16x8 fp8x8_bf16(unsigned a, unsigned b) {
    const f32x2 p0 = __builtin_amdgcn_cvt_pk_f32_fp8((int)a, false), p1 = __builtin_amdgcn_cvt_pk_f32_fp8((int)a, true);
    const f32x2 p2 = __builtin_amdgcn_cvt_pk_f32_fp8((int)b, false), p3 = __builtin_amdgcn_cvt_pk_f32_fp8((int)b, true);
    return pack8(p0[0], p0[1], p1[0], p1[1], p2[0], p2[1], p3[0], p3[1]);
}
#define GW_SCALE 32.f
#define GQ_SCALE 2048.f
#define GK_SCALE 128.f
typedef unsigned u32x4 __attribute__((ext_vector_type(4)));
struct NsaStage { u32x4 k0, k1, v0, v1; };
struct NsaCtx {
    bool noload;
    const bf16_t* Kbase; long kstride;
    const bf16_t* Vbase; long vstride;
    bf16_t* Kb; bf16_t* Vb;
    float* imp_s; unsigned* sel_s;
    bf16x8 qf[4];
    f32x16 O0, O1;
    float m, l, invl, carry;
    int t, tokl, hp, hh, c, lane;
};
__device__ __forceinline__ void nsa_stage_load(const NsaCtx& X, NsaStage& st, int j) {
    const int r0 = threadIdx.x >> 3, c8 = (threadIdx.x & 7) * 8;
    if (X.noload) { st.k0 = (u32x4){0u,0u,0u,0u}; st.k1 = st.k0; st.v0 = st.k0; st.v1 = st.k0; return; }
    const bf16_t* kp = X.Kbase + (size_t)(64 * j + r0) * X.kstride + c8;
    const bf16_t* vp = X.Vbase + (size_t)(64 * j + r0) * X.vstride + c8;
    st.k0 = *(const u32x4*)kp; st.k1 = *(const u32x4*)(kp + 32 * X.kstride);
    st.v0 = *(const u32x4*)vp; st.v1 = *(const u32x4*)(vp + 32 * X.vstride);
}
__device__ __forceinline__ void nsa_stage_store(const NsaCtx& X, const NsaStage& st, int buf) {
    const int r0 = threadIdx.x >> 3, c8 = (threadIdx.x & 7) * 8;
    bf16_t* kb = X.Kb + buf * 64 * NKS + r0 * NKS + c8;
    bf16_t* vb = X.Vb + buf * 64 * NKS + r0 * NKS + c8;
    *(u32x4*)kb = st.k0; *(u32x4*)(kb + 32 * NKS) = st.k1;
    *(u32x4*)vb = st.v0; *(u32x4*)(vb + 32 * NKS) = st.v1;
}
__device__ __forceinline__ float xor32_max(float x) {
    const auto r = __builtin_amdgcn_permlane32_swap(__float_as_uint(x), __float_as_uint(x), false, false);
    return fmaxf(__uint_as_float(r[0]), __uint_as_float(r[1]));
}
__device__ __forceinline__ float xor32_sum(float x) {
    const auto r = __builtin_amdgcn_permlane32_swap(__float_as_uint(x), __float_as_uint(x), false, false);
    return __uint_as_float(r[0]) + __uint_as_float(r[1]);
}
template <int MODE>
__device__ __forceinline__ void nsa_tile(NsaCtx& X, int j, int kt, int buf, unsigned long long mlo, unsigned long long mhi, bool fast) {
    const bf16_t* Kt = X.Kb + buf * 64 * NKS + (32 * kt) * NKS;
    const bf16_t* Vt = X.Vb + buf * 64 * NKS + (32 * kt) * NKS;
    f32x16 S;
#pragma unroll
    for (int i = 0; i < 16; i++) S[i] = 0.f;
#pragma unroll
    for (int s = 0; s < 4; s++) {
        bf16x8 ka = *(const bf16x8*)(Kt + X.c * NKS + 16 * s + 8 * X.hh);
        S = MFMA32(ka, X.qf[s], S);
    }
    const int kbase = 64 * j + 32 * kt;
    int lo = 0, hi;
    bool on = true;
    if (MODE <= 1) hi = ((X.t - 31) >> 4) - kbase;
    else hi = X.t - kbase;
    if (MODE == 3) lo = X.t - 511 - kbase;
    if (MODE == 2) {
        const unsigned long long wsel = (j < 64) ? mlo : mhi;
        on = (wsel >> (j & 63)) & 1ull;
    }
    lo -= 4 * X.hh; hi -= 4 * X.hh;
    if (!on) hi = -1000;
    float P[16];
    if (MODE == 1) {
#pragma unroll
        for (int i = 0; i < 16; i++) {
            const int cr = (i & 3) + 8 * (i >> 2);
            P[i] = (cr <= hi) ? __builtin_amdgcn_exp2f(S[i] - X.m) * X.invl : 0.f;
        }
        float mainv[4], nxt[4];
#pragma unroll
        for (int q = 0; q < 4; q++) { mainv[q] = 2.f * (P[4 * q] + P[4 * q + 1] + P[4 * q + 2]) + P[4 * q + 3]; nxt[q] = P[4 * q + 3]; }
#pragma unroll
        for (int q = 0; q < 4; q++) {
            mainv[q] += __shfl_xor(mainv[q], 1); mainv[q] += __shfl_xor(mainv[q], 2);
            nxt[q] += __shfl_xor(nxt[q], 1); nxt[q] += __shfl_xor(nxt[q], 2);
        }
        float recv[4];
#pragma unroll
        for (int q = 0; q < 4; q++) recv[q] = __shfl_xor(nxt[q], 32);
        const int jsel0 = 16 * j + 8 * kt + X.hh;
#pragma unroll
        for (int q = 0; q < 4; q++) {
            const float tot = mainv[q] + (X.hh ? recv[q] : (q > 0 ? recv[q > 0 ? q - 1 : 0] : X.carry));
            if (X.hp == 0) X.imp_s[(X.tokl & 7) * 128 + jsel0 + 2 * q] = tot;
        }
        X.carry = recv[3];
    } else if (MODE == 0) {
        float tmax = NEGBIG;
#pragma unroll
        for (int i = 0; i < 16; i++) {
            const int cr = (i & 3) + 8 * (i >> 2);
            const bool vis = (cr <= hi) && (cr >= lo);
            tmax = vis ? fmaxf(tmax, S[i]) : tmax;
        }
        tmax = xor32_max(tmax);
        float ls = 0.f;
        const float mnew = fmaxf(X.m, tmax);
        const float alpha = __builtin_amdgcn_exp2f(X.m - mnew);
        X.m = mnew;
#pragma unroll
        for (int i = 0; i < 16; i++) {
            const int cr = (i & 3) + 8 * (i >> 2);
            const bool vis = (cr <= hi) && (cr >= lo);
            P[i] = vis ? __builtin_amdgcn_exp2f(S[i] - mnew) : 0.f;
            ls += P[i];
        }
        X.l = X.l * alpha + ls;
    } else {
        if (!fast) {
#pragma unroll
            for (int i = 0; i < 16; i++) {
                const int cr = (i & 3) + 8 * (i >> 2);
                const bool vis = (cr <= hi) && (cr >= lo);
                S[i] = vis ? S[i] : -__builtin_inff();
            }
        }
        float tmax = fmaxf(fmaxf(fmaxf(fmaxf(S[0], S[1]), fmaxf(S[2], S[3])), fmaxf(fmaxf(S[4], S[5]), fmaxf(S[6], S[7]))),
                           fmaxf(fmaxf(fmaxf(S[8], S[9]), fmaxf(S[10], S[11])), fmaxf(fmaxf(S[12], S[13]), fmaxf(S[14], S[15]))));
        if (MODE == 2 && !on) tmax = NEGBIG;
        tmax = xor32_max(tmax);
        float ls = 0.f;
        const bool upd = tmax > X.m + 8.f;
        const float mnew = upd ? tmax : X.m;
        if (__builtin_amdgcn_ballot_w64(upd) != 0ull) {
            const float alpha = __builtin_amdgcn_exp2f(X.m - mnew);
            X.l *= alpha;
#pragma unroll
            for (int i = 0; i < 16; i++) { X.O0[i] *= alpha; X.O1[i] *= alpha; }
        }
        X.m = mnew;
        const float msub = (MODE == 2 && !on) ? 1e30f : mnew;
#pragma unroll
        for (int i = 0; i < 16; i++) { P[i] = __builtin_amdgcn_exp2f(S[i] - msub); ls += P[i]; }
        X.l += ls;
    }
    if (MODE >= 1) {
        bf16x8 pb0 = pack8(P[0], P[1], P[2], P[3], P[4], P[5], P[6], P[7]);
        bf16x8 pb1 = pack8(P[8], P[9], P[10], P[11], P[12], P[13], P[14], P[15]);
        const int l15 = X.lane & 15;
        const bf16_t* vrow = Vt + (4 * X.hh + (l15 >> 2)) * NKS + 16 * ((X.lane >> 4) & 1) + 4 * (l15 & 3);
#pragma unroll
        for (int s2 = 0; s2 < 2; s2++) {
#pragma unroll
            for (int dt = 0; dt < 2; dt++) {
                s16x4 lo4 = __builtin_amdgcn_ds_read_tr16_b64_v4i16((LAS3 s16x4*)(vrow + (16 * s2) * NKS + 32 * dt));
                s16x4 hi4 = __builtin_amdgcn_ds_read_tr16_b64_v4i16((LAS3 s16x4*)(vrow + (16 * s2 + 8) * NKS + 32 * dt));
                bf16x8 va = __builtin_shufflevector(lo4, hi4, 0, 1, 2, 3, 4, 5, 6, 7);
                if (dt == 0) X.O0 = MFMA32(va, s2 ? pb1 : pb0, X.O0); else X.O1 = MFMA32(va, s2 ? pb1 : pb0, X.O1);
            }
        }
    }
}
template <int MODE>
__device__ __forceinline__ void nsa_block(NsaCtx& X, int j, unsigned long long mlo, unsigned long long mhi, unsigned long long ulo, unsigned long long uhi, int cur, int tw0) {
    bool need = true;
    if (MODE == 2) {
        const unsigned long long wsel = (j < 64) ? ulo : uhi;
        need = (wsel >> (j & 63)) & 1ull;
    }
    if (need) {
#pragma unroll 1
        for (int kt = 0; kt < 2; kt++) {
            bool fast = false;
            if (MODE == 2) fast = j < cur;
            if (MODE == 3) { const int kb = 64 * j + 32 * kt; fast = (kb + 31 <= tw0) && (kb >= tw0 + 7 - 511); }
            nsa_tile<MODE>(X, j, kt, j & 1, mlo, mhi, fast);
        }
    }
}
template <int MODE>
__device__ __forceinline__ void nsa_branch(NsaCtx& X, int jlo, int jhi, unsigned long long mlo, unsigned long long mhi, unsigned long long ulo, unsigned long long uhi, int cur, int tw0) {
    NsaStage sa;
    nsa_stage_load(X, sa, jlo);
    __syncthreads();
    nsa_stage_store(X, sa, jlo & 1);
    __syncthreads();
#pragma unroll 1
    for (int j = jlo; j <= jhi; j++) {
        if (j < jhi) nsa_stage_load(X, sa, j + 1);
        nsa_block<MODE>(X, j, mlo, mhi, ulo, uhi, cur, tw0);
        if (j < jhi) nsa_stage_store(X, sa, (j + 1) & 1);
        __syncthreads();
    }
}
template <int OP>
__device__ __forceinline__ void nsa_facc(NsaCtx& X, float scale) {
    f32x4* F = (f32x4*)X.imp_s;
#pragma unroll
    for (int q = 0; q < 8; q++) {
        f32x4 v;
#pragma unroll
        for (int e = 0; e < 4; e++) v[e] = ((q < 4) ? X.O0[4 * q + e] : X.O1[4 * (q - 4) + e]) * scale;
        if (OP >= 1) v += F[q * 64 + X.lane];
        if (OP <= 1) F[q * 64 + X.lane] = v;
        else {
#pragma unroll
            for (int e = 0; e < 4; e++) { if (q < 4) X.O0[4 * q + e] = v[e]; else X.O1[4 * (q - 4) + e] = v[e]; }
        }
    }
}
__device__ __forceinline__ void d_nsa_mfma(const bf16_t* __restrict__ proj, const float* __restrict__ qgain, const float2* __restrict__ rope,
                                           const bf16_t* __restrict__ ksn, const bf16_t* __restrict__ kwn,
                                           const bf16_t* __restrict__ kc, const bf16_t* __restrict__ vc, const bf16_t* __restrict__ vsn, const bf16_t* __restrict__ vwn,
                                           bf16_t* __restrict__ mixo, int mix_ld, int item, char* smem, bool noload = false) {
    NsaCtx X;
    X.noload = noload;
    const int tid = opaque_tid(), lane = tid & 63, w = tid >> 6;
    const int bg = item & 3, tile = 255 - (item >> 2);
    const int b = bg >> 1, g = bg & 1, t0 = tile * 32;
    X.lane = lane; X.c = lane & 31; X.hh = lane >> 5; X.hp = X.c & 3; X.tokl = 8 * w + (X.c >> 2); X.t = t0 + X.tokl;
    X.Kb = (bf16_t*)(smem + NSA_K_OFF); X.Vb = (bf16_t*)(smem + NSA_V_OFF);
    X.imp_s = (float*)(smem + NSA_IMP_OFF + w * 8192); X.sel_s = (unsigned*)(smem + NSA_SEL_OFF);
    const int head = g * 4 + X.hp;
    const size_t row = (size_t)(b * SEQ + X.t);
    {
        float y[4][8];
        const bf16_t* qsrc = proj + row * PLD + C_Q + head * 64 + 8 * X.hh;
        float ss = 0.f;
#pragma unroll
        for (int s = 0; s < 4; s++) {
            const uint4 u = *(const uint4*)(qsrc + 16 * s);
            const unsigned wv[4] = {u.x, u.y, u.z, u.w};
#pragma unroll
            for (int e = 0; e < 4; e++) { y[s][2 * e] = __uint_as_float(wv[e] << 16); y[s][2 * e + 1] = __uint_as_float(wv[e] & 0xffff0000u); }
#pragma unroll
            for (int e = 0; e < 8; e++) ss += y[s][e] * y[s][e];
        }
        ss += __shfl_xor(ss, 32);
        const float r = rsqrtf(ss * (1.f / 64.f) + 1e-6f);
#pragma unroll
        for (int s = 0; s < 4; s++)
#pragma unroll
            for (int e = 0; e < 8; e++) y[s][e] *= r * qgain[16 * s + 8 * X.hh + e];
        const float qs = 0.125f * 1.4426950408889634f;
#pragma unroll
        for (int s = 0; s < 2; s++)
#pragma unroll
            for (int e = 0; e < 8; e++) {
                const float2 cs = rope[(size_t)X.t * 32 + 16 * s + 8 * X.hh + e];
                const float x1 = y[s][e], x2 = y[s + 2][e];
                y[s][e] = (x1 * cs.x - x2 * cs.y) * qs; y[s + 2][e] = (x2 * cs.x + x1 * cs.y) * qs;
            }
#pragma unroll
        for (int s = 0; s < 4; s++) X.qf[s] = pack8(y[s][0], y[s][1], y[s][2], y[s][3], y[s][4], y[s][5], y[s][6], y[s][7]);
    }
    const bf16_t* gp = proj + row * PLD + C_GATE + head * 3;
    const float g0 = sigmoidf_(bf2f(gp[0])), g1 = sigmoidf_(bf2f(gp[1])), g2 = sigmoidf_(bf2f(gp[2]));
    const int cur = t0 >> 6;
    {
        X.Kbase = kc + (size_t)bg * 512 * 64; X.kstride = 64; X.Vbase = vc + (size_t)bg * 512 * 64; X.vstride = 64;
        const int nvmax = (t0 >> 4) + 1, jhi = (nvmax - 1) >> 6;
        X.m = NEGBIG; X.l = 0.f;
        nsa_branch<0>(X, 0, jhi, 0ull, 0ull, 0ull, 0ull, cur, t0 + 8 * w);
        const float lt = xor32_sum(X.l);
        X.invl = (lt > 0.f) ? 1.f / lt : 0.f;
        X.carry = 0.f;
#pragma unroll
        for (int i = 0; i < 16; i++) { X.O0[i] = 0.f; X.O1[i] = 0.f; }
        nsa_branch<1>(X, 0, jhi, 0ull, 0ull, 0ull, 0ull, cur, t0 + 8 * w);
    }
    unsigned long long mlo, mhi, ulo, uhi;
    {
        const int tk2 = lane >> 3, sub = lane & 7;
        unsigned k0 = 1u, k1 = 0u, k2 = 0u, k3 = 0u;
#define SETBIT(jj) { const int _j = (jj); if (_j < 32) k0 |= 1u << _j; else if (_j < 64) k1 |= 1u << (_j - 32); else if (_j < 96) k2 |= 1u << (_j - 64); else k3 |= 1u << (_j - 96); }
        SETBIT(cur);
        if (cur >= 1) SETBIT(cur - 1);
        const int ncand = cur - 2;
        if (ncand > 0) {
            if (ncand <= 13) {
                for (int jj = 1; jj <= cur - 2; jj++) SETBIT(jj);
            } else {
                float sc[16];
#pragma unroll
                for (int i = 0; i < 16; i++) { const int jj = sub + 8 * i; sc[i] = (jj >= 1 && jj <= cur - 2) ? X.imp_s[tk2 * 128 + jj] : -3e38f; }
#pragma unroll 1
                for (int it = 0; it < 13; it++) {
                    float bv = sc[0]; int bi = 0;
#pragma unroll
                    for (int i = 1; i < 16; i++) if (sc[i] > bv) { bv = sc[i]; bi = i; }
                    int bj = sub + 8 * bi;
#pragma unroll
                    for (int o = 1; o < 8; o <<= 1) {
                        const float ov = __shfl_xor(bv, o); const int oj = __shfl_xor(bj, o);
                        if (ov > bv || (ov == bv && oj < bj)) { bv = ov; bj = oj; }
                    }
                    SETBIT(bj);
#pragma unroll
                    for (int i = 0; i < 16; i++) if (bj == sub + 8 * i) sc[i] = -3e38f;
                }
            }
        }
#undef SETBIT
        if (sub == 0) { unsigned* d = X.sel_s + (8 * w + tk2) * 4; d[0] = k0; d[1] = k1; d[2] = k2; d[3] = k3; }
        __builtin_amdgcn_s_waitcnt(0xc07f);
        const unsigned* sp = X.sel_s + X.tokl * 4;
        const unsigned m0 = sp[0], m1 = sp[1], m2 = sp[2], m3 = sp[3];
        mlo = (unsigned long long)m0 | ((unsigned long long)m1 << 32); mhi = (unsigned long long)m2 | ((unsigned long long)m3 << 32);
        unsigned u0 = m0, u1 = m1, u2 = m2, u3 = m3;
#pragma unroll
        for (int o = 4; o < 32; o <<= 1) { u0 |= __shfl_xor(u0, o); u1 |= __shfl_xor(u1, o); u2 |= __shfl_xor(u2, o); u3 |= __shfl_xor(u3, o); }
        ulo = (unsigned long long)(unsigned)__builtin_amdgcn_readfirstlane(u0) | ((unsigned long long)(unsigned)__builtin_amdgcn_readfirstlane(u1) << 32);
        uhi = (unsigned long long)(unsigned)__builtin_amdgcn_readfirstlane(u2) | ((unsigned long long)(unsigned)__builtin_amdgcn_readfirstlane(u3) << 32);
    }
    nsa_facc<0>(X, g0);
    {
        X.Kbase = ksn + (size_t)bg * SEQ * 64; X.kstride = 64;
        X.Vbase = vsn + (size_t)bg * SEQ * 64; X.vstride = 64;
        X.m = NEGBIG; X.l = 0.f;
#pragma unroll
        for (int i = 0; i < 16; i++) { X.O0[i] = 0.f; X.O1[i] = 0.f; }
        nsa_branch<2>(X, 0, cur, mlo, mhi, ulo, uhi, cur, t0 + 8 * w);
        const float lt = xor32_sum(X.l);
        nsa_facc<1>(X, (lt > 0.f) ? g1 / lt : 0.f);
    }
    {
        X.Kbase = kwn + (size_t)bg * SEQ * 64; X.kstride = 64;
        X.Vbase = vwn + (size_t)bg * SEQ * 64; X.vstride = 64;
        X.m = NEGBIG; X.l = 0.f;
#pragma unroll
        for (int i = 0; i < 16; i++) { X.O0[i] = 0.f; X.O1[i] = 0.f; }
        const int jlo = (t0 >= 511) ? ((t0 - 511) >> 6) : 0;
        nsa_branch<3>(X, jlo, cur, 0ull, 0ull, 0ull, 0ull, cur, t0 + 8 * w);
        const float lt = xor32_sum(X.l);
        nsa_facc<2>(X, (lt > 0.f) ? g2 / lt : 0.f);
    }
    bf16_t* dst = mixo + row * mix_ld + head * 64 + 4 * X.hh;
#pragma unroll
    for (int q4 = 0; q4 < 4; q4++) {
        *(uint2*)(dst + 8 * q4) = make_uint2(pk2(X.O0[4 * q4], X.O0[4 * q4 + 1]), pk2(X.O0[4 * q4 + 2], X.O0[4 * q4 + 3]));
        *(uint2*)(dst + 32 + 8 * q4) = make_uint2(pk2(X.O1[4 * q4], X.O1[4 * q4 + 1]), pk2(X.O1[4 * q4 + 2], X.O1[4 * q4 + 3]));
    }
}

#define KLS 136
#define XSS 264
#define GDN_PREP_LDS (2 * 64 * KLS * 2 + 64 * XSS * 2 + 512 + 7680)
__device__ __forceinline__ unsigned pack2bf(float lo, float hi) { return (unsigned)f2bf(lo) | ((unsigned)f2bf(hi) << 16); }
__device__ __forceinline__ void d_gdn_prep2(const bf16_t* __restrict__ proj, const float* __restrict__ conv_w,
                                            const float* __restrict__ a_log, const float* __restrict__ dt_bias,
                                            bf16_t* __restrict__ guT, bf16_t* __restrict__ gw, bf16_t* __restrict__ gqd,
                                            bf16_t* __restrict__ gkdT, bf16_t* __restrict__ gin, float* __restrict__ gl, int chunk, char* smem) {
    bf16_t* kL = (bf16_t*)smem;
    bf16_t* qL = kL + 64 * KLS;
    float* AmT = (float*)qL;
    bf16_t* xs = qL + 64 * KLS;
    float* gcs = (float*)(xs + 64 * XSS);
    float* bts = gcs + 64;
    float* wL = bts + 64;
    const int tid = opaque_tid(), lane = tid & 63, w = tid >> 6;
    const int n = chunk & 127, h = (chunk >> 7) & 3, b = chunk >> 9;
    const int t0 = n * 64;
    const size_t rbase = (size_t)(b * SEQ + t0);
    const int i = tid >> 2, cg = tid & 3;
    const int tt0 = t0 + i - 3;
    const bf16_t* xcol = proj + (size_t)(b * SEQ) * PLD + C_GQKV + h * 128 + 32 * cg;
    uint4 xa[8], xb[8];
#define GP_LOAD(buf, hf) { _Pragma("unroll") for (int c2 = 0; c2 < 2; c2++) _Pragma("unroll") for (int j = 0; j < 4; j++) { \
            const int tr = tt0 + j; uint4 u = *(const uint4*)(xcol + (size_t)(tr < 0 ? 0 : tr) * PLD + ((hf) >> 1) * 512 + 16 * ((hf) & 1) + 8 * c2); \
            if (tr < 0) u = make_uint4(0u, 0u, 0u, 0u); buf[c2 * 4 + j] = u; } }
    GP_LOAD(xa, 0)
    GP_LOAD(xb, 1)
#pragma unroll
    for (int k6 = 0; k6 < 6; k6++) {
        const int idx = tid + 256 * k6, r = idx >> 7, c = idx & 127;
        wL[r * 160 + (c >> 5) * 40 + (c & 31)] = conv_w[(r & 3) * 1536 + (r >> 2) * 512 + h * 128 + c];
    }
    if (tid < 64) {
        const size_t r = (rbase + tid) * PLD;
        float a = bf2f(proj[r + C_A + h]), bb = bf2f(proj[r + C_B + h]);
        float xx = a + dt_bias[h];
        float sp = (xx > 20.f) ? xx : log1pf(__expf(xx));
        float c = -__expf(a_log[h]) * sp;
#pragma unroll
        for (int o = 1; o < 64; o <<= 1) { float nb = __shfl_up(c, o); if (lane >= o) c += nb; }
        gcs[tid] = c; bts[tid] = sigmoidf_(bb);
    }
    __syncthreads();
    {
        const float* wrow = wL + 40 * cg;
        float qv[32], kv[32];
        float sq = 0.f, sk = 0.f;
        const float bi = bts[i], ei = __expf(gcs[i]);
#define GP_COMP(buf, hf) { _Pragma("unroll") for (int c2 = 0; c2 < 2; c2++) { \
            const int m = (hf) >> 1, ck = 2 * ((hf) & 1) + c2; float cv[8]; \
            _Pragma("unroll") for (int e = 0; e < 8; e++) cv[e] = 0.f; \
            _Pragma("unroll") for (int j = 0; j < 4; j++) { \
                const uint4 u = buf[c2 * 4 + j]; \
                const float4 w0 = *(const float4*)(wrow + (m * 4 + j) * 160 + 8 * ck), w1 = *(const float4*)(wrow + (m * 4 + j) * 160 + 8 * ck + 4); \
                cv[0] += __uint_as_float(u.x << 16) * w0.x; cv[1] += __uint_as_float(u.x & 0xffff0000u) * w0.y; \
                cv[2] += __uint_as_float(u.y << 16) * w0.z; cv[3] += __uint_as_float(u.y & 0xffff0000u) * w0.w; \
                cv[4] += __uint_as_float(u.z << 16) * w1.x; cv[5] += __uint_as_float(u.z & 0xffff0000u) * w1.y; \
                cv[6] += __uint_as_float(u.w << 16) * w1.z; cv[7] += __uint_as_float(u.w & 0xffff0000u) * w1.w; } \
            _Pragma("unroll") for (int e = 0; e < 8; e++) { \
                const float sv = cv[e] * sigmoidf_(cv[e]); \
                if (m == 0) { qv[8 * ck + e] = sv; sq += sv * sv; } else if (m == 1) { kv[8 * ck + e] = sv; sk += sv * sv; } else cv[e] = sv * bi; } \
            if (m == 2) *(uint4*)(xs + i * XSS + 32 * cg + 8 * ck) = make_uint4(pk2(cv[0], cv[1]), pk2(cv[2], cv[3]), pk2(cv[4], cv[5]), pk2(cv[6], cv[7])); } \
            __builtin_amdgcn_sched_barrier(0); }
        GP_COMP(xa, 0) GP_LOAD(xa, 2)
        GP_COMP(xb, 1) GP_LOAD(xb, 3)
        GP_COMP(xa, 2) GP_LOAD(xa, 4)
        GP_COMP(xb, 3) GP_LOAD(xb, 5)
        GP_COMP(xa, 4)
        GP_COMP(xb, 5)
#undef GP_LOAD
#undef GP_COMP
        sq += dppf<0xB1>(sq); sq += dppf<0x4E>(sq);
        sk += dppf<0xB1>(sk); sk += dppf<0x4E>(sk);
        const float rq = rsqrtf(sq + 1e-6f) * 0.08838834764831845f, rk = rsqrtf(sk + 1e-6f);
        const float rqe = rq * ei, rkw = rk * bi * ei;
        unsigned char* qd = (unsigned char*)gqd + (size_t)chunk * 8192 + i * 128 + 32 * cg;
        const float rq8 = rqe * GQ_SCALE;
        unsigned qw[8];
#pragma unroll
        for (int ck = 0; ck < 4; ck++) {
            const float* q8 = qv + 8 * ck; const float* k8 = kv + 8 * ck;
            *(uint4*)(qL + i * KLS + 32 * cg + 8 * ck) = make_uint4(pk2(q8[0] * rq, q8[1] * rq), pk2(q8[2] * rq, q8[3] * rq), pk2(q8[4] * rq, q8[5] * rq), pk2(q8[6] * rq, q8[7] * rq));
            *(uint4*)(kL + i * KLS + 32 * cg + 8 * ck) = make_uint4(pk2(k8[0] * rk, k8[1] * rk), pk2(k8[2] * rk, k8[3] * rk), pk2(k8[4] * rk, k8[5] * rk), pk2(k8[6] * rk, k8[7] * rk));
            *(uint4*)(xs + i * XSS + 128 + 32 * cg + 8 * ck) = make_uint4(pk2(k8[0] * rkw, k8[1] * rkw), pk2(k8[2] * rkw, k8[3] * rkw), pk2(k8[4] * rkw, k8[5] * rkw), pk2(k8[6] * rkw, k8[7] * rkw));
            qw[2 * ck] = pk4_fp8(q8[0] * rq8, q8[1] * rq8, q8[2] * rq8, q8[3] * rq8); qw[2 * ck + 1] = pk4_fp8(q8[4] * rq8, q8[5] * rq8, q8[6] * rq8, q8[7] * rq8);
        }
        *(uint4*)qd = make_uint4(qw[0], qw[1], qw[2], qw[3]); *(uint4*)(qd + 16) = make_uint4(qw[4], qw[5], qw[6], qw[7]);
    }
    __syncthreads();
    const int n16 = lane & 15, kq = lane >> 4;
    f32x4 aqk[4], akk[4];
#pragma unroll
    for (int tj = 0; tj < 4; tj++) { aqk[tj] = (f32x4){0.f, 0.f, 0.f, 0.f}; akk[tj] = (f32x4){0.f, 0.f, 0.f, 0.f}; }
#pragma unroll
    for (int ks = 0; ks < 4; ks++) {
        bf16x8 qa = *(const bf16x8*)(qL + (16 * w + n16) * KLS + 32 * ks + 8 * kq);
        bf16x8 ka = *(const bf16x8*)(kL + (16 * w + n16) * KLS + 32 * ks + 8 * kq);
#pragma unroll
        for (int tj = 0; tj < 4; tj++) {
            bf16x8 kb = *(const bf16x8*)(kL + (16 * tj + n16) * KLS + 32 * ks + 8 * kq);
            aqk[tj] = __builtin_amdgcn_mfma_f32_16x16x32_bf16(qa, kb, aqk[tj], 0, 0, 0);
            akk[tj] = __builtin_amdgcn_mfma_f32_16x16x32_bf16(ka, kb, akk[tj], 0, 0, 0);
        }
    }
    {
        const float glast = gcs[63];
        const int kidx = tid >> 1, c0 = (tid & 1) * 32;
        unsigned pk[8];
#pragma unroll
        for (int cc = 0; cc < 32; cc += 4) {
            float v4[4];
#pragma unroll
            for (int e = 0; e < 4; e++) v4[e] = bf2f(kL[(c0 + cc + e) * KLS + kidx]) * __expf(glast - gcs[c0 + cc + e]) * GK_SCALE;
            pk[cc >> 2] = pk4_fp8(v4[0], v4[1], v4[2], v4[3]);
        }
        uint4* dst = (uint4*)((unsigned char*)gkdT + (size_t)chunk * 8192 + kidx * 64 + c0);
        dst[0] = make_uint4(pk[0], pk[1], pk[2], pk[3]); dst[1] = make_uint4(pk[4], pk[5], pk[6], pk[7]);
        if (tid == 0) gl[chunk] = __expf(glast);
    }
    __syncthreads();
#pragma unroll
    for (int tj = 0; tj < 4; tj++)
#pragma unroll
        for (int r = 0; r < 4; r++) {
            const int i = 16 * w + 4 * kq + r, j = 16 * tj + n16;
            const float dec = (j <= i) ? __expf(gcs[i] - gcs[j]) : 0.f;
            gin[(size_t)chunk * 4096 + i * 64 + j] = f2bf(aqk[tj][r] * dec);
            AmT[j * 64 + i] = (j < i) ? bts[i] * akk[tj][r] * dec : 0.f;
        }
    __syncthreads();
    {
        const int c = tid;
#pragma unroll 1
        for (int blk = 0; blk < 8; blk++) {
            const int i0 = blk * 8;
            float acc[8];
#pragma unroll
            for (int r = 0; r < 8; r++) acc[r] = bf2f(xs[(i0 + r) * XSS + c]);
#pragma unroll 1
            for (int jb = 0; jb < blk; jb++) {
#pragma unroll
                for (int jj = 0; jj < 8; jj++) {
                    const int j = jb * 8 + jj;
                    const float xj = bf2f(xs[j * XSS + c]);
                    const float4 a0 = *(const float4*)(AmT + j * 64 + i0), a1 = *(const float4*)(AmT + j * 64 + i0 + 4);
                    acc[0] -= a0.x * xj; acc[1] -= a0.y * xj; acc[2] -= a0.z * xj; acc[3] -= a0.w * xj;
                    acc[4] -= a1.x * xj; acc[5] -= a1.y * xj; acc[6] -= a1.z * xj; acc[7] -= a1.w * xj;
                }
            }
#pragma unroll
            for (int r = 1; r < 8; r++)
#pragma unroll
                for (int s2 = 0; s2 < r; s2++) acc[r] -= AmT[(i0 + s2) * 64 + i0 + r] * acc[s2];
#pragma unroll
            for (int r = 0; r < 8; r++) xs[(i0 + r) * XSS + c] = f2bf(acc[r]);
            if (c < 128) {
                *(uint4*)(guT + (size_t)chunk * 8192 + c * 64 + i0) =
                    make_uint4(pack2bf(acc[0], acc[1]), pack2bf(acc[2], acc[3]), pack2bf(acc[4], acc[5]), pack2bf(acc[6], acc[7]));
            }
        }
    }
    __syncthreads();
    {
        const int i = tid >> 2, sg = tid & 3;
        unsigned ww[8];
#pragma unroll
        for (int ck = 0; ck < 4; ck++) {
            const uint4 u = *(const uint4*)(xs + i * XSS + 128 + 32 * sg + 8 * ck);
            ww[2 * ck] = pk4_fp8(__uint_as_float(u.x << 16) * GW_SCALE, __uint_as_float(u.x & 0xffff0000u) * GW_SCALE, __uint_as_float(u.y << 16) * GW_SCALE, __uint_as_float(u.y & 0xffff0000u) * GW_SCALE);
            ww[2 * ck + 1] = pk4_fp8(__uint_as_float(u.z << 16) * GW_SCALE, __uint_as_float(u.z & 0xffff0000u) * GW_SCALE, __uint_as_float(u.w << 16) * GW_SCALE, __uint_as_float(u.w & 0xffff0000u) * GW_SCALE);
        }
        unsigned char* wd = (unsigned char*)gw + (size_t)chunk * 8192 + i * 128 + 32 * sg;
        *(uint4*)wd = make_uint4(ww[0], ww[1], ww[2], ww[3]); *(uint4*)(wd + 16) = make_uint4(ww[4], ww[5], ww[6], ww[7]);
    }
}

#define GNT 2
struct GdnFrag { u32x4 w8[2], q8[2], kd8[2]; bf16x8 inA[2]; uint2 uC[GNT]; float glv; };
__device__ __forceinline__ void gdn_load_frag(GdnFrag& f, const bf16_t* __restrict__ guT, const bf16_t* __restrict__ gw, const bf16_t* __restrict__ gqd,
                                              const bf16_t* __restrict__ gkdT, const bf16_t* __restrict__ gin, const float* __restrict__ gl,
                                              int chunk, int w, int sl, int n16, int kq) {
    const size_t cb = (size_t)chunk * 8192;
    const unsigned char* wr = (const unsigned char*)gw + cb + (16 * w + n16) * 128 + 16 * kq;
    const unsigned char* qr = (const unsigned char*)gqd + cb + (16 * w + n16) * 128 + 16 * kq;
    f.w8[0] = *(const u32x4*)wr; f.w8[1] = *(const u32x4*)(wr + 64);
    f.q8[0] = *(const u32x4*)qr; f.q8[1] = *(const u32x4*)(qr + 64);
#pragma unroll
    for (int hh = 0; hh < 2; hh++) f.kd8[hh] = *(const u32x4*)((const unsigned char*)gkdT + cb + (32 * w + 16 * hh + n16) * 64 + 16 * kq);
#pragma unroll
    for (int ks = 0; ks < 2; ks++) f.inA[ks] = *(const bf16x8*)(gin + (size_t)chunk * 4096 + (16 * w + n16) * 64 + 16 * kq + 8 * ks);
#pragma unroll
    for (int nt = 0; nt < GNT; nt++) f.uC[nt] = *(const uint2*)(guT + cb + (16 * (GNT * sl + nt) + n16) * 64 + 16 * w + 4 * kq);
    f.glv = gl[chunk];
}
#define STS 144
#define VNS 80
__device__ __forceinline__ void gdn_step(const GdnFrag& f, f32x4 (&S)[2][GNT], bf16_t* StT, bf16_t* vnT, float* __restrict__ ogrow, int w, int n16, int kq) {
    bf16x8 wA[4], qA[4], kdA[2][2];
#pragma unroll
    for (int ks = 0; ks < 4; ks++) {
        wA[ks] = fp8x8_bf16(f.w8[ks >> 1][2 * (ks & 1)], f.w8[ks >> 1][2 * (ks & 1) + 1]);
        qA[ks] = fp8x8_bf16(f.q8[ks >> 1][2 * (ks & 1)], f.q8[ks >> 1][2 * (ks & 1) + 1]);
    }
    f32x4 qs[GNT];
#pragma unroll
    for (int nt = 0; nt < GNT; nt++) {
        f32x4 ws = (f32x4){0.f, 0.f, 0.f, 0.f};
        qs[nt] = (f32x4){0.f, 0.f, 0.f, 0.f};
#pragma unroll
        for (int ks = 0; ks < 4; ks++) {
            bf16x8 sb = *(const bf16x8*)(StT + (16 * nt + n16) * STS + 64 * (ks >> 1) + 16 * kq + 8 * (ks & 1));
            ws = __builtin_amdgcn_mfma_f32_16x16x32_bf16(wA[ks], sb, ws, 0, 0, 0);
            qs[nt] = __builtin_amdgcn_mfma_f32_16x16x32_bf16(qA[ks], sb, qs[nt], 0, 0, 0);
        }
        const float iw = 1.f / GW_SCALE;
        float v0 = __uint_as_float(f.uC[nt].x << 16) - ws[0] * iw, v1 = __uint_as_float(f.uC[nt].x & 0xffff0000u) - ws[1] * iw;
        float v2 = __uint_as_float(f.uC[nt].y << 16) - ws[2] * iw, v3 = __uint_as_float(f.uC[nt].y & 0xffff0000u) - ws[3] * iw;
        *(uint2*)(vnT + (16 * nt + n16) * VNS + 16 * w + 4 * kq) = make_uint2(pack2bf(v0, v1), pack2bf(v2, v3));
    }
#pragma unroll
    for (int hh = 0; hh < 2; hh++)
#pragma unroll
        for (int ks = 0; ks < 2; ks++) kdA[hh][ks] = fp8x8_bf16(f.kd8[hh][2 * ks], f.kd8[hh][2 * ks + 1]);
    __syncthreads();
#pragma unroll
    for (int nt = 0; nt < GNT; nt++) {
        bf16x8 vb0 = *(const bf16x8*)(vnT + (16 * nt + n16) * VNS + 16 * kq), vb1 = *(const bf16x8*)(vnT + (16 * nt + n16) * VNS + 16 * kq + 8);
        f32x4 q = qs[nt] * (1.f / GQ_SCALE);
        q = __builtin_amdgcn_mfma_f32_16x16x32_bf16(f.inA[0], vb0, q, 0, 0, 0);
        q = __builtin_amdgcn_mfma_f32_16x16x32_bf16(f.inA[1], vb1, q, 0, 0, 0);
        f32x4 c0 = (f32x4){0.f, 0.f, 0.f, 0.f}, c1 = (f32x4){0.f, 0.f, 0.f, 0.f};
        c0 = __builtin_amdgcn_mfma_f32_16x16x32_bf16(kdA[0][0], vb0, c0, 0, 0, 0);
        c0 = __builtin_amdgcn_mfma_f32_16x16x32_bf16(kdA[0][1], vb1, c0, 0, 0, 0);
        c1 = __builtin_amdgcn_mfma_f32_16x16x32_bf16(kdA[1][0], vb0, c1, 0, 0, 0);
        c1 = __builtin_amdgcn_mfma_f32_16x16x32_bf16(kdA[1][1], vb1, c1, 0, 0, 0);
        const f32x4 s0 = S[0][nt] * f.glv + c0 * (1.f / GK_SCALE), s1 = S[1][nt] * f.glv + c1 * (1.f / GK_SCALE);
        S[0][nt] = s0; S[1][nt] = s1;
#pragma unroll
        for (int r = 0; r < 4; r++) ogrow[(size_t)(4 * kq + r) * 512 + 16 * nt] = q[r];
        *(uint2*)(StT + (16 * nt + n16) * STS + 32 * w + 4 * kq) = make_uint2(pack2bf(s0[0], s0[1]), pack2bf(s0[2], s0[3]));
        *(uint2*)(StT + (16 * nt + n16) * STS + 32 * w + 16 + 4 * kq) = make_uint2(pack2bf(s1[0], s1[1]), pack2bf(s1[2], s1[3]));
    }
    __syncthreads();
}
#define GDN_SCAN_ITEMS (8 * 8 / GNT)
__device__ __forceinline__ void d_gdn_scan2(const bf16_t* __restrict__ guT, const bf16_t* __restrict__ gw, const bf16_t* __restrict__ gqd,
                                            const bf16_t* __restrict__ gkdT, const bf16_t* __restrict__ gin, const float* __restrict__ gl,
                                            float* __restrict__ og, int item, char* smem) {
    bf16_t* StT = (bf16_t*)smem;
    bf16_t* vnT = StT + 16 * GNT * STS;
    const int tid = opaque_tid(), lane = tid & 63, w = tid >> 6, n16 = lane & 15, kq = lane >> 4;
    const int bh = item & 7, sl = item >> 3, b = bh >> 2, h = bh & 3;
    for (int i = tid; i < 16 * GNT * STS / 2; i += 256) ((unsigned*)StT)[i] = 0u;
    f32x4 S[2][GNT];
#pragma unroll
    for (int nt = 0; nt < GNT; nt++) { S[0][nt] = (f32x4){0.f, 0.f, 0.f, 0.f}; S[1][nt] = (f32x4){0.f, 0.f, 0.f, 0.f}; }
    GdnFrag fa, fb, fc;
    gdn_load_frag(fa, guT, gw, gqd, gkdT, gin, gl, bh * 128, w, sl, n16, kq);
    gdn_load_frag(fb, guT, gw, gqd, gkdT, gin, gl, bh * 128 + 1, w, sl, n16, kq);
    __syncthreads();
    float* obase = og + (size_t)(b * SEQ + 16 * w) * 512 + h * 128 + 16 * GNT * sl + n16;
#pragma unroll 1
    for (int n = 0; n < 128; n += 3) {
        if (n + 2 < 128) gdn_load_frag(fc, guT, gw, gqd, gkdT, gin, gl, bh * 128 + n + 2, w, sl, n16, kq);
        __builtin_amdgcn_sched_barrier(0);
        gdn_step(fa, S, StT, vnT, obase + (size_t)(n * 64) * 512, w, n16, kq);
        if (n + 3 < 128) gdn_load_frag(fa, guT, gw, gqd, gkdT, gin, gl, bh * 128 + n + 3, w, sl, n16, kq);
        __builtin_amdgcn_sched_barrier(0);
        gdn_step(fb, S, StT, vnT, obase + (size_t)((n + 1) * 64) * 512, w, n16, kq);
        if (n + 2 < 128) {
            if (n + 4 < 128) gdn_load_frag(fb, guT, gw, gqd, gkdT, gin, gl, bh * 128 + n + 4, w, sl, n16, kq);
            __builtin_amdgcn_sched_barrier(0);
            gdn_step(fc, S, StT, vnT, obase + (size_t)((n + 2) * 64) * 512, w, n16, kq);
        }
    }
}

__device__ __forceinline__ void d_gdn_out(const float* __restrict__ og, const bf16_t* __restrict__ proj, const float* __restrict__ gain, bf16_t* __restrict__ mix, int t, int lane) {
    const float* o = og + (size_t)t * 512;
    const bf16_t* z = proj + (size_t)t * PLD + C_Z;
    float a[8], zz[8];
#pragma unroll
    for (int i = 0; i < 8; i++) { a[i] = o[lane + 64 * i]; zz[i] = bf2f(z[lane + 64 * i]); }
    const float g0 = gain[lane], g1 = gain[lane + 64];
#pragma unroll
    for (int h = 0; h < 4; h++) {
        const float ss = wave_sum_dpp(a[2 * h] * a[2 * h] + a[2 * h + 1] * a[2 * h + 1]);
        const float r = rsqrtf(ss * (1.f / 128.f) + 1e-6f);
        mix[(size_t)t * DM + 512 + h * 128 + lane] = f2bf(a[2 * h] * r * g0 * zz[2 * h] * sigmoidf_(zz[2 * h]));
        mix[(size_t)t * DM + 512 + h * 128 + lane + 64] = f2bf(a[2 * h + 1] * r * g1 * zz[2 * h + 1] * sigmoidf_(zz[2 * h + 1]));
    }
}

__device__ __forceinline__ void route_load_subkeys(const float* __restrict__ subkeys, char* smem) {
    for (int idx = threadIdx.x; idx < 2 * 128 * 16; idx += 256) {
        const int half = idx >> 11, key = (idx >> 4) & 127, ch = idx & 15;
        const float* src = subkeys + ((size_t)(half * 128 + key)) * 128 + ch * 8;
        const float4 x0 = *(const float4*)src, x1 = *(const float4*)(src + 4);
        *(uint4*)(smem + half * 32768 + key * 256 + ((ch ^ (key & 15)) << 4)) = make_uint4(pk2(x0.x, x0.y), pk2(x0.z, x0.w), pk2(x1.x, x1.y), pk2(x1.z, x1.w));
    }
}
__device__ __forceinline__ unsigned f2ord(float f) { const int b = __float_as_int(f); return (unsigned)(b ^ ((b >> 31) | (int)0x80000000)); }
__device__ __forceinline__ float ord2f(unsigned k) { const int m = (int)k >> 31; return __int_as_float((int)(k ^ (unsigned)((~m) | (int)0x80000000))); }
#define CEX(i, j) { const unsigned _a = v[i], _b = v[j]; v[i] = max(_a, _b); v[j] = min(_a, _b); }
__device__ __forceinline__ void d_peer_route2(const bf16_t* __restrict__ qry, int* __restrict__ eidx, float* __restrict__ pgate, int mtile, const char* smem, int lane) {
    const int n16 = lane & 15, kq = lane >> 4;
    const int tA = 2 * mtile + (n16 >> 3), hA = n16 & 7;
    unsigned topk[2][4];
#pragma unroll
    for (int half = 0; half < 2; half++) {
        const bf16_t* qp = qry + (size_t)tA * 2048 + hA * 256 + half * 128 + 8 * kq;
        bf16x8 a[4];
#pragma unroll
        for (int ks = 0; ks < 4; ks++) a[ks] = *(const bf16x8*)(qp + 32 * ks);
        f32x4 acc[8];
#pragma unroll
        for (int nt = 0; nt < 8; nt++) acc[nt] = (f32x4){0.f, 0.f, 0.f, 0.f};
#pragma unroll
        for (int ks = 0; ks < 4; ks++)
#pragma unroll
            for (int nt = 0; nt < 8; nt++) {
                const bf16x8 bb = *(const bf16x8*)(smem + half * 32768 + (16 * nt + n16) * 256 + (((4 * ks + kq) ^ n16) << 4));
                acc[nt] = __builtin_amdgcn_mfma_f32_16x16x32_bf16(a[ks], bb, acc[nt], 0, 0, 0);
                if (nt == 3 || nt == 7) __builtin_amdgcn_sched_barrier(0);
            }
#pragma unroll
        for (int r = 0; r < 4; r++) {
            unsigned v[8];
#pragma unroll
            for (int nt = 0; nt < 8; nt++) v[nt] = (f2ord(acc[nt][r]) & 0xFFFFFF80u) | (unsigned)(nt << 4) | (unsigned)n16;
            CEX(0, 1) CEX(2, 3) CEX(4, 5) CEX(6, 7) CEX(0, 2) CEX(1, 3) CEX(4, 6) CEX(5, 7) CEX(1, 2) CEX(5, 6)
            CEX(0, 4) CEX(1, 5) CEX(2, 6) CEX(3, 7) CEX(2, 4) CEX(3, 5) CEX(1, 2) CEX(3, 4) CEX(5, 6)
            unsigned keep = 0u;
#pragma unroll 1
            for (int it = 0; it < 16; it++) {
                const unsigned mx = allmaxu16(v[0]);
                if (n16 == it) keep = mx;
                if (v[0] == mx) { v[0] = v[1]; v[1] = v[2]; v[2] = v[3]; v[3] = v[4]; v[4] = v[5]; v[5] = v[6]; v[6] = v[7]; v[7] = 0u; }
            }
            topk[half][r] = keep;
            __builtin_amdgcn_sched_barrier(0);
        }
    }
    const int lanebase = lane & 48;
    int si[4], sj[4];
    si[0] = 0; sj[0] = n16;
    si[1] = n16 < 8 ? 1 : (n16 < 13 ? 2 : 4);  sj[1] = n16 < 8 ? n16 : (n16 < 13 ? n16 - 8 : n16 - 13);
    si[2] = n16 < 4 ? 3 : (n16 < 6 ? 5 : (n16 < 8 ? 6 : (n16 < 10 ? 7 : n16 - 2)));
    sj[2] = n16 < 4 ? n16 : (n16 < 6 ? n16 - 4 : (n16 < 8 ? n16 - 6 : (n16 < 10 ? n16 - 8 : 0)));
    si[3] = 14 + (n16 & 1); sj[3] = 0;
#pragma unroll
    for (int r = 0; r < 4; r++) {
        const unsigned k1 = topk[0][r], k2 = topk[1][r];
        const int f1 = (int)((__float_as_uint(ord2f(k1)) & 0xFFFFFF80u) | (k1 & 127u)), f2 = (int)((__float_as_uint(ord2f(k2)) & 0xFFFFFF80u) | (k2 & 127u));
        unsigned v[4], es[4];
#pragma unroll
        for (int q = 0; q < 4; q++) {
            const unsigned av = (unsigned)__builtin_amdgcn_ds_bpermute((lanebase + si[q]) * 4, f1), bv = (unsigned)__builtin_amdgcn_ds_bpermute((lanebase + sj[q]) * 4, f2);
            es[q] = ((av & 127u) << 7) | (bv & 127u);
            v[q] = (f2ord(__uint_as_float(av) + __uint_as_float(bv)) & 0xFFFFFFC0u) | (unsigned)(q << 4) | (unsigned)n16;
        }
        if (n16 >= 2) v[3] = 0u;
        CEX(0, 1) CEX(2, 3) CEX(0, 2) CEX(1, 3) CEX(1, 2)
        unsigned keep = 0u;
#pragma unroll 1
        for (int it = 0; it < 16; it++) {
            const unsigned mx = allmaxu16(v[0]);
            if (n16 == it) keep = mx;
            if (v[0] == mx) { v[0] = v[1]; v[1] = v[2]; v[2] = v[3]; v[3] = 0u; }
        }
        const int src = (lanebase + (int)(keep & 15u)) * 4;
        const unsigned e0 = (unsigned)__builtin_amdgcn_ds_bpermute(src, (int)es[0]), e1 = (unsigned)__builtin_amdgcn_ds_bpermute(src, (int)es[1]);
        const unsigned e2 = (unsigned)__builtin_amdgcn_ds_bpermute(src, (int)es[2]), e3 = (unsigned)__builtin_amdgcn_ds_bpermute(src, (int)es[3]);
        const unsigned qw = (keep >> 4) & 3u;
        const unsigned ke = qw == 0u ? e0 : (qw == 1u ? e1 : (qw == 2u ? e2 : e3));
        const float ksc = ord2f(keep & 0xFFFFFFC0u);
        const float smax = ord2f(allmaxu16(keep) & 0xFFFFFFC0u);
        const float ex = __expf(ksc - smax);
        const float sum = allsum16(ex);
        const int row = 4 * kq + r;
        const size_t o = (size_t)(2 * mtile + (row >> 3)) * 128 + (row & 7) * 16 + n16;
        eidx[o] = (int)ke; pgate[o] = ex / sum;
    }
}
#undef CEX

#define XB_TMO      128
#define XB_XCNT(j)  (256  + 64 * (j))
#define XB_XSUB(j)  (1280 + 64 * (j))
#define XB_XGEN(j)  (2304 + 64 * (j))
#define XB_TOP      3328
#define XB_TOPGEN   3392
#define XB_QUEUE    3456
#define XL_CNT(j)    (4096 + 64 * (j))
#define XL_GEN(j)    (5120 + 64 * (j))
#define XCD_BAR_WORDS 6144
#define XB_SPIN_CAP (1u << 22)
#define LAS __attribute__((address_space(3)))
__device__ __forceinline__ unsigned xb_ld(unsigned* p)              { return __hip_atomic_load(p, __ATOMIC_RELAXED, __HIP_MEMORY_SCOPE_AGENT); }
__device__ __forceinline__ unsigned xb_add(unsigned* p, unsigned v) { return __hip_atomic_fetch_add(p, v, __ATOMIC_RELAXED, __HIP_MEMORY_SCOPE_AGENT); }
__device__ __forceinline__ unsigned xb_xcc_id() { return (unsigned)__builtin_amdgcn_s_getreg((3 << 11) | 20) & 0xFu; }
#define XB_SPIN(cond, bar) do { unsigned _sp = 0; while (cond) { __builtin_amdgcn_s_sleep(1); \
    if ((++_sp & 255u) == 0u) { if (xb_ld(&(bar)[XB_TMO])) break; if (_sp > XB_SPIN_CAP) { atomicAdd(&(bar)[XB_TMO], 1u); break; } } } } while (0)
struct XcdBarrier { unsigned* bar; unsigned x; volatile LAS unsigned* st; };
__device__ __forceinline__ XcdBarrier xcd_barrier_post(unsigned* bar, volatile LAS unsigned* st) {
    XcdBarrier b; b.bar = bar; b.x = xb_xcc_id(); b.st = st;
    if (threadIdx.x == 0) (void)xb_add(&bar[XB_XCNT(b.x)], 1u);
    return b;
}
__device__ __forceinline__ void xcd_barrier_complete(unsigned* bar, unsigned x, unsigned& nloc, unsigned& nx) {
    const unsigned G = gridDim.x * gridDim.y * gridDim.z;
    unsigned sum, cnt, mine, sp = 0u;
    for (;;) {
        sum = 0u; cnt = 0u; mine = 0u;
#pragma unroll
        for (unsigned j = 0; j < 16; ++j) { const unsigned c = xb_ld(&bar[XB_XCNT(j)]); sum += c; cnt += (c > 0u) ? 1u : 0u; mine = (j == x) ? c : mine; }
        if (sum == G) break;
        __builtin_amdgcn_s_sleep(1);
        if ((++sp & 255u) == 0u) { if (xb_ld(&bar[XB_TMO])) break; if (sp > XB_SPIN_CAP) { atomicAdd(&bar[XB_TMO], 1u); break; } }
    }
    nloc = mine > 0u ? mine : 1u; nx = cnt > 0u ? cnt : 1u;
}
__device__ __forceinline__ void xcd_barrier(const XcdBarrier& b) {
    asm volatile("s_waitcnt vmcnt(0)" ::: "memory");
    __syncthreads();
    if (threadIdx.x == 0) {
        unsigned* bar = b.bar;
        __builtin_amdgcn_s_waitcnt(0);
        unsigned nloc = b.st[0], nx = b.st[1];
        if (nloc == 0u) { xcd_barrier_complete(bar, b.x, nloc, nx); b.st[0] = nloc; b.st[1] = nx; }
        const unsigned old = xb_add(&bar[XB_XSUB(b.x)], 1u);
        const unsigned gen = old / nloc;
        if (old + 1u == (gen + 1u) * nloc) {
            __builtin_amdgcn_fence(__ATOMIC_RELEASE, "agent");
            asm volatile("s_waitcnt vmcnt(0)" ::: "memory");
            const unsigned og = xb_add(&bar[XB_TOP], 1u);
            const unsigned tg = og / nx;
            if (og + 1u == (tg + 1u) * nx) xb_add(&bar[XB_TOPGEN], 1u);
            else XB_SPIN(xb_ld(&bar[XB_TOPGEN]) == tg, bar);
            __builtin_amdgcn_fence(__ATOMIC_ACQUIRE, "agent");
            xb_add(&bar[XB_XGEN(b.x)], 1u);
            asm volatile("s_waitcnt vmcnt(0)" ::: "memory");
        } else {
            XB_SPIN(xb_ld(&bar[XB_XGEN(b.x)]) == gen, bar);
            __builtin_amdgcn_fence(__ATOMIC_ACQUIRE, "agent");
            asm volatile("s_waitcnt vmcnt(0)" ::: "memory");
        }
    }
    __syncthreads();
}

__device__ __forceinline__ void xcd_local_sync(const XcdBarrier& b, unsigned round) {
    __syncthreads();
    if (threadIdx.x == 0) {
        unsigned nloc = b.st[0]; if (nloc == 0u) nloc = 1u;
        const unsigned old = xb_add(&b.bar[XL_CNT(b.x)], 1u);
        if (old + 1u == nloc * (round + 1u)) xb_add(&b.bar[XL_GEN(b.x)], 1u);
        else { unsigned sp = 0; while (xb_ld(&b.bar[XL_GEN(b.x)]) <= round && ++sp < (1u << 16)) __builtin_amdgcn_s_sleep(1); }
    }
    __syncthreads();
}

struct QRow { float4 x[4]; };
__device__ __forceinline__ void quant_load(QRow& q, const float* __restrict__ src, int row, int lane) {
    const float4* p = (const float4*)(src + (size_t)row * DM) + lane * 4;
#pragma unroll
    for (int i = 0; i < 4; i++) q.x[i] = p[i];
}
__device__ __forceinline__ void quant_finish(const QRow& q, unsigned char* __restrict__ dst, float* __restrict__ scale, int row, int lane, int bias) {
    float am = 0.f;
#pragma unroll
    for (int i = 0; i < 4; i++) am = fmaxf(am, fmaxf(fmaxf(fabsf(q.x[i].x), fabsf(q.x[i].y)), fmaxf(fabsf(q.x[i].z), fabsf(q.x[i].w))));
    am = wave_max(am);
    const float sc = (am > 0.f) ? am * (bias ? (1.f / 224.f) : (1.f / 127.f)) : 1.f;
    const float inv = 1.f / sc;
    unsigned wv[4];
#pragma unroll
    for (int i = 0; i < 4; i++) {
        if (bias) {
            int w = 0;
            w = __builtin_amdgcn_cvt_pk_fp8_f32(q.x[i].x * inv, q.x[i].y * inv, w, false);
            w = __builtin_amdgcn_cvt_pk_fp8_f32(q.x[i].z * inv, q.x[i].w * inv, w, true);
            wv[i] = (unsigned)w;
        } else {
            const int q0 = (int)rintf(q.x[i].x * inv), q1 = (int)rintf(q.x[i].y * inv), q2 = (int)rintf(q.x[i].z * inv), q3 = (int)rintf(q.x[i].w * inv);
            wv[i] = (unsigned)(q0 & 0xff) | ((unsigned)(q1 & 0xff) << 8) | ((unsigned)(q2 & 0xff) << 16) | ((unsigned)(q3 & 0xff) << 24);
        }
    }
    ((uint4*)(dst + (size_t)row * (2 * DM)))[lane] = make_uint4(wv[0], wv[1], wv[2], wv[3]);
    if (lane == 0) scale[row] = sc;
}
__device__ __forceinline__ void d_quant_rows16(const float* __restrict__ pu, const float* __restrict__ pv, unsigned char* __restrict__ dst,
                                               float* __restrict__ su, float* __restrict__ sv, int r0, int lane) {
#pragma unroll 1
    for (int r = r0; r < r0 + 16; r += 2) {
        QRow a0, a1, b0, b1;
        quant_load(a0, pu, r, lane); quant_load(b0, pv, r, lane); quant_load(a1, pu, r + 1, lane); quant_load(b1, pv, r + 1, lane);
        quant_finish(a0, dst, su, r, lane, 0); quant_finish(b0, dst + DM, sv, r, lane, 128);
        quant_finish(a1, dst, su, r + 1, lane, 0); quant_finish(b1, dst + DM, sv, r + 1, lane, 128);
    }
}

struct PeerGrp { u32x4 u[4]; u32x4 v[4]; float gvl, sul; };
__device__ __forceinline__ void peer_load(PeerGrp& G, const unsigned char* __restrict__ uq, const unsigned char* __restrict__ vq,
                                          int esrc, float gsrc, float susrc, int k0, int lane) {
    const int sl = 4 * (k0 + 2 * (lane & 1) + ((lane >> 1) & 1));
    G.gvl = __builtin_bit_cast(float, __builtin_amdgcn_ds_bpermute(sl, __builtin_bit_cast(int, gsrc)));
    G.sul = __builtin_bit_cast(float, __builtin_amdgcn_ds_bpermute(sl, __builtin_bit_cast(int, susrc)));
#pragma unroll
    for (int i = 0; i < 4; i++) {
        const int e = __builtin_amdgcn_readlane(esrc, (k0 + i) & 63);
        G.u[i] = ((const u32x4*)(uq + (size_t)e * (2 * DM)))[lane];
        G.v[i] = ((const u32x4*)(uq + (size_t)e * (2 * DM) + DM))[lane];
    }
}
__device__ __forceinline__ void peer_compute(const PeerGrp& G, const int (&xq)[4], float sx, float (&acc)[16], float& bsum, int lane) {
    int d[4];
#pragma unroll
    for (int i = 0; i < 4; i++) {
        int sdot = 0;
        sdot = __builtin_amdgcn_sdot4((int)G.u[i][0], xq[0], sdot, false); sdot = __builtin_amdgcn_sdot4((int)G.u[i][1], xq[1], sdot, false);
        sdot = __builtin_amdgcn_sdot4((int)G.u[i][2], xq[2], sdot, false); sdot = __builtin_amdgcn_sdot4((int)G.u[i][3], xq[3], sdot, false);
        d[i] = sdot;
    }
    const bool odd = lane & 1, b1 = lane & 2;
    int ka = odd ? d[2] : d[0], kb = odd ? d[3] : d[1];
    const int sa = odd ? d[0] : d[2], sb = odd ? d[1] : d[3];
    ka += (int)dppu<0xB1>((unsigned)sa); kb += (int)dppu<0xB1>((unsigned)sb);
    int c = b1 ? kb : ka;
    const int sc = b1 ? ka : kb;
    c += (int)dppu<0x4E>((unsigned)sc);
    c += (int)dppu<0x124>((unsigned)c); c += (int)dppu<0x128>((unsigned)c);
    { auto r = __builtin_amdgcn_permlane16_swap((unsigned)c, (unsigned)c, false, false); c = (int)(r[0] + r[1]); }
    { auto r = __builtin_amdgcn_permlane32_swap((unsigned)c, (unsigned)c, false, false); c = (int)(r[0] + r[1]); }
    const float dot = (float)c * (G.sul * sx);
    const float u2 = 1.5957691216057308f * (dot + 0.044715f * dot * dot * dot);
    const float csl = G.gvl * dot * __builtin_amdgcn_rcpf(1.f + __expf(-u2));
#pragma unroll
    for (int i = 0; i < 4; i++) {
        const float cs = __builtin_bit_cast(float, __builtin_amdgcn_readlane(__builtin_bit_cast(int, csl), ((i & 1) << 1) | (i >> 1)));
        const f32x2 cs2 = (f32x2){cs, cs};
#pragma unroll
        for (int j = 0; j < 4; j++) {
            const int wv = (int)G.v[i][j];
            const f32x2 lo = __builtin_amdgcn_cvt_pk_f32_fp8(wv, false), hi = __builtin_amdgcn_cvt_pk_f32_fp8(wv, true);
            f32x2 a0 = (f32x2){acc[4 * j], acc[4 * j + 1]}, a1 = (f32x2){acc[4 * j + 2], acc[4 * j + 3]};
            a0 = __builtin_elementwise_fma(cs2, lo, a0); a1 = __builtin_elementwise_fma(cs2, hi, a1);
            acc[4 * j] = a0[0]; acc[4 * j + 1] = a0[1]; acc[4 * j + 2] = a1[0]; acc[4 * j + 3] = a1[1];
        }
    }
}
struct PeerTok { int xq[4]; float sx; int e_lo, e_hi; float g_lo, g_hi, s_lo, s_hi; };
__device__ __forceinline__ void peer_prep_token(PeerTok& T, const bf16_t* __restrict__ h2, const int* __restrict__ eidx, const float* __restrict__ pgate,
                                                const float* __restrict__ su, const float* __restrict__ sv, const float* __restrict__ ssq, const float* __restrict__ fgain, int token, int lane) {
    const uint4 xa = ((const uint4*)(h2 + (size_t)token * DM))[2 * lane], xb = ((const uint4*)(h2 + (size_t)token * DM))[2 * lane + 1];
    const unsigned xw[8] = {xa.x, xa.y, xa.z, xa.w, xb.x, xb.y, xb.z, xb.w};
    float xf[16];
    float am = 0.f;
    const float rr = rsqrtf(allsum16(ssq[(size_t)token * 16 + (lane & 15)]) * (1.f / DM) + 1e-6f);
    const float4* gp = (const float4*)(fgain + lane * 16);
    const float4 ga = gp[0], gb = gp[1], gc = gp[2], gd = gp[3];
    const float gg[16] = {ga.x, ga.y, ga.z, ga.w, gb.x, gb.y, gb.z, gb.w, gc.x, gc.y, gc.z, gc.w, gd.x, gd.y, gd.z, gd.w};
#pragma unroll
    for (int j = 0; j < 8; j++) {
        xf[2 * j] = __uint_as_float(xw[j] << 16) * rr * gg[2 * j]; xf[2 * j + 1] = __uint_as_float(xw[j] & 0xffff0000u) * rr * gg[2 * j + 1];
        am = fmaxf(am, fmaxf(fabsf(xf[2 * j]), fabsf(xf[2 * j + 1])));
    }
    am = wave_max(am);
    T.sx = (am > 0.f) ? am * (1.f / 127.f) : 1.f;
    const float isx = 1.f / T.sx;
#pragma unroll
    for (int j = 0; j < 4; j++) {
        const int q0 = (int)rintf(xf[4 * j] * isx), q1 = (int)rintf(xf[4 * j + 1] * isx), q2 = (int)rintf(xf[4 * j + 2] * isx), q3 = (int)rintf(xf[4 * j + 3] * isx);
        T.xq[j] = (int)((unsigned)(q0 & 0xff) | ((unsigned)(q1 & 0xff) << 8) | ((unsigned)(q2 & 0xff) << 16) | ((unsigned)(q3 & 0xff) << 24));
    }
    int e_lo = eidx[(size_t)token * 128 + lane], e_hi = eidx[(size_t)token * 128 + 64 + lane];
    float g_lo = pgate[(size_t)token * 128 + lane], g_hi = pgate[(size_t)token * 128 + 64 + lane];
    {
        unsigned long long ka = ((unsigned long long)(unsigned)e_lo << 32) | __float_as_uint(g_lo), kb = ((unsigned long long)(unsigned)e_hi << 32) | __float_as_uint(g_hi);
#pragma unroll
        for (int k = 2; k <= 128; k <<= 1) {
#pragma unroll
            for (int j = k >> 1; j > 0; j >>= 1) {
                if (j == 64) { const unsigned long long mn = ka < kb ? ka : kb, mx = ka < kb ? kb : ka; ka = mn; kb = mx; }
                else {
                    const unsigned long long pa = ((unsigned long long)(unsigned)__shfl_xor((int)(ka >> 32), j) << 32) | (unsigned)__shfl_xor((int)ka, j);
                    const unsigned long long pb = ((unsigned long long)(unsigned)__shfl_xor((int)(kb >> 32), j) << 32) | (unsigned)__shfl_xor((int)kb, j);
                    const bool lower = (lane & j) == 0;
                    const bool dirA = (lane & k) == 0, dirB = ((lane + 64) & k) == 0;
                    ka = ((lower == dirA) == (ka < pa)) ? ka : pa;
                    kb = ((lower == dirB) == (kb < pb)) ? kb : pb;
                }
            }
        }
        e_lo = (int)(ka >> 32); g_lo = __uint_as_float((unsigned)ka); e_hi = (int)(kb >> 32); g_hi = __uint_as_float((unsigned)kb);
    }
    T.e_lo = e_lo; T.e_hi = e_hi;
    T.g_lo = g_lo * sv[e_lo]; T.g_hi = g_hi * sv[e_hi];
    T.s_lo = su[e_lo]; T.s_hi = su[e_hi];
}
__device__ __forceinline__ void peer_store(float* __restrict__ out, int token, int lane, const float (&acc)[16], float bsum) {
    float4* o = (float4*)(out + (size_t)token * DM + lane * 16);
#pragma unroll
    for (int j = 0; j < 4; j++) {
        float4 t = o[j];
        t.x += acc[4 * j]; t.y += acc[4 * j + 1]; t.z += acc[4 * j + 2]; t.w += acc[4 * j + 3];
        o[j] = t;
    }
}
__device__ __forceinline__ int peer_key(const PeerTok& T, int g) {
    const int idx = 4 * g;
    return (idx < 64) ? __builtin_amdgcn_readlane(T.e_lo, idx & 63) : __builtin_amdgcn_readlane(T.e_hi, idx & 63);
}
__device__ __forceinline__ void peer_load_grp(PeerGrp& G, const PeerTok& T, int g, const unsigned char* __restrict__ uq, int lane) {
    const int idx = 4 * g;
    if (idx < 64) peer_load(G, uq, uq, T.e_lo, T.g_lo, T.s_lo, idx, lane); else peer_load(G, uq, uq, T.e_hi, T.g_hi, T.s_hi, idx - 64, lane);
}
__device__ __forceinline__ void d_peer_expert_pair(const bf16_t* __restrict__ h2, const int* __restrict__ eidx, const float* __restrict__ pgate,
                                                   const unsigned char* __restrict__ uq, const float* __restrict__ su, const float* __restrict__ sv,
                                                   const float* __restrict__ ssq, const float* __restrict__ fgain, float* __restrict__ out,
                                                   int tokA, int lane, const XcdBarrier& xbar, unsigned midround) {
    PeerTok TA, TB;
    peer_prep_token(TA, h2, eidx, pgate, su, sv, ssq, fgain, tokA, lane);
    peer_prep_token(TB, h2, eidx, pgate, su, sv, ssq, fgain, tokA + 1, lane);
    float accA[16], accB[16];
#pragma unroll
    for (int i = 0; i < 16; i++) { accA[i] = 0.f; accB[i] = 0.f; }
    float bsA = 0.f, bsB = 0.f;
    int gA = 0, gB = 0;
#define PEER_PICK(f) { if (gA >= 32) f = 1; else if (gB >= 32) f = 0; else f = (peer_key(TA, gA) <= peer_key(TB, gB)) ? 0 : 1; }
#define PEER_LOAD(S, f) { if (f) { peer_load_grp(S, TB, gB, uq, lane); gB++; } else { peer_load_grp(S, TA, gA, uq, lane); gA++; } }
#define PEER_COMP(S, f) { if (f) peer_compute(S, TB.xq, TB.sx, accB, bsB, lane); else peer_compute(S, TA.xq, TA.sx, accA, bsA, lane); }
    PeerGrp S0, S1;
    int f0, f1;
    PEER_PICK(f0) PEER_LOAD(S0, f0)
#pragma unroll 1
    for (int step = 0; step < 64; step += 2) {
        PEER_PICK(f1) PEER_LOAD(S1, f1)
        PEER_COMP(S0, f0)
        if (step + 2 < 64) { PEER_PICK(f0) PEER_LOAD(S0, f0) }
        PEER_COMP(S1, f1)
        if (step == 30) xcd_local_sync(xbar, midround);
    }
#undef PEER_PICK
#undef PEER_LOAD
#undef PEER_COMP
    peer_store(out, tokA, lane, accA, bsA);
    peer_store(out, tokA + 1, lane, accB, bsB);
}

struct MKP {
    const float *x, *attn_norm, *w_in, *q_gain, *k_gain, *cmp_pos, *cmp_w1, *cmp_w2, *gdn_conv, *a_log, *dt_bias, *out_gain, *w_out, *ffn_norm, *w_query, *subkeys, *peer_u, *peer_v;
    float* out; char* ws; unsigned* bar;
};

#define SMEM_BYTES 76800

__global__ __launch_bounds__(256, 2) void hybrid_megakernel(MKP P) {
    extern __shared__ __attribute__((aligned(16))) char smem[];
    __shared__ uint4 xb_words;
    __shared__ int q_item;
    const int G = gridDim.x, bid0 = blockIdx.x;
    if (threadIdx.x == 0) xb_words = make_uint4(0u, 0u, 0u, 0u);
    __syncthreads();
    XcdBarrier B = xcd_barrier_post(P.bar, (volatile LAS unsigned*)&xb_words);
    char* ws = P.ws;
    bf16_t* w_in_t = (bf16_t*)(ws + OFF_WINT);
    bf16_t* w_out_t = (bf16_t*)(ws + OFF_WOUTT);
    bf16_t* w_q_t = (bf16_t*)(ws + OFF_WQT);
    bf16_t* cw1_t = (bf16_t*)(ws + OFF_CW1T);
    float* cbias = (float*)(ws + OFF_CBIAS);
    bf16_t* h_bf = (bf16_t*)(ws + OFF_HBF);
    bf16_t* proj = (bf16_t*)(ws + OFF_PROJ);
    bf16_t* ksn = (bf16_t*)(ws + OFF_KSN);
    bf16_t* kwn = (bf16_t*)(ws + OFF_KWN);
    bf16_t* kc = (bf16_t*)(ws + OFF_KC);
    bf16_t* vc = (bf16_t*)(ws + OFF_VC);
    bf16_t* hid = (bf16_t*)(ws + OFF_HID);
    bf16_t* gu = (bf16_t*)(ws + OFF_GU);
    bf16_t* gw = (bf16_t*)(ws + OFF_GW);
    bf16_t* gqd = (bf16_t*)(ws + OFF_GQD);
    bf16_t* gkd = (bf16_t*)(ws + OFF_GKD);
    bf16_t* gin = (bf16_t*)(ws + OFF_GIN);
    float* gl = (float*)(ws + OFF_GL);
    bf16_t* mix = (bf16_t*)(ws + OFF_MIX);
    bf16_t* qry = (bf16_t*)(ws + OFF_QRY);
    bf16_t* h2 = (bf16_t*)(ws + OFF_H2);
    int* eidx = (int*)(ws + OFF_EIDX);
    float* pgate = (float*)(ws + OFF_PGATE);
    unsigned char* uq = (unsigned char*)(ws + OFF_UQ);
    unsigned char* vq = (unsigned char*)(ws + OFF_VQ);
    float* su = (float*)(ws + OFF_SU);
    float* sv = (float*)(ws + OFF_SV);
    float* og = P.out;
    float2* rope = (float2*)(ws + OFF_ROPE);
    float* ssq = (float*)(ws + OFF_SSQ);
    bf16_t* vsn = (bf16_t*)(ws + OFF_VSN);
    bf16_t* vwn = (bf16_t*)(ws + OFF_VWN);
    bf16_t* cw2t = (bf16_t*)(ws + OFF_CW2T);
    unsigned char* uq_tmp = (unsigned char*)(P.out + 8388608);
    unsigned char* vq_tmp = uq_tmp + 16384ull * 1024;

    {
        const int n1 = 108 * 8, n2 = n1 + 32 * 8, n3 = n2 + 64 * 8, n4 = n3 + 2 * 8 * 16, n5 = n4 + 2 * 2 * 2;
        for (int it = bid0; it < n5; it += G) {
            if (it < n1) d_transpose_bf16(P.w_in, 1024, IN_COLS, w_in_t, it % 108, it / 108, smem);
            else if (it < n2) { int r = it - n1; d_transpose_bf16(P.w_out, 1024, 1024, w_out_t, r % 32, r / 32, smem); }
            else if (it < n3) { int r = it - n2; d_transpose_bf16(P.w_query, 1024, 2048, w_q_t, r % 64, r / 64, smem, P.ffn_norm); }
            else if (it < n4) { int r = it - n3; int j = r >> 7; r &= 127; d_transpose_bf16(P.cmp_w1 + (size_t)j * 2048 * 256, 2048, 256, cw1_t + (size_t)j * 256 * 2048, r % 8, r / 8, smem); }
            else { int r = it - n4; int j = r >> 2; r &= 3; d_transpose_bf16(P.cmp_w2 + (size_t)j * 256 * 64, 256, 64, cw2t + (size_t)j * 64 * 256, r % 2, r / 2, smem); }
        }
        for (int it = bid0; it < 16; it += G) d_cmp_bias(P.cmp_pos, P.cmp_w1, cbias, it, smem);
        for (int it = bid0; it < T_TOK / 4; it += G) d_rmsnorm_bf16(P.x, P.attn_norm, h_bf, it);
        for (int i = bid0 * 256 + threadIdx.x; i < 8192 * 32; i += G * 256) {
            const int pos = i >> 5, fi = i & 31;
            float sn, cs; sincosf((float)pos * expf(-9.210340371976184f * (float)(2 * fi) / 64.f), &sn, &cs);
            rope[i] = make_float2(cs, sn);
        }
        for (int i = bid0 * 256 + threadIdx.x; i < 32 * PLD / 2; i += G * 256) ((unsigned*)(proj + (size_t)T_TOK * PLD))[i] = 0u;
    }
    xcd_barrier(B);
    {
        GemmP p{}; p.A = h_bf; p.lda = 1024; p.akts = 64; p.Bt = w_in_t; p.ldb = 1024; p.K = 1024; p.mtiles = 64; p.ntiles = 27; p.out = proj;
        for (int it = bid0; it < 64 * 27; it += G) d_gemm<EPI_PROJ>(p, it, smem);
    }
    xcd_barrier(B);
    {
        for (int it = bid0; it < 32; it += G) {
            int inst = it >> 2, tile = it & 3;
            int j = inst >> 2, b = (inst >> 1) & 1, g = inst & 1;
            GemmP p{}; p.A = proj + (size_t)(b * SEQ) * PLD + C_KV + 128 * j + 64 * g; p.lda = 16 * PLD; p.akts = PLD;
            p.Bt = cw1_t + (size_t)j * 256 * 2048; p.ldb = 2048; p.K = 2048; p.mtiles = 2; p.ntiles = 2;
            p.out = hid + (size_t)inst * 512 * 256; p.aux = cbias + j * 256;
            d_gemm<EPI_HID>(p, tile, smem);
        }
        for (;;) {
            if (threadIdx.x == 0) q_item = (int)xb_add(&P.bar[XB_QUEUE + 64], 1u);
            __syncthreads();
            const int it = q_item;
            __syncthreads();
            if (it >= 1024) break;
            d_gdn_prep2(proj, P.gdn_conv, P.a_log, P.dt_bias, gu, gw, gqd, gkd, gin, gl, it, smem); __syncthreads();
        }
        for (;;) {
            if (threadIdx.x == 0) q_item = (int)xb_add(&P.bar[XB_QUEUE + 128], 1u);
            __syncthreads();
            const int it = q_item;
            __syncthreads();
            if (it >= 1024) break;
            for (int k8 = 0; k8 < 8; k8++) d_knorm_rope(proj, P.k_gain, ksn, kwn, vsn, vwn, rope, it * 8 + k8);
        }
    }
    xcd_barrier(B);
    for (int wi = bid0 * 4 + (threadIdx.x >> 6); wi < 256; wi += G * 4) d_cmp2_mfma(hid, cw2t, P.k_gain, rope, kc, vc, wi, threadIdx.x & 63);
    xcd_barrier(B);
    {
        if (bid0 < GDN_SCAN_ITEMS) d_gdn_scan2(gu, gw, gqd, gkd, gin, gl, og, bid0, smem);
        __syncthreads();
        const int rep = 0;
        for (;;) {
            if (threadIdx.x == 0) q_item = (int)xb_add(&P.bar[XB_QUEUE + 256 * rep], 1u);
            __syncthreads();
            const int it = q_item;
            if (it >= 1024 + 256) break;
            if (it < 256) {
                d_quant_rows16(P.peer_u, P.peer_v, uq_tmp, su, sv, it * 64 + (threadIdx.x >> 6) * 16, threadIdx.x & 63);
            } else {
                d_nsa_mfma(proj, P.q_gain, rope, ksn, kwn, kc, vc, vsn, vwn, mix, DM, it - 256, smem);
            }
            __syncthreads();
        }
    }
    xcd_barrier(B);
    for (int t = bid0 * 4 + (threadIdx.x >> 6); t < T_TOK; t += G * 4) d_gdn_out(og, proj, P.out_gain, mix, t, threadIdx.x & 63);
    for (int i = bid0 * 256 + threadIdx.x; i < 2 * 16384 * 1024 / 16; i += G * 256) ((uint4*)uq)[i] = ((const uint4*)uq_tmp)[i];
    xcd_barrier(B);
    {
        GemmP p{}; p.A = mix; p.lda = 1024; p.akts = 64; p.Bt = w_out_t; p.ldb = 1024; p.K = 1024; p.mtiles = 64; p.ntiles = 8; p.out = P.out; p.aux = P.x; p.out2 = h2; p.ssq = ssq;
        for (int it = bid0; it < 64 * 8; it += G) d_gemm<EPI_OUT>(p, it, smem);
    }
    xcd_barrier(B);
    {
        GemmP p{}; p.A = h2; p.lda = 1024; p.akts = 64; p.Bt = w_q_t; p.ldb = 1024; p.K = 1024; p.mtiles = 64; p.ntiles = 16; p.out = qry; p.ssq = ssq;
        for (int it = bid0; it < 64 * 16; it += G) d_gemm<EPI_QRY>(p, it, smem);
    }
    xcd_barrier(B);
    route_load_subkeys(P.subkeys, smem);
    __syncthreads();
    for (int mt = bid0 * 4 + (threadIdx.x >> 6); mt < T_TOK / 2; mt += G * 4) d_peer_route2(qry, eidx, pgate, mt, smem, threadIdx.x & 63);
    xcd_barrier(B);
    {
        const int rounds = (T_TOK / 8 + G - 1) / G;
        for (int rd = 0; rd < rounds; rd++) {
            xcd_local_sync(B, (unsigned)(2 * rd));
            const int it = rd * G + bid0;
            if (it < T_TOK / 8) d_peer_expert_pair(h2, eidx, pgate, uq, su, sv, ssq, P.ffn_norm, P.out, it * 8 + 2 * (threadIdx.x >> 6), threadIdx.x & 63, B, (unsigned)(2 * rd + 1));
            else xcd_local_sync(B, (unsigned)(2 * rd + 1));
        }
    }
}

extern "C" void kernel_launch(void* const* d_in, const int* in_sizes, int n_in, void* d_out, int out_size, void* d_ws, size_t ws_size,
                              hipStream_t stream) {
    const size_t bar_off = (OFF_END + 255) & ~(size_t)255;
    if (ws_size < bar_off + XCD_BAR_WORDS * 4) return;
    static int grid_blocks = 0;
    if (!grid_blocks) {
        int dev = 0, cus = 0, per_cu = 0;
        (void)hipGetDevice(&dev);
        (void)hipDeviceGetAttribute(&cus, hipDeviceAttributeMultiprocessorCount, dev);
        (void)hipFuncSetAttribute((const void*)hybrid_megakernel, hipFuncAttributeMaxDynamicSharedMemorySize, SMEM_BYTES);
        (void)hipOccupancyMaxActiveBlocksPerMultiprocessor(&per_cu, hybrid_megakernel, 256, SMEM_BYTES);
        if (per_cu > 2) per_cu = 2;
        grid_blocks = cus * per_cu;
    }
    if (grid_blocks <= 0) return;
    MKP P{};
    P.x = (const float*)d_in[0]; P.attn_norm = (const float*)d_in[1]; P.w_in = (const float*)d_in[2]; P.q_gain = (const float*)d_in[3];
    P.k_gain = (const float*)d_in[4]; P.cmp_pos = (const float*)d_in[5]; P.cmp_w1 = (const float*)d_in[6]; P.cmp_w2 = (const float*)d_in[7];
    P.gdn_conv = (const float*)d_in[8]; P.a_log = (const float*)d_in[9]; P.dt_bias = (const float*)d_in[10]; P.out_gain = (const float*)d_in[11];
    P.w_out = (const float*)d_in[12]; P.ffn_norm = (const float*)d_in[13]; P.w_query = (const float*)d_in[14]; P.subkeys = (const float*)d_in[15];
    P.peer_u = (const float*)d_in[16]; P.peer_v = (const float*)d_in[17];
    P.out = (float*)d_out; P.ws = (char*)d_ws; P.bar = (unsigned*)((char*)d_ws + bar_off);
    (void)hipMemsetAsync(P.bar, 0, XCD_BAR_WORDS * 4, stream);
    hipLaunchKernelGGL(hybrid_megakernel, dim3(grid_blocks), dim3(256), SMEM_BYTES, stream, P);
}
```

```cpp
#include <hip/hip_runtime.h>
#include <stdint.h>

typedef unsigned short bf16_t;
typedef __attribute__((ext_vector_type(8))) short bf16x8;
typedef __attribute__((ext_vector_type(4))) float f32x4;
typedef __attribute__((ext_vector_type(2))) float f32x2;
#define LAS3 __attribute__((address_space(3)))

#define T_TOK 16384
#define SEQ 8192
#define DM 1024
#define IN_COLS 3360
#define PLD 3456
#define C_Q 0
#define C_KV 512
#define C_GATE 1280
#define C_GQKV 1304
#define C_Z 2840
#define C_A 3352
#define C_B 3356

#define OFF_WINT   0ull
#define OFF_WOUTT  (OFF_WINT  + 3456ull*1024*2)
#define OFF_WQT    (OFF_WOUTT + 1024ull*1024*2)
#define OFF_CW1T   (OFF_WQT   + 2048ull*1024*2)
#define OFF_CBIAS  (OFF_CW1T  + 2ull*256*2048*2)
#define OFF_HBF    (OFF_CBIAS + 4096ull)
#define OFF_PROJ   (OFF_HBF   + 16384ull*1024*2)
#define OFF_KSN    (OFF_PROJ  + (16384ull+32)*PLD*2)
#define OFF_KWN    (OFF_KSN   + 4ull*8192*64*2)
#define OFF_KC     (OFF_KWN   + 4ull*8192*64*2)
#define OFF_VC     (OFF_KC    + 4ull*512*64*2)
#define OFF_HID    (OFF_VC    + 4ull*512*64*2)
#define OFF_GU     (OFF_HID   + 8ull*512*256*2)
#define GSKEW      4352ull
#define OFF_GW     (OFF_GU    + 1024ull*64*128*2 + GSKEW)
#define OFF_GQD    (OFF_GW    + 1024ull*64*128*2 + GSKEW)
#define OFF_GKD    (OFF_GQD   + 1024ull*64*128*2 + GSKEW)
#define OFF_GIN    (OFF_GKD   + 1024ull*64*128*2 + GSKEW)
#define OFF_GL     (OFF_GIN   + 1024ull*64*64*2 + GSKEW)
#define OFF_ROPE   (OFF_GL    + 4096ull)
#define OFF_CW2T   (OFF_ROPE  + 8192ull*32*8)
#define OFF_SU     (OFF_CW2T  + 2ull*64*256*2)
#define OFF_SV     (OFF_SU    + 65536ull)
#define OFF_SSQ    (OFF_SV    + 65536ull)
#define OFF_VSN    (OFF_SSQ   + 16384ull*16*4)
#define OFF_VWN    (OFF_VSN   + 4ull*8192*64*2)
#define OFF_END    (OFF_VWN   + 4ull*8192*64*2)
#define OFF_MIX    OFF_HBF
#define OFF_QRY    OFF_PROJ
#define OFF_H2     (OFF_PROJ + 16384ull*2048*2)
#define OFF_EIDX   OFF_KSN
#define OFF_PGATE  OFF_GIN
#define OFF_UQ     OFF_GU
#define OFF_VQ     (OFF_GU + 16384ull*1024)

__device__ __forceinline__ bf16_t f2bf(float f) {
    unsigned u = __float_as_uint(f);
    u += 0x7fffu + ((u >> 16) & 1u);
    return (bf16_t)(u >> 16);
}
__device__ __forceinline__ int opaque_tid() { int t = threadIdx.x; asm volatile("" : "+v"(t)); return t; }
__device__ __forceinline__ float bf2f(bf16_t h) { return __uint_as_float(((unsigned)h) << 16); }
typedef __bf16 bf16x2_t2 __attribute__((ext_vector_type(2)));
__device__ __forceinline__ unsigned pk2(float a, float b) { bf16x2_t2 v; v[0] = (__bf16)a; v[1] = (__bf16)b; return __builtin_bit_cast(unsigned, v); }
__device__ __forceinline__ float gelu_tanh(float x) {
    const float u2 = 1.5957691216057308f * (x + 0.044715f * x * x * x);
    return x * __builtin_amdgcn_rcpf(1.f + __expf(-u2));
}
__device__ __forceinline__ float sigmoidf_(float x) { return __builtin_amdgcn_rcpf(1.f + __expf(-x)); }

template <int CTRL> __device__ __forceinline__ float dppf(float x) { return __builtin_bit_cast(float, __builtin_amdgcn_update_dpp(0, __builtin_bit_cast(int, x), CTRL, 0xf, 0xf, true)); }
template <int CTRL> __device__ __forceinline__ unsigned dppu(unsigned x) { return (unsigned)__builtin_amdgcn_update_dpp(0, (int)x, CTRL, 0xf, 0xf, true); }
__device__ __forceinline__ float allmax16(float x) {
    x = fmaxf(x, dppf<0xB1>(x)); x = fmaxf(x, dppf<0x4E>(x)); x = fmaxf(x, dppf<0x141>(x)); x = fmaxf(x, dppf<0x140>(x)); return x;
}
__device__ __forceinline__ unsigned allmaxu16(unsigned x) {
    x = max(x, dppu<0xB1>(x)); x = max(x, dppu<0x4E>(x)); x = max(x, dppu<0x141>(x)); x = max(x, dppu<0x140>(x)); return x;
}
__device__ __forceinline__ float allsum16(float x) {
    x += dppf<0xB1>(x); x += dppf<0x4E>(x); x += dppf<0x141>(x); x += dppf<0x140>(x); return x;
}
__device__ __forceinline__ float wave_sum(float v) {
    v = allsum16(v);
    { const auto r = __builtin_amdgcn_permlane16_swap(__float_as_uint(v), __float_as_uint(v), false, false); v = __uint_as_float(r[0]) + __uint_as_float(r[1]); }
    { const auto r = __builtin_amdgcn_permlane32_swap(__float_as_uint(v), __float_as_uint(v), false, false); v = __uint_as_float(r[0]) + __uint_as_float(r[1]); }
    return v;
}
__device__ __forceinline__ float wave_max(float v) {
    v = allmax16(v);
    { const auto r = __builtin_amdgcn_permlane16_swap(__float_as_uint(v), __float_as_uint(v), false, false); v = fmaxf(__uint_as_float(r[0]), __uint_as_float(r[1])); }
    { const auto r = __builtin_amdgcn_permlane32_swap(__float_as_uint(v), __float_as_uint(v), false, false); v = fmaxf(__uint_as_float(r[0]), __uint_as_float(r[1])); }
    return v;
}
__device__ __forceinline__ unsigned xorlane(unsigned x, int J, int lane) {
    if (J == 1) return dppu<0xB1>(x);
    if (J == 2) return dppu<0x4E>(x);
    if (J == 4) return dppu<0x1B>(dppu<0x141>(x));
    if (J == 8) return dppu<0x141>(dppu<0x140>(x));
    if (J == 16) { const auto r = __builtin_amdgcn_permlane16_swap(x, x, false, false); return (lane & 16) ? r[0] : r[1]; }
    const auto r = __builtin_amdgcn_permlane32_swap(x, x, false, false); return (lane & 32) ? r[0] : r[1];
}
__device__ __forceinline__ float wave_sum_dpp(float x) {
    x = allsum16(x);
    return __builtin_bit_cast(float, __builtin_amdgcn_readlane(__builtin_bit_cast(int, x), 0)) + __builtin_bit_cast(float, __builtin_amdgcn_readlane(__builtin_bit_cast(int, x), 16)) +
           __builtin_bit_cast(float, __builtin_amdgcn_readlane(__builtin_bit_cast(int, x), 32)) + __builtin_bit_cast(float, __builtin_amdgcn_readlane(__builtin_bit_cast(int, x), 48));
}
__device__ __forceinline__ void d_transpose_bf16(const float* __restrict__ W, int K, int N, bf16_t* __restrict__ Wt, int bx, int by, char* smem, const float* __restrict__ kscale = nullptr) {
    float* tile = (float*)smem;
    const int n0 = bx * 32, k0 = by * 128;
    const int tx = threadIdx.x & 31, ty = threadIdx.x >> 5;
    const int n = n0 + tx;
    float v[16];
#pragma unroll
    for (int i = 0; i < 16; i++) { const int k = k0 + ty + 8 * i; v[i] = (n < N) ? W[(size_t)k * N + n] : 0.f; }
#pragma unroll
    for (int i = 0; i < 16; i++) { const int kk = ty + 8 * i; tile[kk * 33 + tx] = v[i] * (kscale ? kscale[k0 + kk] : 1.f); }
    __syncthreads();
    {
        const int nn = threadIdx.x >> 3, kc = (threadIdx.x & 7) * 16;
        unsigned pk[8];
#pragma unroll
        for (int j = 0; j < 8; j++) pk[j] = pk2(tile[(kc + 2 * j) * 33 + nn], tile[(kc + 2 * j + 1) * 33 + nn]);
        uint4* dst = (uint4*)(Wt + (size_t)(n0 + nn) * K + k0 + kc);
        dst[0] = make_uint4(pk[0], pk[1], pk[2], pk[3]); dst[1] = make_uint4(pk[4], pk[5], pk[6], pk[7]);
    }
    __syncthreads();
}

__device__ __forceinline__ void d_rmsnorm_bf16(const float* __restrict__ x, const float* __restrict__ g, bf16_t* __restrict__ out, int bid) {
    int row = bid * 4 + (threadIdx.x >> 6);
    int lane = threadIdx.x & 63;
    const float4* xr = (const float4*)(x + (size_t)row * DM);
    float4 v[4];
    float ss = 0.f;
#pragma unroll
    for (int i = 0; i < 4; i++) { v[i] = xr[lane + 64 * i]; ss += v[i].x * v[i].x + v[i].y * v[i].y + v[i].z * v[i].z + v[i].w * v[i].w; }
    ss = wave_sum(ss);
    float r = rsqrtf(ss * (1.f / DM) + 1e-6f);
#pragma unroll
    for (int i = 0; i < 4; i++) {
        float4 gg = ((const float4*)g)[lane + 64 * i];
        ushort4 o;
        o.x = f2bf(v[i].x * r * gg.x); o.y = f2bf(v[i].y * r * gg.y); o.z = f2bf(v[i].z * r * gg.z); o.w = f2bf(v[i].w * r * gg.w);
        ((ushort4*)(out + (size_t)row * DM))[lane + 64 * i] = o;
    }
}

__device__ __forceinline__ void d_cmp_bias(const float* __restrict__ pos, const float* __restrict__ w1, float* __restrict__ bias, int item, char* smem) {
    float* part = (float*)smem;
    const int j = item >> 3, c = (item & 7) * 32 + (threadIdx.x & 31), ksl = threadIdx.x >> 5;
    float s0 = 0.f, s1 = 0.f, s2 = 0.f, s3 = 0.f;
    const float* wp = w1 + ((size_t)j * 2048 + ksl * 256) * 256 + c;
    const float* pp = pos + j * 2048 + ksl * 256;
    for (int k = 0; k < 256; k += 4) {
        s0 += pp[k] * wp[(size_t)k * 256]; s1 += pp[k + 1] * wp[(size_t)(k + 1) * 256];
        s2 += pp[k + 2] * wp[(size_t)(k + 2) * 256]; s3 += pp[k + 3] * wp[(size_t)(k + 3) * 256];
    }
    part[ksl * 32 + (threadIdx.x & 31)] = (s0 + s1) + (s2 + s3);
    __syncthreads();
    if (threadIdx.x < 32) {
        float t = 0.f;
#pragma unroll
        for (int i = 0; i < 8; i++) t += part[i * 32 + threadIdx.x];
        bias[j * 256 + c] = t;
    }
    __syncthreads();
}

#define EPI_PROJ 0
#define EPI_HID 1
#define EPI_OUT 2
#define EPI_QRY 3
struct GemmP {
    const bf16_t* A; long lda; long akts;
    const bf16_t* Bt; long ldb;
    int K; int mtiles; int ntiles;
    long a_inst; long b_inst;
    void* out; const float* aux; const float* aux2; bf16_t* out2; float* ssq;
};

#define GEMM_STAGE 24576
template <int EPI>
__device__ __forceinline__ void d_gemm(const GemmP& p, int bid, char* smem) {
    const int tid = opaque_tid(), lane = tid & 63, wave = tid >> 6;
    const int wm = wave >> 1, wn = wave & 1;
    const int inst = 0;
    const int nwg = p.mtiles * p.ntiles, wgid = (nwg & 7) ? bid : ((bid & 7) * (nwg >> 3) + (bid >> 3));
    const int mt = wgid / p.ntiles, nt = wgid % p.ntiles;
    const int m0 = mt * 256, n0 = nt * 128;
    const bf16_t* A = p.A + (size_t)inst * p.a_inst + (size_t)m0 * p.lda;
    const bf16_t* Bt = p.Bt + (size_t)inst * p.b_inst + (size_t)n0 * p.ldb;
    f32x4 acc[8][4];
#pragma unroll
    for (int i = 0; i < 8; i++)
#pragma unroll
        for (int j = 0; j < 4; j++) acc[i][j] = (f32x4){0.f, 0.f, 0.f, 0.f};
    const int nk = p.K >> 5;
    const int crow = tid >> 2, cslot = tid & 3;
    const int csrc = (cslot ^ (((crow >> 3) & 1) << 1)) * 8;
    const bf16_t* Ap = A + (size_t)crow * p.lda + csrc;
    const bf16_t* Bp = Bt + (size_t)crow * p.ldb + csrc;
    const size_t a64 = (size_t)64 * p.lda, b64 = (size_t)64 * p.ldb;
    char* ldsw = smem + tid * 16;
#define GSTAGE(stg, kt_) { char* _d = ldsw + (stg) * GEMM_STAGE; const size_t _ka = (size_t)((kt_) >> 1) * p.akts + (size_t)(((kt_) & 1) * 32), _kb = (size_t)(kt_) * 32; \
    __builtin_amdgcn_global_load_lds((const unsigned*)(Ap + _ka), (LAS3 unsigned*)(_d), 16, 0, 0); \
    __builtin_amdgcn_global_load_lds((const unsigned*)(Ap + a64 + _ka), (LAS3 unsigned*)(_d + 4096), 16, 0, 0); \
    __builtin_amdgcn_global_load_lds((const unsigned*)(Ap + 2 * a64 + _ka), (LAS3 unsigned*)(_d + 8192), 16, 0, 0); \
    __builtin_amdgcn_global_load_lds((const unsigned*)(Ap + 3 * a64 + _ka), (LAS3 unsigned*)(_d + 12288), 16, 0, 0); \
    __builtin_amdgcn_global_load_lds((const unsigned*)(Bp + _kb), (LAS3 unsigned*)(_d + 16384), 16, 0, 0); \
    __builtin_amdgcn_global_load_lds((const unsigned*)(Bp + b64 + _kb), (LAS3 unsigned*)(_d + 16384 + 4096), 16, 0, 0); }
    const int n16 = lane & 15, kq = lane >> 4;
    if (EPI == EPI_QRY) {
        const float4* q = (const float4*)(p.ssq + (size_t)(m0 + tid) * 16);
        const float4 q0 = q[0], q1 = q[1], q2 = q[2], q3 = q[3];
        const float t = ((q0.x + q0.y) + (q0.z + q0.w)) + ((q1.x + q1.y) + (q1.z + q1.w)) + ((q2.x + q2.y) + (q2.z + q2.w)) + ((q3.x + q3.y) + (q3.z + q3.w));
        ((float*)(smem + 3 * GEMM_STAGE))[tid] = rsqrtf(t * (1.f / DM) + 1e-6f);
    }
    const int rdsw = ((kq ^ (((n16 >> 3) & 1) << 1)) << 4);
    GSTAGE(0, 0)
    if (nk > 1) GSTAGE(1, 1)
    int scur = 0, snext = 2;
    for (int kt = 0; kt < nk; kt++) {
        if (kt + 1 < nk) asm volatile("s_waitcnt vmcnt(6)" ::: "memory");
        else asm volatile("s_waitcnt vmcnt(0)" ::: "memory");
        __builtin_amdgcn_s_barrier();
        if (kt + 2 < nk) GSTAGE(snext, kt + 2)
        const char* Ab = smem + scur * GEMM_STAGE;
        const char* Bb = Ab + 16384;
        bf16x8 bfr[4];
#pragma unroll
        for (int j = 0; j < 4; j++) bfr[j] = *(const bf16x8*)(Bb + (wn * 64 + j * 16 + n16) * 64 + rdsw);
#pragma unroll
        for (int ih = 0; ih < 2; ih++) {
            bf16x8 af[4];
#pragma unroll
            for (int i = 0; i < 4; i++) af[i] = *(const bf16x8*)(Ab + (wm * 128 + (ih * 4 + i) * 16 + n16) * 64 + rdsw);
#pragma unroll
            for (int i = 0; i < 4; i++)
#pragma unroll
                for (int j = 0; j < 4; j++) acc[ih * 4 + i][j] = __builtin_amdgcn_mfma_f32_16x16x32_bf16(bfr[j], af[i], acc[ih * 4 + i][j], 0, 0, 0);
        }
        scur = (scur == 2) ? 0 : scur + 1; snext = (snext == 2) ? 0 : snext + 1;
    }
#undef GSTAGE
    asm volatile("s_waitcnt lgkmcnt(0)" ::: "memory");
    __syncthreads();
    {
        char* slab = smem + wave * 9216;
        const int cbase = n0 + wn * 64;
#pragma unroll
        for (int ip = 0; ip < 2; ip++) {
            const int rbase = m0 + wm * 128 + ip * 64;
            if (EPI == EPI_OUT) {
                float* st = (float*)slab;
#pragma unroll
                for (int hlf = 0; hlf < 2; hlf++) {
#pragma unroll
                    for (int ii = 0; ii < 2; ii++)
#pragma unroll
                        for (int j = 0; j < 4; j++) *(f32x4*)(st + (ii * 16 + n16) * 68 + j * 16 + 4 * kq) = acc[ip * 4 + hlf * 2 + ii][j];
#pragma unroll
                    for (int ps = 0; ps < 8; ps++) {
                        const int rl = ps * 4 + kq, row = rbase + hlf * 32 + rl;
                        const float4 a = *(const float4*)(st + rl * 68 + n16 * 4);
                        const float4 xx = *(const float4*)(p.aux + (size_t)row * DM + cbase + n16 * 4);
                        const float4 o = make_float4(xx.x + a.x, xx.y + a.y, xx.z + a.z, xx.w + a.w);
                        *(float4*)((float*)p.out + (size_t)row * DM + cbase + n16 * 4) = o;
                        *(uint2*)(p.out2 + (size_t)row * DM + cbase + n16 * 4) = make_uint2(pk2(o.x, o.y), pk2(o.z, o.w));
                        const float ss = allsum16(o.x * o.x + o.y * o.y + o.z * o.z + o.w * o.w);
                        if (n16 == 0) p.ssq[(size_t)row * 16 + nt * 2 + wn] = ss;
                    }
                }
            } else {
                bf16_t* st = (bf16_t*)slab;
#pragma unroll
                for (int i = 0; i < 4; i++) {
                    float rs = 1.f;
                    if (EPI == EPI_QRY) rs = ((const float*)(smem + 3 * GEMM_STAGE))[wm * 128 + ip * 64 + i * 16 + n16];
#pragma unroll
                    for (int j = 0; j < 4; j++) {
                        float v0 = acc[ip * 4 + i][j][0], v1 = acc[ip * 4 + i][j][1], v2 = acc[ip * 4 + i][j][2], v3 = acc[ip * 4 + i][j][3];
                        if (EPI == EPI_HID) {
                            const float4 bb = *(const float4*)(p.aux + (inst >> 2) * 256 + cbase + 16 * j + 4 * kq);
                            v0 = gelu_tanh(v0 + bb.x); v1 = gelu_tanh(v1 + bb.y); v2 = gelu_tanh(v2 + bb.z); v3 = gelu_tanh(v3 + bb.w);
                        }
                        if (EPI == EPI_QRY) { v0 *= rs; v1 *= rs; v2 *= rs; v3 *= rs; }
                        *(uint2*)(st + (i * 16 + n16) * 72 + j * 16 + 4 * kq) = make_uint2(pk2(v0, v1), pk2(v2, v3));
                    }
                }
                const int ld = (EPI == EPI_PROJ) ? PLD : (EPI == EPI_HID ? 256 : 2048);
#pragma unroll
                for (int ps = 0; ps < 8; ps++) {
                    const int rl = ps * 8 + (lane >> 3), ch = lane & 7;
                    const uint4 v = *(const uint4*)(st + rl * 72 + ch * 8);
                    *(uint4*)((bf16_t*)p.out + (size_t)(rbase + rl) * ld + cbase + ch * 8) = v;
                }
            }
        }
        __syncthreads();
    }
}

__device__ __forceinline__ void d_knorm_rope(const bf16_t* __restrict__ proj, const float* __restrict__ kgain, bf16_t* __restrict__ ksn, bf16_t* __restrict__ kwn, bf16_t* __restrict__ vsn, bf16_t* __restrict__ vwn, const float2* __restrict__ rope, int item) {
    const int vec = item * 64 + (threadIdx.x >> 2), c = threadIdx.x & 3;
    const int which = vec >> 15;
    const int rem = vec & 32767;
    const int b = rem >> 14, g = (rem >> 13) & 1, s = rem & 8191;
    const bf16_t* src = proj + (size_t)(b * SEQ + s) * PLD + C_KV + 128 * (which ? 4 : 2) + 64 * g;
    const uint4 ua = *(const uint4*)(src + 8 * c), ub = *(const uint4*)(src + 32 + 8 * c);
    const uint4 va = *(const uint4*)(src + 128 + 16 * c), vb = *(const uint4*)(src + 128 + 16 * c + 8);
    const float4* rp = (const float4*)(rope + (size_t)s * 32 + 8 * c);
    const float4 r0 = rp[0], r1 = rp[1], r2 = rp[2], r3 = rp[3];
    const float* gn = kgain + (which ? 2 : 1) * 64 + 8 * c;
    const float4 ga0 = *(const float4*)gn, ga1 = *(const float4*)(gn + 4), gb0 = *(const float4*)(gn + 32), gb1 = *(const float4*)(gn + 36);
    const unsigned wa[4] = {ua.x, ua.y, ua.z, ua.w}, wb[4] = {ub.x, ub.y, ub.z, ub.w};
    float x1[8], x2[8];
    float ss = 0.f;
#pragma unroll
    for (int e = 0; e < 4; e++) {
        x1[2 * e] = __uint_as_float(wa[e] << 16); x1[2 * e + 1] = __uint_as_float(wa[e] & 0xffff0000u);
        x2[2 * e] = __uint_as_float(wb[e] << 16); x2[2 * e + 1] = __uint_as_float(wb[e] & 0xffff0000u);
        ss += x1[2 * e] * x1[2 * e] + x1[2 * e + 1] * x1[2 * e + 1] + x2[2 * e] * x2[2 * e] + x2[2 * e + 1] * x2[2 * e + 1];
    }
    ss += dppf<0xB1>(ss); ss += dppf<0x4E>(ss);
    const float r = rsqrtf(ss * (1.f / 64.f) + 1e-6f);
    const float g1[8] = {ga0.x, ga0.y, ga0.z, ga0.w, ga1.x, ga1.y, ga1.z, ga1.w}, g2[8] = {gb0.x, gb0.y, gb0.z, gb0.w, gb1.x, gb1.y, gb1.z, gb1.w};
    const float cs[8] = {r0.x, r0.z, r1.x, r1.z, r2.x, r2.z, r3.x, r3.z}, sn[8] = {r0.y, r0.w, r1.y, r1.w, r2.y, r2.w, r3.y, r3.w};
    float o1[8], o2[8];
#pragma unroll
    for (int e = 0; e < 8; e++) {
        const float y1 = x1[e] * r * g1[e], y2 = x2[e] * r * g2[e];
        o1[e] = y1 * cs[e] - y2 * sn[e]; o2[e] = y2 * cs[e] + y1 * sn[e];
    }
    bf16_t* dst = (which ? kwn : ksn) + ((size_t)(b * 2 + g) * SEQ + s) * 64;
    *(uint4*)(dst + 8 * c) = make_uint4(pk2(o1[0], o1[1]), pk2(o1[2], o1[3]), pk2(o1[4], o1[5]), pk2(o1[6], o1[7]));
    *(uint4*)(dst + 32 + 8 * c) = make_uint4(pk2(o2[0], o2[1]), pk2(o2[2], o2[3]), pk2(o2[4], o2[5]), pk2(o2[6], o2[7]));
    bf16_t* vd = (which ? vwn : vsn) + ((size_t)(b * 2 + g) * SEQ + s) * 64 + 16 * c;
    *(uint4*)vd = va; *(uint4*)(vd + 8) = vb;
}

__device__ __forceinline__ void d_cmp2_mfma(const bf16_t* __restrict__ hid, const bf16_t* __restrict__ cw2t, const float* __restrict__ kgain, const float2* __restrict__ rope,
                                            bf16_t* __restrict__ kc, bf16_t* __restrict__ vc, int witem, int lane) {
    const int n16 = lane & 15, kq = lane >> 4;
    const int rowbase = 16 * witem, inst = rowbase >> 9, n0 = rowbase & 511, j = inst >> 2, bg = inst & 3;
    f32x4 acc[4];
#pragma unroll
    for (int nt = 0; nt < 4; nt++) acc[nt] = (f32x4){0.f, 0.f, 0.f, 0.f};
    const bf16_t* ap = hid + (size_t)(rowbase + n16) * 256 + 8 * kq;
    const bf16_t* bp = cw2t + (size_t)j * 64 * 256 + n16 * 256 + 8 * kq;
#pragma unroll
    for (int ks = 0; ks < 8; ks++) {
        const bf16x8 a = *(const bf16x8*)(ap + 32 * ks);
#pragma unroll
        for (int nt = 0; nt < 4; nt++) {
            const bf16x8 bb = *(const bf16x8*)(bp + (size_t)(16 * nt) * 256 + 32 * ks);
            acc[nt] = __builtin_amdgcn_mfma_f32_16x16x32_bf16(a, bb, acc[nt], 0, 0, 0);
        }
    }
#pragma unroll
    for (int r = 0; r < 4; r++) {
        const int n = n0 + 4 * kq + r;
        if (j == 0) {
            float ss = acc[0][r] * acc[0][r] + acc[1][r] * acc[1][r] + acc[2][r] * acc[2][r] + acc[3][r] * acc[3][r];
            ss = allsum16(ss);
            const float ri = rsqrtf(ss * (1.f / 64.f) + 1e-6f);
#pragma unroll
            for (int nt = 0; nt < 2; nt++) {
                const int i = 16 * nt + n16;
                const float y1 = acc[nt][r] * ri * kgain[i], y2 = acc[nt + 2][r] * ri * kgain[i + 32];
                const float2 cs = rope[(size_t)((n < 511 ? n : 510) * 16 + 31) * 32 + i];
                if (n < 511) {
                    kc[((size_t)bg * 512 + n) * 64 + i] = f2bf(y1 * cs.x - y2 * cs.y);
                    kc[((size_t)bg * 512 + n) * 64 + i + 32] = f2bf(y2 * cs.x + y1 * cs.y);
                }
            }
        } else if (n < 511) {
#pragma unroll
            for (int nt = 0; nt < 4; nt++) vc[((size_t)bg * 512 + n) * 64 + 16 * nt + n16] = f2bf(acc[nt][r]);
        }
    }
}

typedef float f32x16 __attribute__((ext_vector_type(16)));
typedef short s16x4 __attribute__((ext_vector_type(4)));
#define MFMA32(a, b, c) __builtin_amdgcn_mfma_f32_32x32x16_bf16((a), (b), (c), 0, 0, 0)
#define NKS 72
#define NSA_K_OFF 0
#define NSA_V_OFF (2 * 64 * NKS * 2)
#define NSA_IMP_OFF (NSA_V_OFF + 2 * 64 * NKS * 2)
#define NSA_SEL_OFF (NSA_IMP_OFF + 4 * 8192)
#define NSA_LDS (NSA_SEL_OFF + 32 * 4 * 4)
#define NEGBIG (-1e30f)
__device__ __forceinline__ bf16x8 pack8(float a0, float a1, float a2, float a3, float a4, float a5, float a6, float a7) {
    uint4 u = make_uint4(pk2(a0, a1), pk2(a2, a3), pk2(a4, a5), pk2(a6, a7));
    return __builtin_bit_cast(bf16x8, u);
}
__device__ __forceinline__ unsigned pk4_fp8(float a, float b, float c, float d) {
    int w = 0;
    w = __builtin_amdgcn_cvt_pk_fp8_f32(a, b, w, false);
    w = __builtin_amdgcn_cvt_pk_fp8_f32(c, d, w, true);
    return (unsigned)w;
}
__device__ __forceinline__ bf16x8 fp8x8_bf16(unsigned a, unsigned b) {
    const f32x2 p0 = __builtin_amdgcn_cvt_pk_f32_fp8((int)a, false), p1 = __builtin_amdgcn_cvt_pk_f32_fp8((int)a, true);
    const f32x2 p2 = __builtin_amdgcn_cvt_pk_f32_fp8((int)b, false), p3 = __builtin_amdgcn_cvt_pk_f32_fp8((int)b, true);
    return pack8(p0[0], p0[1], p1[0], p1[1], p2[0], p2[1], p3[0], p3[1]);
}
#define GW_SCALE 32.f
#define GQ_SCALE 2048.f
#define GK_SCALE 128.f
typedef unsigned u32x4 __attribute__((ext_vector_type(4)));
struct NsaStage { u32x4 k0, k1, v0, v1; };
struct NsaCtx {
    bool noload;
    const bf16_t* Kbase; long kstride;
    const bf16_t* Vbase; long vstride;
    bf16_t* Kb; bf16_t* Vb;
    float* imp_s; unsigned* sel_s;
    bf16x8 qf[4];
    f32x16 O0, O1;
    float m, l, invl, carry;
    int t, tokl, hp, hh, c, lane;
};
__device__ __forceinline__ void nsa_stage_load(const NsaCtx& X, NsaStage& st, int j) {
    const int r0 = threadIdx.x >> 3, c8 = (threadIdx.x & 7) * 8;
    if (X.noload) { st.k0 = (u32x4){0u,0u,0u,0u}; st.k1 = st.k0; st.v0 = st.k0; st.v1 = st.k0; return; }
    const bf16_t* kp = X.Kbase + (size_t)(64 * j + r0) * X.kstride + c8;
    const bf16_t* vp = X.Vbase + (size_t)(64 * j + r0) * X.vstride + c8;
    st.k0 = *(const u32x4*)kp; st.k1 = *(const u32x4*)(kp + 32 * X.kstride);
    st.v0 = *(const u32x4*)vp; st.v1 = *(const u32x4*)(vp + 32 * X.vstride);
}
__device__ __forceinline__ void nsa_stage_store(const NsaCtx& X, const NsaStage& st, int buf) {
    const int r0 = threadIdx.x >> 3, c8 = (threadIdx.x & 7) * 8;
    bf16_t* kb = X.Kb + buf * 64 * NKS + r0 * NKS + c8;
    bf16_t* vb = X.Vb + buf * 64 * NKS + r0 * NKS + c8;
    *(u32x4*)kb = st.k0; *(u32x4*)(kb + 32 * NKS) = st.k1;
    *(u32x4*)vb = st.v0; *(u32x4*)(vb + 32 * NKS) = st.v1;
}
__device__ __forceinline__ float smax16(const f32x16& S) {
    const float inf = 3.0e38f;
    const float a0 = __builtin_amdgcn_fmed3f(S[0], S[1], inf), a1 = __builtin_amdgcn_fmed3f(S[2], S[3], inf), a2 = __builtin_amdgcn_fmed3f(S[4], S[5], inf), a3 = __builtin_amdgcn_fmed3f(S[6], S[7], inf);
    const float a4 = __builtin_amdgcn_fmed3f(S[8], S[9], inf), a5 = __builtin_amdgcn_fmed3f(S[10], S[11], inf), a6 = __builtin_amdgcn_fmed3f(S[12], S[13], inf), a7 = __builtin_amdgcn_fmed3f(S[14], S[15], inf);
    return fmaxf(fmaxf(fmaxf(a0, a1), fmaxf(a2, a3)), fmaxf(fmaxf(a4, a5), fmaxf(a6, a7)));
}
__device__ __forceinline__ float xor32_max(float x) {
    const auto r = __builtin_amdgcn_permlane32_swap(__float_as_uint(x), __float_as_uint(x), false, false);
    return fmaxf(__uint_as_float(r[0]), __uint_as_float(r[1]));
}
__device__ __forceinline__ float xor32_sum(float x) {
    const auto r = __builtin_amdgcn_permlane32_swap(__float_as_uint(x), __float_as_uint(x), false, false);
    return __uint_as_float(r[0]) + __uint_as_float(r[1]);
}
template <int MODE>
__device__ __forceinline__ void nsa_tile(NsaCtx& X, int j, int kt, int buf, unsigned long long mlo, unsigned long long mhi, bool fast) {
    const bf16_t* Kt = X.Kb + buf * 64 * NKS + (32 * kt) * NKS;
    const bf16_t* Vt = X.Vb + buf * 64 * NKS + (32 * kt) * NKS;
    f32x16 S;
#pragma unroll
    for (int i = 0; i < 16; i++) S[i] = 0.f;
#pragma unroll
    for (int s = 0; s < 4; s++) {
        bf16x8 ka = *(const bf16x8*)(Kt + X.c * NKS + 16 * s + 8 * X.hh);
        S = MFMA32(ka, X.qf[s], S);
    }
    const int kbase = 64 * j + 32 * kt;
    int lo = 0, hi;
    bool on = true;
    if (MODE <= 1) hi = ((X.t - 31) >> 4) - kbase;
    else hi = X.t - kbase;
    if (MODE == 3) lo = X.t - 511 - kbase;
    if (MODE == 2) {
        const unsigned long long wsel = (j < 64) ? mlo : mhi;
        on = (wsel >> (j & 63)) & 1ull;
    }
    lo -= 4 * X.hh; hi -= 4 * X.hh;
    if (!on) hi = -1000;
    float P[16];
    if (MODE == 1) {
        if (!fast) {
#pragma unroll
            for (int i = 0; i < 16; i++) { const int cr = (i & 3) + 8 * (i >> 2); S[i] = (cr <= hi) ? S[i] : -__builtin_inff(); }
        }
#pragma unroll
        for (int i = 0; i < 16; i++) P[i] = __builtin_amdgcn_exp2f(S[i] - X.m) * X.invl;
        float mainv[4], nxt[4];
#pragma unroll
        for (int q = 0; q < 4; q++) { mainv[q] = 2.f * (P[4 * q] + P[4 * q + 1] + P[4 * q + 2]) + P[4 * q + 3]; nxt[q] = P[4 * q + 3]; }
#pragma unroll
        for (int q = 0; q < 4; q++) {
            mainv[q] += dppf<0xB1>(mainv[q]); mainv[q] += dppf<0x4E>(mainv[q]);
            nxt[q] += dppf<0xB1>(nxt[q]); nxt[q] += dppf<0x4E>(nxt[q]);
        }
        float recv[4];
#pragma unroll
        for (int q = 0; q < 4; q++) recv[q] = __uint_as_float(xorlane(__float_as_uint(nxt[q]), 32, X.lane));
        const int jsel0 = 16 * j + 8 * kt + X.hh;
#pragma unroll
        for (int q = 0; q < 4; q++) {
            const float tot = mainv[q] + (X.hh ? recv[q] : (q > 0 ? recv[q > 0 ? q - 1 : 0] : X.carry));
            if (X.hp == 0) X.imp_s[(X.tokl & 7) * 128 + jsel0 + 2 * q] = tot;
        }
        X.carry = recv[3];
    } else if (MODE == 0) {
        if (!fast) {
#pragma unroll
            for (int i = 0; i < 16; i++) { const int cr = (i & 3) + 8 * (i >> 2); S[i] = (cr <= hi) ? S[i] : -__builtin_inff(); }
        }
        float tmax = smax16(S);
        tmax = xor32_max(tmax);
        float ls = 0.f;
        const float mnew = fmaxf(fmaxf(X.m, tmax), NEGBIG);
        const float alpha = __builtin_amdgcn_exp2f(X.m - mnew);
        X.m = mnew;
#pragma unroll
        for (int i = 0; i < 16; i++) { P[i] = __builtin_amdgcn_exp2f(S[i] - mnew); ls += P[i]; }
        X.l = X.l * alpha + ls;
    } else {
        if (!fast) {
#pragma unroll
            for (int i = 0; i < 16; i++) {
                const int cr = (i & 3) + 8 * (i >> 2);
                const bool vis = (cr <= hi) && (cr >= lo);
                S[i] = vis ? S[i] : -__builtin_inff();
            }
        }
        float tmax = smax16(S);
        if (MODE == 2 && !on) tmax = NEGBIG;
        tmax = xor32_max(tmax);
        float ls = 0.f;
        const bool upd = tmax > X.m + 8.f;
        const float mnew = upd ? tmax : X.m;
        if (__builtin_amdgcn_ballot_w64(upd) != 0ull) {
            const float alpha = __builtin_amdgcn_exp2f(X.m - mnew);
            X.l *= alpha;
#pragma unroll
            for (int i = 0; i < 16; i++) { X.O0[i] *= alpha; X.O1[i] *= alpha; }
        }
        X.m = mnew;
        const float msub = (MODE == 2 && !on) ? 1e30f : mnew;
#pragma unroll
        for (int i = 0; i < 16; i++) { P[i] = __builtin_amdgcn_exp2f(S[i] - msub); ls += P[i]; }
        X.l += ls;
    }
    if (MODE >= 1) {
        bf16x8 pb0 = pack8(P[0], P[1], P[2], P[3], P[4], P[5], P[6], P[7]);
        bf16x8 pb1 = pack8(P[8], P[9], P[10], P[11], P[12], P[13], P[14], P[15]);
        const int l15 = X.lane & 15;
        const bf16_t* vrow = Vt + (4 * X.hh + (l15 >> 2)) * NKS + 16 * ((X.lane >> 4) & 1) + 4 * (l15 & 3);
#pragma unroll
        for (int s2 = 0; s2 < 2; s2++) {
#pragma unroll
            for (int dt = 0; dt < 2; dt++) {
                s16x4 lo4 = __builtin_amdgcn_ds_read_tr16_b64_v4i16((LAS3 s16x4*)(vrow + (16 * s2) * NKS + 32 * dt));
                s16x4 hi4 = __builtin_amdgcn_ds_read_tr16_b64_v4i16((LAS3 s16x4*)(vrow + (16 * s2 + 8) * NKS + 32 * dt));
                bf16x8 va = __builtin_shufflevector(lo4, hi4, 0, 1, 2, 3, 4, 5, 6, 7);
                if (dt == 0) X.O0 = MFMA32(va, s2 ? pb1 : pb0, X.O0); else X.O1 = MFMA32(va, s2 ? pb1 : pb0, X.O1);
            }
        }
    }
}
template <int MODE>
__device__ __forceinline__ void nsa_tile2(NsaCtx& X, int j, int buf, unsigned long long mlo, unsigned long long mhi, bool fast0, bool fast1) {
    const bf16_t* Kt = X.Kb + buf * 64 * NKS;
    const bf16_t* Vt = X.Vb + buf * 64 * NKS;
    f32x16 S0, S1;
#pragma unroll
    for (int i = 0; i < 16; i++) { S0[i] = 0.f; S1[i] = 0.f; }
#pragma unroll
    for (int s = 0; s < 4; s++) {
        const bf16x8 ka0 = *(const bf16x8*)(Kt + X.c * NKS + 16 * s + 8 * X.hh);
        const bf16x8 ka1 = *(const bf16x8*)(Kt + (32 + X.c) * NKS + 16 * s + 8 * X.hh);
        S0 = MFMA32(ka0, X.qf[s], S0);
        S1 = MFMA32(ka1, X.qf[s], S1);
    }
    const int kbase = 64 * j;
    int lo = 0, hi = X.t - kbase;
    bool on = true;
    if (MODE == 3) lo = X.t - 511 - kbase;
    if (MODE == 2) {
        const unsigned long long wsel = (j < 64) ? mlo : mhi;
        on = (wsel >> (j & 63)) & 1ull;
    }
    lo -= 4 * X.hh; hi -= 4 * X.hh;
    if (!on) hi = -1000;
    if (!fast0) {
#pragma unroll
        for (int i = 0; i < 16; i++) { const int cr = (i & 3) + 8 * (i >> 2); S0[i] = ((cr <= hi) && (cr >= lo)) ? S0[i] : -__builtin_inff(); }
    }
    if (!fast1) {
#pragma unroll
        for (int i = 0; i < 16; i++) { const int cr = 32 + (i & 3) + 8 * (i >> 2); S1[i] = ((cr <= hi) && (cr >= lo)) ? S1[i] : -__builtin_inff(); }
    }
    float tmax = fmaxf(smax16(S0), smax16(S1));
    if (MODE == 2 && !on) tmax = NEGBIG;
    tmax = xor32_max(tmax);
    const bool upd = tmax > X.m + 8.f;
    const float mnew = upd ? tmax : X.m;
    if (__builtin_amdgcn_ballot_w64(upd) != 0ull) {
        const float alpha = __builtin_amdgcn_exp2f(X.m - mnew);
        X.l *= alpha;
#pragma unroll
        for (int i = 0; i < 16; i++) { X.O0[i] *= alpha; X.O1[i] *= alpha; }
    }
    X.m = mnew;
    const float msub = (MODE == 2 && !on) ? 1e30f : mnew;
    const int l15 = X.lane & 15;
    float ls = 0.f;
#pragma unroll
    for (int t2 = 0; t2 < 2; t2++) {
        float P[16];
#pragma unroll
        for (int i = 0; i < 16; i++) { P[i] = __builtin_amdgcn_exp2f((t2 ? S1[i] : S0[i]) - msub); ls += P[i]; }
        const bf16x8 pb0 = pack8(P[0], P[1], P[2], P[3], P[4], P[5], P[6], P[7]);
        const bf16x8 pb1 = pack8(P[8], P[9], P[10], P[11], P[12], P[13], P[14], P[15]);
        const bf16_t* vrow = Vt + (32 * t2 + 4 * X.hh + (l15 >> 2)) * NKS + 16 * ((X.lane >> 4) & 1) + 4 * (l15 & 3);
#pragma unroll
        for (int s2 = 0; s2 < 2; s2++) {
#pragma unroll
            for (int dt = 0; dt < 2; dt++) {
                s16x4 lo4 = __builtin_amdgcn_ds_read_tr16_b64_v4i16((LAS3 s16x4*)(vrow + (16 * s2) * NKS + 32 * dt));
                s16x4 hi4 = __builtin_amdgcn_ds_read_tr16_b64_v4i16((LAS3 s16x4*)(vrow + (16 * s2 + 8) * NKS + 32 * dt));
                bf16x8 va = __builtin_shufflevector(lo4, hi4, 0, 1, 2, 3, 4, 5, 6, 7);
                if (dt == 0) X.O0 = MFMA32(va, s2 ? pb1 : pb0, X.O0); else X.O1 = MFMA32(va, s2 ? pb1 : pb0, X.O1);
            }
        }
    }
    X.l += ls;
}
template <int MODE>
__device__ __forceinline__ void nsa_block(NsaCtx& X, int j, unsigned long long mlo, unsigned long long mhi, unsigned long long ulo, unsigned long long uhi, int cur, int tw0) {
    bool need = true;
    if (MODE == 2) {
        const unsigned long long wsel = (j < 64) ? ulo : uhi;
        need = (wsel >> (j & 63)) & 1ull;
    }
    if (need && MODE >= 2) {
        bool f0 = false, f1 = false;
        if (MODE == 2) { f0 = j < cur; f1 = f0; }
        if (MODE == 3) { const int kb = 64 * j; f0 = (kb + 31 <= tw0) && (kb >= tw0 + 7 - 511); f1 = (kb + 63 <= tw0) && (kb + 32 >= tw0 + 7 - 511); }
        nsa_tile2<MODE>(X, j, j & 1, mlo, mhi, f0, f1);
    } else if (need) {
#pragma unroll
        for (int kt = 0; kt < 2; kt++) {
            bool fast = false;
            if (MODE <= 1) fast = (64 * j + 32 * kt + 31) <= ((tw0 - 31) >> 4);
            if (MODE == 2) fast = j < cur;
            if (MODE == 3) { const int kb = 64 * j + 32 * kt; fast = (kb + 31 <= tw0) && (kb >= tw0 + 7 - 511); }
            nsa_tile<MODE>(X, j, kt, j & 1, mlo, mhi, fast);
        }
    }
}
template <int MODE>
__device__ __forceinline__ void nsa_branch(NsaCtx& X, int jlo, int jhi, unsigned long long mlo, unsigned long long mhi, unsigned long long ulo, unsigned long long uhi, int cur, int tw0) {
    NsaStage sa;
    nsa_stage_load(X, sa, jlo);
    __syncthreads();
    nsa_stage_store(X, sa, jlo & 1);
    __syncthreads();
#pragma unroll 1
    for (int j = jlo; j <= jhi; j++) {
        if (j < jhi) nsa_stage_load(X, sa, j + 1);
        nsa_block<MODE>(X, j, mlo, mhi, ulo, uhi, cur, tw0);
        if (j < jhi) nsa_stage_store(X, sa, (j + 1) & 1);
        __syncthreads();
    }
}
template <int OP>
__device__ __forceinline__ void nsa_facc(NsaCtx& X, float scale) {
    f32x4* F = (f32x4*)X.imp_s;
#pragma unroll
    for (int q = 0; q < 8; q++) {
        f32x4 v;
#pragma unroll
        for (int e = 0; e < 4; e++) v[e] = ((q < 4) ? X.O0[4 * q + e] : X.O1[4 * (q - 4) + e]) * scale;
        if (OP >= 1) v += F[q * 64 + X.lane];
        if (OP <= 1) F[q * 64 + X.lane] = v;
        else {
#pragma unroll
            for (int e = 0; e < 4; e++) { if (q < 4) X.O0[4 * q + e] = v[e]; else X.O1[4 * (q - 4) + e] = v[e]; }
        }
    }
}
__device__ __forceinline__ void d_nsa_mfma(const bf16_t* __restrict__ proj, const float* __restrict__ qgain, const float2* __restrict__ rope,
                                           const bf16_t* __restrict__ ksn, const bf16_t* __restrict__ kwn,
                                           const bf16_t* __restrict__ kc, const bf16_t* __restrict__ vc, const bf16_t* __restrict__ vsn, const bf16_t* __restrict__ vwn,
                                           bf16_t* __restrict__ mixo, int mix_ld, int item, char* smem, bool noload = false) {
    NsaCtx X;
    X.noload = noload;
    const int tid = opaque_tid(), lane = tid & 63, w = tid >> 6;
    const int bg = item & 3, tile = 255 - (item >> 2);
    const int b = bg >> 1, g = bg & 1, t0 = tile * 32;
    X.lane = lane; X.c = lane & 31; X.hh = lane >> 5; X.hp = X.c & 3; X.tokl = 8 * w + (X.c >> 2); X.t = t0 + X.tokl;
    X.Kb = (bf16_t*)(smem + NSA_K_OFF); X.Vb = (bf16_t*)(smem + NSA_V_OFF);
    X.imp_s = (float*)(smem + NSA_IMP_OFF + w * 8192); X.sel_s = (unsigned*)(smem + NSA_SEL_OFF);
    const int head = g * 4 + X.hp;
    const size_t row = (size_t)(b * SEQ + X.t);
    {
        float y[4][8];
        const bf16_t* qsrc = proj + row * PLD + C_Q + head * 64 + 8 * X.hh;
        float ss = 0.f;
#pragma unroll
        for (int s = 0; s < 4; s++) {
            const uint4 u = *(const uint4*)(qsrc + 16 * s);
            const unsigned wv[4] = {u.x, u.y, u.z, u.w};
#pragma unroll
            for (int e = 0; e < 4; e++) { y[s][2 * e] = __uint_as_float(wv[e] << 16); y[s][2 * e + 1] = __uint_as_float(wv[e] & 0xffff0000u); }
#pragma unroll
            for (int e = 0; e < 8; e++) ss += y[s][e] * y[s][e];
        }
        ss = xor32_sum(ss);
        const float r = rsqrtf(ss * (1.f / 64.f) + 1e-6f);
#pragma unroll
        for (int s = 0; s < 4; s++)
#pragma unroll
            for (int e = 0; e < 8; e++) y[s][e] *= r * qgain[16 * s + 8 * X.hh + e];
        const float qs = 0.125f * 1.4426950408889634f;
#pragma unroll
        for (int s = 0; s < 2; s++)
#pragma unroll
            for (int e = 0; e < 8; e++) {
                const float2 cs = rope[(size_t)X.t * 32 + 16 * s + 8 * X.hh + e];
                const float x1 = y[s][e], x2 = y[s + 2][e];
                y[s][e] = (x1 * cs.x - x2 * cs.y) * qs; y[s + 2][e] = (x2 * cs.x + x1 * cs.y) * qs;
            }
#pragma unroll
        for (int s = 0; s < 4; s++) X.qf[s] = pack8(y[s][0], y[s][1], y[s][2], y[s][3], y[s][4], y[s][5], y[s][6], y[s][7]);
    }
    const bf16_t* gp = proj + row * PLD + C_GATE + head * 3;
    const float g0 = sigmoidf_(bf2f(gp[0])), g1 = sigmoidf_(bf2f(gp[1])), g2 = sigmoidf_(bf2f(gp[2]));
    const int cur = t0 >> 6;
    {
        X.Kbase = kc + (size_t)bg * 512 * 64; X.kstride = 64; X.Vbase = vc + (size_t)bg * 512 * 64; X.vstride = 64;
        const int nvmax = (t0 >> 4) + 1, jhi = (nvmax - 1) >> 6;
        X.m = NEGBIG; X.l = 0.f;
        nsa_branch<0>(X, 0, jhi, 0ull, 0ull, 0ull, 0ull, cur, t0 + 8 * w);
        const float lt = xor32_sum(X.l);
        X.invl = (lt > 0.f) ? 1.f / lt : 0.f;
        X.carry = 0.f;
#pragma unroll
        for (int i = 0; i < 16; i++) { X.O0[i] = 0.f; X.O1[i] = 0.f; }
        nsa_branch<1>(X, 0, jhi, 0ull, 0ull, 0ull, 0ull, cur, t0 + 8 * w);
    }
    unsigned long long mlo, mhi, ulo, uhi;
    {
        const int tk2 = lane >> 3, sub = lane & 7;
        unsigned k0 = 1u, k1 = 0u, k2 = 0u, k3 = 0u;
#define SETBIT(jj) { const int _j = (jj); if (_j < 32) k0 |= 1u << _j; else if (_j < 64) k1 |= 1u << (_j - 32); else if (_j < 96) k2 |= 1u << (_j - 64); else k3 |= 1u << (_j - 96); }
        SETBIT(cur);
        if (cur >= 1) SETBIT(cur - 1);
        const int ncand = cur - 2;
        if (ncand > 0) {
            if (ncand <= 13) {
                for (int jj = 1; jj <= cur - 2; jj++) SETBIT(jj);
            } else {
                float sc[16];
#pragma unroll
                for (int i = 0; i < 16; i++) { const int jj = sub + 8 * i; sc[i] = (jj >= 1 && jj <= cur - 2) ? X.imp_s[tk2 * 128 + jj] : -3e38f; }
#pragma unroll 1
                for (int it = 0; it < 13; it++) {
                    float bv = sc[0]; int bi = 0;
#pragma unroll
                    for (int i = 1; i < 16; i++) if (sc[i] > bv) { bv = sc[i]; bi = i; }
                    int bj = sub + 8 * bi;
#pragma unroll
                    for (int o = 1; o < 8; o <<= 1) {
                        const float ov = __uint_as_float(xorlane(__float_as_uint(bv), o, lane)); const int oj = (int)xorlane((unsigned)bj, o, lane);
                        if (ov > bv || (ov == bv && oj < bj)) { bv = ov; bj = oj; }
                    }
                    SETBIT(bj);
#pragma unroll
                    for (int i = 0; i < 16; i++) if (bj == sub + 8 * i) sc[i] = -3e38f;
                }
            }
        }
#undef SETBIT
        if (sub == 0) { unsigned* d = X.sel_s + (8 * w + tk2) * 4; d[0] = k0; d[1] = k1; d[2] = k2; d[3] = k3; }
        __builtin_amdgcn_s_waitcnt(0xc07f);
        const unsigned* sp = X.sel_s + X.tokl * 4;
        const unsigned m0 = sp[0], m1 = sp[1], m2 = sp[2], m3 = sp[3];
        mlo = (unsigned long long)m0 | ((unsigned long long)m1 << 32); mhi = (unsigned long long)m2 | ((unsigned long long)m3 << 32);
        unsigned u0 = m0, u1 = m1, u2 = m2, u3 = m3;
#pragma unroll
        for (int o = 4; o < 32; o <<= 1) { u0 |= xorlane(u0, o, lane); u1 |= xorlane(u1, o, lane); u2 |= xorlane(u2, o, lane); u3 |= xorlane(u3, o, lane); }
        ulo = (unsigned long long)(unsigned)__builtin_amdgcn_readfirstlane(u0) | ((unsigned long long)(unsigned)__builtin_amdgcn_readfirstlane(u1) << 32);
        uhi = (unsigned long long)(unsigned)__builtin_amdgcn_readfirstlane(u2) | ((unsigned long long)(unsigned)__builtin_amdgcn_readfirstlane(u3) << 32);
    }
    nsa_facc<0>(X, g0);
    {
        X.Kbase = ksn + (size_t)bg * SEQ * 64; X.kstride = 64;
        X.Vbase = vsn + (size_t)bg * SEQ * 64; X.vstride = 64;
        X.m = NEGBIG; X.l = 0.f;
#pragma unroll
        for (int i = 0; i < 16; i++) { X.O0[i] = 0.f; X.O1[i] = 0.f; }
        nsa_branch<2>(X, 0, cur, mlo, mhi, ulo, uhi, cur, t0 + 8 * w);
        const float lt = xor32_sum(X.l);
        nsa_facc<1>(X, (lt > 0.f) ? g1 / lt : 0.f);
    }
    {
        X.Kbase = kwn + (size_t)bg * SEQ * 64; X.kstride = 64;
        X.Vbase = vwn + (size_t)bg * SEQ * 64; X.vstride = 64;
        X.m = NEGBIG; X.l = 0.f;
#pragma unroll
        for (int i = 0; i < 16; i++) { X.O0[i] = 0.f; X.O1[i] = 0.f; }
        const int jlo = (t0 >= 511) ? ((t0 - 511) >> 6) : 0;
        nsa_branch<3>(X, jlo, cur, 0ull, 0ull, 0ull, 0ull, cur, t0 + 8 * w);
        const float lt = xor32_sum(X.l);
        nsa_facc<2>(X, (lt > 0.f) ? g2 / lt : 0.f);
    }
    bf16_t* dst = mixo + row * mix_ld + head * 64 + 4 * X.hh;
#pragma unroll
    for (int q4 = 0; q4 < 4; q4++) {
        *(uint2*)(dst + 8 * q4) = make_uint2(pk2(X.O0[4 * q4], X.O0[4 * q4 + 1]), pk2(X.O0[4 * q4 + 2], X.O0[4 * q4 + 3]));
        *(uint2*)(dst + 32 + 8 * q4) = make_uint2(pk2(X.O1[4 * q4], X.O1[4 * q4 + 1]), pk2(X.O1[4 * q4 + 2], X.O1[4 * q4 + 3]));
    }
}

#define KLS 136
#define XSS 264
#define GDN_PREP_LDS (2 * 64 * KLS * 2 + 64 * XSS * 2 + 512 + 7680)
__device__ __forceinline__ unsigned pack2bf(float lo, float hi) { return (unsigned)f2bf(lo) | ((unsigned)f2bf(hi) << 16); }
__device__ __forceinline__ void d_gdn_prep2(const bf16_t* __restrict__ proj, const float* __restrict__ conv_w,
                                            const float* __restrict__ a_log, const float* __restrict__ dt_bias,
                                            bf16_t* __restrict__ guT, bf16_t* __restrict__ gw, bf16_t* __restrict__ gqd,
                                            bf16_t* __restrict__ gkdT, bf16_t* __restrict__ gin, float* __restrict__ gl, int chunk, char* smem) {
    bf16_t* kL = (bf16_t*)smem;
    bf16_t* qL = kL + 64 * KLS;
    float* AmT = (float*)qL;
    bf16_t* xs = qL + 64 * KLS;
    float* gcs = (float*)(xs + 64 * XSS);
    float* bts = gcs + 64;
    float* wL = bts + 64;
    const int tid = opaque_tid(), lane = tid & 63, w = tid >> 6;
    const int n = chunk & 127, h = (chunk >> 7) & 3, b = chunk >> 9;
    const int t0 = n * 64;
    const size_t rbase = (size_t)(b * SEQ + t0);
#pragma unroll
    for (int k6 = 0; k6 < 6; k6++) {
        const int idx = tid + 256 * k6, r = idx >> 7, c = idx & 127;
        wL[r * 160 + (c >> 5) * 40 + (c & 31)] = conv_w[(r & 3) * 1536 + (r >> 2) * 512 + h * 128 + c];
    }
    if (tid < 64) {
        const size_t r = (rbase + tid) * PLD;
        float a = bf2f(proj[r + C_A + h]), bb = bf2f(proj[r + C_B + h]);
        float xx = a + dt_bias[h];
        float sp = (xx > 20.f) ? xx : log1pf(__expf(xx));
        float c = -__expf(a_log[h]) * sp;
#pragma unroll
        for (int o = 1; o < 64; o <<= 1) { float nb = __shfl_up(c, o); if (lane >= o) c += nb; }
        gcs[tid] = c; bts[tid] = sigmoidf_(bb);
    }
    __syncthreads();
    {
        const int i = tid >> 2, cg = tid & 3;
        const int tt0 = t0 + i - 3;
        const bf16_t* xcol = proj + (size_t)(b * SEQ) * PLD + C_GQKV + h * 128 + 32 * cg;
        const float* wrow = wL + 40 * cg;
        float qv[32], kv[32];
        float sq = 0.f, sk = 0.f;
        const float bi = bts[i], ei = __expf(gcs[i]);
        uint4 xa[8], xb[8];
#define GP_LOAD(buf, hf) { _Pragma("unroll") for (int c2 = 0; c2 < 2; c2++) _Pragma("unroll") for (int j = 0; j < 4; j++) { \
            const int tr = tt0 + j; uint4 u = *(const uint4*)(xcol + (size_t)(tr < 0 ? 0 : tr) * PLD + ((hf) >> 1) * 512 + 16 * ((hf) & 1) + 8 * c2); \
            if (tr < 0) u = make_uint4(0u, 0u, 0u, 0u); buf[c2 * 4 + j] = u; } }
#define GP_COMP(buf, hf) { _Pragma("unroll") for (int c2 = 0; c2 < 2; c2++) { \
            const int m = (hf) >> 1, ck = 2 * ((hf) & 1) + c2; float cv[8]; \
            _Pragma("unroll") for (int e = 0; e < 8; e++) cv[e] = 0.f; \
            _Pragma("unroll") for (int j = 0; j < 4; j++) { \
                const uint4 u = buf[c2 * 4 + j]; \
                const float4 w0 = *(const float4*)(wrow + (m * 4 + j) * 160 + 8 * ck), w1 = *(const float4*)(wrow + (m * 4 + j) * 160 + 8 * ck + 4); \
                cv[0] += __uint_as_float(u.x << 16) * w0.x; cv[1] += __uint_as_float(u.x & 0xffff0000u) * w0.y; \
                cv[2] += __uint_as_float(u.y << 16) * w0.z; cv[3] += __uint_as_float(u.y & 0xffff0000u) * w0.w; \
                cv[4] += __uint_as_float(u.z << 16) * w1.x; cv[5] += __uint_as_float(u.z & 0xffff0000u) * w1.y; \
                cv[6] += __uint_as_float(u.w << 16) * w1.z; cv[7] += __uint_as_float(u.w & 0xffff0000u) * w1.w; } \
            _Pragma("unroll") for (int e = 0; e < 8; e++) { \
                const float sv = cv[e] * sigmoidf_(cv[e]); \
                if (m == 0) { qv[8 * ck + e] = sv; sq += sv * sv; } else if (m == 1) { kv[8 * ck + e] = sv; sk += sv * sv; } else cv[e] = sv * bi; } \
            if (m == 2) *(uint4*)(xs + i * XSS + 32 * cg + 8 * ck) = make_uint4(pk2(cv[0], cv[1]), pk2(cv[2], cv[3]), pk2(cv[4], cv[5]), pk2(cv[6], cv[7])); } \
            __builtin_amdgcn_sched_barrier(0); }
        GP_LOAD(xa, 0)
        GP_LOAD(xb, 1) GP_COMP(xa, 0)
        GP_LOAD(xa, 2) GP_COMP(xb, 1)
        GP_LOAD(xb, 3) GP_COMP(xa, 2)
        GP_LOAD(xa, 4) GP_COMP(xb, 3)
        GP_LOAD(xb, 5) GP_COMP(xa, 4)
        GP_COMP(xb, 5)
#undef GP_LOAD
#undef GP_COMP
        sq += dppf<0xB1>(sq); sq += dppf<0x4E>(sq);
        sk += dppf<0xB1>(sk); sk += dppf<0x4E>(sk);
        const float rq = rsqrtf(sq + 1e-6f) * 0.08838834764831845f, rk = rsqrtf(sk + 1e-6f);
        const float rqe = rq * ei, rkw = rk * bi * ei;
        unsigned char* qd = (unsigned char*)gqd + (size_t)chunk * 8192 + i * 128 + 32 * cg;
        const float rq8 = rqe * GQ_SCALE;
        unsigned qw[8];
#pragma unroll
        for (int ck = 0; ck < 4; ck++) {
            const float* q8 = qv + 8 * ck; const float* k8 = kv + 8 * ck;
            *(uint4*)(qL + i * KLS + 32 * cg + 8 * ck) = make_uint4(pk2(q8[0] * rq, q8[1] * rq), pk2(q8[2] * rq, q8[3] * rq), pk2(q8[4] * rq, q8[5] * rq), pk2(q8[6] * rq, q8[7] * rq));
            *(uint4*)(kL + i * KLS + 32 * cg + 8 * ck) = make_uint4(pk2(k8[0] * rk, k8[1] * rk), pk2(k8[2] * rk, k8[3] * rk), pk2(k8[4] * rk, k8[5] * rk), pk2(k8[6] * rk, k8[7] * rk));
            *(uint4*)(xs + i * XSS + 128 + 32 * cg + 8 * ck) = make_uint4(pk2(k8[0] * rkw, k8[1] * rkw), pk2(k8[2] * rkw, k8[3] * rkw), pk2(k8[4] * rkw, k8[5] * rkw), pk2(k8[6] * rkw, k8[7] * rkw));
            qw[2 * ck] = pk4_fp8(q8[0] * rq8, q8[1] * rq8, q8[2] * rq8, q8[3] * rq8); qw[2 * ck + 1] = pk4_fp8(q8[4] * rq8, q8[5] * rq8, q8[6] * rq8, q8[7] * rq8);
        }
        *(uint4*)qd = make_uint4(qw[0], qw[1], qw[2], qw[3]); *(uint4*)(qd + 16) = make_uint4(qw[4], qw[5], qw[6], qw[7]);
    }
    __syncthreads();
    const int n16 = lane & 15, kq = lane >> 4;
    f32x4 aqk[4], akk[4];
#pragma unroll
    for (int tj = 0; tj < 4; tj++) { aqk[tj] = (f32x4){0.f, 0.f, 0.f, 0.f}; akk[tj] = (f32x4){0.f, 0.f, 0.f, 0.f}; }
#pragma unroll
    for (int ks = 0; ks < 4; ks++) {
        bf16x8 qa = *(const bf16x8*)(qL + (16 * w + n16) * KLS + 32 * ks + 8 * kq);
        bf16x8 ka = *(const bf16x8*)(kL + (16 * w + n16) * KLS + 32 * ks + 8 * kq);
#pragma unroll
        for (int tj = 0; tj < 4; tj++) {
            bf16x8 kb = *(const bf16x8*)(kL + (16 * tj + n16) * KLS + 32 * ks + 8 * kq);
            aqk[tj] = __builtin_amdgcn_mfma_f32_16x16x32_bf16(qa, kb, aqk[tj], 0, 0, 0);
            akk[tj] = __builtin_amdgcn_mfma_f32_16x16x32_bf16(ka, kb, akk[tj], 0, 0, 0);
        }
    }
    {
        const float glast = gcs[63];
        const int kidx = tid >> 1, c0 = (tid & 1) * 32;
        unsigned pk[8];
#pragma unroll
        for (int cc = 0; cc < 32; cc += 4) {
            float v4[4];
#pragma unroll
            for (int e = 0; e < 4; e++) v4[e] = bf2f(kL[(c0 + cc + e) * KLS + kidx]) * __expf(glast - gcs[c0 + cc + e]) * GK_SCALE;
            pk[cc >> 2] = pk4_fp8(v4[0], v4[1], v4[2], v4[3]);
        }
        uint4* dst = (uint4*)((unsigned char*)gkdT + (size_t)chunk * 8192 + kidx * 64 + c0);
        dst[0] = make_uint4(pk[0], pk[1], pk[2], pk[3]); dst[1] = make_uint4(pk[4], pk[5], pk[6], pk[7]);
        if (tid == 0) gl[chunk] = __expf(glast);
    }
    __syncthreads();
#pragma unroll
    for (int tj = 0; tj < 4; tj++)
#pragma unroll
        for (int r = 0; r < 4; r++) {
            const int i = 16 * w + 4 * kq + r, j = 16 * tj + n16;
            const float dec = (j <= i) ? __expf(gcs[i] - gcs[j]) : 0.f;
            gin[(size_t)chunk * 4096 + i * 64 + j] = f2bf(aqk[tj][r] * dec);
            AmT[j * 64 + i] = (j < i) ? bts[i] * akk[tj][r] * dec : 0.f;
        }
    __syncthreads();
    {
        const int c = tid;
#pragma unroll 1
        for (int blk = 0; blk < 8; blk++) {
            const int i0 = blk * 8;
            float acc[8];
#pragma unroll
            for (int r = 0; r < 8; r++) acc[r] = bf2f(xs[(i0 + r) * XSS + c]);
            {
                f32x2 p0 = (f32x2){acc[0], acc[1]}, p1 = (f32x2){acc[2], acc[3]}, p2 = (f32x2){acc[4], acc[5]}, p3 = (f32x2){acc[6], acc[7]};
#pragma unroll 1
                for (int jb = 0; jb < blk; jb++) {
#pragma unroll
                    for (int jj = 0; jj < 8; jj++) {
                        const int j = jb * 8 + jj;
                        const float nx = -bf2f(xs[j * XSS + c]);
                        const f32x2 nx2 = (f32x2){nx, nx};
                        const f32x4 a0 = *(const f32x4*)(AmT + j * 64 + i0), a1 = *(const f32x4*)(AmT + j * 64 + i0 + 4);
                        p0 = __builtin_elementwise_fma((f32x2){a0[0], a0[1]}, nx2, p0); p1 = __builtin_elementwise_fma((f32x2){a0[2], a0[3]}, nx2, p1);
                        p2 = __builtin_elementwise_fma((f32x2){a1[0], a1[1]}, nx2, p2); p3 = __builtin_elementwise_fma((f32x2){a1[2], a1[3]}, nx2, p3);
                    }
                }
                acc[0] = p0[0]; acc[1] = p0[1]; acc[2] = p1[0]; acc[3] = p1[1]; acc[4] = p2[0]; acc[5] = p2[1]; acc[6] = p3[0]; acc[7] = p3[1];
            }
#pragma unroll
            for (int r = 1; r < 8; r++)
#pragma unroll
                for (int s2 = 0; s2 < r; s2++) acc[r] -= AmT[(i0 + s2) * 64 + i0 + r] * acc[s2];
#pragma unroll
            for (int r = 0; r < 8; r++) xs[(i0 + r) * XSS + c] = f2bf(acc[r]);
            if (c < 128) {
                *(uint4*)(guT + (size_t)chunk * 8192 + c * 64 + i0) =
                    make_uint4(pack2bf(acc[0], acc[1]), pack2bf(acc[2], acc[3]), pack2bf(acc[4], acc[5]), pack2bf(acc[6], acc[7]));
            }
        }
    }
    __syncthreads();
    {
        const int i = tid >> 2, sg = tid & 3;
        unsigned ww[8];
#pragma unroll
        for (int ck = 0; ck < 4; ck++) {
            const uint4 u = *(const uint4*)(xs + i * XSS + 128 + 32 * sg + 8 * ck);
            ww[2 * ck] = pk4_fp8(__uint_as_float(u.x << 16) * GW_SCALE, __uint_as_float(u.x & 0xffff0000u) * GW_SCALE, __uint_as_float(u.y << 16) * GW_SCALE, __uint_as_float(u.y & 0xffff0000u) * GW_SCALE);
            ww[2 * ck + 1] = pk4_fp8(__uint_as_float(u.z << 16) * GW_SCALE, __uint_as_float(u.z & 0xffff0000u) * GW_SCALE, __uint_as_float(u.w << 16) * GW_SCALE, __uint_as_float(u.w & 0xffff0000u) * GW_SCALE);
        }
        unsigned char* wd = (unsigned char*)gw + (size_t)chunk * 8192 + i * 128 + 32 * sg;
        *(uint4*)wd = make_uint4(ww[0], ww[1], ww[2], ww[3]); *(uint4*)(wd + 16) = make_uint4(ww[4], ww[5], ww[6], ww[7]);
    }
}

#define GNT 2
struct GdnFrag { u32x4 w8[2], q8[2], kd8[2]; bf16x8 inA[2]; uint2 uC[GNT]; float glv; };
__device__ __forceinline__ void gdn_load_frag(GdnFrag& f, const bf16_t* __restrict__ guT, const bf16_t* __restrict__ gw, const bf16_t* __restrict__ gqd,
                                              const bf16_t* __restrict__ gkdT, const bf16_t* __restrict__ gin, const float* __restrict__ gl,
                                              int chunk, int w, int sl, int n16, int kq) {
    const size_t cb = (size_t)chunk * 8192;
    const unsigned char* wr = (const unsigned char*)gw + cb + (16 * w + n16) * 128 + 16 * kq;
    const unsigned char* qr = (const unsigned char*)gqd + cb + (16 * w + n16) * 128 + 16 * kq;
    f.w8[0] = *(const u32x4*)wr; f.w8[1] = *(const u32x4*)(wr + 64);
    f.q8[0] = *(const u32x4*)qr; f.q8[1] = *(const u32x4*)(qr + 64);
#pragma unroll
    for (int hh = 0; hh < 2; hh++) f.kd8[hh] = *(const u32x4*)((const unsigned char*)gkdT + cb + (32 * w + 16 * hh + n16) * 64 + 16 * kq);
#pragma unroll
    for (int ks = 0; ks < 2; ks++) f.inA[ks] = *(const bf16x8*)(gin + (size_t)chunk * 4096 + (16 * w + n16) * 64 + 16 * kq + 8 * ks);
#pragma unroll
    for (int nt = 0; nt < GNT; nt++) f.uC[nt] = *(const uint2*)(guT + cb + (16 * (GNT * sl + nt) + n16) * 64 + 16 * w + 4 * kq);
    f.glv = gl[chunk];
}
#define STS 144
#define VNS 80
__device__ __forceinline__ void gdn_step(const GdnFrag& f, f32x4 (&S)[2][GNT], bf16_t* StT, bf16_t* vnT, float* __restrict__ ogrow, int w, int n16, int kq) {
    bf16x8 wA[4], qA[4], kdA[2][2];
#pragma unroll
    for (int ks = 0; ks < 4; ks++) {
        wA[ks] = fp8x8_bf16(f.w8[ks >> 1][2 * (ks & 1)], f.w8[ks >> 1][2 * (ks & 1) + 1]);
        qA[ks] = fp8x8_bf16(f.q8[ks >> 1][2 * (ks & 1)], f.q8[ks >> 1][2 * (ks & 1) + 1]);
    }
    f32x4 qs[GNT];
#pragma unroll
    for (int nt = 0; nt < GNT; nt++) {
        f32x4 ws = (f32x4){0.f, 0.f, 0.f, 0.f};
        qs[nt] = (f32x4){0.f, 0.f, 0.f, 0.f};
#pragma unroll
        for (int ks = 0; ks < 4; ks++) {
            bf16x8 sb = *(const bf16x8*)(StT + (16 * nt + n16) * STS + 64 * (ks >> 1) + 16 * kq + 8 * (ks & 1));
            ws = __builtin_amdgcn_mfma_f32_16x16x32_bf16(wA[ks], sb, ws, 0, 0, 0);
            qs[nt] = __builtin_amdgcn_mfma_f32_16x16x32_bf16(qA[ks], sb, qs[nt], 0, 0, 0);
        }
        const float iw = 1.f / GW_SCALE;
        float v0 = __uint_as_float(f.uC[nt].x << 16) - ws[0] * iw, v1 = __uint_as_float(f.uC[nt].x & 0xffff0000u) - ws[1] * iw;
        float v2 = __uint_as_float(f.uC[nt].y << 16) - ws[2] * iw, v3 = __uint_as_float(f.uC[nt].y & 0xffff0000u) - ws[3] * iw;
        *(uint2*)(vnT + (16 * nt + n16) * VNS + 16 * w + 4 * kq) = make_uint2(pack2bf(v0, v1), pack2bf(v2, v3));
    }
#pragma unroll
    for (int hh = 0; hh < 2; hh++)
#pragma unroll
        for (int ks = 0; ks < 2; ks++) kdA[hh][ks] = fp8x8_bf16(f.kd8[hh][2 * ks], f.kd8[hh][2 * ks + 1]);
    __syncthreads();
#pragma unroll
    for (int nt = 0; nt < GNT; nt++) {
        bf16x8 vb0 = *(const bf16x8*)(vnT + (16 * nt + n16) * VNS + 16 * kq), vb1 = *(const bf16x8*)(vnT + (16 * nt + n16) * VNS + 16 * kq + 8);
        f32x4 q = qs[nt] * (1.f / GQ_SCALE);
        q = __builtin_amdgcn_mfma_f32_16x16x32_bf16(f.inA[0], vb0, q, 0, 0, 0);
        q = __builtin_amdgcn_mfma_f32_16x16x32_bf16(f.inA[1], vb1, q, 0, 0, 0);
        f32x4 c0 = (f32x4){0.f, 0.f, 0.f, 0.f}, c1 = (f32x4){0.f, 0.f, 0.f, 0.f};
        c0 = __builtin_amdgcn_mfma_f32_16x16x32_bf16(kdA[0][0], vb0, c0, 0, 0, 0);
        c0 = __builtin_amdgcn_mfma_f32_16x16x32_bf16(kdA[0][1], vb1, c0, 0, 0, 0);
        c1 = __builtin_amdgcn_mfma_f32_16x16x32_bf16(kdA[1][0], vb0, c1, 0, 0, 0);
        c1 = __builtin_amdgcn_mfma_f32_16x16x32_bf16(kdA[1][1], vb1, c1, 0, 0, 0);
        const f32x4 s0 = S[0][nt] * f.glv + c0 * (1.f / GK_SCALE), s1 = S[1][nt] * f.glv + c1 * (1.f / GK_SCALE);
        S[0][nt] = s0; S[1][nt] = s1;
#pragma unroll
        for (int r = 0; r < 4; r++) ogrow[(size_t)(4 * kq + r) * 512 + 16 * nt] = q[r];
        *(uint2*)(StT + (16 * nt + n16) * STS + 32 * w + 4 * kq) = make_uint2(pack2bf(s0[0], s0[1]), pack2bf(s0[2], s0[3]));
        *(uint2*)(StT + (16 * nt + n16) * STS + 32 * w + 16 + 4 * kq) = make_uint2(pack2bf(s1[0], s1[1]), pack2bf(s1[2], s1[3]));
    }
    __syncthreads();
}
#define GDN_SCAN_ITEMS (8 * 8 / GNT)
__device__ __forceinline__ void d_gdn_scan2(const bf16_t* __restrict__ guT, const bf16_t* __restrict__ gw, const bf16_t* __restrict__ gqd,
                                            const bf16_t* __restrict__ gkdT, const bf16_t* __restrict__ gin, const float* __restrict__ gl,
                                            float* __restrict__ og, int item, char* smem) {
    bf16_t* StT = (bf16_t*)smem;
    bf16_t* vnT = StT + 16 * GNT * STS;
    const int tid = opaque_tid(), lane = tid & 63, w = tid >> 6, n16 = lane & 15, kq = lane >> 4;
    const int bh = item & 7, sl = item >> 3, b = bh >> 2, h = bh & 3;
    for (int i = tid; i < 16 * GNT * STS / 2; i += 256) ((unsigned*)StT)[i] = 0u;
    f32x4 S[2][GNT];
#pragma unroll
    for (int nt = 0; nt < GNT; nt++) { S[0][nt] = (f32x4){0.f, 0.f, 0.f, 0.f}; S[1][nt] = (f32x4){0.f, 0.f, 0.f, 0.f}; }
    GdnFrag fa, fb, fc;
    gdn_load_frag(fa, guT, gw, gqd, gkdT, gin, gl, bh * 128, w, sl, n16, kq);
    gdn_load_frag(fb, guT, gw, gqd, gkdT, gin, gl, bh * 128 + 1, w, sl, n16, kq);
    __syncthreads();
    float* obase = og + (size_t)(b * SEQ + 16 * w) * 512 + h * 128 + 16 * GNT * sl + n16;
#pragma unroll 1
    for (int n = 0; n < 128; n += 3) {
        if (n + 2 < 128) gdn_load_frag(fc, guT, gw, gqd, gkdT, gin, gl, bh * 128 + n + 2, w, sl, n16, kq);
        __builtin_amdgcn_sched_barrier(0);
        gdn_step(fa, S, StT, vnT, obase + (size_t)(n * 64) * 512, w, n16, kq);
        if (n + 3 < 128) gdn_load_frag(fa, guT, gw, gqd, gkdT, gin, gl, bh * 128 + n + 3, w, sl, n16, kq);
        __builtin_amdgcn_sched_barrier(0);
        gdn_step(fb, S, StT, vnT, obase + (size_t)((n + 1) * 64) * 512, w, n16, kq);
        if (n + 2 < 128) {
            if (n + 4 < 128) gdn_load_frag(fb, guT, gw, gqd, gkdT, gin, gl, bh * 128 + n + 4, w, sl, n16, kq);
            __builtin_amdgcn_sched_barrier(0);
            gdn_step(fc, S, StT, vnT, obase + (size_t)((n + 2) * 64) * 512, w, n16, kq);
        }
    }
}

__device__ __forceinline__ void d_gdn_out(const float* __restrict__ og, const bf16_t* __restrict__ proj, const float* __restrict__ gain, bf16_t* __restrict__ mix, int t, int lane) {
    const int c8 = 8 * (lane & 15);
    const float4 g0 = *(const float4*)(gain + c8), g1 = *(const float4*)(gain + c8 + 4);
    const float gg[8] = {g0.x, g0.y, g0.z, g0.w, g1.x, g1.y, g1.z, g1.w};
    float4 a0[2], a1[2]; uint4 zz[2];
#pragma unroll
    for (int k = 0; k < 2; k++) {
        const float* o = og + (size_t)(t + k) * 512 + 8 * lane;
        a0[k] = *(const float4*)o; a1[k] = *(const float4*)(o + 4);
        zz[k] = *(const uint4*)(proj + (size_t)(t + k) * PLD + C_Z + 8 * lane);
    }
#pragma unroll
    for (int k = 0; k < 2; k++) {
        const float a[8] = {a0[k].x, a0[k].y, a0[k].z, a0[k].w, a1[k].x, a1[k].y, a1[k].z, a1[k].w};
        const unsigned zw[4] = {zz[k].x, zz[k].y, zz[k].z, zz[k].w};
        float ss = 0.f;
#pragma unroll
        for (int e = 0; e < 8; e++) ss += a[e] * a[e];
        ss = allsum16(ss);
        const float r = rsqrtf(ss * (1.f / 128.f) + 1e-6f);
        float y[8];
#pragma unroll
        for (int e = 0; e < 4; e++) {
            const float z0 = __uint_as_float(zw[e] << 16), z1 = __uint_as_float(zw[e] & 0xffff0000u);
            y[2 * e] = a[2 * e] * r * gg[2 * e] * z0 * sigmoidf_(z0); y[2 * e + 1] = a[2 * e + 1] * r * gg[2 * e + 1] * z1 * sigmoidf_(z1);
        }
        *(uint4*)(mix + (size_t)(t + k) * DM + 512 + 8 * lane) = make_uint4(pk2(y[0], y[1]), pk2(y[2], y[3]), pk2(y[4], y[5]), pk2(y[6], y[7]));
    }
}

__device__ __forceinline__ void route_load_subkeys(const float* __restrict__ subkeys, char* smem) {
    for (int idx = threadIdx.x; idx < 2 * 128 * 16; idx += 256) {
        const int half = idx >> 11, key = (idx >> 4) & 127, ch = idx & 15;
        const float* src = subkeys + ((size_t)(half * 128 + key)) * 128 + ch * 8;
        const float4 x0 = *(const float4*)src, x1 = *(const float4*)(src + 4);
        *(uint4*)(smem + half * 32768 + key * 256 + ((ch ^ (key & 15)) << 4)) = make_uint4(pk2(x0.x, x0.y), pk2(x0.z, x0.w), pk2(x1.x, x1.y), pk2(x1.z, x1.w));
    }
}
__device__ __forceinline__ unsigned f2ord(float f) { const int b = __float_as_int(f); return (unsigned)(b ^ ((b >> 31) | (int)0x80000000)); }
__device__ __forceinline__ float ord2f(unsigned k) { const int m = (int)k >> 31; return __int_as_float((int)(k ^ (unsigned)((~m) | (int)0x80000000))); }
#define CEX(i, j) { const unsigned _a = v[i], _b = v[j]; v[i] = max(_a, _b); v[j] = min(_a, _b); }
__device__ __forceinline__ void d_peer_route2(const bf16_t* __restrict__ qry, int* __restrict__ eidx, float* __restrict__ pgate, int mtile, const char* smem, int lane) {
    const int n16 = lane & 15, kq = lane >> 4;
    const int tA = 2 * mtile + (n16 >> 3), hA = n16 & 7;
    unsigned topk[2][4];
    bf16x8 aq[2][4];
#pragma unroll
    for (int half = 0; half < 2; half++) {
        const bf16_t* qp = qry + (size_t)tA * 2048 + hA * 256 + half * 128 + 8 * kq;
#pragma unroll
        for (int ks = 0; ks < 4; ks++) aq[half][ks] = *(const bf16x8*)(qp + 32 * ks);
    }
#pragma unroll
    for (int half = 0; half < 2; half++) {
        bf16x8 a[4];
#pragma unroll
        for (int ks = 0; ks < 4; ks++) a[ks] = aq[half][ks];
        f32x4 acc[8];
#pragma unroll
        for (int nt = 0; nt < 8; nt++) acc[nt] = (f32x4){0.f, 0.f, 0.f, 0.f};
#pragma unroll
        for (int ks = 0; ks < 4; ks++)
#pragma unroll
            for (int nt = 0; nt < 8; nt++) {
                const bf16x8 bb = *(const bf16x8*)(smem + half * 32768 + (16 * nt + n16) * 256 + (((4 * ks + kq) ^ n16) << 4));
                acc[nt] = __builtin_amdgcn_mfma_f32_16x16x32_bf16(a[ks], bb, acc[nt], 0, 0, 0);
                if (nt == 3 || nt == 7) __builtin_amdgcn_sched_barrier(0);
            }
#pragma unroll
        for (int r = 0; r < 4; r++) {
            unsigned v[8];
#pragma unroll
            for (int nt = 0; nt < 8; nt++) v[nt] = (f2ord(acc[nt][r]) & 0xFFFFFF80u) | (unsigned)(nt << 4) | (unsigned)n16;
            CEX(0, 1) CEX(2, 3) CEX(4, 5) CEX(6, 7) CEX(0, 2) CEX(1, 3) CEX(4, 6) CEX(5, 7) CEX(1, 2) CEX(5, 6)
            CEX(0, 4) CEX(1, 5) CEX(2, 6) CEX(3, 7) CEX(2, 4) CEX(3, 5) CEX(1, 2) CEX(3, 4) CEX(5, 6)
            unsigned keep = 0u;
#pragma unroll 1
            for (int it = 0; it < 16; it++) {
                const unsigned mx = allmaxu16(v[0]);
                if (n16 == it) keep = mx;
                if (v[0] == mx) { v[0] = v[1]; v[1] = v[2]; v[2] = v[3]; v[3] = v[4]; v[4] = v[5]; v[5] = v[6]; v[6] = v[7]; v[7] = 0u; }
            }
            topk[half][r] = keep;
            __builtin_amdgcn_sched_barrier(0);
        }
    }
    const int lanebase = lane & 48;
    int si[4], sj[4];
    si[0] = 0; sj[0] = n16;
    si[1] = n16 < 8 ? 1 : (n16 < 13 ? 2 : 4);  sj[1] = n16 < 8 ? n16 : (n16 < 13 ? n16 - 8 : n16 - 13);
    si[2] = n16 < 4 ? 3 : (n16 < 6 ? 5 : (n16 < 8 ? 6 : (n16 < 10 ? 7 : n16 - 2)));
    sj[2] = n16 < 4 ? n16 : (n16 < 6 ? n16 - 4 : (n16 < 8 ? n16 - 6 : (n16 < 10 ? n16 - 8 : 0)));
    si[3] = 14 + (n16 & 1); sj[3] = 0;
#pragma unroll
    for (int r = 0; r < 4; r++) {
        const unsigned k1 = topk[0][r], k2 = topk[1][r];
        const int f1 = (int)((__float_as_uint(ord2f(k1)) & 0xFFFFFF80u) | (k1 & 127u)), f2 = (int)((__float_as_uint(ord2f(k2)) & 0xFFFFFF80u) | (k2 & 127u));
        unsigned v[4], es[4];
#pragma unroll
        for (int q = 0; q < 4; q++) {
            const unsigned av = (unsigned)__builtin_amdgcn_ds_bpermute((lanebase + si[q]) * 4, f1), bv = (unsigned)__builtin_amdgcn_ds_bpermute((lanebase + sj[q]) * 4, f2);
            es[q] = ((av & 127u) << 7) | (bv & 127u);
            v[q] = (f2ord(__uint_as_float(av) + __uint_as_float(bv)) & 0xFFFFFFC0u) | (unsigned)(q << 4) | (unsigned)n16;
        }
        if (n16 >= 2) v[3] = 0u;
        CEX(0, 1) CEX(2, 3) CEX(0, 2) CEX(1, 3) CEX(1, 2)
        unsigned keep = 0u;
#pragma unroll 1
        for (int it = 0; it < 16; it++) {
            const unsigned mx = allmaxu16(v[0]);
            if (n16 == it) keep = mx;
            if (v[0] == mx) { v[0] = v[1]; v[1] = v[2]; v[2] = v[3]; v[3] = 0u; }
        }
        const int src = (lanebase + (int)(keep & 15u)) * 4;
        const unsigned e0 = (unsigned)__builtin_amdgcn_ds_bpermute(src, (int)es[0]), e1 = (unsigned)__builtin_amdgcn_ds_bpermute(src, (int)es[1]);
        const unsigned e2 = (unsigned)__builtin_amdgcn_ds_bpermute(src, (int)es[2]), e3 = (unsigned)__builtin_amdgcn_ds_bpermute(src, (int)es[3]);
        const unsigned qw = (keep >> 4) & 3u;
        const unsigned ke = qw == 0u ? e0 : (qw == 1u ? e1 : (qw == 2u ? e2 : e3));
        const float ksc = ord2f(keep & 0xFFFFFFC0u);
        const float smax = ord2f(allmaxu16(keep) & 0xFFFFFFC0u);
        const float ex = __expf(ksc - smax);
        const float sum = allsum16(ex);
        const int row = 4 * kq + r;
        const size_t o = (size_t)(2 * mtile + (row >> 3)) * 128 + (row & 7) * 16 + n16;
        eidx[o] = (int)ke; pgate[o] = ex / sum;
    }
}
#undef CEX

#define XB_TMO      128
#define XB_XCNT(j)  (256  + 64 * (j))
#define XB_XSUB(j)  (1280 + 64 * (j))
#define XB_XGEN(j)  (2304 + 64 * (j))
#define XB_TOP      3328
#define XB_TOPGEN   3392
#define XB_QUEUE    3456
#define XL_CNT(j)    (4096 + 64 * (j))
#define XL_GEN(j)    (5120 + 64 * (j))
#define XB_XCHK      6144
#define XL2_CNT(j)   (6400 + 64 * (j))
#define XL2_GEN(j)   (7424 + 64 * (j))
#define XCD_BAR_WORDS 8448
#define XB_SPIN_CAP (1u << 22)
#define LAS __attribute__((address_space(3)))
__device__ __forceinline__ unsigned xb_ld(unsigned* p)              { return __hip_atomic_load(p, __ATOMIC_RELAXED, __HIP_MEMORY_SCOPE_AGENT); }
__device__ __forceinline__ unsigned xb_add(unsigned* p, unsigned v) { return __hip_atomic_fetch_add(p, v, __ATOMIC_RELAXED, __HIP_MEMORY_SCOPE_AGENT); }
__device__ __forceinline__ unsigned xb_xcc_id() { return (unsigned)__builtin_amdgcn_s_getreg((3 << 11) | 20) & 0xFu; }
#define XB_SPIN(cond, bar) do { unsigned _sp = 0; while (cond) { __builtin_amdgcn_s_sleep(1); \
    if ((++_sp & 255u) == 0u) { if (xb_ld(&(bar)[XB_TMO])) break; if (_sp > XB_SPIN_CAP) { atomicAdd(&(bar)[XB_TMO], 1u); break; } } } } while (0)
struct XcdBarrier { unsigned* bar; unsigned x; volatile LAS unsigned* st; };
__device__ __forceinline__ XcdBarrier xcd_barrier_post(unsigned* bar, volatile LAS unsigned* st) {
    XcdBarrier b; b.bar = bar; b.x = xb_xcc_id(); b.st = st;
    if (threadIdx.x == 0) (void)xb_add(&bar[XB_XCNT(b.x)], 1u);
    return b;
}
__device__ __forceinline__ void xcd_barrier_complete(unsigned* bar, unsigned x, unsigned& nloc, unsigned& nx) {
    const unsigned G = gridDim.x * gridDim.y * gridDim.z;
    unsigned sum, cnt, mine, sp = 0u;
    for (;;) {
        sum = 0u; cnt = 0u; mine = 0u;
#pragma unroll
        for (unsigned j = 0; j < 16; ++j) { const unsigned c = xb_ld(&bar[XB_XCNT(j)]); sum += c; cnt += (c > 0u) ? 1u : 0u; mine = (j == x) ? c : mine; }
        if (sum == G) break;
        __builtin_amdgcn_s_sleep(1);
        if ((++sp & 255u) == 0u) { if (xb_ld(&bar[XB_TMO])) break; if (sp > XB_SPIN_CAP) { atomicAdd(&bar[XB_TMO], 1u); break; } }
    }
    nloc = mine > 0u ? mine : 1u; nx = cnt > 0u ? cnt : 1u;
}
__device__ __forceinline__ void xcd_barrier(const XcdBarrier& b) {
    asm volatile("s_waitcnt vmcnt(0)" ::: "memory");
    __syncthreads();
    if (threadIdx.x == 0) {
        unsigned* bar = b.bar;
        __builtin_amdgcn_s_waitcnt(0);
        unsigned nloc = b.st[0], nx = b.st[1];
        if (nloc == 0u) { xcd_barrier_complete(bar, b.x, nloc, nx); b.st[0] = nloc; b.st[1] = nx; }
        const unsigned old = xb_add(&bar[XB_XSUB(b.x)], 1u);
        const unsigned gen = old / nloc;
        if (old + 1u == (gen + 1u) * nloc) {
            __builtin_amdgcn_fence(__ATOMIC_RELEASE, "agent");
            asm volatile("s_waitcnt vmcnt(0)" ::: "memory");
            const unsigned og = xb_add(&bar[XB_TOP], 1u);
            const unsigned tg = og / nx;
            if (og + 1u == (tg + 1u) * nx) xb_add(&bar[XB_TOPGEN], 1u);
            else XB_SPIN(xb_ld(&bar[XB_TOPGEN]) == tg, bar);
            __builtin_amdgcn_fence(__ATOMIC_ACQUIRE, "agent");
            xb_add(&bar[XB_XGEN(b.x)], 1u);
            asm volatile("s_waitcnt vmcnt(0)" ::: "memory");
        } else {
            XB_SPIN(xb_ld(&bar[XB_XGEN(b.x)]) == gen, bar);
            __builtin_amdgcn_fence(__ATOMIC_ACQUIRE, "agent");
            asm volatile("s_waitcnt vmcnt(0)" ::: "memory");
        }
    }
    __syncthreads();
}

__device__ __forceinline__ void xcd_local_sync(const XcdBarrier& b, unsigned round) {
    __syncthreads();
    if (threadIdx.x == 0) {
        unsigned nloc = b.st[0]; if (nloc == 0u) nloc = 1u;
        const unsigned old = xb_add(&b.bar[XL_CNT(b.x)], 1u);
        if (old + 1u == nloc * (round + 1u)) xb_add(&b.bar[XL_GEN(b.x)], 1u);
        else { unsigned sp = 0; while (xb_ld(&b.bar[XL_GEN(b.x)]) <= round && ++sp < (1u << 16)) __builtin_amdgcn_s_sleep(1); }
    }
    __syncthreads();
}
__device__ __forceinline__ void xcd_barrier_local(const XcdBarrier& b, unsigned idx) {
    asm volatile("s_waitcnt vmcnt(0)" ::: "memory");
    __syncthreads();
    if (threadIdx.x == 0) {
        unsigned nloc = b.st[0]; if (nloc == 0u) nloc = 1u;
        const unsigned old = xb_add(&b.bar[XL2_CNT(b.x)], 1u);
        if (old + 1u == nloc * (idx + 1u)) xb_add(&b.bar[XL2_GEN(b.x)], 1u);
        else XB_SPIN(xb_ld(&b.bar[XL2_GEN(b.x)]) <= idx, b.bar);
        __builtin_amdgcn_fence(__ATOMIC_ACQUIRE, "agent");
        asm volatile("s_waitcnt vmcnt(0)" ::: "memory");
    }
    __syncthreads();
}

struct QRow { float4 x[4]; };
__device__ __forceinline__ void quant_load(QRow& q, const float* __restrict__ src, int row, int lane) {
    const float4* p = (const float4*)(src + (size_t)row * DM) + lane * 4;
#pragma unroll
    for (int i = 0; i < 4; i++) q.x[i] = p[i];
}
__device__ __forceinline__ void quant_finish(const QRow& q, unsigned char* __restrict__ dst, float* __restrict__ scale, int row, int lane, int bias) {
    float am = 0.f;
#pragma unroll
    for (int i = 0; i < 4; i++) am = fmaxf(am, fmaxf(fmaxf(fabsf(q.x[i].x), fabsf(q.x[i].y)), fmaxf(fabsf(q.x[i].z), fabsf(q.x[i].w))));
    am = wave_max(am);
    const float sc = (am > 0.f) ? am * (bias ? (1.f / 224.f) : (1.f / 127.f)) : 1.f;
    const float inv = 1.f / sc;
    unsigned wv[4];
#pragma unroll
    for (int i = 0; i < 4; i++) {
        if (bias) {
            int w = 0;
            w = __builtin_amdgcn_cvt_pk_fp8_f32(q.x[i].x * inv, q.x[i].y * inv, w, false);
            w = __builtin_amdgcn_cvt_pk_fp8_f32(q.x[i].z * inv, q.x[i].w * inv, w, true);
            wv[i] = (unsigned)w;
        } else {
            const int q0 = (int)rintf(q.x[i].x * inv), q1 = (int)rintf(q.x[i].y * inv), q2 = (int)rintf(q.x[i].z * inv), q3 = (int)rintf(q.x[i].w * inv);
            wv[i] = (unsigned)(q0 & 0xff) | ((unsigned)(q1 & 0xff) << 8) | ((unsigned)(q2 & 0xff) << 16) | ((unsigned)(q3 & 0xff) << 24);
        }
    }
    ((uint4*)(dst + (size_t)row * (2 * DM)))[lane] = make_uint4(wv[0], wv[1], wv[2], wv[3]);
    if (lane == 0) scale[row] = sc;
}
__device__ __forceinline__ void d_quant_rows16(const float* __restrict__ pu, const float* __restrict__ pv, unsigned char* __restrict__ dst,
                                               float* __restrict__ su, float* __restrict__ sv, int r0, int lane) {
#pragma unroll 1
    for (int r = r0; r < r0 + 16; r += 2) {
        QRow a0, a1, b0, b1;
        quant_load(a0, pu, r, lane); quant_load(b0, pv, r, lane); quant_load(a1, pu, r + 1, lane); quant_load(b1, pv, r + 1, lane);
        quant_finish(a0, dst, su, r, lane, 0); quant_finish(b0, dst + DM, sv, r, lane, 128);
        quant_finish(a1, dst, su, r + 1, lane, 0); quant_finish(b1, dst + DM, sv, r + 1, lane, 128);
    }
}

struct PeerGrp { u32x4 u[4]; u32x4 v[4]; float gvl, sul; };
__device__ __forceinline__ void peer_load(PeerGrp& G, const unsigned char* __restrict__ uq, const unsigned char* __restrict__ vq,
                                          int esrc, float gsrc, float susrc, int k0, int lane) {
    const int sl = 4 * (k0 + 2 * (lane & 1) + ((lane >> 1) & 1));
    G.gvl = __builtin_bit_cast(float, __builtin_amdgcn_ds_bpermute(sl, __builtin_bit_cast(int, gsrc)));
    G.sul = __builtin_bit_cast(float, __builtin_amdgcn_ds_bpermute(sl, __builtin_bit_cast(int, susrc)));
#pragma unroll
    for (int i = 0; i < 4; i++) {
        const int e = __builtin_amdgcn_readlane(esrc, (k0 + i) & 63);
        G.u[i] = ((const u32x4*)(uq + (size_t)e * (2 * DM)))[lane];
        G.v[i] = ((const u32x4*)(uq + (size_t)e * (2 * DM) + DM))[lane];
    }
}
__device__ __forceinline__ void peer_compute(const PeerGrp& G, const int (&xq)[4], float sx, float (&acc)[16], float& bsum, int lane) {
    int d[4];
#pragma unroll
    for (int i = 0; i < 4; i++) {
        int sdot = 0;
        sdot = __builtin_amdgcn_sdot4((int)G.u[i][0], xq[0], sdot, false); sdot = __builtin_amdgcn_sdot4((int)G.u[i][1], xq[1], sdot, false);
        sdot = __builtin_amdgcn_sdot4((int)G.u[i][2], xq[2], sdot, false); sdot = __builtin_amdgcn_sdot4((int)G.u[i][3], xq[3], sdot, false);
        d[i] = sdot;
    }
    const bool odd = lane & 1, b1 = lane & 2;
    int ka = odd ? d[2] : d[0], kb = odd ? d[3] : d[1];
    const int sa = odd ? d[0] : d[2], sb = odd ? d[1] : d[3];
    ka += (int)dppu<0xB1>((unsigned)sa); kb += (int)dppu<0xB1>((unsigned)sb);
    int c = b1 ? kb : ka;
    const int sc = b1 ? ka : kb;
    c += (int)dppu<0x4E>((unsigned)sc);
    c += (int)dppu<0x124>((unsigned)c); c += (int)dppu<0x128>((unsigned)c);
    { auto r = __builtin_amdgcn_permlane16_swap((unsigned)c, (unsigned)c, false, false); c = (int)(r[0] + r[1]); }
    { auto r = __builtin_amdgcn_permlane32_swap((unsigned)c, (unsigned)c, false, false); c = (int)(r[0] + r[1]); }
    const float dot = (float)c * (G.sul * sx);
    const float u2 = 1.5957691216057308f * (dot + 0.044715f * dot * dot * dot);
    const float csl = G.gvl * dot * __builtin_amdgcn_rcpf(1.f + __expf(-u2));
#pragma unroll
    for (int i = 0; i < 4; i++) {
        const float cs = __builtin_bit_cast(float, __builtin_amdgcn_readlane(__builtin_bit_cast(int, csl), ((i & 1) << 1) | (i >> 1)));
        const f32x2 cs2 = (f32x2){cs, cs};
#pragma unroll
        for (int j = 0; j < 4; j++) {
            const int wv = (int)G.v[i][j];
            const f32x2 lo = __builtin_amdgcn_cvt_pk_f32_fp8(wv, false), hi = __builtin_amdgcn_cvt_pk_f32_fp8(wv, true);
            f32x2 a0 = (f32x2){acc[4 * j], acc[4 * j + 1]}, a1 = (f32x2){acc[4 * j + 2], acc[4 * j + 3]};
            a0 = __builtin_elementwise_fma(cs2, lo, a0); a1 = __builtin_elementwise_fma(cs2, hi, a1);
            acc[4 * j] = a0[0]; acc[4 * j + 1] = a0[1]; acc[4 * j + 2] = a1[0]; acc[4 * j + 3] = a1[1];
        }
    }
}
struct PeerTok { int xq[4]; float sx; int e_lo, e_hi; float g_lo, g_hi, s_lo, s_hi; };
__device__ __forceinline__ void peer_prep_token(PeerTok& T, const bf16_t* __restrict__ h2, const int* __restrict__ eidx, const float* __restrict__ pgate,
                                                const float* __restrict__ su, const float* __restrict__ sv, const float* __restrict__ ssq, const float* __restrict__ fgain, int token, int lane) {
    const uint4 xa = ((const uint4*)(h2 + (size_t)token * DM))[2 * lane], xb = ((const uint4*)(h2 + (size_t)token * DM))[2 * lane + 1];
    const unsigned xw[8] = {xa.x, xa.y, xa.z, xa.w, xb.x, xb.y, xb.z, xb.w};
    float xf[16];
    float am = 0.f;
    const float rr = rsqrtf(allsum16(ssq[(size_t)token * 16 + (lane & 15)]) * (1.f / DM) + 1e-6f);
    const float4* gp = (const float4*)(fgain + lane * 16);
    const float4 ga = gp[0], gb = gp[1], gc = gp[2], gd = gp[3];
    const float gg[16] = {ga.x, ga.y, ga.z, ga.w, gb.x, gb.y, gb.z, gb.w, gc.x, gc.y, gc.z, gc.w, gd.x, gd.y, gd.z, gd.w};
#pragma unroll
    for (int j = 0; j < 8; j++) {
        xf[2 * j] = __uint_as_float(xw[j] << 16) * rr * gg[2 * j]; xf[2 * j + 1] = __uint_as_float(xw[j] & 0xffff0000u) * rr * gg[2 * j + 1];
        am = fmaxf(am, fmaxf(fabsf(xf[2 * j]), fabsf(xf[2 * j + 1])));
    }
    am = wave_max(am);
    T.sx = (am > 0.f) ? am * (1.f / 127.f) : 1.f;
    const float isx = 1.f / T.sx;
#pragma unroll
    for (int j = 0; j < 4; j++) {
        const int q0 = (int)rintf(xf[4 * j] * isx), q1 = (int)rintf(xf[4 * j + 1] * isx), q2 = (int)rintf(xf[4 * j + 2] * isx), q3 = (int)rintf(xf[4 * j + 3] * isx);
        T.xq[j] = (int)((unsigned)(q0 & 0xff) | ((unsigned)(q1 & 0xff) << 8) | ((unsigned)(q2 & 0xff) << 16) | ((unsigned)(q3 & 0xff) << 24));
    }
    int e_lo = eidx[(size_t)token * 128 + lane], e_hi = eidx[(size_t)token * 128 + 64 + lane];
    float g_lo = pgate[(size_t)token * 128 + lane], g_hi = pgate[(size_t)token * 128 + 64 + lane];
    {
        unsigned long long ka = ((unsigned long long)(unsigned)e_lo << 32) | __float_as_uint(g_lo), kb = ((unsigned long long)(unsigned)e_hi << 32) | __float_as_uint(g_hi);
#pragma unroll
        for (int k = 2; k <= 128; k <<= 1) {
#pragma unroll
            for (int j = k >> 1; j > 0; j >>= 1) {
                if (j == 64) { const unsigned long long mn = ka < kb ? ka : kb, mx = ka < kb ? kb : ka; ka = mn; kb = mx; }
                else {
                    const unsigned long long pa = ((unsigned long long)xorlane((unsigned)(ka >> 32), j, lane) << 32) | xorlane((unsigned)ka, j, lane);
                    const unsigned long long pb = ((unsigned long long)xorlane((unsigned)(kb >> 32), j, lane) << 32) | xorlane((unsigned)kb, j, lane);
                    const bool lower = (lane & j) == 0;
                    const bool dirA = (lane & k) == 0, dirB = ((lane + 64) & k) == 0;
                    ka = ((lower == dirA) == (ka < pa)) ? ka : pa;
                    kb = ((lower == dirB) == (kb < pb)) ? kb : pb;
                }
            }
        }
        e_lo = (int)(ka >> 32); g_lo = __uint_as_float((unsigned)ka); e_hi = (int)(kb >> 32); g_hi = __uint_as_float((unsigned)kb);
    }
    T.e_lo = e_lo; T.e_hi = e_hi;
    T.g_lo = g_lo * sv[e_lo]; T.g_hi = g_hi * sv[e_hi];
    T.s_lo = su[e_lo]; T.s_hi = su[e_hi];
}
__device__ __forceinline__ void peer_store(float* __restrict__ out, int token, int lane, const float (&acc)[16], float bsum) {
    float4* o = (float4*)(out + (size_t)token * DM + lane * 16);
#pragma unroll
    for (int j = 0; j < 4; j++) {
        float4 t = o[j];
        t.x += acc[4 * j]; t.y += acc[4 * j + 1]; t.z += acc[4 * j + 2]; t.w += acc[4 * j + 3];
        o[j] = t;
    }
}
__device__ __forceinline__ int peer_key(const PeerTok& T, int g) {
    const int idx = 4 * g;
    return (idx < 64) ? __builtin_amdgcn_readlane(T.e_lo, idx & 63) : __builtin_amdgcn_readlane(T.e_hi, idx & 63);
}
__device__ __forceinline__ void peer_load_grp(PeerGrp& G, const PeerTok& T, int g, const unsigned char* __restrict__ uq, int lane) {
    const int idx = 4 * g;
    if (idx < 64) peer_load(G, uq, uq, T.e_lo, T.g_lo, T.s_lo, idx, lane); else peer_load(G, uq, uq, T.e_hi, T.g_hi, T.s_hi, idx - 64, lane);
}
__device__ __forceinline__ void d_peer_expert_pair(const bf16_t* __restrict__ h2, const int* __restrict__ eidx, const float* __restrict__ pgate,
                                                   const unsigned char* __restrict__ uq, const float* __restrict__ su, const float* __restrict__ sv,
                                                   const float* __restrict__ ssq, const float* __restrict__ fgain, float* __restrict__ out,
                                                   int tokA, int lane, const XcdBarrier& xbar, unsigned midround) {
    PeerTok TA, TB;
    peer_prep_token(TA, h2, eidx, pgate, su, sv, ssq, fgain, tokA, lane);
    peer_prep_token(TB, h2, eidx, pgate, su, sv, ssq, fgain, tokA + 1, lane);
    float accA[16], accB[16];
#pragma unroll
    for (int i = 0; i < 16; i++) { accA[i] = 0.f; accB[i] = 0.f; }
    float bsA = 0.f, bsB = 0.f;
    int gA = 0, gB = 0;
#define PEER_PICK(f) { if (gA >= 32) f = 1; else if (gB >= 32) f = 0; else f = (peer_key(TA, gA) <= peer_key(TB, gB)) ? 0 : 1; }
#define PEER_LOAD(S, f) { if (f) { peer_load_grp(S, TB, gB, uq, lane); gB++; } else { peer_load_grp(S, TA, gA, uq, lane); gA++; } }
#define PEER_COMP(S, f) { if (f) peer_compute(S, TB.xq, TB.sx, accB, bsB, lane); else peer_compute(S, TA.xq, TA.sx, accA, bsA, lane); }
    PeerGrp S0, S1, S2;
    int f0, f1, f2;
    PEER_PICK(f0) PEER_LOAD(S0, f0)
    PEER_PICK(f1) PEER_LOAD(S1, f1)
#pragma unroll 1
    for (int step = 0; step < 63; step += 3) {
        PEER_PICK(f2) PEER_LOAD(S2, f2)
        PEER_COMP(S0, f0)
        PEER_PICK(f0) PEER_LOAD(S0, f0)
        PEER_COMP(S1, f1)
        if (step + 4 < 64) { PEER_PICK(f1) PEER_LOAD(S1, f1) }
        PEER_COMP(S2, f2)
        if (step == 21 || step == 42) xcd_local_sync(xbar, midround + (step > 30 ? 1u : 0u));
    }
    PEER_COMP(S0, f0)
#undef PEER_PICK
#undef PEER_LOAD
#undef PEER_COMP
    peer_store(out, tokA, lane, accA, bsA);
    peer_store(out, tokA + 1, lane, accB, bsB);
}

struct MKP {
    const float *x, *attn_norm, *w_in, *q_gain, *k_gain, *cmp_pos, *cmp_w1, *cmp_w2, *gdn_conv, *a_log, *dt_bias, *out_gain, *w_out, *ffn_norm, *w_query, *subkeys, *peer_u, *peer_v;
    float* out; char* ws; unsigned* bar;
};

#define SMEM_BYTES 76800

__global__ __launch_bounds__(256, 2) void hybrid_megakernel(MKP P) {
    extern __shared__ __attribute__((aligned(16))) char smem[];
    __shared__ uint4 xb_words;
    __shared__ int q_item;
    const int G = gridDim.x, bid0 = blockIdx.x;
    if (threadIdx.x == 0) xb_words = make_uint4(0u, 0u, 0u, 0u);
    __syncthreads();
    XcdBarrier B = xcd_barrier_post(P.bar, (volatile LAS unsigned*)&xb_words);
    __shared__ int xcd_ok_s;
    if (threadIdx.x == 0) (void)__hip_atomic_fetch_or(&P.bar[XB_XCHK + (bid0 & 7)], 1u << (B.x & 15u), __ATOMIC_RELAXED, __HIP_MEMORY_SCOPE_AGENT);
    char* ws = P.ws;
    bf16_t* w_in_t = (bf16_t*)(ws + OFF_WINT);
    bf16_t* w_out_t = (bf16_t*)(ws + OFF_WOUTT);
    bf16_t* w_q_t = (bf16_t*)(ws + OFF_WQT);
    bf16_t* cw1_t = (bf16_t*)(ws + OFF_CW1T);
    float* cbias = (float*)(ws + OFF_CBIAS);
    bf16_t* h_bf = (bf16_t*)(ws + OFF_HBF);
    bf16_t* proj = (bf16_t*)(ws + OFF_PROJ);
    bf16_t* ksn = (bf16_t*)(ws + OFF_KSN);
    bf16_t* kwn = (bf16_t*)(ws + OFF_KWN);
    bf16_t* kc = (bf16_t*)(ws + OFF_KC);
    bf16_t* vc = (bf16_t*)(ws + OFF_VC);
    bf16_t* hid = (bf16_t*)(ws + OFF_HID);
    bf16_t* gu = (bf16_t*)(ws + OFF_GU);
    bf16_t* gw = (bf16_t*)(ws + OFF_GW);
    bf16_t* gqd = (bf16_t*)(ws + OFF_GQD);
    bf16_t* gkd = (bf16_t*)(ws + OFF_GKD);
    bf16_t* gin = (bf16_t*)(ws + OFF_GIN);
    float* gl = (float*)(ws + OFF_GL);
    bf16_t* mix = (bf16_t*)(ws + OFF_MIX);
    bf16_t* qry = (bf16_t*)(ws + OFF_QRY);
    bf16_t* h2 = (bf16_t*)(ws + OFF_H2);
    int* eidx = (int*)(ws + OFF_EIDX);
    float* pgate = (float*)(ws + OFF_PGATE);
    unsigned char* uq = (unsigned char*)(ws + OFF_UQ);
    unsigned char* vq = (unsigned char*)(ws + OFF_VQ);
    float* su = (float*)(ws + OFF_SU);
    float* sv = (float*)(ws + OFF_SV);
    float* og = P.out;
    float2* rope = (float2*)(ws + OFF_ROPE);
    float* ssq = (float*)(ws + OFF_SSQ);
    bf16_t* vsn = (bf16_t*)(ws + OFF_VSN);
    bf16_t* vwn = (bf16_t*)(ws + OFF_VWN);
    bf16_t* cw2t = (bf16_t*)(ws + OFF_CW2T);
    unsigned char* uq_tmp = (unsigned char*)(P.out + 8388608);
    unsigned char* vq_tmp = uq_tmp + 16384ull * 1024;

    {
        const int n1 = 108 * 8, n2 = n1 + 32 * 8, n3 = n2 + 64 * 8, n4 = n3 + 2 * 8 * 16, n5 = n4 + 2 * 2 * 2;
        for (int it = bid0; it < n5; it += G) {
            if (it < n1) d_transpose_bf16(P.w_in, 1024, IN_COLS, w_in_t, it % 108, it / 108, smem);
            else if (it < n2) { int r = it - n1; d_transpose_bf16(P.w_out, 1024, 1024, w_out_t, r % 32, r / 32, smem); }
            else if (it < n3) { int r = it - n2; d_transpose_bf16(P.w_query, 1024, 2048, w_q_t, r % 64, r / 64, smem, P.ffn_norm); }
            else if (it < n4) { int r = it - n3; int j = r >> 7; r &= 127; d_transpose_bf16(P.cmp_w1 + (size_t)j * 2048 * 256, 2048, 256, cw1_t + (size_t)j * 256 * 2048, r % 8, r / 8, smem); }
            else { int r = it - n4; int j = r >> 2; r &= 3; d_transpose_bf16(P.cmp_w2 + (size_t)j * 256 * 64, 256, 64, cw2t + (size_t)j * 64 * 256, r % 2, r / 2, smem); }
        }
        for (int it = bid0; it < 16; it += G) d_cmp_bias(P.cmp_pos, P.cmp_w1, cbias, it, smem);
        for (;;) {
            if (threadIdx.x == 0) q_item = (int)xb_add(&P.bar[XB_QUEUE + 256], 4u);
            __syncthreads();
            const int it0 = q_item;
            __syncthreads();
            if (it0 >= T_TOK / 4) break;
#pragma unroll 1
            for (int k = 0; k < 4; k++) if (it0 + k < T_TOK / 4) d_rmsnorm_bf16(P.x, P.attn_norm, h_bf, it0 + k);
        }
        for (int i = bid0 * 256 + threadIdx.x; i < 8192 * 32; i += G * 256) {
            const int pos = i >> 5, fi = i & 31;
            float sn, cs; sincosf((float)pos * expf(-9.210340371976184f * (float)(2 * fi) / 64.f), &sn, &cs);
            rope[i] = make_float2(cs, sn);
        }
        for (int i = bid0 * 256 + threadIdx.x; i < 32 * PLD / 2; i += G * 256) ((unsigned*)(proj + (size_t)T_TOK * PLD))[i] = 0u;
    }
    xcd_barrier(B);
    if (threadIdx.x == 0) {
        unsigned all = 0u; int ok = ((G & 7) == 0 && G >= 8) ? 1 : 0;
        for (int c = 0; c < 8; c++) { const unsigned m = xb_ld(&P.bar[XB_XCHK + c]); if (m == 0u || (m & (m - 1u)) != 0u || (all & m) != 0u) ok = 0; all |= m; }
        xcd_ok_s = ok;
    }
    __syncthreads();
    const bool xok = xcd_ok_s != 0;
    {
        GemmP p{}; p.A = h_bf; p.lda = 1024; p.akts = 64; p.Bt = w_in_t; p.ldb = 1024; p.K = 1024; p.mtiles = 64; p.ntiles = 27; p.out = proj;
        for (int it = bid0; it < 64 * 27; it += G) d_gemm<EPI_PROJ>(p, it, smem);
    }
    xcd_barrier(B);
    {
        for (int it = bid0; it < 32; it += G) {
            int inst = it >> 2, tile = it & 3;
            int j = inst >> 2, b = (inst >> 1) & 1, g = inst & 1;
            GemmP p{}; p.A = proj + (size_t)(b * SEQ) * PLD + C_KV + 128 * j + 64 * g; p.lda = 16 * PLD; p.akts = PLD;
            p.Bt = cw1_t + (size_t)j * 256 * 2048; p.ldb = 2048; p.K = 2048; p.mtiles = 2; p.ntiles = 2;
            p.out = hid + (size_t)inst * 512 * 256; p.aux = cbias + j * 256;
            d_gemm<EPI_HID>(p, tile, smem);
        }
        for (;;) {
            if (threadIdx.x == 0) q_item = (int)xb_add(&P.bar[XB_QUEUE + 64], 1u);
            __syncthreads();
            const int it = q_item;
            __syncthreads();
            if (it >= 1024) break;
            d_gdn_prep2(proj, P.gdn_conv, P.a_log, P.dt_bias, gu, gw, gqd, gkd, gin, gl, it, smem); __syncthreads();
        }
        for (;;) {
            if (threadIdx.x == 0) q_item = (int)xb_add(&P.bar[XB_QUEUE + 128], 1u);
            __syncthreads();
            const int it = q_item;
            __syncthreads();
            if (it >= 1024) break;
            d_knorm_rope(proj, P.k_gain, ksn, kwn, vsn, vwn, rope, it);
        }
    }
    xcd_barrier(B);
    for (int wi = bid0 * 4 + (threadIdx.x >> 6); wi < 256; wi += G * 4) d_cmp2_mfma(hid, cw2t, P.k_gain, rope, kc, vc, wi, threadIdx.x & 63);
    xcd_barrier(B);
    {
        if (bid0 < GDN_SCAN_ITEMS) d_gdn_scan2(gu, gw, gqd, gkd, gin, gl, og, bid0, smem);
        __syncthreads();
        const int rep = 0;
        for (;;) {
            if (threadIdx.x == 0) q_item = (int)xb_add(&P.bar[XB_QUEUE + 256 * rep], 1u);
            __syncthreads();
            const int it = q_item;
            if (it >= 1024 + 256) break;
            if (it >= 1024) {
                d_quant_rows16(P.peer_u, P.peer_v, uq_tmp, su, sv, (it - 1024) * 64 + (threadIdx.x >> 6) * 16, threadIdx.x & 63);
            } else {
                d_nsa_mfma(proj, P.q_gain, rope, ksn, kwn, kc, vc, vsn, vwn, mix, DM, it, smem);
            }
            __syncthreads();
        }
    }
    xcd_barrier(B);
    for (int t = 2 * (bid0 * 4 + (threadIdx.x >> 6)); t < T_TOK; t += G * 8) d_gdn_out(og, proj, P.out_gain, mix, t, threadIdx.x & 63);
    {
        const int n16 = 2 * 16384 * 1024 / 16, stride = G * 256;
        for (int i = bid0 * 256 + threadIdx.x; i < n16; i += 8 * stride) {
            u32x4 v[8];
#pragma unroll
            for (int k = 0; k < 8; k++) { const int ii = i + k * stride; v[k] = ((const u32x4*)uq_tmp)[ii < n16 ? ii : i]; }
#pragma unroll
            for (int k = 0; k < 8; k++) { const int ii = i + k * stride; if (ii < n16) ((u32x4*)uq)[ii] = v[k]; }
        }
    }
    xcd_barrier(B);
    {
        GemmP p{}; p.A = mix; p.lda = 1024; p.akts = 64; p.Bt = w_out_t; p.ldb = 1024; p.K = 1024; p.mtiles = 64; p.ntiles = 8; p.out = P.out; p.aux = P.x; p.out2 = h2; p.ssq = ssq;
        for (int it = bid0; it < 64 * 8; it += G) d_gemm<EPI_OUT>(p, it, smem);
    }
    if (xok) xcd_barrier_local(B, 0u); else xcd_barrier(B);
    {
        GemmP p{}; p.A = h2; p.lda = 1024; p.akts = 64; p.Bt = w_q_t; p.ldb = 1024; p.K = 1024; p.mtiles = 64; p.ntiles = 16; p.out = qry; p.ssq = ssq;
        for (int it = bid0; it < 64 * 16; it += G) d_gemm<EPI_QRY>(p, it, smem);
    }
    if (xok) xcd_barrier_local(B, 1u); else xcd_barrier(B);
    route_load_subkeys(P.subkeys, smem);
    __syncthreads();
    const int cls = bid0 & 7, lrank = bid0 >> 3, L = G >> 3;
    if (xok) { for (int i = lrank * 4 + (threadIdx.x >> 6); i < 1024; i += L * 4) d_peer_route2(qry, eidx, pgate, cls * 1024 + i, smem, threadIdx.x & 63); }
    else     { for (int mt = bid0 * 4 + (threadIdx.x >> 6); mt < T_TOK / 2; mt += G * 4) d_peer_route2(qry, eidx, pgate, mt, smem, threadIdx.x & 63); }
    asm volatile("s_waitcnt vmcnt(0)" ::: "memory");
    __builtin_amdgcn_fence(__ATOMIC_ACQUIRE, "agent");
    __syncthreads();
    {
        const int nitems = xok ? 256 : T_TOK / 8, stride = xok ? L : G, first = xok ? lrank : bid0;
        const int rounds = (nitems + stride - 1) / stride;
        for (int rd = 0; rd < rounds; rd++) {
            xcd_local_sync(B, (unsigned)(3 * rd));
            const int it = rd * stride + first;
            const int tok = (xok ? cls * 2048 : 0) + it * 8 + 2 * (threadIdx.x >> 6);
            if (it < nitems) d_peer_expert_pair(h2, eidx, pgate, uq, su, sv, ssq, P.ffn_norm, P.out, tok, threadIdx.x & 63, B, (unsigned)(3 * rd + 1));
            else { xcd_local_sync(B, (unsigned)(3 * rd + 1)); xcd_local_sync(B, (unsigned)(3 * rd + 2)); }
        }
    }
}

extern "C" void kernel_launch(void* const* d_in, const int* in_sizes, int n_in, void* d_out, int out_size, void* d_ws, size_t ws_size,
                              hipStream_t stream) {
    const size_t bar_off = (OFF_END + 255) & ~(size_t)255;
    if (ws_size < bar_off + XCD_BAR_WORDS * 4) return;
    static int grid_blocks = 0;
    if (!grid_blocks) {
        int dev = 0, cus = 0, per_cu = 0;
        (void)hipGetDevice(&dev);
        (void)hipDeviceGetAttribute(&cus, hipDeviceAttributeMultiprocessorCount, dev);
        (void)hipFuncSetAttribute((const void*)hybrid_megakernel, hipFuncAttributeMaxDynamicSharedMemorySize, SMEM_BYTES);
        (void)hipOccupancyMaxActiveBlocksPerMultiprocessor(&per_cu, hybrid_megakernel, 256, SMEM_BYTES);
        if (per_cu > 2) per_cu = 2;
        grid_blocks = cus * per_cu;
    }
    if (grid_blocks <= 0) return;
    MKP P{};
    P.x = (const float*)d_in[0]; P.attn_norm = (const float*)d_in[1]; P.w_in = (const float*)d_in[2]; P.q_gain = (const float*)d_in[3];
    P.k_gain = (const float*)d_in[4]; P.cmp_pos = (const float*)d_in[5]; P.cmp_w1 = (const float*)d_in[6]; P.cmp_w2 = (const float*)d_in[7];
    P.gdn_conv = (const float*)d_in[8]; P.a_log = (const float*)d_in[9]; P.dt_bias = (const float*)d_in[10]; P.out_gain = (const float*)d_in[11];
    P.w_out = (const float*)d_in[12]; P.ffn_norm = (const float*)d_in[13]; P.w_query = (const float*)d_in[14]; P.subkeys = (const float*)d_in[15];
    P.peer_u = (const float*)d_in[16]; P.peer_v = (const float*)d_in[17];
    P.out = (float*)d_out; P.ws = (char*)d_ws; P.bar = (unsigned*)((char*)d_ws + bar_off);
    (void)hipMemsetAsync(P.bar, 0, XCD_BAR_WORDS * 4, stream);
    hipLaunchKernelGGL(hybrid_megakernel, dim3(grid_blocks), dim3(256), SMEM_BYTES, stream, P);
}
```
